# Optimizing an MI355X kernel written in HIP

```python
import math
import jax, jax.numpy as jnp
from jax import lax
import numpy as np

D_MODEL = 1024
BATCH = 8
SEQ = 2048
DEPTH = 4

D_MIX = D_MODEL
D_MLSTM = D_MIX // 2
D_SB = D_MIX - D_MLSTM
H_MLSTM = 4
DH_MLSTM = D_MLSTM // H_MLSTM
H_SB = 8
DH_SB = D_SB // H_SB
CONV_K = 4
MLSTM_CHUNK = 64
SB_BLOCK = 128
P_IN = 4 * D_MLSTM + 2 * H_MLSTM + 3 * D_SB
D_FF_DENSE = 2752
N_EXPERTS = 8
TOP_K = 2
D_FF_EXPERT = 3584
N_DENSE_LAYERS = (DEPTH + 1) // 2
N_MOE_LAYERS = DEPTH // 2
EPS = 1e-6
M_INIT = -1e30

kernel_name = 'hybrid_mlstm_stickbreak_moe'


def _rmsnorm(x, g):
    xf = x.astype(jnp.float32)
    y = xf * lax.rsqrt(jnp.mean(xf * xf, axis=-1, keepdims=True) + EPS)
    return (y * g.astype(jnp.float32)).astype(x.dtype)


def _headwise_rmsnorm(x, g, n_heads):
    B, S, D = x.shape
    xf = x.astype(jnp.float32).reshape(B, S, n_heads, D // n_heads)
    y = xf * lax.rsqrt(jnp.mean(xf * xf, axis=-1, keepdims=True) + EPS)
    return y.reshape(B, S, D) * g.astype(jnp.float32)


def _to_heads(x, n_heads):
    B, S, D = x.shape
    return x.reshape(B, S, n_heads, D // n_heads).transpose(0, 2, 1, 3)


def _from_heads(x):
    B, H, S, dh = x.shape
    return x.transpose(0, 2, 1, 3).reshape(B, S, H * dh)


def _split_columns(proj):
    widths = (D_MLSTM, D_MLSTM, D_MLSTM, D_MLSTM, H_MLSTM, H_MLSTM, D_SB, D_SB, D_SB)
    out = []
    off = 0
    for w in widths:
        out.append(proj[..., off:off + w])
        off += w
    return out


def _causal_conv_silu(x, w, b):
    S = x.shape[1]
    xp = jnp.pad(x, ((0, 0), (CONV_K - 1, 0), (0, 0)))
    y = b
    for tap in range(CONV_K):
        y = y + xp[:, tap:tap + S, :] * w[tap]
    return jax.nn.silu(y)


def _mlstm_chunkwise(q, k, v, i_pre, f_pre):
    B, H, S, DH = q.shape
    L = MLSTM_CHUNK
    NC = S // L
    q = q.astype(jnp.float32)
    k = k.astype(jnp.float32) * (DH ** -0.5)
    v = v.astype(jnp.float32)
    log_i = i_pre.astype(jnp.float32)
    log_f = jax.nn.log_sigmoid(f_pre.astype(jnp.float32))

    def to_chunks(a):
        return jnp.moveaxis(a.reshape(B, H, NC, L, *a.shape[3:]), 2, 0)

    qc, kc, vc = to_chunks(q), to_chunks(k), to_chunks(v)
    ic, fc = to_chunks(log_i), to_chunks(log_f)
    causal = jnp.tril(jnp.ones((L, L), dtype=bool))

    def step(carry, inp):
        C, n, m = carry
        q_, k_, v_, i_, lf = inp
        b = jnp.cumsum(lf, axis=-1)
        d = b[..., :, None] - b[..., None, :] + i_[..., None, :]
        d = jnp.where(causal, d, -jnp.inf)
        inter = b + m[..., None]
        m_t = jnp.maximum(inter, jnp.max(d, axis=-1))
        w = jnp.exp(d - m_t[..., None])
        s = jnp.einsum('bhtd,bhsd->bhts', q_, k_) * w
        a_inter = jnp.exp(inter - m_t)
        num = a_inter[..., None] * jnp.einsum('bhtd,bhde->bhte', q_, C) + jnp.einsum('bhts,bhse->bhte', s, v_)
        den = a_inter * jnp.einsum('bhtd,bhd->bht', q_, n) + jnp.sum(s, axis=-1)
        h = num / jnp.maximum(jnp.abs(den), jnp.exp(-m_t))[..., None]
        b_last = b[..., -1]
        g = b_last[..., None] - b + i_
        m_new = jnp.maximum(b_last + m, jnp.max(g, axis=-1))
        decay = jnp.exp(b_last + m - m_new)
        wk = jnp.exp(g - m_new[..., None])[..., None] * k_
        C_new = decay[..., None, None] * C + jnp.einsum('bhsd,bhse->bhde', wk, v_)
        n_new = decay[..., None] * n + jnp.sum(wk, axis=2)
        return (C_new, n_new, m_new), h

    init = (jnp.zeros((B, H, DH, DH), jnp.float32),
            jnp.zeros((B, H, DH), jnp.float32),
            jnp.full((B, H), M_INIT, jnp.float32))
    _, hc = lax.scan(step, init, (qc, kc, vc, ic, fc))
    return jnp.moveaxis(hc, 0, 2).reshape(B, H, S, DH)


def _stick_breaking_attention(q, k, v):
    B, H, S, DH = q.shape
    scale = DH ** -0.5
    outs = []
    for blk in range(S // SB_BLOCK):
        t0 = blk * SB_BLOCK
        t1 = t0 + SB_BLOCK
        q_blk = q[:, :, t0:t1].astype(jnp.float32)
        k_blk = k[:, :, :t1].astype(jnp.float32)
        v_blk = v[:, :, :t1].astype(jnp.float32)
        z = jnp.einsum('bhtd,bhsd->bhts', q_blk, k_blk) * scale
        t_idx = t0 + jnp.arange(SB_BLOCK)[:, None]
        s_idx = jnp.arange(t1)[None, :]
        strict = s_idx < t_idx
        log_beta = jax.nn.log_sigmoid(z)
        log_rest = jnp.where(strict, jax.nn.log_sigmoid(-z), 0.0)
        rev = lax.cumsum(log_rest, axis=3, reverse=True)
        after = jnp.pad(rev[..., 1:], ((0, 0), (0, 0), (0, 0), (0, 1)))
        a = jnp.exp(jnp.where(strict, log_beta + after, -jnp.inf))
        outs.append(jnp.einsum('bhts,bhse->bhte', a, v_blk))
    return jnp.concatenate(outs, axis=2)


def _hybrid_mixer(h, w_in, b_igate, b_fgate, conv_w, conv_b, g_mlstm, g_sb, w_out):
    proj = h @ w_in
    q_m, k_m, v_m, o_m, i_pre, f_pre, q_s, k_s, v_s = _split_columns(proj)
    qk = _causal_conv_silu(jnp.concatenate([q_m, k_m], axis=-1), conv_w, conv_b)
    q_m, k_m = qk[..., :D_MLSTM], qk[..., D_MLSTM:]
    i_h = (i_pre + b_igate).transpose(0, 2, 1)
    f_h = (f_pre + b_fgate).transpose(0, 2, 1)
    h_m = _mlstm_chunkwise(_to_heads(q_m, H_MLSTM), _to_heads(k_m, H_MLSTM),
                           _to_heads(v_m, H_MLSTM), i_h, f_h)
    h_m = jax.nn.sigmoid(o_m.astype(jnp.float32)) * _headwise_rmsnorm(_from_heads(h_m), g_mlstm, H_MLSTM)
    h_s = _stick_breaking_attention(_to_heads(q_s, H_SB), _to_heads(k_s, H_SB), _to_heads(v_s, H_SB))
    h_s = _headwise_rmsnorm(_from_heads(h_s), g_sb, H_SB)
    mixed = jnp.concatenate([h_m, h_s], axis=-1).astype(h.dtype)
    return (mixed @ w_out).astype(h.dtype)


def _swiglu(h, w_gate, w_up, w_down):
    return (jax.nn.silu(h @ w_gate) * (h @ w_up)) @ w_down


def _moe_swiglu(h, w_router, w_gate, w_up, w_down):
    logits = (h @ w_router).astype(jnp.float32)
    top_val, top_idx = lax.top_k(logits, TOP_K)
    top_w = jax.nn.softmax(top_val, axis=-1)
    combine = jnp.sum(jax.nn.one_hot(top_idx, N_EXPERTS, dtype=jnp.float32) * top_w[..., None], axis=-2)
    combine = combine.astype(h.dtype)
    out = jnp.zeros_like(h)
    for e in range(N_EXPERTS):
        out = out + combine[..., e:e + 1] * _swiglu(h, w_gate[e], w_up[e], w_down[e])
    return out


def setup_inputs(seed: int = 0) -> dict:
    key = jax.random.key(seed)
    ks = jax.random.split(key, 20)
    f32 = jnp.float32
    nrm = lambda k, shape, fan_in: jax.random.normal(k, shape, f32) * (fan_in ** -0.5)
    return {
        'x': jax.random.normal(ks[0], (BATCH, SEQ, D_MODEL), f32),
        'norm_mix_g': 1.0 + 0.02 * jax.random.normal(ks[1], (DEPTH, D_MODEL), f32),
        'w_in': nrm(ks[2], (DEPTH, D_MODEL, P_IN), D_MODEL),
        'b_igate': 0.1 * jax.random.normal(ks[3], (DEPTH, H_MLSTM), f32),
        'b_fgate': 3.0 + 3.0 * jax.random.uniform(ks[4], (DEPTH, H_MLSTM), f32),
        'conv_w': nrm(ks[5], (DEPTH, CONV_K, 2 * D_MLSTM), CONV_K),
        'conv_b': 0.02 * jax.random.normal(ks[6], (DEPTH, 2 * D_MLSTM), f32),
        'g_mlstm': 1.0 + 0.02 * jax.random.normal(ks[7], (DEPTH, D_MLSTM), f32),
        'g_sb': 1.0 + 0.02 * jax.random.normal(ks[8], (DEPTH, D_SB), f32),
        'w_out': nrm(ks[9], (DEPTH, D_MIX, D_MODEL), D_MIX),
        'norm_ffn_g': 1.0 + 0.02 * jax.random.normal(ks[10], (DEPTH, D_MODEL), f32),
        'ffn_w_gate': nrm(ks[11], (N_DENSE_LAYERS, D_MODEL, D_FF_DENSE), D_MODEL),
        'ffn_w_up': nrm(ks[12], (N_DENSE_LAYERS, D_MODEL, D_FF_DENSE), D_MODEL),
        'ffn_w_down': nrm(ks[13], (N_DENSE_LAYERS, D_FF_DENSE, D_MODEL), D_FF_DENSE),
        'w_router': nrm(ks[14], (N_MOE_LAYERS, D_MODEL, N_EXPERTS), D_MODEL),
        'moe_w_gate': nrm(ks[15], (N_MOE_LAYERS, N_EXPERTS, D_MODEL, D_FF_EXPERT), D_MODEL),
        'moe_w_up': nrm(ks[16], (N_MOE_LAYERS, N_EXPERTS, D_MODEL, D_FF_EXPERT), D_MODEL),
        'moe_w_down': nrm(ks[17], (N_MOE_LAYERS, N_EXPERTS, D_FF_EXPERT, D_MODEL), D_FF_EXPERT),
        'norm_final_g': 1.0 + 0.02 * jax.random.normal(ks[18], (D_MODEL,), f32),
    }


def reference(x, norm_mix_g, w_in, b_igate, b_fgate, conv_w, conv_b, g_mlstm, g_sb, w_out,
              norm_ffn_g, ffn_w_gate, ffn_w_up, ffn_w_down, w_router, moe_w_gate, moe_w_up,
              moe_w_down, norm_final_g):
    h = x
    for layer in range(DEPTH):
        y = _rmsnorm(h, norm_mix_g[layer])
        h = h + _hybrid_mixer(y, w_in[layer], b_igate[layer], b_fgate[layer], conv_w[layer],
                              conv_b[layer], g_mlstm[layer], g_sb[layer], w_out[layer])
        y = _rmsnorm(h, norm_ffn_g[layer])
        j = layer // 2
        if layer % 2 == 0:
            h = h + _swiglu(y, ffn_w_gate[j], ffn_w_up[j], ffn_w_down[j])
        else:
            h = h + _moe_swiglu(y, w_router[j], moe_w_gate[j], moe_w_up[j], moe_w_down[j])
    return _rmsnorm(h, norm_final_g)
```

```cpp
#include <hip/hip_runtime.h>
#include <cstdio>
#include <cstdint>

#ifndef REP_PRO
#define REP_PRO 1
#endif
#ifndef REP_MIX
#define REP_MIX 1
#endif
#ifndef REP_INPROJ
#define REP_INPROJ 1
#endif
#ifndef REP_DUP
#define REP_DUP 1
#endif
#ifndef REP_MOEUP
#define REP_MOEUP 1
#endif
#ifndef REP_MOEDN
#define REP_MOEDN 1
#endif
#ifndef REP_CONV
#define REP_CONV 1
#endif
#ifndef MX_LATE
#define MX_LATE 0
#endif
#ifndef ML_CHUNK
#define ML_CHUNK 1
#endif
#ifndef MOE_TAIL_KS
#define MOE_TAIL_KS 4
#endif
#ifndef CONV_NOBAR
#define CONV_NOBAR 0
#endif
#ifndef NAIVE_MIX
#define NAIVE_MIX 0
#endif

constexpr int T = 16384, DM = 1024, SEQ = 2048, NBATCH = 8, DEPTH = 4;
constexpr int PIN = 3592, NPROJ = 3584;
constexpr int FFD = 2752, FFDP = 2816, FFE = 3584, NEXP = 8;
constexpr int HM = 4, DHM = 128, HS = 8, DHS = 64;
constexpr float EPS = 1e-6f;
constexpr float LOG2E = 1.4426950408889634f;
constexpr float QS_SCALE = 0.125f * LOG2E;
constexpr float KM_SCALE = 0.08838834764831845f;
constexpr int NWAVES = 8, NTHREADS = 512;

constexpr size_t MiB = 1u << 20;
constexpr size_t WS_CTL = 0, CTL_ZERO_BYTES = 1 * MiB;
constexpr size_t WS_WIN = 1 * MiB;
constexpr size_t WS_WOUT = 29 * MiB;
constexpr size_t WS_WGU = 37 * MiB;
constexpr size_t WS_WD = 59 * MiB;
constexpr size_t WS_MGU = 70 * MiB;
constexpr size_t WS_MD = 294 * MiB;
constexpr size_t WS_Y = 406 * MiB;
constexpr size_t WS_MIXED = 438 * MiB;
constexpr size_t WS_G = 470 * MiB;
constexpr size_t WS_GA = WS_G + 512 * 1024, WS_GM = WS_GA + 256 * 1024, WS_GE = WS_GM + 256 * 1024, WS_TG = WS_GE + 256 * 1024;
constexpr size_t WS_RINFO = 472 * MiB;
constexpr size_t WS_O2 = 474 * MiB;
constexpr size_t WS_BIG = 538 * MiB;
constexpr size_t WS_PROJ = WS_BIG, WS_QKC = WS_BIG + 112 * MiB, WS_HIDM = WS_BIG;
constexpr size_t WS_U = WS_BIG + 238 * MiB;
constexpr size_t WS_NV = WS_U + 15 * MiB, WS_CM = WS_NV + 128 * 1024;
constexpr size_t WS_RREC = WS_CM + 128 * 1024, WS_CNTW = WS_RREC + 512 * 1024;
constexpr size_t WS_HID = WS_BIG + 144 * MiB;
constexpr size_t WS_H16 = WS_U + 16 * MiB;
constexpr size_t WS_RS = WS_H16 + 32 * MiB, WS_RSI = WS_RS + 64 * 1024;
constexpr size_t WS_END = WS_H16 + 33 * MiB;
constexpr int HIDM_ROWS = 2 * T + 2048;
static_assert((size_t)HIDM_ROWS * FFE * 2 <= 238 * MiB, "hidm");
constexpr int CW_TMO = 0;
constexpr int CW_CNT = 64;
constexpr int CW_BAR = 4096;
constexpr int CW_INP = 3264;
constexpr int CW_CONV = 3200;
constexpr int CW_GB = 8192;
constexpr int CW_TAIL = 2048;

constexpr int RING_OFF = 0, RING_BYTES = 131072;
constexpr int MISC_OFF = 155648;
constexpr int LDS_BYTES = 163840;

#define GAS __attribute__((address_space(1)))
#define LAS __attribute__((address_space(3)))
typedef unsigned short bf16;
typedef unsigned v4u __attribute__((ext_vector_type(4)));
typedef unsigned v2u __attribute__((ext_vector_type(2)));
typedef float f32x4 __attribute__((ext_vector_type(4)));
typedef int i32x4 __attribute__((ext_vector_type(4)));
typedef float f32x2 __attribute__((ext_vector_type(2)));
typedef short bf16x8 __attribute__((ext_vector_type(8)));
typedef GAS unsigned gu32;
#define RLX_AGENT __ATOMIC_RELAXED, __HIP_MEMORY_SCOPE_AGENT
#define LDS_WAIT() asm volatile("s_waitcnt lgkmcnt(0)" ::: "memory")
#define VM_WAIT() asm volatile("s_waitcnt vmcnt(0)" ::: "memory")

__device__ __forceinline__ unsigned f2bf(float f) { unsigned u = __builtin_bit_cast(unsigned, f); return (u + 0x7fffu + ((u >> 16) & 1u)) >> 16; }
__device__ __forceinline__ unsigned pk2(float lo, float hi) { return f2bf(lo) | (f2bf(hi) << 16); }
__device__ __forceinline__ float bf2f(unsigned b) { return __builtin_bit_cast(float, b << 16); }
__device__ __forceinline__ float bflo(unsigned w) { return __builtin_bit_cast(float, w << 16); }
__device__ __forceinline__ float bfhi(unsigned w) { return __builtin_bit_cast(float, w & 0xffff0000u); }
__device__ __forceinline__ int lane_id() { return (int)__builtin_amdgcn_mbcnt_hi(~0u, __builtin_amdgcn_mbcnt_lo(~0u, 0u)); }
#define dpp_f(old, src, ctrl, rmask) __builtin_bit_cast(float, __builtin_amdgcn_update_dpp(__builtin_bit_cast(int, (float)(old)), __builtin_bit_cast(int, (float)(src)), ctrl, rmask, 0xf, false))
__device__ __forceinline__ float sxor32(float v, int hi) { auto rr = __builtin_amdgcn_permlane32_swap(__builtin_bit_cast(unsigned, v), __builtin_bit_cast(unsigned, v), false, false);
    return __builtin_bit_cast(float, hi ? rr[0] : rr[1]); }
__device__ __forceinline__ float quad_sum(float v) { v += dpp_f(0.f, v, 0xB1, 0xf); v += dpp_f(0.f, v, 0x4E, 0xf); return v; }
__device__ __forceinline__ float oct_sum(float v, int lane) { v = quad_sum(v); const float dn = dpp_f(0.f, v, 0x114, 0xf), up = dpp_f(0.f, v, 0x104, 0xf); return v + ((lane & 4) ? dn : up); }
#define DPP_SCAN(v, OP, ID) do { v = OP(v, __builtin_bit_cast(float, __builtin_amdgcn_update_dpp(__builtin_bit_cast(int, ID), __builtin_bit_cast(int, v), 0x111, 0xf, 0xf, false))); \
    v = OP(v, __builtin_bit_cast(float, __builtin_amdgcn_update_dpp(__builtin_bit_cast(int, ID), __builtin_bit_cast(int, v), 0x112, 0xf, 0xf, false))); \
    v = OP(v, __builtin_bit_cast(float, __builtin_amdgcn_update_dpp(__builtin_bit_cast(int, ID), __builtin_bit_cast(int, v), 0x114, 0xf, 0xf, false))); \
    v = OP(v, __builtin_bit_cast(float, __builtin_amdgcn_update_dpp(__builtin_bit_cast(int, ID), __builtin_bit_cast(int, v), 0x118, 0xf, 0xf, false))); \
    v = OP(v, __builtin_bit_cast(float, __builtin_amdgcn_update_dpp(__builtin_bit_cast(int, ID), __builtin_bit_cast(int, v), 0x142, 0xa, 0xf, false))); \
    v = OP(v, __builtin_bit_cast(float, __builtin_amdgcn_update_dpp(__builtin_bit_cast(int, ID), __builtin_bit_cast(int, v), 0x143, 0xc, 0xf, false))); } while (0)
#define OP_ADD(a, b) ((a) + (b))
#define OP_MAX(a, b) fmaxf((a), (b))
__device__ __forceinline__ float wave_sum(float v) { DPP_SCAN(v, OP_ADD, 0.0f); return __builtin_bit_cast(float, __builtin_amdgcn_readlane(__builtin_bit_cast(int, v), 63)); }

namespace pg8 {
#define PG8_LAS __attribute__((address_space(3)))
typedef unsigned short bf16_t;
typedef unsigned u32x4 __attribute__((ext_vector_type(4)));
constexpr int BM = 256, BK = 64, HALF = 128, HTB = HALF * BK * 2, STAGE_BYTES = 8 * HTB, NXCD = 8, WGM = 8;

__host__ __device__ __forceinline__ int lds_byte(int r, int c) { const int st = (r >> 4) * 2 + (c >> 5), rr = r & 15, cc = c & 31, ob = rr * 64 + cc * 2; return st * 1024 + (ob ^ (((ob >> 9) & 1) << 5)); }
__host__ __device__ __forceinline__ void stage_rc(int b, int& R, int& C) { const int st = b / 1024, sb = b % 1024, swz = sb ^ (((sb >> 9) & 1) << 5); R = (st >> 1) * 16 + swz / 64; C = (st & 1) * 32 + (swz % 64) / 2; }
__host__ __device__ __forceinline__ int perm32(int rho) { const int n = rho >> 4, i = rho & 15; return 8 * (i >> 2) + 4 * n + (i & 3); }

struct Unit { int pm, pn, e, pml, nvalid; };

__device__ __forceinline__ void tile_decode(int wgid, int nM, int nN, int& pm, int& pn) {
    const int nig = WGM * nN, gid = wgid / nig, fm = gid * WGM, gsz = (nM - fm) < WGM ? (nM - fm) : WGM;
    pm = fm + ((wgid % nig) % gsz); pn = (wgid % nig) / gsz;
}
__device__ __forceinline__ int xcd_remap(int L, int nwg) { const int q = nwg / NXCD, r = nwg % NXCD, xcd = L % NXCD, off = L / NXCD; return (xcd < r ? xcd * (q + 1) : r * (q + 1) + (xcd - r) * q) + off; }

struct DenseOrder {
    static constexpr bool GATHER = false;
    const char* A; const char* B; int K, KT; int nM, nN, nwg, G, c;
    __device__ void init(const void* A_, const void* B_, int M, int N, int K_, int G_, int c_) { A = (const char*)A_; B = (const char*)B_; K = K_; KT = K_ / BK; nM = M / BM; nN = N / BM; nwg = nM * nN; G = G_; c = c_; }
    __device__ __forceinline__ bool next(int i, Unit& u) const {
        const long L = (long)i * G + c; if (L >= nwg) return false;
        const int wgid = xcd_remap((int)L, nwg); tile_decode(wgid, nM, nN, u.pm, u.pn); u.e = 0; u.pml = u.pm; u.nvalid = BM; return true;
    }
    __device__ __forceinline__ const char* a_ptr(const Unit& u) const { return A + (size_t)u.pm * ((size_t)BM * K * 2); }
    __device__ __forceinline__ const char* b_ptr(const Unit& u) const { return B + (size_t)u.pn * ((size_t)BM * K * 2); }
    __device__ __forceinline__ unsigned grow(const Unit&, int) const { return 0u; }
    __device__ __forceinline__ const unsigned* rptr(const Unit&, int) const { return nullptr; }
};
struct InprojOrder {
    static constexpr bool GATHER = false;
    const char* A; const char* B; int K, KT, nM, nN, G, c, i0, ni;
    __device__ void init(const void* A_, const void* B_, int M, int N, int K_, int G_, int c_, int i0_, int ni_) { A = (const char*)A_; B = (const char*)B_; K = K_; KT = K_ / BK; nM = M / BM; nN = N / BM; G = G_; c = c_; i0 = i0_; ni = ni_; }
    __device__ __forceinline__ bool next(int i, Unit& u) const {
        if (i >= ni) return false;
        const int off = (i0 + i) * (G >> 3) + (c >> 3); if (off >= WGM * nN) return false;
        tile_decode((c & 7) * WGM * nN + off, nM, nN, u.pm, u.pn); u.e = 0; u.pml = u.pm; u.nvalid = BM; return true;
    }
    __device__ __forceinline__ const char* a_ptr(const Unit& u) const { return A + (size_t)u.pm * ((size_t)BM * K * 2); }
    __device__ __forceinline__ const char* b_ptr(const Unit& u) const { return B + (size_t)u.pn * ((size_t)BM * K * 2); }
    __device__ __forceinline__ unsigned grow(const Unit&, int) const { return 0u; }
    __device__ __forceinline__ const unsigned* rptr(const Unit&, int) const { return nullptr; }
};
template <bool GATH> struct MoeOrder {
    static constexpr bool GATHER = GATH;
    const char* A; const char* B; int K, KT; size_t bstride; int nN, nwg, G, c; const volatile LAS int* tab; const uint2* rinfo;
    __device__ void init(const void* A_, const void* B_, size_t bstride_, int N, int K_, int G_, int c_, const volatile LAS int* tab_, const uint2* rinfo_) {
        A = (const char*)A_; B = (const char*)B_; K = K_; KT = K_ / BK; bstride = bstride_; nN = N / BM; G = G_; c = c_; tab = tab_; rinfo = rinfo_; nwg = tab_[8] * nN; }
    __device__ __forceinline__ bool next(int i, Unit& u) const {
        const long L = (long)i * G + c; if (L >= nwg) return false;
        decode(xcd_remap((int)L, nwg), u); return true;
    }
    __device__ __forceinline__ void decode(const int wgid, Unit& u) const {
        int e = 0;
#pragma unroll
        for (int j = 1; j < 8; ++j) if (wgid >= tab[j] * nN) e = j;
        const int t0 = tab[e], nMe = tab[e + 1] - t0, cnt = tab[16 + e];
        int pml, pn;
        if (GATH) {
            const int ng = (nMe + WGM - 1) / WGM, bs = nMe / ng, ex = nMe - bs * ng, big = (bs + 1) * 4;
            int w = wgid - t0 * nN, fm, gsz;
            const int cb = w / (4 * nMe); w -= cb * 4 * nMe;
            if (w < ex * big) { const int g = w / big; w -= g * big; gsz = bs + 1; fm = g * (bs + 1); }
            else { w -= ex * big; const int g = w / (bs * 4); w -= g * bs * 4; gsz = bs; fm = ex * (bs + 1) + g * bs; }
            pml = fm + w % gsz; pn = 4 * cb + w / gsz;
        } else tile_decode(wgid - t0 * nN, nMe, nN, pml, pn);
        u.e = __builtin_amdgcn_readfirstlane(e); u.pml = __builtin_amdgcn_readfirstlane(pml); u.pn = __builtin_amdgcn_readfirstlane(pn); u.pm = __builtin_amdgcn_readfirstlane(t0 + pml);
        const int nv = cnt - pml * BM; u.nvalid = __builtin_amdgcn_readfirstlane(nv < BM ? nv : BM);
    }
    __device__ __forceinline__ const char* a_ptr(const Unit& u) const { return GATH ? A : A + (size_t)u.pm * ((size_t)BM * K * 2); }
    __device__ __forceinline__ const char* b_ptr(const Unit& u) const { return B + (size_t)u.e * bstride + (size_t)u.pn * ((size_t)BM * K * 2); }
    __device__ __forceinline__ const unsigned* rptr(const Unit& u, int r) const { const int rr = r < u.nvalid ? r : u.nvalid - 1; return (const unsigned*)(rinfo + (size_t)u.e * T + (size_t)u.pml * BM + rr); }
    __device__ __forceinline__ unsigned grow(const Unit& u, int r) const {
        const int rr = r < u.nvalid ? r : u.nvalid - 1;
        const unsigned ts = rinfo[(size_t)u.e * T + (size_t)u.pml * BM + rr].x;
        return (ts >> 1) * (unsigned)(K * 2);
    }
};

__device__ __forceinline__ unsigned cvt_pk_bf16(float lo, float hi) { unsigned r; asm volatile("v_cvt_pk_bf16_f32 %0, %1, %2" : "=v"(r) : "v"(lo), "v"(hi)); return r; }

struct EpiProj {
    static constexpr bool PERM = true, RSLDS = true;
    bf16_t* O; const float* RS;
    __device__ __forceinline__ const float* rs_base(const Unit& u) const { return RS + (size_t)u.pm * BM; }
    __device__ __forceinline__ void operator()(const f32x4 (&acc)[2][2][4][2], const Unit& u, int wr, int wc, int fr, int fq, const PG8_LAS float* rsl) const {
        const int row0 = u.pm * BM + wr * 64 + fr, col0 = u.pn * BM + wc * 32 + 8 * fq;
        const float sc0 = (u.pn == 8 || u.pn == 9) ? QS_SCALE : 1.0f;
        float rsv[2][4];
#pragma unroll
        for (int ai = 0; ai < 2; ++ai)
#pragma unroll
            for (int m = 0; m < 4; ++m) rsv[ai][m] = rsl[wr * 64 + fr + ai * HALF + m * 16];
#pragma unroll
        for (int ai = 0; ai < 2; ++ai)
#pragma unroll
            for (int m = 0; m < 4; ++m) { bf16_t* rowp = O + (size_t)(row0 + ai * HALF + m * 16) * NPROJ + col0; const float sc = sc0 * rsv[ai][m];
#pragma unroll
                for (int bj = 0; bj < 2; ++bj) { const f32x4 v0 = acc[ai][bj][m][0] * sc, v1 = acc[ai][bj][m][1] * sc;
                    u32x4 w; w.x = cvt_pk_bf16(v0[0], v0[1]); w.y = cvt_pk_bf16(v0[2], v0[3]); w.z = cvt_pk_bf16(v1[0], v1[1]); w.w = cvt_pk_bf16(v1[2], v1[3]);
                    *(u32x4*)(rowp + bj * HALF) = w; } }
    }
};
struct EpiResid {
    static constexpr bool PERM = false, RSLDS = false;
    const float* Hin; float* Hout;
    __device__ __forceinline__ void operator()(const f32x4 (&acc)[2][2][4][2], const Unit& u, int wr, int wc, int fr, int fq) const {
        const int row0 = u.pm * BM + wr * 64 + fr, col0 = u.pn * BM + wc * 32 + 4 * fq;
#pragma unroll
        for (int ai = 0; ai < 2; ++ai)
#pragma unroll
            for (int mh = 0; mh < 2; ++mh) {
                f32x4 hv[2][2][2];
#pragma unroll
                for (int m2 = 0; m2 < 2; ++m2) { const size_t off = (size_t)(row0 + ai * HALF + (2 * mh + m2) * 16) * DM + col0;
#pragma unroll
                    for (int bj = 0; bj < 2; ++bj)
#pragma unroll
                        for (int n = 0; n < 2; ++n) hv[m2][bj][n] = *(const f32x4*)(Hin + off + bj * HALF + n * 16); }
                asm volatile("" : "+v"(hv[0][0][0]), "+v"(hv[0][0][1]), "+v"(hv[0][1][0]), "+v"(hv[0][1][1]), "+v"(hv[1][0][0]), "+v"(hv[1][0][1]), "+v"(hv[1][1][0]), "+v"(hv[1][1][1]));
#pragma unroll
                for (int m2 = 0; m2 < 2; ++m2) { const size_t off = (size_t)(row0 + ai * HALF + (2 * mh + m2) * 16) * DM + col0;
#pragma unroll
                    for (int bj = 0; bj < 2; ++bj)
#pragma unroll
                        for (int n = 0; n < 2; ++n) *(f32x4*)(Hout + off + bj * HALF + n * 16) = hv[m2][bj][n] + acc[ai][bj][2 * mh + m2][n]; }
            }
    }
};
template <bool XIN> struct EpiResid16 {
    static constexpr bool PERM = false, RSLDS = false;
    const float* X; bf16_t* H;
    __device__ __forceinline__ void operator()(const f32x4 (&acc)[2][2][4][2], const Unit& u, int wr, int wc, int fr, int fq) const {
        typedef unsigned u32x2_ __attribute__((ext_vector_type(2)));
        const int row0 = u.pm * BM + wr * 64 + fr, col0 = u.pn * BM + wc * 32 + 4 * fq;
#pragma unroll
        for (int ai = 0; ai < 2; ++ai)
#pragma unroll
            for (int mh = 0; mh < 2; ++mh) {
                f32x4 hv[2][2][2]; u32x2_ hb[2][2][2];
#pragma unroll
                for (int m2 = 0; m2 < 2; ++m2) { const size_t off = (size_t)(row0 + ai * HALF + (2 * mh + m2) * 16) * DM + col0;
#pragma unroll
                    for (int bj = 0; bj < 2; ++bj)
#pragma unroll
                        for (int n = 0; n < 2; ++n) { if constexpr (XIN) hv[m2][bj][n] = *(const f32x4*)(X + off + bj * HALF + n * 16); else hb[m2][bj][n] = *(const u32x2_*)(H + off + bj * HALF + n * 16); } }
                if constexpr (XIN) asm volatile("" : "+v"(hv[0][0][0]), "+v"(hv[0][0][1]), "+v"(hv[0][1][0]), "+v"(hv[0][1][1]), "+v"(hv[1][0][0]), "+v"(hv[1][0][1]), "+v"(hv[1][1][0]), "+v"(hv[1][1][1]));
                else asm volatile("" : "+v"(hb[0][0][0]), "+v"(hb[0][0][1]), "+v"(hb[0][1][0]), "+v"(hb[0][1][1]), "+v"(hb[1][0][0]), "+v"(hb[1][0][1]), "+v"(hb[1][1][0]), "+v"(hb[1][1][1]));
#pragma unroll
                for (int m2 = 0; m2 < 2; ++m2) { const size_t off = (size_t)(row0 + ai * HALF + (2 * mh + m2) * 16) * DM + col0;
#pragma unroll
                    for (int bj = 0; bj < 2; ++bj)
#pragma unroll
                        for (int n = 0; n < 2; ++n) { f32x4 h4;
                            if constexpr (XIN) h4 = hv[m2][bj][n];
                            else { const u32x2_ b = hb[m2][bj][n]; h4 = (f32x4){__builtin_bit_cast(float, b.x << 16), __builtin_bit_cast(float, b.x & 0xffff0000u), __builtin_bit_cast(float, b.y << 16), __builtin_bit_cast(float, b.y & 0xffff0000u)}; }
                            const f32x4 r = h4 + acc[ai][bj][2 * mh + m2][n];
                            *(u32x2_*)(H + off + bj * HALF + n * 16) = (u32x2_){cvt_pk_bf16(r[0], r[1]), cvt_pk_bf16(r[2], r[3])}; } }
            }
    }
};
__device__ __forceinline__ float silu_mul(float g, float u) { return g * u * __builtin_amdgcn_rcpf(1.0f + __builtin_amdgcn_exp2f(-g * LOG2E)); }
struct EpiSwiglu {
    static constexpr bool PERM = true, RSLDS = true;
    bf16_t* O; int ld; const float* RS; const float* RSI;
    __device__ __forceinline__ const float* rs_base(const Unit& u) const { return RSI ? RSI + (size_t)u.e * T + (size_t)u.pml * BM : RS + (size_t)u.pm * BM; }
    __device__ __forceinline__ void operator()(const f32x4 (&acc)[2][2][4][2], const Unit& u, int wr, int wc, int fr, int fq, const PG8_LAS float* rsl) const {
        const int row0 = u.pm * BM + wr * 64 + fr, col0 = u.pn * HALF + wc * 32 + 8 * fq;
        float rsv[2][4];
#pragma unroll
        for (int ai = 0; ai < 2; ++ai)
#pragma unroll
            for (int m = 0; m < 4; ++m) rsv[ai][m] = rsl[wr * 64 + fr + ai * HALF + m * 16];
#pragma unroll
        for (int ai = 0; ai < 2; ++ai)
#pragma unroll
            for (int m = 0; m < 4; ++m) { bf16_t* rowp = O + (size_t)(row0 + ai * HALF + m * 16) * ld + col0; const float rs = rsv[ai][m];
                const f32x4 g0 = acc[ai][0][m][0] * rs, g1 = acc[ai][0][m][1] * rs, u0 = acc[ai][1][m][0] * rs, u1 = acc[ai][1][m][1] * rs;
                u32x4 w; w.x = cvt_pk_bf16(silu_mul(g0[0], u0[0]), silu_mul(g0[1], u0[1])); w.y = cvt_pk_bf16(silu_mul(g0[2], u0[2]), silu_mul(g0[3], u0[3]));
                w.z = cvt_pk_bf16(silu_mul(g1[0], u1[0]), silu_mul(g1[1], u1[1])); w.w = cvt_pk_bf16(silu_mul(g1[2], u1[2]), silu_mul(g1[3], u1[3]));
                *(u32x4*)rowp = w; }
    }
};
struct EpiScatter {
    static constexpr bool PERM = true, RSLDS = false;
    bf16_t* O2; const uint2* rinfo;
    __device__ __forceinline__ void operator()(const f32x4 (&acc)[2][2][4][2], const Unit& u, int wr, int wc, int fr, int fq) const {
        const int col0 = u.pn * BM + wc * 32 + 8 * fq;
        uint2 inf[2][4];
#pragma unroll
        for (int ai = 0; ai < 2; ++ai)
#pragma unroll
            for (int m = 0; m < 4; ++m) { const int rl = ai * HALF + wr * 64 + m * 16 + fr; const int rc = rl < u.nvalid ? rl : u.nvalid - 1;
                inf[ai][m] = rinfo[(size_t)u.e * T + (size_t)u.pml * BM + rc]; }
#pragma unroll
        for (int ai = 0; ai < 2; ++ai)
#pragma unroll
            for (int m = 0; m < 4; ++m) asm volatile("" : "+v"(inf[ai][m].x), "+v"(inf[ai][m].y));
#pragma unroll
        for (int ai = 0; ai < 2; ++ai)
#pragma unroll
            for (int m = 0; m < 4; ++m) { const int rl = ai * HALF + wr * 64 + m * 16 + fr;
                if (rl < u.nvalid) { const float wgt = __builtin_bit_cast(float, inf[ai][m].y);
                    bf16_t* rowp = O2 + ((size_t)(inf[ai][m].x & 1u) * T + (size_t)(inf[ai][m].x >> 1)) * DM + col0;
#pragma unroll
                    for (int bj = 0; bj < 2; ++bj) { const f32x4 v0 = acc[ai][bj][m][0] * wgt, v1 = acc[ai][bj][m][1] * wgt;
                        u32x4 w; w.x = cvt_pk_bf16(v0[0], v0[1]); w.y = cvt_pk_bf16(v0[2], v0[3]); w.z = cvt_pk_bf16(v1[0], v1[1]); w.w = cvt_pk_bf16(v1[2], v1[3]);
                        *(u32x4*)(rowp + bj * HALF) = w; } } }
    }
};

struct MoeTailOrder {
    static constexpr bool GATHER = false;
    MoeOrder<false> base; const char* A; const char* B; int K, KT, slice, wgid; bool have;
    __device__ void init(const MoeOrder<false>& b, int nmain, int rem, int ks, int c) { base = b; A = b.A; B = b.B; K = b.K; KT = b.KT / ks; have = c < rem * ks; slice = c / (rem > 0 ? rem : 1); wgid = nmain + c % (rem > 0 ? rem : 1); }
    __device__ __forceinline__ bool next(int i, Unit& u) const { if (i != 0 || !have) return false; base.decode(wgid, u); return true; }
    __device__ __forceinline__ const char* a_ptr(const Unit& u) const { return base.a_ptr(u) + (size_t)slice * KT * (BK * 2); }
    __device__ __forceinline__ const char* b_ptr(const Unit& u) const { return base.b_ptr(u) + (size_t)slice * KT * (BK * 2); }
    __device__ __forceinline__ unsigned grow(const Unit&, int) const { return 0u; }
    __device__ __forceinline__ const unsigned* rptr(const Unit&, int) const { return nullptr; }
};
struct EpiPartial {
    static constexpr bool PERM = true, RSLDS = false;
    float* P;
    __device__ __forceinline__ void operator()(const f32x4 (&acc)[2][2][4][2], const Unit&, int wr, int wc, int fr, int fq) const {
        const int tid = (wr * 4 + wc) * 64 + fq * 16 + fr;
#pragma unroll
        for (int ai = 0; ai < 2; ++ai)
#pragma unroll
            for (int bj = 0; bj < 2; ++bj)
#pragma unroll
                for (int m = 0; m < 4; ++m)
#pragma unroll
                    for (int n = 0; n < 2; ++n) *(f32x4*)(P + ((size_t)((((ai * 2 + bj) * 4 + m) * 2 + n) * 512 + tid)) * 4) = acc[ai][bj][m][n];
    }
};

template <class Epi, class Sched, bool ALIGN_EPI>
__device__ __forceinline__ void gemm_phase(PG8_LAS unsigned char* lds, const Sched& S, const Epi& E, const int tid) {
    const int wid = __builtin_amdgcn_readfirstlane(tid >> 6), lane = tid & 63, wr = wid >> 2, wc = wid & 3, fr = lane & 15, fq = lane >> 4;
    const int K = S.K, nt = S.KT;
    constexpr bool GA = Sched::GATHER;
    unsigned voffA[2], voffB[2]; int RA[2], CA[2];
#pragma unroll
    for (int i = 0; i < 2; ++i) { int R, C; stage_rc(tid * 16 + i * 8192, R, C); const int Rb = Epi::PERM ? ((R & ~31) + perm32(R & 31)) : R;
        RA[i] = R; CA[i] = C; voffA[i] = GA ? (unsigned)(C * 2) : (unsigned)(R * K + C) * 2u; voffB[i] = (unsigned)(Rb * K + C) * 2u; }
    const size_t kstep = (size_t)(BK * 2);
    const size_t hstep = (size_t)HALF * K * 2;
    const unsigned ldsw = (unsigned)wid * 1024u;
    const int aoff = lds_byte(wr * 64 + fr, fq * 8), boff = lds_byte(wc * 32 + fr, fq * 8);
#define PG8_SA(b, h) (((b) * 2 + (h)) * HTB)
#define PG8_SB(b, h) ((4 + (b) * 2 + (h)) * HTB)
#define PG8_STAGE(bufoff, gbase, voff) do { _Pragma("unroll") for (int _i = 0; _i < 2; ++_i) \
        __builtin_amdgcn_global_load_lds((const unsigned*)((const char*)(gbase) + (voff)[_i]), (PG8_LAS unsigned*)(lds + (bufoff) + ldsw + _i * 8192), 16, 0, 0); } while (0)
#define PG8_STAGE_A(bufoff, kb, h, NX) do { if constexpr (GA) { _Pragma("unroll") for (int _i = 0; _i < 2; ++_i) { const unsigned _o = ((NX) ? gnx[h][_i] : gcu[h][_i]) + voffA[_i]; \
        __builtin_amdgcn_global_load_lds((const unsigned*)((const char*)(kb) + _o), (PG8_LAS unsigned*)(lds + (bufoff) + ldsw + _i * 8192), 16, 0, 0); } } \
        else { PG8_STAGE(bufoff, (kb) + (h) * hstep, voffA); } } while (0)
#define PG8_LDA(dst, b, h) do { _Pragma("unroll") for (int m = 0; m < 4; ++m) _Pragma("unroll") for (int k = 0; k < 2; ++k) dst[m][k] = *(const PG8_LAS bf16x8*)(lds + PG8_SA(b, h) + aoff + m * 2048 + k * 1024); } while (0)
#define PG8_LDB(dst, b, h) do { _Pragma("unroll") for (int n = 0; n < 2; ++n) _Pragma("unroll") for (int k = 0; k < 2; ++k) dst[n][k] = *(const PG8_LAS bf16x8*)(lds + PG8_SB(b, h) + boff + n * 2048 + k * 1024); } while (0)
#define PG8_MMA(ai, bj, At, Bt) do { __builtin_amdgcn_s_setprio(1); _Pragma("unroll") for (int m = 0; m < 4; ++m) _Pragma("unroll") for (int n = 0; n < 2; ++n) _Pragma("unroll") for (int k = 0; k < 2; ++k) \
        acc[ai][bj][m][n] = __builtin_amdgcn_mfma_f32_16x16x32_bf16(Bt[n][k], At[m][k], acc[ai][bj][m][n], 0, 0, 0); __builtin_amdgcn_s_setprio(0); } while (0)
#define PG8_WAIT_V(n) asm volatile("s_waitcnt vmcnt(" #n ")" ::: "memory")
#define PG8_WAIT_L(n) asm volatile("s_waitcnt lgkmcnt(" #n ")" ::: "memory")
#define PG8_BAR __builtin_amdgcn_s_barrier()
#define PG8_SCHED __builtin_amdgcn_sched_barrier(0)
    Unit cur, nxt; int ui = 0;
    if (!S.next(0, cur)) return;
#define PG8_RS_STAGE(u_, par_) do { if constexpr (Epi::RSLDS) { if (wid < 4) __builtin_amdgcn_global_load_lds((const unsigned*)(E.rs_base(u_) + wid * 64 + lane), (PG8_LAS unsigned*)(lds + STAGE_BYTES + (par_) * 1024 + wid * 256), 4, 0, 0); } } while (0)
    PG8_RS_STAGE(cur, 0);
    unsigned gcu[2][2] = {{0u, 0u}, {0u, 0u}}, gnx[2][2] = {{0u, 0u}, {0u, 0u}};
    if constexpr (GA) {
#pragma unroll
        for (int h = 0; h < 2; ++h)
#pragma unroll
            for (int i = 0; i < 2; ++i) gcu[h][i] = S.grow(cur, h * HALF + RA[i]);
    }
    f32x4 acc[2][2][4][2];
#pragma unroll
    for (int a = 0; a < 2; ++a)
#pragma unroll
        for (int b = 0; b < 2; ++b)
#pragma unroll
            for (int m = 0; m < 4; ++m)
#pragma unroll
                for (int n = 0; n < 2; ++n) acc[a][b][m][n] = (f32x4){0.f, 0.f, 0.f, 0.f};
    bf16x8 At[4][2], B0[2][2], B1[2][2];
    const char* cA = S.a_ptr(cur); const char* cB = S.b_ptr(cur);
    PG8_STAGE(PG8_SB(0, 0), cB, voffB); PG8_STAGE(PG8_SB(0, 1), cB + hstep, voffB); PG8_STAGE_A(PG8_SA(0, 0), cA, 0, false); PG8_STAGE_A(PG8_SA(0, 1), cA, 1, false);
    if (wr == 1) PG8_BAR;
    PG8_WAIT_V(2); PG8_BAR;
    PG8_STAGE(PG8_SB(1, 0), cB + kstep, voffB); PG8_STAGE_A(PG8_SA(1, 0), cA + kstep, 0, false); PG8_STAGE(PG8_SB(1, 1), cB + hstep + kstep, voffB);
    PG8_WAIT_V(6); PG8_BAR;
    for (;;) {
        const bool has_next = S.next(ui + 1, nxt);
        const char* nA = has_next ? S.a_ptr(nxt) : cA; const char* nB = has_next ? S.b_ptr(nxt) : cB;
        unsigned raw[2][2] = {{0u, 0u}, {0u, 0u}};
        if constexpr (GA) {
            if (has_next) {
#pragma unroll
                for (int h = 0; h < 2; ++h)
#pragma unroll
                    for (int i = 0; i < 2; ++i) { const unsigned* rp = S.rptr(nxt, h * HALF + RA[i]); asm volatile("global_load_dword %0, %1, off" : "=v"(raw[h][i]) : "v"(rp) : "memory"); }
            }
        }
        for (int t = 0; t < nt; t += 2) {
            const bool last = (t == nt - 2);
            if constexpr (GA) { if (last) { asm volatile("" : "+v"(raw[0][0]), "+v"(raw[0][1]), "+v"(raw[1][0]), "+v"(raw[1][1]));
#pragma unroll
                for (int h = 0; h < 2; ++h)
#pragma unroll
                    for (int i = 0; i < 2; ++i) gnx[h][i] = has_next ? (raw[h][i] >> 1) * (unsigned)(K * 2) : gcu[h][i]; } }
            const char* a1 = cA + (size_t)(t + 1) * kstep;
            const char* a2 = last ? nA : cA + (size_t)(t + 2) * kstep; const char* b2 = last ? nB : cB + (size_t)(t + 2) * kstep;
            const char* a3 = a2 + kstep; const char* b3 = b2 + kstep;
            PG8_LDB(B0, 0, 0); PG8_LDB(B1, 0, 1); PG8_SCHED; PG8_LDA(At, 0, 0); PG8_STAGE_A(PG8_SA(1, 1), a1, 1, false);
            PG8_WAIT_V(8); PG8_WAIT_L(0); PG8_BAR; PG8_MMA(0, 0, At, B0); PG8_MMA(0, 1, At, B1); PG8_BAR; PG8_SCHED;
            PG8_LDA(At, 0, 1); PG8_STAGE(PG8_SB(0, 0), b2, voffB); PG8_STAGE(PG8_SB(0, 1), b2 + hstep, voffB); PG8_STAGE_A(PG8_SA(0, 0), a2, 0, last);
            PG8_WAIT_V(8); PG8_WAIT_L(0); PG8_BAR; PG8_MMA(1, 0, At, B0); PG8_MMA(1, 1, At, B1); PG8_BAR; PG8_SCHED;
            PG8_LDB(B0, 1, 0); PG8_LDB(B1, 1, 1); PG8_SCHED; PG8_LDA(At, 1, 0); PG8_STAGE_A(PG8_SA(0, 1), a2, 1, last);
            PG8_WAIT_V(8); PG8_WAIT_L(0); PG8_BAR; PG8_MMA(0, 0, At, B0); PG8_MMA(0, 1, At, B1); PG8_BAR; PG8_SCHED;
            PG8_LDA(At, 1, 1); PG8_STAGE(PG8_SB(1, 0), b3, voffB); PG8_STAGE(PG8_SB(1, 1), b3 + hstep, voffB); PG8_STAGE_A(PG8_SA(1, 0), a3, 0, last);
            PG8_WAIT_V(8); PG8_WAIT_L(0); PG8_BAR; PG8_MMA(1, 0, At, B0); PG8_MMA(1, 1, At, B1); PG8_BAR; PG8_SCHED;
        }
        if constexpr (ALIGN_EPI) { if (wr == 0) PG8_BAR; }
        if constexpr (Epi::RSLDS) E(acc, cur, wr, wc, fr, fq, (const PG8_LAS float*)(lds + STAGE_BYTES + (ui & 1) * 1024)); else E(acc, cur, wr, wc, fr, fq);
        if (!has_next) break;
#pragma unroll
        for (int a = 0; a < 2; ++a)
#pragma unroll
            for (int b = 0; b < 2; ++b)
#pragma unroll
                for (int m = 0; m < 4; ++m)
#pragma unroll
                    for (int n = 0; n < 2; ++n) acc[a][b][m][n] = (f32x4){0.f, 0.f, 0.f, 0.f};
        cur = nxt; cA = nA; cB = nB; ++ui;
        PG8_RS_STAGE(cur, ui & 1);
        if constexpr (GA) {
#pragma unroll
            for (int h = 0; h < 2; ++h)
#pragma unroll
                for (int i = 0; i < 2; ++i) gcu[h][i] = gnx[h][i];
        }
        if constexpr (ALIGN_EPI) { if (wr == 1) PG8_BAR; }
    }
    PG8_WAIT_V(0);
    if constexpr (!ALIGN_EPI) { if (wr == 0) PG8_BAR; }
    PG8_BAR;
#undef PG8_RS_STAGE
#undef PG8_SA
#undef PG8_SB
#undef PG8_STAGE
#undef PG8_STAGE_A
#undef PG8_LDA
#undef PG8_LDB
#undef PG8_MMA
#undef PG8_WAIT_V
#undef PG8_WAIT_L
#undef PG8_BAR
#undef PG8_SCHED
}
}

#define XB_TMO      128
#define XB_XCNT(j)  (256  + 64 * (j))
#define XB_XSUB(j)  (1280 + 64 * (j))
#define XB_XGEN(j)  (2304 + 64 * (j))
#define XB_TOP      3328
#define XB_TOPGEN   3392
#define XCD_BAR_WORDS 3456
#define XB_SPIN_CAP (1u << 20)

__device__ __forceinline__ unsigned xb_ld(unsigned* p)              { return __hip_atomic_load(p, __ATOMIC_RELAXED, __HIP_MEMORY_SCOPE_AGENT); }
__device__ __forceinline__ unsigned xb_add(unsigned* p, unsigned v) { return __hip_atomic_fetch_add(p, v, __ATOMIC_RELAXED, __HIP_MEMORY_SCOPE_AGENT); }
__device__ __forceinline__ unsigned xb_xcc_id() { return (unsigned)__builtin_amdgcn_s_getreg((3 << 11) | 20) & 0xFu; }
#define XB_SPIN(cond, bar) do { unsigned _sp = 0; while (cond) { __builtin_amdgcn_s_sleep(1); \
    if ((++_sp & 255u) == 0u) { if (xb_ld(&(bar)[XB_TMO])) break; if (_sp > XB_SPIN_CAP) { atomicAdd(&(bar)[XB_TMO], 1u); break; } } } } while (0)

struct XcdBarrier { unsigned* bar; unsigned x; volatile LAS unsigned* st; };

__device__ __forceinline__ XcdBarrier xcd_barrier_post(unsigned* bar, volatile LAS unsigned* st) {
    XcdBarrier b; b.bar = bar; b.x = xb_xcc_id(); b.st = st;
    if (threadIdx.x == 0) (void)xb_add(&bar[XB_XCNT(b.x)], 1u);
    return b;
}
__device__ __forceinline__ void xcd_barrier_complete(unsigned* bar, unsigned x, unsigned& nloc, unsigned& nx) {
    const unsigned G = gridDim.x * gridDim.y * gridDim.z;
    unsigned sum, cnt, mine, sp = 0u;
    for (;;) {
        sum = 0u; cnt = 0u; mine = 0u;
#pragma unroll
        for (unsigned j = 0; j < 16; ++j) { const unsigned c = xb_ld(&bar[XB_XCNT(j)]); sum += c; cnt += (c > 0u) ? 1u : 0u; mine = (j == x) ? c : mine; }
        if (sum == G) break;
        __builtin_amdgcn_s_sleep(1);
        if ((++sp & 255u) == 0u) { if (xb_ld(&bar[XB_TMO])) break; if (sp > XB_SPIN_CAP) { atomicAdd(&bar[XB_TMO], 1u); break; } }
    }
    nloc = mine > 0u ? mine : 1u; nx = cnt > 0u ? cnt : 1u;
}
__device__ __forceinline__ void xcd_barrier(const XcdBarrier& b, const int wave_s) {
    asm volatile("s_waitcnt vmcnt(0)" ::: "memory");
    __syncthreads();
    if (wave_s == 0 && lane_id() == 0) {
        unsigned* bar = b.bar;
        __builtin_amdgcn_s_waitcnt(0);
        unsigned nloc = b.st[0], nx = b.st[1];
        if (nloc == 0u) { xcd_barrier_complete(bar, b.x, nloc, nx); b.st[0] = nloc; b.st[1] = nx; }
        const unsigned old = xb_add(&bar[XB_XSUB(b.x)], 1u);
        const unsigned gen = old / nloc;
        if (old + 1u == (gen + 1u) * nloc) {
            __builtin_amdgcn_fence(__ATOMIC_RELEASE, "agent");
            asm volatile("s_waitcnt vmcnt(0)" ::: "memory");
            const unsigned og = xb_add(&bar[XB_TOP], 1u);
            const unsigned tg = og / nx;
            if (og + 1u == (tg + 1u) * nx) xb_add(&bar[XB_TOPGEN], 1u);
            else XB_SPIN(xb_ld(&bar[XB_TOPGEN]) == tg, bar);
            __builtin_amdgcn_fence(__ATOMIC_ACQUIRE, "agent");
            xb_add(&bar[XB_XGEN(b.x)], 1u);
            asm volatile("s_waitcnt vmcnt(0)" ::: "memory");
        } else {
            XB_SPIN(xb_ld(&bar[XB_XGEN(b.x)]) == gen, bar);
            __builtin_amdgcn_fence(__ATOMIC_ACQUIRE, "agent");
            asm volatile("s_waitcnt vmcnt(0)" ::: "memory");
        }
    }
    __syncthreads();
}

#define GB_XCNT(x) (64 * (x))
#define GB_SUB(x)  (1024 + 64 * (x))
#define GB_GEN(x)  (2048 + 64 * (x))
#define GB_TOP     3072
#define GB_ASUB(x) (3136 + 32 * (x))
#define GB_ATOP    3712
__device__ __forceinline__ void group_members(gu32* gb, volatile LAS unsigned* st, const unsigned x, unsigned& nloc, unsigned& nx) {
    nloc = st[1]; nx = st[2];
    if (nloc == 0u) { nx = 0u;
        for (unsigned q = 0; q < 16; ++q) { const unsigned c = __hip_atomic_load(gb + GB_XCNT(q), __ATOMIC_RELAXED, __HIP_MEMORY_SCOPE_AGENT); nx += c > 0u ? 1u : 0u; nloc = q == x ? c : nloc; }
        nloc = nloc > 0u ? nloc : 1u; st[1] = nloc; st[2] = nx; }
}
__device__ __forceinline__ void group_arrive(gu32* gb, volatile LAS unsigned* st, const unsigned x, const unsigned r) {
    unsigned nloc, nx; group_members(gb, st, x, nloc, nx);
    const unsigned old = __hip_atomic_fetch_add(gb + GB_ASUB(x), 1u, __ATOMIC_RELAXED, __HIP_MEMORY_SCOPE_AGENT);
    if (old + 1u == r * nloc) { __builtin_amdgcn_fence(__ATOMIC_RELEASE, "agent"); asm volatile("s_waitcnt vmcnt(0)" ::: "memory");
        (void)__hip_atomic_fetch_add(gb + GB_ATOP, 1u, __ATOMIC_RELAXED, __HIP_MEMORY_SCOPE_AGENT); }
}
__device__ __forceinline__ void group_wait(gu32* gb, volatile LAS unsigned* st, const unsigned x, const unsigned r) {
    unsigned nloc, nx; group_members(gb, st, x, nloc, nx);
    unsigned sp = 0u;
    while (__hip_atomic_load(gb + GB_ATOP, __ATOMIC_RELAXED, __HIP_MEMORY_SCOPE_AGENT) < r * nx) { __builtin_amdgcn_s_sleep(1); if (++sp > (1u << 22)) break; }
    __builtin_amdgcn_fence(__ATOMIC_ACQUIRE, "agent");
}
__device__ __forceinline__ void group_barrier(gu32* gb, const int wave_s, volatile LAS unsigned* st, const unsigned x) {
    asm volatile("s_waitcnt vmcnt(0)" ::: "memory");
    __syncthreads();
    if (wave_s == 0 && lane_id() == 0) {
        unsigned nloc, nx; group_members(gb, st, x, nloc, nx);
        const unsigned r = st[0] + 1u; st[0] = r;
        const unsigned old = __hip_atomic_fetch_add(gb + GB_SUB(x), 1u, __ATOMIC_RELAXED, __HIP_MEMORY_SCOPE_AGENT);
        unsigned sp = 0u;
        if (old + 1u == r * nloc) {
            __builtin_amdgcn_fence(__ATOMIC_RELEASE, "agent");
            asm volatile("s_waitcnt vmcnt(0)" ::: "memory");
            (void)__hip_atomic_fetch_add(gb + GB_TOP, 1u, __ATOMIC_RELAXED, __HIP_MEMORY_SCOPE_AGENT);
            while (__hip_atomic_load(gb + GB_TOP, __ATOMIC_RELAXED, __HIP_MEMORY_SCOPE_AGENT) < r * nx) { __builtin_amdgcn_s_sleep(1); if (++sp > (1u << 22)) break; }
            __builtin_amdgcn_fence(__ATOMIC_ACQUIRE, "agent");
            (void)__hip_atomic_fetch_add(gb + GB_GEN(x), 1u, __ATOMIC_RELAXED, __HIP_MEMORY_SCOPE_AGENT);
        } else {
            while (__hip_atomic_load(gb + GB_GEN(x), __ATOMIC_RELAXED, __HIP_MEMORY_SCOPE_AGENT) < r) { __builtin_amdgcn_s_sleep(1); if (++sp > (1u << 22)) break; }
            __builtin_amdgcn_fence(__ATOMIC_ACQUIRE, "agent");
        }
    }
    __syncthreads();
}

struct Args {
    const float* x; const float* norm_mix_g; const float* w_in; const float* b_igate; const float* b_fgate; const float* conv_w; const float* conv_b;
    const float* g_mlstm; const float* g_sb; const float* w_out; const float* norm_ffn_g; const float* ffn_w_gate; const float* ffn_w_up; const float* ffn_w_down;
    const float* w_router; const float* moe_w_gate; const float* moe_w_up; const float* moe_w_down; const float* norm_final_g;
    float* out; unsigned char* ws; int ph_lo, ph_hi;
};
struct Frame {
    LAS unsigned char* lds; volatile LAS unsigned* MISC; gu32* ctl; int tid, lane, wave, G, bid;
};

__device__ __forceinline__ void tr_item(const float* src, int ldw, bf16* dst, int ldk, LAS float* scr, int lane, const float* gk) {
    const int c = lane & 7;
    f32x4 ga = {1.f, 1.f, 1.f, 1.f}, gb = ga;
    if (gk) { ga = *(const GAS f32x4*)(gk + 8 * c); gb = *(const GAS f32x4*)(gk + 8 * c + 4); }
    {
        const int r8 = lane >> 3, c4 = 4 * (lane & 7);
        f32x4 v[8];
#pragma unroll
        for (int i = 0; i < 8; ++i) v[i] = *(const GAS f32x4*)(src + (size_t)(8 * i + r8) * ldw + c4);
#pragma unroll
        for (int i = 0; i < 8; ++i) { LAS float* d = scr + (8 * i + r8) * 33 + c4; d[0] = v[i].x; d[1] = v[i].y; d[2] = v[i].z; d[3] = v[i].w; }
    }
    LDS_WAIT(); asm volatile("" ::: "memory");
#pragma unroll
    for (int j = 0; j < 4; ++j) { const int n = (lane >> 3) + 8 * j; const LAS float* s = scr + (8 * c) * 33 + n;
        v4u o; o.x = pk2(s[0 * 33] * ga.x, s[1 * 33] * ga.y); o.y = pk2(s[2 * 33] * ga.z, s[3 * 33] * ga.w); o.z = pk2(s[4 * 33] * gb.x, s[5 * 33] * gb.y); o.w = pk2(s[6 * 33] * gb.z, s[7 * 33] * gb.w);
        *(GAS v4u*)(dst + (size_t)n * ldk + 8 * c) = o; }
    LDS_WAIT(); asm volatile("" ::: "memory");
}
template <int ROWMAP>
__device__ __forceinline__ bool tr_matrix(int& r, const float* W, int K, int N, int ldw, int c0, bf16* dst, int ldk, int drow0, LAS float* scr, int lane, const float* g = nullptr) {
    const int nblk = N / 32, items = (K / 64) * nblk;
    if (r >= items) { r -= items; return false; }
    const int kb = r / nblk, nb = r % nblk, k0 = 64 * kb, n0 = 32 * nb;
    const int drow = ROWMAP == 0 ? drow0 + n0 : drow0 + (n0 >> 7) * 256 + (n0 & 127);
    tr_item(W + (size_t)k0 * ldw + c0 + n0, ldw, dst + (size_t)drow * ldk + k0, ldk, scr, lane, g ? g + k0 : nullptr);
    return true;
}
__device__ __forceinline__ void prologue_phase(const Args& a, Frame& F) {
    LAS float* scr = (LAS float*)(F.lds + RING_OFF + F.wave * 16384);
    unsigned char* ws = a.ws;
    const int gw = F.bid * NWAVES + F.wave, NGW = F.G * NWAVES;
    constexpr int I_IN = 16 * 112, I_OUT = 16 * 32, I_DG = 16 * 86, I_DD = 43 * 32, I_MG = 16 * 112, I_MD = 56 * 32;
    constexpr int PER_LAYER_A = I_IN + I_OUT;
    constexpr int PER_DENSE = 2 * I_DG + I_DD;
    constexpr int PER_EXP = 2 * I_MG + I_MD;
    constexpr int NITEMS = 4 * PER_LAYER_A + 2 * PER_DENSE + 16 * PER_EXP;
    for (int it = gw; it < NITEMS; it += NGW) {
        int r = it;
        if (r < 4 * PER_LAYER_A) {
            const int l = r / PER_LAYER_A; r -= l * PER_LAYER_A;
            const float* W = a.w_in + (size_t)l * DM * PIN; bf16* D = (bf16*)(ws + WS_WIN) + (size_t)l * NPROJ * DM;
            if (r < 16 * 64) { (void)tr_matrix<0>(r, W, DM, 2048, PIN, 0, D, DM, 0, scr, F.lane, a.norm_mix_g + l * DM); continue; } r -= 16 * 64;
            if (r < 16 * 48) { (void)tr_matrix<0>(r, W, DM, 1536, PIN, 2056, D, DM, 2048, scr, F.lane, a.norm_mix_g + l * DM); continue; } r -= 16 * 48;
            (void)tr_matrix<0>(r, a.w_out + (size_t)l * DM * DM, DM, DM, DM, 0, (bf16*)(ws + WS_WOUT) + (size_t)l * DM * DM, DM, 0, scr, F.lane); continue;
        }
        r -= 4 * PER_LAYER_A;
        if (r < 2 * PER_DENSE) {
            const int j = r / PER_DENSE; r -= j * PER_DENSE;
            bf16* GU = (bf16*)(ws + WS_WGU) + (size_t)j * 2 * FFDP * DM;
            if (tr_matrix<1>(r, a.ffn_w_gate + (size_t)j * DM * FFD, DM, FFD, FFD, 0, GU, DM, 0, scr, F.lane, a.norm_ffn_g + (2 * j) * DM)) continue;
            if (tr_matrix<1>(r, a.ffn_w_up + (size_t)j * DM * FFD, DM, FFD, FFD, 0, GU, DM, 128, scr, F.lane, a.norm_ffn_g + (2 * j) * DM)) continue;
            (void)tr_matrix<0>(r, a.ffn_w_down + (size_t)j * FFD * DM, FFD, DM, DM, 0, (bf16*)(ws + WS_WD) + (size_t)j * DM * FFDP, FFDP, 0, scr, F.lane); continue;
        }
        r -= 2 * PER_DENSE;
        {
            const int je = r / PER_EXP; r -= je * PER_EXP;
            bf16* GU = (bf16*)(ws + WS_MGU) + (size_t)je * 2 * FFE * DM;
            if (tr_matrix<1>(r, a.moe_w_gate + (size_t)je * DM * FFE, DM, FFE, FFE, 0, GU, DM, 0, scr, F.lane, a.norm_ffn_g + (2 * (je >> 3) + 1) * DM)) continue;
            if (tr_matrix<1>(r, a.moe_w_up + (size_t)je * DM * FFE, DM, FFE, FFE, 0, GU, DM, 128, scr, F.lane, a.norm_ffn_g + (2 * (je >> 3) + 1) * DM)) continue;
            (void)tr_matrix<0>(r, a.moe_w_down + (size_t)je * FFE * DM, FFE, DM, DM, 0, (bf16*)(ws + WS_MD) + (size_t)je * DM * FFE, FFE, 0, scr, F.lane);
        }
    }
    const int gt = F.bid * NTHREADS + F.tid, NGT = F.G * NTHREADS;
    for (int i = gt; i < 2 * 128 * (DM / 8); i += NGT) {
        const int j = i / (128 * 128), rr = (i / 128) % 128, ch = i % 128;
        const int row = 21 * 256 + (rr < 64 ? 64 + rr : 128 + rr);
        *(GAS v4u*)((bf16*)(ws + WS_WGU) + ((size_t)j * 2 * FFDP + row) * DM + ch * 8) = (v4u){0u, 0u, 0u, 0u};
    }
    for (int i = gt; i < 2 * DM * 8; i += NGT) {
        const int j = i / (DM * 8), row = (i / 8) % DM, ch = i % 8;
        *(GAS v4u*)((bf16*)(ws + WS_WD) + ((size_t)j * DM + row) * FFDP + FFD + ch * 8) = (v4u){0u, 0u, 0u, 0u};
    }
}

struct NormIn { const float* src; const bf16* o2; float* hout; const float* gain; bf16* y; const float* w8; int ld8; float* G; unsigned* cnt; uint2* rinfo; int* cntw; int* rrec; const bf16* src16; bf16* hout16; float* rs; };
template <bool B> struct RowSel { typedef f32x4 T; };
template <> struct RowSel<true> { typedef v2u T; };
template <int MODE, bool S16 = false>
__device__ __forceinline__ void norm_phase(Frame& F, const NormIn& p) {
    typedef typename RowSel<S16>::T RowT;
    LAS float* W8 = (LAS float*)(F.lds + RING_OFF);
    LAS int* lcnt = (LAS int*)(F.lds + RING_OFF + 32768);
    LAS int* lbase = lcnt + 8;
    LAS int* rec = lcnt + 16;
    f32x4 wr[(MODE == 0 || MODE == 2) ? 32 : 1];
    if (MODE == 0 || MODE == 2) {
        for (int i = F.tid; i < DM * 2; i += NTHREADS) *(LAS f32x4*)(W8 + 4 * i) = *(const GAS f32x4*)(p.w8 + (size_t)(i >> 1) * p.ld8 + 4 * (i & 1));
        __syncthreads();
#pragma unroll
        for (int j = 0; j < 4; ++j)
#pragma unroll
            for (int c = 0; c < 4; ++c) { const int k = 4 * (F.lane + 64 * j) + c; wr[(j * 4 + c) * 2] = *(const LAS f32x4*)(W8 + k * 8); wr[(j * 4 + c) * 2 + 1] = *(const LAS f32x4*)(W8 + k * 8 + 4); }
        __syncthreads();
    }
    for (int rb0 = F.bid; rb0 < T / 64; rb0 += F.G) {
        const int rb = (rb0 & 7) * 32 + (rb0 >> 3);
        RowT vn[4], vm[4]; v2u na[4], nb[4], ma[4], mb[4];
        const GAS RowT* const srcr = (S16 ? (const GAS RowT*)p.src16 : (const GAS RowT*)p.src) + F.lane;
        { const int row = rb * 64 + F.wave * 8; const GAS RowT* xr = srcr + (size_t)row * (DM / 4);
#pragma unroll
          for (int j = 0; j < 4; ++j) { vn[j] = xr[64 * j]; vm[j] = xr[64 * j + DM / 4]; }
          if (p.o2) { const GAS v2u* oa = (const GAS v2u*)(p.o2 + (size_t)row * DM) + F.lane; const GAS v2u* ob = (const GAS v2u*)(p.o2 + ((size_t)T + row) * DM) + F.lane;
#pragma unroll
              for (int j = 0; j < 4; ++j) { na[j] = oa[64 * j]; nb[j] = ob[64 * j]; ma[j] = oa[64 * j + DM / 4]; mb[j] = ob[64 * j + DM / 4]; } } }
#pragma unroll 1
        for (int i = 0; i < 8; ++i) {
            const int row = rb * 64 + F.wave * 8 + i;
            f32x4 v[4]; float s = 0.f;
#pragma unroll
            for (int j = 0; j < 4; ++j) { if constexpr (S16) { const v2u a = vn[j]; v[j] = (f32x4){bflo(a.x), bfhi(a.x), bflo(a.y), bfhi(a.y)}; } else v[j] = vn[j]; }
            if (p.o2) {
#pragma unroll
                for (int j = 0; j < 4; ++j) { const v2u a = na[j], b = nb[j];
                    v[j].x += bflo(a.x) + bflo(b.x); v[j].y += bfhi(a.x) + bfhi(b.x); v[j].z += bflo(a.y) + bflo(b.y); v[j].w += bfhi(a.y) + bfhi(b.y); }
            }
#pragma unroll
            for (int j = 0; j < 4; ++j) { vn[j] = vm[j]; na[j] = ma[j]; nb[j] = mb[j]; }
            if (i + 2 < 8) { const int rn = row + 2; const GAS RowT* xr = srcr + (size_t)rn * (DM / 4);
#pragma unroll
                for (int j = 0; j < 4; ++j) vm[j] = xr[64 * j];
                if (p.o2) { const GAS v2u* oa = (const GAS v2u*)(p.o2 + (size_t)rn * DM) + F.lane; const GAS v2u* ob = (const GAS v2u*)(p.o2 + ((size_t)T + rn) * DM) + F.lane;
#pragma unroll
                    for (int j = 0; j < 4; ++j) { ma[j] = oa[64 * j]; mb[j] = ob[64 * j]; } } }
            if (MODE != 3 && p.hout) { GAS f32x4* ho = (GAS f32x4*)(p.hout + (size_t)row * DM) + F.lane;
#pragma unroll
                for (int j = 0; j < 4; ++j) ho[64 * j] = v[j]; }
            if (MODE != 3 && p.hout16) { GAS v2u* ho = (GAS v2u*)(p.hout16 + (size_t)row * DM) + F.lane;
#pragma unroll
                for (int j = 0; j < 4; ++j) { const v2u w = (v2u){pk2(v[j].x, v[j].y), pk2(v[j].z, v[j].w)}; ho[64 * j] = w; v[j] = (f32x4){bflo(w.x), bfhi(w.x), bflo(w.y), bfhi(w.y)}; } }
#pragma unroll
            for (int j = 0; j < 4; ++j) s += (v[j].x * v[j].x + v[j].y * v[j].y) + (v[j].z * v[j].z + v[j].w * v[j].w);
            const float rstd = 1.0f / sqrtf(wave_sum(s) * (1.0f / DM) + EPS);
            const GAS f32x4* gr = (const GAS f32x4*)p.gain + F.lane;
#pragma unroll
            for (int j = 0; j < 4; ++j) { const f32x4 g = gr[64 * j]; v[j] = v[j] * rstd * g; }
            if (MODE == 3) { GAS f32x4* ho = (GAS f32x4*)(p.hout + (size_t)row * DM) + F.lane;
#pragma unroll
                for (int j = 0; j < 4; ++j) ho[64 * j] = v[j];
                continue; }
            if (F.lane == 0) ((GAS float*)p.rs)[row] = rstd;
            if (MODE == 0 || MODE == 2) {
                float d[8];
#pragma unroll
                for (int g = 0; g < 8; ++g) d[g] = 0.f;
#pragma unroll
                for (int j = 0; j < 4; ++j)
#pragma unroll
                    for (int c = 0; c < 4; ++c) { const f32x4 w0 = wr[(j * 4 + c) * 2], w1 = wr[(j * 4 + c) * 2 + 1];
                        const float yv = v[j][c];
                        d[0] += yv * w0.x; d[1] += yv * w0.y; d[2] += yv * w0.z; d[3] += yv * w0.w; d[4] += yv * w1.x; d[5] += yv * w1.y; d[6] += yv * w1.z; d[7] += yv * w1.w; }
#pragma unroll
                for (int g = 0; g < 8; ++g) d[g] = wave_sum(d[g]);
                if (MODE == 0) { if (F.lane == 0) { GAS f32x4* gp = (GAS f32x4*)(p.G + (size_t)row * 8); gp[0] = (f32x4){d[0], d[1], d[2], d[3]}; gp[1] = (f32x4){d[4], d[5], d[6], d[7]}; } }
                else {
                    int e0 = 0; float v0 = d[0];
#pragma unroll
                    for (int g = 1; g < 8; ++g) if (d[g] > v0) { v0 = d[g]; e0 = g; }
                    int e1 = -1; float v1 = -INFINITY;
#pragma unroll
                    for (int g = 0; g < 8; ++g) if (g != e0 && d[g] > v1) { v1 = d[g]; e1 = g; }
                    const float w0 = 1.0f / (1.0f + expf(v1 - v0)), w1 = 1.0f - w0;
                    if (F.lane == 0) { LAS int* rr = rec + (F.wave * 8 + i) * 6; rr[0] = e0; rr[1] = e1; rr[4] = __builtin_bit_cast(int, w0); rr[5] = __builtin_bit_cast(int, w1); }
                }
            }
        }
        if (MODE == 2) {
            __syncthreads();
            if (F.wave == 0) { const LAS int* rr = rec + F.lane * 6; const int e0 = rr[0], e1 = rr[1], row = rb * 64 + F.lane;
                const unsigned long long below = (1ull << F.lane) - 1ull;
                int lp0 = 0, lp1 = 0, mycnt = 0;
#pragma unroll
                for (int e = 0; e < 8; ++e) { const unsigned long long m0 = __ballot(e0 == e), m1 = __ballot(e1 == e);
                    const int lp = __popcll(m0 & below) + __popcll(m1 & below), ce = __popcll(m0) + __popcll(m1);
                    if (e0 == e) lp0 = lp; if (e1 == e) lp1 = lp; if (F.lane == e) mycnt = ce; }
                GAS int* ro = (GAS int*)p.rrec + (size_t)row * 6; ro[0] = e0; ro[1] = e1; ro[2] = lp0; ro[3] = lp1; ro[4] = rr[4]; ro[5] = rr[5];
                if (F.lane < 8) { ((GAS int*)p.cntw)[rb * 8 + F.lane] = mycnt; (void)__hip_atomic_fetch_add(p.cnt + F.lane, (unsigned)mycnt, __ATOMIC_RELAXED, __HIP_MEMORY_SCOPE_AGENT); } }
            __syncthreads();
        }
    }
}

__device__ __forceinline__ void route_finish(Frame& F, const int* cntw, const int* rrec, uint2* rinfo, const float* RS, float* RSI) {
    LAS float* lred = (LAS float*)(F.lds + RING_OFF);
    for (int rb0 = F.bid; rb0 < T / 64; rb0 += F.G) {
        const int rb = (rb0 & 7) * 32 + (rb0 >> 3);
        float c[8];
#pragma unroll
        for (int e = 0; e < 8; ++e) c[e] = 0.f;
        if (F.tid < rb) { const GAS i32x4* cp = (const GAS i32x4*)(cntw + F.tid * 8); const i32x4 a = cp[0], b = cp[1];
            c[0] = (float)a.x; c[1] = (float)a.y; c[2] = (float)a.z; c[3] = (float)a.w; c[4] = (float)b.x; c[5] = (float)b.y; c[6] = (float)b.z; c[7] = (float)b.w; }
#pragma unroll
        for (int e = 0; e < 8; ++e) c[e] = wave_sum(c[e]);
        if (F.lane == 0) {
#pragma unroll
            for (int e = 0; e < 8; ++e) lred[F.wave * 8 + e] = c[e]; }
        __syncthreads();
        if (F.tid < 64) { const int row = rb * 64 + F.tid; const GAS int* rr = (const GAS int*)rrec + (size_t)row * 6;
            const int e0 = rr[0], e1 = rr[1];
            float b0 = 0.f, b1 = 0.f;
#pragma unroll
            for (int w = 0; w < NWAVES; ++w) { b0 += lred[w * 8 + e0]; b1 += lred[w * 8 + e1]; }
            const int p0 = (int)b0 + rr[2], p1 = (int)b1 + rr[3];
            rinfo[(size_t)e0 * T + p0] = make_uint2((unsigned)row * 2u, (unsigned)rr[4]);
            rinfo[(size_t)e1 * T + p1] = make_uint2((unsigned)row * 2u + 1u, (unsigned)rr[5]);
            const float rsr = ((const GAS float*)RS)[row]; ((GAS float*)RSI)[(size_t)e0 * T + p0] = rsr; ((GAS float*)RSI)[(size_t)e1 * T + p1] = rsr; }
        __syncthreads();
    }
}

__device__ __forceinline__ float logsigmoid_f(float x) { return fminf(x, 0.f) - log1pf(expf(-fabsf(x))); }
__device__ __forceinline__ void gate_scan(Frame& F, int bh, const float* G, const float* b_i, const float* b_f, float* GA, float* GM, float* GE, float* TG) {
    LAS float* sc = (LAS float*)(F.lds + RING_OFF);
    const int b = bh >> 2, h = bh & 3, t0 = 4 * F.tid;
    const float bi = b_i[h], bf = b_f[h];
    float lf[4], ig[4];
#pragma unroll
    for (int j = 0; j < 4; ++j) { const float* g = G + ((size_t)b * SEQ + t0 + j) * 8; ig[j] = g[h] + bi; lf[j] = logsigmoid_f(g[4 + h] + bf); }
    float c[4]; c[0] = lf[0]; c[1] = c[0] + lf[1]; c[2] = c[1] + lf[2]; c[3] = c[2] + lf[3];
    float ws = c[3];
    DPP_SCAN(ws, OP_ADD, 0.0f);
    if (F.lane == 63) sc[F.wave] = ws;
    __syncthreads();
    float woff = 0.f;
    for (int w = 0; w < F.wave; ++w) woff += sc[w];
    const float excl = woff + ws - c[3];
    float Fc[4], av[4];
#pragma unroll
    for (int j = 0; j < 4; ++j) { Fc[j] = excl + c[j]; av[j] = ig[j] - Fc[j]; }
    float m[4]; m[0] = av[0]; m[1] = fmaxf(m[0], av[1]); m[2] = fmaxf(m[1], av[2]); m[3] = fmaxf(m[2], av[3]);
    float wm = m[3];
    DPP_SCAN(wm, OP_MAX, -INFINITY);
    if (F.lane == 63) sc[16 + F.wave] = wm;
    __syncthreads();
    float pm = -INFINITY;
    for (int w = 0; w < F.wave; ++w) pm = fmaxf(pm, sc[16 + w]);
    { float u = dpp_f(-INFINITY, wm, 0x111, 0xf);
      const float r15 = dpp_f(-INFINITY, wm, 0x142, 0xa), r31 = dpp_f(-INFINITY, wm, 0x143, 0xc);
      if ((F.lane & 15) == 0) u = (F.lane == 32) ? r31 : r15;
      pm = fmaxf(pm, u); }
    float tmx = m[3];
    tmx = fmaxf(tmx, dpp_f(-INFINITY, tmx, 0x111, 0xf)); tmx = fmaxf(tmx, dpp_f(-INFINITY, tmx, 0x112, 0xf)); tmx = fmaxf(tmx, dpp_f(-INFINITY, tmx, 0x114, 0xf)); tmx = fmaxf(tmx, dpp_f(-INFINITY, tmx, 0x118, 0xf));
    const int tbits = __builtin_bit_cast(int, tmx);
    const float t0m = __builtin_bit_cast(float, __builtin_amdgcn_readlane(tbits, 15)), t1m = __builtin_bit_cast(float, __builtin_amdgcn_readlane(tbits, 31)),
                t2m = __builtin_bit_cast(float, __builtin_amdgcn_readlane(tbits, 47)), t3m = __builtin_bit_cast(float, __builtin_amdgcn_readlane(tbits, 63));
    const int rw = F.lane >> 4; const float tm = rw == 0 ? t0m : (rw == 1 ? t1m : (rw == 2 ? t2m : t3m));
    if ((F.lane & 15) == 0) TG[bh * 32 + F.wave * 4 + rw] = tm * LOG2E;
#pragma unroll
    for (int j = 0; j < 4; ++j) { const float Mt = fmaxf(pm, m[j]); const size_t o = (size_t)bh * SEQ + t0 + j;
        GA[o] = expf(av[j] - tm); GM[o] = Mt * LOG2E; GE[o] = expf(-(Fc[j] + Mt)); }
    __syncthreads();
}

__device__ __forceinline__ void unpack8(const v4u r, float (&d)[8]) { d[0] = bflo(r.x); d[1] = bfhi(r.x); d[2] = bflo(r.y); d[3] = bfhi(r.y); d[4] = bflo(r.z); d[5] = bfhi(r.z); d[6] = bflo(r.w); d[7] = bfhi(r.w); }
__device__ __forceinline__ void conv_phase(Frame& F, const bf16* proj, const float* cw, const float* cb, bf16* qkc, const int hidx, const int nh) {
    const int cbat = F.bid & 7;
    for (int wi = F.wave * nh + hidx; wi < 144; wi += NWAVES * nh) {
        const int kpart = wi >= 128 ? 1 : 0;
        const int seg = cbat * 128 + (kpart ? 112 + (wi - 128) : wi);
        const int t0 = seg * 16, c0 = kpart * 512 + F.lane * 8;
        float w[4][8], bb[8];
#pragma unroll
        for (int tap = 0; tap < 4; ++tap) { const f32x4 a = *(const GAS f32x4*)(cw + tap * 1024 + c0), b = *(const GAS f32x4*)(cw + tap * 1024 + c0 + 4);
            w[tap][0] = a.x; w[tap][1] = a.y; w[tap][2] = a.z; w[tap][3] = a.w; w[tap][4] = b.x; w[tap][5] = b.y; w[tap][6] = b.z; w[tap][7] = b.w; }
        { const f32x4 a = *(const GAS f32x4*)(cb + c0), b = *(const GAS f32x4*)(cb + c0 + 4); bb[0] = a.x; bb[1] = a.y; bb[2] = a.z; bb[3] = a.w; bb[4] = b.x; bb[5] = b.y; bb[6] = b.z; bb[7] = b.w; }
        const float osc = kpart ? KM_SCALE : 1.0f;
        const bool first = (t0 % SEQ) == 0;
        v4u rw[19];
#pragma unroll
        for (int q = 0; q < 3; ++q) { rw[q] = (v4u){0u, 0u, 0u, 0u}; if (!first) rw[q] = *(const GAS v4u*)(proj + (size_t)(t0 - 3 + q) * NPROJ + c0); }
#pragma unroll
        for (int q = 0; q < 16; ++q) rw[3 + q] = *(const GAS v4u*)(proj + (size_t)(t0 + q) * NPROJ + c0);
        float x0[8], x1[8], x2[8];
        unpack8(rw[0], x0); unpack8(rw[1], x1); unpack8(rw[2], x2);
#pragma unroll
        for (int i = 0; i < 16; ++i) {
            float x3[8]; unpack8(rw[3 + i], x3);
            float o[8];
#pragma unroll
            for (int c = 0; c < 8; ++c) { const float yv = bb[c] + x0[c] * w[0][c] + x1[c] * w[1][c] + x2[c] * w[2][c] + x3[c] * w[3][c];
                o[c] = osc * yv * __builtin_amdgcn_rcpf(1.0f + __builtin_amdgcn_exp2f(-yv * LOG2E)); x0[c] = x1[c]; x1[c] = x2[c]; x2[c] = x3[c]; }
            *(GAS v4u*)(qkc + (size_t)(t0 + i) * DM + c0) = (v4u){pk2(o[0], o[1]), pk2(o[2], o[3]), pk2(o[4], o[5]), pk2(o[6], o[7])};
        }
    }
}

__device__ __forceinline__ void naive_sb(Frame& F, const bf16* proj, const float* g_sb, bf16* mixed) {
    LAS float* qs = (LAS float*)(F.lds + RING_OFF) + F.wave * 256;
    LAS float* ps = qs + 64;
    for (int it = F.bid * NWAVES + F.wave; it < T * HS; it += F.G * NWAVES) {
        const int h = it & 7, row = it >> 3, t = row % SEQ, rb = row - t;
        qs[F.lane] = bf2f(proj[(size_t)row * NPROJ + 2048 + h * 64 + F.lane]);
        LDS_WAIT();
        float R = 1.0f, o = 0.f;
        const int nch = (t + 63) / 64;
        for (int c = nch - 1; c >= 0; --c) {
            const int s = 64 * c + F.lane; const bool valid = s < t;
            const bf16* kr = proj + (size_t)(rb + s) * NPROJ + 2560 + h * 64;
            float z = 0.f;
#pragma unroll
            for (int d8 = 0; d8 < 8; ++d8) { const v4u kk = *(const GAS v4u*)(kr + d8 * 8); const f32x4 qa = *(const LAS f32x4*)(qs + d8 * 8), qb = *(const LAS f32x4*)(qs + d8 * 8 + 4);
                z += qa.x * bflo(kk.x) + qa.y * bfhi(kk.x) + qa.z * bflo(kk.y) + qa.w * bfhi(kk.y) + qb.x * bflo(kk.z) + qb.y * bfhi(kk.z) + qb.z * bflo(kk.w) + qb.w * bfhi(kk.w); }
            const float e = exp2f(-z); float beta = 1.0f / (1.0f + e); float omb = 1.0f - beta;
            if (!valid) { beta = 0.f; omb = 1.0f; }
            float pr = omb;
#pragma unroll
            for (int off = 1; off < 64; off <<= 1) { const float u = __shfl_down(pr, off); if (F.lane + off < 64) pr *= u; }
            float ex = __shfl_down(pr, 1); if (F.lane == 63) ex = 1.0f;
            const float a = beta * ex * R;
            R *= __shfl(pr, 0);
            ps[F.lane] = a; LDS_WAIT();
            const bf16* vr = proj + (size_t)(rb + 64 * c) * NPROJ + 3072 + h * 64 + F.lane;
#pragma unroll 8
            for (int j = 0; j < 64; ++j) o += ps[j] * bf2f(vr[(size_t)j * NPROJ]);
            LDS_WAIT();
        }
        const float ss = wave_sum(o * o) * (1.0f / 64.0f);
        const float val = o * (1.0f / sqrtf(ss + EPS)) * g_sb[h * 64 + F.lane];
        mixed[(size_t)row * DM + 512 + h * 64 + F.lane] = (bf16)f2bf(val);
    }
}
__device__ __forceinline__ void naive_mlstm(Frame& F, const bf16* proj, const bf16* qkc, const float* GA, const float* GM, const float* GE, const float* g_m, bf16* mixed) {
    LAS float* qs = (LAS float*)(F.lds + RING_OFF) + F.wave * 256;
    LAS float* ps = qs + 128;
    for (int it = F.bid * NWAVES + F.wave; it < T * HM; it += F.G * NWAVES) {
        const int h = it & 3, row = it >> 2, t = row % SEQ, rb = row - t, b = row / SEQ, bh = b * 4 + h;
        qs[F.lane] = bf2f(qkc[(size_t)row * DM + h * 128 + F.lane]); qs[64 + F.lane] = bf2f(qkc[(size_t)row * DM + h * 128 + 64 + F.lane]);
        LDS_WAIT();
        const float Mt = GM[(size_t)bh * SEQ + t];
        float den = 0.f, o0 = 0.f, o1 = 0.f;
        const int nch = t / 64 + 1;
        for (int c = 0; c < nch; ++c) {
            const int s = 64 * c + F.lane; const bool valid = s <= t;
            const bf16* kr = qkc + (size_t)(rb + s) * DM + 512 + h * 128;
            float z = 0.f;
#pragma unroll
            for (int d8 = 0; d8 < 16; ++d8) { const v4u kk = *(const GAS v4u*)(kr + d8 * 8); const f32x4 qa = *(const LAS f32x4*)(qs + d8 * 8), qb = *(const LAS f32x4*)(qs + d8 * 8 + 4);
                z += qa.x * bflo(kk.x) + qa.y * bfhi(kk.x) + qa.z * bflo(kk.y) + qa.w * bfhi(kk.y) + qb.x * bflo(kk.z) + qb.y * bfhi(kk.z) + qb.z * bflo(kk.w) + qb.w * bfhi(kk.w); }
            const float wgt = valid ? exp2f(GA[(size_t)bh * SEQ + s] - Mt) : 0.f;
            const float pv = z * wgt;
            den += pv;
            ps[F.lane] = pv; LDS_WAIT();
            const bf16* vr = proj + (size_t)(rb + 64 * c) * NPROJ + 1024 + h * 128 + F.lane;
#pragma unroll 8
            for (int j = 0; j < 64; ++j) { const float pj = ps[j]; o0 += pj * bf2f(vr[(size_t)j * NPROJ]); o1 += pj * bf2f(vr[(size_t)j * NPROJ + 64]); }
            LDS_WAIT();
        }
        den = wave_sum(den);
        const float dn = fmaxf(fabsf(den), GE[(size_t)bh * SEQ + t]);
        const float h0 = o0 / dn, h1 = o1 / dn;
        const float ss = wave_sum(h0 * h0 + h1 * h1) * (1.0f / 128.0f);
        const float rs = 1.0f / sqrtf(ss + EPS);
        const float om0 = bf2f(proj[(size_t)row * NPROJ + 1536 + h * 128 + F.lane]), om1 = bf2f(proj[(size_t)row * NPROJ + 1536 + h * 128 + 64 + F.lane]);
        const float r0 = h0 * rs * g_m[h * 128 + F.lane] / (1.0f + expf(-om0)), r1 = h1 * rs * g_m[h * 128 + 64 + F.lane] / (1.0f + expf(-om1));
        mixed[(size_t)row * DM + h * 128 + F.lane] = (bf16)f2bf(r0); mixed[(size_t)row * DM + h * 128 + 64 + F.lane] = (bf16)f2bf(r1);
    }
}

namespace mix {
typedef float f32x16 __attribute__((ext_vector_type(16)));
typedef short s16x4 __attribute__((ext_vector_type(4)));
typedef short v4i16_t __attribute__((ext_vector_type(4)));
typedef unsigned u32x4 __attribute__((ext_vector_type(4)));
typedef LAS const unsigned char* lptr;
#define MX_MFMA(a, b, c) __builtin_amdgcn_mfma_f32_32x32x16_bf16(a, b, c, 0, 0, 0)
__device__ __forceinline__ int crow(int r, int hi) { return (r & 3) + 8 * (r >> 2) + 4 * hi; }
__device__ __forceinline__ unsigned cvtpk(float lo, float hi) { unsigned r; asm("v_cvt_pk_bf16_f32 %0, %1, %2" : "=v"(r) : "v"(lo), "v"(hi)); return r; }
__device__ __forceinline__ s16x4 vtr(lptr p) { return __builtin_bit_cast(s16x4, __builtin_amdgcn_ds_read_tr16_b64_v4i16((LAS v4i16_t*)p)); }
__device__ __forceinline__ float partner(float x, int hi) { auto rr = __builtin_amdgcn_permlane32_swap(__builtin_bit_cast(unsigned, x), __builtin_bit_cast(unsigned, x), false, false);
    return __builtin_bit_cast(float, hi ? rr[0] : rr[1]); }

constexpr int STG_BYTES = 65536, GRP_BYTES = 32768, VIMG_OFF = 16384;
constexpr int EX_OFF = RING_BYTES + 1024;
constexpr int EX_GA = EX_OFF, EX_FA = EX_OFF + 1024, EX_FB = EX_OFF + 1536;

__device__ __forceinline__ void glds16(const void* g, unsigned lds_base) {
    unsigned sv; asm volatile("s_mov_b32 %0, m0\n\ts_mov_b32 m0, %2\n\ts_nop 0\n\tglobal_load_lds_dwordx4 %1, off\n\ts_mov_b32 m0, %0" : "=&s"(sv) : "v"(g), "s"(lds_base) : "memory"); }
__device__ __forceinline__ void glds4(const void* g, unsigned lds_base) {
    unsigned sv; asm volatile("s_mov_b32 %0, m0\n\ts_mov_b32 m0, %2\n\ts_nop 0\n\tglobal_load_lds_dword %1, off\n\ts_mov_b32 m0, %0" : "=&s"(sv) : "v"(g), "s"(lds_base) : "memory"); }
template <int D, bool ML>
__device__ __forceinline__ void issue_tile(unsigned gbase, unsigned gaimg, const bf16* Kp, int pk, const bf16* Vp, int pv, const float* ga, int s0, int w4, int lane) {
#pragma unroll
    for (int c = 0; c < D / 32; ++c) { const int ch = w4 + 4 * c;
        glds16(Kp + (size_t)(s0 + lane) * pk + 8 * ch, (unsigned)__builtin_amdgcn_readfirstlane(gbase + ch * 1024)); }
#pragma unroll
    for (int c = 0; c < D / 32; ++c) { const int idx = w4 + 4 * c, dp = idx >> 2, rg = idx & 3;
        glds16(Vp + (size_t)(s0 + 16 * rg + (lane >> 2)) * pv + 32 * dp + 8 * (lane & 3), (unsigned)__builtin_amdgcn_readfirstlane(gbase + VIMG_OFF + dp * 4096 + rg * 1024)); }
    if (ML) { if (w4 == 0) glds4(ga + s0 + lane, (unsigned)__builtin_amdgcn_readfirstlane(gaimg)); }
}

template <int D, bool SBK, bool MASK>
__device__ __forceinline__ void compute_tile(lptr kimg, lptr vimg, LAS const float* gat, const bf16x8 (&qr)[D / 16], f32x16 (&o)[D / 32], float& st, const float Mt, const int qrow, const int key0, const int lane) {
    const int r32 = lane & 31, hi = lane >> 5;
    f32x16 p0 = {}, p1 = {};
    const lptr kp = kimg + hi * 1024 + r32 * 16;
    {
        bf16x8 kf[D / 8];
#pragma unroll
        for (int d0 = 0; d0 < D / 16; ++d0) { kf[2 * d0] = *(LAS const bf16x8*)(kp + d0 * 2048); kf[2 * d0 + 1] = *(LAS const bf16x8*)(kp + d0 * 2048 + 512); }
        __builtin_amdgcn_sched_barrier(0);
#pragma unroll
        for (int d0 = 0; d0 < D / 16; ++d0) { p0 = MX_MFMA(kf[2 * d0], qr[d0], p0); p1 = MX_MFMA(kf[2 * d0 + 1], qr[d0], p1); }
    }
    const lptr vp = vimg + ((lane >> 4) & 1) * 32 + (lane & 3) * 8 + (4 * hi + ((lane & 15) >> 2)) * 64;
    s16x4 vlo[D / 8], vhi[D / 8];
#pragma unroll
    for (int dp = 0; dp < D / 32; ++dp)
#pragma unroll
        for (int ks = 0; ks < 4; ++ks) { vlo[dp * 4 + ks] = vtr(vp + dp * 4096 + ks * 1024); vhi[dp * 4 + ks] = vtr(vp + dp * 4096 + ks * 1024 + 512); }
    __builtin_amdgcn_sched_barrier(0);
    u32x4 pw[4];
    if constexpr (SBK) {
        float R = st;
#pragma unroll
        for (int blk = 1; blk >= 0; --blk) {
            const f32x16& X = blk ? p1 : p0; const int kb = key0 + 32 * blk;
            float bt[16], sx[16], Pg[4], Qg[4];
#pragma unroll
            for (int g = 0; g < 4; ++g) { float run = 1.f;
#pragma unroll
                for (int i = 3; i >= 0; --i) { const int r = 4 * g + i; float z = X[r]; if (MASK) z = (kb + crow(r, hi) < qrow) ? z : -INFINITY;
                    const float e = __builtin_amdgcn_exp2f(-z); const float b = __builtin_amdgcn_rcpf(1.0f + e); bt[r] = b; sx[r] = run; run *= (1.0f - b); }
                Pg[g] = run; }
#pragma unroll
            for (int g = 0; g < 4; ++g) Qg[g] = partner(Pg[g], hi);
            float a[16];
#pragma unroll
            for (int g = 3; g >= 0; --g) { const float pre = R * (hi ? 1.0f : Qg[g]);
#pragma unroll
                for (int i = 0; i < 4; ++i) a[4 * g + i] = bt[4 * g + i] * sx[4 * g + i] * pre;
                R *= Pg[g] * Qg[g]; }
            pw[2 * blk] = (u32x4){cvtpk(a[0], a[1]), cvtpk(a[2], a[3]), cvtpk(a[4], a[5]), cvtpk(a[6], a[7])};
            pw[2 * blk + 1] = (u32x4){cvtpk(a[8], a[9]), cvtpk(a[10], a[11]), cvtpk(a[12], a[13]), cvtpk(a[14], a[15])};
        }
        st = R;
    } else {
        float den = st;
#pragma unroll
        for (int blk = 0; blk < 2; ++blk) {
            const f32x16& X = blk ? p1 : p0; const int kb = key0 + 32 * blk;
            float a[16];
#pragma unroll
            for (int g = 0; g < 4; ++g) { const f32x4 gv = *(LAS const f32x4*)(gat + 32 * blk + 8 * g + 4 * hi);
#pragma unroll
                for (int i = 0; i < 4; ++i) { const int r = 4 * g + i; float p = X[r] * __builtin_amdgcn_exp2f(gv[i] - Mt); if (MASK) p = (kb + crow(r, hi) <= qrow) ? p : 0.f; den += p; a[r] = p; } }
            pw[2 * blk] = (u32x4){cvtpk(a[0], a[1]), cvtpk(a[2], a[3]), cvtpk(a[4], a[5]), cvtpk(a[6], a[7])};
            pw[2 * blk + 1] = (u32x4){cvtpk(a[8], a[9]), cvtpk(a[10], a[11]), cvtpk(a[12], a[13]), cvtpk(a[14], a[15])};
        }
        st = den;
    }
    __builtin_amdgcn_sched_barrier(0);
#pragma unroll
    for (int dp = 0; dp < D / 32; ++dp)
#pragma unroll
        for (int ks = 0; ks < 4; ++ks) { const s16x4 a = vlo[dp * 4 + ks], b = vhi[dp * 4 + ks];
            const bf16x8 vf = (bf16x8){a[0], a[1], a[2], a[3], b[0], b[1], b[2], b[3]};
            o[dp] = MX_MFMA(__builtin_bit_cast(bf16x8, pw[ks]), vf, o[dp]); }
}

template <int D, bool SBK>
__device__ __forceinline__ void attn_unit(LAS unsigned char* lds, const int tid_in, const bf16* Qp, int pq, const bf16* Kp, int pk, const bf16* Vp, int pv,
                                          const float* ga, const float* gm, const float* ge, const int qb, bf16* out, const float* gain, const bf16* om) {
    int tid = tid_in; asm volatile("" : "+v"(tid));
    const int lane = tid & 63, wid = __builtin_amdgcn_readfirstlane(tid >> 6), grp = wid >> 2, w4 = wid & 3, r32 = lane & 31, hi = lane >> 5;
    const int t0 = 128 * qb, ns = qb + 1, nt = 2 * ns;
    const int qrow = t0 + 32 * w4 + r32;
    bf16x8 qr[D / 16];
#pragma unroll
    for (int d0 = 0; d0 < D / 16; ++d0) qr[d0] = *(const GAS bf16x8*)(Qp + (size_t)qrow * pq + d0 * 16 + hi * 8);
    float Mt = 0.f; if (!SBK) Mt = gm[qrow];
    f32x16 o[D / 32];
#pragma unroll
    for (int i = 0; i < D / 32; ++i) o[i] = f32x16{};
    float st = SBK ? 1.0f : 0.0f;
    LAS unsigned char* const gb0 = lds + grp * GRP_BYTES; LAS unsigned char* const ga0 = lds + EX_GA + grp * 256;
    const unsigned gb0u = (unsigned)(size_t)gb0, ga0u = (unsigned)(size_t)ga0;
    const int tfirst = grp ? ns - 1 : nt - 1;
    issue_tile<D, !SBK>(gb0u, ga0u, Kp, pk, Vp, pv, ga, 64 * tfirst, w4, lane);
#pragma unroll
    for (int d0 = 0; d0 < D / 16; ++d0) asm volatile("" : "+v"(qr[d0]));
    asm volatile("" : "+v"(Mt));
    for (int i = 0; i < ns; ++i) {
        const int tl = tfirst - i, sb = (i & 1);
        asm volatile("s_waitcnt vmcnt(0)" ::: "memory");
        __builtin_amdgcn_s_barrier();
        asm volatile("" ::: "memory");
        if (i + 1 < ns) issue_tile<D, !SBK>(gb0u + (sb ^ 1) * STG_BYTES, ga0u + (sb ^ 1) * 512, Kp, pk, Vp, pv, ga, 64 * (tl - 1), w4, lane);
        const lptr kimg = (lptr)(gb0 + sb * STG_BYTES); LAS const float* gat = (LAS const float*)(ga0 + sb * 512);
        if (tl >= nt - 2) compute_tile<D, SBK, true>(kimg, kimg + VIMG_OFF, gat, qr, o, st, Mt, qrow, 64 * tl, lane);
        else compute_tile<D, SBK, false>(kimg, kimg + VIMG_OFF, gat, qr, o, st, Mt, qrow, 64 * tl, lane);
    }
    constexpr int PITCH = D + 4;
    LAS float* stg = (LAS float*)lds; LAS float* fA = (LAS float*)(lds + EX_FA); LAS float* fB = (LAS float*)(lds + EX_FB);
    if (!SBK) st += partner(st, hi);
    LDS_WAIT(); __builtin_amdgcn_s_barrier(); asm volatile("" ::: "memory");
    if (grp == 1) {
#pragma unroll
        for (int dp = 0; dp < D / 32; ++dp)
#pragma unroll
            for (int r = 0; r < 16; ++r) stg[(32 * w4 + crow(r, hi)) * PITCH + 32 * dp + r32] = o[dp][r];
        if (hi == 0) fB[32 * w4 + r32] = st;
    } else { if (hi == 0) fA[32 * w4 + r32] = st; }
    LDS_WAIT(); __builtin_amdgcn_s_barrier(); asm volatile("" ::: "memory");
    if (grp == 0) {
#pragma unroll
        for (int r = 0; r < 16; ++r) { const int row = 32 * w4 + crow(r, hi); const float f = SBK ? fA[row] : 1.0f;
#pragma unroll
            for (int dp = 0; dp < D / 32; ++dp) { LAS float* p = stg + row * PITCH + 32 * dp + r32; *p = o[dp][r] + f * (*p); } }
    }
    LDS_WAIT(); __builtin_amdgcn_s_barrier(); asm volatile("" ::: "memory");
    {
        constexpr int NC = D / 4;
        const int row = tid >> 2, qd = tid & 3, trow = t0 + row;
        float v[NC];
#pragma unroll
        for (int c = 0; c < NC / 4; ++c) { const f32x4 x = *(LAS const f32x4*)(stg + row * PITCH + qd * NC + 4 * c); v[4 * c] = x.x; v[4 * c + 1] = x.y; v[4 * c + 2] = x.z; v[4 * c + 3] = x.w; }
        if (!SBK) { const float den = fA[row] + fB[row]; const float inv = 1.0f / fmaxf(fabsf(den), ge[trow]);
#pragma unroll
            for (int c = 0; c < NC; ++c) v[c] *= inv; }
        float ss = 0.f;
#pragma unroll
        for (int c = 0; c < NC; ++c) ss += v[c] * v[c];
        ss += __shfl_xor(ss, 1); ss += __shfl_xor(ss, 2);
        const float rs = 1.0f / sqrtf(ss * (1.0f / D) + EPS);
        bf16* op = out + (size_t)trow * DM + qd * NC;
#pragma unroll
        for (int c8 = 0; c8 < NC / 8; ++c8) {
            float w[8];
#pragma unroll
            for (int c = 0; c < 8; ++c) w[c] = v[8 * c8 + c] * rs * gain[qd * NC + 8 * c8 + c];
            if (!SBK) { const v4u g = *(const GAS v4u*)(om + (size_t)trow * NPROJ + qd * NC + 8 * c8); float gg[8];
                gg[0] = bflo(g.x); gg[1] = bfhi(g.x); gg[2] = bflo(g.y); gg[3] = bfhi(g.y); gg[4] = bflo(g.z); gg[5] = bfhi(g.z); gg[6] = bflo(g.w); gg[7] = bfhi(g.w);
#pragma unroll
                for (int c = 0; c < 8; ++c) w[c] *= 1.0f / (1.0f + __expf(-gg[c])); }
            *(GAS v4u*)(op + 8 * c8) = (v4u){pk2(w[0], w[1]), pk2(w[2], w[3]), pk2(w[4], w[5]), pk2(w[6], w[7])};
        }
    }
    LDS_WAIT(); __builtin_amdgcn_s_barrier(); asm volatile("" ::: "memory");
}
#undef MX_MFMA
}

typedef unsigned cs_u32x2 __attribute__((ext_vector_type(2)));
constexpr int CS_PART = 4160, CS_IMG = 4 * CS_PART, CS_NV = 8 * CS_IMG;
static_assert(CS_NV + 16384 <= MISC_OFF, "chunk-state LDS map");
__device__ __forceinline__ void chunk_state_unit(Frame& F, const int bh, const int j, const bf16* proj, const float* cw, const float* cb, const float* GAw, const float* TG,
                                                 bf16* U, float* NV, float* CM, bf16* qkc) {
    using mix::f32x16; using mix::s16x4; using mix::vtr; using mix::lptr; using mix::cvtpk;
    const int b = bh >> 2, h = bh & 3, tid = F.tid, lane = F.lane, wid = F.wave;
    const size_t r0 = (size_t)b * SEQ;
    const int cg = tid & 15, kg = tid >> 4, c0 = 8 * cg, tl = kg >> 3;
    const int s0 = 256 * j + 8 * kg;
    LAS unsigned char* const img = F.lds + RING_OFF;
    const bf16* kp = proj + (r0 + s0) * NPROJ + 512 + h * 128 + c0;
    const bf16* vp = proj + (r0 + s0) * NPROJ + 1024 + h * 128 + c0;
    v4u kr[11], vr[8];
#pragma unroll
    for (int q = 0; q < 3; ++q) { kr[q] = (v4u){0u, 0u, 0u, 0u}; if (s0 > 0) kr[q] = *(const GAS v4u*)(kp + (ptrdiff_t)(q - 3) * NPROJ); }
#pragma unroll
    for (int q = 0; q < 8; ++q) { kr[3 + q] = *(const GAS v4u*)(kp + (size_t)q * NPROJ); vr[q] = *(const GAS v4u*)(vp + (size_t)q * NPROJ); }
    const f32x4 ga0 = *(const GAS f32x4*)(GAw + (size_t)bh * SEQ + s0), ga1 = *(const GAS f32x4*)(GAw + (size_t)bh * SEQ + s0 + 4);
    const float t0g = TG[bh * 32 + 4 * j], t1g = TG[bh * 32 + 4 * j + 1], t2g = TG[bh * 32 + 4 * j + 2], t3g = TG[bh * 32 + 4 * j + 3];
    const float cm = fmaxf(fmaxf(t0g, t1g), fmaxf(t2g, t3g));
    const float tf = __builtin_amdgcn_exp2f((tl == 0 ? t0g : (tl == 1 ? t1g : (tl == 2 ? t2g : t3g))) - cm);
    float w[4][8], bb[8];
#pragma unroll
    for (int tap = 0; tap < 4; ++tap) { const f32x4 x = *(const GAS f32x4*)(cw + tap * 1024 + 512 + h * 128 + c0), y = *(const GAS f32x4*)(cw + tap * 1024 + 512 + h * 128 + c0 + 4);
        w[tap][0] = x.x; w[tap][1] = x.y; w[tap][2] = x.z; w[tap][3] = x.w; w[tap][4] = y.x; w[tap][5] = y.y; w[tap][6] = y.z; w[tap][7] = y.w; }
    { const f32x4 x = *(const GAS f32x4*)(cb + 512 + h * 128 + c0), y = *(const GAS f32x4*)(cb + 512 + h * 128 + c0 + 4); bb[0] = x.x; bb[1] = x.y; bb[2] = x.z; bb[3] = x.w; bb[4] = y.x; bb[5] = y.y; bb[6] = y.z; bb[7] = y.w; }
    {
        float nvp[8];
#pragma unroll
        for (int c = 0; c < 8; ++c) nvp[c] = 0.f;
        float x0[8], x1[8], x2[8];
        unpack8(kr[0], x0); unpack8(kr[1], x1); unpack8(kr[2], x2);
        LAS unsigned char* const wp = img + tl * (2 * CS_IMG) + (cg >> 2) * CS_PART + (8 * (kg & 7)) * 64 + (cg & 3) * 16;
#pragma unroll
        for (int i = 0; i < 8; ++i) {
            float x3[8], o[8], xv[8]; unpack8(kr[3 + i], x3); unpack8(vr[i], xv);
            const float ws_ = (i < 4 ? ga0[i & 3] : ga1[i & 3]) * tf;
#pragma unroll
            for (int c = 0; c < 8; ++c) { const float yv = bb[c] + x0[c] * w[0][c] + x1[c] * w[1][c] + x2[c] * w[2][c] + x3[c] * w[3][c];
                o[c] = KM_SCALE * yv * __builtin_amdgcn_rcpf(1.0f + __builtin_amdgcn_exp2f(-yv * LOG2E)); nvp[c] += ws_ * o[c]; x0[c] = x1[c]; x1[c] = x2[c]; x2[c] = x3[c]; }
            const v4u kcv = (v4u){pk2(o[0], o[1]), pk2(o[2], o[3]), pk2(o[4], o[5]), pk2(o[6], o[7])};
            *(LAS v4u*)(wp + i * 64) = kcv;
            *(GAS v4u*)(qkc + (r0 + s0 + i) * DM + 512 + h * 128 + c0) = kcv;
            *(LAS v4u*)(wp + CS_IMG + i * 64) = (v4u){pk2(xv[0] * ws_, xv[1] * ws_), pk2(xv[2] * ws_, xv[3] * ws_), pk2(xv[4] * ws_, xv[5] * ws_), pk2(xv[6] * ws_, xv[7] * ws_)};
        }
        LAS float* np = (LAS float*)(img + CS_NV) + kg * 128 + c0;
        *(LAS f32x4*)np = (f32x4){nvp[0], nvp[1], nvp[2], nvp[3]}; *(LAS f32x4*)(np + 4) = (f32x4){nvp[4], nvp[5], nvp[6], nvp[7]};
    }
    LDS_WAIT(); __syncthreads();
    if (tid < 128) { const LAS float* np = (const LAS float*)(img + CS_NV) + tid; float nv = 0.f;
#pragma unroll
        for (int g = 0; g < 32; ++g) nv += np[g * 128];
        NV[((size_t)bh * 7 + j) * 128 + tid] = nv; }
    if (tid == 0) { CM[bh * 8 + j] = cm; if (j == 6) CM[bh * 8 + 7] = cm; }
    {
        const int hi = lane >> 5, r32 = lane & 31;
        const lptr fb = (lptr)img + ((lane >> 4) & 1) * 32 + (lane & 3) * 8 + (4 * hi + ((lane & 15) >> 2)) * 64;
        unsigned short* Uj = (unsigned short*)U + ((size_t)bh * 7 + j) * 16384;
#pragma unroll
        for (int q = 0; q < 2; ++q) { const int idx = 2 * wid + q, dpd = idx >> 2, dpe = idx & 3;
            f32x16 acc = {};
#pragma unroll
            for (int t = 0; t < 4; ++t)
#pragma unroll
                for (int ks = 0; ks < 4; ++ks) { const lptr tb = fb + t * (2 * CS_IMG) + ks * 1024;
                    const s16x4 a0 = vtr(tb + CS_IMG + dpe * CS_PART), a1 = vtr(tb + CS_IMG + dpe * CS_PART + 512), b0 = vtr(tb + dpd * CS_PART), b1 = vtr(tb + dpd * CS_PART + 512);
                    acc = __builtin_amdgcn_mfma_f32_32x32x16_bf16(((bf16x8){a0[0], a0[1], a0[2], a0[3], a1[0], a1[1], a1[2], a1[3]}), ((bf16x8){b0[0], b0[1], b0[2], b0[3], b1[0], b1[1], b1[2], b1[3]}), acc, 0, 0, 0); }
#pragma unroll
            for (int g = 0; g < 4; ++g) *(GAS cs_u32x2*)(Uj + (size_t)(32 * dpd + r32) * 128 + 32 * dpe + 8 * g + 4 * hi) = (cs_u32x2){pk2(acc[4 * g], acc[4 * g + 1]), pk2(acc[4 * g + 2], acc[4 * g + 3])};
        }
    }
    LDS_WAIT(); __syncthreads();
}

typedef const __attribute__((address_space(4))) Args* KArgs;
#define KA(field) ({ KArgs _p = kap; asm volatile("" : "+s"(_p)); _p->field; })
#define WSP(off) ((unsigned char*)KA(ws) + (off))
namespace mix2 {
using mix::f32x16; using mix::s16x4; using mix::u32x4; using mix::lptr; using mix::crow; using mix::cvtpk; using mix::vtr; using mix::partner; using mix::glds16; using mix::glds4;
#define MX_MFMA(a, b, c) __builtin_amdgcn_mfma_f32_32x32x16_bf16(a, b, c, 0, 0, 0)
constexpr int NKB = 3, NVB = 4;
constexpr int KBUF0 = 0, VBUF0 = NKB * 16384, BUFSZ = 16384, STAGE0 = (NKB + NVB) * 16384, STAGE_W = 4608;
constexpr int EX_GA = STAGE0 + 8 * STAGE_W;
constexpr int EX_DEAD = EX_GA + NVB * 256;
static_assert(EX_DEAD + 64 <= MISC_OFF, "mixer LDS map");
struct UnitP { int b, h, qb, layer; };
template <bool SBK> struct LoopPtrs { const bf16* Kp; const bf16* Vp; const float* ga; int pk, pv; };
template <bool SBK> __device__ __forceinline__ LoopPtrs<SBK> loop_ptrs(KArgs kap, const UnitP& u) {
    LoopPtrs<SBK> p; const size_t r0 = (size_t)u.b * SEQ; const bf16* proj = (const bf16*)WSP(WS_PROJ);
    if (SBK) { p.Kp = proj + r0 * NPROJ + 2560 + u.h * 64; p.Vp = proj + r0 * NPROJ + 3072 + u.h * 64; p.ga = nullptr; p.pk = NPROJ; p.pv = NPROJ; }
    else { const bf16* qkc = (const bf16*)WSP(WS_QKC); p.Kp = qkc + r0 * DM + 512 + u.h * 128; p.Vp = proj + r0 * NPROJ + 1024 + u.h * 128; p.ga = (const float*)WSP(WS_GA) + (size_t)(u.b * 4 + u.h) * SEQ; p.pk = DM; p.pv = NPROJ; }
    return p;
}

template <int D, bool ML, class LP>
__device__ __forceinline__ void issue_tile(unsigned kbuf, unsigned vbuf, unsigned gabuf, const LP& u, int s0, int wid, int lane) {
#pragma unroll
    for (int c = 0; c < D / 64; ++c) { const int ch = wid + 8 * c;
        glds16(u.Kp + (size_t)(s0 + lane) * u.pk + 8 * ch, (unsigned)__builtin_amdgcn_readfirstlane(kbuf + ch * 1024)); }
#pragma unroll
    for (int c = 0; c < D / 64; ++c) { const int idx = wid + 8 * c, dp = idx >> 2, rg = idx & 3;
        glds16(u.Vp + (size_t)(s0 + 16 * rg + (lane >> 2)) * u.pv + 32 * dp + 8 * (lane & 3), (unsigned)__builtin_amdgcn_readfirstlane(vbuf + dp * 4096 + rg * 1024)); }
    if (ML) glds4(u.ga + s0 + lane, (unsigned)__builtin_amdgcn_readfirstlane(gabuf));
}
template <int D>
__device__ __forceinline__ void qk(lptr kimg, const bf16x8 (&qr)[D / 16], f32x16& p0, f32x16& p1, const int lane) {
    const lptr kp = kimg + (lane >> 5) * 1024 + (lane & 31) * 16;
    p0 = f32x16{}; p1 = f32x16{};
#pragma unroll
    for (int hb = 0; hb < D / 64; ++hb) {
        bf16x8 kf[8];
#pragma unroll
        for (int d = 0; d < 4; ++d) { const int d0 = 4 * hb + d; kf[2 * d] = *(LAS const bf16x8*)(kp + d0 * 2048); kf[2 * d + 1] = *(LAS const bf16x8*)(kp + d0 * 2048 + 512); }
        __builtin_amdgcn_sched_barrier(0);
#pragma unroll
        for (int d = 0; d < 4; ++d) { const int d0 = 4 * hb + d; p0 = MX_MFMA(kf[2 * d], qr[d0], p0); p1 = MX_MFMA(kf[2 * d + 1], qr[d0], p1); }
        __builtin_amdgcn_sched_barrier(0);
    }
}
template <int D, bool SBK, bool MASK>
__device__ __forceinline__ void vp(lptr vimg, LAS const float* gat, const f32x16& p0, const f32x16& p1, f32x16 (&o)[D / 32], float& st, const float Mt, const int qrow, const int key0, const int lane) {
    const int hi = lane >> 5;
    const lptr vb = vimg + ((lane >> 4) & 1) * 32 + (lane & 3) * 8 + (4 * hi + ((lane & 15) >> 2)) * 64;
    constexpr int VPRE = (D == 128) ? 2 : D / 32;
    s16x4 vlo[VPRE * 4], vhi[VPRE * 4];
#pragma unroll
    for (int dp = 0; dp < VPRE; ++dp)
#pragma unroll
        for (int ks = 0; ks < 4; ++ks) { vlo[dp * 4 + ks] = vtr(vb + dp * 4096 + ks * 1024); vhi[dp * 4 + ks] = vtr(vb + dp * 4096 + ks * 1024 + 512); }
    __builtin_amdgcn_sched_barrier(0);
    u32x4 pw[4];
    if constexpr (SBK) {
        float R = st;
#pragma unroll
        for (int blk = 1; blk >= 0; --blk) {
            const f32x16& X = blk ? p1 : p0; const int kb = key0 + 32 * blk;
            float bt[16], sx[16], Pg[4], Qg[4];
#pragma unroll
            for (int g = 0; g < 4; ++g) { float run = 1.f;
#pragma unroll
                for (int i = 3; i >= 0; --i) { const int r = 4 * g + i; float z = X[r]; if (MASK) z = (kb + crow(r, hi) < qrow) ? z : -INFINITY;
                    const float e = __builtin_amdgcn_exp2f(-z); const float b = __builtin_amdgcn_rcpf(1.0f + e); bt[r] = b; sx[r] = run; run *= (1.0f - b); }
                Pg[g] = run; }
#pragma unroll
            for (int g = 0; g < 4; ++g) Qg[g] = partner(Pg[g], hi);
            float a[16];
#pragma unroll
            for (int g = 3; g >= 0; --g) { const float pre = R * (hi ? 1.0f : Qg[g]);
#pragma unroll
                for (int i = 0; i < 4; ++i) a[4 * g + i] = bt[4 * g + i] * sx[4 * g + i] * pre;
                R *= Pg[g] * Qg[g]; }
            pw[2 * blk] = (u32x4){cvtpk(a[0], a[1]), cvtpk(a[2], a[3]), cvtpk(a[4], a[5]), cvtpk(a[6], a[7])};
            pw[2 * blk + 1] = (u32x4){cvtpk(a[8], a[9]), cvtpk(a[10], a[11]), cvtpk(a[12], a[13]), cvtpk(a[14], a[15])};
        }
        st = R;
    } else {
        float den = st;
#pragma unroll
        for (int blk = 0; blk < 2; ++blk) {
            const f32x16& X = blk ? p1 : p0; const int kb = key0 + 32 * blk;
            float a[16];
#pragma unroll
            for (int g = 0; g < 4; ++g) { const f32x4 gv = *(LAS const f32x4*)(gat + 32 * blk + 8 * g + 4 * hi);
#pragma unroll
                for (int i = 0; i < 4; ++i) { const int r = 4 * g + i; float p = X[r] * (gv[i] * Mt); if (MASK) p = (kb + crow(r, hi) <= qrow) ? p : 0.f; den += p; a[r] = p; } }
            pw[2 * blk] = (u32x4){cvtpk(a[0], a[1]), cvtpk(a[2], a[3]), cvtpk(a[4], a[5]), cvtpk(a[6], a[7])};
            pw[2 * blk + 1] = (u32x4){cvtpk(a[8], a[9]), cvtpk(a[10], a[11]), cvtpk(a[12], a[13]), cvtpk(a[14], a[15])};
        }
        st = den;
    }
    __builtin_amdgcn_sched_barrier(0);
    if constexpr (VPRE < D / 32) {
#pragma unroll
        for (int dp = 0; dp < VPRE; ++dp)
#pragma unroll
            for (int ks = 0; ks < 4; ++ks) { const s16x4 a = vlo[dp * 4 + ks], b = vhi[dp * 4 + ks];
                o[dp] = MX_MFMA(__builtin_bit_cast(bf16x8, pw[ks]), ((bf16x8){a[0], a[1], a[2], a[3], b[0], b[1], b[2], b[3]}), o[dp]); }
        __builtin_amdgcn_sched_barrier(0);
        s16x4 wlo[(D / 32 - VPRE) * 4], whi[(D / 32 - VPRE) * 4];
#pragma unroll
        for (int dp = VPRE; dp < D / 32; ++dp)
#pragma unroll
            for (int ks = 0; ks < 4; ++ks) { wlo[(dp - VPRE) * 4 + ks] = vtr(vb + dp * 4096 + ks * 1024); whi[(dp - VPRE) * 4 + ks] = vtr(vb + dp * 4096 + ks * 1024 + 512); }
        __builtin_amdgcn_sched_barrier(0);
#pragma unroll
        for (int dp = VPRE; dp < D / 32; ++dp)
#pragma unroll
            for (int ks = 0; ks < 4; ++ks) { const s16x4 a = wlo[(dp - VPRE) * 4 + ks], b = whi[(dp - VPRE) * 4 + ks];
                o[dp] = MX_MFMA(__builtin_bit_cast(bf16x8, pw[ks]), ((bf16x8){a[0], a[1], a[2], a[3], b[0], b[1], b[2], b[3]}), o[dp]); }
    } else {
#pragma unroll
        for (int dp = 0; dp < D / 32; ++dp)
#pragma unroll
            for (int ks = 0; ks < 4; ++ks) { const s16x4 a = vlo[dp * 4 + ks], b = vhi[dp * 4 + ks];
                o[dp] = MX_MFMA(__builtin_bit_cast(bf16x8, pw[ks]), ((bf16x8){a[0], a[1], a[2], a[3], b[0], b[1], b[2], b[3]}), o[dp]); }
    }
}
template <int D, bool SBK, bool MASK>
__device__ __forceinline__ void valu(LAS const float* gat, const f32x16& p0, const f32x16& p1, u32x4 (&pw)[4], float& st, const float Mt, const int qrow, const int key0, const int lane) {
    const int hi = lane >> 5;
    if constexpr (SBK) {
        float R = st;
#pragma unroll
        for (int blk = 1; blk >= 0; --blk) {
            const f32x16& X = blk ? p1 : p0; const int kb = key0 + 32 * blk;
            float bt[16], sx[16], Pg[4], Qg[4];
#pragma unroll
            for (int g = 0; g < 4; ++g) { float run = 1.f;
#pragma unroll
                for (int i = 3; i >= 0; --i) { const int r = 4 * g + i; float z = X[r]; if (MASK) z = (kb + crow(r, hi) < qrow) ? z : -INFINITY;
                    const float e = __builtin_amdgcn_exp2f(-z); const float b = __builtin_amdgcn_rcpf(1.0f + e); bt[r] = b; sx[r] = run; run *= (1.0f - b); }
                Pg[g] = run; }
#pragma unroll
            for (int g = 0; g < 4; ++g) Qg[g] = partner(Pg[g], hi);
            float a[16];
#pragma unroll
            for (int g = 3; g >= 0; --g) { const float pre = R * (hi ? 1.0f : Qg[g]);
#pragma unroll
                for (int i = 0; i < 4; ++i) a[4 * g + i] = bt[4 * g + i] * sx[4 * g + i] * pre;
                R *= Pg[g] * Qg[g]; }
            pw[2 * blk] = (u32x4){cvtpk(a[0], a[1]), cvtpk(a[2], a[3]), cvtpk(a[4], a[5]), cvtpk(a[6], a[7])};
            pw[2 * blk + 1] = (u32x4){cvtpk(a[8], a[9]), cvtpk(a[10], a[11]), cvtpk(a[12], a[13]), cvtpk(a[14], a[15])};
        }
        st = R;
    } else {
        float den = st;
#pragma unroll
        for (int blk = 0; blk < 2; ++blk) {
            const f32x16& X = blk ? p1 : p0; const int kb = key0 + 32 * blk;
            float a[16];
#pragma unroll
            for (int g = 0; g < 4; ++g) { const f32x4 gv = *(LAS const f32x4*)(gat + 32 * blk + 8 * g + 4 * hi);
#pragma unroll
                for (int i = 0; i < 4; ++i) { const int r = 4 * g + i; float p = X[r] * (gv[i] * Mt); if (MASK) p = (kb + crow(r, hi) <= qrow) ? p : 0.f; den += p; a[r] = p; } }
            pw[2 * blk] = (u32x4){cvtpk(a[0], a[1]), cvtpk(a[2], a[3]), cvtpk(a[4], a[5]), cvtpk(a[6], a[7])};
            pw[2 * blk + 1] = (u32x4){cvtpk(a[8], a[9]), cvtpk(a[10], a[11]), cvtpk(a[12], a[13]), cvtpk(a[14], a[15])};
        }
        st = den;
    }
}
template <int D>
__device__ __forceinline__ void pv(lptr vimg, const u32x4 (&pw)[4], f32x16 (&o)[D / 32], const int lane) {
    const int hi = lane >> 5;
    const lptr vb = vimg + ((lane >> 4) & 1) * 32 + (lane & 3) * 8 + (4 * hi + ((lane & 15) >> 2)) * 64;
#pragma unroll
    for (int hb = 0; hb < D / 64; ++hb) {
        s16x4 vlo[8], vhi[8];
#pragma unroll
        for (int d = 0; d < 2; ++d)
#pragma unroll
            for (int ks = 0; ks < 4; ++ks) { const int dp = 2 * hb + d; vlo[d * 4 + ks] = vtr(vb + dp * 4096 + ks * 1024); vhi[d * 4 + ks] = vtr(vb + dp * 4096 + ks * 1024 + 512); }
        __builtin_amdgcn_sched_barrier(0);
#pragma unroll
        for (int d = 0; d < 2; ++d)
#pragma unroll
            for (int ks = 0; ks < 4; ++ks) { const int dp = 2 * hb + d; const s16x4 a = vlo[d * 4 + ks], b = vhi[d * 4 + ks];
                o[dp] = MX_MFMA(__builtin_bit_cast(bf16x8, pw[ks]), ((bf16x8){a[0], a[1], a[2], a[3], b[0], b[1], b[2], b[3]}), o[dp]); }
        __builtin_amdgcn_sched_barrier(0);
    }
}
__device__ __forceinline__ void ml_fused(LAS const float* gat, const f32x16& p0, const f32x16& p1, u32x4 (&pwN)[4], float& den, const float ft, const int lane,
                                         lptr vimgP, const u32x4 (&pwP)[4], f32x16 (&o)[4], const bool dopv) {
    const int hi = lane >> 5;
    const lptr vb = vimgP + ((lane >> 4) & 1) * 32 + (lane & 3) * 8 + (4 * hi + ((lane & 15) >> 2)) * 64;
    s16x4 f0a = vtr(vb), f0b = vtr(vb + 512), f1a = vtr(vb + 1024), f1b = vtr(vb + 1024 + 512);
    f32x4 gv = {};
    __builtin_amdgcn_sched_barrier(0);
#pragma unroll
    for (int k = 0; k < 16; ++k) {
        const int dp = k >> 2, ks = k & 3;
        s16x4 f2a = f0a, f2b = f0b;
        if (k + 2 < 16) { const int dn = (k + 2) >> 2, kn = (k + 2) & 3; f2a = vtr(vb + dn * 4096 + kn * 1024); f2b = vtr(vb + dn * 4096 + kn * 1024 + 512); }
        if (dopv) o[dp] = MX_MFMA(__builtin_bit_cast(bf16x8, pwP[ks]), ((bf16x8){f0a[0], f0a[1], f0a[2], f0a[3], f0b[0], f0b[1], f0b[2], f0b[3]}), o[dp]);
        const int blk = k >> 3, r = 2 * (k & 7);
        if ((k & 1) == 0) gv = *(LAS const f32x4*)(gat + 32 * blk + 8 * (r >> 2) + 4 * hi);
        const f32x16& X = blk ? p1 : p0;
        const float q0 = X[r] * (gv[r & 3] * ft), q1 = X[r + 1] * (gv[(r & 3) + 1] * ft);
        den += q0; den += q1;
        unsigned w = cvtpk(q0, q1);
        asm volatile("" : "+v"(w)); asm volatile("" : "+v"(den));
        pwN[2 * blk + ((k & 7) >> 2)][(k & 7) & 3] = w;
        f0a = f1a; f0b = f1b; f1a = f2a; f1b = f2b;
        __builtin_amdgcn_sched_barrier(0);
    }
}
__device__ __forceinline__ void ml_mask(f32x16& p0, f32x16& p1, const int qrow, const int key0, const int lane) {
    const int hi = lane >> 5;
#pragma unroll
    for (int r = 0; r < 16; ++r) { const int kk = key0 + crow(r, hi); p0[r] = (kk <= qrow) ? p0[r] : 0.f; p1[r] = (kk + 32 <= qrow) ? p1[r] : 0.f; }
}
template <int D, bool SBK>
__device__ __forceinline__ void prefetch_unit(KArgs kap, LAS unsigned char* lds, const int wave_s, const UnitP& u, bf16x8 (&qr)[D / 16], float& Mt, float& Ml, float& tgv) {
    int tid = wave_s * 64 + lane_id(); asm volatile("" : "+v"(tid));
    const int lane = tid & 63, wid = __builtin_amdgcn_readfirstlane(tid >> 6);
    const int qrow = 256 * u.qb + 32 * wid + (lane & 31), nt = 4 * (u.qb + 1);
    const unsigned l0 = (unsigned)(size_t)lds;
    const LoopPtrs<SBK> lp = loop_ptrs<SBK>(kap, u);
    issue_tile<D, !SBK>(l0 + KBUF0, l0 + VBUF0, l0 + EX_GA, lp, 64 * (nt - 1), wid, lane);
    issue_tile<D, !SBK>(l0 + KBUF0 + BUFSZ, l0 + VBUF0 + BUFSZ, l0 + EX_GA + 256, lp, 64 * (nt - 2), wid, lane);
    const size_t r0 = (size_t)u.b * SEQ;
    const bf16* Qp = SBK ? (const bf16*)WSP(WS_PROJ) + r0 * NPROJ + 2048 + u.h * 64 : (const bf16*)WSP(WS_QKC) + r0 * DM + u.h * 128; const int pq = SBK ? NPROJ : DM;
#pragma unroll
    for (int d0 = 0; d0 < D / 16; ++d0) qr[d0] = *(const GAS bf16x8*)(Qp + (size_t)qrow * pq + d0 * 16 + (lane >> 5) * 8);
    Mt = 0.f; Ml = 0.f; tgv = 0.f;
    if (!SBK) { const size_t bh = (size_t)(u.b * 4 + u.h); Mt = ((const float*)WSP(WS_GM))[bh * SEQ + qrow]; Ml = ((const float*)WSP(WS_GM))[bh * SEQ + 256 * u.qb + 255];
        tgv = ((const float*)WSP(WS_TG))[bh * 32 + (lane & 31)]; }
}
template <int D, bool SBK>
__device__ __forceinline__ void unit_run(KArgs kap, LAS unsigned char* lds, const int wave_s, const UnitP& u, const bool has_next, const UnitP& nx, bf16x8 (&qr)[D / 16], float& Mt, float& Ml, float& tgv) {
    int tid = wave_s * 64 + lane_id(); asm volatile("" : "+v"(tid));
    const LoopPtrs<SBK> lp = loop_ptrs<SBK>(kap, u);
    const int lane = tid & 63, wid = __builtin_amdgcn_readfirstlane(tid >> 6), late = MX_LATE ? (wid >> 2) : 0, r32 = lane & 31, hi = lane >> 5;
    const int t0 = 256 * u.qb, nt = 4 * (u.qb + 1), R0 = t0 + 32 * wid, qrow = R0 + r32;
    const unsigned l0 = (unsigned)(size_t)lds;
#pragma unroll
    for (int d0 = 0; d0 < D / 16; ++d0) asm volatile("" : "+v"(qr[d0]));
    asm volatile("" : "+v"(Mt)); asm volatile("" : "+v"(Ml)); asm volatile("" : "+v"(tgv));
    const float fv = SBK ? 0.f : __builtin_amdgcn_exp2f(tgv - Ml);
    const float Bt = SBK ? 1.f : __builtin_amdgcn_exp2f(Ml - Mt);
    f32x16 o[D / 32];
#pragma unroll
    for (int i = 0; i < D / 32; ++i) o[i] = f32x16{};
    float st = SBK ? 1.0f : 0.0f;
    const int nti = (!SBK && ML_CHUNK) ? 4 : nt;
    if constexpr (!SBK && ML_CHUNK) {
        __builtin_amdgcn_s_barrier();
        if (u.qb > 0) {
            const int bh = u.b * 4 + u.h;
            const float* CMp = (const float*)WSP(WS_CM) + bh * 8;
            {
                const int d = tid >> 2, dp = tid & 3;
                const unsigned short* Ub = (const unsigned short*)WSP(WS_U) + (size_t)bh * 7 * 16384 + d * 128 + dp * 32;
                v4u rr[7][4];
#pragma unroll
                for (int j = 0; j < 7; ++j) { const int jc = (j < u.qb) ? j : u.qb - 1;
#pragma unroll
                    for (int c = 0; c < 4; ++c) rr[j][c] = *(const GAS v4u*)(Ub + (size_t)jc * 16384 + 8 * c); }
                float scj[7];
                { const f32x4 c0 = *(const GAS f32x4*)CMp, c1 = *(const GAS f32x4*)(CMp + 4);
                  const float cmv[8] = {c0.x, c0.y, c0.z, c0.w, c1.x, c1.y, c1.z, c1.w};
#pragma unroll
                  for (int j = 0; j < 7; ++j) scj[j] = (j < u.qb) ? __builtin_amdgcn_exp2f(cmv[j] - Ml) : 0.f; }
                float ac[32];
#pragma unroll
                for (int c = 0; c < 32; ++c) ac[c] = 0.f;
#pragma unroll
                for (int j = 0; j < 7; ++j)
#pragma unroll
                    for (int c = 0; c < 4; ++c) { const v4u x = rr[j][c];
                        ac[8 * c + 0] += scj[j] * bflo(x.x); ac[8 * c + 1] += scj[j] * bfhi(x.x); ac[8 * c + 2] += scj[j] * bflo(x.y); ac[8 * c + 3] += scj[j] * bfhi(x.y);
                        ac[8 * c + 4] += scj[j] * bflo(x.z); ac[8 * c + 5] += scj[j] * bfhi(x.z); ac[8 * c + 6] += scj[j] * bflo(x.w); ac[8 * c + 7] += scj[j] * bfhi(x.w); }
                const int dl = d & 63, rho = (dl & 0x33) | ((dl & 4) << 1) | ((dl & 8) >> 1);
                LAS unsigned char* ip = lds + STAGE0 + (d >> 6) * 16384 + dp * 4096 + rho * 64;
#pragma unroll
                for (int c = 0; c < 4; ++c) *(LAS v4u*)(ip + 16 * c) = (v4u){cvtpk(ac[8 * c], ac[8 * c + 1]), cvtpk(ac[8 * c + 2], ac[8 * c + 3]), cvtpk(ac[8 * c + 4], ac[8 * c + 5]), cvtpk(ac[8 * c + 6], ac[8 * c + 7])};
                if (tid < 128) { const float* NVp = (const float*)WSP(WS_NV) + (size_t)bh * 7 * 128 + tid; float nn = 0.f, nvv[7];
#pragma unroll
                    for (int j = 0; j < 7; ++j) { const int jc = (j < u.qb) ? j : u.qb - 1; nvv[j] = NVp[jc * 128]; }
                    asm volatile("" : "+v"(nvv[0]), "+v"(nvv[1]), "+v"(nvv[2]), "+v"(nvv[3]), "+v"(nvv[4]), "+v"(nvv[5]), "+v"(nvv[6]));
#pragma unroll
                    for (int j = 0; j < 7; ++j) nn += scj[j] * nvv[j];
                    ((LAS float*)(lds + STAGE0 + 32768))[tid] = nn; }
            }
            LDS_WAIT(); __builtin_amdgcn_s_barrier(); asm volatile("" ::: "memory");
            {
                u32x4 qa[4], qb_[4];
#pragma unroll
                for (int c = 0; c < 4; ++c) { qa[c] = __builtin_bit_cast(u32x4, qr[c]); qb_[c] = __builtin_bit_cast(u32x4, qr[4 + c]); }
                pv<128>((lptr)(lds + STAGE0), qa, o, lane);
                pv<128>((lptr)(lds + STAGE0 + 16384), qb_, o, lane);
                LAS const float* nvl = (LAS const float*)(lds + STAGE0 + 32768);
                float dn = 0.f;
#pragma unroll
                for (int d0 = 0; d0 < 8; ++d0) { const f32x4 n0 = *(LAS const f32x4*)(nvl + 16 * d0 + 8 * hi), n1 = *(LAS const f32x4*)(nvl + 16 * d0 + 8 * hi + 4); const u32x4 qq = __builtin_bit_cast(u32x4, qr[d0]);
                    dn += bflo(qq.x) * n0.x + bfhi(qq.x) * n0.y + bflo(qq.y) * n0.z + bfhi(qq.y) * n0.w + bflo(qq.z) * n1.x + bfhi(qq.z) * n1.y + bflo(qq.w) * n1.z + bfhi(qq.w) * n1.w; }
                st = dn;
            }
        }
    }
    f32x16 p0 = {}, p1 = {};
    u32x4 pwP[4] = {}; bool havep = false;
    LAS unsigned* const dflag = (LAS unsigned*)(lds + EX_DEAD);
    if (SBK) { if (lane == 0) dflag[wid] = 0u; }
    int k3 = 0, v4 = 0;
    bool wdead = false;
    for (int i = 0; i < nti + MX_LATE; ++i) {
        if (i + 1 < nti) { if (D == 64) asm volatile("s_waitcnt vmcnt(2)" ::: "memory"); else asm volatile("s_waitcnt vmcnt(5)" ::: "memory"); }
        else asm volatile("s_waitcnt vmcnt(0)" ::: "memory");
        if (SBK) LDS_WAIT();
        __builtin_amdgcn_s_barrier();
        asm volatile("" ::: "memory");
        if (SBK && i > 0) { const u32x4 d0 = *(LAS const u32x4*)dflag, d1 = *(LAS const u32x4*)(dflag + 4);
            if (__builtin_amdgcn_readfirstlane((int)(d0.x & d0.y & d0.z & d0.w & d1.x & d1.y & d1.z & d1.w)) != 0) break; }
        if (i + 2 < nti) { const int k3n = (k3 == 0) ? 2 : k3 - 1, v4n = (v4 + 2) & 3;
            issue_tile<D, !SBK>(l0 + KBUF0 + k3n * BUFSZ, l0 + VBUF0 + v4n * BUFSZ, l0 + EX_GA + v4n * 256, lp, 64 * (nt - 3 - i), wid, lane); }
        const int v4p = (v4 + 3) & 3;
        const int tv = late ? nt - i : nt - 1 - i;
        const int vb = late ? v4p : v4;
        const bool dov = late ? (i >= 1) : (i < nti);
        const int tq = nt - 1 - i;
        const bool doq = (i < nti) && (SBK ? (64 * tq < R0 + 31) : (64 * tq <= R0 + 31));
        const lptr kimg = (lptr)(lds + KBUF0 + k3 * BUFSZ);
        if (!late && doq && !wdead) qk<D>(kimg, qr, p0, p1, lane);
        if constexpr (!SBK) {
            if (doq) {
                const float ft = __builtin_bit_cast(float, __builtin_amdgcn_readlane(__builtin_bit_cast(int, fv), tq));
                const bool unm = (64 * tq + 63 <= R0);
                LAS const float* gat = (LAS const float*)(lds + EX_GA + v4 * 256); const lptr vprev = (lptr)(lds + VBUF0 + v4p * BUFSZ);
                u32x4 pwN[4];
                if (!unm) ml_mask(p0, p1, qrow, 64 * tq, lane);
                ml_fused(gat, p0, p1, pwN, st, ft, lane, vprev, pwP, o, havep);
#pragma unroll
                for (int q_ = 0; q_ < 4; ++q_) pwP[q_] = pwN[q_];
                havep = true;
            }
        } else
        if (dov) {
            const bool live = SBK ? (64 * tv < R0 + 31) : (64 * tv <= R0 + 31);
            const bool unm = SBK ? (64 * tv + 63 < R0) : (64 * tv + 63 <= R0);
            const lptr vimg = (lptr)(lds + VBUF0 + vb * BUFSZ); LAS const float* gat = (LAS const float*)(lds + EX_GA + vb * 256);
            if (live && !wdead) { const float ft = SBK ? 0.f : __builtin_bit_cast(float, __builtin_amdgcn_readlane(__builtin_bit_cast(int, fv), tv));
                if (unm) vp<D, SBK, false>(vimg, gat, p0, p1, o, st, ft, qrow, 64 * tv, lane); else vp<D, SBK, true>(vimg, gat, p0, p1, o, st, ft, qrow, 64 * tv, lane);
                if (SBK) { const bool dead = (__ballot(st != 0.0f) == 0ull); if (lane == 0) dflag[wid] = dead ? 1u : 0u; wdead = dead; } }
        }
        if (late && doq) qk<D>(kimg, qr, p0, p1, lane);
        k3 = (k3 == 2) ? 0 : k3 + 1; v4 = (v4 + 1) & 3;
    }
    if constexpr (!SBK) { if (havep) pv<D>((lptr)(lds + VBUF0 + ((nt - 1) & 3) * BUFSZ), pwP, o, lane); }
    LDS_WAIT(); __builtin_amdgcn_s_barrier(); asm volatile("" ::: "memory");
    const float ge_q = SBK ? 0.f : ((const float*)WSP(WS_GE))[(size_t)(u.b * 4 + u.h) * SEQ + qrow];
    if (has_next) prefetch_unit<D, SBK>(kap, lds, wave_s, nx, qr, Mt, Ml, tgv);
    const size_t er0 = (size_t)u.b * SEQ;
    bf16* const e_out = (bf16*)WSP(WS_MIXED) + er0 * DM + (SBK ? 512 + u.h * 64 : u.h * 128);
    const float* const e_gain = SBK ? KA(g_sb) + u.layer * 512 + u.h * 64 : KA(g_mlstm) + u.layer * 512 + u.h * 128;
    const bf16* const e_om = (const bf16*)WSP(WS_PROJ) + er0 * NPROJ + 1536 + u.h * 128;
    LAS float* stg = (LAS float*)(lds + STAGE0 + wid * STAGE_W); LAS float* wsf = stg + 1088;
    if (!SBK) { const float den = (st + partner(st, hi)) * Bt; if (hi == 0) wsf[r32] = Bt / fmaxf(fabsf(den), ge_q); }
    constexpr int RP = (D == 64) ? 16 : 8, NPASS = 32 / RP, LPR = 64 / RP, PITCH = D + 4, RPP = 16 / NPASS;
    const int rl = lane / LPR, seg = lane % LPR;
    float gn[16];
#pragma unroll
    for (int c = 0; c < 4; ++c) { const f32x4 g = *(const GAS f32x4*)(e_gain + 16 * seg + 4 * c); gn[4 * c] = g.x; gn[4 * c + 1] = g.y; gn[4 * c + 2] = g.z; gn[4 * c + 3] = g.w; }
    v4u gpre[SBK ? 1 : NPASS][2];
    if constexpr (!SBK) {
#pragma unroll
        for (int ps = 0; ps < NPASS; ++ps) { const int gr_ = R0 + ps * RP + rl; gpre[ps][0] = *(const GAS v4u*)(e_om + (size_t)gr_ * NPROJ + 16 * seg); gpre[ps][1] = *(const GAS v4u*)(e_om + (size_t)gr_ * NPROJ + 16 * seg + 8); }
    }
#pragma unroll
    for (int ps = 0; ps < NPASS; ++ps) {
        LDS_WAIT(); asm volatile("" ::: "memory");
#pragma unroll
        for (int rr = 0; rr < RPP; ++rr) { const int r = ps * RPP + rr; const int srow = crow(r, hi) - ps * RP;
#pragma unroll
            for (int dp = 0; dp < D / 32; ++dp) stg[srow * PITCH + 32 * dp + r32] = o[dp][r]; }
        LDS_WAIT(); asm volatile("" ::: "memory");
        float x[16];
#pragma unroll
        for (int c = 0; c < 4; ++c) { const f32x4 v4 = *(LAS const f32x4*)(stg + rl * PITCH + 16 * seg + 4 * c); x[4 * c] = v4.x; x[4 * c + 1] = v4.y; x[4 * c + 2] = v4.z; x[4 * c + 3] = v4.w; }
        const int prow = ps * RP + rl, grow = R0 + prow;
        if (!SBK) { const float inv = wsf[prow];
#pragma unroll
            for (int c = 0; c < 16; ++c) x[c] *= inv; }
        float ss = 0.f;
#pragma unroll
        for (int c = 0; c < 16; ++c) ss += x[c] * x[c];
        ss = (LPR == 8) ? oct_sum(ss, lane) : quad_sum(ss);
        const float rs = 1.0f / sqrtf(ss * (1.0f / D) + EPS);
#pragma unroll
        for (int c = 0; c < 16; ++c) x[c] *= rs * gn[c];
        if (!SBK) { const v4u g0 = gpre[SBK ? 0 : ps][0], g1 = gpre[SBK ? 0 : ps][1];
            float gg[16]; gg[0] = bflo(g0.x); gg[1] = bfhi(g0.x); gg[2] = bflo(g0.y); gg[3] = bfhi(g0.y); gg[4] = bflo(g0.z); gg[5] = bfhi(g0.z); gg[6] = bflo(g0.w); gg[7] = bfhi(g0.w);
            gg[8] = bflo(g1.x); gg[9] = bfhi(g1.x); gg[10] = bflo(g1.y); gg[11] = bfhi(g1.y); gg[12] = bflo(g1.z); gg[13] = bfhi(g1.z); gg[14] = bflo(g1.w); gg[15] = bfhi(g1.w);
#pragma unroll
            for (int c = 0; c < 16; ++c) x[c] *= 1.0f / (1.0f + __expf(-gg[c])); }
        bf16* op = e_out + (size_t)grow * DM + 16 * seg;
        *(GAS v4u*)op = (v4u){pk2(x[0], x[1]), pk2(x[2], x[3]), pk2(x[4], x[5]), pk2(x[6], x[7])};
        *(GAS v4u*)(op + 8) = (v4u){pk2(x[8], x[9]), pk2(x[10], x[11]), pk2(x[12], x[13]), pk2(x[14], x[15])};
    }
    LDS_WAIT();
}
#undef MX_MFMA
}

__device__ __forceinline__ void mixer_phase(KArgs kap, LAS unsigned char* lds, const int wave_s, const int layer) {
    int G = gridDim.x; asm volatile("" : "+s"(G)); int bid = blockIdx.x; asm volatile("" : "+s"(bid));
    for (int jb = bid; jb < 256; jb += G) {
        {
            int jb2 = jb; asm volatile("" : "+s"(jb2));
            const int b = jb2 & 7, idx = jb2 >> 3, m = idx & 7, hl = idx >> 3;
#if ML_CHUNK
            int hA, qA, hB, qB;
            if (m < 6) { const int n0 = (m * 4 + hl) * 2, n1 = n0 + 1; hA = (n0 * 37) >> 8; qA = 1 + n0 - 7 * hA; hB = (n1 * 37) >> 8; qB = 1 + n1 - 7 * hB; }
            else { const int n0 = 48 + (m - 6) * 4 + hl; hA = (n0 * 37) >> 8; qA = 1 + n0 - 7 * hA; hB = hl + 4 * (m - 6); qB = 0; }
            bf16x8 qr[4]; float Mt, Ml, tgv;
            __builtin_amdgcn_s_barrier();
            {
                const mix2::UnitP uA{b, hA, qA, layer}, uB{b, hB, qB, layer};
                mix2::prefetch_unit<64, true>(kap, lds, wave_s, uA, qr, Mt, Ml, tgv);
                mix2::unit_run<64, true>(kap, lds, wave_s, uA, true, uB, qr, Mt, Ml, tgv);
                mix2::unit_run<64, true>(kap, lds, wave_s, uB, false, uB, qr, Mt, Ml, tgv);
            }
#else
            const int nsb = (0x01122334 >> (4 * m)) & 15, st0 = (int)((0xFECA740ull >> (4 * m)) & 15ull);
            bf16x8 qr[4]; float Mt, Ml, tgv;
            __builtin_amdgcn_s_barrier();
            if (nsb > 0) {
                const int u0 = hl * 16 + st0;
                mix2::UnitP uc{b, u0 >> 3, u0 & 7, layer};
                mix2::prefetch_unit<64, true>(kap, lds, wave_s, uc, qr, Mt, Ml, tgv);
#pragma unroll 1
                for (int k = 0; k < nsb; ++k) {
                    const int un = u0 + k + 1; const mix2::UnitP nx{b, un >> 3, un & 7, layer};
                    mix2::unit_run<64, true>(kap, lds, wave_s, uc, k + 1 < nsb, nx, qr, Mt, Ml, tgv);
                    uc = nx;
                }
            }
#endif
        }
#if CONV_NOBAR
        {
            int t0_ = wave_s * 64 + lane_id();
            if (t0_ == 0) { gu32* cc = (gu32*)WSP(WS_CTL) + CW_CONV + 8 * layer + (bid & 7); unsigned sp = 0u;
                while (__hip_atomic_load(cc, __ATOMIC_RELAXED, __HIP_MEMORY_SCOPE_AGENT) < (unsigned)(G >> 3)) { __builtin_amdgcn_s_sleep(1); if (++sp > (1u << 22)) break; }
                __builtin_amdgcn_fence(__ATOMIC_ACQUIRE, "agent"); }
            __builtin_amdgcn_s_barrier();
        }
#endif
        {
            const int b = jb & 7, idx = jb >> 3, m = idx & 7, hl = idx >> 3;
            const mix2::UnitP u{b, hl, m, layer};
            bf16x8 qr[8]; float Mt, Ml, tgv;
            mix2::prefetch_unit<128, false>(kap, lds, wave_s, u, qr, Mt, Ml, tgv);
            mix2::unit_run<128, false>(kap, lds, wave_s, u, false, u, qr, Mt, Ml, tgv);
        }
        __builtin_amdgcn_s_barrier();
    }
}

#define MKFRAME() Frame F; F.lds = (LAS unsigned char*)lds; F.MISC = (volatile LAS unsigned*)(F.lds + MISC_OFF); F.tid = wave_s * 64 + lane_id(); asm volatile("" : "+v"(F.tid)); F.lane = F.tid & 63; \
    F.wave = __builtin_amdgcn_readfirstlane(F.tid >> 6); F.G = gridDim.x; asm volatile("" : "+s"(F.G)); F.bid = blockIdx.x; asm volatile("" : "+s"(F.bid)); F.ctl = (gu32*)WSP(WS_CTL)
#define GRID_BAR() do { XcdBarrier bar_; bar_.bar = (unsigned*)WSP(WS_CTL) + CW_BAR; bar_.x = xb_xcc_id(); bar_.st = (volatile LAS unsigned*)((LAS unsigned char*)lds + MISC_OFF) + 8; xcd_barrier(bar_, wave_s); } while (0)
#define GROUP_BAR() group_barrier((gu32*)WSP(WS_CTL) + CW_GB + 4096 * ((int)blockIdx.x & 7), wave_s, (volatile LAS unsigned*)((LAS unsigned char*)lds + MISC_OFF) + 24, xb_xcc_id())
#define BUILD_TAB() do { __syncthreads(); \
            if (F.tid == 0) { int acc_ = 0; for (int e = 0; e < 8; ++e) { const int c_ = (int)__hip_atomic_load(F.ctl + CW_CNT + 64 * j + e, RLX_AGENT); tab[e] = acc_; tab[16 + e] = c_; acc_ += (c_ + 255) >> 8; } tab[8] = acc_; } \
            __syncthreads(); } while (0)

__global__ void __launch_bounds__(NTHREADS, 2) mk_fwd(Args args_unused) {
    extern __shared__ __attribute__((aligned(16))) unsigned char lds[];
    KArgs kap = (KArgs)__builtin_amdgcn_kernarg_segment_ptr();
    const int wave_s = __builtin_amdgcn_readfirstlane((int)threadIdx.x >> 6);
    for (int u = threadIdx.x; u < 256; u += NTHREADS) ((LAS unsigned*)((LAS unsigned char*)lds + MISC_OFF))[u] = 0u;
    __syncthreads();
    (void)xcd_barrier_post((unsigned*)WSP(WS_CTL) + CW_BAR, (volatile LAS unsigned*)((LAS unsigned char*)lds + MISC_OFF) + 8);
    { gu32* gbp = (gu32*)WSP(WS_CTL) + CW_GB + 4096 * ((int)blockIdx.x & 7) + GB_XCNT(xb_xcc_id());
      if (threadIdx.x == 0) (void)__hip_atomic_fetch_add(gbp, 1u, __ATOMIC_RELAXED, __HIP_MEMORY_SCOPE_AGENT); }

    { MKFRAME(); Args a; a.ws = KA(ws); a.w_in = KA(w_in); a.w_out = KA(w_out); a.ffn_w_gate = KA(ffn_w_gate); a.ffn_w_up = KA(ffn_w_up); a.ffn_w_down = KA(ffn_w_down);
      a.moe_w_gate = KA(moe_w_gate); a.moe_w_up = KA(moe_w_up); a.moe_w_down = KA(moe_w_down); a.norm_mix_g = KA(norm_mix_g); a.norm_ffn_g = KA(norm_ffn_g);
#pragma unroll 1
      for (int rep = 0; rep < REP_PRO; ++rep) prologue_phase(a, F); }
    __syncthreads();
    for (int layer = 0; layer < DEPTH; ++layer) {
        const int j = layer >> 1; const bool moe = layer & 1;
        { MKFRAME();
            NormIn p{}; p.src = KA(x); p.src16 = (const bf16*)WSP(WS_H16); p.o2 = (layer == 2) ? (bf16*)WSP(WS_O2) : nullptr; p.hout16 = (layer == 0 || layer == 2) ? (bf16*)WSP(WS_H16) : nullptr; p.rs = (float*)WSP(WS_RS);
            p.gain = KA(norm_mix_g) + layer * DM; p.w8 = KA(w_in) + (size_t)layer * DM * PIN + 2048; p.ld8 = PIN; p.G = (float*)WSP(WS_G);
            if (layer == 0) norm_phase<0, false>(F, p); else norm_phase<0, true>(F, p);
        }
        if (layer == 0) GRID_BAR(); else GROUP_BAR();
        { MKFRAME();
            if (F.bid >= 128 && F.bid < 160) gate_scan(F, (F.bid & 7) * HM + ((F.bid >> 3) - 16), (float*)WSP(WS_G), KA(b_igate) + layer * HM, KA(b_fgate) + layer * HM, (float*)WSP(WS_GA), (float*)WSP(WS_GM), (float*)WSP(WS_GE), (float*)WSP(WS_TG));
            __syncthreads();
            pg8::EpiProj E{(bf16*)WSP(WS_PROJ), (const float*)WSP(WS_RS)};
            const int ngw = F.G >> 3, lw = F.bid >> 3, ntl = pg8::WGM * (NPROJ / pg8::BM);
            const int maxu = (ntl + ngw - 1) / ngw, h0 = ntl - (maxu - 1) * ngw, nh = ngw - h0;
            { pg8::InprojOrder S; S.init(WSP(WS_H16), (bf16*)WSP(WS_WIN) + (size_t)layer * NPROJ * DM, T, NPROJ, DM, F.G, F.bid, 0, 2);
              pg8::gemm_phase<pg8::EpiProj, pg8::InprojOrder, true>(F.lds + RING_OFF, S, E, F.tid); }
            asm volatile("s_waitcnt vmcnt(0)" ::: "memory");
            __syncthreads();
            { const unsigned xcc = xb_xcc_id(); gu32* gbp = F.ctl + CW_GB + 4096 * (F.bid & 7);
              if (F.tid == 0) group_arrive(gbp, F.MISC + 24, xcc, (unsigned)layer + 1u); }
            { pg8::InprojOrder S; S.init(WSP(WS_H16), (bf16*)WSP(WS_WIN) + (size_t)layer * NPROJ * DM, T, NPROJ, DM, F.G, F.bid, 2, maxu - 2);
              pg8::gemm_phase<pg8::EpiProj, pg8::InprojOrder, true>(F.lds + RING_OFF, S, E, F.tid); }
            if (nh == 0 || lw >= h0) {
                const int hidx = nh == 0 ? lw : lw - h0, nhe = nh == 0 ? ngw : nh;
                __syncthreads();
                { const unsigned xcc = xb_xcc_id(); gu32* gbp = F.ctl + CW_GB + 4096 * (F.bid & 7);
                  if (F.tid == 0) group_wait(gbp, F.MISC + 24, xcc, (unsigned)layer + 1u); }
                __syncthreads();
                conv_phase(F, (bf16*)WSP(WS_PROJ), KA(conv_w) + (size_t)layer * 4 * 1024, KA(conv_b) + (size_t)layer * 1024, (bf16*)WSP(WS_QKC), hidx, nhe);
#pragma unroll 1
                for (int ub = nhe - 1 - hidx; ub < HM * 7; ub += nhe) chunk_state_unit(F, (F.bid & 7) * HM + ub / 7, ub % 7, (bf16*)WSP(WS_PROJ), KA(conv_w) + (size_t)layer * 4 * 1024, KA(conv_b) + (size_t)layer * 1024,
                                                                   (float*)WSP(WS_GA), (float*)WSP(WS_TG), (bf16*)WSP(WS_U), (float*)WSP(WS_NV), (float*)WSP(WS_CM), (bf16*)WSP(WS_QKC));
            }
        }
        GROUP_BAR();
        { MKFRAME();
#if NAIVE_MIX == 1
            naive_sb(F, (bf16*)WSP(WS_PROJ), KA(g_sb) + layer * 512, (bf16*)WSP(WS_MIXED));
            naive_mlstm(F, (bf16*)WSP(WS_PROJ), (bf16*)WSP(WS_QKC), (float*)WSP(WS_GA), (float*)WSP(WS_GM), (float*)WSP(WS_GE), KA(g_mlstm) + layer * 512, (bf16*)WSP(WS_MIXED));
#else
#pragma unroll 1
            for (int rep = 0; rep < REP_MIX; ++rep) mixer_phase(kap, F.lds, wave_s, layer);
#endif
            __syncthreads();
        }
        GROUP_BAR();
        { MKFRAME();
            pg8::DenseOrder S; S.init(WSP(WS_MIXED), (bf16*)WSP(WS_WOUT) + (size_t)layer * DM * DM, T, DM, DM, F.G, F.bid);
            { pg8::EpiResid16<false> E{nullptr, (bf16*)WSP(WS_H16)}; pg8::gemm_phase<pg8::EpiResid16<false>, pg8::DenseOrder, true>(F.lds + RING_OFF, S, E, F.tid); }
        }
        GROUP_BAR();
        { MKFRAME();
            NormIn p{}; p.src16 = (const bf16*)WSP(WS_H16); p.gain = KA(norm_ffn_g) + layer * DM; p.rs = (float*)WSP(WS_RS);
            if (moe) { p.w8 = KA(w_router) + (size_t)j * DM * 8; p.ld8 = 8; p.cnt = (unsigned*)(F.ctl + CW_CNT + 64 * j); p.rinfo = (uint2*)WSP(WS_RINFO); p.cntw = (int*)WSP(WS_CNTW); p.rrec = (int*)WSP(WS_RREC);
                norm_phase<2, true>(F, p); }
            else norm_phase<1, true>(F, p);
        }
        if (moe) { GRID_BAR(); MKFRAME(); route_finish(F, (const int*)WSP(WS_CNTW), (const int*)WSP(WS_RREC), (uint2*)WSP(WS_RINFO), (const float*)WSP(WS_RS), (float*)WSP(WS_RSI)); }
        if (moe) GRID_BAR(); else GROUP_BAR();
        { MKFRAME(); volatile LAS int* tab = (volatile LAS int*)(F.MISC + 32);
            if (!moe) {
                pg8::DenseOrder S; S.init(WSP(WS_H16), (bf16*)WSP(WS_WGU) + (size_t)j * 2 * FFDP * DM, T, 2 * FFDP, DM, F.G, F.bid);
                pg8::EpiSwiglu E{(bf16*)WSP(WS_HID), FFDP, (const float*)WSP(WS_RS), nullptr};
#pragma unroll 1
                for (int rep = 0; rep < REP_DUP; ++rep) pg8::gemm_phase<pg8::EpiSwiglu, pg8::DenseOrder, true>(F.lds + RING_OFF, S, E, F.tid);
            } else {
                BUILD_TAB();
                pg8::MoeOrder<true> S; S.init(WSP(WS_H16), (bf16*)WSP(WS_MGU) + (size_t)j * 8 * 2 * FFE * DM, (size_t)2 * FFE * DM * 2, 2 * FFE, DM, F.G, F.bid, tab, (const uint2*)WSP(WS_RINFO));
                pg8::EpiSwiglu E{(bf16*)WSP(WS_HIDM), FFE, nullptr, (const float*)WSP(WS_RSI)};
#pragma unroll 1
                for (int rep = 0; rep < REP_MOEUP; ++rep) pg8::gemm_phase<pg8::EpiSwiglu, pg8::MoeOrder<true>, true>(F.lds + RING_OFF, S, E, F.tid);
            }
        }
        if (moe) GRID_BAR(); else GROUP_BAR();
        { MKFRAME(); volatile LAS int* tab = (volatile LAS int*)(F.MISC + 32);
            if (!moe) {
                pg8::DenseOrder S; S.init(WSP(WS_HID), (bf16*)WSP(WS_WD) + (size_t)j * DM * FFDP, T, DM, FFDP, F.G, F.bid);
                pg8::EpiResid16<false> E{nullptr, (bf16*)WSP(WS_H16)};
                pg8::gemm_phase<pg8::EpiResid16<false>, pg8::DenseOrder, true>(F.lds + RING_OFF, S, E, F.tid);
            } else {
                BUILD_TAB();
                pg8::MoeOrder<false> S; S.init(WSP(WS_HIDM), (bf16*)WSP(WS_MD) + (size_t)j * 8 * DM * FFE, (size_t)DM * FFE * 2, DM, FFE, F.G, F.bid, tab, (const uint2*)WSP(WS_RINFO));
                pg8::EpiScatter E{(bf16*)WSP(WS_O2), (const uint2*)WSP(WS_RINFO)};
#if MOE_TAIL_KS > 1
                const int rem = S.nwg % F.G, nmain = S.nwg - rem;
                pg8::MoeOrder<false> S0 = S; S0.nwg = nmain;
                pg8::gemm_phase<pg8::EpiScatter, pg8::MoeOrder<false>, true>(F.lds + RING_OFF, S0, E, F.tid);
                if (rem > 0 && F.bid < rem * MOE_TAIL_KS) {
                    pg8::MoeTailOrder ST; ST.init(S, nmain, rem, MOE_TAIL_KS, F.bid);
                    const int tl = F.bid % rem;
                    float* Pt = (float*)WSP(WS_Y) + (size_t)tl * MOE_TAIL_KS * 65536;
                    pg8::EpiPartial EP{Pt + (size_t)ST.slice * 65536};
                    pg8::gemm_phase<pg8::EpiPartial, pg8::MoeTailOrder, true>(F.lds + RING_OFF, ST, EP, F.tid);
                    asm volatile("s_waitcnt vmcnt(0)" ::: "memory");
                    __syncthreads();
                    if (F.tid == 0) { __builtin_amdgcn_fence(__ATOMIC_RELEASE, "agent");
                        const unsigned old_ = __hip_atomic_fetch_add(F.ctl + CW_TAIL + 32 * j + tl, 1u, __ATOMIC_RELAXED, __HIP_MEMORY_SCOPE_AGENT);
                        if (old_ == MOE_TAIL_KS - 1) __builtin_amdgcn_fence(__ATOMIC_ACQUIRE, "agent");
                        F.MISC[16] = old_; }
                    __syncthreads();
                    if (F.MISC[16] == MOE_TAIL_KS - 1) {
                        f32x4 acc[2][2][4][2];
#pragma unroll
                        for (int g = 0; g < 4; ++g) {
                            const float* pg = Pt + ((size_t)(g * 8) * 512 + F.tid) * 4; asm volatile("" : "+v"(pg));
#pragma unroll
                            for (int kh = 0; kh < 2; ++kh) {
                                f32x4 t[4][MOE_TAIL_KS];
#pragma unroll
                                for (int k2 = 0; k2 < 4; ++k2)
#pragma unroll
                                    for (int sl = 0; sl < MOE_TAIL_KS; ++sl) t[k2][sl] = *(const GAS f32x4*)(pg + (size_t)sl * 65536 + (4 * kh + k2) * 2048);
#pragma unroll
                                for (int k2 = 0; k2 < 4; ++k2)
#pragma unroll
                                    for (int sl = 0; sl < MOE_TAIL_KS; ++sl) asm volatile("" : "+v"(t[k2][sl]));
#pragma unroll
                                for (int k2 = 0; k2 < 4; ++k2) { f32x4 v = t[k2][0];
#pragma unroll
                                    for (int sl = 1; sl < MOE_TAIL_KS; ++sl) v += t[k2][sl];
                                    const int k = 4 * kh + k2; acc[g >> 1][g & 1][k >> 1][k & 1] = v; }
                            }
                            asm volatile("" : "+v"(acc[g >> 1][g & 1][0][0]), "+v"(acc[g >> 1][g & 1][0][1]), "+v"(acc[g >> 1][g & 1][1][0]), "+v"(acc[g >> 1][g & 1][1][1]),
                                              "+v"(acc[g >> 1][g & 1][2][0]), "+v"(acc[g >> 1][g & 1][2][1]), "+v"(acc[g >> 1][g & 1][3][0]), "+v"(acc[g >> 1][g & 1][3][1]));
                        }
                        pg8::Unit ut; ST.base.decode(ST.wgid, ut);
                        const int wid_ = F.tid >> 6, ln_ = F.tid & 63;
                        E(acc, ut, wid_ >> 2, wid_ & 3, ln_ & 15, ln_ >> 4);
                    }
                    __syncthreads();
                }
#else
#pragma unroll 1
                for (int rep = 0; rep < REP_MOEDN; ++rep) pg8::gemm_phase<pg8::EpiScatter, pg8::MoeOrder<false>, true>(F.lds + RING_OFF, S, E, F.tid);
#endif
            }
        }
        if (moe) GRID_BAR(); else GROUP_BAR();
    }
    { MKFRAME(); NormIn p{}; p.src16 = (const bf16*)WSP(WS_H16); p.o2 = (bf16*)WSP(WS_O2); p.hout = KA(out); p.gain = KA(norm_final_g); norm_phase<3, true>(F, p); }
}

extern "C" void kernel_launch(void* const* d_in, const int* in_sizes, int n_in, void* d_out, int out_size, void* d_ws, size_t ws_size, hipStream_t stream) {
    static int grid = 0;
    if (grid == 0) {
        if (n_in != 19 || in_sizes[0] != T * DM || out_size != T * DM || ws_size < WS_END) { fprintf(stderr, "kernel_launch: unexpected shapes / workspace (%d inputs, in0 %d, out %d, ws %zu)\n", n_in, n_in > 0 ? in_sizes[0] : -1, out_size, ws_size); grid = -1; return; }
        int dev = 0, cus = 0, per_cu = 0;
        if (hipGetDevice(&dev) != hipSuccess || hipDeviceGetAttribute(&cus, hipDeviceAttributeMultiprocessorCount, dev) != hipSuccess) { grid = -1; return; }
        if (hipFuncSetAttribute((const void*)mk_fwd, hipFuncAttributeMaxDynamicSharedMemorySize, LDS_BYTES) != hipSuccess) { grid = -1; return; }
        if (hipOccupancyMaxActiveBlocksPerMultiprocessor(&per_cu, (const void*)mk_fwd, NTHREADS, LDS_BYTES) != hipSuccess || per_cu < 1) fprintf(stderr, "kernel_launch: occupancy query says %d\n", per_cu);
        (void)hipGetLastError();
        grid = cus - cus % 8;
        if (grid < 160) { fprintf(stderr, "kernel_launch: %d compute units: this kernel needs at least 160\n", cus); grid = -1; return; }
    }
    if (grid < 0) return;
    if (hipMemsetAsync((char*)d_ws + WS_CTL, 0, CTL_ZERO_BYTES, stream) != hipSuccess) return;
    Args a{};
    a.x = (const float*)d_in[0]; a.norm_mix_g = (const float*)d_in[1]; a.w_in = (const float*)d_in[2]; a.b_igate = (const float*)d_in[3]; a.b_fgate = (const float*)d_in[4];
    a.conv_w = (const float*)d_in[5]; a.conv_b = (const float*)d_in[6]; a.g_mlstm = (const float*)d_in[7]; a.g_sb = (const float*)d_in[8]; a.w_out = (const float*)d_in[9];
    a.norm_ffn_g = (const float*)d_in[10]; a.ffn_w_gate = (const float*)d_in[11]; a.ffn_w_up = (const float*)d_in[12]; a.ffn_w_down = (const float*)d_in[13];
    a.w_router = (const float*)d_in[14]; a.moe_w_gate = (const float*)d_in[15]; a.moe_w_up = (const float*)d_in[16]; a.moe_w_down = (const float*)d_in[17]; a.norm_final_g = (const float*)d_in[18];
    a.out = (float*)d_out; a.ws = (unsigned char*)d_ws; a.ph_lo = 0; a.ph_hi = 0;
    hipLaunchKernelGGL(mk_fwd, dim3(grid), dim3(NTHREADS), LDS_BYTES, stream, a);
}
```

```cpp
#include <hip/hip_runtime.h>
#include <cstdio>
#include <cstdint>

#ifndef REP_PRO
#define REP_PRO 1
#endif
#ifndef REP_MIX
#define REP_MIX 1
#endif
#ifndef REP_INPROJ
#define REP_INPROJ 1
#endif
#ifndef REP_DUP
#define REP_DUP 1
#endif
#ifndef REP_MOEUP
#define REP_MOEUP 1
#endif
#ifndef REP_MOEDN
#define REP_MOEDN 1
#endif
#ifndef REP_CONV
#define REP_CONV 1
#endif
#ifndef MX_LATE
#define MX_LATE 0
#endif
#ifndef ML_CHUNK
#define ML_CHUNK 1
#endif
#ifndef MOE_TAIL_KS
#define MOE_TAIL_KS 4
#endif
#ifndef CONV_NOBAR
#define CONV_NOBAR 0
#endif
#ifndef NAIVE_MIX
#define NAIVE_MIX 0
#endif

constexpr int T = 16384, DM = 1024, SEQ = 2048, NBATCH = 8, DEPTH = 4;
constexpr int PIN = 3592, NPROJ = 3584;
constexpr int FFD = 2752, FFDP = 2816, FFE = 3584, NEXP = 8;
constexpr int HM = 4, DHM = 128, HS = 8, DHS = 64;
constexpr float EPS = 1e-6f;
constexpr float LOG2E = 1.4426950408889634f;
constexpr float QS_SCALE = 0.125f * LOG2E;
constexpr float KM_SCALE = 0.08838834764831845f;
constexpr int NWAVES = 8, NTHREADS = 512;

constexpr size_t MiB = 1u << 20;
constexpr size_t WS_CTL = 0, CTL_ZERO_BYTES = 1 * MiB;
constexpr size_t WS_WIN = 1 * MiB;
constexpr size_t WS_WOUT = 29 * MiB;
constexpr size_t WS_WGU = 37 * MiB;
constexpr size_t WS_WD = 59 * MiB;
constexpr size_t WS_MGU = 70 * MiB;
constexpr size_t WS_MD = 294 * MiB;
constexpr size_t WS_Y = 406 * MiB;
constexpr size_t WS_MIXED = 438 * MiB;
constexpr size_t WS_G = 470 * MiB;
constexpr size_t WS_GA = WS_G + 512 * 1024, WS_GM = WS_GA + 256 * 1024, WS_GE = WS_GM + 256 * 1024, WS_TG = WS_GE + 256 * 1024;
constexpr size_t WS_RINFO = 472 * MiB;
constexpr size_t WS_O2 = 474 * MiB;
constexpr size_t WS_BIG = 538 * MiB;
constexpr size_t WS_PROJ = WS_BIG, WS_QKC = WS_BIG + 112 * MiB, WS_HIDM = WS_BIG;
constexpr size_t WS_U = WS_BIG + 238 * MiB;
constexpr size_t WS_NV = WS_U + 15 * MiB, WS_CM = WS_NV + 128 * 1024;
constexpr size_t WS_RREC = WS_CM + 128 * 1024, WS_CNTW = WS_RREC + 512 * 1024;
constexpr size_t WS_HID = WS_BIG + 144 * MiB;
constexpr size_t WS_H16 = WS_U + 16 * MiB;
constexpr size_t WS_RS = WS_H16 + 32 * MiB, WS_RSI = WS_RS + 64 * 1024;
constexpr size_t WS_END = WS_H16 + 33 * MiB;
constexpr int HIDM_ROWS = 2 * T + 2048;
static_assert((size_t)HIDM_ROWS * FFE * 2 <= 238 * MiB, "hidm");
constexpr int CW_TMO = 0;
constexpr int CW_CNT = 64;
constexpr int CW_BAR = 4096;
constexpr int CW_INP = 3264;
constexpr int CW_CONV = 3200;
constexpr int CW_GB = 8192;
constexpr int CW_TAIL = 2048;

constexpr int RING_OFF = 0, RING_BYTES = 131072;
constexpr int MISC_OFF = 155648;
constexpr int LDS_BYTES = 163840;

#define GAS __attribute__((address_space(1)))
#define LAS __attribute__((address_space(3)))
typedef unsigned short bf16;
typedef unsigned v4u __attribute__((ext_vector_type(4)));
typedef unsigned v2u __attribute__((ext_vector_type(2)));
typedef float f32x4 __attribute__((ext_vector_type(4)));
typedef int i32x4 __attribute__((ext_vector_type(4)));
typedef float f32x2 __attribute__((ext_vector_type(2)));
typedef short bf16x8 __attribute__((ext_vector_type(8)));
typedef GAS unsigned gu32;
#define RLX_AGENT __ATOMIC_RELAXED, __HIP_MEMORY_SCOPE_AGENT
#define LDS_WAIT() asm volatile("s_waitcnt lgkmcnt(0)" ::: "memory")
#define VM_WAIT() asm volatile("s_waitcnt vmcnt(0)" ::: "memory")

__device__ __forceinline__ unsigned f2bf(float f) { unsigned u = __builtin_bit_cast(unsigned, f); return (u + 0x7fffu + ((u >> 16) & 1u)) >> 16; }
__device__ __forceinline__ unsigned pk2(float lo, float hi) { return f2bf(lo) | (f2bf(hi) << 16); }
__device__ __forceinline__ float bf2f(unsigned b) { return __builtin_bit_cast(float, b << 16); }
__device__ __forceinline__ float bflo(unsigned w) { return __builtin_bit_cast(float, w << 16); }
__device__ __forceinline__ float bfhi(unsigned w) { return __builtin_bit_cast(float, w & 0xffff0000u); }
__device__ __forceinline__ int lane_id() { return (int)__builtin_amdgcn_mbcnt_hi(~0u, __builtin_amdgcn_mbcnt_lo(~0u, 0u)); }
#define dpp_f(old, src, ctrl, rmask) __builtin_bit_cast(float, __builtin_amdgcn_update_dpp(__builtin_bit_cast(int, (float)(old)), __builtin_bit_cast(int, (float)(src)), ctrl, rmask, 0xf, false))
__device__ __forceinline__ float sxor32(float v, int hi) { auto rr = __builtin_amdgcn_permlane32_swap(__builtin_bit_cast(unsigned, v), __builtin_bit_cast(unsigned, v), false, false);
    return __builtin_bit_cast(float, hi ? rr[0] : rr[1]); }
__device__ __forceinline__ float quad_sum(float v) { v += dpp_f(0.f, v, 0xB1, 0xf); v += dpp_f(0.f, v, 0x4E, 0xf); return v; }
__device__ __forceinline__ float oct_sum(float v, int lane) { v = quad_sum(v); const float dn = dpp_f(0.f, v, 0x114, 0xf), up = dpp_f(0.f, v, 0x104, 0xf); return v + ((lane & 4) ? dn : up); }
#define DPP_SCAN(v, OP, ID) do { v = OP(v, __builtin_bit_cast(float, __builtin_amdgcn_update_dpp(__builtin_bit_cast(int, ID), __builtin_bit_cast(int, v), 0x111, 0xf, 0xf, false))); \
    v = OP(v, __builtin_bit_cast(float, __builtin_amdgcn_update_dpp(__builtin_bit_cast(int, ID), __builtin_bit_cast(int, v), 0x112, 0xf, 0xf, false))); \
    v = OP(v, __builtin_bit_cast(float, __builtin_amdgcn_update_dpp(__builtin_bit_cast(int, ID), __builtin_bit_cast(int, v), 0x114, 0xf, 0xf, false))); \
    v = OP(v, __builtin_bit_cast(float, __builtin_amdgcn_update_dpp(__builtin_bit_cast(int, ID), __builtin_bit_cast(int, v), 0x118, 0xf, 0xf, false))); \
    v = OP(v, __builtin_bit_cast(float, __builtin_amdgcn_update_dpp(__builtin_bit_cast(int, ID), __builtin_bit_cast(int, v), 0x142, 0xa, 0xf, false))); \
    v = OP(v, __builtin_bit_cast(float, __builtin_amdgcn_update_dpp(__builtin_bit_cast(int, ID), __builtin_bit_cast(int, v), 0x143, 0xc, 0xf, false))); } while (0)
#define OP_ADD(a, b) ((a) + (b))
#define OP_MAX(a, b) fmaxf((a), (b))
__device__ __forceinline__ float wave_sum(float v) { DPP_SCAN(v, OP_ADD, 0.0f); return __builtin_bit_cast(float, __builtin_amdgcn_readlane(__builtin_bit_cast(int, v), 63)); }

namespace pg8 {
#define PG8_LAS __attribute__((address_space(3)))
typedef unsigned short bf16_t;
typedef unsigned u32x4 __attribute__((ext_vector_type(4)));
constexpr int BM = 256, BK = 64, HALF = 128, HTB = HALF * BK * 2, STAGE_BYTES = 8 * HTB, NXCD = 8, WGM = 8;

__host__ __device__ __forceinline__ int lds_byte(int r, int c) { const int st = (r >> 4) * 2 + (c >> 5), rr = r & 15, cc = c & 31, ob = rr * 64 + cc * 2; return st * 1024 + (ob ^ (((ob >> 9) & 1) << 5)); }
__host__ __device__ __forceinline__ void stage_rc(int b, int& R, int& C) { const int st = b / 1024, sb = b % 1024, swz = sb ^ (((sb >> 9) & 1) << 5); R = (st >> 1) * 16 + swz / 64; C = (st & 1) * 32 + (swz % 64) / 2; }
__host__ __device__ __forceinline__ int perm32(int rho) { const int n = rho >> 4, i = rho & 15; return 8 * (i >> 2) + 4 * n + (i & 3); }

struct Unit { int pm, pn, e, pml, nvalid; };

__device__ __forceinline__ void tile_decode(int wgid, int nM, int nN, int& pm, int& pn) {
    const int nig = WGM * nN, gid = wgid / nig, fm = gid * WGM, gsz = (nM - fm) < WGM ? (nM - fm) : WGM;
    pm = fm + ((wgid % nig) % gsz); pn = (wgid % nig) / gsz;
}
__device__ __forceinline__ int xcd_remap(int L, int nwg) { const int q = nwg / NXCD, r = nwg % NXCD, xcd = L % NXCD, off = L / NXCD; return (xcd < r ? xcd * (q + 1) : r * (q + 1) + (xcd - r) * q) + off; }

struct DenseOrder {
    static constexpr bool GATHER = false;
    const char* A; const char* B; int K, KT; int nM, nN, nwg, G, c;
    __device__ void init(const void* A_, const void* B_, int M, int N, int K_, int G_, int c_) { A = (const char*)A_; B = (const char*)B_; K = K_; KT = K_ / BK; nM = M / BM; nN = N / BM; nwg = nM * nN; G = G_; c = c_; }
    __device__ __forceinline__ bool next(int i, Unit& u) const {
        const long L = (long)i * G + c; if (L >= nwg) return false;
        const int wgid = xcd_remap((int)L, nwg); tile_decode(wgid, nM, nN, u.pm, u.pn); u.e = 0; u.pml = u.pm; u.nvalid = BM; return true;
    }
    __device__ __forceinline__ const char* a_ptr(const Unit& u) const { return A + (size_t)u.pm * ((size_t)BM * K * 2); }
    __device__ __forceinline__ const char* b_ptr(const Unit& u) const { return B + (size_t)u.pn * ((size_t)BM * K * 2); }
    __device__ __forceinline__ unsigned grow(const Unit&, int) const { return 0u; }
    __device__ __forceinline__ const unsigned* rptr(const Unit&, int) const { return nullptr; }
};
struct InprojOrder {
    static constexpr bool GATHER = false;
    const char* A; const char* B; int K, KT, nM, nN, G, c, i0, ni;
    __device__ void init(const void* A_, const void* B_, int M, int N, int K_, int G_, int c_, int i0_, int ni_) { A = (const char*)A_; B = (const char*)B_; K = K_; KT = K_ / BK; nM = M / BM; nN = N / BM; G = G_; c = c_; i0 = i0_; ni = ni_; }
    __device__ __forceinline__ bool next(int i, Unit& u) const {
        if (i >= ni) return false;
        const int off = (i0 + i) * (G >> 3) + (c >> 3); if (off >= WGM * nN) return false;
        tile_decode((c & 7) * WGM * nN + off, nM, nN, u.pm, u.pn); u.e = 0; u.pml = u.pm; u.nvalid = BM; return true;
    }
    __device__ __forceinline__ const char* a_ptr(const Unit& u) const { return A + (size_t)u.pm * ((size_t)BM * K * 2); }
    __device__ __forceinline__ const char* b_ptr(const Unit& u) const { return B + (size_t)u.pn * ((size_t)BM * K * 2); }
    __device__ __forceinline__ unsigned grow(const Unit&, int) const { return 0u; }
    __device__ __forceinline__ const unsigned* rptr(const Unit&, int) const { return nullptr; }
};
template <bool GATH> struct MoeOrder {
    static constexpr bool GATHER = GATH;
    const char* A; const char* B; int K, KT; size_t bstride; int nN, nwg, G, c; const volatile LAS int* tab; const uint2* rinfo;
    __device__ void init(const void* A_, const void* B_, size_t bstride_, int N, int K_, int G_, int c_, const volatile LAS int* tab_, const uint2* rinfo_) {
        A = (const char*)A_; B = (const char*)B_; K = K_; KT = K_ / BK; bstride = bstride_; nN = N / BM; G = G_; c = c_; tab = tab_; rinfo = rinfo_; nwg = tab_[8] * nN; }
    __device__ __forceinline__ bool next(int i, Unit& u) const {
        const long L = (long)i * G + c; if (L >= nwg) return false;
        decode(xcd_remap((int)L, nwg), u); return true;
    }
    __device__ __forceinline__ void decode(const int wgid, Unit& u) const {
        int e = 0;
#pragma unroll
        for (int j = 1; j < 8; ++j) if (wgid >= tab[j] * nN) e = j;
        const int t0 = tab[e], nMe = tab[e + 1] - t0, cnt = tab[16 + e];
        int pml, pn;
        if (GATH) {
            const int ng = (nMe + WGM - 1) / WGM, bs = nMe / ng, ex = nMe - bs * ng, big = (bs + 1) * 4;
            int w = wgid - t0 * nN, fm, gsz;
            const int cb = w / (4 * nMe); w -= cb * 4 * nMe;
            if (w < ex * big) { const int g = w / big; w -= g * big; gsz = bs + 1; fm = g * (bs + 1); }
            else { w -= ex * big; const int g = w / (bs * 4); w -= g * bs * 4; gsz = bs; fm = ex * (bs + 1) + g * bs; }
            pml = fm + w % gsz; pn = 4 * cb + w / gsz;
        } else tile_decode(wgid - t0 * nN, nMe, nN, pml, pn);
        u.e = __builtin_amdgcn_readfirstlane(e); u.pml = __builtin_amdgcn_readfirstlane(pml); u.pn = __builtin_amdgcn_readfirstlane(pn); u.pm = __builtin_amdgcn_readfirstlane(t0 + pml);
        const int nv = cnt - pml * BM; u.nvalid = __builtin_amdgcn_readfirstlane(nv < BM ? nv : BM);
    }
    __device__ __forceinline__ const char* a_ptr(const Unit& u) const { return GATH ? A : A + (size_t)u.pm * ((size_t)BM * K * 2); }
    __device__ __forceinline__ const char* b_ptr(const Unit& u) const { return B + (size_t)u.e * bstride + (size_t)u.pn * ((size_t)BM * K * 2); }
    __device__ __forceinline__ const unsigned* rptr(const Unit& u, int r) const { const int rr = r < u.nvalid ? r : u.nvalid - 1; return (const unsigned*)(rinfo + (size_t)u.e * T + (size_t)u.pml * BM + rr); }
    __device__ __forceinline__ unsigned grow(const Unit& u, int r) const {
        const int rr = r < u.nvalid ? r : u.nvalid - 1;
        const unsigned ts = rinfo[(size_t)u.e * T + (size_t)u.pml * BM + rr].x;
        return (ts >> 1) * (unsigned)(K * 2);
    }
};

__device__ __forceinline__ unsigned cvt_pk_bf16(float lo, float hi) { unsigned r; asm volatile("v_cvt_pk_bf16_f32 %0, %1, %2" : "=v"(r) : "v"(lo), "v"(hi)); return r; }

struct EpiProj {
    static constexpr bool PERM = true, RSLDS = true;
    bf16_t* O; const float* RS;
    __device__ __forceinline__ const float* rs_base(const Unit& u) const { return RS + (size_t)u.pm * BM; }
    __device__ __forceinline__ void operator()(const f32x4 (&acc)[2][2][4][2], const Unit& u, int wr, int wc, int fr, int fq, const PG8_LAS float* rsl) const {
        const int row0 = u.pm * BM + wr * 64 + fr, col0 = u.pn * BM + wc * 32 + 8 * fq;
        const float sc0 = (u.pn == 8 || u.pn == 9) ? QS_SCALE : 1.0f;
        float rsv[2][4];
#pragma unroll
        for (int ai = 0; ai < 2; ++ai)
#pragma unroll
            for (int m = 0; m < 4; ++m) rsv[ai][m] = rsl[wr * 64 + fr + ai * HALF + m * 16];
#pragma unroll
        for (int ai = 0; ai < 2; ++ai)
#pragma unroll
            for (int m = 0; m < 4; ++m) { bf16_t* rowp = O + (size_t)(row0 + ai * HALF + m * 16) * NPROJ + col0; const float sc = sc0 * rsv[ai][m];
#pragma unroll
                for (int bj = 0; bj < 2; ++bj) { const f32x4 v0 = acc[ai][bj][m][0] * sc, v1 = acc[ai][bj][m][1] * sc;
                    u32x4 w; w.x = cvt_pk_bf16(v0[0], v0[1]); w.y = cvt_pk_bf16(v0[2], v0[3]); w.z = cvt_pk_bf16(v1[0], v1[1]); w.w = cvt_pk_bf16(v1[2], v1[3]);
                    *(u32x4*)(rowp + bj * HALF) = w; } }
    }
};
struct EpiResid {
    static constexpr bool PERM = false, RSLDS = false;
    const float* Hin; float* Hout;
    __device__ __forceinline__ void operator()(const f32x4 (&acc)[2][2][4][2], const Unit& u, int wr, int wc, int fr, int fq) const {
        const int row0 = u.pm * BM + wr * 64 + fr, col0 = u.pn * BM + wc * 32 + 4 * fq;
#pragma unroll
        for (int ai = 0; ai < 2; ++ai)
#pragma unroll
            for (int mh = 0; mh < 2; ++mh) {
                f32x4 hv[2][2][2];
#pragma unroll
                for (int m2 = 0; m2 < 2; ++m2) { const size_t off = (size_t)(row0 + ai * HALF + (2 * mh + m2) * 16) * DM + col0;
#pragma unroll
                    for (int bj = 0; bj < 2; ++bj)
#pragma unroll
                        for (int n = 0; n < 2; ++n) hv[m2][bj][n] = *(const f32x4*)(Hin + off + bj * HALF + n * 16); }
                asm volatile("" : "+v"(hv[0][0][0]), "+v"(hv[0][0][1]), "+v"(hv[0][1][0]), "+v"(hv[0][1][1]), "+v"(hv[1][0][0]), "+v"(hv[1][0][1]), "+v"(hv[1][1][0]), "+v"(hv[1][1][1]));
#pragma unroll
                for (int m2 = 0; m2 < 2; ++m2) { const size_t off = (size_t)(row0 + ai * HALF + (2 * mh + m2) * 16) * DM + col0;
#pragma unroll
                    for (int bj = 0; bj < 2; ++bj)
#pragma unroll
                        for (int n = 0; n < 2; ++n) *(f32x4*)(Hout + off + bj * HALF + n * 16) = hv[m2][bj][n] + acc[ai][bj][2 * mh + m2][n]; }
            }
    }
};
template <bool XIN> struct EpiResid16 {
    static constexpr bool PERM = true, RSLDS = false;
    const float* X; bf16_t* H;
    __device__ __forceinline__ void operator()(const f32x4 (&acc)[2][2][4][2], const Unit& u, int wr, int wc, int fr, int fq) const {
        const int row0 = u.pm * BM + wr * 64 + fr, col0 = u.pn * BM + wc * 32 + 8 * fq;
#pragma unroll
        for (int ai = 0; ai < 2; ++ai) {
            u32x4 hb[4][2];
#pragma unroll
            for (int m = 0; m < 4; ++m)
#pragma unroll
                for (int bj = 0; bj < 2; ++bj) hb[m][bj] = *(const u32x4*)(H + (size_t)(row0 + ai * HALF + m * 16) * DM + col0 + bj * HALF);
            asm volatile("" : "+v"(hb[0][0]), "+v"(hb[0][1]), "+v"(hb[1][0]), "+v"(hb[1][1]), "+v"(hb[2][0]), "+v"(hb[2][1]), "+v"(hb[3][0]), "+v"(hb[3][1]));
#pragma unroll
            for (int m = 0; m < 4; ++m)
#pragma unroll
                for (int bj = 0; bj < 2; ++bj) { const u32x4 b = hb[m][bj];
                    const f32x4 h0 = (f32x4){__builtin_bit_cast(float, b.x << 16), __builtin_bit_cast(float, b.x & 0xffff0000u), __builtin_bit_cast(float, b.y << 16), __builtin_bit_cast(float, b.y & 0xffff0000u)};
                    const f32x4 h1 = (f32x4){__builtin_bit_cast(float, b.z << 16), __builtin_bit_cast(float, b.z & 0xffff0000u), __builtin_bit_cast(float, b.w << 16), __builtin_bit_cast(float, b.w & 0xffff0000u)};
                    const f32x4 r0 = h0 + acc[ai][bj][m][0], r1 = h1 + acc[ai][bj][m][1];
                    u32x4 w; w.x = cvt_pk_bf16(r0[0], r0[1]); w.y = cvt_pk_bf16(r0[2], r0[3]); w.z = cvt_pk_bf16(r1[0], r1[1]); w.w = cvt_pk_bf16(r1[2], r1[3]);
                    *(u32x4*)(H + (size_t)(row0 + ai * HALF + m * 16) * DM + col0 + bj * HALF) = w; }
        }
    }
};
__device__ __forceinline__ float silu_mul(float g, float u) { return g * u * __builtin_amdgcn_rcpf(1.0f + __builtin_amdgcn_exp2f(-g * LOG2E)); }
struct EpiSwiglu {
    static constexpr bool PERM = true, RSLDS = true;
    bf16_t* O; int ld; const float* RS; const float* RSI;
    __device__ __forceinline__ const float* rs_base(const Unit& u) const { return RSI ? RSI + (size_t)u.e * T + (size_t)u.pml * BM : RS + (size_t)u.pm * BM; }
    __device__ __forceinline__ void operator()(const f32x4 (&acc)[2][2][4][2], const Unit& u, int wr, int wc, int fr, int fq, const PG8_LAS float* rsl) const {
        const int row0 = u.pm * BM + wr * 64 + fr, col0 = u.pn * HALF + wc * 32 + 8 * fq;
        float rsv[2][4];
#pragma unroll
        for (int ai = 0; ai < 2; ++ai)
#pragma unroll
            for (int m = 0; m < 4; ++m) rsv[ai][m] = rsl[wr * 64 + fr + ai * HALF + m * 16];
#pragma unroll
        for (int ai = 0; ai < 2; ++ai)
#pragma unroll
            for (int m = 0; m < 4; ++m) { bf16_t* rowp = O + (size_t)(row0 + ai * HALF + m * 16) * ld + col0; const float rs = rsv[ai][m];
                const f32x4 g0 = acc[ai][0][m][0] * rs, g1 = acc[ai][0][m][1] * rs, u0 = acc[ai][1][m][0] * rs, u1 = acc[ai][1][m][1] * rs;
                u32x4 w; w.x = cvt_pk_bf16(silu_mul(g0[0], u0[0]), silu_mul(g0[1], u0[1])); w.y = cvt_pk_bf16(silu_mul(g0[2], u0[2]), silu_mul(g0[3], u0[3]));
                w.z = cvt_pk_bf16(silu_mul(g1[0], u1[0]), silu_mul(g1[1], u1[1])); w.w = cvt_pk_bf16(silu_mul(g1[2], u1[2]), silu_mul(g1[3], u1[3]));
                *(u32x4*)rowp = w; }
    }
};
struct EpiScatter {
    static constexpr bool PERM = true, RSLDS = false;
    bf16_t* O2; const uint2* rinfo;
    __device__ __forceinline__ void operator()(const f32x4 (&acc)[2][2][4][2], const Unit& u, int wr, int wc, int fr, int fq) const {
        const int col0 = u.pn * BM + wc * 32 + 8 * fq;
        uint2 inf[2][4];
#pragma unroll
        for (int ai = 0; ai < 2; ++ai)
#pragma unroll
            for (int m = 0; m < 4; ++m) { const int rl = ai * HALF + wr * 64 + m * 16 + fr; const int rc = rl < u.nvalid ? rl : u.nvalid - 1;
                inf[ai][m] = rinfo[(size_t)u.e * T + (size_t)u.pml * BM + rc]; }
#pragma unroll
        for (int ai = 0; ai < 2; ++ai)
#pragma unroll
            for (int m = 0; m < 4; ++m) asm volatile("" : "+v"(inf[ai][m].x), "+v"(inf[ai][m].y));
#pragma unroll
        for (int ai = 0; ai < 2; ++ai)
#pragma unroll
            for (int m = 0; m < 4; ++m) { const int rl = ai * HALF + wr * 64 + m * 16 + fr;
                if (rl < u.nvalid) { const float wgt = __builtin_bit_cast(float, inf[ai][m].y);
                    bf16_t* rowp = O2 + ((size_t)(inf[ai][m].x & 1u) * T + (size_t)(inf[ai][m].x >> 1)) * DM + col0;
#pragma unroll
                    for (int bj = 0; bj < 2; ++bj) { const f32x4 v0 = acc[ai][bj][m][0] * wgt, v1 = acc[ai][bj][m][1] * wgt;
                        u32x4 w; w.x = cvt_pk_bf16(v0[0], v0[1]); w.y = cvt_pk_bf16(v0[2], v0[3]); w.z = cvt_pk_bf16(v1[0], v1[1]); w.w = cvt_pk_bf16(v1[2], v1[3]);
                        *(u32x4*)(rowp + bj * HALF) = w; } } }
    }
};

struct MoeTailOrder {
    static constexpr bool GATHER = false;
    MoeOrder<false> base; const char* A; const char* B; int K, KT, slice, wgid; bool have;
    __device__ void init(const MoeOrder<false>& b, int nmain, int rem, int ks, int c) { base = b; A = b.A; B = b.B; K = b.K; KT = b.KT / ks; have = c < rem * ks; slice = c / (rem > 0 ? rem : 1); wgid = nmain + c % (rem > 0 ? rem : 1); }
    __device__ __forceinline__ bool next(int i, Unit& u) const { if (i != 0 || !have) return false; base.decode(wgid, u); return true; }
    __device__ __forceinline__ const char* a_ptr(const Unit& u) const { return base.a_ptr(u) + (size_t)slice * KT * (BK * 2); }
    __device__ __forceinline__ const char* b_ptr(const Unit& u) const { return base.b_ptr(u) + (size_t)slice * KT * (BK * 2); }
    __device__ __forceinline__ unsigned grow(const Unit&, int) const { return 0u; }
    __device__ __forceinline__ const unsigned* rptr(const Unit&, int) const { return nullptr; }
};
struct EpiPartial {
    static constexpr bool PERM = true, RSLDS = false;
    float* P;
    __device__ __forceinline__ void operator()(const f32x4 (&acc)[2][2][4][2], const Unit&, int wr, int wc, int fr, int fq) const {
        const int tid = (wr * 4 + wc) * 64 + fq * 16 + fr;
#pragma unroll
        for (int ai = 0; ai < 2; ++ai)
#pragma unroll
            for (int bj = 0; bj < 2; ++bj)
#pragma unroll
                for (int m = 0; m < 4; ++m)
#pragma unroll
                    for (int n = 0; n < 2; ++n) *(f32x4*)(P + ((size_t)((((ai * 2 + bj) * 4 + m) * 2 + n) * 512 + tid)) * 4) = acc[ai][bj][m][n];
    }
};

template <class Epi, class Sched, bool ALIGN_EPI>
__device__ __forceinline__ void gemm_phase(PG8_LAS unsigned char* lds, const Sched& S, const Epi& E, const int tid) {
    const int wid = __builtin_amdgcn_readfirstlane(tid >> 6), lane = tid & 63, wr = wid >> 2, wc = wid & 3, fr = lane & 15, fq = lane >> 4;
    const int K = S.K, nt = S.KT;
    constexpr bool GA = Sched::GATHER;
    unsigned voffA[2], voffB[2]; int RA[2], CA[2];
#pragma unroll
    for (int i = 0; i < 2; ++i) { int R, C; stage_rc(tid * 16 + i * 8192, R, C); const int Rb = Epi::PERM ? ((R & ~31) + perm32(R & 31)) : R;
        RA[i] = R; CA[i] = C; voffA[i] = GA ? (unsigned)(C * 2) : (unsigned)(R * K + C) * 2u; voffB[i] = (unsigned)(Rb * K + C) * 2u; }
    const size_t kstep = (size_t)(BK * 2);
    const size_t hstep = (size_t)HALF * K * 2;
    const unsigned ldsw = (unsigned)wid * 1024u;
    const int aoff = lds_byte(wr * 64 + fr, fq * 8), boff = lds_byte(wc * 32 + fr, fq * 8);
#define PG8_SA(b, h) (((b) * 2 + (h)) * HTB)
#define PG8_SB(b, h) ((4 + (b) * 2 + (h)) * HTB)
#define PG8_STAGE(bufoff, gbase, voff) do { _Pragma("unroll") for (int _i = 0; _i < 2; ++_i) \
        __builtin_amdgcn_global_load_lds((const unsigned*)((const char*)(gbase) + (voff)[_i]), (PG8_LAS unsigned*)(lds + (bufoff) + ldsw + _i * 8192), 16, 0, 0); } while (0)
#define PG8_STAGE_A(bufoff, kb, h, NX) do { if constexpr (GA) { _Pragma("unroll") for (int _i = 0; _i < 2; ++_i) { const unsigned _o = ((NX) ? gnx[h][_i] : gcu[h][_i]) + voffA[_i]; \
        __builtin_amdgcn_global_load_lds((const unsigned*)((const char*)(kb) + _o), (PG8_LAS unsigned*)(lds + (bufoff) + ldsw + _i * 8192), 16, 0, 0); } } \
        else { PG8_STAGE(bufoff, (kb) + (h) * hstep, voffA); } } while (0)
#define PG8_LDA(dst, b, h) do { _Pragma("unroll") for (int m = 0; m < 4; ++m) _Pragma("unroll") for (int k = 0; k < 2; ++k) dst[m][k] = *(const PG8_LAS bf16x8*)(lds + PG8_SA(b, h) + aoff + m * 2048 + k * 1024); } while (0)
#define PG8_LDB(dst, b, h) do { _Pragma("unroll") for (int n = 0; n < 2; ++n) _Pragma("unroll") for (int k = 0; k < 2; ++k) dst[n][k] = *(const PG8_LAS bf16x8*)(lds + PG8_SB(b, h) + boff + n * 2048 + k * 1024); } while (0)
#define PG8_MMA(ai, bj, At, Bt) do { __builtin_amdgcn_s_setprio(1); _Pragma("unroll") for (int m = 0; m < 4; ++m) _Pragma("unroll") for (int n = 0; n < 2; ++n) _Pragma("unroll") for (int k = 0; k < 2; ++k) \
        acc[ai][bj][m][n] = __builtin_amdgcn_mfma_f32_16x16x32_bf16(Bt[n][k], At[m][k], acc[ai][bj][m][n], 0, 0, 0); __builtin_amdgcn_s_setprio(0); } while (0)
#define PG8_WAIT_V(n) asm volatile("s_waitcnt vmcnt(" #n ")" ::: "memory")
#define PG8_WAIT_L(n) asm volatile("s_waitcnt lgkmcnt(" #n ")" ::: "memory")
#define PG8_BAR __builtin_amdgcn_s_barrier()
#define PG8_SCHED __builtin_amdgcn_sched_barrier(0)
    Unit cur, nxt; int ui = 0;
    if (!S.next(0, cur)) return;
#define PG8_RS_STAGE(u_, par_) do { if constexpr (Epi::RSLDS) { if (wid < 4) __builtin_amdgcn_global_load_lds((const unsigned*)(E.rs_base(u_) + wid * 64 + lane), (PG8_LAS unsigned*)(lds + STAGE_BYTES + (par_) * 1024 + wid * 256), 4, 0, 0); } } while (0)
    PG8_RS_STAGE(cur, 0);
    unsigned gcu[2][2] = {{0u, 0u}, {0u, 0u}}, gnx[2][2] = {{0u, 0u}, {0u, 0u}};
    if constexpr (GA) {
#pragma unroll
        for (int h = 0; h < 2; ++h)
#pragma unroll
            for (int i = 0; i < 2; ++i) gcu[h][i] = S.grow(cur, h * HALF + RA[i]);
    }
    f32x4 acc[2][2][4][2];
#pragma unroll
    for (int a = 0; a < 2; ++a)
#pragma unroll
        for (int b = 0; b < 2; ++b)
#pragma unroll
            for (int m = 0; m < 4; ++m)
#pragma unroll
                for (int n = 0; n < 2; ++n) acc[a][b][m][n] = (f32x4){0.f, 0.f, 0.f, 0.f};
    bf16x8 At[4][2], B0[2][2], B1[2][2];
    const char* cA = S.a_ptr(cur); const char* cB = S.b_ptr(cur);
    PG8_STAGE(PG8_SB(0, 0), cB, voffB); PG8_STAGE(PG8_SB(0, 1), cB + hstep, voffB); PG8_STAGE_A(PG8_SA(0, 0), cA, 0, false); PG8_STAGE_A(PG8_SA(0, 1), cA, 1, false);
    if (wr == 1) PG8_BAR;
    PG8_WAIT_V(2); PG8_BAR;
    PG8_STAGE(PG8_SB(1, 0), cB + kstep, voffB); PG8_STAGE_A(PG8_SA(1, 0), cA + kstep, 0, false); PG8_STAGE(PG8_SB(1, 1), cB + hstep + kstep, voffB);
    PG8_WAIT_V(6); PG8_BAR;
    for (;;) {
        const bool has_next = S.next(ui + 1, nxt);
        const char* nA = has_next ? S.a_ptr(nxt) : cA; const char* nB = has_next ? S.b_ptr(nxt) : cB;
        unsigned raw[2][2] = {{0u, 0u}, {0u, 0u}};
        if constexpr (GA) {
            if (has_next) {
#pragma unroll
                for (int h = 0; h < 2; ++h)
#pragma unroll
                    for (int i = 0; i < 2; ++i) { const unsigned* rp = S.rptr(nxt, h * HALF + RA[i]); asm volatile("global_load_dword %0, %1, off" : "=v"(raw[h][i]) : "v"(rp) : "memory"); }
            }
        }
        for (int t = 0; t < nt; t += 2) {
            const bool last = (t == nt - 2);
            if constexpr (GA) { if (last) { asm volatile("" : "+v"(raw[0][0]), "+v"(raw[0][1]), "+v"(raw[1][0]), "+v"(raw[1][1]));
#pragma unroll
                for (int h = 0; h < 2; ++h)
#pragma unroll
                    for (int i = 0; i < 2; ++i) gnx[h][i] = has_next ? (raw[h][i] >> 1) * (unsigned)(K * 2) : gcu[h][i]; } }
            const char* a1 = cA + (size_t)(t + 1) * kstep;
            const char* a2 = last ? nA : cA + (size_t)(t + 2) * kstep; const char* b2 = last ? nB : cB + (size_t)(t + 2) * kstep;
            const char* a3 = a2 + kstep; const char* b3 = b2 + kstep;
            PG8_LDB(B0, 0, 0); PG8_LDB(B1, 0, 1); PG8_SCHED; PG8_LDA(At, 0, 0); PG8_STAGE_A(PG8_SA(1, 1), a1, 1, false);
            PG8_WAIT_V(8); PG8_WAIT_L(0); PG8_BAR; PG8_MMA(0, 0, At, B0); PG8_MMA(0, 1, At, B1); PG8_BAR; PG8_SCHED;
            PG8_LDA(At, 0, 1); PG8_STAGE(PG8_SB(0, 0), b2, voffB); PG8_STAGE(PG8_SB(0, 1), b2 + hstep, voffB); PG8_STAGE_A(PG8_SA(0, 0), a2, 0, last);
            PG8_WAIT_V(8); PG8_WAIT_L(0); PG8_BAR; PG8_MMA(1, 0, At, B0); PG8_MMA(1, 1, At, B1); PG8_BAR; PG8_SCHED;
            PG8_LDB(B0, 1, 0); PG8_LDB(B1, 1, 1); PG8_SCHED; PG8_LDA(At, 1, 0); PG8_STAGE_A(PG8_SA(0, 1), a2, 1, last);
            PG8_WAIT_V(8); PG8_WAIT_L(0); PG8_BAR; PG8_MMA(0, 0, At, B0); PG8_MMA(0, 1, At, B1); PG8_BAR; PG8_SCHED;
            PG8_LDA(At, 1, 1); PG8_STAGE(PG8_SB(1, 0), b3, voffB); PG8_STAGE(PG8_SB(1, 1), b3 + hstep, voffB); PG8_STAGE_A(PG8_SA(1, 0), a3, 0, last);
            PG8_WAIT_V(8); PG8_WAIT_L(0); PG8_BAR; PG8_MMA(1, 0, At, B0); PG8_MMA(1, 1, At, B1); PG8_BAR; PG8_SCHED;
        }
        if constexpr (ALIGN_EPI) { if (wr == 0) PG8_BAR; }
        if constexpr (Epi::RSLDS) E(acc, cur, wr, wc, fr, fq, (const PG8_LAS float*)(lds + STAGE_BYTES + (ui & 1) * 1024)); else E(acc, cur, wr, wc, fr, fq);
        if (!has_next) break;
#pragma unroll
        for (int a = 0; a < 2; ++a)
#pragma unroll
            for (int b = 0; b < 2; ++b)
#pragma unroll
                for (int m = 0; m < 4; ++m)
#pragma unroll
                    for (int n = 0; n < 2; ++n) acc[a][b][m][n] = (f32x4){0.f, 0.f, 0.f, 0.f};
        cur = nxt; cA = nA; cB = nB; ++ui;
        PG8_RS_STAGE(cur, ui & 1);
        if constexpr (GA) {
#pragma unroll
            for (int h = 0; h < 2; ++h)
#pragma unroll
                for (int i = 0; i < 2; ++i) gcu[h][i] = gnx[h][i];
        }
        if constexpr (ALIGN_EPI) { if (wr == 1) PG8_BAR; }
    }
    PG8_WAIT_V(0);
    if constexpr (!ALIGN_EPI) { if (wr == 0) PG8_BAR; }
    PG8_BAR;
#undef PG8_RS_STAGE
#undef PG8_SA
#undef PG8_SB
#undef PG8_STAGE
#undef PG8_STAGE_A
#undef PG8_LDA
#undef PG8_LDB
#undef PG8_MMA
#undef PG8_WAIT_V
#undef PG8_WAIT_L
#undef PG8_BAR
#undef PG8_SCHED
}
}

#define XB_TMO      128
#define XB_XCNT(j)  (256  + 64 * (j))
#define XB_XSUB(j)  (1280 + 64 * (j))
#define XB_XGEN(j)  (2304 + 64 * (j))
#define XB_TOP      3328
#define XB_TOPGEN   3392
#define XCD_BAR_WORDS 3456
#define XB_SPIN_CAP (1u << 20)

__device__ __forceinline__ unsigned xb_ld(unsigned* p)              { return __hip_atomic_load(p, __ATOMIC_RELAXED, __HIP_MEMORY_SCOPE_AGENT); }
__device__ __forceinline__ unsigned xb_add(unsigned* p, unsigned v) { return __hip_atomic_fetch_add(p, v, __ATOMIC_RELAXED, __HIP_MEMORY_SCOPE_AGENT); }
__device__ __forceinline__ unsigned xb_xcc_id() { return (unsigned)__builtin_amdgcn_s_getreg((3 << 11) | 20) & 0xFu; }
#define XB_SPIN(cond, bar) do { unsigned _sp = 0; while (cond) { __builtin_amdgcn_s_sleep(1); \
    if ((++_sp & 255u) == 0u) { if (xb_ld(&(bar)[XB_TMO])) break; if (_sp > XB_SPIN_CAP) { atomicAdd(&(bar)[XB_TMO], 1u); break; } } } } while (0)

struct XcdBarrier { unsigned* bar; unsigned x; volatile LAS unsigned* st; };

__device__ __forceinline__ XcdBarrier xcd_barrier_post(unsigned* bar, volatile LAS unsigned* st) {
    XcdBarrier b; b.bar = bar; b.x = xb_xcc_id(); b.st = st;
    if (threadIdx.x == 0) (void)xb_add(&bar[XB_XCNT(b.x)], 1u);
    return b;
}
__device__ __forceinline__ void xcd_barrier_complete(unsigned* bar, unsigned x, unsigned& nloc, unsigned& nx) {
    const unsigned G = gridDim.x * gridDim.y * gridDim.z;
    unsigned sum, cnt, mine, sp = 0u;
    for (;;) {
        sum = 0u; cnt = 0u; mine = 0u;
#pragma unroll
        for (unsigned j = 0; j < 16; ++j) { const unsigned c = xb_ld(&bar[XB_XCNT(j)]); sum += c; cnt += (c > 0u) ? 1u : 0u; mine = (j == x) ? c : mine; }
        if (sum == G) break;
        __builtin_amdgcn_s_sleep(1);
        if ((++sp & 255u) == 0u) { if (xb_ld(&bar[XB_TMO])) break; if (sp > XB_SPIN_CAP) { atomicAdd(&bar[XB_TMO], 1u); break; } }
    }
    nloc = mine > 0u ? mine : 1u; nx = cnt > 0u ? cnt : 1u;
}
__device__ __forceinline__ void xcd_barrier(const XcdBarrier& b, const int wave_s) {
    asm volatile("s_waitcnt vmcnt(0)" ::: "memory");
    __syncthreads();
    if (wave_s == 0 && lane_id() == 0) {
        unsigned* bar = b.bar;
        __builtin_amdgcn_s_waitcnt(0);
        unsigned nloc = b.st[0], nx = b.st[1];
        if (nloc == 0u) { xcd_barrier_complete(bar, b.x, nloc, nx); b.st[0] = nloc; b.st[1] = nx; }
        const unsigned old = xb_add(&bar[XB_XSUB(b.x)], 1u);
        const unsigned gen = old / nloc;
        if (old + 1u == (gen + 1u) * nloc) {
            __builtin_amdgcn_fence(__ATOMIC_RELEASE, "agent");
            asm volatile("s_waitcnt vmcnt(0)" ::: "memory");
            const unsigned og = xb_add(&bar[XB_TOP], 1u);
            const unsigned tg = og / nx;
            if (og + 1u == (tg + 1u) * nx) xb_add(&bar[XB_TOPGEN], 1u);
            else XB_SPIN(xb_ld(&bar[XB_TOPGEN]) == tg, bar);
            __builtin_amdgcn_fence(__ATOMIC_ACQUIRE, "agent");
            xb_add(&bar[XB_XGEN(b.x)], 1u);
            asm volatile("s_waitcnt vmcnt(0)" ::: "memory");
        } else {
            XB_SPIN(xb_ld(&bar[XB_XGEN(b.x)]) == gen, bar);
            __builtin_amdgcn_fence(__ATOMIC_ACQUIRE, "agent");
            asm volatile("s_waitcnt vmcnt(0)" ::: "memory");
        }
    }
    __syncthreads();
}

#define GB_XCNT(x) (64 * (x))
#define GB_SUB(x)  (1024 + 64 * (x))
#define GB_GEN(x)  (2048 + 64 * (x))
#define GB_TOP     3072
#define GB_ASUB(x) (3136 + 32 * (x))
#define GB_ATOP    3712
__device__ __forceinline__ void group_members(gu32* gb, volatile LAS unsigned* st, const unsigned x, unsigned& nloc, unsigned& nx) {
    nloc = st[1]; nx = st[2];
    if (nloc == 0u) { nx = 0u;
        for (unsigned q = 0; q < 16; ++q) { const unsigned c = __hip_atomic_load(gb + GB_XCNT(q), __ATOMIC_RELAXED, __HIP_MEMORY_SCOPE_AGENT); nx += c > 0u ? 1u : 0u; nloc = q == x ? c : nloc; }
        nloc = nloc > 0u ? nloc : 1u; st[1] = nloc; st[2] = nx; }
}
__device__ __forceinline__ void group_arrive(gu32* gb, volatile LAS unsigned* st, const unsigned x, const unsigned r) {
    unsigned nloc, nx; group_members(gb, st, x, nloc, nx);
    const unsigned old = __hip_atomic_fetch_add(gb + GB_ASUB(x), 1u, __ATOMIC_RELAXED, __HIP_MEMORY_SCOPE_AGENT);
    if (old + 1u == r * nloc) { __builtin_amdgcn_fence(__ATOMIC_RELEASE, "agent"); asm volatile("s_waitcnt vmcnt(0)" ::: "memory");
        (void)__hip_atomic_fetch_add(gb + GB_ATOP, 1u, __ATOMIC_RELAXED, __HIP_MEMORY_SCOPE_AGENT); }
}
__device__ __forceinline__ void group_wait(gu32* gb, volatile LAS unsigned* st, const unsigned x, const unsigned r) {
    unsigned nloc, nx; group_members(gb, st, x, nloc, nx);
    unsigned sp = 0u;
    while (__hip_atomic_load(gb + GB_ATOP, __ATOMIC_RELAXED, __HIP_MEMORY_SCOPE_AGENT) < r * nx) { __builtin_amdgcn_s_sleep(1); if (++sp > (1u << 22)) break; }
    __builtin_amdgcn_fence(__ATOMIC_ACQUIRE, "agent");
}
__device__ __forceinline__ void group_barrier(gu32* gb, const int wave_s, volatile LAS unsigned* st, const unsigned x) {
    asm volatile("s_waitcnt vmcnt(0)" ::: "memory");
    __syncthreads();
    if (wave_s == 0 && lane_id() == 0) {
        unsigned nloc, nx; group_members(gb, st, x, nloc, nx);
        const unsigned r = st[0] + 1u; st[0] = r;
        const unsigned old = __hip_atomic_fetch_add(gb + GB_SUB(x), 1u, __ATOMIC_RELAXED, __HIP_MEMORY_SCOPE_AGENT);
        unsigned sp = 0u;
        if (old + 1u == r * nloc) {
            __builtin_amdgcn_fence(__ATOMIC_RELEASE, "agent");
            asm volatile("s_waitcnt vmcnt(0)" ::: "memory");
            (void)__hip_atomic_fetch_add(gb + GB_TOP, 1u, __ATOMIC_RELAXED, __HIP_MEMORY_SCOPE_AGENT);
            while (__hip_atomic_load(gb + GB_TOP, __ATOMIC_RELAXED, __HIP_MEMORY_SCOPE_AGENT) < r * nx) { __builtin_amdgcn_s_sleep(1); if (++sp > (1u << 22)) break; }
            __builtin_amdgcn_fence(__ATOMIC_ACQUIRE, "agent");
            (void)__hip_atomic_fetch_add(gb + GB_GEN(x), 1u, __ATOMIC_RELAXED, __HIP_MEMORY_SCOPE_AGENT);
        } else {
            while (__hip_atomic_load(gb + GB_GEN(x), __ATOMIC_RELAXED, __HIP_MEMORY_SCOPE_AGENT) < r) { __builtin_amdgcn_s_sleep(1); if (++sp > (1u << 22)) break; }
            __builtin_amdgcn_fence(__ATOMIC_ACQUIRE, "agent");
        }
    }
    __syncthreads();
}

struct Args {
    const float* x; const float* norm_mix_g; const float* w_in; const float* b_igate; const float* b_fgate; const float* conv_w; const float* conv_b;
    const float* g_mlstm; const float* g_sb; const float* w_out; const float* norm_ffn_g; const float* ffn_w_gate; const float* ffn_w_up; const float* ffn_w_down;
    const float* w_router; const float* moe_w_gate; const float* moe_w_up; const float* moe_w_down; const float* norm_final_g;
    float* out; unsigned char* ws; int ph_lo, ph_hi;
};
struct Frame {
    LAS unsigned char* lds; volatile LAS unsigned* MISC; gu32* ctl; int tid, lane, wave, G, bid;
};

__device__ __forceinline__ void tr_item(const float* src, int ldw, bf16* dst, int ldk, LAS float* scr, int lane, const float* gk) {
    const int c = lane & 7;
    f32x4 ga = {1.f, 1.f, 1.f, 1.f}, gb = ga;
    if (gk) { ga = *(const GAS f32x4*)(gk + 8 * c); gb = *(const GAS f32x4*)(gk + 8 * c + 4); }
    {
        const int r8 = lane >> 3, c4 = 4 * (lane & 7);
        f32x4 v[8];
#pragma unroll
        for (int i = 0; i < 8; ++i) v[i] = *(const GAS f32x4*)(src + (size_t)(8 * i + r8) * ldw + c4);
#pragma unroll
        for (int i = 0; i < 8; ++i) { LAS float* d = scr + (8 * i + r8) * 33 + c4; d[0] = v[i].x; d[1] = v[i].y; d[2] = v[i].z; d[3] = v[i].w; }
    }
    LDS_WAIT(); asm volatile("" ::: "memory");
#pragma unroll
    for (int j = 0; j < 4; ++j) { const int n = (lane >> 3) + 8 * j; const LAS float* s = scr + (8 * c) * 33 + n;
        v4u o; o.x = pk2(s[0 * 33] * ga.x, s[1 * 33] * ga.y); o.y = pk2(s[2 * 33] * ga.z, s[3 * 33] * ga.w); o.z = pk2(s[4 * 33] * gb.x, s[5 * 33] * gb.y); o.w = pk2(s[6 * 33] * gb.z, s[7 * 33] * gb.w);
        *(GAS v4u*)(dst + (size_t)n * ldk + 8 * c) = o; }
    LDS_WAIT(); asm volatile("" ::: "memory");
}
template <int ROWMAP>
__device__ __forceinline__ bool tr_matrix(int& r, const float* W, int K, int N, int ldw, int c0, bf16* dst, int ldk, int drow0, LAS float* scr, int lane, const float* g = nullptr) {
    const int nblk = N / 32, items = (K / 64) * nblk;
    if (r >= items) { r -= items; return false; }
    const int kb = r / nblk, nb = r % nblk, k0 = 64 * kb, n0 = 32 * nb;
    const int drow = ROWMAP == 0 ? drow0 + n0 : drow0 + (n0 >> 7) * 256 + (n0 & 127);
    tr_item(W + (size_t)k0 * ldw + c0 + n0, ldw, dst + (size_t)drow * ldk + k0, ldk, scr, lane, g ? g + k0 : nullptr);
    return true;
}
__device__ __forceinline__ void prologue_phase(const Args& a, Frame& F) {
    LAS float* scr = (LAS float*)(F.lds + RING_OFF + F.wave * 16384);
    unsigned char* ws = a.ws;
    const int gw = F.bid * NWAVES + F.wave, NGW = F.G * NWAVES;
    constexpr int I_IN = 16 * 112, I_OUT = 16 * 32, I_DG = 16 * 86, I_DD = 43 * 32, I_MG = 16 * 112, I_MD = 56 * 32;
    constexpr int PER_LAYER_A = I_IN + I_OUT;
    constexpr int PER_DENSE = 2 * I_DG + I_DD;
    constexpr int PER_EXP = 2 * I_MG + I_MD;
    constexpr int NITEMS = 4 * PER_LAYER_A + 2 * PER_DENSE + 16 * PER_EXP;
    for (int it = gw; it < NITEMS; it += NGW) {
        int r = it;
        if (r < 4 * PER_LAYER_A) {
            const int l = r / PER_LAYER_A; r -= l * PER_LAYER_A;
            const float* W = a.w_in + (size_t)l * DM * PIN; bf16* D = (bf16*)(ws + WS_WIN) + (size_t)l * NPROJ * DM;
            if (r < 16 * 64) { (void)tr_matrix<0>(r, W, DM, 2048, PIN, 0, D, DM, 0, scr, F.lane, a.norm_mix_g + l * DM); continue; } r -= 16 * 64;
            if (r < 16 * 48) { (void)tr_matrix<0>(r, W, DM, 1536, PIN, 2056, D, DM, 2048, scr, F.lane, a.norm_mix_g + l * DM); continue; } r -= 16 * 48;
            (void)tr_matrix<0>(r, a.w_out + (size_t)l * DM * DM, DM, DM, DM, 0, (bf16*)(ws + WS_WOUT) + (size_t)l * DM * DM, DM, 0, scr, F.lane); continue;
        }
        r -= 4 * PER_LAYER_A;
        if (r < 2 * PER_DENSE) {
            const int j = r / PER_DENSE; r -= j * PER_DENSE;
            bf16* GU = (bf16*)(ws + WS_WGU) + (size_t)j * 2 * FFDP * DM;
            if (tr_matrix<1>(r, a.ffn_w_gate + (size_t)j * DM * FFD, DM, FFD, FFD, 0, GU, DM, 0, scr, F.lane, a.norm_ffn_g + (2 * j) * DM)) continue;
            if (tr_matrix<1>(r, a.ffn_w_up + (size_t)j * DM * FFD, DM, FFD, FFD, 0, GU, DM, 128, scr, F.lane, a.norm_ffn_g + (2 * j) * DM)) continue;
            (void)tr_matrix<0>(r, a.ffn_w_down + (size_t)j * FFD * DM, FFD, DM, DM, 0, (bf16*)(ws + WS_WD) + (size_t)j * DM * FFDP, FFDP, 0, scr, F.lane); continue;
        }
        r -= 2 * PER_DENSE;
        {
            const int je = r / PER_EXP; r -= je * PER_EXP;
            bf16* GU = (bf16*)(ws + WS_MGU) + (size_t)je * 2 * FFE * DM;
            if (tr_matrix<1>(r, a.moe_w_gate + (size_t)je * DM * FFE, DM, FFE, FFE, 0, GU, DM, 0, scr, F.lane, a.norm_ffn_g + (2 * (je >> 3) + 1) * DM)) continue;
            if (tr_matrix<1>(r, a.moe_w_up + (size_t)je * DM * FFE, DM, FFE, FFE, 0, GU, DM, 128, scr, F.lane, a.norm_ffn_g + (2 * (je >> 3) + 1) * DM)) continue;
            (void)tr_matrix<0>(r, a.moe_w_down + (size_t)je * FFE * DM, FFE, DM, DM, 0, (bf16*)(ws + WS_MD) + (size_t)je * DM * FFE, FFE, 0, scr, F.lane);
        }
    }
    const int gt = F.bid * NTHREADS + F.tid, NGT = F.G * NTHREADS;
    for (int i = gt; i < 2 * 128 * (DM / 8); i += NGT) {
        const int j = i / (128 * 128), rr = (i / 128) % 128, ch = i % 128;
        const int row = 21 * 256 + (rr < 64 ? 64 + rr : 128 + rr);
        *(GAS v4u*)((bf16*)(ws + WS_WGU) + ((size_t)j * 2 * FFDP + row) * DM + ch * 8) = (v4u){0u, 0u, 0u, 0u};
    }
    for (int i = gt; i < 2 * DM * 8; i += NGT) {
        const int j = i / (DM * 8), row = (i / 8) % DM, ch = i % 8;
        *(GAS v4u*)((bf16*)(ws + WS_WD) + ((size_t)j * DM + row) * FFDP + FFD + ch * 8) = (v4u){0u, 0u, 0u, 0u};
    }
}

struct NormIn { const float* src; const bf16* o2; float* hout; const float* gain; bf16* y; const float* w8; int ld8; float* G; unsigned* cnt; uint2* rinfo; int* cntw; int* rrec; const bf16* src16; bf16* hout16; float* rs; };
template <bool B> struct RowSel { typedef f32x4 T; };
template <> struct RowSel<true> { typedef v2u T; };
template <int MODE, bool S16 = false>
__device__ __forceinline__ void norm_phase(Frame& F, const NormIn& p) {
    typedef typename RowSel<S16>::T RowT;
    LAS float* W8 = (LAS float*)(F.lds + RING_OFF);
    LAS int* lcnt = (LAS int*)(F.lds + RING_OFF + 32768);
    LAS int* lbase = lcnt + 8;
    LAS int* rec = lcnt + 16;
    f32x4 wr[(MODE == 0 || MODE == 2) ? 32 : 1];
    if (MODE == 0 || MODE == 2) {
        for (int i = F.tid; i < DM * 2; i += NTHREADS) *(LAS f32x4*)(W8 + 4 * i) = *(const GAS f32x4*)(p.w8 + (size_t)(i >> 1) * p.ld8 + 4 * (i & 1));
        __syncthreads();
#pragma unroll
        for (int j = 0; j < 4; ++j)
#pragma unroll
            for (int c = 0; c < 4; ++c) { const int k = 4 * (F.lane + 64 * j) + c; wr[(j * 4 + c) * 2] = *(const LAS f32x4*)(W8 + k * 8); wr[(j * 4 + c) * 2 + 1] = *(const LAS f32x4*)(W8 + k * 8 + 4); }
        __syncthreads();
    }
    for (int rb0 = F.bid; rb0 < T / 64; rb0 += F.G) {
        const int rb = (rb0 & 7) * 32 + (rb0 >> 3);
        RowT vn[4], vm[4]; v2u na[4], nb[4], ma[4], mb[4];
        const GAS RowT* const srcr = (S16 ? (const GAS RowT*)p.src16 : (const GAS RowT*)p.src) + F.lane;
        { const int row = rb * 64 + F.wave * 8; const GAS RowT* xr = srcr + (size_t)row * (DM / 4);
#pragma unroll
          for (int j = 0; j < 4; ++j) { vn[j] = xr[64 * j]; vm[j] = xr[64 * j + DM / 4]; }
          if (p.o2) { const GAS v2u* oa = (const GAS v2u*)(p.o2 + (size_t)row * DM) + F.lane; const GAS v2u* ob = (const GAS v2u*)(p.o2 + ((size_t)T + row) * DM) + F.lane;
#pragma unroll
              for (int j = 0; j < 4; ++j) { na[j] = oa[64 * j]; nb[j] = ob[64 * j]; ma[j] = oa[64 * j + DM / 4]; mb[j] = ob[64 * j + DM / 4]; } } }
#pragma unroll 1
        for (int i = 0; i < 8; ++i) {
            const int row = rb * 64 + F.wave * 8 + i;
            f32x4 v[4]; float s = 0.f;
#pragma unroll
            for (int j = 0; j < 4; ++j) { if constexpr (S16) { const v2u a = vn[j]; v[j] = (f32x4){bflo(a.x), bfhi(a.x), bflo(a.y), bfhi(a.y)}; } else v[j] = vn[j]; }
            if (p.o2) {
#pragma unroll
                for (int j = 0; j < 4; ++j) { const v2u a = na[j], b = nb[j];
                    v[j].x += bflo(a.x) + bflo(b.x); v[j].y += bfhi(a.x) + bfhi(b.x); v[j].z += bflo(a.y) + bflo(b.y); v[j].w += bfhi(a.y) + bfhi(b.y); }
            }
#pragma unroll
            for (int j = 0; j < 4; ++j) { vn[j] = vm[j]; na[j] = ma[j]; nb[j] = mb[j]; }
            if (i + 2 < 8) { const int rn = row + 2; const GAS RowT* xr = srcr + (size_t)rn * (DM / 4);
#pragma unroll
                for (int j = 0; j < 4; ++j) vm[j] = xr[64 * j];
                if (p.o2) { const GAS v2u* oa = (const GAS v2u*)(p.o2 + (size_t)rn * DM) + F.lane; const GAS v2u* ob = (const GAS v2u*)(p.o2 + ((size_t)T + rn) * DM) + F.lane;
#pragma unroll
                    for (int j = 0; j < 4; ++j) { ma[j] = oa[64 * j]; mb[j] = ob[64 * j]; } } }
            if (MODE != 3 && p.hout) { GAS f32x4* ho = (GAS f32x4*)(p.hout + (size_t)row * DM) + F.lane;
#pragma unroll
                for (int j = 0; j < 4; ++j) ho[64 * j] = v[j]; }
            if (MODE != 3 && p.hout16) { GAS v2u* ho = (GAS v2u*)(p.hout16 + (size_t)row * DM) + F.lane;
#pragma unroll
                for (int j = 0; j < 4; ++j) { const v2u w = (v2u){pk2(v[j].x, v[j].y), pk2(v[j].z, v[j].w)}; ho[64 * j] = w; v[j] = (f32x4){bflo(w.x), bfhi(w.x), bflo(w.y), bfhi(w.y)}; } }
#pragma unroll
            for (int j = 0; j < 4; ++j) s += (v[j].x * v[j].x + v[j].y * v[j].y) + (v[j].z * v[j].z + v[j].w * v[j].w);
            const float rstd = 1.0f / sqrtf(wave_sum(s) * (1.0f / DM) + EPS);
            const GAS f32x4* gr = (const GAS f32x4*)p.gain + F.lane;
#pragma unroll
            for (int j = 0; j < 4; ++j) { const f32x4 g = gr[64 * j]; v[j] = v[j] * rstd * g; }
            if (MODE == 3) { GAS f32x4* ho = (GAS f32x4*)(p.hout + (size_t)row * DM) + F.lane;
#pragma unroll
                for (int j = 0; j < 4; ++j) ho[64 * j] = v[j];
                continue; }
            if (F.lane == 0) ((GAS float*)p.rs)[row] = rstd;
            if (MODE == 0 || MODE == 2) {
                float d[8];
#pragma unroll
                for (int g = 0; g < 8; ++g) d[g] = 0.f;
#pragma unroll
                for (int j = 0; j < 4; ++j)
#pragma unroll
                    for (int c = 0; c < 4; ++c) { const f32x4 w0 = wr[(j * 4 + c) * 2], w1 = wr[(j * 4 + c) * 2 + 1];
                        const float yv = v[j][c];
                        d[0] += yv * w0.x; d[1] += yv * w0.y; d[2] += yv * w0.z; d[3] += yv * w0.w; d[4] += yv * w1.x; d[5] += yv * w1.y; d[6] += yv * w1.z; d[7] += yv * w1.w; }
#pragma unroll
                for (int g = 0; g < 8; ++g) d[g] = wave_sum(d[g]);
                if (MODE == 0) { if (F.lane == 0) { GAS f32x4* gp = (GAS f32x4*)(p.G + (size_t)row * 8); gp[0] = (f32x4){d[0], d[1], d[2], d[3]}; gp[1] = (f32x4){d[4], d[5], d[6], d[7]}; } }
                else {
                    int e0 = 0; float v0 = d[0];
#pragma unroll
                    for (int g = 1; g < 8; ++g) if (d[g] > v0) { v0 = d[g]; e0 = g; }
                    int e1 = -1; float v1 = -INFINITY;
#pragma unroll
                    for (int g = 0; g < 8; ++g) if (g != e0 && d[g] > v1) { v1 = d[g]; e1 = g; }
                    const float w0 = 1.0f / (1.0f + expf(v1 - v0)), w1 = 1.0f - w0;
                    if (F.lane == 0) { LAS int* rr = rec + (F.wave * 8 + i) * 6; rr[0] = e0; rr[1] = e1; rr[4] = __builtin_bit_cast(int, w0); rr[5] = __builtin_bit_cast(int, w1); }
                }
            }
        }
        if (MODE == 2) {
            __syncthreads();
            if (F.wave == 0) { const LAS int* rr = rec + F.lane * 6; const int e0 = rr[0], e1 = rr[1], row = rb * 64 + F.lane;
                const unsigned long long below = (1ull << F.lane) - 1ull;
                int lp0 = 0, lp1 = 0, mycnt = 0;
#pragma unroll
                for (int e = 0; e < 8; ++e) { const unsigned long long m0 = __ballot(e0 == e), m1 = __ballot(e1 == e);
                    const int lp = __popcll(m0 & below) + __popcll(m1 & below), ce = __popcll(m0) + __popcll(m1);
                    if (e0 == e) lp0 = lp; if (e1 == e) lp1 = lp; if (F.lane == e) mycnt = ce; }
                GAS int* ro = (GAS int*)p.rrec + (size_t)row * 6; ro[0] = e0; ro[1] = e1; ro[2] = lp0; ro[3] = lp1; ro[4] = rr[4]; ro[5] = rr[5];
                if (F.lane < 8) { ((GAS int*)p.cntw)[rb * 8 + F.lane] = mycnt; (void)__hip_atomic_fetch_add(p.cnt + F.lane, (unsigned)mycnt, __ATOMIC_RELAXED, __HIP_MEMORY_SCOPE_AGENT); } }
            __syncthreads();
        }
    }
}

__device__ __forceinline__ void route_finish(Frame& F, const int* cntw, const int* rrec, uint2* rinfo, const float* RS, float* RSI) {
    LAS float* lred = (LAS float*)(F.lds + RING_OFF);
    for (int rb0 = F.bid; rb0 < T / 64; rb0 += F.G) {
        const int rb = (rb0 & 7) * 32 + (rb0 >> 3);
        float c[8];
#pragma unroll
        for (int e = 0; e < 8; ++e) c[e] = 0.f;
        if (F.tid < rb) { const GAS i32x4* cp = (const GAS i32x4*)(cntw + F.tid * 8); const i32x4 a = cp[0], b = cp[1];
            c[0] = (float)a.x; c[1] = (float)a.y; c[2] = (float)a.z; c[3] = (float)a.w; c[4] = (float)b.x; c[5] = (float)b.y; c[6] = (float)b.z; c[7] = (float)b.w; }
#pragma unroll
        for (int e = 0; e < 8; ++e) c[e] = wave_sum(c[e]);
        if (F.lane == 0) {
#pragma unroll
            for (int e = 0; e < 8; ++e) lred[F.wave * 8 + e] = c[e]; }
        __syncthreads();
        if (F.tid < 64) { const int row = rb * 64 + F.tid; const GAS int* rr = (const GAS int*)rrec + (size_t)row * 6;
            const int e0 = rr[0], e1 = rr[1];
            float b0 = 0.f, b1 = 0.f;
#pragma unroll
            for (int w = 0; w < NWAVES; ++w) { b0 += lred[w * 8 + e0]; b1 += lred[w * 8 + e1]; }
            const int p0 = (int)b0 + rr[2], p1 = (int)b1 + rr[3];
            rinfo[(size_t)e0 * T + p0] = make_uint2((unsigned)row * 2u, (unsigned)rr[4]);
            rinfo[(size_t)e1 * T + p1] = make_uint2((unsigned)row * 2u + 1u, (unsigned)rr[5]);
            const float rsr = ((const GAS float*)RS)[row]; ((GAS float*)RSI)[(size_t)e0 * T + p0] = rsr; ((GAS float*)RSI)[(size_t)e1 * T + p1] = rsr; }
        __syncthreads();
    }
}

__device__ __forceinline__ float logsigmoid_f(float x) { return fminf(x, 0.f) - log1pf(expf(-fabsf(x))); }
__device__ __forceinline__ void gate_scan(Frame& F, int bh, const float* G, const float* b_i, const float* b_f, float* GA, float* GM, float* GE, float* TG) {
    LAS float* sc = (LAS float*)(F.lds + RING_OFF);
    const int b = bh >> 2, h = bh & 3, t0 = 4 * F.tid;
    const float bi = b_i[h], bf = b_f[h];
    float lf[4], ig[4];
#pragma unroll
    for (int j = 0; j < 4; ++j) { const float* g = G + ((size_t)b * SEQ + t0 + j) * 8; ig[j] = g[h] + bi; lf[j] = logsigmoid_f(g[4 + h] + bf); }
    float c[4]; c[0] = lf[0]; c[1] = c[0] + lf[1]; c[2] = c[1] + lf[2]; c[3] = c[2] + lf[3];
    float ws = c[3];
    DPP_SCAN(ws, OP_ADD, 0.0f);
    if (F.lane == 63) sc[F.wave] = ws;
    __syncthreads();
    float woff = 0.f;
    for (int w = 0; w < F.wave; ++w) woff += sc[w];
    const float excl = woff + ws - c[3];
    float Fc[4], av[4];
#pragma unroll
    for (int j = 0; j < 4; ++j) { Fc[j] = excl + c[j]; av[j] = ig[j] - Fc[j]; }
    float m[4]; m[0] = av[0]; m[1] = fmaxf(m[0], av[1]); m[2] = fmaxf(m[1], av[2]); m[3] = fmaxf(m[2], av[3]);
    float wm = m[3];
    DPP_SCAN(wm, OP_MAX, -INFINITY);
    if (F.lane == 63) sc[16 + F.wave] = wm;
    __syncthreads();
    float pm = -INFINITY;
    for (int w = 0; w < F.wave; ++w) pm = fmaxf(pm, sc[16 + w]);
    { float u = dpp_f(-INFINITY, wm, 0x111, 0xf);
      const float r15 = dpp_f(-INFINITY, wm, 0x142, 0xa), r31 = dpp_f(-INFINITY, wm, 0x143, 0xc);
      if ((F.lane & 15) == 0) u = (F.lane == 32) ? r31 : r15;
      pm = fmaxf(pm, u); }
    float tmx = m[3];
    tmx = fmaxf(tmx, dpp_f(-INFINITY, tmx, 0x111, 0xf)); tmx = fmaxf(tmx, dpp_f(-INFINITY, tmx, 0x112, 0xf)); tmx = fmaxf(tmx, dpp_f(-INFINITY, tmx, 0x114, 0xf)); tmx = fmaxf(tmx, dpp_f(-INFINITY, tmx, 0x118, 0xf));
    const int tbits = __builtin_bit_cast(int, tmx);
    const float t0m = __builtin_bit_cast(float, __builtin_amdgcn_readlane(tbits, 15)), t1m = __builtin_bit_cast(float, __builtin_amdgcn_readlane(tbits, 31)),
                t2m = __builtin_bit_cast(float, __builtin_amdgcn_readlane(tbits, 47)), t3m = __builtin_bit_cast(float, __builtin_amdgcn_readlane(tbits, 63));
    const int rw = F.lane >> 4; const float tm = rw == 0 ? t0m : (rw == 1 ? t1m : (rw == 2 ? t2m : t3m));
    if ((F.lane & 15) == 0) TG[bh * 32 + F.wave * 4 + rw] = tm * LOG2E;
#pragma unroll
    for (int j = 0; j < 4; ++j) { const float Mt = fmaxf(pm, m[j]); const size_t o = (size_t)bh * SEQ + t0 + j;
        GA[o] = expf(av[j] - tm); GM[o] = Mt * LOG2E; GE[o] = expf(-(Fc[j] + Mt)); }
    __syncthreads();
}

__device__ __forceinline__ void unpack8(const v4u r, float (&d)[8]) { d[0] = bflo(r.x); d[1] = bfhi(r.x); d[2] = bflo(r.y); d[3] = bfhi(r.y); d[4] = bflo(r.z); d[5] = bfhi(r.z); d[6] = bflo(r.w); d[7] = bfhi(r.w); }
__device__ __forceinline__ void conv_phase(Frame& F, const bf16* proj, const float* cw, const float* cb, bf16* qkc, const int hidx, const int nh) {
    const int cbat = F.bid & 7;
    for (int wi = F.wave * nh + hidx; wi < 144; wi += NWAVES * nh) {
        const int kpart = wi >= 128 ? 1 : 0;
        const int seg = cbat * 128 + (kpart ? 112 + (wi - 128) : wi);
        const int t0 = seg * 16, c0 = kpart * 512 + F.lane * 8;
        float w[4][8], bb[8];
#pragma unroll
        for (int tap = 0; tap < 4; ++tap) { const f32x4 a = *(const GAS f32x4*)(cw + tap * 1024 + c0), b = *(const GAS f32x4*)(cw + tap * 1024 + c0 + 4);
            w[tap][0] = a.x; w[tap][1] = a.y; w[tap][2] = a.z; w[tap][3] = a.w; w[tap][4] = b.x; w[tap][5] = b.y; w[tap][6] = b.z; w[tap][7] = b.w; }
        { const f32x4 a = *(const GAS f32x4*)(cb + c0), b = *(const GAS f32x4*)(cb + c0 + 4); bb[0] = a.x; bb[1] = a.y; bb[2] = a.z; bb[3] = a.w; bb[4] = b.x; bb[5] = b.y; bb[6] = b.z; bb[7] = b.w; }
        const float osc = kpart ? KM_SCALE : 1.0f;
        const bool first = (t0 % SEQ) == 0;
        v4u rw[19];
#pragma unroll
        for (int q = 0; q < 3; ++q) { rw[q] = (v4u){0u, 0u, 0u, 0u}; if (!first) rw[q] = *(const GAS v4u*)(proj + (size_t)(t0 - 3 + q) * NPROJ + c0); }
#pragma unroll
        for (int q = 0; q < 16; ++q) rw[3 + q] = *(const GAS v4u*)(proj + (size_t)(t0 + q) * NPROJ + c0);
        float x0[8], x1[8], x2[8];
        unpack8(rw[0], x0); unpack8(rw[1], x1); unpack8(rw[2], x2);
#pragma unroll
        for (int i = 0; i < 16; ++i) {
            float x3[8]; unpack8(rw[3 + i], x3);
            float o[8];
#pragma unroll
            for (int c = 0; c < 8; ++c) { const float yv = bb[c] + x0[c] * w[0][c] + x1[c] * w[1][c] + x2[c] * w[2][c] + x3[c] * w[3][c];
                o[c] = osc * yv * __builtin_amdgcn_rcpf(1.0f + __builtin_amdgcn_exp2f(-yv * LOG2E)); x0[c] = x1[c]; x1[c] = x2[c]; x2[c] = x3[c]; }
            *(GAS v4u*)(qkc + (size_t)(t0 + i) * DM + c0) = (v4u){pk2(o[0], o[1]), pk2(o[2], o[3]), pk2(o[4], o[5]), pk2(o[6], o[7])};
        }
    }
}

__device__ __forceinline__ void naive_sb(Frame& F, const bf16* proj, const float* g_sb, bf16* mixed) {
    LAS float* qs = (LAS float*)(F.lds + RING_OFF) + F.wave * 256;
    LAS float* ps = qs + 64;
    for (int it = F.bid * NWAVES + F.wave; it < T * HS; it += F.G * NWAVES) {
        const int h = it & 7, row = it >> 3, t = row % SEQ, rb = row - t;
        qs[F.lane] = bf2f(proj[(size_t)row * NPROJ + 2048 + h * 64 + F.lane]);
        LDS_WAIT();
        float R = 1.0f, o = 0.f;
        const int nch = (t + 63) / 64;
        for (int c = nch - 1; c >= 0; --c) {
            const int s = 64 * c + F.lane; const bool valid = s < t;
            const bf16* kr = proj + (size_t)(rb + s) * NPROJ + 2560 + h * 64;
            float z = 0.f;
#pragma unroll
            for (int d8 = 0; d8 < 8; ++d8) { const v4u kk = *(const GAS v4u*)(kr + d8 * 8); const f32x4 qa = *(const LAS f32x4*)(qs + d8 * 8), qb = *(const LAS f32x4*)(qs + d8 * 8 + 4);
                z += qa.x * bflo(kk.x) + qa.y * bfhi(kk.x) + qa.z * bflo(kk.y) + qa.w * bfhi(kk.y) + qb.x * bflo(kk.z) + qb.y * bfhi(kk.z) + qb.z * bflo(kk.w) + qb.w * bfhi(kk.w); }
            const float e = exp2f(-z); float beta = 1.0f / (1.0f + e); float omb = 1.0f - beta;
            if (!valid) { beta = 0.f; omb = 1.0f; }
            float pr = omb;
#pragma unroll
            for (int off = 1; off < 64; off <<= 1) { const float u = __shfl_down(pr, off); if (F.lane + off < 64) pr *= u; }
            float ex = __shfl_down(pr, 1); if (F.lane == 63) ex = 1.0f;
            const float a = beta * ex * R;
            R *= __shfl(pr, 0);
            ps[F.lane] = a; LDS_WAIT();
            const bf16* vr = proj + (size_t)(rb + 64 * c) * NPROJ + 3072 + h * 64 + F.lane;
#pragma unroll 8
            for (int j = 0; j < 64; ++j) o += ps[j] * bf2f(vr[(size_t)j * NPROJ]);
            LDS_WAIT();
        }
        const float ss = wave_sum(o * o) * (1.0f / 64.0f);
        const float val = o * (1.0f / sqrtf(ss + EPS)) * g_sb[h * 64 + F.lane];
        mixed[(size_t)row * DM + 512 + h * 64 + F.lane] = (bf16)f2bf(val);
    }
}
__device__ __forceinline__ void naive_mlstm(Frame& F, const bf16* proj, const bf16* qkc, const float* GA, const float* GM, const float* GE, const float* g_m, bf16* mixed) {
    LAS float* qs = (LAS float*)(F.lds + RING_OFF) + F.wave * 256;
    LAS float* ps = qs + 128;
    for (int it = F.bid * NWAVES + F.wave; it < T * HM; it += F.G * NWAVES) {
        const int h = it & 3, row = it >> 2, t = row % SEQ, rb = row - t, b = row / SEQ, bh = b * 4 + h;
        qs[F.lane] = bf2f(qkc[(size_t)row * DM + h * 128 + F.lane]); qs[64 + F.lane] = bf2f(qkc[(size_t)row * DM + h * 128 + 64 + F.lane]);
        LDS_WAIT();
        const float Mt = GM[(size_t)bh * SEQ + t];
        float den = 0.f, o0 = 0.f, o1 = 0.f;
        const int nch = t / 64 + 1;
        for (int c = 0; c < nch; ++c) {
            const int s = 64 * c + F.lane; const bool valid = s <= t;
            const bf16* kr = qkc + (size_t)(rb + s) * DM + 512 + h * 128;
            float z = 0.f;
#pragma unroll
            for (int d8 = 0; d8 < 16; ++d8) { const v4u kk = *(const GAS v4u*)(kr + d8 * 8); const f32x4 qa = *(const LAS f32x4*)(qs + d8 * 8), qb = *(const LAS f32x4*)(qs + d8 * 8 + 4);
                z += qa.x * bflo(kk.x) + qa.y * bfhi(kk.x) + qa.z * bflo(kk.y) + qa.w * bfhi(kk.y) + qb.x * bflo(kk.z) + qb.y * bfhi(kk.z) + qb.z * bflo(kk.w) + qb.w * bfhi(kk.w); }
            const float wgt = valid ? exp2f(GA[(size_t)bh * SEQ + s] - Mt) : 0.f;
            const float pv = z * wgt;
            den += pv;
            ps[F.lane] = pv; LDS_WAIT();
            const bf16* vr = proj + (size_t)(rb + 64 * c) * NPROJ + 1024 + h * 128 + F.lane;
#pragma unroll 8
            for (int j = 0; j < 64; ++j) { const float pj = ps[j]; o0 += pj * bf2f(vr[(size_t)j * NPROJ]); o1 += pj * bf2f(vr[(size_t)j * NPROJ + 64]); }
            LDS_WAIT();
        }
        den = wave_sum(den);
        const float dn = fmaxf(fabsf(den), GE[(size_t)bh * SEQ + t]);
        const float h0 = o0 / dn, h1 = o1 / dn;
        const float ss = wave_sum(h0 * h0 + h1 * h1) * (1.0f / 128.0f);
        const float rs = 1.0f / sqrtf(ss + EPS);
        const float om0 = bf2f(proj[(size_t)row * NPROJ + 1536 + h * 128 + F.lane]), om1 = bf2f(proj[(size_t)row * NPROJ + 1536 + h * 128 + 64 + F.lane]);
        const float r0 = h0 * rs * g_m[h * 128 + F.lane] / (1.0f + expf(-om0)), r1 = h1 * rs * g_m[h * 128 + 64 + F.lane] / (1.0f + expf(-om1));
        mixed[(size_t)row * DM + h * 128 + F.lane] = (bf16)f2bf(r0); mixed[(size_t)row * DM + h * 128 + 64 + F.lane] = (bf16)f2bf(r1);
    }
}

namespace mix {
typedef float f32x16 __attribute__((ext_vector_type(16)));
typedef short s16x4 __attribute__((ext_vector_type(4)));
typedef short v4i16_t __attribute__((ext_vector_type(4)));
typedef unsigned u32x4 __attribute__((ext_vector_type(4)));
typedef LAS const unsigned char* lptr;
#define MX_MFMA(a, b, c) __builtin_amdgcn_mfma_f32_32x32x16_bf16(a, b, c, 0, 0, 0)
__device__ __forceinline__ int crow(int r, int hi) { return (r & 3) + 8 * (r >> 2) + 4 * hi; }
__device__ __forceinline__ unsigned cvtpk(float lo, float hi) { unsigned r; asm("v_cvt_pk_bf16_f32 %0, %1, %2" : "=v"(r) : "v"(lo), "v"(hi)); return r; }
__device__ __forceinline__ s16x4 vtr(lptr p) { return __builtin_bit_cast(s16x4, __builtin_amdgcn_ds_read_tr16_b64_v4i16((LAS v4i16_t*)p)); }
__device__ __forceinline__ float partner(float x, int hi) { auto rr = __builtin_amdgcn_permlane32_swap(__builtin_bit_cast(unsigned, x), __builtin_bit_cast(unsigned, x), false, false);
    return __builtin_bit_cast(float, hi ? rr[0] : rr[1]); }

constexpr int STG_BYTES = 65536, GRP_BYTES = 32768, VIMG_OFF = 16384;
constexpr int EX_OFF = RING_BYTES + 1024;
constexpr int EX_GA = EX_OFF, EX_FA = EX_OFF + 1024, EX_FB = EX_OFF + 1536;

__device__ __forceinline__ void glds16(const void* g, unsigned lds_base) {
    unsigned sv; asm volatile("s_mov_b32 %0, m0\n\ts_mov_b32 m0, %2\n\ts_nop 0\n\tglobal_load_lds_dwordx4 %1, off\n\ts_mov_b32 m0, %0" : "=&s"(sv) : "v"(g), "s"(lds_base) : "memory"); }
__device__ __forceinline__ void glds4(const void* g, unsigned lds_base) {
    unsigned sv; asm volatile("s_mov_b32 %0, m0\n\ts_mov_b32 m0, %2\n\ts_nop 0\n\tglobal_load_lds_dword %1, off\n\ts_mov_b32 m0, %0" : "=&s"(sv) : "v"(g), "s"(lds_base) : "memory"); }
template <int D, bool ML>
__device__ __forceinline__ void issue_tile(unsigned gbase, unsigned gaimg, const bf16* Kp, int pk, const bf16* Vp, int pv, const float* ga, int s0, int w4, int lane) {
#pragma unroll
    for (int c = 0; c < D / 32; ++c) { const int ch = w4 + 4 * c;
        glds16(Kp + (size_t)(s0 + lane) * pk + 8 * ch, (unsigned)__builtin_amdgcn_readfirstlane(gbase + ch * 1024)); }
#pragma unroll
    for (int c = 0; c < D / 32; ++c) { const int idx = w4 + 4 * c, dp = idx >> 2, rg = idx & 3;
        glds16(Vp + (size_t)(s0 + 16 * rg + (lane >> 2)) * pv + 32 * dp + 8 * (lane & 3), (unsigned)__builtin_amdgcn_readfirstlane(gbase + VIMG_OFF + dp * 4096 + rg * 1024)); }
    if (ML) { if (w4 == 0) glds4(ga + s0 + lane, (unsigned)__builtin_amdgcn_readfirstlane(gaimg)); }
}

template <int D, bool SBK, bool MASK>
__device__ __forceinline__ void compute_tile(lptr kimg, lptr vimg, LAS const float* gat, const bf16x8 (&qr)[D / 16], f32x16 (&o)[D / 32], float& st, const float Mt, const int qrow, const int key0, const int lane) {
    const int r32 = lane & 31, hi = lane >> 5;
    f32x16 p0 = {}, p1 = {};
    const lptr kp = kimg + hi * 1024 + r32 * 16;
    {
        bf16x8 kf[D / 8];
#pragma unroll
        for (int d0 = 0; d0 < D / 16; ++d0) { kf[2 * d0] = *(LAS const bf16x8*)(kp + d0 * 2048); kf[2 * d0 + 1] = *(LAS const bf16x8*)(kp + d0 * 2048 + 512); }
        __builtin_amdgcn_sched_barrier(0);
#pragma unroll
        for (int d0 = 0; d0 < D / 16; ++d0) { p0 = MX_MFMA(kf[2 * d0], qr[d0], p0); p1 = MX_MFMA(kf[2 * d0 + 1], qr[d0], p1); }
    }
    const lptr vp = vimg + ((lane >> 4) & 1) * 32 + (lane & 3) * 8 + (4 * hi + ((lane & 15) >> 2)) * 64;
    s16x4 vlo[D / 8], vhi[D / 8];
#pragma unroll
    for (int dp = 0; dp < D / 32; ++dp)
#pragma unroll
        for (int ks = 0; ks < 4; ++ks) { vlo[dp * 4 + ks] = vtr(vp + dp * 4096 + ks * 1024); vhi[dp * 4 + ks] = vtr(vp + dp * 4096 + ks * 1024 + 512); }
    __builtin_amdgcn_sched_barrier(0);
    u32x4 pw[4];
    if constexpr (SBK) {
        float R = st;
#pragma unroll
        for (int blk = 1; blk >= 0; --blk) {
            const f32x16& X = blk ? p1 : p0; const int kb = key0 + 32 * blk;
            float bt[16], sx[16], Pg[4], Qg[4];
#pragma unroll
            for (int g = 0; g < 4; ++g) { float run = 1.f;
#pragma unroll
                for (int i = 3; i >= 0; --i) { const int r = 4 * g + i; float z = X[r]; if (MASK) z = (kb + crow(r, hi) < qrow) ? z : -INFINITY;
                    const float e = __builtin_amdgcn_exp2f(-z); const float b = __builtin_amdgcn_rcpf(1.0f + e); bt[r] = b; sx[r] = run; run *= (1.0f - b); }
                Pg[g] = run; }
#pragma unroll
            for (int g = 0; g < 4; ++g) Qg[g] = partner(Pg[g], hi);
            float a[16];
#pragma unroll
            for (int g = 3; g >= 0; --g) { const float pre = R * (hi ? 1.0f : Qg[g]);
#pragma unroll
                for (int i = 0; i < 4; ++i) a[4 * g + i] = bt[4 * g + i] * sx[4 * g + i] * pre;
                R *= Pg[g] * Qg[g]; }
            pw[2 * blk] = (u32x4){cvtpk(a[0], a[1]), cvtpk(a[2], a[3]), cvtpk(a[4], a[5]), cvtpk(a[6], a[7])};
            pw[2 * blk + 1] = (u32x4){cvtpk(a[8], a[9]), cvtpk(a[10], a[11]), cvtpk(a[12], a[13]), cvtpk(a[14], a[15])};
        }
        st = R;
    } else {
        float den = st;
#pragma unroll
        for (int blk = 0; blk < 2; ++blk) {
            const f32x16& X = blk ? p1 : p0; const int kb = key0 + 32 * blk;
            float a[16];
#pragma unroll
            for (int g = 0; g < 4; ++g) { const f32x4 gv = *(LAS const f32x4*)(gat + 32 * blk + 8 * g + 4 * hi);
#pragma unroll
                for (int i = 0; i < 4; ++i) { const int r = 4 * g + i; float p = X[r] * __builtin_amdgcn_exp2f(gv[i] - Mt); if (MASK) p = (kb + crow(r, hi) <= qrow) ? p : 0.f; den += p; a[r] = p; } }
            pw[2 * blk] = (u32x4){cvtpk(a[0], a[1]), cvtpk(a[2], a[3]), cvtpk(a[4], a[5]), cvtpk(a[6], a[7])};
            pw[2 * blk + 1] = (u32x4){cvtpk(a[8], a[9]), cvtpk(a[10], a[11]), cvtpk(a[12], a[13]), cvtpk(a[14], a[15])};
        }
        st = den;
    }
    __builtin_amdgcn_sched_barrier(0);
#pragma unroll
    for (int dp = 0; dp < D / 32; ++dp)
#pragma unroll
        for (int ks = 0; ks < 4; ++ks) { const s16x4 a = vlo[dp * 4 + ks], b = vhi[dp * 4 + ks];
            const bf16x8 vf = (bf16x8){a[0], a[1], a[2], a[3], b[0], b[1], b[2], b[3]};
            o[dp] = MX_MFMA(__builtin_bit_cast(bf16x8, pw[ks]), vf, o[dp]); }
}

template <int D, bool SBK>
__device__ __forceinline__ void attn_unit(LAS unsigned char* lds, const int tid_in, const bf16* Qp, int pq, const bf16* Kp, int pk, const bf16* Vp, int pv,
                                          const float* ga, const float* gm, const float* ge, const int qb, bf16* out, const float* gain, const bf16* om) {
    int tid = tid_in; asm volatile("" : "+v"(tid));
    const int lane = tid & 63, wid = __builtin_amdgcn_readfirstlane(tid >> 6), grp = wid >> 2, w4 = wid & 3, r32 = lane & 31, hi = lane >> 5;
    const int t0 = 128 * qb, ns = qb + 1, nt = 2 * ns;
    const int qrow = t0 + 32 * w4 + r32;
    bf16x8 qr[D / 16];
#pragma unroll
    for (int d0 = 0; d0 < D / 16; ++d0) qr[d0] = *(const GAS bf16x8*)(Qp + (size_t)qrow * pq + d0 * 16 + hi * 8);
    float Mt = 0.f; if (!SBK) Mt = gm[qrow];
    f32x16 o[D / 32];
#pragma unroll
    for (int i = 0; i < D / 32; ++i) o[i] = f32x16{};
    float st = SBK ? 1.0f : 0.0f;
    LAS unsigned char* const gb0 = lds + grp * GRP_BYTES; LAS unsigned char* const ga0 = lds + EX_GA + grp * 256;
    const unsigned gb0u = (unsigned)(size_t)gb0, ga0u = (unsigned)(size_t)ga0;
    const int tfirst = grp ? ns - 1 : nt - 1;
    issue_tile<D, !SBK>(gb0u, ga0u, Kp, pk, Vp, pv, ga, 64 * tfirst, w4, lane);
#pragma unroll
    for (int d0 = 0; d0 < D / 16; ++d0) asm volatile("" : "+v"(qr[d0]));
    asm volatile("" : "+v"(Mt));
    for (int i = 0; i < ns; ++i) {
        const int tl = tfirst - i, sb = (i & 1);
        asm volatile("s_waitcnt vmcnt(0)" ::: "memory");
        __builtin_amdgcn_s_barrier();
        asm volatile("" ::: "memory");
        if (i + 1 < ns) issue_tile<D, !SBK>(gb0u + (sb ^ 1) * STG_BYTES, ga0u + (sb ^ 1) * 512, Kp, pk, Vp, pv, ga, 64 * (tl - 1), w4, lane);
        const lptr kimg = (lptr)(gb0 + sb * STG_BYTES); LAS const float* gat = (LAS const float*)(ga0 + sb * 512);
        if (tl >= nt - 2) compute_tile<D, SBK, true>(kimg, kimg + VIMG_OFF, gat, qr, o, st, Mt, qrow, 64 * tl, lane);
        else compute_tile<D, SBK, false>(kimg, kimg + VIMG_OFF, gat, qr, o, st, Mt, qrow, 64 * tl, lane);
    }
    constexpr int PITCH = D + 4;
    LAS float* stg = (LAS float*)lds; LAS float* fA = (LAS float*)(lds + EX_FA); LAS float* fB = (LAS float*)(lds + EX_FB);
    if (!SBK) st += partner(st, hi);
    LDS_WAIT(); __builtin_amdgcn_s_barrier(); asm volatile("" ::: "memory");
    if (grp == 1) {
#pragma unroll
        for (int dp = 0; dp < D / 32; ++dp)
#pragma unroll
            for (int r = 0; r < 16; ++r) stg[(32 * w4 + crow(r, hi)) * PITCH + 32 * dp + r32] = o[dp][r];
        if (hi == 0) fB[32 * w4 + r32] = st;
    } else { if (hi == 0) fA[32 * w4 + r32] = st; }
    LDS_WAIT(); __builtin_amdgcn_s_barrier(); asm volatile("" ::: "memory");
    if (grp == 0) {
#pragma unroll
        for (int r = 0; r < 16; ++r) { const int row = 32 * w4 + crow(r, hi); const float f = SBK ? fA[row] : 1.0f;
#pragma unroll
            for (int dp = 0; dp < D / 32; ++dp) { LAS float* p = stg + row * PITCH + 32 * dp + r32; *p = o[dp][r] + f * (*p); } }
    }
    LDS_WAIT(); __builtin_amdgcn_s_barrier(); asm volatile("" ::: "memory");
    {
        constexpr int NC = D / 4;
        const int row = tid >> 2, qd = tid & 3, trow = t0 + row;
        float v[NC];
#pragma unroll
        for (int c = 0; c < NC / 4; ++c) { const f32x4 x = *(LAS const f32x4*)(stg + row * PITCH + qd * NC + 4 * c); v[4 * c] = x.x; v[4 * c + 1] = x.y; v[4 * c + 2] = x.z; v[4 * c + 3] = x.w; }
        if (!SBK) { const float den = fA[row] + fB[row]; const float inv = 1.0f / fmaxf(fabsf(den), ge[trow]);
#pragma unroll
            for (int c = 0; c < NC; ++c) v[c] *= inv; }
        float ss = 0.f;
#pragma unroll
        for (int c = 0; c < NC; ++c) ss += v[c] * v[c];
        ss += __shfl_xor(ss, 1); ss += __shfl_xor(ss, 2);
        const float rs = 1.0f / sqrtf(ss * (1.0f / D) + EPS);
        bf16* op = out + (size_t)trow * DM + qd * NC;
#pragma unroll
        for (int c8 = 0; c8 < NC / 8; ++c8) {
            float w[8];
#pragma unroll
            for (int c = 0; c < 8; ++c) w[c] = v[8 * c8 + c] * rs * gain[qd * NC + 8 * c8 + c];
            if (!SBK) { const v4u g = *(const GAS v4u*)(om + (size_t)trow * NPROJ + qd * NC + 8 * c8); float gg[8];
                gg[0] = bflo(g.x); gg[1] = bfhi(g.x); gg[2] = bflo(g.y); gg[3] = bfhi(g.y); gg[4] = bflo(g.z); gg[5] = bfhi(g.z); gg[6] = bflo(g.w); gg[7] = bfhi(g.w);
#pragma unroll
                for (int c = 0; c < 8; ++c) w[c] *= 1.0f / (1.0f + __expf(-gg[c])); }
            *(GAS v4u*)(op + 8 * c8) = (v4u){pk2(w[0], w[1]), pk2(w[2], w[3]), pk2(w[4], w[5]), pk2(w[6], w[7])};
        }
    }
    LDS_WAIT(); __builtin_amdgcn_s_barrier(); asm volatile("" ::: "memory");
}
#undef MX_MFMA
}

typedef unsigned cs_u32x2 __attribute__((ext_vector_type(2)));
constexpr int CS_PART = 4160, CS_IMG = 4 * CS_PART, CS_NV = 8 * CS_IMG;
static_assert(CS_NV + 16384 <= MISC_OFF, "chunk-state LDS map");
__device__ __forceinline__ void chunk_state_unit(Frame& F, const int bh, const int j, const bf16* proj, const float* cw, const float* cb, const float* GAw, const float* TG,
                                                 bf16* U, float* NV, float* CM, bf16* qkc) {
    using mix::f32x16; using mix::s16x4; using mix::vtr; using mix::lptr; using mix::cvtpk;
    const int b = bh >> 2, h = bh & 3, tid = F.tid, lane = F.lane, wid = F.wave;
    const size_t r0 = (size_t)b * SEQ;
    const int cg = tid & 15, kg = tid >> 4, c0 = 8 * cg, tl = kg >> 3;
    const int s0 = 256 * j + 8 * kg;
    LAS unsigned char* const img = F.lds + RING_OFF;
    const bf16* kp = proj + (r0 + s0) * NPROJ + 512 + h * 128 + c0;
    const bf16* vp = proj + (r0 + s0) * NPROJ + 1024 + h * 128 + c0;
    v4u kr[11], vr[8];
#pragma unroll
    for (int q = 0; q < 3; ++q) { kr[q] = (v4u){0u, 0u, 0u, 0u}; if (s0 > 0) kr[q] = *(const GAS v4u*)(kp + (ptrdiff_t)(q - 3) * NPROJ); }
#pragma unroll
    for (int q = 0; q < 8; ++q) { kr[3 + q] = *(const GAS v4u*)(kp + (size_t)q * NPROJ); vr[q] = *(const GAS v4u*)(vp + (size_t)q * NPROJ); }
    const f32x4 ga0 = *(const GAS f32x4*)(GAw + (size_t)bh * SEQ + s0), ga1 = *(const GAS f32x4*)(GAw + (size_t)bh * SEQ + s0 + 4);
    const float t0g = TG[bh * 32 + 4 * j], t1g = TG[bh * 32 + 4 * j + 1], t2g = TG[bh * 32 + 4 * j + 2], t3g = TG[bh * 32 + 4 * j + 3];
    const float cm = fmaxf(fmaxf(t0g, t1g), fmaxf(t2g, t3g));
    const float tf = __builtin_amdgcn_exp2f((tl == 0 ? t0g : (tl == 1 ? t1g : (tl == 2 ? t2g : t3g))) - cm);
    float w[4][8], bb[8];
#pragma unroll
    for (int tap = 0; tap < 4; ++tap) { const f32x4 x = *(const GAS f32x4*)(cw + tap * 1024 + 512 + h * 128 + c0), y = *(const GAS f32x4*)(cw + tap * 1024 + 512 + h * 128 + c0 + 4);
        w[tap][0] = x.x; w[tap][1] = x.y; w[tap][2] = x.z; w[tap][3] = x.w; w[tap][4] = y.x; w[tap][5] = y.y; w[tap][6] = y.z; w[tap][7] = y.w; }
    { const f32x4 x = *(const GAS f32x4*)(cb + 512 + h * 128 + c0), y = *(const GAS f32x4*)(cb + 512 + h * 128 + c0 + 4); bb[0] = x.x; bb[1] = x.y; bb[2] = x.z; bb[3] = x.w; bb[4] = y.x; bb[5] = y.y; bb[6] = y.z; bb[7] = y.w; }
    {
        float nvp[8];
#pragma unroll
        for (int c = 0; c < 8; ++c) nvp[c] = 0.f;
        float x0[8], x1[8], x2[8];
        unpack8(kr[0], x0); unpack8(kr[1], x1); unpack8(kr[2], x2);
        LAS unsigned char* const wp = img + tl * (2 * CS_IMG) + (cg >> 2) * CS_PART + (8 * (kg & 7)) * 64 + (cg & 3) * 16;
#pragma unroll
        for (int i = 0; i < 8; ++i) {
            float x3[8], o[8], xv[8]; unpack8(kr[3 + i], x3); unpack8(vr[i], xv);
            const float ws_ = (i < 4 ? ga0[i & 3] : ga1[i & 3]) * tf;
#pragma unroll
            for (int c = 0; c < 8; ++c) { const float yv = bb[c] + x0[c] * w[0][c] + x1[c] * w[1][c] + x2[c] * w[2][c] + x3[c] * w[3][c];
                o[c] = KM_SCALE * yv * __builtin_amdgcn_rcpf(1.0f + __builtin_amdgcn_exp2f(-yv * LOG2E)); nvp[c] += ws_ * o[c]; x0[c] = x1[c]; x1[c] = x2[c]; x2[c] = x3[c]; }
            const v4u kcv = (v4u){pk2(o[0], o[1]), pk2(o[2], o[3]), pk2(o[4], o[5]), pk2(o[6], o[7])};
            *(LAS v4u*)(wp + i * 64) = kcv;
            *(GAS v4u*)(qkc + (r0 + s0 + i) * DM + 512 + h * 128 + c0) = kcv;
            *(LAS v4u*)(wp + CS_IMG + i * 64) = (v4u){pk2(xv[0] * ws_, xv[1] * ws_), pk2(xv[2] * ws_, xv[3] * ws_), pk2(xv[4] * ws_, xv[5] * ws_), pk2(xv[6] * ws_, xv[7] * ws_)};
        }
        LAS float* np = (LAS float*)(img + CS_NV) + kg * 128 + c0;
        *(LAS f32x4*)np = (f32x4){nvp[0], nvp[1], nvp[2], nvp[3]}; *(LAS f32x4*)(np + 4) = (f32x4){nvp[4], nvp[5], nvp[6], nvp[7]};
    }
    LDS_WAIT(); __syncthreads();
    if (tid < 128) { const LAS float* np = (const LAS float*)(img + CS_NV) + tid; float nv = 0.f;
#pragma unroll
        for (int g = 0; g < 32; ++g) nv += np[g * 128];
        NV[((size_t)bh * 7 + j) * 128 + tid] = nv; }
    if (tid == 0) { CM[bh * 8 + j] = cm; if (j == 6) CM[bh * 8 + 7] = cm; }
    {
        const int hi = lane >> 5, r32 = lane & 31;
        const lptr fb = (lptr)img + ((lane >> 4) & 1) * 32 + (lane & 3) * 8 + (4 * hi + ((lane & 15) >> 2)) * 64;
        unsigned short* Uj = (unsigned short*)U + ((size_t)bh * 7 + j) * 16384;
#pragma unroll
        for (int q = 0; q < 2; ++q) { const int idx = 2 * wid + q, dpd = idx >> 2, dpe = idx & 3;
            f32x16 acc = {};
#pragma unroll
            for (int t = 0; t < 4; ++t)
#pragma unroll
                for (int ks = 0; ks < 4; ++ks) { const lptr tb = fb + t * (2 * CS_IMG) + ks * 1024;
                    const s16x4 a0 = vtr(tb + CS_IMG + dpe * CS_PART), a1 = vtr(tb + CS_IMG + dpe * CS_PART + 512), b0 = vtr(tb + dpd * CS_PART), b1 = vtr(tb + dpd * CS_PART + 512);
                    acc = __builtin_amdgcn_mfma_f32_32x32x16_bf16(((bf16x8){a0[0], a0[1], a0[2], a0[3], a1[0], a1[1], a1[2], a1[3]}), ((bf16x8){b0[0], b0[1], b0[2], b0[3], b1[0], b1[1], b1[2], b1[3]}), acc, 0, 0, 0); }
#pragma unroll
            for (int g = 0; g < 4; ++g) *(GAS cs_u32x2*)(Uj + (size_t)(32 * dpd + r32) * 128 + 32 * dpe + 8 * g + 4 * hi) = (cs_u32x2){pk2(acc[4 * g], acc[4 * g + 1]), pk2(acc[4 * g + 2], acc[4 * g + 3])};
        }
    }
    LDS_WAIT(); __syncthreads();
}

typedef const __attribute__((address_space(4))) Args* KArgs;
#define KA(field) ({ KArgs _p = kap; asm volatile("" : "+s"(_p)); _p->field; })
#define WSP(off) ((unsigned char*)KA(ws) + (off))
namespace mix2 {
using mix::f32x16; using mix::s16x4; using mix::u32x4; using mix::lptr; using mix::crow; using mix::cvtpk; using mix::vtr; using mix::partner; using mix::glds16; using mix::glds4;
#define MX_MFMA(a, b, c) __builtin_amdgcn_mfma_f32_32x32x16_bf16(a, b, c, 0, 0, 0)
constexpr int NKB = 3, NVB = 4;
constexpr int KBUF0 = 0, VBUF0 = NKB * 16384, BUFSZ = 16384, STAGE0 = (NKB + NVB) * 16384, STAGE_W = 4608;
constexpr int EX_GA = STAGE0 + 8 * STAGE_W;
constexpr int EX_DEAD = EX_GA + NVB * 256;
static_assert(EX_DEAD + 64 <= MISC_OFF, "mixer LDS map");
struct UnitP { int b, h, qb, layer; };
template <bool SBK> struct LoopPtrs { const bf16* Kp; const bf16* Vp; const float* ga; int pk, pv; };
template <bool SBK> __device__ __forceinline__ LoopPtrs<SBK> loop_ptrs(KArgs kap, const UnitP& u) {
    LoopPtrs<SBK> p; const size_t r0 = (size_t)u.b * SEQ; const bf16* proj = (const bf16*)WSP(WS_PROJ);
    if (SBK) { p.Kp = proj + r0 * NPROJ + 2560 + u.h * 64; p.Vp = proj + r0 * NPROJ + 3072 + u.h * 64; p.ga = nullptr; p.pk = NPROJ; p.pv = NPROJ; }
    else { const bf16* qkc = (const bf16*)WSP(WS_QKC); p.Kp = qkc + r0 * DM + 512 + u.h * 128; p.Vp = proj + r0 * NPROJ + 1024 + u.h * 128; p.ga = (const float*)WSP(WS_GA) + (size_t)(u.b * 4 + u.h) * SEQ; p.pk = DM; p.pv = NPROJ; }
    return p;
}

template <int D, bool ML, class LP>
__device__ __forceinline__ void issue_tile(unsigned kbuf, unsigned vbuf, unsigned gabuf, const LP& u, int s0, int wid, int lane) {
#pragma unroll
    for (int c = 0; c < D / 64; ++c) { const int ch = wid + 8 * c;
        glds16(u.Kp + (size_t)(s0 + lane) * u.pk + 8 * ch, (unsigned)__builtin_amdgcn_readfirstlane(kbuf + ch * 1024)); }
#pragma unroll
    for (int c = 0; c < D / 64; ++c) { const int idx = wid + 8 * c, dp = idx >> 2, rg = idx & 3;
        glds16(u.Vp + (size_t)(s0 + 16 * rg + (lane >> 2)) * u.pv + 32 * dp + 8 * (lane & 3), (unsigned)__builtin_amdgcn_readfirstlane(vbuf + dp * 4096 + rg * 1024)); }
    if (ML) glds4(u.ga + s0 + lane, (unsigned)__builtin_amdgcn_readfirstlane(gabuf));
}
template <int D>
__device__ __forceinline__ void qk(lptr kimg, const bf16x8 (&qr)[D / 16], f32x16& p0, f32x16& p1, const int lane) {
    const lptr kp = kimg + (lane >> 5) * 1024 + (lane & 31) * 16;
    p0 = f32x16{}; p1 = f32x16{};
#pragma unroll
    for (int hb = 0; hb < D / 64; ++hb) {
        bf16x8 kf[8];
#pragma unroll
        for (int d = 0; d < 4; ++d) { const int d0 = 4 * hb + d; kf[2 * d] = *(LAS const bf16x8*)(kp + d0 * 2048); kf[2 * d + 1] = *(LAS const bf16x8*)(kp + d0 * 2048 + 512); }
        __builtin_amdgcn_sched_barrier(0);
#pragma unroll
        for (int d = 0; d < 4; ++d) { const int d0 = 4 * hb + d; p0 = MX_MFMA(kf[2 * d], qr[d0], p0); p1 = MX_MFMA(kf[2 * d + 1], qr[d0], p1); }
        __builtin_amdgcn_sched_barrier(0);
    }
}
template <int D, bool SBK, bool MASK>
__device__ __forceinline__ void vp(lptr vimg, LAS const float* gat, const f32x16& p0, const f32x16& p1, f32x16 (&o)[D / 32], float& st, const float Mt, const int qrow, const int key0, const int lane) {
    const int hi = lane >> 5;
    const lptr vb = vimg + ((lane >> 4) & 1) * 32 + (lane & 3) * 8 + (4 * hi + ((lane & 15) >> 2)) * 64;
    constexpr int VPRE = (D == 128) ? 2 : D / 32;
    s16x4 vlo[VPRE * 4], vhi[VPRE * 4];
#pragma unroll
    for (int dp = 0; dp < VPRE; ++dp)
#pragma unroll
        for (int ks = 0; ks < 4; ++ks) { vlo[dp * 4 + ks] = vtr(vb + dp * 4096 + ks * 1024); vhi[dp * 4 + ks] = vtr(vb + dp * 4096 + ks * 1024 + 512); }
    __builtin_amdgcn_sched_barrier(0);
    u32x4 pw[4];
    if constexpr (SBK) {
        float R = st;
#pragma unroll
        for (int blk = 1; blk >= 0; --blk) {
            const f32x16& X = blk ? p1 : p0; const int kb = key0 + 32 * blk;
            float bt[16], sx[16], Pg[4], Qg[4];
#pragma unroll
            for (int g = 0; g < 4; ++g) { float run = 1.f;
#pragma unroll
                for (int i = 3; i >= 0; --i) { const int r = 4 * g + i; float z = X[r]; if (MASK) z = (kb + crow(r, hi) < qrow) ? z : -INFINITY;
                    const float e = __builtin_amdgcn_exp2f(-z); const float b = __builtin_amdgcn_rcpf(1.0f + e); bt[r] = b; sx[r] = run; run *= (1.0f - b); }
                Pg[g] = run; }
#pragma unroll
            for (int g = 0; g < 4; ++g) Qg[g] = partner(Pg[g], hi);
            float a[16];
#pragma unroll
            for (int g = 3; g >= 0; --g) { const float pre = R * (hi ? 1.0f : Qg[g]);
#pragma unroll
                for (int i = 0; i < 4; ++i) a[4 * g + i] = bt[4 * g + i] * sx[4 * g + i] * pre;
                R *= Pg[g] * Qg[g]; }
            pw[2 * blk] = (u32x4){cvtpk(a[0], a[1]), cvtpk(a[2], a[3]), cvtpk(a[4], a[5]), cvtpk(a[6], a[7])};
            pw[2 * blk + 1] = (u32x4){cvtpk(a[8], a[9]), cvtpk(a[10], a[11]), cvtpk(a[12], a[13]), cvtpk(a[14], a[15])};
        }
        st = R;
    } else {
        float den = st;
#pragma unroll
        for (int blk = 0; blk < 2; ++blk) {
            const f32x16& X = blk ? p1 : p0; const int kb = key0 + 32 * blk;
            float a[16];
#pragma unroll
            for (int g = 0; g < 4; ++g) { const f32x4 gv = *(LAS const f32x4*)(gat + 32 * blk + 8 * g + 4 * hi);
#pragma unroll
                for (int i = 0; i < 4; ++i) { const int r = 4 * g + i; float p = X[r] * (gv[i] * Mt); if (MASK) p = (kb + crow(r, hi) <= qrow) ? p : 0.f; den += p; a[r] = p; } }
            pw[2 * blk] = (u32x4){cvtpk(a[0], a[1]), cvtpk(a[2], a[3]), cvtpk(a[4], a[5]), cvtpk(a[6], a[7])};
            pw[2 * blk + 1] = (u32x4){cvtpk(a[8], a[9]), cvtpk(a[10], a[11]), cvtpk(a[12], a[13]), cvtpk(a[14], a[15])};
        }
        st = den;
    }
    __builtin_amdgcn_sched_barrier(0);
    if constexpr (VPRE < D / 32) {
#pragma unroll
        for (int dp = 0; dp < VPRE; ++dp)
#pragma unroll
            for (int ks = 0; ks < 4; ++ks) { const s16x4 a = vlo[dp * 4 + ks], b = vhi[dp * 4 + ks];
                o[dp] = MX_MFMA(__builtin_bit_cast(bf16x8, pw[ks]), ((bf16x8){a[0], a[1], a[2], a[3], b[0], b[1], b[2], b[3]}), o[dp]); }
        __builtin_amdgcn_sched_barrier(0);
        s16x4 wlo[(D / 32 - VPRE) * 4], whi[(D / 32 - VPRE) * 4];
#pragma unroll
        for (int dp = VPRE; dp < D / 32; ++dp)
#pragma unroll
            for (int ks = 0; ks < 4; ++ks) { wlo[(dp - VPRE) * 4 + ks] = vtr(vb + dp * 4096 + ks * 1024); whi[(dp - VPRE) * 4 + ks] = vtr(vb + dp * 4096 + ks * 1024 + 512); }
        __builtin_amdgcn_sched_barrier(0);
#pragma unroll
        for (int dp = VPRE; dp < D / 32; ++dp)
#pragma unroll
            for (int ks = 0; ks < 4; ++ks) { const s16x4 a = wlo[(dp - VPRE) * 4 + ks], b = whi[(dp - VPRE) * 4 + ks];
                o[dp] = MX_MFMA(__builtin_bit_cast(bf16x8, pw[ks]), ((bf16x8){a[0], a[1], a[2], a[3], b[0], b[1], b[2], b[3]}), o[dp]); }
    } else {
#pragma unroll
        for (int dp = 0; dp < D / 32; ++dp)
#pragma unroll
            for (int ks = 0; ks < 4; ++ks) { const s16x4 a = vlo[dp * 4 + ks], b = vhi[dp * 4 + ks];
                o[dp] = MX_MFMA(__builtin_bit_cast(bf16x8, pw[ks]), ((bf16x8){a[0], a[1], a[2], a[3], b[0], b[1], b[2], b[3]}), o[dp]); }
    }
}
template <int D, bool SBK, bool MASK>
__device__ __forceinline__ void valu(LAS const float* gat, const f32x16& p0, const f32x16& p1, u32x4 (&pw)[4], float& st, const float Mt, const int qrow, const int key0, const int lane) {
    const int hi = lane >> 5;
    if constexpr (SBK) {
        float R = st;
#pragma unroll
        for (int blk = 1; blk >= 0; --blk) {
            const f32x16& X = blk ? p1 : p0; const int kb = key0 + 32 * blk;
            float bt[16], sx[16], Pg[4], Qg[4];
#pragma unroll
            for (int g = 0; g < 4; ++g) { float run = 1.f;
#pragma unroll
                for (int i = 3; i >= 0; --i) { const int r = 4 * g + i; float z = X[r]; if (MASK) z = (kb + crow(r, hi) < qrow) ? z : -INFINITY;
                    const float e = __builtin_amdgcn_exp2f(-z); const float b = __builtin_amdgcn_rcpf(1.0f + e); bt[r] = b; sx[r] = run; run *= (1.0f - b); }
                Pg[g] = run; }
#pragma unroll
            for (int g = 0; g < 4; ++g) Qg[g] = partner(Pg[g], hi);
            float a[16];
#pragma unroll
            for (int g = 3; g >= 0; --g) { const float pre = R * (hi ? 1.0f : Qg[g]);
#pragma unroll
                for (int i = 0; i < 4; ++i) a[4 * g + i] = bt[4 * g + i] * sx[4 * g + i] * pre;
                R *= Pg[g] * Qg[g]; }
            pw[2 * blk] = (u32x4){cvtpk(a[0], a[1]), cvtpk(a[2], a[3]), cvtpk(a[4], a[5]), cvtpk(a[6], a[7])};
            pw[2 * blk + 1] = (u32x4){cvtpk(a[8], a[9]), cvtpk(a[10], a[11]), cvtpk(a[12], a[13]), cvtpk(a[14], a[15])};
        }
        st = R;
    } else {
        float den = st;
#pragma unroll
        for (int blk = 0; blk < 2; ++blk) {
            const f32x16& X = blk ? p1 : p0; const int kb = key0 + 32 * blk;
            float a[16];
#pragma unroll
            for (int g = 0; g < 4; ++g) { const f32x4 gv = *(LAS const f32x4*)(gat + 32 * blk + 8 * g + 4 * hi);
#pragma unroll
                for (int i = 0; i < 4; ++i) { const int r = 4 * g + i; float p = X[r] * (gv[i] * Mt); if (MASK) p = (kb + crow(r, hi) <= qrow) ? p : 0.f; den += p; a[r] = p; } }
            pw[2 * blk] = (u32x4){cvtpk(a[0], a[1]), cvtpk(a[2], a[3]), cvtpk(a[4], a[5]), cvtpk(a[6], a[7])};
            pw[2 * blk + 1] = (u32x4){cvtpk(a[8], a[9]), cvtpk(a[10], a[11]), cvtpk(a[12], a[13]), cvtpk(a[14], a[15])};
        }
        st = den;
    }
}
template <int D>
__device__ __forceinline__ void pv(lptr vimg, const u32x4 (&pw)[4], f32x16 (&o)[D / 32], const int lane) {
    const int hi = lane >> 5;
    const lptr vb = vimg + ((lane >> 4) & 1) * 32 + (lane & 3) * 8 + (4 * hi + ((lane & 15) >> 2)) * 64;
#pragma unroll
    for (int hb = 0; hb < D / 64; ++hb) {
        s16x4 vlo[8], vhi[8];
#pragma unroll
        for (int d = 0; d < 2; ++d)
#pragma unroll
            for (int ks = 0; ks < 4; ++ks) { const int dp = 2 * hb + d; vlo[d * 4 + ks] = vtr(vb + dp * 4096 + ks * 1024); vhi[d * 4 + ks] = vtr(vb + dp * 4096 + ks * 1024 + 512); }
        __builtin_amdgcn_sched_barrier(0);
#pragma unroll
        for (int d = 0; d < 2; ++d)
#pragma unroll
            for (int ks = 0; ks < 4; ++ks) { const int dp = 2 * hb + d; const s16x4 a = vlo[d * 4 + ks], b = vhi[d * 4 + ks];
                o[dp] = MX_MFMA(__builtin_bit_cast(bf16x8, pw[ks]), ((bf16x8){a[0], a[1], a[2], a[3], b[0], b[1], b[2], b[3]}), o[dp]); }
        __builtin_amdgcn_sched_barrier(0);
    }
}
__device__ __forceinline__ void ml_fused(LAS const float* gat, const f32x16& p0, const f32x16& p1, u32x4 (&pwN)[4], float& den, const float ft, const int lane,
                                         lptr vimgP, const u32x4 (&pwP)[4], f32x16 (&o)[4], const bool dopv) {
    const int hi = lane >> 5;
    const lptr vb = vimgP + ((lane >> 4) & 1) * 32 + (lane & 3) * 8 + (4 * hi + ((lane & 15) >> 2)) * 64;
    s16x4 f0a = vtr(vb), f0b = vtr(vb + 512), f1a = vtr(vb + 1024), f1b = vtr(vb + 1024 + 512);
    f32x4 gv = {};
    __builtin_amdgcn_sched_barrier(0);
#pragma unroll
    for (int k = 0; k < 16; ++k) {
        const int dp = k >> 2, ks = k & 3;
        s16x4 f2a = f0a, f2b = f0b;
        if (k + 2 < 16) { const int dn = (k + 2) >> 2, kn = (k + 2) & 3; f2a = vtr(vb + dn * 4096 + kn * 1024); f2b = vtr(vb + dn * 4096 + kn * 1024 + 512); }
        if (dopv) o[dp] = MX_MFMA(__builtin_bit_cast(bf16x8, pwP[ks]), ((bf16x8){f0a[0], f0a[1], f0a[2], f0a[3], f0b[0], f0b[1], f0b[2], f0b[3]}), o[dp]);
        const int blk = k >> 3, r = 2 * (k & 7);
        if ((k & 1) == 0) gv = *(LAS const f32x4*)(gat + 32 * blk + 8 * (r >> 2) + 4 * hi);
        const f32x16& X = blk ? p1 : p0;
        const float q0 = X[r] * (gv[r & 3] * ft), q1 = X[r + 1] * (gv[(r & 3) + 1] * ft);
        den += q0; den += q1;
        unsigned w = cvtpk(q0, q1);
        asm volatile("" : "+v"(w)); asm volatile("" : "+v"(den));
        pwN[2 * blk + ((k & 7) >> 2)][(k & 7) & 3] = w;
        f0a = f1a; f0b = f1b; f1a = f2a; f1b = f2b;
        __builtin_amdgcn_sched_barrier(0);
    }
}
__device__ __forceinline__ void ml_mask(f32x16& p0, f32x16& p1, const int qrow, const int key0, const int lane) {
    const int hi = lane >> 5;
#pragma unroll
    for (int r = 0; r < 16; ++r) { const int kk = key0 + crow(r, hi); p0[r] = (kk <= qrow) ? p0[r] : 0.f; p1[r] = (kk + 32 <= qrow) ? p1[r] : 0.f; }
}
template <int D, bool SBK>
__device__ __forceinline__ void prefetch_unit(KArgs kap, LAS unsigned char* lds, const int wave_s, const UnitP& u, bf16x8 (&qr)[D / 16], float& Mt, float& Ml, float& tgv) {
    int tid = wave_s * 64 + lane_id(); asm volatile("" : "+v"(tid));
    const int lane = tid & 63, wid = __builtin_amdgcn_readfirstlane(tid >> 6);
    const int qrow = 256 * u.qb + 32 * wid + (lane & 31), nt = 4 * (u.qb + 1);
    const unsigned l0 = (unsigned)(size_t)lds;
    const LoopPtrs<SBK> lp = loop_ptrs<SBK>(kap, u);
    issue_tile<D, !SBK>(l0 + KBUF0, l0 + VBUF0, l0 + EX_GA, lp, 64 * (nt - 1), wid, lane);
    issue_tile<D, !SBK>(l0 + KBUF0 + BUFSZ, l0 + VBUF0 + BUFSZ, l0 + EX_GA + 256, lp, 64 * (nt - 2), wid, lane);
    const size_t r0 = (size_t)u.b * SEQ;
    const bf16* Qp = SBK ? (const bf16*)WSP(WS_PROJ) + r0 * NPROJ + 2048 + u.h * 64 : (const bf16*)WSP(WS_QKC) + r0 * DM + u.h * 128; const int pq = SBK ? NPROJ : DM;
#pragma unroll
    for (int d0 = 0; d0 < D / 16; ++d0) qr[d0] = *(const GAS bf16x8*)(Qp + (size_t)qrow * pq + d0 * 16 + (lane >> 5) * 8);
    Mt = 0.f; Ml = 0.f; tgv = 0.f;
    if (!SBK) { const size_t bh = (size_t)(u.b * 4 + u.h); Mt = ((const float*)WSP(WS_GM))[bh * SEQ + qrow]; Ml = ((const float*)WSP(WS_GM))[bh * SEQ + 256 * u.qb + 255];
        tgv = ((const float*)WSP(WS_TG))[bh * 32 + (lane & 31)]; }
}
template <int D, bool SBK>
__device__ __forceinline__ void unit_run(KArgs kap, LAS unsigned char* lds, const int wave_s, const UnitP& u, const bool has_next, const UnitP& nx, bf16x8 (&qr)[D / 16], float& Mt, float& Ml, float& tgv) {
    int tid = wave_s * 64 + lane_id(); asm volatile("" : "+v"(tid));
    const LoopPtrs<SBK> lp = loop_ptrs<SBK>(kap, u);
    const int lane = tid & 63, wid = __builtin_amdgcn_readfirstlane(tid >> 6), late = MX_LATE ? (wid >> 2) : 0, r32 = lane & 31, hi = lane >> 5;
    const int t0 = 256 * u.qb, nt = 4 * (u.qb + 1), R0 = t0 + 32 * wid, qrow = R0 + r32;
    const unsigned l0 = (unsigned)(size_t)lds;
#pragma unroll
    for (int d0 = 0; d0 < D / 16; ++d0) asm volatile("" : "+v"(qr[d0]));
    asm volatile("" : "+v"(Mt)); asm volatile("" : "+v"(Ml)); asm volatile("" : "+v"(tgv));
    const float fv = SBK ? 0.f : __builtin_amdgcn_exp2f(tgv - Ml);
    const float Bt = SBK ? 1.f : __builtin_amdgcn_exp2f(Ml - Mt);
    f32x16 o[D / 32];
#pragma unroll
    for (int i = 0; i < D / 32; ++i) o[i] = f32x16{};
    float st = SBK ? 1.0f : 0.0f;
    const int nti = (!SBK && ML_CHUNK) ? 4 : nt;
    if constexpr (!SBK && ML_CHUNK) {
        __builtin_amdgcn_s_barrier();
        if (u.qb > 0) {
            const int bh = u.b * 4 + u.h;
            const float* CMp = (const float*)WSP(WS_CM) + bh * 8;
            {
                const int d = tid >> 2, dp = tid & 3;
                const unsigned short* Ub = (const unsigned short*)WSP(WS_U) + (size_t)bh * 7 * 16384 + d * 128 + dp * 32;
                v4u rr[7][4];
#pragma unroll
                for (int j = 0; j < 7; ++j) { const int jc = (j < u.qb) ? j : u.qb - 1;
#pragma unroll
                    for (int c = 0; c < 4; ++c) rr[j][c] = *(const GAS v4u*)(Ub + (size_t)jc * 16384 + 8 * c); }
                float scj[7];
                { const f32x4 c0 = *(const GAS f32x4*)CMp, c1 = *(const GAS f32x4*)(CMp + 4);
                  const float cmv[8] = {c0.x, c0.y, c0.z, c0.w, c1.x, c1.y, c1.z, c1.w};
#pragma unroll
                  for (int j = 0; j < 7; ++j) scj[j] = (j < u.qb) ? __builtin_amdgcn_exp2f(cmv[j] - Ml) : 0.f; }
                float ac[32];
#pragma unroll
                for (int c = 0; c < 32; ++c) ac[c] = 0.f;
#pragma unroll
                for (int j = 0; j < 7; ++j)
#pragma unroll
                    for (int c = 0; c < 4; ++c) { const v4u x = rr[j][c];
                        ac[8 * c + 0] += scj[j] * bflo(x.x); ac[8 * c + 1] += scj[j] * bfhi(x.x); ac[8 * c + 2] += scj[j] * bflo(x.y); ac[8 * c + 3] += scj[j] * bfhi(x.y);
                        ac[8 * c + 4] += scj[j] * bflo(x.z); ac[8 * c + 5] += scj[j] * bfhi(x.z); ac[8 * c + 6] += scj[j] * bflo(x.w); ac[8 * c + 7] += scj[j] * bfhi(x.w); }
                const int dl = d & 63, rho = (dl & 0x33) | ((dl & 4) << 1) | ((dl & 8) >> 1);
                LAS unsigned char* ip = lds + STAGE0 + (d >> 6) * 16384 + dp * 4096 + rho * 64;
#pragma unroll
                for (int c = 0; c < 4; ++c) *(LAS v4u*)(ip + 16 * c) = (v4u){cvtpk(ac[8 * c], ac[8 * c + 1]), cvtpk(ac[8 * c + 2], ac[8 * c + 3]), cvtpk(ac[8 * c + 4], ac[8 * c + 5]), cvtpk(ac[8 * c + 6], ac[8 * c + 7])};
                if (tid < 128) { const float* NVp = (const float*)WSP(WS_NV) + (size_t)bh * 7 * 128 + tid; float nn = 0.f, nvv[7];
#pragma unroll
                    for (int j = 0; j < 7; ++j) { const int jc = (j < u.qb) ? j : u.qb - 1; nvv[j] = NVp[jc * 128]; }
                    asm volatile("" : "+v"(nvv[0]), "+v"(nvv[1]), "+v"(nvv[2]), "+v"(nvv[3]), "+v"(nvv[4]), "+v"(nvv[5]), "+v"(nvv[6]));
#pragma unroll
                    for (int j = 0; j < 7; ++j) nn += scj[j] * nvv[j];
                    ((LAS float*)(lds + STAGE0 + 32768))[tid] = nn; }
            }
            LDS_WAIT(); __builtin_amdgcn_s_barrier(); asm volatile("" ::: "memory");
            {
                u32x4 qa[4], qb_[4];
#pragma unroll
                for (int c = 0; c < 4; ++c) { qa[c] = __builtin_bit_cast(u32x4, qr[c]); qb_[c] = __builtin_bit_cast(u32x4, qr[4 + c]); }
                pv<128>((lptr)(lds + STAGE0), qa, o, lane);
                pv<128>((lptr)(lds + STAGE0 + 16384), qb_, o, lane);
                LAS const float* nvl = (LAS const float*)(lds + STAGE0 + 32768);
                float dn = 0.f;
#pragma unroll
                for (int d0 = 0; d0 < 8; ++d0) { const f32x4 n0 = *(LAS const f32x4*)(nvl + 16 * d0 + 8 * hi), n1 = *(LAS const f32x4*)(nvl + 16 * d0 + 8 * hi + 4); const u32x4 qq = __builtin_bit_cast(u32x4, qr[d0]);
                    dn += bflo(qq.x) * n0.x + bfhi(qq.x) * n0.y + bflo(qq.y) * n0.z + bfhi(qq.y) * n0.w + bflo(qq.z) * n1.x + bfhi(qq.z) * n1.y + bflo(qq.w) * n1.z + bfhi(qq.w) * n1.w; }
                st = dn;
            }
        }
    }
    f32x16 p0 = {}, p1 = {};
    u32x4 pwP[4] = {}; bool havep = false;
    LAS unsigned* const dflag = (LAS unsigned*)(lds + EX_DEAD);
    if (SBK) { if (lane == 0) dflag[wid] = 0u; }
    int k3 = 0, v4 = 0;
    bool wdead = false;
    for (int i = 0; i < nti + MX_LATE; ++i) {
        if (i + 1 < nti) { if (D == 64) asm volatile("s_waitcnt vmcnt(2)" ::: "memory"); else asm volatile("s_waitcnt vmcnt(5)" ::: "memory"); }
        else asm volatile("s_waitcnt vmcnt(0)" ::: "memory");
        if (SBK) LDS_WAIT();
        __builtin_amdgcn_s_barrier();
        asm volatile("" ::: "memory");
        if (SBK && i > 0) { const u32x4 d0 = *(LAS const u32x4*)dflag, d1 = *(LAS const u32x4*)(dflag + 4);
            if (__builtin_amdgcn_readfirstlane((int)(d0.x & d0.y & d0.z & d0.w & d1.x & d1.y & d1.z & d1.w)) != 0) break; }
        if (i + 2 < nti) { const int k3n = (k3 == 0) ? 2 : k3 - 1, v4n = (v4 + 2) & 3;
            issue_tile<D, !SBK>(l0 + KBUF0 + k3n * BUFSZ, l0 + VBUF0 + v4n * BUFSZ, l0 + EX_GA + v4n * 256, lp, 64 * (nt - 3 - i), wid, lane); }
        const int v4p = (v4 + 3) & 3;
        const int tv = late ? nt - i : nt - 1 - i;
        const int vb = late ? v4p : v4;
        const bool dov = late ? (i >= 1) : (i < nti);
        const int tq = nt - 1 - i;
        const bool doq = (i < nti) && (SBK ? (64 * tq < R0 + 31) : (64 * tq <= R0 + 31));
        const lptr kimg = (lptr)(lds + KBUF0 + k3 * BUFSZ);
        if (!late && doq && !wdead) qk<D>(kimg, qr, p0, p1, lane);
        if constexpr (!SBK) {
            if (doq) {
                const float ft = __builtin_bit_cast(float, __builtin_amdgcn_readlane(__builtin_bit_cast(int, fv), tq));
                const bool unm = (64 * tq + 63 <= R0);
                LAS const float* gat = (LAS const float*)(lds + EX_GA + v4 * 256); const lptr vprev = (lptr)(lds + VBUF0 + v4p * BUFSZ);
                u32x4 pwN[4];
                if (!unm) ml_mask(p0, p1, qrow, 64 * tq, lane);
                ml_fused(gat, p0, p1, pwN, st, ft, lane, vprev, pwP, o, havep);
#pragma unroll
                for (int q_ = 0; q_ < 4; ++q_) pwP[q_] = pwN[q_];
                havep = true;
            }
        } else
        if (dov) {
            const bool live = SBK ? (64 * tv < R0 + 31) : (64 * tv <= R0 + 31);
            const bool unm = SBK ? (64 * tv + 63 < R0) : (64 * tv + 63 <= R0);
            const lptr vimg = (lptr)(lds + VBUF0 + vb * BUFSZ); LAS const float* gat = (LAS const float*)(lds + EX_GA + vb * 256);
            if (live && !wdead) { const float ft = SBK ? 0.f : __builtin_bit_cast(float, __builtin_amdgcn_readlane(__builtin_bit_cast(int, fv), tv));
                if (unm) vp<D, SBK, false>(vimg, gat, p0, p1, o, st, ft, qrow, 64 * tv, lane); else vp<D, SBK, true>(vimg, gat, p0, p1, o, st, ft, qrow, 64 * tv, lane);
                if (SBK) { const bool dead = (__ballot(st != 0.0f) == 0ull); if (lane == 0) dflag[wid] = dead ? 1u : 0u; wdead = dead; } }
        }
        if (late && doq) qk<D>(kimg, qr, p0, p1, lane);
        k3 = (k3 == 2) ? 0 : k3 + 1; v4 = (v4 + 1) & 3;
    }
    if constexpr (!SBK) { if (havep) pv<D>((lptr)(lds + VBUF0 + ((nt - 1) & 3) * BUFSZ), pwP, o, lane); }
    LDS_WAIT(); __builtin_amdgcn_s_barrier(); asm volatile("" ::: "memory");
    const float ge_q = SBK ? 0.f : ((const float*)WSP(WS_GE))[(size_t)(u.b * 4 + u.h) * SEQ + qrow];
    if (has_next) prefetch_unit<D, SBK>(kap, lds, wave_s, nx, qr, Mt, Ml, tgv);
    const size_t er0 = (size_t)u.b * SEQ;
    bf16* const e_out = (bf16*)WSP(WS_MIXED) + er0 * DM + (SBK ? 512 + u.h * 64 : u.h * 128);
    const float* const e_gain = SBK ? KA(g_sb) + u.layer * 512 + u.h * 64 : KA(g_mlstm) + u.layer * 512 + u.h * 128;
    const bf16* const e_om = (const bf16*)WSP(WS_PROJ) + er0 * NPROJ + 1536 + u.h * 128;
    LAS float* stg = (LAS float*)(lds + STAGE0 + wid * STAGE_W); LAS float* wsf = stg + 1088;
    if (!SBK) { const float den = (st + partner(st, hi)) * Bt; if (hi == 0) wsf[r32] = Bt / fmaxf(fabsf(den), ge_q); }
    constexpr int RP = (D == 64) ? 16 : 8, NPASS = 32 / RP, LPR = 64 / RP, PITCH = D + 4, RPP = 16 / NPASS;
    const int rl = lane / LPR, seg = lane % LPR;
    float gn[16];
#pragma unroll
    for (int c = 0; c < 4; ++c) { const f32x4 g = *(const GAS f32x4*)(e_gain + 16 * seg + 4 * c); gn[4 * c] = g.x; gn[4 * c + 1] = g.y; gn[4 * c + 2] = g.z; gn[4 * c + 3] = g.w; }
    v4u gpre[SBK ? 1 : NPASS][2];
    if constexpr (!SBK) {
#pragma unroll
        for (int ps = 0; ps < NPASS; ++ps) { const int gr_ = R0 + ps * RP + rl; gpre[ps][0] = *(const GAS v4u*)(e_om + (size_t)gr_ * NPROJ + 16 * seg); gpre[ps][1] = *(const GAS v4u*)(e_om + (size_t)gr_ * NPROJ + 16 * seg + 8); }
    }
#pragma unroll
    for (int ps = 0; ps < NPASS; ++ps) {
        LDS_WAIT(); asm volatile("" ::: "memory");
#pragma unroll
        for (int rr = 0; rr < RPP; ++rr) { const int r = ps * RPP + rr; const int srow = crow(r, hi) - ps * RP;
#pragma unroll
            for (int dp = 0; dp < D / 32; ++dp) stg[srow * PITCH + 32 * dp + r32] = o[dp][r]; }
        LDS_WAIT(); asm volatile("" ::: "memory");
        float x[16];
#pragma unroll
        for (int c = 0; c < 4; ++c) { const f32x4 v4 = *(LAS const f32x4*)(stg + rl * PITCH + 16 * seg + 4 * c); x[4 * c] = v4.x; x[4 * c + 1] = v4.y; x[4 * c + 2] = v4.z; x[4 * c + 3] = v4.w; }
        const int prow = ps * RP + rl, grow = R0 + prow;
        if (!SBK) { const float inv = wsf[prow];
#pragma unroll
            for (int c = 0; c < 16; ++c) x[c] *= inv; }
        float ss = 0.f;
#pragma unroll
        for (int c = 0; c < 16; ++c) ss += x[c] * x[c];
        ss = (LPR == 8) ? oct_sum(ss, lane) : quad_sum(ss);
        const float rs = 1.0f / sqrtf(ss * (1.0f / D) + EPS);
#pragma unroll
        for (int c = 0; c < 16; ++c) x[c] *= rs * gn[c];
        if (!SBK) { const v4u g0 = gpre[SBK ? 0 : ps][0], g1 = gpre[SBK ? 0 : ps][1];
            float gg[16]; gg[0] = bflo(g0.x); gg[1] = bfhi(g0.x); gg[2] = bflo(g0.y); gg[3] = bfhi(g0.y); gg[4] = bflo(g0.z); gg[5] = bfhi(g0.z); gg[6] = bflo(g0.w); gg[7] = bfhi(g0.w);
            gg[8] = bflo(g1.x); gg[9] = bfhi(g1.x); gg[10] = bflo(g1.y); gg[11] = bfhi(g1.y); gg[12] = bflo(g1.z); gg[13] = bfhi(g1.z); gg[14] = bflo(g1.w); gg[15] = bfhi(g1.w);
#pragma unroll
            for (int c = 0; c < 16; ++c) x[c] *= 1.0f / (1.0f + __expf(-gg[c])); }
        bf16* op = e_out + (size_t)grow * DM + 16 * seg;
        *(GAS v4u*)op = (v4u){pk2(x[0], x[1]), pk2(x[2], x[3]), pk2(x[4], x[5]), pk2(x[6], x[7])};
        *(GAS v4u*)(op + 8) = (v4u){pk2(x[8], x[9]), pk2(x[10], x[11]), pk2(x[12], x[13]), pk2(x[14], x[15])};
    }
    LDS_WAIT();
}
#undef MX_MFMA
}

__device__ __forceinline__ void mixer_phase(KArgs kap, LAS unsigned char* lds, const int wave_s, const int layer) {
    int G = gridDim.x; asm volatile("" : "+s"(G)); int bid = blockIdx.x; asm volatile("" : "+s"(bid));
    for (int jb = bid; jb < 256; jb += G) {
        {
            int jb2 = jb; asm volatile("" : "+s"(jb2));
            const int b = jb2 & 7, idx = jb2 >> 3, m = idx & 7, hl = idx >> 3;
#if ML_CHUNK
            int hA, qA, hB, qB;
            if (m < 6) { const int n0 = (m * 4 + hl) * 2, n1 = n0 + 1; hA = (n0 * 37) >> 8; qA = 1 + n0 - 7 * hA; hB = (n1 * 37) >> 8; qB = 1 + n1 - 7 * hB; }
            else { const int n0 = 48 + (m - 6) * 4 + hl; hA = (n0 * 37) >> 8; qA = 1 + n0 - 7 * hA; hB = hl + 4 * (m - 6); qB = 0; }
            bf16x8 qr[4]; float Mt, Ml, tgv;
            __builtin_amdgcn_s_barrier();
            {
                const mix2::UnitP uA{b, hA, qA, layer}, uB{b, hB, qB, layer};
                mix2::prefetch_unit<64, true>(kap, lds, wave_s, uA, qr, Mt, Ml, tgv);
                mix2::unit_run<64, true>(kap, lds, wave_s, uA, true, uB, qr, Mt, Ml, tgv);
                mix2::unit_run<64, true>(kap, lds, wave_s, uB, false, uB, qr, Mt, Ml, tgv);
            }
#else
            const int nsb = (0x01122334 >> (4 * m)) & 15, st0 = (int)((0xFECA740ull >> (4 * m)) & 15ull);
            bf16x8 qr[4]; float Mt, Ml, tgv;
            __builtin_amdgcn_s_barrier();
            if (nsb > 0) {
                const int u0 = hl * 16 + st0;
                mix2::UnitP uc{b, u0 >> 3, u0 & 7, layer};
                mix2::prefetch_unit<64, true>(kap, lds, wave_s, uc, qr, Mt, Ml, tgv);
#pragma unroll 1
                for (int k = 0; k < nsb; ++k) {
                    const int un = u0 + k + 1; const mix2::UnitP nx{b, un >> 3, un & 7, layer};
                    mix2::unit_run<64, true>(kap, lds, wave_s, uc, k + 1 < nsb, nx, qr, Mt, Ml, tgv);
                    uc = nx;
                }
            }
#endif
        }
#if CONV_NOBAR
        {
            int t0_ = wave_s * 64 + lane_id();
            if (t0_ == 0) { gu32* cc = (gu32*)WSP(WS_CTL) + CW_CONV + 8 * layer + (bid & 7); unsigned sp = 0u;
                while (__hip_atomic_load(cc, __ATOMIC_RELAXED, __HIP_MEMORY_SCOPE_AGENT) < (unsigned)(G >> 3)) { __builtin_amdgcn_s_sleep(1); if (++sp > (1u << 22)) break; }
                __builtin_amdgcn_fence(__ATOMIC_ACQUIRE, "agent"); }
            __builtin_amdgcn_s_barrier();
        }
#endif
        {
            const int b = jb & 7, idx = jb >> 3, m = idx & 7, hl = idx >> 3;
            const mix2::UnitP u{b, hl, m, layer};
            bf16x8 qr[8]; float Mt, Ml, tgv;
            mix2::prefetch_unit<128, false>(kap, lds, wave_s, u, qr, Mt, Ml, tgv);
            mix2::unit_run<128, false>(kap, lds, wave_s, u, false, u, qr, Mt, Ml, tgv);
        }
        __builtin_amdgcn_s_barrier();
    }
}

#define MKFRAME() Frame F; F.lds = (LAS unsigned char*)lds; F.MISC = (volatile LAS unsigned*)(F.lds + MISC_OFF); F.tid = wave_s * 64 + lane_id(); asm volatile("" : "+v"(F.tid)); F.lane = F.tid & 63; \
    F.wave = __builtin_amdgcn_readfirstlane(F.tid >> 6); F.G = gridDim.x; asm volatile("" : "+s"(F.G)); F.bid = blockIdx.x; asm volatile("" : "+s"(F.bid)); F.ctl = (gu32*)WSP(WS_CTL)
#define GRID_BAR() do { XcdBarrier bar_; bar_.bar = (unsigned*)WSP(WS_CTL) + CW_BAR; bar_.x = xb_xcc_id(); bar_.st = (volatile LAS unsigned*)((LAS unsigned char*)lds + MISC_OFF) + 8; xcd_barrier(bar_, wave_s); } while (0)
#define GROUP_BAR() group_barrier((gu32*)WSP(WS_CTL) + CW_GB + 4096 * ((int)blockIdx.x & 7), wave_s, (volatile LAS unsigned*)((LAS unsigned char*)lds + MISC_OFF) + 24, xb_xcc_id())
#define BUILD_TAB() do { __syncthreads(); \
            if (F.tid == 0) { int acc_ = 0; for (int e = 0; e < 8; ++e) { const int c_ = (int)__hip_atomic_load(F.ctl + CW_CNT + 64 * j + e, RLX_AGENT); tab[e] = acc_; tab[16 + e] = c_; acc_ += (c_ + 255) >> 8; } tab[8] = acc_; } \
            __syncthreads(); } while (0)

__global__ void __launch_bounds__(NTHREADS, 2) mk_fwd(Args args_unused) {
    extern __shared__ __attribute__((aligned(16))) unsigned char lds[];
    KArgs kap = (KArgs)__builtin_amdgcn_kernarg_segment_ptr();
    const int wave_s = __builtin_amdgcn_readfirstlane((int)threadIdx.x >> 6);
    for (int u = threadIdx.x; u < 256; u += NTHREADS) ((LAS unsigned*)((LAS unsigned char*)lds + MISC_OFF))[u] = 0u;
    __syncthreads();
    (void)xcd_barrier_post((unsigned*)WSP(WS_CTL) + CW_BAR, (volatile LAS unsigned*)((LAS unsigned char*)lds + MISC_OFF) + 8);
    { gu32* gbp = (gu32*)WSP(WS_CTL) + CW_GB + 4096 * ((int)blockIdx.x & 7) + GB_XCNT(xb_xcc_id());
      if (threadIdx.x == 0) (void)__hip_atomic_fetch_add(gbp, 1u, __ATOMIC_RELAXED, __HIP_MEMORY_SCOPE_AGENT); }

    { MKFRAME(); Args a; a.ws = KA(ws); a.w_in = KA(w_in); a.w_out = KA(w_out); a.ffn_w_gate = KA(ffn_w_gate); a.ffn_w_up = KA(ffn_w_up); a.ffn_w_down = KA(ffn_w_down);
      a.moe_w_gate = KA(moe_w_gate); a.moe_w_up = KA(moe_w_up); a.moe_w_down = KA(moe_w_down); a.norm_mix_g = KA(norm_mix_g); a.norm_ffn_g = KA(norm_ffn_g);
#pragma unroll 1
      for (int rep = 0; rep < REP_PRO; ++rep) prologue_phase(a, F); }
    __syncthreads();
    for (int layer = 0; layer < DEPTH; ++layer) {
        const int j = layer >> 1; const bool moe = layer & 1;
        { MKFRAME();
            NormIn p{}; p.src = KA(x); p.src16 = (const bf16*)WSP(WS_H16); p.o2 = (layer == 2) ? (bf16*)WSP(WS_O2) : nullptr; p.hout16 = (layer == 0 || layer == 2) ? (bf16*)WSP(WS_H16) : nullptr; p.rs = (float*)WSP(WS_RS);
            p.gain = KA(norm_mix_g) + layer * DM; p.w8 = KA(w_in) + (size_t)layer * DM * PIN + 2048; p.ld8 = PIN; p.G = (float*)WSP(WS_G);
            if (layer == 0) norm_phase<0, false>(F, p); else norm_phase<0, true>(F, p);
        }
        if (layer == 0) GRID_BAR(); else GROUP_BAR();
        { MKFRAME();
            if (F.bid >= 128 && F.bid < 160) gate_scan(F, (F.bid & 7) * HM + ((F.bid >> 3) - 16), (float*)WSP(WS_G), KA(b_igate) + layer * HM, KA(b_fgate) + layer * HM, (float*)WSP(WS_GA), (float*)WSP(WS_GM), (float*)WSP(WS_GE), (float*)WSP(WS_TG));
            __syncthreads();
            pg8::EpiProj E{(bf16*)WSP(WS_PROJ), (const float*)WSP(WS_RS)};
            const int ngw = F.G >> 3, lw = F.bid >> 3, ntl = pg8::WGM * (NPROJ / pg8::BM);
            const int maxu = (ntl + ngw - 1) / ngw, h0 = ntl - (maxu - 1) * ngw, nh = ngw - h0;
            { pg8::InprojOrder S; S.init(WSP(WS_H16), (bf16*)WSP(WS_WIN) + (size_t)layer * NPROJ * DM, T, NPROJ, DM, F.G, F.bid, 0, 2);
              pg8::gemm_phase<pg8::EpiProj, pg8::InprojOrder, true>(F.lds + RING_OFF, S, E, F.tid); }
            asm volatile("s_waitcnt vmcnt(0)" ::: "memory");
            __syncthreads();
            { const unsigned xcc = xb_xcc_id(); gu32* gbp = F.ctl + CW_GB + 4096 * (F.bid & 7);
              if (F.tid == 0) group_arrive(gbp, F.MISC + 24, xcc, (unsigned)layer + 1u); }
            { pg8::InprojOrder S; S.init(WSP(WS_H16), (bf16*)WSP(WS_WIN) + (size_t)layer * NPROJ * DM, T, NPROJ, DM, F.G, F.bid, 2, maxu - 2);
              pg8::gemm_phase<pg8::EpiProj, pg8::InprojOrder, true>(F.lds + RING_OFF, S, E, F.tid); }
            if (nh == 0 || lw >= h0) {
                const int hidx = nh == 0 ? lw : lw - h0, nhe = nh == 0 ? ngw : nh;
                __syncthreads();
                { const unsigned xcc = xb_xcc_id(); gu32* gbp = F.ctl + CW_GB + 4096 * (F.bid & 7);
                  if (F.tid == 0) group_wait(gbp, F.MISC + 24, xcc, (unsigned)layer + 1u); }
                __syncthreads();
                conv_phase(F, (bf16*)WSP(WS_PROJ), KA(conv_w) + (size_t)layer * 4 * 1024, KA(conv_b) + (size_t)layer * 1024, (bf16*)WSP(WS_QKC), hidx, nhe);
#pragma unroll 1
                for (int ub = nhe - 1 - hidx; ub < HM * 7; ub += nhe) chunk_state_unit(F, (F.bid & 7) * HM + ub / 7, ub % 7, (bf16*)WSP(WS_PROJ), KA(conv_w) + (size_t)layer * 4 * 1024, KA(conv_b) + (size_t)layer * 1024,
                                                                   (float*)WSP(WS_GA), (float*)WSP(WS_TG), (bf16*)WSP(WS_U), (float*)WSP(WS_NV), (float*)WSP(WS_CM), (bf16*)WSP(WS_QKC));
            }
        }
        GROUP_BAR();
        { MKFRAME();
#if NAIVE_MIX == 1
            naive_sb(F, (bf16*)WSP(WS_PROJ), KA(g_sb) + layer * 512, (bf16*)WSP(WS_MIXED));
            naive_mlstm(F, (bf16*)WSP(WS_PROJ), (bf16*)WSP(WS_QKC), (float*)WSP(WS_GA), (float*)WSP(WS_GM), (float*)WSP(WS_GE), KA(g_mlstm) + layer * 512, (bf16*)WSP(WS_MIXED));
#else
#pragma unroll 1
            for (int rep = 0; rep < REP_MIX; ++rep) mixer_phase(kap, F.lds, wave_s, layer);
#endif
            __syncthreads();
        }
        GROUP_BAR();
        { MKFRAME();
            pg8::DenseOrder S; S.init(WSP(WS_MIXED), (bf16*)WSP(WS_WOUT) + (size_t)layer * DM * DM, T, DM, DM, F.G, F.bid);
            { pg8::EpiResid16<false> E{nullptr, (bf16*)WSP(WS_H16)}; pg8::gemm_phase<pg8::EpiResid16<false>, pg8::DenseOrder, true>(F.lds + RING_OFF, S, E, F.tid); }
        }
        GROUP_BAR();
        { MKFRAME();
            NormIn p{}; p.src16 = (const bf16*)WSP(WS_H16); p.gain = KA(norm_ffn_g) + layer * DM; p.rs = (float*)WSP(WS_RS);
            if (moe) { p.w8 = KA(w_router) + (size_t)j * DM * 8; p.ld8 = 8; p.cnt = (unsigned*)(F.ctl + CW_CNT + 64 * j); p.rinfo = (uint2*)WSP(WS_RINFO); p.cntw = (int*)WSP(WS_CNTW); p.rrec = (int*)WSP(WS_RREC);
                norm_phase<2, true>(F, p); }
            else norm_phase<1, true>(F, p);
        }
        if (moe) { GRID_BAR(); MKFRAME(); route_finish(F, (const int*)WSP(WS_CNTW), (const int*)WSP(WS_RREC), (uint2*)WSP(WS_RINFO), (const float*)WSP(WS_RS), (float*)WSP(WS_RSI)); }
        if (moe) GRID_BAR(); else GROUP_BAR();
        { MKFRAME(); volatile LAS int* tab = (volatile LAS int*)(F.MISC + 32);
            if (!moe) {
                pg8::DenseOrder S; S.init(WSP(WS_H16), (bf16*)WSP(WS_WGU) + (size_t)j * 2 * FFDP * DM, T, 2 * FFDP, DM, F.G, F.bid);
                pg8::EpiSwiglu E{(bf16*)WSP(WS_HID), FFDP, (const float*)WSP(WS_RS), nullptr};
#pragma unroll 1
                for (int rep = 0; rep < REP_DUP; ++rep) pg8::gemm_phase<pg8::EpiSwiglu, pg8::DenseOrder, true>(F.lds + RING_OFF, S, E, F.tid);
            } else {
                BUILD_TAB();
                pg8::MoeOrder<true> S; S.init(WSP(WS_H16), (bf16*)WSP(WS_MGU) + (size_t)j * 8 * 2 * FFE * DM, (size_t)2 * FFE * DM * 2, 2 * FFE, DM, F.G, F.bid, tab, (const uint2*)WSP(WS_RINFO));
                pg8::EpiSwiglu E{(bf16*)WSP(WS_HIDM), FFE, nullptr, (const float*)WSP(WS_RSI)};
#pragma unroll 1
                for (int rep = 0; rep < REP_MOEUP; ++rep) pg8::gemm_phase<pg8::EpiSwiglu, pg8::MoeOrder<true>, true>(F.lds + RING_OFF, S, E, F.tid);
            }
        }
        if (moe) GRID_BAR(); else GROUP_BAR();
        { MKFRAME(); volatile LAS int* tab = (volatile LAS int*)(F.MISC + 32);
            if (!moe) {
                pg8::DenseOrder S; S.init(WSP(WS_HID), (bf16*)WSP(WS_WD) + (size_t)j * DM * FFDP, T, DM, FFDP, F.G, F.bid);
                pg8::EpiResid16<false> E{nullptr, (bf16*)WSP(WS_H16)};
                pg8::gemm_phase<pg8::EpiResid16<false>, pg8::DenseOrder, true>(F.lds + RING_OFF, S, E, F.tid);
            } else {
                BUILD_TAB();
                pg8::MoeOrder<false> S; S.init(WSP(WS_HIDM), (bf16*)WSP(WS_MD) + (size_t)j * 8 * DM * FFE, (size_t)DM * FFE * 2, DM, FFE, F.G, F.bid, tab, (const uint2*)WSP(WS_RINFO));
                pg8::EpiScatter E{(bf16*)WSP(WS_O2), (const uint2*)WSP(WS_RINFO)};
#if MOE_TAIL_KS > 1
                const int rem = S.nwg % F.G, nmain = S.nwg - rem;
                pg8::MoeOrder<false> S0 = S; S0.nwg = nmain;
                pg8::gemm_phase<pg8::EpiScatter, pg8::MoeOrder<false>, true>(F.lds + RING_OFF, S0, E, F.tid);
                if (rem > 0 && F.bid < rem * MOE_TAIL_KS) {
                    pg8::MoeTailOrder ST; ST.init(S, nmain, rem, MOE_TAIL_KS, F.bid);
                    const int tl = F.bid % rem;
                    float* Pt = (float*)WSP(WS_Y) + (size_t)tl * MOE_TAIL_KS * 65536;
                    pg8::EpiPartial EP{Pt + (size_t)ST.slice * 65536};
                    pg8::gemm_phase<pg8::EpiPartial, pg8::MoeTailOrder, true>(F.lds + RING_OFF, ST, EP, F.tid);
                    asm volatile("s_waitcnt vmcnt(0)" ::: "memory");
                    __syncthreads();
                    if (F.tid == 0) { __builtin_amdgcn_fence(__ATOMIC_RELEASE, "agent");
                        const unsigned old_ = __hip_atomic_fetch_add(F.ctl + CW_TAIL + 32 * j + tl, 1u, __ATOMIC_RELAXED, __HIP_MEMORY_SCOPE_AGENT);
                        if (old_ == MOE_TAIL_KS - 1) __builtin_amdgcn_fence(__ATOMIC_ACQUIRE, "agent");
                        F.MISC[16] = old_; }
                    __syncthreads();
                    if (F.MISC[16] == MOE_TAIL_KS - 1) {
                        f32x4 acc[2][2][4][2];
#pragma unroll
                        for (int g = 0; g < 4; ++g) {
                            const float* pg = Pt + ((size_t)(g * 8) * 512 + F.tid) * 4; asm volatile("" : "+v"(pg));
#pragma unroll
                            for (int kh = 0; kh < 2; ++kh) {
                                f32x4 t[4][MOE_TAIL_KS];
#pragma unroll
                                for (int k2 = 0; k2 < 4; ++k2)
#pragma unroll
                                    for (int sl = 0; sl < MOE_TAIL_KS; ++sl) t[k2][sl] = *(const GAS f32x4*)(pg + (size_t)sl * 65536 + (4 * kh + k2) * 2048);
#pragma unroll
                                for (int k2 = 0; k2 < 4; ++k2)
#pragma unroll
                                    for (int sl = 0; sl < MOE_TAIL_KS; ++sl) asm volatile("" : "+v"(t[k2][sl]));
#pragma unroll
                                for (int k2 = 0; k2 < 4; ++k2) { f32x4 v = t[k2][0];
#pragma unroll
                                    for (int sl = 1; sl < MOE_TAIL_KS; ++sl) v += t[k2][sl];
                                    const int k = 4 * kh + k2; acc[g >> 1][g & 1][k >> 1][k & 1] = v; }
                            }
                            asm volatile("" : "+v"(acc[g >> 1][g & 1][0][0]), "+v"(acc[g >> 1][g & 1][0][1]), "+v"(acc[g >> 1][g & 1][1][0]), "+v"(acc[g >> 1][g & 1][1][1]),
                                              "+v"(acc[g >> 1][g & 1][2][0]), "+v"(acc[g >> 1][g & 1][2][1]), "+v"(acc[g >> 1][g & 1][3][0]), "+v"(acc[g >> 1][g & 1][3][1]));
                        }
                        pg8::Unit ut; ST.base.decode(ST.wgid, ut);
                        const int wid_ = F.tid >> 6, ln_ = F.tid & 63;
                        E(acc, ut, wid_ >> 2, wid_ & 3, ln_ & 15, ln_ >> 4);
                    }
                    __syncthreads();
                }
#else
#pragma unroll 1
                for (int rep = 0; rep < REP_MOEDN; ++rep) pg8::gemm_phase<pg8::EpiScatter, pg8::MoeOrder<false>, true>(F.lds + RING_OFF, S, E, F.tid);
#endif
            }
        }
        if (moe) GRID_BAR(); else GROUP_BAR();
    }
    { MKFRAME(); NormIn p{}; p.src16 = (const bf16*)WSP(WS_H16); p.o2 = (bf16*)WSP(WS_O2); p.hout = KA(out); p.gain = KA(norm_final_g); norm_phase<3, true>(F, p); }
}

extern "C" void kernel_launch(void* const* d_in, const int* in_sizes, int n_in, void* d_out, int out_size, void* d_ws, size_t ws_size, hipStream_t stream) {
    static int grid = 0;
    if (grid == 0) {
        if (n_in != 19 || in_sizes[0] != T * DM || out_size != T * DM || ws_size < WS_END) { fprintf(stderr, "kernel_launch: unexpected shapes / workspace (%d inputs, in0 %d, out %d, ws %zu)\n", n_in, n_in > 0 ? in_sizes[0] : -1, out_size, ws_size); grid = -1; return; }
        int dev = 0, cus = 0, per_cu = 0;
        if (hipGetDevice(&dev) != hipSuccess || hipDeviceGetAttribute(&cus, hipDeviceAttributeMultiprocessorCount, dev) != hipSuccess) { grid = -1; return; }
        if (hipFuncSetAttribute((const void*)mk_fwd, hipFuncAttributeMaxDynamicSharedMemorySize, LDS_BYTES) != hipSuccess) { grid = -1; return; }
        if (hipOccupancyMaxActiveBlocksPerMultiprocessor(&per_cu, (const void*)mk_fwd, NTHREADS, LDS_BYTES) != hipSuccess || per_cu < 1) fprintf(stderr, "kernel_launch: occupancy query says %d\n", per_cu);
        (void)hipGetLastError();
        grid = cus - cus % 8;
        if (grid < 160) { fprintf(stderr, "kernel_launch: %d compute units: this kernel needs at least 160\n", cus); grid = -1; return; }
    }
    if (grid < 0) return;
    if (hipMemsetAsync((char*)d_ws + WS_CTL, 0, CTL_ZERO_BYTES, stream) != hipSuccess) return;
    Args a{};
    a.x = (const float*)d_in[0]; a.norm_mix_g = (const float*)d_in[1]; a.w_in = (const float*)d_in[2]; a.b_igate = (const float*)d_in[3]; a.b_fgate = (const float*)d_in[4];
    a.conv_w = (const float*)d_in[5]; a.conv_b = (const float*)d_in[6]; a.g_mlstm = (const float*)d_in[7]; a.g_sb = (const float*)d_in[8]; a.w_out = (const float*)d_in[9];
    a.norm_ffn_g = (const float*)d_in[10]; a.ffn_w_gate = (const float*)d_in[11]; a.ffn_w_up = (const float*)d_in[12]; a.ffn_w_down = (const float*)d_in[13];
    a.w_router = (const float*)d_in[14]; a.moe_w_gate = (const float*)d_in[15]; a.moe_w_up = (const float*)d_in[16]; a.moe_w_down = (const float*)d_in[17]; a.norm_final_g = (const float*)d_in[18];
    a.out = (float*)d_out; a.ws = (unsigned char*)d_ws; a.ph_lo = 0; a.ph_hi = 0;
    hipLaunchKernelGGL(mk_fwd, dim3(grid), dim3(NTHREADS), LDS_BYTES, stream, a);
}
```

```cpp
#include <hip/hip_runtime.h>
#include <cstdio>
#include <cstdint>

#ifndef REP_PRO
#define REP_PRO 1
#endif
#ifndef REP_MIX
#define REP_MIX 1
#endif
#ifndef REP_INPROJ
#define REP_INPROJ 1
#endif
#ifndef REP_DUP
#define REP_DUP 1
#endif
#ifndef REP_MOEUP
#define REP_MOEUP 1
#endif
#ifndef REP_MOEDN
#define REP_MOEDN 1
#endif
#ifndef REP_CONV
#define REP_CONV 1
#endif
#ifndef MX_LATE
#define MX_LATE 0
#endif
#ifndef ML_CHUNK
#define ML_CHUNK 1
#endif
#ifndef MOE_TAIL_KS
#define MOE_TAIL_KS 4
#endif
#ifndef CONV_NOBAR
#define CONV_NOBAR 0
#endif
#ifndef NAIVE_MIX
#define NAIVE_MIX 0
#endif

constexpr int T = 16384, DM = 1024, SEQ = 2048, NBATCH = 8, DEPTH = 4;
constexpr int PIN = 3592, NPROJ = 3584;
constexpr int FFD = 2752, FFDP = 2816, FFE = 3584, NEXP = 8;
constexpr int HM = 4, DHM = 128, HS = 8, DHS = 64;
constexpr float EPS = 1e-6f;
constexpr float LOG2E = 1.4426950408889634f;
constexpr float QS_SCALE = 0.125f * LOG2E;
constexpr float KM_SCALE = 0.08838834764831845f;
constexpr int NWAVES = 8, NTHREADS = 512;

constexpr size_t MiB = 1u << 20;
constexpr size_t WS_CTL = 0, CTL_ZERO_BYTES = 1 * MiB;
constexpr size_t WS_WIN = 1 * MiB;
constexpr size_t WS_WOUT = 29 * MiB;
constexpr size_t WS_WGU = 37 * MiB;
constexpr size_t WS_WD = 59 * MiB;
constexpr size_t WS_MGU = 70 * MiB;
constexpr size_t WS_MD = 294 * MiB;
constexpr size_t WS_Y = 406 * MiB;
constexpr size_t WS_MIXED = 438 * MiB;
constexpr size_t WS_G = 470 * MiB;
constexpr size_t WS_GA = WS_G + 512 * 1024, WS_GM = WS_GA + 256 * 1024, WS_GE = WS_GM + 256 * 1024, WS_TG = WS_GE + 256 * 1024;
constexpr size_t WS_RINFO = 472 * MiB;
constexpr size_t WS_O2 = 474 * MiB;
constexpr size_t WS_BIG = 538 * MiB;
constexpr size_t WS_PROJ = WS_BIG, WS_QKC = WS_BIG + 112 * MiB, WS_HIDM = WS_BIG;
constexpr size_t WS_U = WS_BIG + 238 * MiB;
constexpr size_t WS_NV = WS_U + 15 * MiB, WS_CM = WS_NV + 128 * 1024;
constexpr size_t WS_RREC = WS_CM + 128 * 1024, WS_CNTW = WS_RREC + 512 * 1024;
constexpr size_t WS_HID = WS_BIG + 144 * MiB;
constexpr size_t WS_H16 = WS_U + 16 * MiB;
constexpr size_t WS_RS = WS_H16 + 32 * MiB, WS_RSI = WS_RS + 64 * 1024;
constexpr size_t WS_END = WS_H16 + 33 * MiB;
constexpr int HIDM_ROWS = 2 * T + 2048;
static_assert((size_t)HIDM_ROWS * FFE * 2 <= 238 * MiB, "hidm");
constexpr int CW_TMO = 0;
constexpr int CW_CNT = 64;
constexpr int CW_BAR = 4096;
constexpr int CW_INP = 3264;
constexpr int CW_CONV = 3200;
constexpr int CW_GB = 8192;
constexpr int CW_TAIL = 2048;

constexpr int RING_OFF = 0, RING_BYTES = 131072;
constexpr int MISC_OFF = 155648;
constexpr int LDS_BYTES = 163840;

#define GAS __attribute__((address_space(1)))
#define LAS __attribute__((address_space(3)))
typedef unsigned short bf16;
typedef unsigned v4u __attribute__((ext_vector_type(4)));
typedef unsigned v2u __attribute__((ext_vector_type(2)));
typedef float f32x4 __attribute__((ext_vector_type(4)));
typedef int i32x4 __attribute__((ext_vector_type(4)));
typedef float f32x2 __attribute__((ext_vector_type(2)));
typedef short bf16x8 __attribute__((ext_vector_type(8)));
typedef GAS unsigned gu32;
#define RLX_AGENT __ATOMIC_RELAXED, __HIP_MEMORY_SCOPE_AGENT
#define LDS_WAIT() asm volatile("s_waitcnt lgkmcnt(0)" ::: "memory")
#define VM_WAIT() asm volatile("s_waitcnt vmcnt(0)" ::: "memory")

__device__ __forceinline__ unsigned f2bf(float f) { unsigned u = __builtin_bit_cast(unsigned, f); return (u + 0x7fffu + ((u >> 16) & 1u)) >> 16; }
__device__ __forceinline__ unsigned pk2(float lo, float hi) { return f2bf(lo) | (f2bf(hi) << 16); }
__device__ __forceinline__ float bf2f(unsigned b) { return __builtin_bit_cast(float, b << 16); }
__device__ __forceinline__ float bflo(unsigned w) { return __builtin_bit_cast(float, w << 16); }
__device__ __forceinline__ float bfhi(unsigned w) { return __builtin_bit_cast(float, w & 0xffff0000u); }
__device__ __forceinline__ int lane_id() { return (int)__builtin_amdgcn_mbcnt_hi(~0u, __builtin_amdgcn_mbcnt_lo(~0u, 0u)); }
#define dpp_f(old, src, ctrl, rmask) __builtin_bit_cast(float, __builtin_amdgcn_update_dpp(__builtin_bit_cast(int, (float)(old)), __builtin_bit_cast(int, (float)(src)), ctrl, rmask, 0xf, false))
__device__ __forceinline__ float sxor32(float v, int hi) { auto rr = __builtin_amdgcn_permlane32_swap(__builtin_bit_cast(unsigned, v), __builtin_bit_cast(unsigned, v), false, false);
    return __builtin_bit_cast(float, hi ? rr[0] : rr[1]); }
__device__ __forceinline__ float quad_sum(float v) { v += dpp_f(0.f, v, 0xB1, 0xf); v += dpp_f(0.f, v, 0x4E, 0xf); return v; }
__device__ __forceinline__ float oct_sum(float v, int lane) { v = quad_sum(v); const float dn = dpp_f(0.f, v, 0x114, 0xf), up = dpp_f(0.f, v, 0x104, 0xf); return v + ((lane & 4) ? dn : up); }
#define DPP_SCAN(v, OP, ID) do { v = OP(v, __builtin_bit_cast(float, __builtin_amdgcn_update_dpp(__builtin_bit_cast(int, ID), __builtin_bit_cast(int, v), 0x111, 0xf, 0xf, false))); \
    v = OP(v, __builtin_bit_cast(float, __builtin_amdgcn_update_dpp(__builtin_bit_cast(int, ID), __builtin_bit_cast(int, v), 0x112, 0xf, 0xf, false))); \
    v = OP(v, __builtin_bit_cast(float, __builtin_amdgcn_update_dpp(__builtin_bit_cast(int, ID), __builtin_bit_cast(int, v), 0x114, 0xf, 0xf, false))); \
    v = OP(v, __builtin_bit_cast(float, __builtin_amdgcn_update_dpp(__builtin_bit_cast(int, ID), __builtin_bit_cast(int, v), 0x118, 0xf, 0xf, false))); \
    v = OP(v, __builtin_bit_cast(float, __builtin_amdgcn_update_dpp(__builtin_bit_cast(int, ID), __builtin_bit_cast(int, v), 0x142, 0xa, 0xf, false))); \
    v = OP(v, __builtin_bit_cast(float, __builtin_amdgcn_update_dpp(__builtin_bit_cast(int, ID), __builtin_bit_cast(int, v), 0x143, 0xc, 0xf, false))); } while (0)
#define OP_ADD(a, b) ((a) + (b))
#define OP_MAX(a, b) fmaxf((a), (b))
__device__ __forceinline__ float wave_sum(float v) { DPP_SCAN(v, OP_ADD, 0.0f); return __builtin_bit_cast(float, __builtin_amdgcn_readlane(__builtin_bit_cast(int, v), 63)); }

namespace pg8 {
#define PG8_LAS __attribute__((address_space(3)))
typedef unsigned short bf16_t;
typedef unsigned u32x4 __attribute__((ext_vector_type(4)));
constexpr int BM = 256, BK = 64, HALF = 128, HTB = HALF * BK * 2, STAGE_BYTES = 8 * HTB, NXCD = 8, WGM = 8;

__host__ __device__ __forceinline__ int lds_byte(int r, int c) { const int st = (r >> 4) * 2 + (c >> 5), rr = r & 15, cc = c & 31, ob = rr * 64 + cc * 2; return st * 1024 + (ob ^ (((ob >> 9) & 1) << 5)); }
__host__ __device__ __forceinline__ void stage_rc(int b, int& R, int& C) { const int st = b / 1024, sb = b % 1024, swz = sb ^ (((sb >> 9) & 1) << 5); R = (st >> 1) * 16 + swz / 64; C = (st & 1) * 32 + (swz % 64) / 2; }
__host__ __device__ __forceinline__ int perm32(int rho) { const int n = rho >> 4, i = rho & 15; return 8 * (i >> 2) + 4 * n + (i & 3); }

struct Unit { int pm, pn, e, pml, nvalid; };

__device__ __forceinline__ void tile_decode(int wgid, int nM, int nN, int& pm, int& pn) {
    const int nig = WGM * nN, gid = wgid / nig, fm = gid * WGM, gsz = (nM - fm) < WGM ? (nM - fm) : WGM;
    pm = fm + ((wgid % nig) % gsz); pn = (wgid % nig) / gsz;
}
__device__ __forceinline__ int xcd_remap(int L, int nwg) { const int q = nwg / NXCD, r = nwg % NXCD, xcd = L % NXCD, off = L / NXCD; return (xcd < r ? xcd * (q + 1) : r * (q + 1) + (xcd - r) * q) + off; }

struct DenseOrder {
    static constexpr bool GATHER = false;
    const char* A; const char* B; int K, KT; int nM, nN, nwg, G, c;
    __device__ void init(const void* A_, const void* B_, int M, int N, int K_, int G_, int c_) { A = (const char*)A_; B = (const char*)B_; K = K_; KT = K_ / BK; nM = M / BM; nN = N / BM; nwg = nM * nN; G = G_; c = c_; }
    __device__ __forceinline__ bool next(int i, Unit& u) const {
        const long L = (long)i * G + c; if (L >= nwg) return false;
        const int wgid = xcd_remap((int)L, nwg); tile_decode(wgid, nM, nN, u.pm, u.pn); u.e = 0; u.pml = u.pm; u.nvalid = BM; return true;
    }
    __device__ __forceinline__ const char* a_ptr(const Unit& u) const { return A + (size_t)u.pm * ((size_t)BM * K * 2); }
    __device__ __forceinline__ const char* b_ptr(const Unit& u) const { return B + (size_t)u.pn * ((size_t)BM * K * 2); }
    __device__ __forceinline__ unsigned grow(const Unit&, int) const { return 0u; }
    __device__ __forceinline__ const unsigned* rptr(const Unit&, int) const { return nullptr; }
};
struct InprojOrder {
    static constexpr bool GATHER = false;
    const char* A; const char* B; int K, KT, nM, nN, G, c, i0, ni;
    __device__ void init(const void* A_, const void* B_, int M, int N, int K_, int G_, int c_, int i0_, int ni_) { A = (const char*)A_; B = (const char*)B_; K = K_; KT = K_ / BK; nM = M / BM; nN = N / BM; G = G_; c = c_; i0 = i0_; ni = ni_; }
    __device__ __forceinline__ bool next(int i, Unit& u) const {
        if (i >= ni) return false;
        const int off = (i0 + i) * (G >> 3) + (c >> 3); if (off >= WGM * nN) return false;
        tile_decode((c & 7) * WGM * nN + off, nM, nN, u.pm, u.pn); u.e = 0; u.pml = u.pm; u.nvalid = BM; return true;
    }
    __device__ __forceinline__ const char* a_ptr(const Unit& u) const { return A + (size_t)u.pm * ((size_t)BM * K * 2); }
    __device__ __forceinline__ const char* b_ptr(const Unit& u) const { return B + (size_t)u.pn * ((size_t)BM * K * 2); }
    __device__ __forceinline__ unsigned grow(const Unit&, int) const { return 0u; }
    __device__ __forceinline__ const unsigned* rptr(const Unit&, int) const { return nullptr; }
};
template <bool GATH> struct MoeOrder {
    static constexpr bool GATHER = GATH;
    const char* A; const char* B; int K, KT; size_t bstride; int nN, nwg, G, c; const volatile LAS int* tab; const uint2* rinfo;
    __device__ void init(const void* A_, const void* B_, size_t bstride_, int N, int K_, int G_, int c_, const volatile LAS int* tab_, const uint2* rinfo_) {
        A = (const char*)A_; B = (const char*)B_; K = K_; KT = K_ / BK; bstride = bstride_; nN = N / BM; G = G_; c = c_; tab = tab_; rinfo = rinfo_; nwg = tab_[8] * nN; }
    __device__ __forceinline__ bool next(int i, Unit& u) const {
        const long L = (long)i * G + c; if (L >= nwg) return false;
        decode(xcd_remap((int)L, nwg), u); return true;
    }
    __device__ __forceinline__ void decode(const int wgid, Unit& u) const {
        int e = 0;
#pragma unroll
        for (int j = 1; j < 8; ++j) if (wgid >= tab[j] * nN) e = j;
        const int t0 = tab[e], nMe = tab[e + 1] - t0, cnt = tab[16 + e];
        int pml, pn;
        if (GATH) {
            const int ng = (nMe + WGM - 1) / WGM, bs = nMe / ng, ex = nMe - bs * ng, big = (bs + 1) * 4;
            int w = wgid - t0 * nN, fm, gsz;
            const int cb = w / (4 * nMe); w -= cb * 4 * nMe;
            if (w < ex * big) { const int g = w / big; w -= g * big; gsz = bs + 1; fm = g * (bs + 1); }
            else { w -= ex * big; const int g = w / (bs * 4); w -= g * bs * 4; gsz = bs; fm = ex * (bs + 1) + g * bs; }
            pml = fm + w % gsz; pn = 4 * cb + w / gsz;
        } else tile_decode(wgid - t0 * nN, nMe, nN, pml, pn);
        u.e = __builtin_amdgcn_readfirstlane(e); u.pml = __builtin_amdgcn_readfirstlane(pml); u.pn = __builtin_amdgcn_readfirstlane(pn); u.pm = __builtin_amdgcn_readfirstlane(t0 + pml);
        const int nv = cnt - pml * BM; u.nvalid = __builtin_amdgcn_readfirstlane(nv < BM ? nv : BM);
    }
    __device__ __forceinline__ const char* a_ptr(const Unit& u) const { return GATH ? A : A + (size_t)u.pm * ((size_t)BM * K * 2); }
    __device__ __forceinline__ const char* b_ptr(const Unit& u) const { return B + (size_t)u.e * bstride + (size_t)u.pn * ((size_t)BM * K * 2); }
    __device__ __forceinline__ const unsigned* rptr(const Unit& u, int r) const { const int rr = r < u.nvalid ? r : u.nvalid - 1; return (const unsigned*)(rinfo + (size_t)u.e * T + (size_t)u.pml * BM + rr); }
    __device__ __forceinline__ unsigned grow(const Unit& u, int r) const {
        const int rr = r < u.nvalid ? r : u.nvalid - 1;
        const unsigned ts = rinfo[(size_t)u.e * T + (size_t)u.pml * BM + rr].x;
        return (ts >> 1) * (unsigned)(K * 2);
    }
};

__device__ __forceinline__ unsigned cvt_pk_bf16(float lo, float hi) { unsigned r; asm volatile("v_cvt_pk_bf16_f32 %0, %1, %2" : "=v"(r) : "v"(lo), "v"(hi)); return r; }

struct EpiProj {
    static constexpr bool PERM = true, RSLDS = true;
    bf16_t* O; const float* RS;
    __device__ __forceinline__ const float* rs_base(const Unit& u) const { return RS + (size_t)u.pm * BM; }
    __device__ __forceinline__ void operator()(const f32x4 (&acc)[2][2][4][2], const Unit& u, int wr, int wc, int fr, int fq, const PG8_LAS float* rsl) const {
        const int row0 = u.pm * BM + wr * 64 + fr, col0 = u.pn * BM + wc * 64 + 8 * fq;
        const float sc0 = (u.pn == 8 || u.pn == 9) ? QS_SCALE : 1.0f;
        float rsv[2][4];
#pragma unroll
        for (int ai = 0; ai < 2; ++ai)
#pragma unroll
            for (int m = 0; m < 4; ++m) rsv[ai][m] = rsl[wr * 64 + fr + ai * HALF + m * 16];
#pragma unroll
        for (int ai = 0; ai < 2; ++ai)
#pragma unroll
            for (int m = 0; m < 4; ++m) { bf16_t* rowp = O + (size_t)(row0 + ai * HALF + m * 16) * NPROJ + col0; const float sc = sc0 * rsv[ai][m];
#pragma unroll
                for (int bj = 0; bj < 2; ++bj) { const f32x4 v0 = acc[ai][bj][m][0] * sc, v1 = acc[ai][bj][m][1] * sc;
                    u32x4 w; w.x = cvt_pk_bf16(v0[0], v0[1]); w.y = cvt_pk_bf16(v0[2], v0[3]); w.z = cvt_pk_bf16(v1[0], v1[1]); w.w = cvt_pk_bf16(v1[2], v1[3]);
                    *(u32x4*)(rowp + bj * 32) = w; } }
    }
};
struct EpiResid {
    static constexpr bool PERM = false, RSLDS = false;
    const float* Hin; float* Hout;
    __device__ __forceinline__ void operator()(const f32x4 (&acc)[2][2][4][2], const Unit& u, int wr, int wc, int fr, int fq) const {
        const int row0 = u.pm * BM + wr * 64 + fr, col0 = u.pn * BM + wc * 32 + 4 * fq;
#pragma unroll
        for (int ai = 0; ai < 2; ++ai)
#pragma unroll
            for (int mh = 0; mh < 2; ++mh) {
                f32x4 hv[2][2][2];
#pragma unroll
                for (int m2 = 0; m2 < 2; ++m2) { const size_t off = (size_t)(row0 + ai * HALF + (2 * mh + m2) * 16) * DM + col0;
#pragma unroll
                    for (int bj = 0; bj < 2; ++bj)
#pragma unroll
                        for (int n = 0; n < 2; ++n) hv[m2][bj][n] = *(const f32x4*)(Hin + off + bj * HALF + n * 16); }
                asm volatile("" : "+v"(hv[0][0][0]), "+v"(hv[0][0][1]), "+v"(hv[0][1][0]), "+v"(hv[0][1][1]), "+v"(hv[1][0][0]), "+v"(hv[1][0][1]), "+v"(hv[1][1][0]), "+v"(hv[1][1][1]));
#pragma unroll
                for (int m2 = 0; m2 < 2; ++m2) { const size_t off = (size_t)(row0 + ai * HALF + (2 * mh + m2) * 16) * DM + col0;
#pragma unroll
                    for (int bj = 0; bj < 2; ++bj)
#pragma unroll
                        for (int n = 0; n < 2; ++n) *(f32x4*)(Hout + off + bj * HALF + n * 16) = hv[m2][bj][n] + acc[ai][bj][2 * mh + m2][n]; }
            }
    }
};
template <bool XIN> struct EpiResid16 {
    static constexpr bool PERM = true, RSLDS = false;
    const float* X; bf16_t* H;
    __device__ __forceinline__ void operator()(const f32x4 (&acc)[2][2][4][2], const Unit& u, int wr, int wc, int fr, int fq) const {
        const int row0 = u.pm * BM + wr * 64 + fr, col0 = u.pn * BM + wc * 64 + 8 * fq;
#pragma unroll
        for (int ai = 0; ai < 2; ++ai) {
            u32x4 hb[4][2];
#pragma unroll
            for (int m = 0; m < 4; ++m)
#pragma unroll
                for (int bj = 0; bj < 2; ++bj) hb[m][bj] = *(const u32x4*)(H + (size_t)(row0 + ai * HALF + m * 16) * DM + col0 + bj * 32);
            asm volatile("" : "+v"(hb[0][0]), "+v"(hb[0][1]), "+v"(hb[1][0]), "+v"(hb[1][1]), "+v"(hb[2][0]), "+v"(hb[2][1]), "+v"(hb[3][0]), "+v"(hb[3][1]));
#pragma unroll
            for (int m = 0; m < 4; ++m)
#pragma unroll
                for (int bj = 0; bj < 2; ++bj) { const u32x4 b = hb[m][bj];
                    const f32x4 h0 = (f32x4){__builtin_bit_cast(float, b.x << 16), __builtin_bit_cast(float, b.x & 0xffff0000u), __builtin_bit_cast(float, b.y << 16), __builtin_bit_cast(float, b.y & 0xffff0000u)};
                    const f32x4 h1 = (f32x4){__builtin_bit_cast(float, b.z << 16), __builtin_bit_cast(float, b.z & 0xffff0000u), __builtin_bit_cast(float, b.w << 16), __builtin_bit_cast(float, b.w & 0xffff0000u)};
                    const f32x4 r0 = h0 + acc[ai][bj][m][0], r1 = h1 + acc[ai][bj][m][1];
                    u32x4 w; w.x = cvt_pk_bf16(r0[0], r0[1]); w.y = cvt_pk_bf16(r0[2], r0[3]); w.z = cvt_pk_bf16(r1[0], r1[1]); w.w = cvt_pk_bf16(r1[2], r1[3]);
                    *(u32x4*)(H + (size_t)(row0 + ai * HALF + m * 16) * DM + col0 + bj * 32) = w; }
        }
    }
};
__device__ __forceinline__ float silu_mul(float g, float u) { return g * u * __builtin_amdgcn_rcpf(1.0f + __builtin_amdgcn_exp2f(-g * LOG2E)); }
struct EpiSwiglu {
    static constexpr bool PERM = true, RSLDS = true;
    bf16_t* O; int ld; const float* RS; const float* RSI;
    __device__ __forceinline__ const float* rs_base(const Unit& u) const { return RSI ? RSI + (size_t)u.e * T + (size_t)u.pml * BM : RS + (size_t)u.pm * BM; }
    __device__ __forceinline__ void operator()(const f32x4 (&acc)[2][2][4][2], const Unit& u, int wr, int wc, int fr, int fq, const PG8_LAS float* rsl) const {
        const int row0 = u.pm * BM + wr * 64 + fr, col0 = u.pn * HALF + wc * 32 + 8 * fq;
        float rsv[2][4];
#pragma unroll
        for (int ai = 0; ai < 2; ++ai)
#pragma unroll
            for (int m = 0; m < 4; ++m) rsv[ai][m] = rsl[wr * 64 + fr + ai * HALF + m * 16];
#pragma unroll
        for (int ai = 0; ai < 2; ++ai)
#pragma unroll
            for (int m = 0; m < 4; ++m) { bf16_t* rowp = O + (size_t)(row0 + ai * HALF + m * 16) * ld + col0; const float rs = rsv[ai][m];
                const f32x4 g0 = acc[ai][0][m][0] * rs, g1 = acc[ai][0][m][1] * rs, u0 = acc[ai][1][m][0] * rs, u1 = acc[ai][1][m][1] * rs;
                u32x4 w; w.x = cvt_pk_bf16(silu_mul(g0[0], u0[0]), silu_mul(g0[1], u0[1])); w.y = cvt_pk_bf16(silu_mul(g0[2], u0[2]), silu_mul(g0[3], u0[3]));
                w.z = cvt_pk_bf16(silu_mul(g1[0], u1[0]), silu_mul(g1[1], u1[1])); w.w = cvt_pk_bf16(silu_mul(g1[2], u1[2]), silu_mul(g1[3], u1[3]));
                *(u32x4*)rowp = w; }
    }
};
struct EpiScatter {
    static constexpr bool PERM = true, RSLDS = false;
    bf16_t* O2; const uint2* rinfo;
    __device__ __forceinline__ void operator()(const f32x4 (&acc)[2][2][4][2], const Unit& u, int wr, int wc, int fr, int fq) const {
        const int col0 = u.pn * BM + wc * 64 + 8 * fq;
        uint2 inf[2][4];
#pragma unroll
        for (int ai = 0; ai < 2; ++ai)
#pragma unroll
            for (int m = 0; m < 4; ++m) { const int rl = ai * HALF + wr * 64 + m * 16 + fr; const int rc = rl < u.nvalid ? rl : u.nvalid - 1;
                inf[ai][m] = rinfo[(size_t)u.e * T + (size_t)u.pml * BM + rc]; }
#pragma unroll
        for (int ai = 0; ai < 2; ++ai)
#pragma unroll
            for (int m = 0; m < 4; ++m) asm volatile("" : "+v"(inf[ai][m].x), "+v"(inf[ai][m].y));
#pragma unroll
        for (int ai = 0; ai < 2; ++ai)
#pragma unroll
            for (int m = 0; m < 4; ++m) { const int rl = ai * HALF + wr * 64 + m * 16 + fr;
                if (rl < u.nvalid) { const float wgt = __builtin_bit_cast(float, inf[ai][m].y);
                    bf16_t* rowp = O2 + ((size_t)(inf[ai][m].x & 1u) * T + (size_t)(inf[ai][m].x >> 1)) * DM + col0;
#pragma unroll
                    for (int bj = 0; bj < 2; ++bj) { const f32x4 v0 = acc[ai][bj][m][0] * wgt, v1 = acc[ai][bj][m][1] * wgt;
                        u32x4 w; w.x = cvt_pk_bf16(v0[0], v0[1]); w.y = cvt_pk_bf16(v0[2], v0[3]); w.z = cvt_pk_bf16(v1[0], v1[1]); w.w = cvt_pk_bf16(v1[2], v1[3]);
                        *(u32x4*)(rowp + bj * 32) = w; } } }
    }
};

struct MoeTailOrder {
    static constexpr bool GATHER = false;
    MoeOrder<false> base; const char* A; const char* B; int K, KT, slice, wgid; bool have;
    __device__ void init(const MoeOrder<false>& b, int nmain, int rem, int ks, int c) { base = b; A = b.A; B = b.B; K = b.K; KT = b.KT / ks; have = c < rem * ks; slice = c / (rem > 0 ? rem : 1); wgid = nmain + c % (rem > 0 ? rem : 1); }
    __device__ __forceinline__ bool next(int i, Unit& u) const { if (i != 0 || !have) return false; base.decode(wgid, u); return true; }
    __device__ __forceinline__ const char* a_ptr(const Unit& u) const { return base.a_ptr(u) + (size_t)slice * KT * (BK * 2); }
    __device__ __forceinline__ const char* b_ptr(const Unit& u) const { return base.b_ptr(u) + (size_t)slice * KT * (BK * 2); }
    __device__ __forceinline__ unsigned grow(const Unit&, int) const { return 0u; }
    __device__ __forceinline__ const unsigned* rptr(const Unit&, int) const { return nullptr; }
};
struct EpiPartial {
    static constexpr bool PERM = true, RSLDS = false;
    float* P;
    __device__ __forceinline__ void operator()(const f32x4 (&acc)[2][2][4][2], const Unit&, int wr, int wc, int fr, int fq) const {
        const int tid = (wr * 4 + wc) * 64 + fq * 16 + fr;
#pragma unroll
        for (int ai = 0; ai < 2; ++ai)
#pragma unroll
            for (int bj = 0; bj < 2; ++bj)
#pragma unroll
                for (int m = 0; m < 4; ++m)
#pragma unroll
                    for (int n = 0; n < 2; ++n) *(f32x4*)(P + ((size_t)((((ai * 2 + bj) * 4 + m) * 2 + n) * 512 + tid)) * 4) = acc[ai][bj][m][n];
    }
};

template <class Epi, class Sched, bool ALIGN_EPI>
__device__ __forceinline__ void gemm_phase(PG8_LAS unsigned char* lds, const Sched& S, const Epi& E, const int tid) {
    const int wid = __builtin_amdgcn_readfirstlane(tid >> 6), lane = tid & 63, wr = wid >> 2, wc = wid & 3, fr = lane & 15, fq = lane >> 4;
    const int K = S.K, nt = S.KT;
    constexpr bool GA = Sched::GATHER;
    unsigned voffA[2], voffB[2]; int RA[2], CA[2];
#pragma unroll
    for (int i = 0; i < 2; ++i) { int R, C; stage_rc(tid * 16 + i * 8192, R, C); const int Rb = Epi::PERM ? ((R >> 5) * 64 + perm32(R & 31)) : R;
        RA[i] = R; CA[i] = C; voffA[i] = GA ? (unsigned)(C * 2) : (unsigned)(R * K + C) * 2u; voffB[i] = (unsigned)(Rb * K + C) * 2u; }
    const size_t kstep = (size_t)(BK * 2);
    const size_t hstep = (size_t)HALF * K * 2;
    const size_t hstepB = Epi::PERM ? (size_t)32 * K * 2 : hstep;
    const unsigned ldsw = (unsigned)wid * 1024u;
    const int aoff = lds_byte(wr * 64 + fr, fq * 8), boff = lds_byte(wc * 32 + fr, fq * 8);
#define PG8_SA(b, h) (((b) * 2 + (h)) * HTB)
#define PG8_SB(b, h) ((4 + (b) * 2 + (h)) * HTB)
#define PG8_STAGE(bufoff, gbase, voff) do { _Pragma("unroll") for (int _i = 0; _i < 2; ++_i) \
        __builtin_amdgcn_global_load_lds((const unsigned*)((const char*)(gbase) + (voff)[_i]), (PG8_LAS unsigned*)(lds + (bufoff) + ldsw + _i * 8192), 16, 0, 0); } while (0)
#define PG8_STAGE_A(bufoff, kb, h, NX) do { if constexpr (GA) { _Pragma("unroll") for (int _i = 0; _i < 2; ++_i) { const unsigned _o = ((NX) ? gnx[h][_i] : gcu[h][_i]) + voffA[_i]; \
        __builtin_amdgcn_global_load_lds((const unsigned*)((const char*)(kb) + _o), (PG8_LAS unsigned*)(lds + (bufoff) + ldsw + _i * 8192), 16, 0, 0); } } \
        else { PG8_STAGE(bufoff, (kb) + (h) * hstep, voffA); } } while (0)
#define PG8_LDA(dst, b, h) do { _Pragma("unroll") for (int m = 0; m < 4; ++m) _Pragma("unroll") for (int k = 0; k < 2; ++k) dst[m][k] = *(const PG8_LAS bf16x8*)(lds + PG8_SA(b, h) + aoff + m * 2048 + k * 1024); } while (0)
#define PG8_LDB(dst, b, h) do { _Pragma("unroll") for (int n = 0; n < 2; ++n) _Pragma("unroll") for (int k = 0; k < 2; ++k) dst[n][k] = *(const PG8_LAS bf16x8*)(lds + PG8_SB(b, h) + boff + n * 2048 + k * 1024); } while (0)
#define PG8_MMA(ai, bj, At, Bt) do { __builtin_amdgcn_s_setprio(1); _Pragma("unroll") for (int m = 0; m < 4; ++m) _Pragma("unroll") for (int n = 0; n < 2; ++n) _Pragma("unroll") for (int k = 0; k < 2; ++k) \
        acc[ai][bj][m][n] = __builtin_amdgcn_mfma_f32_16x16x32_bf16(Bt[n][k], At[m][k], acc[ai][bj][m][n], 0, 0, 0); __builtin_amdgcn_s_setprio(0); } while (0)
#define PG8_WAIT_V(n) asm volatile("s_waitcnt vmcnt(" #n ")" ::: "memory")
#define PG8_WAIT_L(n) asm volatile("s_waitcnt lgkmcnt(" #n ")" ::: "memory")
#define PG8_BAR __builtin_amdgcn_s_barrier()
#define PG8_SCHED __builtin_amdgcn_sched_barrier(0)
    Unit cur, nxt; int ui = 0;
    if (!S.next(0, cur)) return;
#define PG8_RS_STAGE(u_, par_) do { if constexpr (Epi::RSLDS) { if (wid < 4) __builtin_amdgcn_global_load_lds((const unsigned*)(E.rs_base(u_) + wid * 64 + lane), (PG8_LAS unsigned*)(lds + STAGE_BYTES + (par_) * 1024 + wid * 256), 4, 0, 0); } } while (0)
    PG8_RS_STAGE(cur, 0);
    unsigned gcu[2][2] = {{0u, 0u}, {0u, 0u}}, gnx[2][2] = {{0u, 0u}, {0u, 0u}};
    if constexpr (GA) {
#pragma unroll
        for (int h = 0; h < 2; ++h)
#pragma unroll
            for (int i = 0; i < 2; ++i) gcu[h][i] = S.grow(cur, h * HALF + RA[i]);
    }
    f32x4 acc[2][2][4][2];
#pragma unroll
    for (int a = 0; a < 2; ++a)
#pragma unroll
        for (int b = 0; b < 2; ++b)
#pragma unroll
            for (int m = 0; m < 4; ++m)
#pragma unroll
                for (int n = 0; n < 2; ++n) acc[a][b][m][n] = (f32x4){0.f, 0.f, 0.f, 0.f};
    bf16x8 At[4][2], B0[2][2], B1[2][2];
    const char* cA = S.a_ptr(cur); const char* cB = S.b_ptr(cur);
    PG8_STAGE(PG8_SB(0, 0), cB, voffB); PG8_STAGE(PG8_SB(0, 1), cB + hstepB, voffB); PG8_STAGE_A(PG8_SA(0, 0), cA, 0, false); PG8_STAGE_A(PG8_SA(0, 1), cA, 1, false);
    if (wr == 1) PG8_BAR;
    PG8_WAIT_V(2); PG8_BAR;
    PG8_STAGE(PG8_SB(1, 0), cB + kstep, voffB); PG8_STAGE_A(PG8_SA(1, 0), cA + kstep, 0, false); PG8_STAGE(PG8_SB(1, 1), cB + hstepB + kstep, voffB);
    PG8_WAIT_V(6); PG8_BAR;
    for (;;) {
        const bool has_next = S.next(ui + 1, nxt);
        const char* nA = has_next ? S.a_ptr(nxt) : cA; const char* nB = has_next ? S.b_ptr(nxt) : cB;
        unsigned raw[2][2] = {{0u, 0u}, {0u, 0u}};
        if constexpr (GA) {
            if (has_next) {
#pragma unroll
                for (int h = 0; h < 2; ++h)
#pragma unroll
                    for (int i = 0; i < 2; ++i) { const unsigned* rp = S.rptr(nxt, h * HALF + RA[i]); asm volatile("global_load_dword %0, %1, off" : "=v"(raw[h][i]) : "v"(rp) : "memory"); }
            }
        }
        for (int t = 0; t < nt; t += 2) {
            const bool last = (t == nt - 2);
            if constexpr (GA) { if (last) { asm volatile("" : "+v"(raw[0][0]), "+v"(raw[0][1]), "+v"(raw[1][0]), "+v"(raw[1][1]));
#pragma unroll
                for (int h = 0; h < 2; ++h)
#pragma unroll
                    for (int i = 0; i < 2; ++i) gnx[h][i] = has_next ? (raw[h][i] >> 1) * (unsigned)(K * 2) : gcu[h][i]; } }
            const char* a1 = cA + (size_t)(t + 1) * kstep;
            const char* a2 = last ? nA : cA + (size_t)(t + 2) * kstep; const char* b2 = last ? nB : cB + (size_t)(t + 2) * kstep;
            const char* a3 = a2 + kstep; const char* b3 = b2 + kstep;
            PG8_LDB(B0, 0, 0); PG8_LDB(B1, 0, 1); PG8_SCHED; PG8_LDA(At, 0, 0); PG8_STAGE_A(PG8_SA(1, 1), a1, 1, false);
            PG8_WAIT_V(8); PG8_WAIT_L(0); PG8_BAR; PG8_MMA(0, 0, At, B0); PG8_MMA(0, 1, At, B1); PG8_BAR; PG8_SCHED;
            PG8_LDA(At, 0, 1); PG8_STAGE(PG8_SB(0, 0), b2, voffB); PG8_STAGE(PG8_SB(0, 1), b2 + hstepB, voffB); PG8_STAGE_A(PG8_SA(0, 0), a2, 0, last);
            PG8_WAIT_V(8); PG8_WAIT_L(0); PG8_BAR; PG8_MMA(1, 0, At, B0); PG8_MMA(1, 1, At, B1); PG8_BAR; PG8_SCHED;
            PG8_LDB(B0, 1, 0); PG8_LDB(B1, 1, 1); PG8_SCHED; PG8_LDA(At, 1, 0); PG8_STAGE_A(PG8_SA(0, 1), a2, 1, last);
            PG8_WAIT_V(8); PG8_WAIT_L(0); PG8_BAR; PG8_MMA(0, 0, At, B0); PG8_MMA(0, 1, At, B1); PG8_BAR; PG8_SCHED;
            PG8_LDA(At, 1, 1); PG8_STAGE(PG8_SB(1, 0), b3, voffB); PG8_STAGE(PG8_SB(1, 1), b3 + hstepB, voffB); PG8_STAGE_A(PG8_SA(1, 0), a3, 0, last);
            PG8_WAIT_V(8); PG8_WAIT_L(0); PG8_BAR; PG8_MMA(1, 0, At, B0); PG8_MMA(1, 1, At, B1); PG8_BAR; PG8_SCHED;
        }
        if constexpr (ALIGN_EPI) { if (wr == 0) PG8_BAR; }
        if constexpr (Epi::RSLDS) E(acc, cur, wr, wc, fr, fq, (const PG8_LAS float*)(lds + STAGE_BYTES + (ui & 1) * 1024)); else E(acc, cur, wr, wc, fr, fq);
        if (!has_next) break;
#pragma unroll
        for (int a = 0; a < 2; ++a)
#pragma unroll
            for (int b = 0; b < 2; ++b)
#pragma unroll
                for (int m = 0; m < 4; ++m)
#pragma unroll
                    for (int n = 0; n < 2; ++n) acc[a][b][m][n] = (f32x4){0.f, 0.f, 0.f, 0.f};
        cur = nxt; cA = nA; cB = nB; ++ui;
        PG8_RS_STAGE(cur, ui & 1);
        if constexpr (GA) {
#pragma unroll
            for (int h = 0; h < 2; ++h)
#pragma unroll
                for (int i = 0; i < 2; ++i) gcu[h][i] = gnx[h][i];
        }
        if constexpr (ALIGN_EPI) { if (wr == 1) PG8_BAR; }
    }
    PG8_WAIT_V(0);
    if constexpr (!ALIGN_EPI) { if (wr == 0) PG8_BAR; }
    PG8_BAR;
#undef PG8_RS_STAGE
#undef PG8_SA
#undef PG8_SB
#undef PG8_STAGE
#undef PG8_STAGE_A
#undef PG8_LDA
#undef PG8_LDB
#undef PG8_MMA
#undef PG8_WAIT_V
#undef PG8_WAIT_L
#undef PG8_BAR
#undef PG8_SCHED
}
}

#define XB_TMO      128
#define XB_XCNT(j)  (256  + 64 * (j))
#define XB_XSUB(j)  (1280 + 64 * (j))
#define XB_XGEN(j)  (2304 + 64 * (j))
#define XB_TOP      3328
#define XB_TOPGEN   3392
#define XCD_BAR_WORDS 3456
#define XB_SPIN_CAP (1u << 20)

__device__ __forceinline__ unsigned xb_ld(unsigned* p)              { return __hip_atomic_load(p, __ATOMIC_RELAXED, __HIP_MEMORY_SCOPE_AGENT); }
__device__ __forceinline__ unsigned xb_add(unsigned* p, unsigned v) { return __hip_atomic_fetch_add(p, v, __ATOMIC_RELAXED, __HIP_MEMORY_SCOPE_AGENT); }
__device__ __forceinline__ unsigned xb_xcc_id() { return (unsigned)__builtin_amdgcn_s_getreg((3 << 11) | 20) & 0xFu; }
#define XB_SPIN(cond, bar) do { unsigned _sp = 0; while (cond) { __builtin_amdgcn_s_sleep(1); \
    if ((++_sp & 255u) == 0u) { if (xb_ld(&(bar)[XB_TMO])) break; if (_sp > XB_SPIN_CAP) { atomicAdd(&(bar)[XB_TMO], 1u); break; } } } } while (0)

struct XcdBarrier { unsigned* bar; unsigned x; volatile LAS unsigned* st; };

__device__ __forceinline__ XcdBarrier xcd_barrier_post(unsigned* bar, volatile LAS unsigned* st) {
    XcdBarrier b; b.bar = bar; b.x = xb_xcc_id(); b.st = st;
    if (threadIdx.x == 0) (void)xb_add(&bar[XB_XCNT(b.x)], 1u);
    return b;
}
__device__ __forceinline__ void xcd_barrier_complete(unsigned* bar, unsigned x, unsigned& nloc, unsigned& nx) {
    const unsigned G = gridDim.x * gridDim.y * gridDim.z;
    unsigned sum, cnt, mine, sp = 0u;
    for (;;) {
        sum = 0u; cnt = 0u; mine = 0u;
#pragma unroll
        for (unsigned j = 0; j < 16; ++j) { const unsigned c = xb_ld(&bar[XB_XCNT(j)]); sum += c; cnt += (c > 0u) ? 1u : 0u; mine = (j == x) ? c : mine; }
        if (sum == G) break;
        __builtin_amdgcn_s_sleep(1);
        if ((++sp & 255u) == 0u) { if (xb_ld(&bar[XB_TMO])) break; if (sp > XB_SPIN_CAP) { atomicAdd(&bar[XB_TMO], 1u); break; } }
    }
    nloc = mine > 0u ? mine : 1u; nx = cnt > 0u ? cnt : 1u;
}
__device__ __forceinline__ void xcd_barrier(const XcdBarrier& b, const int wave_s) {
    asm volatile("s_waitcnt vmcnt(0)" ::: "memory");
    __syncthreads();
    if (wave_s == 0 && lane_id() == 0) {
        unsigned* bar = b.bar;
        __builtin_amdgcn_s_waitcnt(0);
        unsigned nloc = b.st[0], nx = b.st[1];
        if (nloc == 0u) { xcd_barrier_complete(bar, b.x, nloc, nx); b.st[0] = nloc; b.st[1] = nx; }
        const unsigned old = xb_add(&bar[XB_XSUB(b.x)], 1u);
        const unsigned gen = old / nloc;
        if (old + 1u == (gen + 1u) * nloc) {
            __builtin_amdgcn_fence(__ATOMIC_RELEASE, "agent");
            asm volatile("s_waitcnt vmcnt(0)" ::: "memory");
            const unsigned og = xb_add(&bar[XB_TOP], 1u);
            const unsigned tg = og / nx;
            if (og + 1u == (tg + 1u) * nx) xb_add(&bar[XB_TOPGEN], 1u);
            else XB_SPIN(xb_ld(&bar[XB_TOPGEN]) == tg, bar);
            __builtin_amdgcn_fence(__ATOMIC_ACQUIRE, "agent");
            xb_add(&bar[XB_XGEN(b.x)], 1u);
            asm volatile("s_waitcnt vmcnt(0)" ::: "memory");
        } else {
            XB_SPIN(xb_ld(&bar[XB_XGEN(b.x)]) == gen, bar);
            __builtin_amdgcn_fence(__ATOMIC_ACQUIRE, "agent");
            asm volatile("s_waitcnt vmcnt(0)" ::: "memory");
        }
    }
    __syncthreads();
}

#define GB_XCNT(x) (64 * (x))
#define GB_SUB(x)  (1024 + 64 * (x))
#define GB_GEN(x)  (2048 + 64 * (x))
#define GB_TOP     3072
#define GB_ASUB(x) (3136 + 32 * (x))
#define GB_ATOP    3712
__device__ __forceinline__ void group_members(gu32* gb, volatile LAS unsigned* st, const unsigned x, unsigned& nloc, unsigned& nx) {
    nloc = st[1]; nx = st[2];
    if (nloc == 0u) { nx = 0u;
        for (unsigned q = 0; q < 16; ++q) { const unsigned c = __hip_atomic_load(gb + GB_XCNT(q), __ATOMIC_RELAXED, __HIP_MEMORY_SCOPE_AGENT); nx += c > 0u ? 1u : 0u; nloc = q == x ? c : nloc; }
        nloc = nloc > 0u ? nloc : 1u; st[1] = nloc; st[2] = nx; }
}
__device__ __forceinline__ void group_arrive(gu32* gb, volatile LAS unsigned* st, const unsigned x, const unsigned r) {
    unsigned nloc, nx; group_members(gb, st, x, nloc, nx);
    const unsigned old = __hip_atomic_fetch_add(gb + GB_ASUB(x), 1u, __ATOMIC_RELAXED, __HIP_MEMORY_SCOPE_AGENT);
    if (old + 1u == r * nloc) { __builtin_amdgcn_fence(__ATOMIC_RELEASE, "agent"); asm volatile("s_waitcnt vmcnt(0)" ::: "memory");
        (void)__hip_atomic_fetch_add(gb + GB_ATOP, 1u, __ATOMIC_RELAXED, __HIP_MEMORY_SCOPE_AGENT); }
}
__device__ __forceinline__ void group_wait(gu32* gb, volatile LAS unsigned* st, const unsigned x, const unsigned r) {
    unsigned nloc, nx; group_members(gb, st, x, nloc, nx);
    unsigned sp = 0u;
    while (__hip_atomic_load(gb + GB_ATOP, __ATOMIC_RELAXED, __HIP_MEMORY_SCOPE_AGENT) < r * nx) { __builtin_amdgcn_s_sleep(1); if (++sp > (1u << 22)) break; }
    __builtin_amdgcn_fence(__ATOMIC_ACQUIRE, "agent");
}
__device__ __forceinline__ void group_barrier(gu32* gb, const int wave_s, volatile LAS unsigned* st, const unsigned x) {
    asm volatile("s_waitcnt vmcnt(0)" ::: "memory");
    __syncthreads();
    if (wave_s == 0 && lane_id() == 0) {
        unsigned nloc, nx; group_members(gb, st, x, nloc, nx);
        const unsigned r = st[0] + 1u; st[0] = r;
        const unsigned old = __hip_atomic_fetch_add(gb + GB_SUB(x), 1u, __ATOMIC_RELAXED, __HIP_MEMORY_SCOPE_AGENT);
        unsigned sp = 0u;
        if (old + 1u == r * nloc) {
            __builtin_amdgcn_fence(__ATOMIC_RELEASE, "agent");
            asm volatile("s_waitcnt vmcnt(0)" ::: "memory");
            (void)__hip_atomic_fetch_add(gb + GB_TOP, 1u, __ATOMIC_RELAXED, __HIP_MEMORY_SCOPE_AGENT);
            while (__hip_atomic_load(gb + GB_TOP, __ATOMIC_RELAXED, __HIP_MEMORY_SCOPE_AGENT) < r * nx) { __builtin_amdgcn_s_sleep(1); if (++sp > (1u << 22)) break; }
            __builtin_amdgcn_fence(__ATOMIC_ACQUIRE, "agent");
            (void)__hip_atomic_fetch_add(gb + GB_GEN(x), 1u, __ATOMIC_RELAXED, __HIP_MEMORY_SCOPE_AGENT);
        } else {
            while (__hip_atomic_load(gb + GB_GEN(x), __ATOMIC_RELAXED, __HIP_MEMORY_SCOPE_AGENT) < r) { __builtin_amdgcn_s_sleep(1); if (++sp > (1u << 22)) break; }
            __builtin_amdgcn_fence(__ATOMIC_ACQUIRE, "agent");
        }
    }
    __syncthreads();
}

struct Args {
    const float* x; const float* norm_mix_g; const float* w_in; const float* b_igate; const float* b_fgate; const float* conv_w; const float* conv_b;
    const float* g_mlstm; const float* g_sb; const float* w_out; const float* norm_ffn_g; const float* ffn_w_gate; const float* ffn_w_up; const float* ffn_w_down;
    const float* w_router; const float* moe_w_gate; const float* moe_w_up; const float* moe_w_down; const float* norm_final_g;
    float* out; unsigned char* ws; int ph_lo, ph_hi;
};
struct Frame {
    LAS unsigned char* lds; volatile LAS unsigned* MISC; gu32* ctl; int tid, lane, wave, G, bid;
};

__device__ __forceinline__ void tr_item(const float* src, int ldw, bf16* dst, int ldk, LAS float* scr, int lane, const float* gk) {
    const int c = lane & 7;
    f32x4 ga = {1.f, 1.f, 1.f, 1.f}, gb = ga;
    if (gk) { ga = *(const GAS f32x4*)(gk + 8 * c); gb = *(const GAS f32x4*)(gk + 8 * c + 4); }
    {
        const int r8 = lane >> 3, c4 = 4 * (lane & 7);
        f32x4 v[8];
#pragma unroll
        for (int i = 0; i < 8; ++i) v[i] = *(const GAS f32x4*)(src + (size_t)(8 * i + r8) * ldw + c4);
#pragma unroll
        for (int i = 0; i < 8; ++i) { LAS float* d = scr + (8 * i + r8) * 33 + c4; d[0] = v[i].x; d[1] = v[i].y; d[2] = v[i].z; d[3] = v[i].w; }
    }
    LDS_WAIT(); asm volatile("" ::: "memory");
#pragma unroll
    for (int j = 0; j < 4; ++j) { const int n = (lane >> 3) + 8 * j; const LAS float* s = scr + (8 * c) * 33 + n;
        v4u o; o.x = pk2(s[0 * 33] * ga.x, s[1 * 33] * ga.y); o.y = pk2(s[2 * 33] * ga.z, s[3 * 33] * ga.w); o.z = pk2(s[4 * 33] * gb.x, s[5 * 33] * gb.y); o.w = pk2(s[6 * 33] * gb.z, s[7 * 33] * gb.w);
        *(GAS v4u*)(dst + (size_t)n * ldk + 8 * c) = o; }
    LDS_WAIT(); asm volatile("" ::: "memory");
}
template <int ROWMAP>
__device__ __forceinline__ bool tr_matrix(int& r, const float* W, int K, int N, int ldw, int c0, bf16* dst, int ldk, int drow0, LAS float* scr, int lane, const float* g = nullptr) {
    const int nblk = N / 32, items = (K / 64) * nblk;
    if (r >= items) { r -= items; return false; }
    const int kb = r / nblk, nb = r % nblk, k0 = 64 * kb, n0 = 32 * nb;
    const int drow = ROWMAP == 0 ? drow0 + n0 : drow0 + (n0 >> 7) * 256 + ((n0 & 127) >> 5) * 64;
    tr_item(W + (size_t)k0 * ldw + c0 + n0, ldw, dst + (size_t)drow * ldk + k0, ldk, scr, lane, g ? g + k0 : nullptr);
    return true;
}
__device__ __forceinline__ void prologue_phase(const Args& a, Frame& F) {
    LAS float* scr = (LAS float*)(F.lds + RING_OFF + F.wave * 16384);
    unsigned char* ws = a.ws;
    const int gw = F.bid * NWAVES + F.wave, NGW = F.G * NWAVES;
    constexpr int I_IN = 16 * 112, I_OUT = 16 * 32, I_DG = 16 * 86, I_DD = 43 * 32, I_MG = 16 * 112, I_MD = 56 * 32;
    constexpr int PER_LAYER_A = I_IN + I_OUT;
    constexpr int PER_DENSE = 2 * I_DG + I_DD;
    constexpr int PER_EXP = 2 * I_MG + I_MD;
    constexpr int NITEMS = 4 * PER_LAYER_A + 2 * PER_DENSE + 16 * PER_EXP;
    for (int it = gw; it < NITEMS; it += NGW) {
        int r = it;
        if (r < 4 * PER_LAYER_A) {
            const int l = r / PER_LAYER_A; r -= l * PER_LAYER_A;
            const float* W = a.w_in + (size_t)l * DM * PIN; bf16* D = (bf16*)(ws + WS_WIN) + (size_t)l * NPROJ * DM;
            if (r < 16 * 64) { (void)tr_matrix<0>(r, W, DM, 2048, PIN, 0, D, DM, 0, scr, F.lane, a.norm_mix_g + l * DM); continue; } r -= 16 * 64;
            if (r < 16 * 48) { (void)tr_matrix<0>(r, W, DM, 1536, PIN, 2056, D, DM, 2048, scr, F.lane, a.norm_mix_g + l * DM); continue; } r -= 16 * 48;
            (void)tr_matrix<0>(r, a.w_out + (size_t)l * DM * DM, DM, DM, DM, 0, (bf16*)(ws + WS_WOUT) + (size_t)l * DM * DM, DM, 0, scr, F.lane); continue;
        }
        r -= 4 * PER_LAYER_A;
        if (r < 2 * PER_DENSE) {
            const int j = r / PER_DENSE; r -= j * PER_DENSE;
            bf16* GU = (bf16*)(ws + WS_WGU) + (size_t)j * 2 * FFDP * DM;
            if (tr_matrix<1>(r, a.ffn_w_gate + (size_t)j * DM * FFD, DM, FFD, FFD, 0, GU, DM, 0, scr, F.lane, a.norm_ffn_g + (2 * j) * DM)) continue;
            if (tr_matrix<1>(r, a.ffn_w_up + (size_t)j * DM * FFD, DM, FFD, FFD, 0, GU, DM, 32, scr, F.lane, a.norm_ffn_g + (2 * j) * DM)) continue;
            (void)tr_matrix<0>(r, a.ffn_w_down + (size_t)j * FFD * DM, FFD, DM, DM, 0, (bf16*)(ws + WS_WD) + (size_t)j * DM * FFDP, FFDP, 0, scr, F.lane); continue;
        }
        r -= 2 * PER_DENSE;
        {
            const int je = r / PER_EXP; r -= je * PER_EXP;
            bf16* GU = (bf16*)(ws + WS_MGU) + (size_t)je * 2 * FFE * DM;
            if (tr_matrix<1>(r, a.moe_w_gate + (size_t)je * DM * FFE, DM, FFE, FFE, 0, GU, DM, 0, scr, F.lane, a.norm_ffn_g + (2 * (je >> 3) + 1) * DM)) continue;
            if (tr_matrix<1>(r, a.moe_w_up + (size_t)je * DM * FFE, DM, FFE, FFE, 0, GU, DM, 32, scr, F.lane, a.norm_ffn_g + (2 * (je >> 3) + 1) * DM)) continue;
            (void)tr_matrix<0>(r, a.moe_w_down + (size_t)je * FFE * DM, FFE, DM, DM, 0, (bf16*)(ws + WS_MD) + (size_t)je * DM * FFE, FFE, 0, scr, F.lane);
        }
    }
    const int gt = F.bid * NTHREADS + F.tid, NGT = F.G * NTHREADS;
    for (int i = gt; i < 2 * 128 * (DM / 8); i += NGT) {
        const int j = i / (128 * 128), rr = (i / 128) % 128, ch = i % 128;
        const int row = 21 * 256 + 128 + rr;
        *(GAS v4u*)((bf16*)(ws + WS_WGU) + ((size_t)j * 2 * FFDP + row) * DM + ch * 8) = (v4u){0u, 0u, 0u, 0u};
    }
    for (int i = gt; i < 2 * DM * 8; i += NGT) {
        const int j = i / (DM * 8), row = (i / 8) % DM, ch = i % 8;
        *(GAS v4u*)((bf16*)(ws + WS_WD) + ((size_t)j * DM + row) * FFDP + FFD + ch * 8) = (v4u){0u, 0u, 0u, 0u};
    }
}

struct NormIn { const float* src; const bf16* o2; float* hout; const float* gain; bf16* y; const float* w8; int ld8; float* G; unsigned* cnt; uint2* rinfo; int* cntw; int* rrec; const bf16* src16; bf16* hout16; float* rs; };
template <bool B> struct RowSel { typedef f32x4 T; };
template <> struct RowSel<true> { typedef v2u T; };
template <int MODE, bool S16 = false>
__device__ __forceinline__ void norm_phase(Frame& F, const NormIn& p) {
    typedef typename RowSel<S16>::T RowT;
    LAS float* W8 = (LAS float*)(F.lds + RING_OFF);
    LAS int* lcnt = (LAS int*)(F.lds + RING_OFF + 32768);
    LAS int* lbase = lcnt + 8;
    LAS int* rec = lcnt + 16;
    f32x4 wr[(MODE == 0 || MODE == 2) ? 32 : 1];
    if (MODE == 0 || MODE == 2) {
        for (int i = F.tid; i < DM * 2; i += NTHREADS) *(LAS f32x4*)(W8 + 4 * i) = *(const GAS f32x4*)(p.w8 + (size_t)(i >> 1) * p.ld8 + 4 * (i & 1));
        __syncthreads();
#pragma unroll
        for (int j = 0; j < 4; ++j)
#pragma unroll
            for (int c = 0; c < 4; ++c) { const int k = 4 * (F.lane + 64 * j) + c; wr[(j * 4 + c) * 2] = *(const LAS f32x4*)(W8 + k * 8); wr[(j * 4 + c) * 2 + 1] = *(const LAS f32x4*)(W8 + k * 8 + 4); }
        __syncthreads();
    }
    for (int rb0 = F.bid; rb0 < T / 64; rb0 += F.G) {
        const int rb = (rb0 & 7) * 32 + (rb0 >> 3);
        RowT vn[4], vm[4]; v2u na[4], nb[4], ma[4], mb[4];
        const GAS RowT* const srcr = (S16 ? (const GAS RowT*)p.src16 : (const GAS RowT*)p.src) + F.lane;
        { const int row = rb * 64 + F.wave * 8; const GAS RowT* xr = srcr + (size_t)row * (DM / 4);
#pragma unroll
          for (int j = 0; j < 4; ++j) { vn[j] = xr[64 * j]; vm[j] = xr[64 * j + DM / 4]; }
          if (p.o2) { const GAS v2u* oa = (const GAS v2u*)(p.o2 + (size_t)row * DM) + F.lane; const GAS v2u* ob = (const GAS v2u*)(p.o2 + ((size_t)T + row) * DM) + F.lane;
#pragma unroll
              for (int j = 0; j < 4; ++j) { na[j] = oa[64 * j]; nb[j] = ob[64 * j]; ma[j] = oa[64 * j + DM / 4]; mb[j] = ob[64 * j + DM / 4]; } } }
#pragma unroll 1
        for (int i = 0; i < 8; ++i) {
            const int row = rb * 64 + F.wave * 8 + i;
            f32x4 v[4]; float s = 0.f;
#pragma unroll
            for (int j = 0; j < 4; ++j) { if constexpr (S16) { const v2u a = vn[j]; v[j] = (f32x4){bflo(a.x), bfhi(a.x), bflo(a.y), bfhi(a.y)}; } else v[j] = vn[j]; }
            if (p.o2) {
#pragma unroll
                for (int j = 0; j < 4; ++j) { const v2u a = na[j], b = nb[j];
                    v[j].x += bflo(a.x) + bflo(b.x); v[j].y += bfhi(a.x) + bfhi(b.x); v[j].z += bflo(a.y) + bflo(b.y); v[j].w += bfhi(a.y) + bfhi(b.y); }
            }
#pragma unroll
            for (int j = 0; j < 4; ++j) { vn[j] = vm[j]; na[j] = ma[j]; nb[j] = mb[j]; }
            if (i + 2 < 8) { const int rn = row + 2; const GAS RowT* xr = srcr + (size_t)rn * (DM / 4);
#pragma unroll
                for (int j = 0; j < 4; ++j) vm[j] = xr[64 * j];
                if (p.o2) { const GAS v2u* oa = (const GAS v2u*)(p.o2 + (size_t)rn * DM) + F.lane; const GAS v2u* ob = (const GAS v2u*)(p.o2 + ((size_t)T + rn) * DM) + F.lane;
#pragma unroll
                    for (int j = 0; j < 4; ++j) { ma[j] = oa[64 * j]; mb[j] = ob[64 * j]; } } }
            if (MODE != 3 && p.hout) { GAS f32x4* ho = (GAS f32x4*)(p.hout + (size_t)row * DM) + F.lane;
#pragma unroll
                for (int j = 0; j < 4; ++j) ho[64 * j] = v[j]; }
            if (MODE != 3 && p.hout16) { GAS v2u* ho = (GAS v2u*)(p.hout16 + (size_t)row * DM) + F.lane;
#pragma unroll
                for (int j = 0; j < 4; ++j) { const v2u w = (v2u){pk2(v[j].x, v[j].y), pk2(v[j].z, v[j].w)}; ho[64 * j] = w; v[j] = (f32x4){bflo(w.x), bfhi(w.x), bflo(w.y), bfhi(w.y)}; } }
#pragma unroll
            for (int j = 0; j < 4; ++j) s += (v[j].x * v[j].x + v[j].y * v[j].y) + (v[j].z * v[j].z + v[j].w * v[j].w);
            const float rstd = 1.0f / sqrtf(wave_sum(s) * (1.0f / DM) + EPS);
            const GAS f32x4* gr = (const GAS f32x4*)p.gain + F.lane;
#pragma unroll
            for (int j = 0; j < 4; ++j) { const f32x4 g = gr[64 * j]; v[j] = v[j] * rstd * g; }
            if (MODE == 3) { GAS f32x4* ho = (GAS f32x4*)(p.hout + (size_t)row * DM) + F.lane;
#pragma unroll
                for (int j = 0; j < 4; ++j) ho[64 * j] = v[j];
                continue; }
            if (F.lane == 0) ((GAS float*)p.rs)[row] = rstd;
            if (MODE == 0 || MODE == 2) {
                float d[8];
#pragma unroll
                for (int g = 0; g < 8; ++g) d[g] = 0.f;
#pragma unroll
                for (int j = 0; j < 4; ++j)
#pragma unroll
                    for (int c = 0; c < 4; ++c) { const f32x4 w0 = wr[(j * 4 + c) * 2], w1 = wr[(j * 4 + c) * 2 + 1];
                        const float yv = v[j][c];
                        d[0] += yv * w0.x; d[1] += yv * w0.y; d[2] += yv * w0.z; d[3] += yv * w0.w; d[4] += yv * w1.x; d[5] += yv * w1.y; d[6] += yv * w1.z; d[7] += yv * w1.w; }
#pragma unroll
                for (int g = 0; g < 8; ++g) d[g] = wave_sum(d[g]);
                if (MODE == 0) { if (F.lane == 0) { GAS f32x4* gp = (GAS f32x4*)(p.G + (size_t)row * 8); gp[0] = (f32x4){d[0], d[1], d[2], d[3]}; gp[1] = (f32x4){d[4], d[5], d[6], d[7]}; } }
                else {
                    int e0 = 0; float v0 = d[0];
#pragma unroll
                    for (int g = 1; g < 8; ++g) if (d[g] > v0) { v0 = d[g]; e0 = g; }
                    int e1 = -1; float v1 = -INFINITY;
#pragma unroll
                    for (int g = 0; g < 8; ++g) if (g != e0 && d[g] > v1) { v1 = d[g]; e1 = g; }
                    const float w0 = 1.0f / (1.0f + expf(v1 - v0)), w1 = 1.0f - w0;
                    if (F.lane == 0) { LAS int* rr = rec + (F.wave * 8 + i) * 6; rr[0] = e0; rr[1] = e1; rr[4] = __builtin_bit_cast(int, w0); rr[5] = __builtin_bit_cast(int, w1); }
                }
            }
        }
        if (MODE == 2) {
            __syncthreads();
            if (F.wave == 0) { const LAS int* rr = rec + F.lane * 6; const int e0 = rr[0], e1 = rr[1], row = rb * 64 + F.lane;
                const unsigned long long below = (1ull << F.lane) - 1ull;
                int lp0 = 0, lp1 = 0, mycnt = 0;
#pragma unroll
                for (int e = 0; e < 8; ++e) { const unsigned long long m0 = __ballot(e0 == e), m1 = __ballot(e1 == e);
                    const int lp = __popcll(m0 & below) + __popcll(m1 & below), ce = __popcll(m0) + __popcll(m1);
                    if (e0 == e) lp0 = lp; if (e1 == e) lp1 = lp; if (F.lane == e) mycnt = ce; }
                GAS int* ro = (GAS int*)p.rrec + (size_t)row * 6; ro[0] = e0; ro[1] = e1; ro[2] = lp0; ro[3] = lp1; ro[4] = rr[4]; ro[5] = rr[5];
                if (F.lane < 8) { ((GAS int*)p.cntw)[rb * 8 + F.lane] = mycnt; (void)__hip_atomic_fetch_add(p.cnt + F.lane, (unsigned)mycnt, __ATOMIC_RELAXED, __HIP_MEMORY_SCOPE_AGENT); } }
            __syncthreads();
        }
    }
}

__device__ __forceinline__ void route_finish(Frame& F, const int* cntw, const int* rrec, uint2* rinfo, const float* RS, float* RSI) {
    LAS float* lred = (LAS float*)(F.lds + RING_OFF);
    for (int rb0 = F.bid; rb0 < T / 64; rb0 += F.G) {
        const int rb = (rb0 & 7) * 32 + (rb0 >> 3);
        float c[8];
#pragma unroll
        for (int e = 0; e < 8; ++e) c[e] = 0.f;
        if (F.tid < rb) { const GAS i32x4* cp = (const GAS i32x4*)(cntw + F.tid * 8); const i32x4 a = cp[0], b = cp[1];
            c[0] = (float)a.x; c[1] = (float)a.y; c[2] = (float)a.z; c[3] = (float)a.w; c[4] = (float)b.x; c[5] = (float)b.y; c[6] = (float)b.z; c[7] = (float)b.w; }
#pragma unroll
        for (int e = 0; e < 8; ++e) c[e] = wave_sum(c[e]);
        if (F.lane == 0) {
#pragma unroll
            for (int e = 0; e < 8; ++e) lred[F.wave * 8 + e] = c[e]; }
        __syncthreads();
        if (F.tid < 64) { const int row = rb * 64 + F.tid; const GAS int* rr = (const GAS int*)rrec + (size_t)row * 6;
            const int e0 = rr[0], e1 = rr[1];
            float b0 = 0.f, b1 = 0.f;
#pragma unroll
            for (int w = 0; w < NWAVES; ++w) { b0 += lred[w * 8 + e0]; b1 += lred[w * 8 + e1]; }
            const int p0 = (int)b0 + rr[2], p1 = (int)b1 + rr[3];
            rinfo[(size_t)e0 * T + p0] = make_uint2((unsigned)row * 2u, (unsigned)rr[4]);
            rinfo[(size_t)e1 * T + p1] = make_uint2((unsigned)row * 2u + 1u, (unsigned)rr[5]);
            const float rsr = ((const GAS float*)RS)[row]; ((GAS float*)RSI)[(size_t)e0 * T + p0] = rsr; ((GAS float*)RSI)[(size_t)e1 * T + p1] = rsr; }
        __syncthreads();
    }
}

__device__ __forceinline__ float logsigmoid_f(float x) { return fminf(x, 0.f) - log1pf(expf(-fabsf(x))); }
__device__ __forceinline__ void gate_scan(Frame& F, int bh, const float* G, const float* b_i, const float* b_f, float* GA, float* GM, float* GE, float* TG) {
    LAS float* sc = (LAS float*)(F.lds + RING_OFF);
    const int b = bh >> 2, h = bh & 3, t0 = 4 * F.tid;
    const float bi = b_i[h], bf = b_f[h];
    float lf[4], ig[4];
#pragma unroll
    for (int j = 0; j < 4; ++j) { const float* g = G + ((size_t)b * SEQ + t0 + j) * 8; ig[j] = g[h] + bi; lf[j] = logsigmoid_f(g[4 + h] + bf); }
    float c[4]; c[0] = lf[0]; c[1] = c[0] + lf[1]; c[2] = c[1] + lf[2]; c[3] = c[2] + lf[3];
    float ws = c[3];
    DPP_SCAN(ws, OP_ADD, 0.0f);
    if (F.lane == 63) sc[F.wave] = ws;
    __syncthreads();
    float woff = 0.f;
    for (int w = 0; w < F.wave; ++w) woff += sc[w];
    const float excl = woff + ws - c[3];
    float Fc[4], av[4];
#pragma unroll
    for (int j = 0; j < 4; ++j) { Fc[j] = excl + c[j]; av[j] = ig[j] - Fc[j]; }
    float m[4]; m[0] = av[0]; m[1] = fmaxf(m[0], av[1]); m[2] = fmaxf(m[1], av[2]); m[3] = fmaxf(m[2], av[3]);
    float wm = m[3];
    DPP_SCAN(wm, OP_MAX, -INFINITY);
    if (F.lane == 63) sc[16 + F.wave] = wm;
    __syncthreads();
    float pm = -INFINITY;
    for (int w = 0; w < F.wave; ++w) pm = fmaxf(pm, sc[16 + w]);
    { float u = dpp_f(-INFINITY, wm, 0x111, 0xf);
      const float r15 = dpp_f(-INFINITY, wm, 0x142, 0xa), r31 = dpp_f(-INFINITY, wm, 0x143, 0xc);
      if ((F.lane & 15) == 0) u = (F.lane == 32) ? r31 : r15;
      pm = fmaxf(pm, u); }
    float tmx = m[3];
    tmx = fmaxf(tmx, dpp_f(-INFINITY, tmx, 0x111, 0xf)); tmx = fmaxf(tmx, dpp_f(-INFINITY, tmx, 0x112, 0xf)); tmx = fmaxf(tmx, dpp_f(-INFINITY, tmx, 0x114, 0xf)); tmx = fmaxf(tmx, dpp_f(-INFINITY, tmx, 0x118, 0xf));
    const int tbits = __builtin_bit_cast(int, tmx);
    const float t0m = __builtin_bit_cast(float, __builtin_amdgcn_readlane(tbits, 15)), t1m = __builtin_bit_cast(float, __builtin_amdgcn_readlane(tbits, 31)),
                t2m = __builtin_bit_cast(float, __builtin_amdgcn_readlane(tbits, 47)), t3m = __builtin_bit_cast(float, __builtin_amdgcn_readlane(tbits, 63));
    const int rw = F.lane >> 4; const float tm = rw == 0 ? t0m : (rw == 1 ? t1m : (rw == 2 ? t2m : t3m));
    if ((F.lane & 15) == 0) TG[bh * 32 + F.wave * 4 + rw] = tm * LOG2E;
#pragma unroll
    for (int j = 0; j < 4; ++j) { const float Mt = fmaxf(pm, m[j]); const size_t o = (size_t)bh * SEQ + t0 + j;
        GA[o] = expf(av[j] - tm); GM[o] = Mt * LOG2E; GE[o] = expf(-(Fc[j] + Mt)); }
    __syncthreads();
}

__device__ __forceinline__ void unpack8(const v4u r, float (&d)[8]) { d[0] = bflo(r.x); d[1] = bfhi(r.x); d[2] = bflo(r.y); d[3] = bfhi(r.y); d[4] = bflo(r.z); d[5] = bfhi(r.z); d[6] = bflo(r.w); d[7] = bfhi(r.w); }
__device__ __forceinline__ void conv_phase(Frame& F, const bf16* proj, const float* cw, const float* cb, bf16* qkc, const int hidx, const int nh) {
    const int cbat = F.bid & 7;
    for (int wi = F.wave * nh + hidx; wi < 144; wi += NWAVES * nh) {
        const int kpart = wi >= 128 ? 1 : 0;
        const int seg = cbat * 128 + (kpart ? 112 + (wi - 128) : wi);
        const int t0 = seg * 16, c0 = kpart * 512 + F.lane * 8;
        float w[4][8], bb[8];
#pragma unroll
        for (int tap = 0; tap < 4; ++tap) { const f32x4 a = *(const GAS f32x4*)(cw + tap * 1024 + c0), b = *(const GAS f32x4*)(cw + tap * 1024 + c0 + 4);
            w[tap][0] = a.x; w[tap][1] = a.y; w[tap][2] = a.z; w[tap][3] = a.w; w[tap][4] = b.x; w[tap][5] = b.y; w[tap][6] = b.z; w[tap][7] = b.w; }
        { const f32x4 a = *(const GAS f32x4*)(cb + c0), b = *(const GAS f32x4*)(cb + c0 + 4); bb[0] = a.x; bb[1] = a.y; bb[2] = a.z; bb[3] = a.w; bb[4] = b.x; bb[5] = b.y; bb[6] = b.z; bb[7] = b.w; }
        const float osc = kpart ? KM_SCALE : 1.0f;
        const bool first = (t0 % SEQ) == 0;
        v4u rw[19];
#pragma unroll
        for (int q = 0; q < 3; ++q) { rw[q] = (v4u){0u, 0u, 0u, 0u}; if (!first) rw[q] = *(const GAS v4u*)(proj + (size_t)(t0 - 3 + q) * NPROJ + c0); }
#pragma unroll
        for (int q = 0; q < 16; ++q) rw[3 + q] = *(const GAS v4u*)(proj + (size_t)(t0 + q) * NPROJ + c0);
        float x0[8], x1[8], x2[8];
        unpack8(rw[0], x0); unpack8(rw[1], x1); unpack8(rw[2], x2);
#pragma unroll
        for (int i = 0; i < 16; ++i) {
            float x3[8]; unpack8(rw[3 + i], x3);
            float o[8];
#pragma unroll
            for (int c = 0; c < 8; ++c) { const float yv = bb[c] + x0[c] * w[0][c] + x1[c] * w[1][c] + x2[c] * w[2][c] + x3[c] * w[3][c];
                o[c] = osc * yv * __builtin_amdgcn_rcpf(1.0f + __builtin_amdgcn_exp2f(-yv * LOG2E)); x0[c] = x1[c]; x1[c] = x2[c]; x2[c] = x3[c]; }
            *(GAS v4u*)(qkc + (size_t)(t0 + i) * DM + c0) = (v4u){pk2(o[0], o[1]), pk2(o[2], o[3]), pk2(o[4], o[5]), pk2(o[6], o[7])};
        }
    }
}

__device__ __forceinline__ void naive_sb(Frame& F, const bf16* proj, const float* g_sb, bf16* mixed) {
    LAS float* qs = (LAS float*)(F.lds + RING_OFF) + F.wave * 256;
    LAS float* ps = qs + 64;
    for (int it = F.bid * NWAVES + F.wave; it < T * HS; it += F.G * NWAVES) {
        const int h = it & 7, row = it >> 3, t = row % SEQ, rb = row - t;
        qs[F.lane] = bf2f(proj[(size_t)row * NPROJ + 2048 + h * 64 + F.lane]);
        LDS_WAIT();
        float R = 1.0f, o = 0.f;
        const int nch = (t + 63) / 64;
        for (int c = nch - 1; c >= 0; --c) {
            const int s = 64 * c + F.lane; const bool valid = s < t;
            const bf16* kr = proj + (size_t)(rb + s) * NPROJ + 2560 + h * 64;
            float z = 0.f;
#pragma unroll
            for (int d8 = 0; d8 < 8; ++d8) { const v4u kk = *(const GAS v4u*)(kr + d8 * 8); const f32x4 qa = *(const LAS f32x4*)(qs + d8 * 8), qb = *(const LAS f32x4*)(qs + d8 * 8 + 4);
                z += qa.x * bflo(kk.x) + qa.y * bfhi(kk.x) + qa.z * bflo(kk.y) + qa.w * bfhi(kk.y) + qb.x * bflo(kk.z) + qb.y * bfhi(kk.z) + qb.z * bflo(kk.w) + qb.w * bfhi(kk.w); }
            const float e = exp2f(-z); float beta = 1.0f / (1.0f + e); float omb = 1.0f - beta;
            if (!valid) { beta = 0.f; omb = 1.0f; }
            float pr = omb;
#pragma unroll
            for (int off = 1; off < 64; off <<= 1) { const float u = __shfl_down(pr, off); if (F.lane + off < 64) pr *= u; }
            float ex = __shfl_down(pr, 1); if (F.lane == 63) ex = 1.0f;
            const float a = beta * ex * R;
            R *= __shfl(pr, 0);
            ps[F.lane] = a; LDS_WAIT();
            const bf16* vr = proj + (size_t)(rb + 64 * c) * NPROJ + 3072 + h * 64 + F.lane;
#pragma unroll 8
            for (int j = 0; j < 64; ++j) o += ps[j] * bf2f(vr[(size_t)j * NPROJ]);
            LDS_WAIT();
        }
        const float ss = wave_sum(o * o) * (1.0f / 64.0f);
        const float val = o * (1.0f / sqrtf(ss + EPS)) * g_sb[h * 64 + F.lane];
        mixed[(size_t)row * DM + 512 + h * 64 + F.lane] = (bf16)f2bf(val);
    }
}
__device__ __forceinline__ void naive_mlstm(Frame& F, const bf16* proj, const bf16* qkc, const float* GA, const float* GM, const float* GE, const float* g_m, bf16* mixed) {
    LAS float* qs = (LAS float*)(F.lds + RING_OFF) + F.wave * 256;
    LAS float* ps = qs + 128;
    for (int it = F.bid * NWAVES + F.wave; it < T * HM; it += F.G * NWAVES) {
        const int h = it & 3, row = it >> 2, t = row % SEQ, rb = row - t, b = row / SEQ, bh = b * 4 + h;
        qs[F.lane] = bf2f(qkc[(size_t)row * DM + h * 128 + F.lane]); qs[64 + F.lane] = bf2f(qkc[(size_t)row * DM + h * 128 + 64 + F.lane]);
        LDS_WAIT();
        const float Mt = GM[(size_t)bh * SEQ + t];
        float den = 0.f, o0 = 0.f, o1 = 0.f;
        const int nch = t / 64 + 1;
        for (int c = 0; c < nch; ++c) {
            const int s = 64 * c + F.lane; const bool valid = s <= t;
            const bf16* kr = qkc + (size_t)(rb + s) * DM + 512 + h * 128;
            float z = 0.f;
#pragma unroll
            for (int d8 = 0; d8 < 16; ++d8) { const v4u kk = *(const GAS v4u*)(kr + d8 * 8); const f32x4 qa = *(const LAS f32x4*)(qs + d8 * 8), qb = *(const LAS f32x4*)(qs + d8 * 8 + 4);
                z += qa.x * bflo(kk.x) + qa.y * bfhi(kk.x) + qa.z * bflo(kk.y) + qa.w * bfhi(kk.y) + qb.x * bflo(kk.z) + qb.y * bfhi(kk.z) + qb.z * bflo(kk.w) + qb.w * bfhi(kk.w); }
            const float wgt = valid ? exp2f(GA[(size_t)bh * SEQ + s] - Mt) : 0.f;
            const float pv = z * wgt;
            den += pv;
            ps[F.lane] = pv; LDS_WAIT();
            const bf16* vr = proj + (size_t)(rb + 64 * c) * NPROJ + 1024 + h * 128 + F.lane;
#pragma unroll 8
            for (int j = 0; j < 64; ++j) { const float pj = ps[j]; o0 += pj * bf2f(vr[(size_t)j * NPROJ]); o1 += pj * bf2f(vr[(size_t)j * NPROJ + 64]); }
            LDS_WAIT();
        }
        den = wave_sum(den);
        const float dn = fmaxf(fabsf(den), GE[(size_t)bh * SEQ + t]);
        const float h0 = o0 / dn, h1 = o1 / dn;
        const float ss = wave_sum(h0 * h0 + h1 * h1) * (1.0f / 128.0f);
        const float rs = 1.0f / sqrtf(ss + EPS);
        const float om0 = bf2f(proj[(size_t)row * NPROJ + 1536 + h * 128 + F.lane]), om1 = bf2f(proj[(size_t)row * NPROJ + 1536 + h * 128 + 64 + F.lane]);
        const float r0 = h0 * rs * g_m[h * 128 + F.lane] / (1.0f + expf(-om0)), r1 = h1 * rs * g_m[h * 128 + 64 + F.lane] / (1.0f + expf(-om1));
        mixed[(size_t)row * DM + h * 128 + F.lane] = (bf16)f2bf(r0); mixed[(size_t)row * DM + h * 128 + 64 + F.lane] = (bf16)f2bf(r1);
    }
}

namespace mix {
typedef float f32x16 __attribute__((ext_vector_type(16)));
typedef short s16x4 __attribute__((ext_vector_type(4)));
typedef short v4i16_t __attribute__((ext_vector_type(4)));
typedef unsigned u32x4 __attribute__((ext_vector_type(4)));
typedef LAS const unsigned char* lptr;
#define MX_MFMA(a, b, c) __builtin_amdgcn_mfma_f32_32x32x16_bf16(a, b, c, 0, 0, 0)
__device__ __forceinline__ int crow(int r, int hi) { return (r & 3) + 8 * (r >> 2) + 4 * hi; }
__device__ __forceinline__ unsigned cvtpk(float lo, float hi) { unsigned r; asm("v_cvt_pk_bf16_f32 %0, %1, %2" : "=v"(r) : "v"(lo), "v"(hi)); return r; }
__device__ __forceinline__ s16x4 vtr(lptr p) { return __builtin_bit_cast(s16x4, __builtin_amdgcn_ds_read_tr16_b64_v4i16((LAS v4i16_t*)p)); }
__device__ __forceinline__ float partner(float x, int hi) { auto rr = __builtin_amdgcn_permlane32_swap(__builtin_bit_cast(unsigned, x), __builtin_bit_cast(unsigned, x), false, false);
    return __builtin_bit_cast(float, hi ? rr[0] : rr[1]); }

constexpr int STG_BYTES = 65536, GRP_BYTES = 32768, VIMG_OFF = 16384;
constexpr int EX_OFF = RING_BYTES + 1024;
constexpr int EX_GA = EX_OFF, EX_FA = EX_OFF + 1024, EX_FB = EX_OFF + 1536;

__device__ __forceinline__ void glds16(const void* g, unsigned lds_base) {
    unsigned sv; asm volatile("s_mov_b32 %0, m0\n\ts_mov_b32 m0, %2\n\ts_nop 0\n\tglobal_load_lds_dwordx4 %1, off\n\ts_mov_b32 m0, %0" : "=&s"(sv) : "v"(g), "s"(lds_base) : "memory"); }
__device__ __forceinline__ void glds4(const void* g, unsigned lds_base) {
    unsigned sv; asm volatile("s_mov_b32 %0, m0\n\ts_mov_b32 m0, %2\n\ts_nop 0\n\tglobal_load_lds_dword %1, off\n\ts_mov_b32 m0, %0" : "=&s"(sv) : "v"(g), "s"(lds_base) : "memory"); }
template <int D, bool ML>
__device__ __forceinline__ void issue_tile(unsigned gbase, unsigned gaimg, const bf16* Kp, int pk, const bf16* Vp, int pv, const float* ga, int s0, int w4, int lane) {
#pragma unroll
    for (int c = 0; c < D / 32; ++c) { const int ch = w4 + 4 * c;
        glds16(Kp + (size_t)(s0 + lane) * pk + 8 * ch, (unsigned)__builtin_amdgcn_readfirstlane(gbase + ch * 1024)); }
#pragma unroll
    for (int c = 0; c < D / 32; ++c) { const int idx = w4 + 4 * c, dp = idx >> 2, rg = idx & 3;
        glds16(Vp + (size_t)(s0 + 16 * rg + (lane >> 2)) * pv + 32 * dp + 8 * (lane & 3), (unsigned)__builtin_amdgcn_readfirstlane(gbase + VIMG_OFF + dp * 4096 + rg * 1024)); }
    if (ML) { if (w4 == 0) glds4(ga + s0 + lane, (unsigned)__builtin_amdgcn_readfirstlane(gaimg)); }
}

template <int D, bool SBK, bool MASK>
__device__ __forceinline__ void compute_tile(lptr kimg, lptr vimg, LAS const float* gat, const bf16x8 (&qr)[D / 16], f32x16 (&o)[D / 32], float& st, const float Mt, const int qrow, const int key0, const int lane) {
    const int r32 = lane & 31, hi = lane >> 5;
    f32x16 p0 = {}, p1 = {};
    const lptr kp = kimg + hi * 1024 + r32 * 16;
    {
        bf16x8 kf[D / 8];
#pragma unroll
        for (int d0 = 0; d0 < D / 16; ++d0) { kf[2 * d0] = *(LAS const bf16x8*)(kp + d0 * 2048); kf[2 * d0 + 1] = *(LAS const bf16x8*)(kp + d0 * 2048 + 512); }
        __builtin_amdgcn_sched_barrier(0);
#pragma unroll
        for (int d0 = 0; d0 < D / 16; ++d0) { p0 = MX_MFMA(kf[2 * d0], qr[d0], p0); p1 = MX_MFMA(kf[2 * d0 + 1], qr[d0], p1); }
    }
    const lptr vp = vimg + ((lane >> 4) & 1) * 32 + (lane & 3) * 8 + (4 * hi + ((lane & 15) >> 2)) * 64;
    s16x4 vlo[D / 8], vhi[D / 8];
#pragma unroll
    for (int dp = 0; dp < D / 32; ++dp)
#pragma unroll
        for (int ks = 0; ks < 4; ++ks) { vlo[dp * 4 + ks] = vtr(vp + dp * 4096 + ks * 1024); vhi[dp * 4 + ks] = vtr(vp + dp * 4096 + ks * 1024 + 512); }
    __builtin_amdgcn_sched_barrier(0);
    u32x4 pw[4];
    if constexpr (SBK) {
        float R = st;
#pragma unroll
        for (int blk = 1; blk >= 0; --blk) {
            const f32x16& X = blk ? p1 : p0; const int kb = key0 + 32 * blk;
            float bt[16], sx[16], Pg[4], Qg[4];
#pragma unroll
            for (int g = 0; g < 4; ++g) { float run = 1.f;
#pragma unroll
                for (int i = 3; i >= 0; --i) { const int r = 4 * g + i; float z = X[r]; if (MASK) z = (kb + crow(r, hi) < qrow) ? z : -INFINITY;
                    const float e = __builtin_amdgcn_exp2f(-z); const float b = __builtin_amdgcn_rcpf(1.0f + e); bt[r] = b; sx[r] = run; run *= (1.0f - b); }
                Pg[g] = run; }
#pragma unroll
            for (int g = 0; g < 4; ++g) Qg[g] = partner(Pg[g], hi);
            float a[16];
#pragma unroll
            for (int g = 3; g >= 0; --g) { const float pre = R * (hi ? 1.0f : Qg[g]);
#pragma unroll
                for (int i = 0; i < 4; ++i) a[4 * g + i] = bt[4 * g + i] * sx[4 * g + i] * pre;
                R *= Pg[g] * Qg[g]; }
            pw[2 * blk] = (u32x4){cvtpk(a[0], a[1]), cvtpk(a[2], a[3]), cvtpk(a[4], a[5]), cvtpk(a[6], a[7])};
            pw[2 * blk + 1] = (u32x4){cvtpk(a[8], a[9]), cvtpk(a[10], a[11]), cvtpk(a[12], a[13]), cvtpk(a[14], a[15])};
        }
        st = R;
    } else {
        float den = st;
#pragma unroll
        for (int blk = 0; blk < 2; ++blk) {
            const f32x16& X = blk ? p1 : p0; const int kb = key0 + 32 * blk;
            float a[16];
#pragma unroll
            for (int g = 0; g < 4; ++g) { const f32x4 gv = *(LAS const f32x4*)(gat + 32 * blk + 8 * g + 4 * hi);
#pragma unroll
                for (int i = 0; i < 4; ++i) { const int r = 4 * g + i; float p = X[r] * __builtin_amdgcn_exp2f(gv[i] - Mt); if (MASK) p = (kb + crow(r, hi) <= qrow) ? p : 0.f; den += p; a[r] = p; } }
            pw[2 * blk] = (u32x4){cvtpk(a[0], a[1]), cvtpk(a[2], a[3]), cvtpk(a[4], a[5]), cvtpk(a[6], a[7])};
            pw[2 * blk + 1] = (u32x4){cvtpk(a[8], a[9]), cvtpk(a[10], a[11]), cvtpk(a[12], a[13]), cvtpk(a[14], a[15])};
        }
        st = den;
    }
    __builtin_amdgcn_sched_barrier(0);
#pragma unroll
    for (int dp = 0; dp < D / 32; ++dp)
#pragma unroll
        for (int ks = 0; ks < 4; ++ks) { const s16x4 a = vlo[dp * 4 + ks], b = vhi[dp * 4 + ks];
            const bf16x8 vf = (bf16x8){a[0], a[1], a[2], a[3], b[0], b[1], b[2], b[3]};
            o[dp] = MX_MFMA(__builtin_bit_cast(bf16x8, pw[ks]), vf, o[dp]); }
}

template <int D, bool SBK>
__device__ __forceinline__ void attn_unit(LAS unsigned char* lds, const int tid_in, const bf16* Qp, int pq, const bf16* Kp, int pk, const bf16* Vp, int pv,
                                          const float* ga, const float* gm, const float* ge, const int qb, bf16* out, const float* gain, const bf16* om) {
    int tid = tid_in; asm volatile("" : "+v"(tid));
    const int lane = tid & 63, wid = __builtin_amdgcn_readfirstlane(tid >> 6), grp = wid >> 2, w4 = wid & 3, r32 = lane & 31, hi = lane >> 5;
    const int t0 = 128 * qb, ns = qb + 1, nt = 2 * ns;
    const int qrow = t0 + 32 * w4 + r32;
    bf16x8 qr[D / 16];
#pragma unroll
    for (int d0 = 0; d0 < D / 16; ++d0) qr[d0] = *(const GAS bf16x8*)(Qp + (size_t)qrow * pq + d0 * 16 + hi * 8);
    float Mt = 0.f; if (!SBK) Mt = gm[qrow];
    f32x16 o[D / 32];
#pragma unroll
    for (int i = 0; i < D / 32; ++i) o[i] = f32x16{};
    float st = SBK ? 1.0f : 0.0f;
    LAS unsigned char* const gb0 = lds + grp * GRP_BYTES; LAS unsigned char* const ga0 = lds + EX_GA + grp * 256;
    const unsigned gb0u = (unsigned)(size_t)gb0, ga0u = (unsigned)(size_t)ga0;
    const int tfirst = grp ? ns - 1 : nt - 1;
    issue_tile<D, !SBK>(gb0u, ga0u, Kp, pk, Vp, pv, ga, 64 * tfirst, w4, lane);
#pragma unroll
    for (int d0 = 0; d0 < D / 16; ++d0) asm volatile("" : "+v"(qr[d0]));
    asm volatile("" : "+v"(Mt));
    for (int i = 0; i < ns; ++i) {
        const int tl = tfirst - i, sb = (i & 1);
        asm volatile("s_waitcnt vmcnt(0)" ::: "memory");
        __builtin_amdgcn_s_barrier();
        asm volatile("" ::: "memory");
        if (i + 1 < ns) issue_tile<D, !SBK>(gb0u + (sb ^ 1) * STG_BYTES, ga0u + (sb ^ 1) * 512, Kp, pk, Vp, pv, ga, 64 * (tl - 1), w4, lane);
        const lptr kimg = (lptr)(gb0 + sb * STG_BYTES); LAS const float* gat = (LAS const float*)(ga0 + sb * 512);
        if (tl >= nt - 2) compute_tile<D, SBK, true>(kimg, kimg + VIMG_OFF, gat, qr, o, st, Mt, qrow, 64 * tl, lane);
        else compute_tile<D, SBK, false>(kimg, kimg + VIMG_OFF, gat, qr, o, st, Mt, qrow, 64 * tl, lane);
    }
    constexpr int PITCH = D + 4;
    LAS float* stg = (LAS float*)lds; LAS float* fA = (LAS float*)(lds + EX_FA); LAS float* fB = (LAS float*)(lds + EX_FB);
    if (!SBK) st += partner(st, hi);
    LDS_WAIT(); __builtin_amdgcn_s_barrier(); asm volatile("" ::: "memory");
    if (grp == 1) {
#pragma unroll
        for (int dp = 0; dp < D / 32; ++dp)
#pragma unroll
            for (int r = 0; r < 16; ++r) stg[(32 * w4 + crow(r, hi)) * PITCH + 32 * dp + r32] = o[dp][r];
        if (hi == 0) fB[32 * w4 + r32] = st;
    } else { if (hi == 0) fA[32 * w4 + r32] = st; }
    LDS_WAIT(); __builtin_amdgcn_s_barrier(); asm volatile("" ::: "memory");
    if (grp == 0) {
#pragma unroll
        for (int r = 0; r < 16; ++r) { const int row = 32 * w4 + crow(r, hi); const float f = SBK ? fA[row] : 1.0f;
#pragma unroll
            for (int dp = 0; dp < D / 32; ++dp) { LAS float* p = stg + row * PITCH + 32 * dp + r32; *p = o[dp][r] + f * (*p); } }
    }
    LDS_WAIT(); __builtin_amdgcn_s_barrier(); asm volatile("" ::: "memory");
    {
        constexpr int NC = D / 4;
        const int row = tid >> 2, qd = tid & 3, trow = t0 + row;
        float v[NC];
#pragma unroll
        for (int c = 0; c < NC / 4; ++c) { const f32x4 x = *(LAS const f32x4*)(stg + row * PITCH + qd * NC + 4 * c); v[4 * c] = x.x; v[4 * c + 1] = x.y; v[4 * c + 2] = x.z; v[4 * c + 3] = x.w; }
        if (!SBK) { const float den = fA[row] + fB[row]; const float inv = 1.0f / fmaxf(fabsf(den), ge[trow]);
#pragma unroll
            for (int c = 0; c < NC; ++c) v[c] *= inv; }
        float ss = 0.f;
#pragma unroll
        for (int c = 0; c < NC; ++c) ss += v[c] * v[c];
        ss += __shfl_xor(ss, 1); ss += __shfl_xor(ss, 2);
        const float rs = 1.0f / sqrtf(ss * (1.0f / D) + EPS);
        bf16* op = out + (size_t)trow * DM + qd * NC;
#pragma unroll
        for (int c8 = 0; c8 < NC / 8; ++c8) {
            float w[8];
#pragma unroll
            for (int c = 0; c < 8; ++c) w[c] = v[8 * c8 + c] * rs * gain[qd * NC + 8 * c8 + c];
            if (!SBK) { const v4u g = *(const GAS v4u*)(om + (size_t)trow * NPROJ + qd * NC + 8 * c8); float gg[8];
                gg[0] = bflo(g.x); gg[1] = bfhi(g.x); gg[2] = bflo(g.y); gg[3] = bfhi(g.y); gg[4] = bflo(g.z); gg[5] = bfhi(g.z); gg[6] = bflo(g.w); gg[7] = bfhi(g.w);
#pragma unroll
                for (int c = 0; c < 8; ++c) w[c] *= 1.0f / (1.0f + __expf(-gg[c])); }
            *(GAS v4u*)(op + 8 * c8) = (v4u){pk2(w[0], w[1]), pk2(w[2], w[3]), pk2(w[4], w[5]), pk2(w[6], w[7])};
        }
    }
    LDS_WAIT(); __builtin_amdgcn_s_barrier(); asm volatile("" ::: "memory");
}
#undef MX_MFMA
}

typedef unsigned cs_u32x2 __attribute__((ext_vector_type(2)));
constexpr int CS_PART = 4160, CS_IMG = 4 * CS_PART, CS_NV = 8 * CS_IMG;
static_assert(CS_NV + 16384 <= MISC_OFF, "chunk-state LDS map");
__device__ __forceinline__ void chunk_state_unit(Frame& F, const int bh, const int j, const bf16* proj, const float* cw, const float* cb, const float* GAw, const float* TG,
                                                 bf16* U, float* NV, float* CM, bf16* qkc) {
    using mix::f32x16; using mix::s16x4; using mix::vtr; using mix::lptr; using mix::cvtpk;
    const int b = bh >> 2, h = bh & 3, tid = F.tid, lane = F.lane, wid = F.wave;
    const size_t r0 = (size_t)b * SEQ;
    const int cg = tid & 15, kg = tid >> 4, c0 = 8 * cg, tl = kg >> 3;
    const int s0 = 256 * j + 8 * kg;
    LAS unsigned char* const img = F.lds + RING_OFF;
    const bf16* kp = proj + (r0 + s0) * NPROJ + 512 + h * 128 + c0;
    const bf16* vp = proj + (r0 + s0) * NPROJ + 1024 + h * 128 + c0;
    v4u kr[11], vr[8];
#pragma unroll
    for (int q = 0; q < 3; ++q) { kr[q] = (v4u){0u, 0u, 0u, 0u}; if (s0 > 0) kr[q] = *(const GAS v4u*)(kp + (ptrdiff_t)(q - 3) * NPROJ); }
#pragma unroll
    for (int q = 0; q < 8; ++q) { kr[3 + q] = *(const GAS v4u*)(kp + (size_t)q * NPROJ); vr[q] = *(const GAS v4u*)(vp + (size_t)q * NPROJ); }
    const f32x4 ga0 = *(const GAS f32x4*)(GAw + (size_t)bh * SEQ + s0), ga1 = *(const GAS f32x4*)(GAw + (size_t)bh * SEQ + s0 + 4);
    const float t0g = TG[bh * 32 + 4 * j], t1g = TG[bh * 32 + 4 * j + 1], t2g = TG[bh * 32 + 4 * j + 2], t3g = TG[bh * 32 + 4 * j + 3];
    const float cm = fmaxf(fmaxf(t0g, t1g), fmaxf(t2g, t3g));
    const float tf = __builtin_amdgcn_exp2f((tl == 0 ? t0g : (tl == 1 ? t1g : (tl == 2 ? t2g : t3g))) - cm);
    float w[4][8], bb[8];
#pragma unroll
    for (int tap = 0; tap < 4; ++tap) { const f32x4 x = *(const GAS f32x4*)(cw + tap * 1024 + 512 + h * 128 + c0), y = *(const GAS f32x4*)(cw + tap * 1024 + 512 + h * 128 + c0 + 4);
        w[tap][0] = x.x; w[tap][1] = x.y; w[tap][2] = x.z; w[tap][3] = x.w; w[tap][4] = y.x; w[tap][5] = y.y; w[tap][6] = y.z; w[tap][7] = y.w; }
    { const f32x4 x = *(const GAS f32x4*)(cb + 512 + h * 128 + c0), y = *(const GAS f32x4*)(cb + 512 + h * 128 + c0 + 4); bb[0] = x.x; bb[1] = x.y; bb[2] = x.z; bb[3] = x.w; bb[4] = y.x; bb[5] = y.y; bb[6] = y.z; bb[7] = y.w; }
    {
        float nvp[8];
#pragma unroll
        for (int c = 0; c < 8; ++c) nvp[c] = 0.f;
        float x0[8], x1[8], x2[8];
        unpack8(kr[0], x0); unpack8(kr[1], x1); unpack8(kr[2], x2);
        LAS unsigned char* const wp = img + tl * (2 * CS_IMG) + (cg >> 2) * CS_PART + (8 * (kg & 7)) * 64 + (cg & 3) * 16;
#pragma unroll
        for (int i = 0; i < 8; ++i) {
            float x3[8], o[8], xv[8]; unpack8(kr[3 + i], x3); unpack8(vr[i], xv);
            const float ws_ = (i < 4 ? ga0[i & 3] : ga1[i & 3]) * tf;
#pragma unroll
            for (int c = 0; c < 8; ++c) { const float yv = bb[c] + x0[c] * w[0][c] + x1[c] * w[1][c] + x2[c] * w[2][c] + x3[c] * w[3][c];
                o[c] = KM_SCALE * yv * __builtin_amdgcn_rcpf(1.0f + __builtin_amdgcn_exp2f(-yv * LOG2E)); nvp[c] += ws_ * o[c]; x0[c] = x1[c]; x1[c] = x2[c]; x2[c] = x3[c]; }
            const v4u kcv = (v4u){pk2(o[0], o[1]), pk2(o[2], o[3]), pk2(o[4], o[5]), pk2(o[6], o[7])};
            *(LAS v4u*)(wp + i * 64) = kcv;
            *(GAS v4u*)(qkc + (r0 + s0 + i) * DM + 512 + h * 128 + c0) = kcv;
            *(LAS v4u*)(wp + CS_IMG + i * 64) = (v4u){pk2(xv[0] * ws_, xv[1] * ws_), pk2(xv[2] * ws_, xv[3] * ws_), pk2(xv[4] * ws_, xv[5] * ws_), pk2(xv[6] * ws_, xv[7] * ws_)};
        }
        LAS float* np = (LAS float*)(img + CS_NV) + kg * 128 + c0;
        *(LAS f32x4*)np = (f32x4){nvp[0], nvp[1], nvp[2], nvp[3]}; *(LAS f32x4*)(np + 4) = (f32x4){nvp[4], nvp[5], nvp[6], nvp[7]};
    }
    LDS_WAIT(); __syncthreads();
    if (tid < 128) { const LAS float* np = (const LAS float*)(img + CS_NV) + tid; float nv = 0.f;
#pragma unroll
        for (int g = 0; g < 32; ++g) nv += np[g * 128];
        NV[((size_t)bh * 7 + j) * 128 + tid] = nv; }
    if (tid == 0) { CM[bh * 8 + j] = cm; if (j == 6) CM[bh * 8 + 7] = cm; }
    {
        const int hi = lane >> 5, r32 = lane & 31;
        const lptr fb = (lptr)img + ((lane >> 4) & 1) * 32 + (lane & 3) * 8 + (4 * hi + ((lane & 15) >> 2)) * 64;
        unsigned short* Uj = (unsigned short*)U + ((size_t)bh * 7 + j) * 16384;
#pragma unroll
        for (int q = 0; q < 2; ++q) { const int idx = 2 * wid + q, dpd = idx >> 2, dpe = idx & 3;
            f32x16 acc = {};
#pragma unroll
            for (int t = 0; t < 4; ++t)
#pragma unroll
                for (int ks = 0; ks < 4; ++ks) { const lptr tb = fb + t * (2 * CS_IMG) + ks * 1024;
                    const s16x4 a0 = vtr(tb + CS_IMG + dpe * CS_PART), a1 = vtr(tb + CS_IMG + dpe * CS_PART + 512), b0 = vtr(tb + dpd * CS_PART), b1 = vtr(tb + dpd * CS_PART + 512);
                    acc = __builtin_amdgcn_mfma_f32_32x32x16_bf16(((bf16x8){a0[0], a0[1], a0[2], a0[3], a1[0], a1[1], a1[2], a1[3]}), ((bf16x8){b0[0], b0[1], b0[2], b0[3], b1[0], b1[1], b1[2], b1[3]}), acc, 0, 0, 0); }
#pragma unroll
            for (int g = 0; g < 4; ++g) *(GAS cs_u32x2*)(Uj + (size_t)(32 * dpd + r32) * 128 + 32 * dpe + 8 * g + 4 * hi) = (cs_u32x2){pk2(acc[4 * g], acc[4 * g + 1]), pk2(acc[4 * g + 2], acc[4 * g + 3])};
        }
    }
    LDS_WAIT(); __syncthreads();
}

typedef const __attribute__((address_space(4))) Args* KArgs;
#define KA(field) ({ KArgs _p = kap; asm volatile("" : "+s"(_p)); _p->field; })
#define WSP(off) ((unsigned char*)KA(ws) + (off))
namespace mix2 {
using mix::f32x16; using mix::s16x4; using mix::u32x4; using mix::lptr; using mix::crow; using mix::cvtpk; using mix::vtr; using mix::partner; using mix::glds16; using mix::glds4;
#define MX_MFMA(a, b, c) __builtin_amdgcn_mfma_f32_32x32x16_bf16(a, b, c, 0, 0, 0)
constexpr int NKB = 3, NVB = 4;
constexpr int KBUF0 = 0, VBUF0 = NKB * 16384, BUFSZ = 16384, STAGE0 = (NKB + NVB) * 16384, STAGE_W = 4608;
constexpr int EX_GA = STAGE0 + 8 * STAGE_W;
constexpr int EX_DEAD = EX_GA + NVB * 256;
static_assert(EX_DEAD + 64 <= MISC_OFF, "mixer LDS map");
struct UnitP { int b, h, qb, layer; };
template <bool SBK> struct LoopPtrs { const bf16* Kp; const bf16* Vp; const float* ga; int pk, pv; };
template <bool SBK> __device__ __forceinline__ LoopPtrs<SBK> loop_ptrs(KArgs kap, const UnitP& u) {
    LoopPtrs<SBK> p; const size_t r0 = (size_t)u.b * SEQ; const bf16* proj = (const bf16*)WSP(WS_PROJ);
    if (SBK) { p.Kp = proj + r0 * NPROJ + 2560 + u.h * 64; p.Vp = proj + r0 * NPROJ + 3072 + u.h * 64; p.ga = nullptr; p.pk = NPROJ; p.pv = NPROJ; }
    else { const bf16* qkc = (const bf16*)WSP(WS_QKC); p.Kp = qkc + r0 * DM + 512 + u.h * 128; p.Vp = proj + r0 * NPROJ + 1024 + u.h * 128; p.ga = (const float*)WSP(WS_GA) + (size_t)(u.b * 4 + u.h) * SEQ; p.pk = DM; p.pv = NPROJ; }
    return p;
}

template <int D, bool ML, class LP>
__device__ __forceinline__ void issue_tile(unsigned kbuf, unsigned vbuf, unsigned gabuf, const LP& u, int s0, int wid, int lane) {
#pragma unroll
    for (int c = 0; c < D / 64; ++c) { const int ch = wid + 8 * c;
        glds16(u.Kp + (size_t)(s0 + lane) * u.pk + 8 * ch, (unsigned)__builtin_amdgcn_readfirstlane(kbuf + ch * 1024)); }
#pragma unroll
    for (int c = 0; c < D / 64; ++c) { const int idx = wid + 8 * c, dp = idx >> 2, rg = idx & 3;
        glds16(u.Vp + (size_t)(s0 + 16 * rg + (lane >> 2)) * u.pv + 32 * dp + 8 * (lane & 3), (unsigned)__builtin_amdgcn_readfirstlane(vbuf + dp * 4096 + rg * 1024)); }
    if (ML) glds4(u.ga + s0 + lane, (unsigned)__builtin_amdgcn_readfirstlane(gabuf));
}
template <int D>
__device__ __forceinline__ void qk(lptr kimg, const bf16x8 (&qr)[D / 16], f32x16& p0, f32x16& p1, const int lane) {
    const lptr kp = kimg + (lane >> 5) * 1024 + (lane & 31) * 16;
    p0 = f32x16{}; p1 = f32x16{};
#pragma unroll
    for (int hb = 0; hb < D / 64; ++hb) {
        bf16x8 kf[8];
#pragma unroll
        for (int d = 0; d < 4; ++d) { const int d0 = 4 * hb + d; kf[2 * d] = *(LAS const bf16x8*)(kp + d0 * 2048); kf[2 * d + 1] = *(LAS const bf16x8*)(kp + d0 * 2048 + 512); }
        __builtin_amdgcn_sched_barrier(0);
#pragma unroll
        for (int d = 0; d < 4; ++d) { const int d0 = 4 * hb + d; p0 = MX_MFMA(kf[2 * d], qr[d0], p0); p1 = MX_MFMA(kf[2 * d + 1], qr[d0], p1); }
        __builtin_amdgcn_sched_barrier(0);
    }
}
template <int D, bool SBK, bool MASK>
__device__ __forceinline__ void vp(lptr vimg, LAS const float* gat, const f32x16& p0, const f32x16& p1, f32x16 (&o)[D / 32], float& st, const float Mt, const int qrow, const int key0, const int lane) {
    const int hi = lane >> 5;
    const lptr vb = vimg + ((lane >> 4) & 1) * 32 + (lane & 3) * 8 + (4 * hi + ((lane & 15) >> 2)) * 64;
    constexpr int VPRE = (D == 128) ? 2 : D / 32;
    s16x4 vlo[VPRE * 4], vhi[VPRE * 4];
#pragma unroll
    for (int dp = 0; dp < VPRE; ++dp)
#pragma unroll
        for (int ks = 0; ks < 4; ++ks) { vlo[dp * 4 + ks] = vtr(vb + dp * 4096 + ks * 1024); vhi[dp * 4 + ks] = vtr(vb + dp * 4096 + ks * 1024 + 512); }
    __builtin_amdgcn_sched_barrier(0);
    u32x4 pw[4];
    if constexpr (SBK) {
        float R = st;
#pragma unroll
        for (int blk = 1; blk >= 0; --blk) {
            const f32x16& X = blk ? p1 : p0; const int kb = key0 + 32 * blk;
            float bt[16], sx[16], Pg[4], Qg[4];
#pragma unroll
            for (int g = 0; g < 4; ++g) { float run = 1.f;
#pragma unroll
                for (int i = 3; i >= 0; --i) { const int r = 4 * g + i; float z = X[r]; if (MASK) z = (kb + crow(r, hi) < qrow) ? z : -INFINITY;
                    const float e = __builtin_amdgcn_exp2f(-z); const float b = __builtin_amdgcn_rcpf(1.0f + e); bt[r] = b; sx[r] = run; run *= (1.0f - b); }
                Pg[g] = run; }
#pragma unroll
            for (int g = 0; g < 4; ++g) Qg[g] = partner(Pg[g], hi);
            float a[16];
#pragma unroll
            for (int g = 3; g >= 0; --g) { const float pre = R * (hi ? 1.0f : Qg[g]);
#pragma unroll
                for (int i = 0; i < 4; ++i) a[4 * g + i] = bt[4 * g + i] * sx[4 * g + i] * pre;
                R *= Pg[g] * Qg[g]; }
            pw[2 * blk] = (u32x4){cvtpk(a[0], a[1]), cvtpk(a[2], a[3]), cvtpk(a[4], a[5]), cvtpk(a[6], a[7])};
            pw[2 * blk + 1] = (u32x4){cvtpk(a[8], a[9]), cvtpk(a[10], a[11]), cvtpk(a[12], a[13]), cvtpk(a[14], a[15])};
        }
        st = R;
    } else {
        float den = st;
#pragma unroll
        for (int blk = 0; blk < 2; ++blk) {
            const f32x16& X = blk ? p1 : p0; const int kb = key0 + 32 * blk;
            float a[16];
#pragma unroll
            for (int g = 0; g < 4; ++g) { const f32x4 gv = *(LAS const f32x4*)(gat + 32 * blk + 8 * g + 4 * hi);
#pragma unroll
                for (int i = 0; i < 4; ++i) { const int r = 4 * g + i; float p = X[r] * (gv[i] * Mt); if (MASK) p = (kb + crow(r, hi) <= qrow) ? p : 0.f; den += p; a[r] = p; } }
            pw[2 * blk] = (u32x4){cvtpk(a[0], a[1]), cvtpk(a[2], a[3]), cvtpk(a[4], a[5]), cvtpk(a[6], a[7])};
            pw[2 * blk + 1] = (u32x4){cvtpk(a[8], a[9]), cvtpk(a[10], a[11]), cvtpk(a[12], a[13]), cvtpk(a[14], a[15])};
        }
        st = den;
    }
    __builtin_amdgcn_sched_barrier(0);
    if constexpr (VPRE < D / 32) {
#pragma unroll
        for (int dp = 0; dp < VPRE; ++dp)
#pragma unroll
            for (int ks = 0; ks < 4; ++ks) { const s16x4 a = vlo[dp * 4 + ks], b = vhi[dp * 4 + ks];
                o[dp] = MX_MFMA(__builtin_bit_cast(bf16x8, pw[ks]), ((bf16x8){a[0], a[1], a[2], a[3], b[0], b[1], b[2], b[3]}), o[dp]); }
        __builtin_amdgcn_sched_barrier(0);
        s16x4 wlo[(D / 32 - VPRE) * 4], whi[(D / 32 - VPRE) * 4];
#pragma unroll
        for (int dp = VPRE; dp < D / 32; ++dp)
#pragma unroll
            for (int ks = 0; ks < 4; ++ks) { wlo[(dp - VPRE) * 4 + ks] = vtr(vb + dp * 4096 + ks * 1024); whi[(dp - VPRE) * 4 + ks] = vtr(vb + dp * 4096 + ks * 1024 + 512); }
        __builtin_amdgcn_sched_barrier(0);
#pragma unroll
        for (int dp = VPRE; dp < D / 32; ++dp)
#pragma unroll
            for (int ks = 0; ks < 4; ++ks) { const s16x4 a = wlo[(dp - VPRE) * 4 + ks], b = whi[(dp - VPRE) * 4 + ks];
                o[dp] = MX_MFMA(__builtin_bit_cast(bf16x8, pw[ks]), ((bf16x8){a[0], a[1], a[2], a[3], b[0], b[1], b[2], b[3]}), o[dp]); }
    } else {
#pragma unroll
        for (int dp = 0; dp < D / 32; ++dp)
#pragma unroll
            for (int ks = 0; ks < 4; ++ks) { const s16x4 a = vlo[dp * 4 + ks], b = vhi[dp * 4 + ks];
                o[dp] = MX_MFMA(__builtin_bit_cast(bf16x8, pw[ks]), ((bf16x8){a[0], a[1], a[2], a[3], b[0], b[1], b[2], b[3]}), o[dp]); }
    }
}
template <int D, bool SBK, bool MASK>
__device__ __forceinline__ void valu(LAS const float* gat, const f32x16& p0, const f32x16& p1, u32x4 (&pw)[4], float& st, const float Mt, const int qrow, const int key0, const int lane) {
    const int hi = lane >> 5;
    if constexpr (SBK) {
        float R = st;
#pragma unroll
        for (int blk = 1; blk >= 0; --blk) {
            const f32x16& X = blk ? p1 : p0; const int kb = key0 + 32 * blk;
            float bt[16], sx[16], Pg[4], Qg[4];
#pragma unroll
            for (int g = 0; g < 4; ++g) { float run = 1.f;
#pragma unroll
                for (int i = 3; i >= 0; --i) { const int r = 4 * g + i; float z = X[r]; if (MASK) z = (kb + crow(r, hi) < qrow) ? z : -INFINITY;
                    const float e = __builtin_amdgcn_exp2f(-z); const float b = __builtin_amdgcn_rcpf(1.0f + e); bt[r] = b; sx[r] = run; run *= (1.0f - b); }
                Pg[g] = run; }
#pragma unroll
            for (int g = 0; g < 4; ++g) Qg[g] = partner(Pg[g], hi);
            float a[16];
#pragma unroll
            for (int g = 3; g >= 0; --g) { const float pre = R * (hi ? 1.0f : Qg[g]);
#pragma unroll
                for (int i = 0; i < 4; ++i) a[4 * g + i] = bt[4 * g + i] * sx[4 * g + i] * pre;
                R *= Pg[g] * Qg[g]; }
            pw[2 * blk] = (u32x4){cvtpk(a[0], a[1]), cvtpk(a[2], a[3]), cvtpk(a[4], a[5]), cvtpk(a[6], a[7])};
            pw[2 * blk + 1] = (u32x4){cvtpk(a[8], a[9]), cvtpk(a[10], a[11]), cvtpk(a[12], a[13]), cvtpk(a[14], a[15])};
        }
        st = R;
    } else {
        float den = st;
#pragma unroll
        for (int blk = 0; blk < 2; ++blk) {
            const f32x16& X = blk ? p1 : p0; const int kb = key0 + 32 * blk;
            float a[16];
#pragma unroll
            for (int g = 0; g < 4; ++g) { const f32x4 gv = *(LAS const f32x4*)(gat + 32 * blk + 8 * g + 4 * hi);
#pragma unroll
                for (int i = 0; i < 4; ++i) { const int r = 4 * g + i; float p = X[r] * (gv[i] * Mt); if (MASK) p = (kb + crow(r, hi) <= qrow) ? p : 0.f; den += p; a[r] = p; } }
            pw[2 * blk] = (u32x4){cvtpk(a[0], a[1]), cvtpk(a[2], a[3]), cvtpk(a[4], a[5]), cvtpk(a[6], a[7])};
            pw[2 * blk + 1] = (u32x4){cvtpk(a[8], a[9]), cvtpk(a[10], a[11]), cvtpk(a[12], a[13]), cvtpk(a[14], a[15])};
        }
        st = den;
    }
}
template <int D>
__device__ __forceinline__ void pv(lptr vimg, const u32x4 (&pw)[4], f32x16 (&o)[D / 32], const int lane) {
    const int hi = lane >> 5;
    const lptr vb = vimg + ((lane >> 4) & 1) * 32 + (lane & 3) * 8 + (4 * hi + ((lane & 15) >> 2)) * 64;
#pragma unroll
    for (int hb = 0; hb < D / 64; ++hb) {
        s16x4 vlo[8], vhi[8];
#pragma unroll
        for (int d = 0; d < 2; ++d)
#pragma unroll
            for (int ks = 0; ks < 4; ++ks) { const int dp = 2 * hb + d; vlo[d * 4 + ks] = vtr(vb + dp * 4096 + ks * 1024); vhi[d * 4 + ks] = vtr(vb + dp * 4096 + ks * 1024 + 512); }
        __builtin_amdgcn_sched_barrier(0);
#pragma unroll
        for (int d = 0; d < 2; ++d)
#pragma unroll
            for (int ks = 0; ks < 4; ++ks) { const int dp = 2 * hb + d; const s16x4 a = vlo[d * 4 + ks], b = vhi[d * 4 + ks];
                o[dp] = MX_MFMA(__builtin_bit_cast(bf16x8, pw[ks]), ((bf16x8){a[0], a[1], a[2], a[3], b[0], b[1], b[2], b[3]}), o[dp]); }
        __builtin_amdgcn_sched_barrier(0);
    }
}
__device__ __forceinline__ void ml_fused(LAS const float* gat, const f32x16& p0, const f32x16& p1, u32x4 (&pwN)[4], float& den, const float ft, const int lane,
                                         lptr vimgP, const u32x4 (&pwP)[4], f32x16 (&o)[4], const bool dopv) {
    const int hi = lane >> 5;
    const lptr vb = vimgP + ((lane >> 4) & 1) * 32 + (lane & 3) * 8 + (4 * hi + ((lane & 15) >> 2)) * 64;
    s16x4 f0a = vtr(vb), f0b = vtr(vb + 512), f1a = vtr(vb + 1024), f1b = vtr(vb + 1024 + 512);
    f32x4 gv = {};
    __builtin_amdgcn_sched_barrier(0);
#pragma unroll
    for (int k = 0; k < 16; ++k) {
        const int dp = k >> 2, ks = k & 3;
        s16x4 f2a = f0a, f2b = f0b;
        if (k + 2 < 16) { const int dn = (k + 2) >> 2, kn = (k + 2) & 3; f2a = vtr(vb + dn * 4096 + kn * 1024); f2b = vtr(vb + dn * 4096 + kn * 1024 + 512); }
        if (dopv) o[dp] = MX_MFMA(__builtin_bit_cast(bf16x8, pwP[ks]), ((bf16x8){f0a[0], f0a[1], f0a[2], f0a[3], f0b[0], f0b[1], f0b[2], f0b[3]}), o[dp]);
        const int blk = k >> 3, r = 2 * (k & 7);
        if ((k & 1) == 0) gv = *(LAS const f32x4*)(gat + 32 * blk + 8 * (r >> 2) + 4 * hi);
        const f32x16& X = blk ? p1 : p0;
        const float q0 = X[r] * (gv[r & 3] * ft), q1 = X[r + 1] * (gv[(r & 3) + 1] * ft);
        den += q0; den += q1;
        unsigned w = cvtpk(q0, q1);
        asm volatile("" : "+v"(w)); asm volatile("" : "+v"(den));
        pwN[2 * blk + ((k & 7) >> 2)][(k & 7) & 3] = w;
        f0a = f1a; f0b = f1b; f1a = f2a; f1b = f2b;
        __builtin_amdgcn_sched_barrier(0);
    }
}
__device__ __forceinline__ void ml_mask(f32x16& p0, f32x16& p1, const int qrow, const int key0, const int lane) {
    const int hi = lane >> 5;
#pragma unroll
    for (int r = 0; r < 16; ++r) { const int kk = key0 + crow(r, hi); p0[r] = (kk <= qrow) ? p0[r] : 0.f; p1[r] = (kk + 32 <= qrow) ? p1[r] : 0.f; }
}
template <int D, bool SBK>
__device__ __forceinline__ void prefetch_unit(KArgs kap, LAS unsigned char* lds, const int wave_s, const UnitP& u, bf16x8 (&qr)[D / 16], float& Mt, float& Ml, float& tgv) {
    int tid = wave_s * 64 + lane_id(); asm volatile("" : "+v"(tid));
    const int lane = tid & 63, wid = __builtin_amdgcn_readfirstlane(tid >> 6);
    const int qrow = 256 * u.qb + 32 * wid + (lane & 31), nt = 4 * (u.qb + 1);
    const unsigned l0 = (unsigned)(size_t)lds;
    const LoopPtrs<SBK> lp = loop_ptrs<SBK>(kap, u);
    issue_tile<D, !SBK>(l0 + KBUF0, l0 + VBUF0, l0 + EX_GA, lp, 64 * (nt - 1), wid, lane);
    issue_tile<D, !SBK>(l0 + KBUF0 + BUFSZ, l0 + VBUF0 + BUFSZ, l0 + EX_GA + 256, lp, 64 * (nt - 2), wid, lane);
    const size_t r0 = (size_t)u.b * SEQ;
    const bf16* Qp = SBK ? (const bf16*)WSP(WS_PROJ) + r0 * NPROJ + 2048 + u.h * 64 : (const bf16*)WSP(WS_QKC) + r0 * DM + u.h * 128; const int pq = SBK ? NPROJ : DM;
#pragma unroll
    for (int d0 = 0; d0 < D / 16; ++d0) qr[d0] = *(const GAS bf16x8*)(Qp + (size_t)qrow * pq + d0 * 16 + (lane >> 5) * 8);
    Mt = 0.f; Ml = 0.f; tgv = 0.f;
    if (!SBK) { const size_t bh = (size_t)(u.b * 4 + u.h); Mt = ((const float*)WSP(WS_GM))[bh * SEQ + qrow]; Ml = ((const float*)WSP(WS_GM))[bh * SEQ + 256 * u.qb + 255];
        tgv = ((const float*)WSP(WS_TG))[bh * 32 + (lane & 31)]; }
}
template <int D, bool SBK>
__device__ __forceinline__ void unit_run(KArgs kap, LAS unsigned char* lds, const int wave_s, const UnitP& u, const bool has_next, const UnitP& nx, bf16x8 (&qr)[D / 16], float& Mt, float& Ml, float& tgv) {
    int tid = wave_s * 64 + lane_id(); asm volatile("" : "+v"(tid));
    const LoopPtrs<SBK> lp = loop_ptrs<SBK>(kap, u);
    const int lane = tid & 63, wid = __builtin_amdgcn_readfirstlane(tid >> 6), late = MX_LATE ? (wid >> 2) : 0, r32 = lane & 31, hi = lane >> 5;
    const int t0 = 256 * u.qb, nt = 4 * (u.qb + 1), R0 = t0 + 32 * wid, qrow = R0 + r32;
    const unsigned l0 = (unsigned)(size_t)lds;
#pragma unroll
    for (int d0 = 0; d0 < D / 16; ++d0) asm volatile("" : "+v"(qr[d0]));
    asm volatile("" : "+v"(Mt)); asm volatile("" : "+v"(Ml)); asm volatile("" : "+v"(tgv));
    const float fv = SBK ? 0.f : __builtin_amdgcn_exp2f(tgv - Ml);
    const float Bt = SBK ? 1.f : __builtin_amdgcn_exp2f(Ml - Mt);
    f32x16 o[D / 32];
#pragma unroll
    for (int i = 0; i < D / 32; ++i) o[i] = f32x16{};
    float st = SBK ? 1.0f : 0.0f;
    const int nti = (!SBK && ML_CHUNK) ? 4 : nt;
    if constexpr (!SBK && ML_CHUNK) {
        __builtin_amdgcn_s_barrier();
        if (u.qb > 0) {
            const int bh = u.b * 4 + u.h;
            const float* CMp = (const float*)WSP(WS_CM) + bh * 8;
            {
                const int d = tid >> 2, dp = tid & 3;
                const unsigned short* Ub = (const unsigned short*)WSP(WS_U) + (size_t)bh * 7 * 16384 + d * 128 + dp * 32;
                v4u rr[7][4];
#pragma unroll
                for (int j = 0; j < 7; ++j) { const int jc = (j < u.qb) ? j : u.qb - 1;
#pragma unroll
                    for (int c = 0; c < 4; ++c) rr[j][c] = *(const GAS v4u*)(Ub + (size_t)jc * 16384 + 8 * c); }
                float scj[7];
                { const f32x4 c0 = *(const GAS f32x4*)CMp, c1 = *(const GAS f32x4*)(CMp + 4);
                  const float cmv[8] = {c0.x, c0.y, c0.z, c0.w, c1.x, c1.y, c1.z, c1.w};
#pragma unroll
                  for (int j = 0; j < 7; ++j) scj[j] = (j < u.qb) ? __builtin_amdgcn_exp2f(cmv[j] - Ml) : 0.f; }
                float ac[32];
#pragma unroll
                for (int c = 0; c < 32; ++c) ac[c] = 0.f;
#pragma unroll
                for (int j = 0; j < 7; ++j)
#pragma unroll
                    for (int c = 0; c < 4; ++c) { const v4u x = rr[j][c];
                        ac[8 * c + 0] += scj[j] * bflo(x.x); ac[8 * c + 1] += scj[j] * bfhi(x.x); ac[8 * c + 2] += scj[j] * bflo(x.y); ac[8 * c + 3] += scj[j] * bfhi(x.y);
                        ac[8 * c + 4] += scj[j] * bflo(x.z); ac[8 * c + 5] += scj[j] * bfhi(x.z); ac[8 * c + 6] += scj[j] * bflo(x.w); ac[8 * c + 7] += scj[j] * bfhi(x.w); }
                const int dl = d & 63, rho = (dl & 0x33) | ((dl & 4) << 1) | ((dl & 8) >> 1);
                LAS unsigned char* ip = lds + STAGE0 + (d >> 6) * 16384 + dp * 4096 + rho * 64;
#pragma unroll
                for (int c = 0; c < 4; ++c) *(LAS v4u*)(ip + 16 * c) = (v4u){cvtpk(ac[8 * c], ac[8 * c + 1]), cvtpk(ac[8 * c + 2], ac[8 * c + 3]), cvtpk(ac[8 * c + 4], ac[8 * c + 5]), cvtpk(ac[8 * c + 6], ac[8 * c + 7])};
                if (tid < 128) { const float* NVp = (const float*)WSP(WS_NV) + (size_t)bh * 7 * 128 + tid; float nn = 0.f, nvv[7];
#pragma unroll
                    for (int j = 0; j < 7; ++j) { const int jc = (j < u.qb) ? j : u.qb - 1; nvv[j] = NVp[jc * 128]; }
                    asm volatile("" : "+v"(nvv[0]), "+v"(nvv[1]), "+v"(nvv[2]), "+v"(nvv[3]), "+v"(nvv[4]), "+v"(nvv[5]), "+v"(nvv[6]));
#pragma unroll
                    for (int j = 0; j < 7; ++j) nn += scj[j] * nvv[j];
                    ((LAS float*)(lds + STAGE0 + 32768))[tid] = nn; }
            }
            LDS_WAIT(); __builtin_amdgcn_s_barrier(); asm volatile("" ::: "memory");
            {
                u32x4 qa[4], qb_[4];
#pragma unroll
                for (int c = 0; c < 4; ++c) { qa[c] = __builtin_bit_cast(u32x4, qr[c]); qb_[c] = __builtin_bit_cast(u32x4, qr[4 + c]); }
                pv<128>((lptr)(lds + STAGE0), qa, o, lane);
                pv<128>((lptr)(lds + STAGE0 + 16384), qb_, o, lane);
                LAS const float* nvl = (LAS const float*)(lds + STAGE0 + 32768);
                float dn = 0.f;
#pragma unroll
                for (int d0 = 0; d0 < 8; ++d0) { const f32x4 n0 = *(LAS const f32x4*)(nvl + 16 * d0 + 8 * hi), n1 = *(LAS const f32x4*)(nvl + 16 * d0 + 8 * hi + 4); const u32x4 qq = __builtin_bit_cast(u32x4, qr[d0]);
                    dn += bflo(qq.x) * n0.x + bfhi(qq.x) * n0.y + bflo(qq.y) * n0.z + bfhi(qq.y) * n0.w + bflo(qq.z) * n1.x + bfhi(qq.z) * n1.y + bflo(qq.w) * n1.z + bfhi(qq.w) * n1.w; }
                st = dn;
            }
        }
    }
    f32x16 p0 = {}, p1 = {};
    u32x4 pwP[4] = {}; bool havep = false;
    LAS unsigned* const dflag = (LAS unsigned*)(lds + EX_DEAD);
    if (SBK) { if (lane == 0) dflag[wid] = 0u; }
    int k3 = 0, v4 = 0;
    bool wdead = false;
    for (int i = 0; i < nti + MX_LATE; ++i) {
        if (i + 1 < nti) { if (D == 64) asm volatile("s_waitcnt vmcnt(2)" ::: "memory"); else asm volatile("s_waitcnt vmcnt(5)" ::: "memory"); }
        else asm volatile("s_waitcnt vmcnt(0)" ::: "memory");
        if (SBK) LDS_WAIT();
        __builtin_amdgcn_s_barrier();
        asm volatile("" ::: "memory");
        if (SBK && i > 0) { const u32x4 d0 = *(LAS const u32x4*)dflag, d1 = *(LAS const u32x4*)(dflag + 4);
            if (__builtin_amdgcn_readfirstlane((int)(d0.x & d0.y & d0.z & d0.w & d1.x & d1.y & d1.z & d1.w)) != 0) break; }
        if (i + 2 < nti) { const int k3n = (k3 == 0) ? 2 : k3 - 1, v4n = (v4 + 2) & 3;
            issue_tile<D, !SBK>(l0 + KBUF0 + k3n * BUFSZ, l0 + VBUF0 + v4n * BUFSZ, l0 + EX_GA + v4n * 256, lp, 64 * (nt - 3 - i), wid, lane); }
        const int v4p = (v4 + 3) & 3;
        const int tv = late ? nt - i : nt - 1 - i;
        const int vb = late ? v4p : v4;
        const bool dov = late ? (i >= 1) : (i < nti);
        const int tq = nt - 1 - i;
        const bool doq = (i < nti) && (SBK ? (64 * tq < R0 + 31) : (64 * tq <= R0 + 31));
        const lptr kimg = (lptr)(lds + KBUF0 + k3 * BUFSZ);
        if (!late && doq && !wdead) qk<D>(kimg, qr, p0, p1, lane);
        if constexpr (!SBK) {
            if (doq) {
                const float ft = __builtin_bit_cast(float, __builtin_amdgcn_readlane(__builtin_bit_cast(int, fv), tq));
                const bool unm = (64 * tq + 63 <= R0);
                LAS const float* gat = (LAS const float*)(lds + EX_GA + v4 * 256); const lptr vprev = (lptr)(lds + VBUF0 + v4p * BUFSZ);
                u32x4 pwN[4];
                if (!unm) ml_mask(p0, p1, qrow, 64 * tq, lane);
                ml_fused(gat, p0, p1, pwN, st, ft, lane, vprev, pwP, o, havep);
#pragma unroll
                for (int q_ = 0; q_ < 4; ++q_) pwP[q_] = pwN[q_];
                havep = true;
            }
        } else
        if (dov) {
            const bool live = SBK ? (64 * tv < R0 + 31) : (64 * tv <= R0 + 31);
            const bool unm = SBK ? (64 * tv + 63 < R0) : (64 * tv + 63 <= R0);
            const lptr vimg = (lptr)(lds + VBUF0 + vb * BUFSZ); LAS const float* gat = (LAS const float*)(lds + EX_GA + vb * 256);
            if (live && !wdead) { const float ft = SBK ? 0.f : __builtin_bit_cast(float, __builtin_amdgcn_readlane(__builtin_bit_cast(int, fv), tv));
                if (unm) vp<D, SBK, false>(vimg, gat, p0, p1, o, st, ft, qrow, 64 * tv, lane); else vp<D, SBK, true>(vimg, gat, p0, p1, o, st, ft, qrow, 64 * tv, lane);
                if (SBK) { const bool dead = (__ballot(st != 0.0f) == 0ull); if (lane == 0) dflag[wid] = dead ? 1u : 0u; wdead = dead; } }
        }
        if (late && doq) qk<D>(kimg, qr, p0, p1, lane);
        k3 = (k3 == 2) ? 0 : k3 + 1; v4 = (v4 + 1) & 3;
    }
    if constexpr (!SBK) { if (havep) pv<D>((lptr)(lds + VBUF0 + ((nt - 1) & 3) * BUFSZ), pwP, o, lane); }
    LDS_WAIT(); __builtin_amdgcn_s_barrier(); asm volatile("" ::: "memory");
    const float ge_q = SBK ? 0.f : ((const float*)WSP(WS_GE))[(size_t)(u.b * 4 + u.h) * SEQ + qrow];
    if (has_next) prefetch_unit<D, SBK>(kap, lds, wave_s, nx, qr, Mt, Ml, tgv);
    const size_t er0 = (size_t)u.b * SEQ;
    bf16* const e_out = (bf16*)WSP(WS_MIXED) + er0 * DM + (SBK ? 512 + u.h * 64 : u.h * 128);
    const float* const e_gain = SBK ? KA(g_sb) + u.layer * 512 + u.h * 64 : KA(g_mlstm) + u.layer * 512 + u.h * 128;
    const bf16* const e_om = (const bf16*)WSP(WS_PROJ) + er0 * NPROJ + 1536 + u.h * 128;
    LAS float* stg = (LAS float*)(lds + STAGE0 + wid * STAGE_W); LAS float* wsf = stg + 1088;
    if (!SBK) { const float den = (st + partner(st, hi)) * Bt; if (hi == 0) wsf[r32] = Bt / fmaxf(fabsf(den), ge_q); }
    constexpr int RP = (D == 64) ? 16 : 8, NPASS = 32 / RP, LPR = 64 / RP, PITCH = D + 4, RPP = 16 / NPASS;
    const int rl = lane / LPR, seg = lane % LPR;
    float gn[16];
#pragma unroll
    for (int c = 0; c < 4; ++c) { const f32x4 g = *(const GAS f32x4*)(e_gain + 16 * seg + 4 * c); gn[4 * c] = g.x; gn[4 * c + 1] = g.y; gn[4 * c + 2] = g.z; gn[4 * c + 3] = g.w; }
    v4u gpre[SBK ? 1 : NPASS][2];
    if constexpr (!SBK) {
#pragma unroll
        for (int ps = 0; ps < NPASS; ++ps) { const int gr_ = R0 + ps * RP + rl; gpre[ps][0] = *(const GAS v4u*)(e_om + (size_t)gr_ * NPROJ + 16 * seg); gpre[ps][1] = *(const GAS v4u*)(e_om + (size_t)gr_ * NPROJ + 16 * seg + 8); }
    }
#pragma unroll
    for (int ps = 0; ps < NPASS; ++ps) {
        LDS_WAIT(); asm volatile("" ::: "memory");
#pragma unroll
        for (int rr = 0; rr < RPP; ++rr) { const int r = ps * RPP + rr; const int srow = crow(r, hi) - ps * RP;
#pragma unroll
            for (int dp = 0; dp < D / 32; ++dp) stg[srow * PITCH + 32 * dp + r32] = o[dp][r]; }
        LDS_WAIT(); asm volatile("" ::: "memory");
        float x[16];
#pragma unroll
        for (int c = 0; c < 4; ++c) { const f32x4 v4 = *(LAS const f32x4*)(stg + rl * PITCH + 16 * seg + 4 * c); x[4 * c] = v4.x; x[4 * c + 1] = v4.y; x[4 * c + 2] = v4.z; x[4 * c + 3] = v4.w; }
        const int prow = ps * RP + rl, grow = R0 + prow;
        if (!SBK) { const float inv = wsf[prow];
#pragma unroll
            for (int c = 0; c < 16; ++c) x[c] *= inv; }
        float ss = 0.f;
#pragma unroll
        for (int c = 0; c < 16; ++c) ss += x[c] * x[c];
        ss = (LPR == 8) ? oct_sum(ss, lane) : quad_sum(ss);
        const float rs = 1.0f / sqrtf(ss * (1.0f / D) + EPS);
#pragma unroll
        for (int c = 0; c < 16; ++c) x[c] *= rs * gn[c];
        if (!SBK) { const v4u g0 = gpre[SBK ? 0 : ps][0], g1 = gpre[SBK ? 0 : ps][1];
            float gg[16]; gg[0] = bflo(g0.x); gg[1] = bfhi(g0.x); gg[2] = bflo(g0.y); gg[3] = bfhi(g0.y); gg[4] = bflo(g0.z); gg[5] = bfhi(g0.z); gg[6] = bflo(g0.w); gg[7] = bfhi(g0.w);
            gg[8] = bflo(g1.x); gg[9] = bfhi(g1.x); gg[10] = bflo(g1.y); gg[11] = bfhi(g1.y); gg[12] = bflo(g1.z); gg[13] = bfhi(g1.z); gg[14] = bflo(g1.w); gg[15] = bfhi(g1.w);
#pragma unroll
            for (int c = 0; c < 16; ++c) x[c] *= 1.0f / (1.0f + __expf(-gg[c])); }
        bf16* op = e_out + (size_t)grow * DM + 16 * seg;
        *(GAS v4u*)op = (v4u){pk2(x[0], x[1]), pk2(x[2], x[3]), pk2(x[4], x[5]), pk2(x[6], x[7])};
        *(GAS v4u*)(op + 8) = (v4u){pk2(x[8], x[9]), pk2(x[10], x[11]), pk2(x[12], x[13]), pk2(x[14], x[15])};
    }
    LDS_WAIT();
}
#undef MX_MFMA
}

__device__ __forceinline__ void mixer_phase(KArgs kap, LAS unsigned char* lds, const int wave_s, const int layer) {
    int G = gridDim.x; asm volatile("" : "+s"(G)); int bid = blockIdx.x; asm volatile("" : "+s"(bid));
    for (int jb = bid; jb < 256; jb += G) {
        {
            int jb2 = jb; asm volatile("" : "+s"(jb2));
            const int b = jb2 & 7, idx = jb2 >> 3, m = idx & 7, hl = idx >> 3;
#if ML_CHUNK
            int hA, qA, hB, qB;
            if (m < 6) { const int n0 = (m * 4 + hl) * 2, n1 = n0 + 1; hA = (n0 * 37) >> 8; qA = 1 + n0 - 7 * hA; hB = (n1 * 37) >> 8; qB = 1 + n1 - 7 * hB; }
            else { const int n0 = 48 + (m - 6) * 4 + hl; hA = (n0 * 37) >> 8; qA = 1 + n0 - 7 * hA; hB = hl + 4 * (m - 6); qB = 0; }
            bf16x8 qr[4]; float Mt, Ml, tgv;
            __builtin_amdgcn_s_barrier();
            {
                const mix2::UnitP uA{b, hA, qA, layer}, uB{b, hB, qB, layer};
                mix2::prefetch_unit<64, true>(kap, lds, wave_s, uA, qr, Mt, Ml, tgv);
                mix2::unit_run<64, true>(kap, lds, wave_s, uA, true, uB, qr, Mt, Ml, tgv);
                mix2::unit_run<64, true>(kap, lds, wave_s, uB, false, uB, qr, Mt, Ml, tgv);
            }
#else
            const int nsb = (0x01122334 >> (4 * m)) & 15, st0 = (int)((0xFECA740ull >> (4 * m)) & 15ull);
            bf16x8 qr[4]; float Mt, Ml, tgv;
            __builtin_amdgcn_s_barrier();
            if (nsb > 0) {
                const int u0 = hl * 16 + st0;
                mix2::UnitP uc{b, u0 >> 3, u0 & 7, layer};
                mix2::prefetch_unit<64, true>(kap, lds, wave_s, uc, qr, Mt, Ml, tgv);
#pragma unroll 1
                for (int k = 0; k < nsb; ++k) {
                    const int un = u0 + k + 1; const mix2::UnitP nx{b, un >> 3, un & 7, layer};
                    mix2::unit_run<64, true>(kap, lds, wave_s, uc, k + 1 < nsb, nx, qr, Mt, Ml, tgv);
                    uc = nx;
                }
            }
#endif
        }
#if CONV_NOBAR
        {
            int t0_ = wave_s * 64 + lane_id();
            if (t0_ == 0) { gu32* cc = (gu32*)WSP(WS_CTL) + CW_CONV + 8 * layer + (bid & 7); unsigned sp = 0u;
                while (__hip_atomic_load(cc, __ATOMIC_RELAXED, __HIP_MEMORY_SCOPE_AGENT) < (unsigned)(G >> 3)) { __builtin_amdgcn_s_sleep(1); if (++sp > (1u << 22)) break; }
                __builtin_amdgcn_fence(__ATOMIC_ACQUIRE, "agent"); }
            __builtin_amdgcn_s_barrier();
        }
#endif
        {
            const int b = jb & 7, idx = jb >> 3, m = idx & 7, hl = idx >> 3;
            const mix2::UnitP u{b, hl, m, layer};
            bf16x8 qr[8]; float Mt, Ml, tgv;
            mix2::prefetch_unit<128, false>(kap, lds, wave_s, u, qr, Mt, Ml, tgv);
            mix2::unit_run<128, false>(kap, lds, wave_s, u, false, u, qr, Mt, Ml, tgv);
        }
        __builtin_amdgcn_s_barrier();
    }
}

#define MKFRAME() Frame F; F.lds = (LAS unsigned char*)lds; F.MISC = (volatile LAS unsigned*)(F.lds + MISC_OFF); F.tid = wave_s * 64 + lane_id(); asm volatile("" : "+v"(F.tid)); F.lane = F.tid & 63; \
    F.wave = __builtin_amdgcn_readfirstlane(F.tid >> 6); F.G = gridDim.x; asm volatile("" : "+s"(F.G)); F.bid = blockIdx.x; asm volatile("" : "+s"(F.bid)); F.ctl = (gu32*)WSP(WS_CTL)
#define GRID_BAR() do { XcdBarrier bar_; bar_.bar = (unsigned*)WSP(WS_CTL) + CW_BAR; bar_.x = xb_xcc_id(); bar_.st = (volatile LAS unsigned*)((LAS unsigned char*)lds + MISC_OFF) + 8; xcd_barrier(bar_, wave_s); } while (0)
#define GROUP_BAR() group_barrier((gu32*)WSP(WS_CTL) + CW_GB + 4096 * ((int)blockIdx.x & 7), wave_s, (volatile LAS unsigned*)((LAS unsigned char*)lds + MISC_OFF) + 24, xb_xcc_id())
#define BUILD_TAB() do { __syncthreads(); \
            if (F.tid == 0) { int acc_ = 0; for (int e = 0; e < 8; ++e) { const int c_ = (int)__hip_atomic_load(F.ctl + CW_CNT + 64 * j + e, RLX_AGENT); tab[e] = acc_; tab[16 + e] = c_; acc_ += (c_ + 255) >> 8; } tab[8] = acc_; } \
            __syncthreads(); } while (0)

__global__ void __launch_bounds__(NTHREADS, 2) mk_fwd(Args args_unused) {
    extern __shared__ __attribute__((aligned(16))) unsigned char lds[];
    KArgs kap = (KArgs)__builtin_amdgcn_kernarg_segment_ptr();
    const int wave_s = __builtin_amdgcn_readfirstlane((int)threadIdx.x >> 6);
    for (int u = threadIdx.x; u < 256; u += NTHREADS) ((LAS unsigned*)((LAS unsigned char*)lds + MISC_OFF))[u] = 0u;
    __syncthreads();
    (void)xcd_barrier_post((unsigned*)WSP(WS_CTL) + CW_BAR, (volatile LAS unsigned*)((LAS unsigned char*)lds + MISC_OFF) + 8);
    { gu32* gbp = (gu32*)WSP(WS_CTL) + CW_GB + 4096 * ((int)blockIdx.x & 7) + GB_XCNT(xb_xcc_id());
      if (threadIdx.x == 0) (void)__hip_atomic_fetch_add(gbp, 1u, __ATOMIC_RELAXED, __HIP_MEMORY_SCOPE_AGENT); }

    { MKFRAME(); Args a; a.ws = KA(ws); a.w_in = KA(w_in); a.w_out = KA(w_out); a.ffn_w_gate = KA(ffn_w_gate); a.ffn_w_up = KA(ffn_w_up); a.ffn_w_down = KA(ffn_w_down);
      a.moe_w_gate = KA(moe_w_gate); a.moe_w_up = KA(moe_w_up); a.moe_w_down = KA(moe_w_down); a.norm_mix_g = KA(norm_mix_g); a.norm_ffn_g = KA(norm_ffn_g);
#pragma unroll 1
      for (int rep = 0; rep < REP_PRO; ++rep) prologue_phase(a, F); }
    __syncthreads();
    for (int layer = 0; layer < DEPTH; ++layer) {
        const int j = layer >> 1; const bool moe = layer & 1;
        { MKFRAME();
            NormIn p{}; p.src = KA(x); p.src16 = (const bf16*)WSP(WS_H16); p.o2 = (layer == 2) ? (bf16*)WSP(WS_O2) : nullptr; p.hout16 = (layer == 0 || layer == 2) ? (bf16*)WSP(WS_H16) : nullptr; p.rs = (float*)WSP(WS_RS);
            p.gain = KA(norm_mix_g) + layer * DM; p.w8 = KA(w_in) + (size_t)layer * DM * PIN + 2048; p.ld8 = PIN; p.G = (float*)WSP(WS_G);
            if (layer == 0) norm_phase<0, false>(F, p); else norm_phase<0, true>(F, p);
        }
        if (layer == 0) GRID_BAR(); else GROUP_BAR();
        { MKFRAME();
            if (F.bid >= 128 && F.bid < 160) gate_scan(F, (F.bid & 7) * HM + ((F.bid >> 3) - 16), (float*)WSP(WS_G), KA(b_igate) + layer * HM, KA(b_fgate) + layer * HM, (float*)WSP(WS_GA), (float*)WSP(WS_GM), (float*)WSP(WS_GE), (float*)WSP(WS_TG));
            __syncthreads();
            pg8::EpiProj E{(bf16*)WSP(WS_PROJ), (const float*)WSP(WS_RS)};
            const int ngw = F.G >> 3, lw = F.bid >> 3, ntl = pg8::WGM * (NPROJ / pg8::BM);
            const int maxu = (ntl + ngw - 1) / ngw, h0 = ntl - (maxu - 1) * ngw, nh = ngw - h0;
            { pg8::InprojOrder S; S.init(WSP(WS_H16), (bf16*)WSP(WS_WIN) + (size_t)layer * NPROJ * DM, T, NPROJ, DM, F.G, F.bid, 0, 2);
              pg8::gemm_phase<pg8::EpiProj, pg8::InprojOrder, true>(F.lds + RING_OFF, S, E, F.tid); }
            asm volatile("s_waitcnt vmcnt(0)" ::: "memory");
            __syncthreads();
            { const unsigned xcc = xb_xcc_id(); gu32* gbp = F.ctl + CW_GB + 4096 * (F.bid & 7);
              if (F.tid == 0) group_arrive(gbp, F.MISC + 24, xcc, (unsigned)layer + 1u); }
            { pg8::InprojOrder S; S.init(WSP(WS_H16), (bf16*)WSP(WS_WIN) + (size_t)layer * NPROJ * DM, T, NPROJ, DM, F.G, F.bid, 2, maxu - 2);
              pg8::gemm_phase<pg8::EpiProj, pg8::InprojOrder, true>(F.lds + RING_OFF, S, E, F.tid); }
            if (nh == 0 || lw >= h0) {
                const int hidx = nh == 0 ? lw : lw - h0, nhe = nh == 0 ? ngw : nh;
                __syncthreads();
                { const unsigned xcc = xb_xcc_id(); gu32* gbp = F.ctl + CW_GB + 4096 * (F.bid & 7);
                  if (F.tid == 0) group_wait(gbp, F.MISC + 24, xcc, (unsigned)layer + 1u); }
                __syncthreads();
                conv_phase(F, (bf16*)WSP(WS_PROJ), KA(conv_w) + (size_t)layer * 4 * 1024, KA(conv_b) + (size_t)layer * 1024, (bf16*)WSP(WS_QKC), hidx, nhe);
#pragma unroll 1
                for (int ub = nhe - 1 - hidx; ub < HM * 7; ub += nhe) chunk_state_unit(F, (F.bid & 7) * HM + ub / 7, ub % 7, (bf16*)WSP(WS_PROJ), KA(conv_w) + (size_t)layer * 4 * 1024, KA(conv_b) + (size_t)layer * 1024,
                                                                   (float*)WSP(WS_GA), (float*)WSP(WS_TG), (bf16*)WSP(WS_U), (float*)WSP(WS_NV), (float*)WSP(WS_CM), (bf16*)WSP(WS_QKC));
            }
        }
        GROUP_BAR();
        { MKFRAME();
#if NAIVE_MIX == 1
            naive_sb(F, (bf16*)WSP(WS_PROJ), KA(g_sb) + layer * 512, (bf16*)WSP(WS_MIXED));
            naive_mlstm(F, (bf16*)WSP(WS_PROJ), (bf16*)WSP(WS_QKC), (float*)WSP(WS_GA), (float*)WSP(WS_GM), (float*)WSP(WS_GE), KA(g_mlstm) + layer * 512, (bf16*)WSP(WS_MIXED));
#else
#pragma unroll 1
            for (int rep = 0; rep < REP_MIX; ++rep) mixer_phase(kap, F.lds, wave_s, layer);
#endif
            __syncthreads();
        }
        GROUP_BAR();
        { MKFRAME();
            pg8::DenseOrder S; S.init(WSP(WS_MIXED), (bf16*)WSP(WS_WOUT) + (size_t)layer * DM * DM, T, DM, DM, F.G, F.bid);
            { pg8::EpiResid16<false> E{nullptr, (bf16*)WSP(WS_H16)}; pg8::gemm_phase<pg8::EpiResid16<false>, pg8::DenseOrder, true>(F.lds + RING_OFF, S, E, F.tid); }
        }
        GROUP_BAR();
        { MKFRAME();
            NormIn p{}; p.src16 = (const bf16*)WSP(WS_H16); p.gain = KA(norm_ffn_g) + layer * DM; p.rs = (float*)WSP(WS_RS);
            if (moe) { p.w8 = KA(w_router) + (size_t)j * DM * 8; p.ld8 = 8; p.cnt = (unsigned*)(F.ctl + CW_CNT + 64 * j); p.rinfo = (uint2*)WSP(WS_RINFO); p.cntw = (int*)WSP(WS_CNTW); p.rrec = (int*)WSP(WS_RREC);
                norm_phase<2, true>(F, p); }
            else norm_phase<1, true>(F, p);
        }
        if (moe) { GRID_BAR(); MKFRAME(); route_finish(F, (const int*)WSP(WS_CNTW), (const int*)WSP(WS_RREC), (uint2*)WSP(WS_RINFO), (const float*)WSP(WS_RS), (float*)WSP(WS_RSI)); }
        if (moe) GRID_BAR(); else GROUP_BAR();
        { MKFRAME(); volatile LAS int* tab = (volatile LAS int*)(F.MISC + 32);
            if (!moe) {
                pg8::DenseOrder S; S.init(WSP(WS_H16), (bf16*)WSP(WS_WGU) + (size_t)j * 2 * FFDP * DM, T, 2 * FFDP, DM, F.G, F.bid);
                pg8::EpiSwiglu E{(bf16*)WSP(WS_HID), FFDP, (const float*)WSP(WS_RS), nullptr};
#pragma unroll 1
                for (int rep = 0; rep < REP_DUP; ++rep) pg8::gemm_phase<pg8::EpiSwiglu, pg8::DenseOrder, true>(F.lds + RING_OFF, S, E, F.tid);
            } else {
                BUILD_TAB();
                pg8::MoeOrder<true> S; S.init(WSP(WS_H16), (bf16*)WSP(WS_MGU) + (size_t)j * 8 * 2 * FFE * DM, (size_t)2 * FFE * DM * 2, 2 * FFE, DM, F.G, F.bid, tab, (const uint2*)WSP(WS_RINFO));
                pg8::EpiSwiglu E{(bf16*)WSP(WS_HIDM), FFE, nullptr, (const float*)WSP(WS_RSI)};
#pragma unroll 1
                for (int rep = 0; rep < REP_MOEUP; ++rep) pg8::gemm_phase<pg8::EpiSwiglu, pg8::MoeOrder<true>, true>(F.lds + RING_OFF, S, E, F.tid);
            }
        }
        if (moe) GRID_BAR(); else GROUP_BAR();
        { MKFRAME(); volatile LAS int* tab = (volatile LAS int*)(F.MISC + 32);
            if (!moe) {
                pg8::DenseOrder S; S.init(WSP(WS_HID), (bf16*)WSP(WS_WD) + (size_t)j * DM * FFDP, T, DM, FFDP, F.G, F.bid);
                pg8::EpiResid16<false> E{nullptr, (bf16*)WSP(WS_H16)};
                pg8::gemm_phase<pg8::EpiResid16<false>, pg8::DenseOrder, true>(F.lds + RING_OFF, S, E, F.tid);
            } else {
                BUILD_TAB();
                pg8::MoeOrder<false> S; S.init(WSP(WS_HIDM), (bf16*)WSP(WS_MD) + (size_t)j * 8 * DM * FFE, (size_t)DM * FFE * 2, DM, FFE, F.G, F.bid, tab, (const uint2*)WSP(WS_RINFO));
                pg8::EpiScatter E{(bf16*)WSP(WS_O2), (const uint2*)WSP(WS_RINFO)};
#if MOE_TAIL_KS > 1
                const int rem = S.nwg % F.G, nmain = S.nwg - rem;
                pg8::MoeOrder<false> S0 = S; S0.nwg = nmain;
                pg8::gemm_phase<pg8::EpiScatter, pg8::MoeOrder<false>, true>(F.lds + RING_OFF, S0, E, F.tid);
                if (rem > 0 && F.bid < rem * MOE_TAIL_KS) {
                    pg8::MoeTailOrder ST; ST.init(S, nmain, rem, MOE_TAIL_KS, F.bid);
                    const int tl = F.bid % rem;
                    float* Pt = (float*)WSP(WS_Y) + (size_t)tl * MOE_TAIL_KS * 65536;
                    pg8::EpiPartial EP{Pt + (size_t)ST.slice * 65536};
                    pg8::gemm_phase<pg8::EpiPartial, pg8::MoeTailOrder, true>(F.lds + RING_OFF, ST, EP, F.tid);
                    asm volatile("s_waitcnt vmcnt(0)" ::: "memory");
                    __syncthreads();
                    if (F.tid == 0) { __builtin_amdgcn_fence(__ATOMIC_RELEASE, "agent");
                        const unsigned old_ = __hip_atomic_fetch_add(F.ctl + CW_TAIL + 32 * j + tl, 1u, __ATOMIC_RELAXED, __HIP_MEMORY_SCOPE_AGENT);
                        if (old_ == MOE_TAIL_KS - 1) __builtin_amdgcn_fence(__ATOMIC_ACQUIRE, "agent");
                        F.MISC[16] = old_; }
                    __syncthreads();
                    if (F.MISC[16] == MOE_TAIL_KS - 1) {
                        f32x4 acc[2][2][4][2];
#pragma unroll
                        for (int g = 0; g < 4; ++g) {
                            const float* pg = Pt + ((size_t)(g * 8) * 512 + F.tid) * 4; asm volatile("" : "+v"(pg));
#pragma unroll
                            for (int kh = 0; kh < 2; ++kh) {
                                f32x4 t[4][MOE_TAIL_KS];
#pragma unroll
                                for (int k2 = 0; k2 < 4; ++k2)
#pragma unroll
                                    for (int sl = 0; sl < MOE_TAIL_KS; ++sl) t[k2][sl] = *(const GAS f32x4*)(pg + (size_t)sl * 65536 + (4 * kh + k2) * 2048);
#pragma unroll
                                for (int k2 = 0; k2 < 4; ++k2)
#pragma unroll
                                    for (int sl = 0; sl < MOE_TAIL_KS; ++sl) asm volatile("" : "+v"(t[k2][sl]));
#pragma unroll
                                for (int k2 = 0; k2 < 4; ++k2) { f32x4 v = t[k2][0];
#pragma unroll
                                    for (int sl = 1; sl < MOE_TAIL_KS; ++sl) v += t[k2][sl];
                                    const int k = 4 * kh + k2; acc[g >> 1][g & 1][k >> 1][k & 1] = v; }
                            }
                            asm volatile("" : "+v"(acc[g >> 1][g & 1][0][0]), "+v"(acc[g >> 1][g & 1][0][1]), "+v"(acc[g >> 1][g & 1][1][0]), "+v"(acc[g >> 1][g & 1][1][1]),
                                              "+v"(acc[g >> 1][g & 1][2][0]), "+v"(acc[g >> 1][g & 1][2][1]), "+v"(acc[g >> 1][g & 1][3][0]), "+v"(acc[g >> 1][g & 1][3][1]));
                        }
                        pg8::Unit ut; ST.base.decode(ST.wgid, ut);
                        const int wid_ = F.tid >> 6, ln_ = F.tid & 63;
                        E(acc, ut, wid_ >> 2, wid_ & 3, ln_ & 15, ln_ >> 4);
                    }
                    __syncthreads();
                }
#else
#pragma unroll 1
                for (int rep = 0; rep < REP_MOEDN; ++rep) pg8::gemm_phase<pg8::EpiScatter, pg8::MoeOrder<false>, true>(F.lds + RING_OFF, S, E, F.tid);
#endif
            }
        }
        if (moe) GRID_BAR(); else GROUP_BAR();
    }
    { MKFRAME(); NormIn p{}; p.src16 = (const bf16*)WSP(WS_H16); p.o2 = (bf16*)WSP(WS_O2); p.hout = KA(out); p.gain = KA(norm_final_g); norm_phase<3, true>(F, p); }
}

extern "C" void kernel_launch(void* const* d_in, const int* in_sizes, int n_in, void* d_out, int out_size, void* d_ws, size_t ws_size, hipStream_t stream) {
    static int grid = 0;
    if (grid == 0) {
        if (n_in != 19 || in_sizes[0] != T * DM || out_size != T * DM || ws_size < WS_END) { fprintf(stderr, "kernel_launch: unexpected shapes / workspace (%d inputs, in0 %d, out %d, ws %zu)\n", n_in, n_in > 0 ? in_sizes[0] : -1, out_size, ws_size); grid = -1; return; }
        int dev = 0, cus = 0, per_cu = 0;
        if (hipGetDevice(&dev) != hipSuccess || hipDeviceGetAttribute(&cus, hipDeviceAttributeMultiprocessorCount, dev) != hipSuccess) { grid = -1; return; }
        if (hipFuncSetAttribute((const void*)mk_fwd, hipFuncAttributeMaxDynamicSharedMemorySize, LDS_BYTES) != hipSuccess) { grid = -1; return; }
        if (hipOccupancyMaxActiveBlocksPerMultiprocessor(&per_cu, (const void*)mk_fwd, NTHREADS, LDS_BYTES) != hipSuccess || per_cu < 1) fprintf(stderr, "kernel_launch: occupancy query says %d\n", per_cu);
        (void)hipGetLastError();
        grid = cus - cus % 8;
        if (grid < 160) { fprintf(stderr, "kernel_launch: %d compute units: this kernel needs at least 160\n", cus); grid = -1; return; }
    }
    if (grid < 0) return;
    if (hipMemsetAsync((char*)d_ws + WS_CTL, 0, CTL_ZERO_BYTES, stream) != hipSuccess) return;
    Args a{};
    a.x = (const float*)d_in[0]; a.norm_mix_g = (const float*)d_in[1]; a.w_in = (const float*)d_in[2]; a.b_igate = (const float*)d_in[3]; a.b_fgate = (const float*)d_in[4];
    a.conv_w = (const float*)d_in[5]; a.conv_b = (const float*)d_in[6]; a.g_mlstm = (const float*)d_in[7]; a.g_sb = (const float*)d_in[8]; a.w_out = (const float*)d_in[9];
    a.norm_ffn_g = (const float*)d_in[10]; a.ffn_w_gate = (const float*)d_in[11]; a.ffn_w_up = (const float*)d_in[12]; a.ffn_w_down = (const float*)d_in[13];
    a.w_router = (const float*)d_in[14]; a.moe_w_gate = (const float*)d_in[15]; a.moe_w_up = (const float*)d_in[16]; a.moe_w_down = (const float*)d_in[17]; a.norm_final_g = (const float*)d_in[18];
    a.out = (float*)d_out; a.ws = (unsigned char*)d_ws; a.ph_lo = 0; a.ph_hi = 0;
    hipLaunchKernelGGL(mk_fwd, dim3(grid), dim3(NTHREADS), LDS_BYTES, stream, a);
}
```

```cpp
#include <hip/hip_runtime.h>
#include <cstdio>
#include <cstdint>

#ifndef REP_PRO
#define REP_PRO 1
#endif
#ifndef REP_MIX
#define REP_MIX 1
#endif
#ifndef REP_INPROJ
#define REP_INPROJ 1
#endif
#ifndef REP_DUP
#define REP_DUP 1
#endif
#ifndef REP_MOEUP
#define REP_MOEUP 1
#endif
#ifndef REP_MOEDN
#define REP_MOEDN 1
#endif
#ifndef REP_CONV
#define REP_CONV 1
#endif
#ifndef MX_LATE
#define MX_LATE 0
#endif
#ifndef ML_CHUNK
#define ML_CHUNK 1
#endif
#ifndef MOE_FP8
#define MOE_FP8 1
#endif
#ifndef MOE_TAIL_KS
#define MOE_TAIL_KS (MOE_FP8 ? 2 : 4)
#endif
#ifndef CONV_NOBAR
#define CONV_NOBAR 0
#endif
#ifndef NAIVE_MIX
#define NAIVE_MIX 0
#endif

constexpr int T = 16384, DM = 1024, SEQ = 2048, NBATCH = 8, DEPTH = 4;
constexpr int PIN = 3592, NPROJ = 3584;
constexpr int FFD = 2752, FFDP = 2816, FFE = 3584, NEXP = 8;
constexpr int HM = 4, DHM = 128, HS = 8, DHS = 64;
constexpr float EPS = 1e-6f;
constexpr float LOG2E = 1.4426950408889634f;
constexpr float QS_SCALE = 0.125f * LOG2E;
constexpr float KM_SCALE = 0.08838834764831845f;
constexpr int NWAVES = 8, NTHREADS = 512;
constexpr float F8_WGU = 64.0f, F8_WD = 128.0f, F8_HID = 8.0f, F8_MAX = 448.0f;

constexpr size_t MiB = 1u << 20;
constexpr size_t WS_CTL = 0, CTL_ZERO_BYTES = 1 * MiB;
constexpr size_t WS_WIN = 1 * MiB;
constexpr size_t WS_WOUT = 29 * MiB;
constexpr size_t WS_WGU = 37 * MiB;
constexpr size_t WS_WD = 59 * MiB;
constexpr size_t WS_MGU = 70 * MiB;
constexpr size_t WS_H8 = WS_MGU + 112 * MiB;
constexpr size_t WS_MD = 294 * MiB;
constexpr size_t WS_Y = 406 * MiB;
constexpr size_t WS_MIXED = 438 * MiB;
constexpr size_t WS_G = 470 * MiB;
constexpr size_t WS_GA = WS_G + 512 * 1024, WS_GM = WS_GA + 256 * 1024, WS_GE = WS_GM + 256 * 1024, WS_TG = WS_GE + 256 * 1024;
constexpr size_t WS_RINFO = 472 * MiB;
constexpr size_t WS_O2 = 474 * MiB;
constexpr size_t WS_BIG = 538 * MiB;
constexpr size_t WS_PROJ = WS_BIG, WS_QKC = WS_BIG + 112 * MiB, WS_HIDM = WS_BIG;
constexpr size_t WS_U = WS_BIG + 238 * MiB;
constexpr size_t WS_NV = WS_U + 15 * MiB, WS_CM = WS_NV + 128 * 1024;
constexpr size_t WS_RREC = WS_CM + 128 * 1024, WS_CNTW = WS_RREC + 512 * 1024;
constexpr size_t WS_HID = WS_BIG + 144 * MiB;
constexpr size_t WS_H16 = WS_U + 16 * MiB;
constexpr size_t WS_RS = WS_H16 + 32 * MiB, WS_RSI = WS_RS + 64 * 1024;
constexpr size_t WS_END = WS_H16 + 33 * MiB;
constexpr int HIDM_ROWS = 2 * T + 2048;
static_assert((size_t)HIDM_ROWS * FFE * 2 <= 238 * MiB, "hidm");
constexpr int CW_TMO = 0;
constexpr int CW_CNT = 64;
constexpr int CW_BAR = 4096;
constexpr int CW_INP = 3264;
constexpr int CW_CONV = 3200;
constexpr int CW_GB = 8192;
constexpr int CW_TAIL = 2048;

constexpr int RING_OFF = 0, RING_BYTES = 131072;
constexpr int MISC_OFF = 155648;
constexpr int LDS_BYTES = 163840;

#define GAS __attribute__((address_space(1)))
#define LAS __attribute__((address_space(3)))
typedef unsigned short bf16;
typedef unsigned v4u __attribute__((ext_vector_type(4)));
typedef unsigned v2u __attribute__((ext_vector_type(2)));
typedef float f32x4 __attribute__((ext_vector_type(4)));
typedef int i32x4 __attribute__((ext_vector_type(4)));
typedef float f32x2 __attribute__((ext_vector_type(2)));
typedef short bf16x8 __attribute__((ext_vector_type(8)));
typedef int i32x8 __attribute__((ext_vector_type(8)));
typedef GAS unsigned gu32;
#define RLX_AGENT __ATOMIC_RELAXED, __HIP_MEMORY_SCOPE_AGENT
#define LDS_WAIT() asm volatile("s_waitcnt lgkmcnt(0)" ::: "memory")
#define VM_WAIT() asm volatile("s_waitcnt vmcnt(0)" ::: "memory")

__device__ __forceinline__ unsigned f2bf(float f) { unsigned u = __builtin_bit_cast(unsigned, f); return (u + 0x7fffu + ((u >> 16) & 1u)) >> 16; }
__device__ __forceinline__ unsigned pk2(float lo, float hi) { return f2bf(lo) | (f2bf(hi) << 16); }
__device__ __forceinline__ unsigned pk4_f8(float a, float b, float c, float d) { int w = __builtin_amdgcn_cvt_pk_fp8_f32(a, b, 0, false); w = __builtin_amdgcn_cvt_pk_fp8_f32(c, d, w, true); return (unsigned)w; }
__device__ __forceinline__ float bf2f(unsigned b) { return __builtin_bit_cast(float, b << 16); }
__device__ __forceinline__ float bflo(unsigned w) { return __builtin_bit_cast(float, w << 16); }
__device__ __forceinline__ float bfhi(unsigned w) { return __builtin_bit_cast(float, w & 0xffff0000u); }
__device__ __forceinline__ int lane_id() { return (int)__builtin_amdgcn_mbcnt_hi(~0u, __builtin_amdgcn_mbcnt_lo(~0u, 0u)); }
#define dpp_f(old, src, ctrl, rmask) __builtin_bit_cast(float, __builtin_amdgcn_update_dpp(__builtin_bit_cast(int, (float)(old)), __builtin_bit_cast(int, (float)(src)), ctrl, rmask, 0xf, false))
__device__ __forceinline__ float sxor32(float v, int hi) { auto rr = __builtin_amdgcn_permlane32_swap(__builtin_bit_cast(unsigned, v), __builtin_bit_cast(unsigned, v), false, false);
    return __builtin_bit_cast(float, hi ? rr[0] : rr[1]); }
__device__ __forceinline__ float quad_sum(float v) { v += dpp_f(0.f, v, 0xB1, 0xf); v += dpp_f(0.f, v, 0x4E, 0xf); return v; }
__device__ __forceinline__ float oct_sum(float v, int lane) { v = quad_sum(v); const float dn = dpp_f(0.f, v, 0x114, 0xf), up = dpp_f(0.f, v, 0x104, 0xf); return v + ((lane & 4) ? dn : up); }
#define DPP_SCAN(v, OP, ID) do { v = OP(v, __builtin_bit_cast(float, __builtin_amdgcn_update_dpp(__builtin_bit_cast(int, ID), __builtin_bit_cast(int, v), 0x111, 0xf, 0xf, false))); \
    v = OP(v, __builtin_bit_cast(float, __builtin_amdgcn_update_dpp(__builtin_bit_cast(int, ID), __builtin_bit_cast(int, v), 0x112, 0xf, 0xf, false))); \
    v = OP(v, __builtin_bit_cast(float, __builtin_amdgcn_update_dpp(__builtin_bit_cast(int, ID), __builtin_bit_cast(int, v), 0x114, 0xf, 0xf, false))); \
    v = OP(v, __builtin_bit_cast(float, __builtin_amdgcn_update_dpp(__builtin_bit_cast(int, ID), __builtin_bit_cast(int, v), 0x118, 0xf, 0xf, false))); \
    v = OP(v, __builtin_bit_cast(float, __builtin_amdgcn_update_dpp(__builtin_bit_cast(int, ID), __builtin_bit_cast(int, v), 0x142, 0xa, 0xf, false))); \
    v = OP(v, __builtin_bit_cast(float, __builtin_amdgcn_update_dpp(__builtin_bit_cast(int, ID), __builtin_bit_cast(int, v), 0x143, 0xc, 0xf, false))); } while (0)
#define OP_ADD(a, b) ((a) + (b))
#define OP_MAX(a, b) fmaxf((a), (b))
__device__ __forceinline__ float wave_sum(float v) { DPP_SCAN(v, OP_ADD, 0.0f); return __builtin_bit_cast(float, __builtin_amdgcn_readlane(__builtin_bit_cast(int, v), 63)); }

namespace pg8 {
#define PG8_LAS __attribute__((address_space(3)))
typedef unsigned short bf16_t;
typedef unsigned u32x4 __attribute__((ext_vector_type(4)));
constexpr int BM = 256, BK = 64, HALF = 128, HTB = HALF * BK * 2, STAGE_BYTES = 8 * HTB, NXCD = 8, WGM = 8;

__host__ __device__ __forceinline__ int lds_byte(int r, int c) { const int st = (r >> 4) * 2 + (c >> 5), rr = r & 15, cc = c & 31, ob = rr * 64 + cc * 2; return st * 1024 + (ob ^ (((ob >> 9) & 1) << 5)); }
__host__ __device__ __forceinline__ void stage_rc(int b, int& R, int& C) { const int st = b / 1024, sb = b % 1024, swz = sb ^ (((sb >> 9) & 1) << 5); R = (st >> 1) * 16 + swz / 64; C = (st & 1) * 32 + (swz % 64) / 2; }
__host__ __device__ __forceinline__ int perm32(int rho) { const int n = rho >> 4, i = rho & 15; return 8 * (i >> 2) + 4 * n + (i & 3); }

struct Unit { int pm, pn, e, pml, nvalid; };

__device__ __forceinline__ void tile_decode(int wgid, int nM, int nN, int& pm, int& pn) {
    const int nig = WGM * nN, gid = wgid / nig, fm = gid * WGM, gsz = (nM - fm) < WGM ? (nM - fm) : WGM;
    pm = fm + ((wgid % nig) % gsz); pn = (wgid % nig) / gsz;
}
__device__ __forceinline__ int xcd_remap(int L, int nwg) { const int q = nwg / NXCD, r = nwg % NXCD, xcd = L % NXCD, off = L / NXCD; return (xcd < r ? xcd * (q + 1) : r * (q + 1) + (xcd - r) * q) + off; }

struct DenseOrder {
    static constexpr bool GATHER = false, FP8 = false;
    const char* A; const char* B; int K, KT; int nM, nN, nwg, G, c;
    __device__ void init(const void* A_, const void* B_, int M, int N, int K_, int G_, int c_) { A = (const char*)A_; B = (const char*)B_; K = K_; KT = K_ / BK; nM = M / BM; nN = N / BM; nwg = nM * nN; G = G_; c = c_; }
    __device__ __forceinline__ bool next(int i, Unit& u) const {
        const long L = (long)i * G + c; if (L >= nwg) return false;
        const int wgid = xcd_remap((int)L, nwg); tile_decode(wgid, nM, nN, u.pm, u.pn); u.e = 0; u.pml = u.pm; u.nvalid = BM; return true;
    }
    __device__ __forceinline__ const char* a_ptr(const Unit& u) const { return A + (size_t)u.pm * ((size_t)BM * K * 2); }
    __device__ __forceinline__ const char* b_ptr(const Unit& u) const { return B + (size_t)u.pn * ((size_t)BM * K * 2); }
    __device__ __forceinline__ unsigned grow(const Unit&, int) const { return 0u; }
    __device__ __forceinline__ const unsigned* rptr(const Unit&, int) const { return nullptr; }
};
struct InprojOrder {
    static constexpr bool GATHER = false, FP8 = false;
    const char* A; const char* B; int K, KT, nM, nN, G, c, i0, ni;
    __device__ void init(const void* A_, const void* B_, int M, int N, int K_, int G_, int c_, int i0_, int ni_) { A = (const char*)A_; B = (const char*)B_; K = K_; KT = K_ / BK; nM = M / BM; nN = N / BM; G = G_; c = c_; i0 = i0_; ni = ni_; }
    __device__ __forceinline__ bool next(int i, Unit& u) const {
        if (i >= ni) return false;
        const int off = (i0 + i) * (G >> 3) + (c >> 3); if (off >= WGM * nN) return false;
        tile_decode((c & 7) * WGM * nN + off, nM, nN, u.pm, u.pn); u.e = 0; u.pml = u.pm; u.nvalid = BM; return true;
    }
    __device__ __forceinline__ const char* a_ptr(const Unit& u) const { return A + (size_t)u.pm * ((size_t)BM * K * 2); }
    __device__ __forceinline__ const char* b_ptr(const Unit& u) const { return B + (size_t)u.pn * ((size_t)BM * K * 2); }
    __device__ __forceinline__ unsigned grow(const Unit&, int) const { return 0u; }
    __device__ __forceinline__ const unsigned* rptr(const Unit&, int) const { return nullptr; }
};
template <bool GATH> struct MoeOrder {
    static constexpr bool GATHER = GATH, FP8 = MOE_FP8 != 0;

    const char* A; const char* B; int K, KT; size_t bstride; int nN, nwg, G, c; const volatile LAS int* tab; const uint2* rinfo;
    __device__ void init(const void* A_, const void* B_, size_t bstride_, int N, int K_, int G_, int c_, const volatile LAS int* tab_, const uint2* rinfo_) {
        A = (const char*)A_; B = (const char*)B_; K = K_; KT = K_ / BK; bstride = bstride_; nN = N / BM; G = G_; c = c_; tab = tab_; rinfo = rinfo_; nwg = tab_[8] * nN; }
    __device__ __forceinline__ bool next(int i, Unit& u) const {
        const long L = (long)i * G + c; if (L >= nwg) return false;
        decode(xcd_remap((int)L, nwg), u); return true;
    }
    __device__ __forceinline__ void decode(const int wgid, Unit& u) const {
        int e = 0;
#pragma unroll
        for (int j = 1; j < 8; ++j) if (wgid >= tab[j] * nN) e = j;
        const int t0 = tab[e], nMe = tab[e + 1] - t0, cnt = tab[16 + e];
        int pml, pn;
        if (GATH) {
            const int ng = (nMe + WGM - 1) / WGM, bs = nMe / ng, ex = nMe - bs * ng, big = (bs + 1) * 4;
            int w = wgid - t0 * nN, fm, gsz;
            const int cb = w / (4 * nMe); w -= cb * 4 * nMe;
            if (w < ex * big) { const int g = w / big; w -= g * big; gsz = bs + 1; fm = g * (bs + 1); }
            else { w -= ex * big; const int g = w / (bs * 4); w -= g * bs * 4; gsz = bs; fm = ex * (bs + 1) + g * bs; }
            pml = fm + w % gsz; pn = 4 * cb + w / gsz;
        } else tile_decode(wgid - t0 * nN, nMe, nN, pml, pn);
        u.e = __builtin_amdgcn_readfirstlane(e); u.pml = __builtin_amdgcn_readfirstlane(pml); u.pn = __builtin_amdgcn_readfirstlane(pn); u.pm = __builtin_amdgcn_readfirstlane(t0 + pml);
        const int nv = cnt - pml * BM; u.nvalid = __builtin_amdgcn_readfirstlane(nv < BM ? nv : BM);
    }
    __device__ __forceinline__ const char* a_ptr(const Unit& u) const { return GATH ? A : A + (size_t)u.pm * ((size_t)BM * K * 2); }
    __device__ __forceinline__ const char* b_ptr(const Unit& u) const { return B + (size_t)u.e * bstride + (size_t)u.pn * ((size_t)BM * K * 2); }
    __device__ __forceinline__ const unsigned* rptr(const Unit& u, int r) const { const int rr = r < u.nvalid ? r : u.nvalid - 1; return (const unsigned*)(rinfo + (size_t)u.e * T + (size_t)u.pml * BM + rr); }
    __device__ __forceinline__ unsigned grow(const Unit& u, int r) const {
        const int rr = r < u.nvalid ? r : u.nvalid - 1;
        const unsigned ts = rinfo[(size_t)u.e * T + (size_t)u.pml * BM + rr].x;
        return (ts >> 1) * (unsigned)(K * 2);
    }
};

__device__ __forceinline__ const char* uni_ptr(const char* p) { const unsigned long long v = (unsigned long long)p; const unsigned lo = __builtin_amdgcn_readfirstlane((unsigned)v), hi = __builtin_amdgcn_readfirstlane((unsigned)(v >> 32));
    return (const char*)(((unsigned long long)hi << 32) | lo); }
__device__ __forceinline__ unsigned cvt_pk_bf16(float lo, float hi) { unsigned r; asm volatile("v_cvt_pk_bf16_f32 %0, %1, %2" : "=v"(r) : "v"(lo), "v"(hi)); return r; }

struct EpiProj {
    static constexpr bool PERM = true, RSLDS = true;
    bf16_t* O; const float* RS;
    __device__ __forceinline__ const float* rs_base(const Unit& u) const { return RS + (size_t)u.pm * BM; }
    __device__ __forceinline__ void operator()(const f32x4 (&acc)[2][2][4][2], const Unit& u, int wr, int wc, int fr, int fq, const PG8_LAS float* rsl) const {
        const int row0 = u.pm * BM + wr * 64 + fr, col0 = u.pn * BM + wc * 64 + 8 * fq;
        const float sc0 = (u.pn == 8 || u.pn == 9) ? QS_SCALE : 1.0f;
        float rsv[2][4];
#pragma unroll
        for (int ai = 0; ai < 2; ++ai)
#pragma unroll
            for (int m = 0; m < 4; ++m) rsv[ai][m] = rsl[wr * 64 + fr + ai * HALF + m * 16];
#pragma unroll
        for (int ai = 0; ai < 2; ++ai)
#pragma unroll
            for (int m = 0; m < 4; ++m) { bf16_t* rowp = O + (size_t)(row0 + ai * HALF + m * 16) * NPROJ + col0; const float sc = sc0 * rsv[ai][m];
#pragma unroll
                for (int bj = 0; bj < 2; ++bj) { const f32x4 v0 = acc[ai][bj][m][0] * sc, v1 = acc[ai][bj][m][1] * sc;
                    u32x4 w; w.x = cvt_pk_bf16(v0[0], v0[1]); w.y = cvt_pk_bf16(v0[2], v0[3]); w.z = cvt_pk_bf16(v1[0], v1[1]); w.w = cvt_pk_bf16(v1[2], v1[3]);
                    *(u32x4*)(rowp + bj * 32) = w; } }
    }
};
struct EpiResid {
    static constexpr bool PERM = false, RSLDS = false;
    const float* Hin; float* Hout;
    __device__ __forceinline__ void operator()(const f32x4 (&acc)[2][2][4][2], const Unit& u, int wr, int wc, int fr, int fq) const {
        const int row0 = u.pm * BM + wr * 64 + fr, col0 = u.pn * BM + wc * 32 + 4 * fq;
#pragma unroll
        for (int ai = 0; ai < 2; ++ai)
#pragma unroll
            for (int mh = 0; mh < 2; ++mh) {
                f32x4 hv[2][2][2];
#pragma unroll
                for (int m2 = 0; m2 < 2; ++m2) { const size_t off = (size_t)(row0 + ai * HALF + (2 * mh + m2) * 16) * DM + col0;
#pragma unroll
                    for (int bj = 0; bj < 2; ++bj)
#pragma unroll
                        for (int n = 0; n < 2; ++n) hv[m2][bj][n] = *(const f32x4*)(Hin + off + bj * HALF + n * 16); }
                asm volatile("" : "+v"(hv[0][0][0]), "+v"(hv[0][0][1]), "+v"(hv[0][1][0]), "+v"(hv[0][1][1]), "+v"(hv[1][0][0]), "+v"(hv[1][0][1]), "+v"(hv[1][1][0]), "+v"(hv[1][1][1]));
#pragma unroll
                for (int m2 = 0; m2 < 2; ++m2) { const size_t off = (size_t)(row0 + ai * HALF + (2 * mh + m2) * 16) * DM + col0;
#pragma unroll
                    for (int bj = 0; bj < 2; ++bj)
#pragma unroll
                        for (int n = 0; n < 2; ++n) *(f32x4*)(Hout + off + bj * HALF + n * 16) = hv[m2][bj][n] + acc[ai][bj][2 * mh + m2][n]; }
            }
    }
};
template <bool XIN> struct EpiResid16 {
    static constexpr bool PERM = true, RSLDS = false;
    const float* X; bf16_t* H;
    __device__ __forceinline__ void operator()(const f32x4 (&acc)[2][2][4][2], const Unit& u, int wr, int wc, int fr, int fq) const {
        const int row0 = u.pm * BM + wr * 64 + fr, col0 = u.pn * BM + wc * 64 + 8 * fq;
#pragma unroll
        for (int ai = 0; ai < 2; ++ai) {
            u32x4 hb[4][2];
#pragma unroll
            for (int m = 0; m < 4; ++m)
#pragma unroll
                for (int bj = 0; bj < 2; ++bj) hb[m][bj] = *(const u32x4*)(H + (size_t)(row0 + ai * HALF + m * 16) * DM + col0 + bj * 32);
            asm volatile("" : "+v"(hb[0][0]), "+v"(hb[0][1]), "+v"(hb[1][0]), "+v"(hb[1][1]), "+v"(hb[2][0]), "+v"(hb[2][1]), "+v"(hb[3][0]), "+v"(hb[3][1]));
#pragma unroll
            for (int m = 0; m < 4; ++m)
#pragma unroll
                for (int bj = 0; bj < 2; ++bj) { const u32x4 b = hb[m][bj];
                    const f32x4 h0 = (f32x4){__builtin_bit_cast(float, b.x << 16), __builtin_bit_cast(float, b.x & 0xffff0000u), __builtin_bit_cast(float, b.y << 16), __builtin_bit_cast(float, b.y & 0xffff0000u)};
                    const f32x4 h1 = (f32x4){__builtin_bit_cast(float, b.z << 16), __builtin_bit_cast(float, b.z & 0xffff0000u), __builtin_bit_cast(float, b.w << 16), __builtin_bit_cast(float, b.w & 0xffff0000u)};
                    const f32x4 r0 = h0 + acc[ai][bj][m][0], r1 = h1 + acc[ai][bj][m][1];
                    u32x4 w; w.x = cvt_pk_bf16(r0[0], r0[1]); w.y = cvt_pk_bf16(r0[2], r0[3]); w.z = cvt_pk_bf16(r1[0], r1[1]); w.w = cvt_pk_bf16(r1[2], r1[3]);
                    *(u32x4*)(H + (size_t)(row0 + ai * HALF + m * 16) * DM + col0 + bj * 32) = w; }
        }
    }
};
__device__ __forceinline__ float silu_mul(float g, float u) { return g * u * __builtin_amdgcn_rcpf(1.0f + __builtin_amdgcn_exp2f(-g * LOG2E)); }
struct EpiSwiglu {
    static constexpr bool PERM = true, RSLDS = true;
    bf16_t* O; int ld; const float* RS; const float* RSI;
    __device__ __forceinline__ const float* rs_base(const Unit& u) const { return RSI ? RSI + (size_t)u.e * T + (size_t)u.pml * BM : RS + (size_t)u.pm * BM; }
    __device__ __forceinline__ void operator()(const f32x4 (&acc)[2][2][4][2], const Unit& u, int wr, int wc, int fr, int fq, const PG8_LAS float* rsl) const {
        const int row0 = u.pm * BM + wr * 64 + fr, col0 = u.pn * HALF + wc * 32 + 8 * fq;
        float rsv[2][4];
#pragma unroll
        for (int ai = 0; ai < 2; ++ai)
#pragma unroll
            for (int m = 0; m < 4; ++m) rsv[ai][m] = rsl[wr * 64 + fr + ai * HALF + m * 16];
#pragma unroll
        for (int ai = 0; ai < 2; ++ai)
#pragma unroll
            for (int m = 0; m < 4; ++m) { bf16_t* rowp = O + (size_t)(row0 + ai * HALF + m * 16) * ld + col0; const float rs = rsv[ai][m];
                const f32x4 g0 = acc[ai][0][m][0] * rs, g1 = acc[ai][0][m][1] * rs, u0 = acc[ai][1][m][0] * rs, u1 = acc[ai][1][m][1] * rs;
                u32x4 w; w.x = cvt_pk_bf16(silu_mul(g0[0], u0[0]), silu_mul(g0[1], u0[1])); w.y = cvt_pk_bf16(silu_mul(g0[2], u0[2]), silu_mul(g0[3], u0[3]));
                w.z = cvt_pk_bf16(silu_mul(g1[0], u1[0]), silu_mul(g1[1], u1[1])); w.w = cvt_pk_bf16(silu_mul(g1[2], u1[2]), silu_mul(g1[3], u1[3]));
                *(u32x4*)rowp = w; }
    }
};
struct EpiSwiglu8 {
    static constexpr bool PERM = true, RSLDS = false;
    unsigned char* O; int ld; float sc;
    __device__ __forceinline__ void operator()(const f32x4 (&acc)[2][2][4][2], const Unit& u, int wr, int wc, int fr, int fq) const {
        const int row0 = u.pm * BM + wr * 64 + fr, col0 = u.pn * HALF + wc * 32 + 8 * fq;
#pragma unroll
        for (int ai = 0; ai < 2; ++ai)
#pragma unroll
            for (int m = 0; m < 4; ++m) { unsigned char* rowp = O + (size_t)(row0 + ai * HALF + m * 16) * ld + col0;
                const f32x4 g0 = acc[ai][0][m][0] * sc, g1 = acc[ai][0][m][1] * sc, u0 = acc[ai][1][m][0] * (sc * F8_HID), u1 = acc[ai][1][m][1] * (sc * F8_HID);
                float h[8];
#pragma unroll
                for (int q = 0; q < 4; ++q) { h[q] = __builtin_fminf(__builtin_fmaxf(silu_mul(g0[q], u0[q]), -F8_MAX), F8_MAX); h[4 + q] = __builtin_fminf(__builtin_fmaxf(silu_mul(g1[q], u1[q]), -F8_MAX), F8_MAX); }
                typedef unsigned u32x2_ __attribute__((ext_vector_type(2)));
                *(u32x2_*)rowp = (u32x2_){pk4_f8(h[0], h[1], h[2], h[3]), pk4_f8(h[4], h[5], h[6], h[7])}; }
    }
};
struct EpiScatter {
    static constexpr bool PERM = true, RSLDS = false;
    bf16_t* O2; const uint2* rinfo; float sc;
    __device__ __forceinline__ void operator()(const f32x4 (&acc)[2][2][4][2], const Unit& u, int wr, int wc, int fr, int fq) const {
        const int col0 = u.pn * BM + wc * 64 + 8 * fq;
        uint2 inf[2][4];
#pragma unroll
        for (int ai = 0; ai < 2; ++ai)
#pragma unroll
            for (int m = 0; m < 4; ++m) { const int rl = ai * HALF + wr * 64 + m * 16 + fr; const int rc = rl < u.nvalid ? rl : u.nvalid - 1;
                inf[ai][m] = rinfo[(size_t)u.e * T + (size_t)u.pml * BM + rc]; }
#pragma unroll
        for (int ai = 0; ai < 2; ++ai)
#pragma unroll
            for (int m = 0; m < 4; ++m) asm volatile("" : "+v"(inf[ai][m].x), "+v"(inf[ai][m].y));
#pragma unroll
        for (int ai = 0; ai < 2; ++ai)
#pragma unroll
            for (int m = 0; m < 4; ++m) { const int rl = ai * HALF + wr * 64 + m * 16 + fr;
                if (rl < u.nvalid) { const float wgt = __builtin_bit_cast(float, inf[ai][m].y) * sc;
                    bf16_t* rowp = O2 + ((size_t)(inf[ai][m].x & 1u) * T + (size_t)(inf[ai][m].x >> 1)) * DM + col0;
#pragma unroll
                    for (int bj = 0; bj < 2; ++bj) { const f32x4 v0 = acc[ai][bj][m][0] * wgt, v1 = acc[ai][bj][m][1] * wgt;
                        u32x4 w; w.x = cvt_pk_bf16(v0[0], v0[1]); w.y = cvt_pk_bf16(v0[2], v0[3]); w.z = cvt_pk_bf16(v1[0], v1[1]); w.w = cvt_pk_bf16(v1[2], v1[3]);
                        *(u32x4*)(rowp + bj * 32) = w; } } }
    }
};

struct MoeTailOrder {
    static constexpr bool GATHER = false, FP8 = MOE_FP8 != 0;
    MoeOrder<false> base; const char* A; const char* B; int K, KT, slice, wgid; bool have;
    __device__ void init(const MoeOrder<false>& b, int nmain, int rem, int ks, int c) { base = b; A = b.A; B = b.B; K = b.K; KT = b.KT / ks; have = c < rem * ks; slice = c / (rem > 0 ? rem : 1); wgid = nmain + c % (rem > 0 ? rem : 1); }
    __device__ __forceinline__ bool next(int i, Unit& u) const { if (i != 0 || !have) return false; base.decode(wgid, u); return true; }
    __device__ __forceinline__ const char* a_ptr(const Unit& u) const { return base.a_ptr(u) + (size_t)slice * KT * (BK * 2); }
    __device__ __forceinline__ const char* b_ptr(const Unit& u) const { return base.b_ptr(u) + (size_t)slice * KT * (BK * 2); }
    __device__ __forceinline__ unsigned grow(const Unit&, int) const { return 0u; }
    __device__ __forceinline__ const unsigned* rptr(const Unit&, int) const { return nullptr; }
};
struct EpiPartial {
    static constexpr bool PERM = true, RSLDS = false;
    float* P;
    __device__ __forceinline__ void operator()(const f32x4 (&acc)[2][2][4][2], const Unit&, int wr, int wc, int fr, int fq) const {
        const int tid = (wr * 4 + wc) * 64 + fq * 16 + fr;
#pragma unroll
        for (int ai = 0; ai < 2; ++ai)
#pragma unroll
            for (int bj = 0; bj < 2; ++bj)
#pragma unroll
                for (int m = 0; m < 4; ++m)
#pragma unroll
                    for (int n = 0; n < 2; ++n) *(f32x4*)(P + ((size_t)((((ai * 2 + bj) * 4 + m) * 2 + n) * 512 + tid)) * 4) = acc[ai][bj][m][n];
    }
};

template <class Epi, class Sched, bool ALIGN_EPI>
__device__ __forceinline__ void gemm_phase(PG8_LAS unsigned char* lds, const Sched& S, const Epi& E, const int tid) {
    const int wid = __builtin_amdgcn_readfirstlane(tid >> 6), lane = tid & 63, wr = wid >> 2, wc = wid & 3, fr = lane & 15, fq = lane >> 4;
    const int K = S.K, nt = S.KT;
    constexpr bool GA = Sched::GATHER;
    unsigned voffA[2], voffB[2]; int RA[2], CA[2];
#pragma unroll
    for (int i = 0; i < 2; ++i) { int R, C; stage_rc(tid * 16 + i * 8192, R, C); const int Rb = Epi::PERM ? ((R >> 5) * 64 + perm32(R & 31)) : R;
        RA[i] = R; CA[i] = C; voffA[i] = GA ? (unsigned)(C * 2) : (unsigned)(R * K + C) * 2u; voffB[i] = (unsigned)(Rb * K + C) * 2u; }
    const size_t kstep = (size_t)(BK * 2);
    const size_t hstep = (size_t)HALF * K * 2;
    const size_t hstepB = Epi::PERM ? (size_t)32 * K * 2 : hstep;
    const unsigned ldsw = (unsigned)wid * 1024u;
    const int aoff = lds_byte(wr * 64 + fr, fq * 8), boff = lds_byte(wc * 32 + fr, fq * 8);
#define PG8_SA(b, h) (((b) * 2 + (h)) * HTB)
#define PG8_SB(b, h) ((4 + (b) * 2 + (h)) * HTB)
#define PG8_STAGE(bufoff, gbase, voff) do { const char* _g = (const char*)(gbase); asm volatile("" : "+s"(_g)); _Pragma("unroll") for (int _i = 0; _i < 2; ++_i) { unsigned _v = (voff)[_i]; asm volatile("" : "+v"(_v)); \
        __builtin_amdgcn_global_load_lds((const unsigned*)(_g + _v), (PG8_LAS unsigned*)(lds + (bufoff) + ldsw + _i * 8192), 16, 0, 0); } } while (0)
#define PG8_STAGE_A(bufoff, kb, h, NX) do { if constexpr (GA) { const char* _g = (const char*)(kb); asm volatile("" : "+s"(_g)); _Pragma("unroll") for (int _i = 0; _i < 2; ++_i) { unsigned _o = ((NX) ? gnx[h][_i] : gcu[h][_i]) + voffA[_i]; asm volatile("" : "+v"(_o)); \
        __builtin_amdgcn_global_load_lds((const unsigned*)(_g + _o), (PG8_LAS unsigned*)(lds + (bufoff) + ldsw + _i * 8192), 16, 0, 0); } } \
        else { PG8_STAGE(bufoff, (kb) + (h) * hstep, voffA); } } while (0)
#define PG8_LDA(dst, b, h) do { _Pragma("unroll") for (int m = 0; m < 4; ++m) _Pragma("unroll") for (int k = 0; k < 2; ++k) dst[m][k] = *(const PG8_LAS bf16x8*)(lds + PG8_SA(b, h) + aoff + m * 2048 + k * 1024); } while (0)
#define PG8_LDB(dst, b, h) do { _Pragma("unroll") for (int n = 0; n < 2; ++n) _Pragma("unroll") for (int k = 0; k < 2; ++k) dst[n][k] = *(const PG8_LAS bf16x8*)(lds + PG8_SB(b, h) + boff + n * 2048 + k * 1024); } while (0)
#define PG8_CAT(F) __builtin_shufflevector(__builtin_bit_cast(i32x4, F[0]), __builtin_bit_cast(i32x4, F[1]), 0, 1, 2, 3, 4, 5, 6, 7)
#define PG8_MMA(ai, bj, At, Bt) do { __builtin_amdgcn_s_setprio(1); if constexpr (Sched::FP8) { _Pragma("unroll") for (int m = 0; m < 4; ++m) _Pragma("unroll") for (int n = 0; n < 2; ++n) \
        { const i32x8 _b = PG8_CAT(Bt[n]), _a = PG8_CAT(At[m]); asm volatile("v_mfma_f32_16x16x128_f8f6f4 %0, %1, %2, %0" : "+v"(acc[ai][bj][m][n]) : "v"(_b), "v"(_a)); } } \
        else { _Pragma("unroll") for (int m = 0; m < 4; ++m) _Pragma("unroll") for (int n = 0; n < 2; ++n) _Pragma("unroll") for (int k = 0; k < 2; ++k) \
        acc[ai][bj][m][n] = __builtin_amdgcn_mfma_f32_16x16x32_bf16(Bt[n][k], At[m][k], acc[ai][bj][m][n], 0, 0, 0); } __builtin_amdgcn_s_setprio(0); } while (0)
#define PG8_WAIT_V(n) asm volatile("s_waitcnt vmcnt(" #n ")" ::: "memory")
#define PG8_WAIT_L(n) asm volatile("s_waitcnt lgkmcnt(" #n ")" ::: "memory")
#define PG8_BAR __builtin_amdgcn_s_barrier()
#define PG8_SCHED __builtin_amdgcn_sched_barrier(0)
    Unit cur, nxt; int ui = 0;
    if (!S.next(0, cur)) return;
#define PG8_RS_STAGE(u_, par_) do { if constexpr (Epi::RSLDS) { if (wid < 4) __builtin_amdgcn_global_load_lds((const unsigned*)(E.rs_base(u_) + wid * 64 + lane), (PG8_LAS unsigned*)(lds + STAGE_BYTES + (par_) * 1024 + wid * 256), 4, 0, 0); } } while (0)
    PG8_RS_STAGE(cur, 0);
    unsigned gcu[2][2] = {{0u, 0u}, {0u, 0u}}, gnx[2][2] = {{0u, 0u}, {0u, 0u}};
    if constexpr (GA) {
#pragma unroll
        for (int h = 0; h < 2; ++h)
#pragma unroll
            for (int i = 0; i < 2; ++i) gcu[h][i] = S.grow(cur, h * HALF + RA[i]);
    }
    f32x4 acc[2][2][4][2];
#pragma unroll
    for (int a = 0; a < 2; ++a)
#pragma unroll
        for (int b = 0; b < 2; ++b)
#pragma unroll
            for (int m = 0; m < 4; ++m)
#pragma unroll
                for (int n = 0; n < 2; ++n) acc[a][b][m][n] = (f32x4){0.f, 0.f, 0.f, 0.f};
    bf16x8 At[4][2], B0[2][2], B1[2][2];
    const char* cA = uni_ptr(S.a_ptr(cur)); const char* cB = uni_ptr(S.b_ptr(cur));
    PG8_STAGE(PG8_SB(0, 0), cB, voffB); PG8_STAGE(PG8_SB(0, 1), cB + hstepB, voffB); PG8_STAGE_A(PG8_SA(0, 0), cA, 0, false); PG8_STAGE_A(PG8_SA(0, 1), cA, 1, false);
    if (wr == 1) PG8_BAR;
    PG8_WAIT_V(2); PG8_BAR;
    PG8_STAGE(PG8_SB(1, 0), cB + kstep, voffB); PG8_STAGE_A(PG8_SA(1, 0), cA + kstep, 0, false); PG8_STAGE(PG8_SB(1, 1), cB + hstepB + kstep, voffB);
    PG8_WAIT_V(6); PG8_BAR;
    for (;;) {
        const bool has_next = S.next(ui + 1, nxt);
        const char* nA = uni_ptr(has_next ? S.a_ptr(nxt) : cA); const char* nB = uni_ptr(has_next ? S.b_ptr(nxt) : cB);
        unsigned raw[2][2] = {{0u, 0u}, {0u, 0u}};
        if constexpr (GA) {
            if (has_next) {
#pragma unroll
                for (int h = 0; h < 2; ++h)
#pragma unroll
                    for (int i = 0; i < 2; ++i) { const unsigned* rp = S.rptr(nxt, h * HALF + RA[i]); asm volatile("global_load_dword %0, %1, off" : "=v"(raw[h][i]) : "v"(rp) : "memory"); }
            }
        }
        for (int t = 0; t < nt; t += 2) {
            const bool last = (t == nt - 2);
            if constexpr (GA) { if (last) { asm volatile("" : "+v"(raw[0][0]), "+v"(raw[0][1]), "+v"(raw[1][0]), "+v"(raw[1][1]));
#pragma unroll
                for (int h = 0; h < 2; ++h)
#pragma unroll
                    for (int i = 0; i < 2; ++i) gnx[h][i] = has_next ? (raw[h][i] >> 1) * (unsigned)(K * 2) : gcu[h][i]; } }
            const char* a1 = cA + (size_t)(t + 1) * kstep;
            const char* a2 = last ? nA : cA + (size_t)(t + 2) * kstep; const char* b2 = last ? nB : cB + (size_t)(t + 2) * kstep;
            const char* a3 = a2 + kstep; const char* b3 = b2 + kstep;
            PG8_LDB(B0, 0, 0); PG8_LDB(B1, 0, 1); PG8_SCHED; PG8_LDA(At, 0, 0); PG8_STAGE_A(PG8_SA(1, 1), a1, 1, false);
            PG8_WAIT_V(8); PG8_WAIT_L(0); PG8_BAR; PG8_MMA(0, 0, At, B0); PG8_MMA(0, 1, At, B1); PG8_BAR; PG8_SCHED;
            PG8_LDA(At, 0, 1); PG8_STAGE(PG8_SB(0, 0), b2, voffB); PG8_STAGE(PG8_SB(0, 1), b2 + hstepB, voffB); PG8_STAGE_A(PG8_SA(0, 0), a2, 0, last);
            PG8_WAIT_V(8); PG8_WAIT_L(0); PG8_BAR; PG8_MMA(1, 0, At, B0); PG8_MMA(1, 1, At, B1); PG8_BAR; PG8_SCHED;
            PG8_LDB(B0, 1, 0); PG8_LDB(B1, 1, 1); PG8_SCHED; PG8_LDA(At, 1, 0); PG8_STAGE_A(PG8_SA(0, 1), a2, 1, last);
            PG8_WAIT_V(8); PG8_WAIT_L(0); PG8_BAR; PG8_MMA(0, 0, At, B0); PG8_MMA(0, 1, At, B1); PG8_BAR; PG8_SCHED;
            PG8_LDA(At, 1, 1); PG8_STAGE(PG8_SB(1, 0), b3, voffB); PG8_STAGE(PG8_SB(1, 1), b3 + hstepB, voffB); PG8_STAGE_A(PG8_SA(1, 0), a3, 0, last);
            PG8_WAIT_V(8); PG8_WAIT_L(0); PG8_BAR; PG8_MMA(1, 0, At, B0); PG8_MMA(1, 1, At, B1); PG8_BAR; PG8_SCHED;
        }
        if constexpr (Sched::FP8) asm volatile("s_nop 15\n\ts_nop 15" ::: "memory");
        if constexpr (ALIGN_EPI) { if (wr == 0) PG8_BAR; }
        if constexpr (Epi::RSLDS) E(acc, cur, wr, wc, fr, fq, (const PG8_LAS float*)(lds + STAGE_BYTES + (ui & 1) * 1024)); else E(acc, cur, wr, wc, fr, fq);
        if (!has_next) break;
#pragma unroll
        for (int a = 0; a < 2; ++a)
#pragma unroll
            for (int b = 0; b < 2; ++b)
#pragma unroll
                for (int m = 0; m < 4; ++m)
#pragma unroll
                    for (int n = 0; n < 2; ++n) acc[a][b][m][n] = (f32x4){0.f, 0.f, 0.f, 0.f};
        cur = nxt; cA = nA; cB = nB; ++ui;
        PG8_RS_STAGE(cur, ui & 1);
        if constexpr (GA) {
#pragma unroll
            for (int h = 0; h < 2; ++h)
#pragma unroll
                for (int i = 0; i < 2; ++i) gcu[h][i] = gnx[h][i];
        }
        if constexpr (ALIGN_EPI) { if (wr == 1) PG8_BAR; }
    }
    PG8_WAIT_V(0);
    if constexpr (!ALIGN_EPI) { if (wr == 0) PG8_BAR; }
    PG8_BAR;
#undef PG8_RS_STAGE
#undef PG8_SA
#undef PG8_SB
#undef PG8_STAGE
#undef PG8_STAGE_A
#undef PG8_LDA
#undef PG8_LDB
#undef PG8_MMA
#undef PG8_CAT
#undef PG8_WAIT_V
#undef PG8_WAIT_L
#undef PG8_BAR
#undef PG8_SCHED
}
}

#define XB_TMO      128
#define XB_XCNT(j)  (256  + 64 * (j))
#define XB_XSUB(j)  (1280 + 64 * (j))
#define XB_XGEN(j)  (2304 + 64 * (j))
#define XB_TOP      3328
#define XB_TOPGEN   3392
#define XCD_BAR_WORDS 3456
#define XB_SPIN_CAP (1u << 20)

__device__ __forceinline__ unsigned xb_ld(unsigned* p)              { return __hip_atomic_load(p, __ATOMIC_RELAXED, __HIP_MEMORY_SCOPE_AGENT); }
__device__ __forceinline__ unsigned xb_add(unsigned* p, unsigned v) { return __hip_atomic_fetch_add(p, v, __ATOMIC_RELAXED, __HIP_MEMORY_SCOPE_AGENT); }
__device__ __forceinline__ unsigned xb_xcc_id() { return (unsigned)__builtin_amdgcn_s_getreg((3 << 11) | 20) & 0xFu; }
#define XB_SPIN(cond, bar) do { unsigned _sp = 0; while (cond) { __builtin_amdgcn_s_sleep(1); \
    if ((++_sp & 255u) == 0u) { if (xb_ld(&(bar)[XB_TMO])) break; if (_sp > XB_SPIN_CAP) { atomicAdd(&(bar)[XB_TMO], 1u); break; } } } } while (0)

struct XcdBarrier { unsigned* bar; unsigned x; volatile LAS unsigned* st; };

__device__ __forceinline__ XcdBarrier xcd_barrier_post(unsigned* bar, volatile LAS unsigned* st) {
    XcdBarrier b; b.bar = bar; b.x = xb_xcc_id(); b.st = st;
    if (threadIdx.x == 0) (void)xb_add(&bar[XB_XCNT(b.x)], 1u);
    return b;
}
__device__ __forceinline__ void xcd_barrier_complete(unsigned* bar, unsigned x, unsigned& nloc, unsigned& nx) {
    const unsigned G = gridDim.x * gridDim.y * gridDim.z;
    unsigned sum, cnt, mine, sp = 0u;
    for (;;) {
        sum = 0u; cnt = 0u; mine = 0u;
#pragma unroll
        for (unsigned j = 0; j < 16; ++j) { const unsigned c = xb_ld(&bar[XB_XCNT(j)]); sum += c; cnt += (c > 0u) ? 1u : 0u; mine = (j == x) ? c : mine; }
        if (sum == G) break;
        __builtin_amdgcn_s_sleep(1);
        if ((++sp & 255u) == 0u) { if (xb_ld(&bar[XB_TMO])) break; if (sp > XB_SPIN_CAP) { atomicAdd(&bar[XB_TMO], 1u); break; } }
    }
    nloc = mine > 0u ? mine : 1u; nx = cnt > 0u ? cnt : 1u;
}
__device__ __forceinline__ void xcd_barrier(const XcdBarrier& b, const int wave_s) {
    asm volatile("s_waitcnt vmcnt(0)" ::: "memory");
    __syncthreads();
    if (wave_s == 0 && lane_id() == 0) {
        unsigned* bar = b.bar;
        __builtin_amdgcn_s_waitcnt(0);
        unsigned nloc = b.st[0], nx = b.st[1];
        if (nloc == 0u) { xcd_barrier_complete(bar, b.x, nloc, nx); b.st[0] = nloc; b.st[1] = nx; }
        const unsigned old = xb_add(&bar[XB_XSUB(b.x)], 1u);
        const unsigned gen = old / nloc;
        if (old + 1u == (gen + 1u) * nloc) {
            __builtin_amdgcn_fence(__ATOMIC_RELEASE, "agent");
            asm volatile("s_waitcnt vmcnt(0)" ::: "memory");
            const unsigned og = xb_add(&bar[XB_TOP], 1u);
            const unsigned tg = og / nx;
            if (og + 1u == (tg + 1u) * nx) xb_add(&bar[XB_TOPGEN], 1u);
            else XB_SPIN(xb_ld(&bar[XB_TOPGEN]) == tg, bar);
            __builtin_amdgcn_fence(__ATOMIC_ACQUIRE, "agent");
            xb_add(&bar[XB_XGEN(b.x)], 1u);
            asm volatile("s_waitcnt vmcnt(0)" ::: "memory");
        } else {
            XB_SPIN(xb_ld(&bar[XB_XGEN(b.x)]) == gen, bar);
            __builtin_amdgcn_fence(__ATOMIC_ACQUIRE, "agent");
            asm volatile("s_waitcnt vmcnt(0)" ::: "memory");
        }
    }
    __syncthreads();
}

#define GB_XCNT(x) (64 * (x))
#define GB_SUB(x)  (1024 + 64 * (x))
#define GB_GEN(x)  (2048 + 64 * (x))
#define GB_TOP     3072
#define GB_ASUB(x) (3136 + 32 * (x))
#define GB_ATOP    3712
__device__ __forceinline__ void group_members(gu32* gb, volatile LAS unsigned* st, const unsigned x, unsigned& nloc, unsigned& nx) {
    nloc = st[1]; nx = st[2];
    if (nloc == 0u) { nx = 0u;
        for (unsigned q = 0; q < 16; ++q) { const unsigned c = __hip_atomic_load(gb + GB_XCNT(q), __ATOMIC_RELAXED, __HIP_MEMORY_SCOPE_AGENT); nx += c > 0u ? 1u : 0u; nloc = q == x ? c : nloc; }
        nloc = nloc > 0u ? nloc : 1u; st[1] = nloc; st[2] = nx; }
}
__device__ __forceinline__ void group_arrive(gu32* gb, volatile LAS unsigned* st, const unsigned x, const unsigned r) {
    unsigned nloc, nx; group_members(gb, st, x, nloc, nx);
    const unsigned old = __hip_atomic_fetch_add(gb + GB_ASUB(x), 1u, __ATOMIC_RELAXED, __HIP_MEMORY_SCOPE_AGENT);
    if (old + 1u == r * nloc) { __builtin_amdgcn_fence(__ATOMIC_RELEASE, "agent"); asm volatile("s_waitcnt vmcnt(0)" ::: "memory");
        (void)__hip_atomic_fetch_add(gb + GB_ATOP, 1u, __ATOMIC_RELAXED, __HIP_MEMORY_SCOPE_AGENT); }
}
__device__ __forceinline__ void group_wait(gu32* gb, volatile LAS unsigned* st, const unsigned x, const unsigned r) {
    unsigned nloc, nx; group_members(gb, st, x, nloc, nx);
    unsigned sp = 0u;
    while (__hip_atomic_load(gb + GB_ATOP, __ATOMIC_RELAXED, __HIP_MEMORY_SCOPE_AGENT) < r * nx) { __builtin_amdgcn_s_sleep(1); if (++sp > (1u << 22)) break; }
    __builtin_amdgcn_fence(__ATOMIC_ACQUIRE, "agent");
}
__device__ __forceinline__ void group_barrier(gu32* gb, const int wave_s, volatile LAS unsigned* st, const unsigned x) {
    asm volatile("s_waitcnt vmcnt(0)" ::: "memory");
    __syncthreads();
    if (wave_s == 0 && lane_id() == 0) {
        unsigned nloc, nx; group_members(gb, st, x, nloc, nx);
        const unsigned r = st[0] + 1u; st[0] = r;
        const unsigned old = __hip_atomic_fetch_add(gb + GB_SUB(x), 1u, __ATOMIC_RELAXED, __HIP_MEMORY_SCOPE_AGENT);
        unsigned sp = 0u;
        if (old + 1u == r * nloc) {
            __builtin_amdgcn_fence(__ATOMIC_RELEASE, "agent");
            asm volatile("s_waitcnt vmcnt(0)" ::: "memory");
            (void)__hip_atomic_fetch_add(gb + GB_TOP, 1u, __ATOMIC_RELAXED, __HIP_MEMORY_SCOPE_AGENT);
            while (__hip_atomic_load(gb + GB_TOP, __ATOMIC_RELAXED, __HIP_MEMORY_SCOPE_AGENT) < r * nx) { __builtin_amdgcn_s_sleep(1); if (++sp > (1u << 22)) break; }
            __builtin_amdgcn_fence(__ATOMIC_ACQUIRE, "agent");
            (void)__hip_atomic_fetch_add(gb + GB_GEN(x), 1u, __ATOMIC_RELAXED, __HIP_MEMORY_SCOPE_AGENT);
        } else {
            while (__hip_atomic_load(gb + GB_GEN(x), __ATOMIC_RELAXED, __HIP_MEMORY_SCOPE_AGENT) < r) { __builtin_amdgcn_s_sleep(1); if (++sp > (1u << 22)) break; }
            __builtin_amdgcn_fence(__ATOMIC_ACQUIRE, "agent");
        }
    }
    __syncthreads();
}

struct Args {
    const float* x; const float* norm_mix_g; const float* w_in; const float* b_igate; const float* b_fgate; const float* conv_w; const float* conv_b;
    const float* g_mlstm; const float* g_sb; const float* w_out; const float* norm_ffn_g; const float* ffn_w_gate; const float* ffn_w_up; const float* ffn_w_down;
    const float* w_router; const float* moe_w_gate; const float* moe_w_up; const float* moe_w_down; const float* norm_final_g;
    float* out; unsigned char* ws; int ph_lo, ph_hi;
};
struct Frame {
    LAS unsigned char* lds; volatile LAS unsigned* MISC; gu32* ctl; int tid, lane, wave, G, bid;
};

template <bool F8>
__device__ __forceinline__ void tr_item(const float* src, int ldw, unsigned char* dst, int ldk, LAS float* scr, int lane, const float* gk, const float wsc) {
    const int c = lane & 7;
    f32x4 ga = {1.f, 1.f, 1.f, 1.f}, gb = ga;
    if (gk) { ga = *(const GAS f32x4*)(gk + 8 * c); gb = *(const GAS f32x4*)(gk + 8 * c + 4); }
    {
        const int r8 = lane >> 3, c4 = 4 * (lane & 7);
        f32x4 v[8];
#pragma unroll
        for (int i = 0; i < 8; ++i) v[i] = *(const GAS f32x4*)(src + (size_t)(8 * i + r8) * ldw + c4);
#pragma unroll
        for (int i = 0; i < 8; ++i) { LAS float* d = scr + (8 * i + r8) * 33 + c4; d[0] = v[i].x; d[1] = v[i].y; d[2] = v[i].z; d[3] = v[i].w; }
    }
    LDS_WAIT(); asm volatile("" ::: "memory");
    if constexpr (F8) { ga = ga * wsc; gb = gb * wsc;
#pragma unroll
        for (int j = 0; j < 4; ++j) { const int n = (lane >> 3) + 8 * j; const LAS float* s = scr + (8 * c) * 33 + n;
            v2u o; o.x = pk4_f8(s[0 * 33] * ga.x, s[1 * 33] * ga.y, s[2 * 33] * ga.z, s[3 * 33] * ga.w); o.y = pk4_f8(s[4 * 33] * gb.x, s[5 * 33] * gb.y, s[6 * 33] * gb.z, s[7 * 33] * gb.w);
            *(GAS v2u*)(dst + (size_t)n * ldk + 8 * c) = o; }
    } else {
#pragma unroll
    for (int j = 0; j < 4; ++j) { const int n = (lane >> 3) + 8 * j; const LAS float* s = scr + (8 * c) * 33 + n;
        v4u o; o.x = pk2(s[0 * 33] * ga.x, s[1 * 33] * ga.y); o.y = pk2(s[2 * 33] * ga.z, s[3 * 33] * ga.w); o.z = pk2(s[4 * 33] * gb.x, s[5 * 33] * gb.y); o.w = pk2(s[6 * 33] * gb.z, s[7 * 33] * gb.w);
        *(GAS v4u*)((GAS bf16*)dst + (size_t)n * ldk + 8 * c) = o; }
    }
    LDS_WAIT(); asm volatile("" ::: "memory");
}
template <int ROWMAP, bool F8 = false>
__device__ __forceinline__ bool tr_matrix(int& r, const float* W, int K, int N, int ldw, int c0, void* dstv, int ldk, int drow0, LAS float* scr, int lane, const float* g = nullptr, const float wsc = 1.0f) {
    unsigned char* dst = (unsigned char*)dstv;
    const int nblk = N / 32, items = (K / 64) * nblk;
    if (r >= items) { r -= items; return false; }
    const int kb = r / nblk, nb = r % nblk, k0 = 64 * kb, n0 = 32 * nb;
    const int drow = ROWMAP == 0 ? drow0 + n0 : drow0 + (n0 >> 7) * 256 + ((n0 & 127) >> 5) * 64;
    tr_item<F8>(W + (size_t)k0 * ldw + c0 + n0, ldw, dst + ((size_t)drow * ldk + k0) * (F8 ? 1 : 2), ldk, scr, lane, g ? g + k0 : nullptr, wsc);
    return true;
}
__device__ __forceinline__ void prologue_phase(const Args& a, Frame& F) {
    LAS float* scr = (LAS float*)(F.lds + RING_OFF + F.wave * 16384);
    unsigned char* ws = a.ws;
    const int gw = F.bid * NWAVES + F.wave, NGW = F.G * NWAVES;
    constexpr int I_IN = 16 * 112, I_OUT = 16 * 32, I_DG = 16 * 86, I_DD = 43 * 32, I_MG = 16 * 112, I_MD = 56 * 32;
    constexpr int PER_LAYER_A = I_IN + I_OUT;
    constexpr int PER_DENSE = 2 * I_DG + I_DD;
    constexpr int PER_EXP = 2 * I_MG + I_MD;
    constexpr int NITEMS = 4 * PER_LAYER_A + 2 * PER_DENSE + 16 * PER_EXP;
    for (int it = gw; it < NITEMS; it += NGW) {
        int r = it;
        if (r < 4 * PER_LAYER_A) {
            const int l = r / PER_LAYER_A; r -= l * PER_LAYER_A;
            const float* W = a.w_in + (size_t)l * DM * PIN; bf16* D = (bf16*)(ws + WS_WIN) + (size_t)l * NPROJ * DM;
            if (r < 16 * 64) { (void)tr_matrix<0>(r, W, DM, 2048, PIN, 0, D, DM, 0, scr, F.lane, a.norm_mix_g + l * DM); continue; } r -= 16 * 64;
            if (r < 16 * 48) { (void)tr_matrix<0>(r, W, DM, 1536, PIN, 2056, D, DM, 2048, scr, F.lane, a.norm_mix_g + l * DM); continue; } r -= 16 * 48;
            (void)tr_matrix<0>(r, a.w_out + (size_t)l * DM * DM, DM, DM, DM, 0, (bf16*)(ws + WS_WOUT) + (size_t)l * DM * DM, DM, 0, scr, F.lane); continue;
        }
        r -= 4 * PER_LAYER_A;
        if (r < 2 * PER_DENSE) {
            const int j = r / PER_DENSE; r -= j * PER_DENSE;
            bf16* GU = (bf16*)(ws + WS_WGU) + (size_t)j * 2 * FFDP * DM;
            if (tr_matrix<1>(r, a.ffn_w_gate + (size_t)j * DM * FFD, DM, FFD, FFD, 0, GU, DM, 0, scr, F.lane, a.norm_ffn_g + (2 * j) * DM)) continue;
            if (tr_matrix<1>(r, a.ffn_w_up + (size_t)j * DM * FFD, DM, FFD, FFD, 0, GU, DM, 32, scr, F.lane, a.norm_ffn_g + (2 * j) * DM)) continue;
            (void)tr_matrix<0>(r, a.ffn_w_down + (size_t)j * FFD * DM, FFD, DM, DM, 0, (bf16*)(ws + WS_WD) + (size_t)j * DM * FFDP, FFDP, 0, scr, F.lane); continue;
        }
        r -= 2 * PER_DENSE;
        {
            const int je = r / PER_EXP; r -= je * PER_EXP;
            constexpr bool M8 = MOE_FP8 != 0; constexpr size_t MES = M8 ? 1 : 2;
            unsigned char* GU = ws + WS_MGU + (size_t)je * 2 * FFE * DM * MES;
            if (tr_matrix<1, M8>(r, a.moe_w_gate + (size_t)je * DM * FFE, DM, FFE, FFE, 0, GU, DM, 0, scr, F.lane, a.norm_ffn_g + (2 * (je >> 3) + 1) * DM, F8_WGU)) continue;
            if (tr_matrix<1, M8>(r, a.moe_w_up + (size_t)je * DM * FFE, DM, FFE, FFE, 0, GU, DM, 32, scr, F.lane, a.norm_ffn_g + (2 * (je >> 3) + 1) * DM, F8_WGU)) continue;
            (void)tr_matrix<0, M8>(r, a.moe_w_down + (size_t)je * FFE * DM, FFE, DM, DM, 0, ws + WS_MD + (size_t)je * DM * FFE * MES, FFE, 0, scr, F.lane, nullptr, F8_WD);
        }
    }
    const int gt = F.bid * NTHREADS + F.tid, NGT = F.G * NTHREADS;
    for (int i = gt; i < 2 * 128 * (DM / 8); i += NGT) {
        const int j = i / (128 * 128), rr = (i / 128) % 128, ch = i % 128;
        const int row = 21 * 256 + 128 + rr;
        *(GAS v4u*)((bf16*)(ws + WS_WGU) + ((size_t)j * 2 * FFDP + row) * DM + ch * 8) = (v4u){0u, 0u, 0u, 0u};
    }
    for (int i = gt; i < 2 * DM * 8; i += NGT) {
        const int j = i / (DM * 8), row = (i / 8) % DM, ch = i % 8;
        *(GAS v4u*)((bf16*)(ws + WS_WD) + ((size_t)j * DM + row) * FFDP + FFD + ch * 8) = (v4u){0u, 0u, 0u, 0u};
    }
}

struct NormIn { const float* src; const bf16* o2; float* hout; const float* gain; bf16* y; const float* w8; int ld8; float* G; unsigned* cnt; uint2* rinfo; int* cntw; int* rrec; const bf16* src16; bf16* hout16; float* rs; unsigned char* h8; };
template <bool B> struct RowSel { typedef f32x4 T; };
template <> struct RowSel<true> { typedef v2u T; };
template <int MODE, bool S16 = false>
__device__ __forceinline__ void norm_phase(Frame& F, const NormIn& p) {
    typedef typename RowSel<S16>::T RowT;
    LAS float* W8 = (LAS float*)(F.lds + RING_OFF);
    LAS int* lcnt = (LAS int*)(F.lds + RING_OFF + 32768);
    LAS int* lbase = lcnt + 8;
    LAS int* rec = lcnt + 16;
    f32x4 wr[(MODE == 0 || MODE == 2) ? 32 : 1];
    if (MODE == 0 || MODE == 2) {
        for (int i = F.tid; i < DM * 2; i += NTHREADS) *(LAS f32x4*)(W8 + 4 * i) = *(const GAS f32x4*)(p.w8 + (size_t)(i >> 1) * p.ld8 + 4 * (i & 1));
        __syncthreads();
#pragma unroll
        for (int j = 0; j < 4; ++j)
#pragma unroll
            for (int c = 0; c < 4; ++c) { const int k = 4 * (F.lane + 64 * j) + c; wr[(j * 4 + c) * 2] = *(const LAS f32x4*)(W8 + k * 8); wr[(j * 4 + c) * 2 + 1] = *(const LAS f32x4*)(W8 + k * 8 + 4); }
        __syncthreads();
    }
    for (int rb0 = F.bid; rb0 < T / 64; rb0 += F.G) {
        const int rb = (rb0 & 7) * 32 + (rb0 >> 3);
        RowT vn[4], vm[4]; v2u na[4], nb[4], ma[4], mb[4];
        const GAS RowT* const srcr = (S16 ? (const GAS RowT*)p.src16 : (const GAS RowT*)p.src) + F.lane;
        { const int row = rb * 64 + F.wave * 8; const GAS RowT* xr = srcr + (size_t)row * (DM / 4);
#pragma unroll
          for (int j = 0; j < 4; ++j) { vn[j] = xr[64 * j]; vm[j] = xr[64 * j + DM / 4]; }
          if (p.o2) { const GAS v2u* oa = (const GAS v2u*)(p.o2 + (size_t)row * DM) + F.lane; const GAS v2u* ob = (const GAS v2u*)(p.o2 + ((size_t)T + row) * DM) + F.lane;
#pragma unroll
              for (int j = 0; j < 4; ++j) { na[j] = oa[64 * j]; nb[j] = ob[64 * j]; ma[j] = oa[64 * j + DM / 4]; mb[j] = ob[64 * j + DM / 4]; } } }
#pragma unroll 1
        for (int i = 0; i < 8; ++i) {
            const int row = rb * 64 + F.wave * 8 + i;
            f32x4 v[4]; float s = 0.f;
#pragma unroll
            for (int j = 0; j < 4; ++j) { if constexpr (S16) { const v2u a = vn[j]; v[j] = (f32x4){bflo(a.x), bfhi(a.x), bflo(a.y), bfhi(a.y)}; } else v[j] = vn[j]; }
            if (p.o2) {
#pragma unroll
                for (int j = 0; j < 4; ++j) { const v2u a = na[j], b = nb[j];
                    v[j].x += bflo(a.x) + bflo(b.x); v[j].y += bfhi(a.x) + bfhi(b.x); v[j].z += bflo(a.y) + bflo(b.y); v[j].w += bfhi(a.y) + bfhi(b.y); }
            }
#pragma unroll
            for (int j = 0; j < 4; ++j) { vn[j] = vm[j]; na[j] = ma[j]; nb[j] = mb[j]; }
            if (i + 2 < 8) { const int rn = row + 2; const GAS RowT* xr = srcr + (size_t)rn * (DM / 4);
#pragma unroll
                for (int j = 0; j < 4; ++j) vm[j] = xr[64 * j];
                if (p.o2) { const GAS v2u* oa = (const GAS v2u*)(p.o2 + (size_t)rn * DM) + F.lane; const GAS v2u* ob = (const GAS v2u*)(p.o2 + ((size_t)T + rn) * DM) + F.lane;
#pragma unroll
                    for (int j = 0; j < 4; ++j) { ma[j] = oa[64 * j]; mb[j] = ob[64 * j]; } } }
            if (MODE != 3 && p.hout) { GAS f32x4* ho = (GAS f32x4*)(p.hout + (size_t)row * DM) + F.lane;
#pragma unroll
                for (int j = 0; j < 4; ++j) ho[64 * j] = v[j]; }
            if (MODE != 3 && p.hout16) { GAS v2u* ho = (GAS v2u*)(p.hout16 + (size_t)row * DM) + F.lane;
#pragma unroll
                for (int j = 0; j < 4; ++j) { const v2u w = (v2u){pk2(v[j].x, v[j].y), pk2(v[j].z, v[j].w)}; ho[64 * j] = w; v[j] = (f32x4){bflo(w.x), bfhi(w.x), bflo(w.y), bfhi(w.y)}; } }
#pragma unroll
            for (int j = 0; j < 4; ++j) s += (v[j].x * v[j].x + v[j].y * v[j].y) + (v[j].z * v[j].z + v[j].w * v[j].w);
            const float rstd = 1.0f / sqrtf(wave_sum(s) * (1.0f / DM) + EPS);
            const GAS f32x4* gr = (const GAS f32x4*)p.gain + F.lane;
            if (MODE == 2 && MOE_FP8) { GAS unsigned* h8r = (GAS unsigned*)(p.h8 + (size_t)row * DM) + F.lane;
#pragma unroll
                for (int j = 0; j < 4; ++j) { const f32x4 q = v[j] * rstd; h8r[64 * j] = pk4_f8(q.x, q.y, q.z, q.w); } }
#pragma unroll
            for (int j = 0; j < 4; ++j) { const f32x4 g = gr[64 * j]; v[j] = v[j] * rstd * g; }
            if (MODE == 3) { GAS f32x4* ho = (GAS f32x4*)(p.hout + (size_t)row * DM) + F.lane;
#pragma unroll
                for (int j = 0; j < 4; ++j) ho[64 * j] = v[j];
                continue; }
            if (F.lane == 0) ((GAS float*)p.rs)[row] = rstd;
            if (MODE == 0 || MODE == 2) {
                float d[8];
#pragma unroll
                for (int g = 0; g < 8; ++g) d[g] = 0.f;
#pragma unroll
                for (int j = 0; j < 4; ++j)
#pragma unroll
                    for (int c = 0; c < 4; ++c) { const f32x4 w0 = wr[(j * 4 + c) * 2], w1 = wr[(j * 4 + c) * 2 + 1];
                        const float yv = v[j][c];
                        d[0] += yv * w0.x; d[1] += yv * w0.y; d[2] += yv * w0.z; d[3] += yv * w0.w; d[4] += yv * w1.x; d[5] += yv * w1.y; d[6] += yv * w1.z; d[7] += yv * w1.w; }
#pragma unroll
                for (int g = 0; g < 8; ++g) d[g] = wave_sum(d[g]);
                if (MODE == 0) { if (F.lane == 0) { GAS f32x4* gp = (GAS f32x4*)(p.G + (size_t)row * 8); gp[0] = (f32x4){d[0], d[1], d[2], d[3]}; gp[1] = (f32x4){d[4], d[5], d[6], d[7]}; } }
                else {
                    int e0 = 0; float v0 = d[0];
#pragma unroll
                    for (int g = 1; g < 8; ++g) if (d[g] > v0) { v0 = d[g]; e0 = g; }
                    int e1 = -1; float v1 = -INFINITY;
#pragma unroll
                    for (int g = 0; g < 8; ++g) if (g != e0 && d[g] > v1) { v1 = d[g]; e1 = g; }
                    const float w0 = 1.0f / (1.0f + expf(v1 - v0)), w1 = 1.0f - w0;
                    if (F.lane == 0) { LAS int* rr = rec + (F.wave * 8 + i) * 6; rr[0] = e0; rr[1] = e1; rr[4] = __builtin_bit_cast(int, w0); rr[5] = __builtin_bit_cast(int, w1); }
                }
            }
        }
        if (MODE == 2) {
            __syncthreads();
            if (F.wave == 0) { const LAS int* rr = rec + F.lane * 6; const int e0 = rr[0], e1 = rr[1], row = rb * 64 + F.lane;
                const unsigned long long below = (1ull << F.lane) - 1ull;
                int lp0 = 0, lp1 = 0, mycnt = 0;
#pragma unroll
                for (int e = 0; e < 8; ++e) { const unsigned long long m0 = __ballot(e0 == e), m1 = __ballot(e1 == e);
                    const int lp = __popcll(m0 & below) + __popcll(m1 & below), ce = __popcll(m0) + __popcll(m1);
                    if (e0 == e) lp0 = lp; if (e1 == e) lp1 = lp; if (F.lane == e) mycnt = ce; }
                GAS int* ro = (GAS int*)p.rrec + (size_t)row * 6; ro[0] = e0; ro[1] = e1; ro[2] = lp0; ro[3] = lp1; ro[4] = rr[4]; ro[5] = rr[5];
                if (F.lane < 8) { ((GAS int*)p.cntw)[rb * 8 + F.lane] = mycnt; (void)__hip_atomic_fetch_add(p.cnt + F.lane, (unsigned)mycnt, __ATOMIC_RELAXED, __HIP_MEMORY_SCOPE_AGENT); } }
            __syncthreads();
        }
    }
}

__device__ __forceinline__ void route_finish(Frame& F, const int* cntw, const int* rrec, uint2* rinfo, const float* RS, float* RSI) {
    LAS float* lred = (LAS float*)(F.lds + RING_OFF);
    for (int rb0 = F.bid; rb0 < T / 64; rb0 += F.G) {
        const int rb = (rb0 & 7) * 32 + (rb0 >> 3);
        float c[8];
#pragma unroll
        for (int e = 0; e < 8; ++e) c[e] = 0.f;
        if (F.tid < rb) { const GAS i32x4* cp = (const GAS i32x4*)(cntw + F.tid * 8); const i32x4 a = cp[0], b = cp[1];
            c[0] = (float)a.x; c[1] = (float)a.y; c[2] = (float)a.z; c[3] = (float)a.w; c[4] = (float)b.x; c[5] = (float)b.y; c[6] = (float)b.z; c[7] = (float)b.w; }
#pragma unroll
        for (int e = 0; e < 8; ++e) c[e] = wave_sum(c[e]);
        if (F.lane == 0) {
#pragma unroll
            for (int e = 0; e < 8; ++e) lred[F.wave * 8 + e] = c[e]; }
        __syncthreads();
        if (F.tid < 64) { const int row = rb * 64 + F.tid; const GAS int* rr = (const GAS int*)rrec + (size_t)row * 6;
            const int e0 = rr[0], e1 = rr[1];
            float b0 = 0.f, b1 = 0.f;
#pragma unroll
            for (int w = 0; w < NWAVES; ++w) { b0 += lred[w * 8 + e0]; b1 += lred[w * 8 + e1]; }
            const int p0 = (int)b0 + rr[2], p1 = (int)b1 + rr[3];
            rinfo[(size_t)e0 * T + p0] = make_uint2((unsigned)row * 2u, (unsigned)rr[4]);
            rinfo[(size_t)e1 * T + p1] = make_uint2((unsigned)row * 2u + 1u, (unsigned)rr[5]);
            const float rsr = ((const GAS float*)RS)[row]; ((GAS float*)RSI)[(size_t)e0 * T + p0] = rsr; ((GAS float*)RSI)[(size_t)e1 * T + p1] = rsr; }
        __syncthreads();
    }
}

__device__ __forceinline__ float logsigmoid_f(float x) { return fminf(x, 0.f) - log1pf(expf(-fabsf(x))); }
__device__ __forceinline__ void gate_scan(Frame& F, int bh, const float* G, const float* b_i, const float* b_f, float* GA, float* GM, float* GE, float* TG) {
    LAS float* sc = (LAS float*)(F.lds + RING_OFF);
    const int b = bh >> 2, h = bh & 3, t0 = 4 * F.tid;
    const float bi = b_i[h], bf = b_f[h];
    float lf[4], ig[4];
#pragma unroll
    for (int j = 0; j < 4; ++j) { const float* g = G + ((size_t)b * SEQ + t0 + j) * 8; ig[j] = g[h] + bi; lf[j] = logsigmoid_f(g[4 + h] + bf); }
    float c[4]; c[0] = lf[0]; c[1] = c[0] + lf[1]; c[2] = c[1] + lf[2]; c[3] = c[2] + lf[3];
    float ws = c[3];
    DPP_SCAN(ws, OP_ADD, 0.0f);
    if (F.lane == 63) sc[F.wave] = ws;
    __syncthreads();
    float woff = 0.f;
    for (int w = 0; w < F.wave; ++w) woff += sc[w];
    const float excl = woff + ws - c[3];
    float Fc[4], av[4];
#pragma unroll
    for (int j = 0; j < 4; ++j) { Fc[j] = excl + c[j]; av[j] = ig[j] - Fc[j]; }
    float m[4]; m[0] = av[0]; m[1] = fmaxf(m[0], av[1]); m[2] = fmaxf(m[1], av[2]); m[3] = fmaxf(m[2], av[3]);
    float wm = m[3];
    DPP_SCAN(wm, OP_MAX, -INFINITY);
    if (F.lane == 63) sc[16 + F.wave] = wm;
    __syncthreads();
    float pm = -INFINITY;
    for (int w = 0; w < F.wave; ++w) pm = fmaxf(pm, sc[16 + w]);
    { float u = dpp_f(-INFINITY, wm, 0x111, 0xf);
      const float r15 = dpp_f(-INFINITY, wm, 0x142, 0xa), r31 = dpp_f(-INFINITY, wm, 0x143, 0xc);
      if ((F.lane & 15) == 0) u = (F.lane == 32) ? r31 : r15;
      pm = fmaxf(pm, u); }
    float tmx = m[3];
    tmx = fmaxf(tmx, dpp_f(-INFINITY, tmx, 0x111, 0xf)); tmx = fmaxf(tmx, dpp_f(-INFINITY, tmx, 0x112, 0xf)); tmx = fmaxf(tmx, dpp_f(-INFINITY, tmx, 0x114, 0xf)); tmx = fmaxf(tmx, dpp_f(-INFINITY, tmx, 0x118, 0xf));
    const int tbits = __builtin_bit_cast(int, tmx);
    const float t0m = __builtin_bit_cast(float, __builtin_amdgcn_readlane(tbits, 15)), t1m = __builtin_bit_cast(float, __builtin_amdgcn_readlane(tbits, 31)),
                t2m = __builtin_bit_cast(float, __builtin_amdgcn_readlane(tbits, 47)), t3m = __builtin_bit_cast(float, __builtin_amdgcn_readlane(tbits, 63));
    const int rw = F.lane >> 4; const float tm = rw == 0 ? t0m : (rw == 1 ? t1m : (rw == 2 ? t2m : t3m));
    if ((F.lane & 15) == 0) TG[bh * 32 + F.wave * 4 + rw] = tm * LOG2E;
#pragma unroll
    for (int j = 0; j < 4; ++j) { const float Mt = fmaxf(pm, m[j]); const size_t o = (size_t)bh * SEQ + t0 + j;
        GA[o] = expf(av[j] - tm); GM[o] = Mt * LOG2E; GE[o] = expf(-(Fc[j] + Mt)); }
    __syncthreads();
}

__device__ __forceinline__ void unpack8(const v4u r, float (&d)[8]) { d[0] = bflo(r.x); d[1] = bfhi(r.x); d[2] = bflo(r.y); d[3] = bfhi(r.y); d[4] = bflo(r.z); d[5] = bfhi(r.z); d[6] = bflo(r.w); d[7] = bfhi(r.w); }
__device__ __forceinline__ void conv_phase(Frame& F, const bf16* proj, const float* cw, const float* cb, bf16* qkc, const int hidx, const int nh) {
    const int cbat = F.bid & 7;
    for (int wi = F.wave * nh + hidx; wi < 144; wi += NWAVES * nh) {
        const int kpart = wi >= 128 ? 1 : 0;
        const int seg = cbat * 128 + (kpart ? 112 + (wi - 128) : wi);
        const int t0 = seg * 16, c0 = kpart * 512 + F.lane * 8;
        float w[4][8], bb[8];
#pragma unroll
        for (int tap = 0; tap < 4; ++tap) { const f32x4 a = *(const GAS f32x4*)(cw + tap * 1024 + c0), b = *(const GAS f32x4*)(cw + tap * 1024 + c0 + 4);
            w[tap][0] = a.x; w[tap][1] = a.y; w[tap][2] = a.z; w[tap][3] = a.w; w[tap][4] = b.x; w[tap][5] = b.y; w[tap][6] = b.z; w[tap][7] = b.w; }
        { const f32x4 a = *(const GAS f32x4*)(cb + c0), b = *(const GAS f32x4*)(cb + c0 + 4); bb[0] = a.x; bb[1] = a.y; bb[2] = a.z; bb[3] = a.w; bb[4] = b.x; bb[5] = b.y; bb[6] = b.z; bb[7] = b.w; }
        const float osc = kpart ? KM_SCALE : 1.0f;
        const bool first = (t0 % SEQ) == 0;
        v4u rw[19];
#pragma unroll
        for (int q = 0; q < 3; ++q) { rw[q] = (v4u){0u, 0u, 0u, 0u}; if (!first) rw[q] = *(const GAS v4u*)(proj + (size_t)(t0 - 3 + q) * NPROJ + c0); }
#pragma unroll
        for (int q = 0; q < 16; ++q) rw[3 + q] = *(const GAS v4u*)(proj + (size_t)(t0 + q) * NPROJ + c0);
        float x0[8], x1[8], x2[8];
        unpack8(rw[0], x0); unpack8(rw[1], x1); unpack8(rw[2], x2);
#pragma unroll
        for (int i = 0; i < 16; ++i) {
            float x3[8]; unpack8(rw[3 + i], x3);
            float o[8];
#pragma unroll
            for (int c = 0; c < 8; ++c) { const float yv = bb[c] + x0[c] * w[0][c] + x1[c] * w[1][c] + x2[c] * w[2][c] + x3[c] * w[3][c];
                o[c] = osc * yv * __builtin_amdgcn_rcpf(1.0f + __builtin_amdgcn_exp2f(-yv * LOG2E)); x0[c] = x1[c]; x1[c] = x2[c]; x2[c] = x3[c]; }
            *(GAS v4u*)(qkc + (size_t)(t0 + i) * DM + c0) = (v4u){pk2(o[0], o[1]), pk2(o[2], o[3]), pk2(o[4], o[5]), pk2(o[6], o[7])};
        }
    }
}

__device__ __forceinline__ void naive_sb(Frame& F, const bf16* proj, const float* g_sb, bf16* mixed) {
    LAS float* qs = (LAS float*)(F.lds + RING_OFF) + F.wave * 256;
    LAS float* ps = qs + 64;
    for (int it = F.bid * NWAVES + F.wave; it < T * HS; it += F.G * NWAVES) {
        const int h = it & 7, row = it >> 3, t = row % SEQ, rb = row - t;
        qs[F.lane] = bf2f(proj[(size_t)row * NPROJ + 2048 + h * 64 + F.lane]);
        LDS_WAIT();
        float R = 1.0f, o = 0.f;
        const int nch = (t + 63) / 64;
        for (int c = nch - 1; c >= 0; --c) {
            const int s = 64 * c + F.lane; const bool valid = s < t;
            const bf16* kr = proj + (size_t)(rb + s) * NPROJ + 2560 + h * 64;
            float z = 0.f;
#pragma unroll
            for (int d8 = 0; d8 < 8; ++d8) { const v4u kk = *(const GAS v4u*)(kr + d8 * 8); const f32x4 qa = *(const LAS f32x4*)(qs + d8 * 8), qb = *(const LAS f32x4*)(qs + d8 * 8 + 4);
                z += qa.x * bflo(kk.x) + qa.y * bfhi(kk.x) + qa.z * bflo(kk.y) + qa.w * bfhi(kk.y) + qb.x * bflo(kk.z) + qb.y * bfhi(kk.z) + qb.z * bflo(kk.w) + qb.w * bfhi(kk.w); }
            const float e = exp2f(-z); float beta = 1.0f / (1.0f + e); float omb = 1.0f - beta;
            if (!valid) { beta = 0.f; omb = 1.0f; }
            float pr = omb;
#pragma unroll
            for (int off = 1; off < 64; off <<= 1) { const float u = __shfl_down(pr, off); if (F.lane + off < 64) pr *= u; }
            float ex = __shfl_down(pr, 1); if (F.lane == 63) ex = 1.0f;
            const float a = beta * ex * R;
            R *= __shfl(pr, 0);
            ps[F.lane] = a; LDS_WAIT();
            const bf16* vr = proj + (size_t)(rb + 64 * c) * NPROJ + 3072 + h * 64 + F.lane;
#pragma unroll 8
            for (int j = 0; j < 64; ++j) o += ps[j] * bf2f(vr[(size_t)j * NPROJ]);
            LDS_WAIT();
        }
        const float ss = wave_sum(o * o) * (1.0f / 64.0f);
        const float val = o * (1.0f / sqrtf(ss + EPS)) * g_sb[h * 64 + F.lane];
        mixed[(size_t)row * DM + 512 + h * 64 + F.lane] = (bf16)f2bf(val);
    }
}
__device__ __forceinline__ void naive_mlstm(Frame& F, const bf16* proj, const bf16* qkc, const float* GA, const float* GM, const float* GE, const float* g_m, bf16* mixed) {
    LAS float* qs = (LAS float*)(F.lds + RING_OFF) + F.wave * 256;
    LAS float* ps = qs + 128;
    for (int it = F.bid * NWAVES + F.wave; it < T * HM; it += F.G * NWAVES) {
        const int h = it & 3, row = it >> 2, t = row % SEQ, rb = row - t, b = row / SEQ, bh = b * 4 + h;
        qs[F.lane] = bf2f(qkc[(size_t)row * DM + h * 128 + F.lane]); qs[64 + F.lane] = bf2f(qkc[(size_t)row * DM + h * 128 + 64 + F.lane]);
        LDS_WAIT();
        const float Mt = GM[(size_t)bh * SEQ + t];
        float den = 0.f, o0 = 0.f, o1 = 0.f;
        const int nch = t / 64 + 1;
        for (int c = 0; c < nch; ++c) {
            const int s = 64 * c + F.lane; const bool valid = s <= t;
            const bf16* kr = qkc + (size_t)(rb + s) * DM + 512 + h * 128;
            float z = 0.f;
#pragma unroll
            for (int d8 = 0; d8 < 16; ++d8) { const v4u kk = *(const GAS v4u*)(kr + d8 * 8); const f32x4 qa = *(const LAS f32x4*)(qs + d8 * 8), qb = *(const LAS f32x4*)(qs + d8 * 8 + 4);
                z += qa.x * bflo(kk.x) + qa.y * bfhi(kk.x) + qa.z * bflo(kk.y) + qa.w * bfhi(kk.y) + qb.x * bflo(kk.z) + qb.y * bfhi(kk.z) + qb.z * bflo(kk.w) + qb.w * bfhi(kk.w); }
            const float wgt = valid ? exp2f(GA[(size_t)bh * SEQ + s] - Mt) : 0.f;
            const float pv = z * wgt;
            den += pv;
            ps[F.lane] = pv; LDS_WAIT();
            const bf16* vr = proj + (size_t)(rb + 64 * c) * NPROJ + 1024 + h * 128 + F.lane;
#pragma unroll 8
            for (int j = 0; j < 64; ++j) { const float pj = ps[j]; o0 += pj * bf2f(vr[(size_t)j * NPROJ]); o1 += pj * bf2f(vr[(size_t)j * NPROJ + 64]); }
            LDS_WAIT();
        }
        den = wave_sum(den);
        const float dn = fmaxf(fabsf(den), GE[(size_t)bh * SEQ + t]);
        const float h0 = o0 / dn, h1 = o1 / dn;
        const float ss = wave_sum(h0 * h0 + h1 * h1) * (1.0f / 128.0f);
        const float rs = 1.0f / sqrtf(ss + EPS);
        const float om0 = bf2f(proj[(size_t)row * NPROJ + 1536 + h * 128 + F.lane]), om1 = bf2f(proj[(size_t)row * NPROJ + 1536 + h * 128 + 64 + F.lane]);
        const float r0 = h0 * rs * g_m[h * 128 + F.lane] / (1.0f + expf(-om0)), r1 = h1 * rs * g_m[h * 128 + 64 + F.lane] / (1.0f + expf(-om1));
        mixed[(size_t)row * DM + h * 128 + F.lane] = (bf16)f2bf(r0); mixed[(size_t)row * DM + h * 128 + 64 + F.lane] = (bf16)f2bf(r1);
    }
}

namespace mix {
typedef float f32x16 __attribute__((ext_vector_type(16)));
typedef short s16x4 __attribute__((ext_vector_type(4)));
typedef short v4i16_t __attribute__((ext_vector_type(4)));
typedef unsigned u32x4 __attribute__((ext_vector_type(4)));
typedef LAS const unsigned char* lptr;
#define MX_MFMA(a, b, c) __builtin_amdgcn_mfma_f32_32x32x16_bf16(a, b, c, 0, 0, 0)
__device__ __forceinline__ int crow(int r, int hi) { return (r & 3) + 8 * (r >> 2) + 4 * hi; }
__device__ __forceinline__ unsigned cvtpk(float lo, float hi) { unsigned r; asm("v_cvt_pk_bf16_f32 %0, %1, %2" : "=v"(r) : "v"(lo), "v"(hi)); return r; }
__device__ __forceinline__ s16x4 vtr(lptr p) { return __builtin_bit_cast(s16x4, __builtin_amdgcn_ds_read_tr16_b64_v4i16((LAS v4i16_t*)p)); }
__device__ __forceinline__ float partner(float x, int hi) { auto rr = __builtin_amdgcn_permlane32_swap(__builtin_bit_cast(unsigned, x), __builtin_bit_cast(unsigned, x), false, false);
    return __builtin_bit_cast(float, hi ? rr[0] : rr[1]); }

constexpr int STG_BYTES = 65536, GRP_BYTES = 32768, VIMG_OFF = 16384;
constexpr int EX_OFF = RING_BYTES + 1024;
constexpr int EX_GA = EX_OFF, EX_FA = EX_OFF + 1024, EX_FB = EX_OFF + 1536;

__device__ __forceinline__ void glds16(const void* g, unsigned lds_base) {
    unsigned sv; asm volatile("s_mov_b32 %0, m0\n\ts_mov_b32 m0, %2\n\ts_nop 0\n\tglobal_load_lds_dwordx4 %1, off\n\ts_mov_b32 m0, %0" : "=&s"(sv) : "v"(g), "s"(lds_base) : "memory"); }
__device__ __forceinline__ void glds4(const void* g, unsigned lds_base) {
    unsigned sv; asm volatile("s_mov_b32 %0, m0\n\ts_mov_b32 m0, %2\n\ts_nop 0\n\tglobal_load_lds_dword %1, off\n\ts_mov_b32 m0, %0" : "=&s"(sv) : "v"(g), "s"(lds_base) : "memory"); }
template <int D, bool ML>
__device__ __forceinline__ void issue_tile(unsigned gbase, unsigned gaimg, const bf16* Kp, int pk, const bf16* Vp, int pv, const float* ga, int s0, int w4, int lane) {
#pragma unroll
    for (int c = 0; c < D / 32; ++c) { const int ch = w4 + 4 * c;
        glds16(Kp + (size_t)(s0 + lane) * pk + 8 * ch, (unsigned)__builtin_amdgcn_readfirstlane(gbase + ch * 1024)); }
#pragma unroll
    for (int c = 0; c < D / 32; ++c) { const int idx = w4 + 4 * c, dp = idx >> 2, rg = idx & 3;
        glds16(Vp + (size_t)(s0 + 16 * rg + (lane >> 2)) * pv + 32 * dp + 8 * (lane & 3), (unsigned)__builtin_amdgcn_readfirstlane(gbase + VIMG_OFF + dp * 4096 + rg * 1024)); }
    if (ML) { if (w4 == 0) glds4(ga + s0 + lane, (unsigned)__builtin_amdgcn_readfirstlane(gaimg)); }
}

template <int D, bool SBK, bool MASK>
__device__ __forceinline__ void compute_tile(lptr kimg, lptr vimg, LAS const float* gat, const bf16x8 (&qr)[D / 16], f32x16 (&o)[D / 32], float& st, const float Mt, const int qrow, const int key0, const int lane) {
    const int r32 = lane & 31, hi = lane >> 5;
    f32x16 p0 = {}, p1 = {};
    const lptr kp = kimg + hi * 1024 + r32 * 16;
    {
        bf16x8 kf[D / 8];
#pragma unroll
        for (int d0 = 0; d0 < D / 16; ++d0) { kf[2 * d0] = *(LAS const bf16x8*)(kp + d0 * 2048); kf[2 * d0 + 1] = *(LAS const bf16x8*)(kp + d0 * 2048 + 512); }
        __builtin_amdgcn_sched_barrier(0);
#pragma unroll
        for (int d0 = 0; d0 < D / 16; ++d0) { p0 = MX_MFMA(kf[2 * d0], qr[d0], p0); p1 = MX_MFMA(kf[2 * d0 + 1], qr[d0], p1); }
    }
    const lptr vp = vimg + ((lane >> 4) & 1) * 32 + (lane & 3) * 8 + (4 * hi + ((lane & 15) >> 2)) * 64;
    s16x4 vlo[D / 8], vhi[D / 8];
#pragma unroll
    for (int dp = 0; dp < D / 32; ++dp)
#pragma unroll
        for (int ks = 0; ks < 4; ++ks) { vlo[dp * 4 + ks] = vtr(vp + dp * 4096 + ks * 1024); vhi[dp * 4 + ks] = vtr(vp + dp * 4096 + ks * 1024 + 512); }
    __builtin_amdgcn_sched_barrier(0);
    u32x4 pw[4];
    if constexpr (SBK) {
        float R = st;
#pragma unroll
        for (int blk = 1; blk >= 0; --blk) {
            const f32x16& X = blk ? p1 : p0; const int kb = key0 + 32 * blk;
            float bt[16], sx[16], Pg[4], Qg[4];
#pragma unroll
            for (int g = 0; g < 4; ++g) { float run = 1.f;
#pragma unroll
                for (int i = 3; i >= 0; --i) { const int r = 4 * g + i; float z = X[r]; if (MASK) z = (kb + crow(r, hi) < qrow) ? z : -INFINITY;
                    const float e = __builtin_amdgcn_exp2f(-z); const float b = __builtin_amdgcn_rcpf(1.0f + e); bt[r] = b; sx[r] = run; run *= (1.0f - b); }
                Pg[g] = run; }
#pragma unroll
            for (int g = 0; g < 4; ++g) Qg[g] = partner(Pg[g], hi);
            float a[16];
#pragma unroll
            for (int g = 3; g >= 0; --g) { const float pre = R * (hi ? 1.0f : Qg[g]);
#pragma unroll
                for (int i = 0; i < 4; ++i) a[4 * g + i] = bt[4 * g + i] * sx[4 * g + i] * pre;
                R *= Pg[g] * Qg[g]; }
            pw[2 * blk] = (u32x4){cvtpk(a[0], a[1]), cvtpk(a[2], a[3]), cvtpk(a[4], a[5]), cvtpk(a[6], a[7])};
            pw[2 * blk + 1] = (u32x4){cvtpk(a[8], a[9]), cvtpk(a[10], a[11]), cvtpk(a[12], a[13]), cvtpk(a[14], a[15])};
        }
        st = R;
    } else {
        float den = st;
#pragma unroll
        for (int blk = 0; blk < 2; ++blk) {
            const f32x16& X = blk ? p1 : p0; const int kb = key0 + 32 * blk;
            float a[16];
#pragma unroll
            for (int g = 0; g < 4; ++g) { const f32x4 gv = *(LAS const f32x4*)(gat + 32 * blk + 8 * g + 4 * hi);
#pragma unroll
                for (int i = 0; i < 4; ++i) { const int r = 4 * g + i; float p = X[r] * __builtin_amdgcn_exp2f(gv[i] - Mt); if (MASK) p = (kb + crow(r, hi) <= qrow) ? p : 0.f; den += p; a[r] = p; } }
            pw[2 * blk] = (u32x4){cvtpk(a[0], a[1]), cvtpk(a[2], a[3]), cvtpk(a[4], a[5]), cvtpk(a[6], a[7])};
            pw[2 * blk + 1] = (u32x4){cvtpk(a[8], a[9]), cvtpk(a[10], a[11]), cvtpk(a[12], a[13]), cvtpk(a[14], a[15])};
        }
        st = den;
    }
    __builtin_amdgcn_sched_barrier(0);
#pragma unroll
    for (int dp = 0; dp < D / 32; ++dp)
#pragma unroll
        for (int ks = 0; ks < 4; ++ks) { const s16x4 a = vlo[dp * 4 + ks], b = vhi[dp * 4 + ks];
            const bf16x8 vf = (bf16x8){a[0], a[1], a[2], a[3], b[0], b[1], b[2], b[3]};
            o[dp] = MX_MFMA(__builtin_bit_cast(bf16x8, pw[ks]), vf, o[dp]); }
}

template <int D, bool SBK>
__device__ __forceinline__ void attn_unit(LAS unsigned char* lds, const int tid_in, const bf16* Qp, int pq, const bf16* Kp, int pk, const bf16* Vp, int pv,
                                          const float* ga, const float* gm, const float* ge, const int qb, bf16* out, const float* gain, const bf16* om) {
    int tid = tid_in; asm volatile("" : "+v"(tid));
    const int lane = tid & 63, wid = __builtin_amdgcn_readfirstlane(tid >> 6), grp = wid >> 2, w4 = wid & 3, r32 = lane & 31, hi = lane >> 5;
    const int t0 = 128 * qb, ns = qb + 1, nt = 2 * ns;
    const int qrow = t0 + 32 * w4 + r32;
    bf16x8 qr[D / 16];
#pragma unroll
    for (int d0 = 0; d0 < D / 16; ++d0) qr[d0] = *(const GAS bf16x8*)(Qp + (size_t)qrow * pq + d0 * 16 + hi * 8);
    float Mt = 0.f; if (!SBK) Mt = gm[qrow];
    f32x16 o[D / 32];
#pragma unroll
    for (int i = 0; i < D / 32; ++i) o[i] = f32x16{};
    float st = SBK ? 1.0f : 0.0f;
    LAS unsigned char* const gb0 = lds + grp * GRP_BYTES; LAS unsigned char* const ga0 = lds + EX_GA + grp * 256;
    const unsigned gb0u = (unsigned)(size_t)gb0, ga0u = (unsigned)(size_t)ga0;
    const int tfirst = grp ? ns - 1 : nt - 1;
    issue_tile<D, !SBK>(gb0u, ga0u, Kp, pk, Vp, pv, ga, 64 * tfirst, w4, lane);
#pragma unroll
    for (int d0 = 0; d0 < D / 16; ++d0) asm volatile("" : "+v"(qr[d0]));
    asm volatile("" : "+v"(Mt));
    for (int i = 0; i < ns; ++i) {
        const int tl = tfirst - i, sb = (i & 1);
        asm volatile("s_waitcnt vmcnt(0)" ::: "memory");
        __builtin_amdgcn_s_barrier();
        asm volatile("" ::: "memory");
        if (i + 1 < ns) issue_tile<D, !SBK>(gb0u + (sb ^ 1) * STG_BYTES, ga0u + (sb ^ 1) * 512, Kp, pk, Vp, pv, ga, 64 * (tl - 1), w4, lane);
        const lptr kimg = (lptr)(gb0 + sb * STG_BYTES); LAS const float* gat = (LAS const float*)(ga0 + sb * 512);
        if (tl >= nt - 2) compute_tile<D, SBK, true>(kimg, kimg + VIMG_OFF, gat, qr, o, st, Mt, qrow, 64 * tl, lane);
        else compute_tile<D, SBK, false>(kimg, kimg + VIMG_OFF, gat, qr, o, st, Mt, qrow, 64 * tl, lane);
    }
    constexpr int PITCH = D + 4;
    LAS float* stg = (LAS float*)lds; LAS float* fA = (LAS float*)(lds + EX_FA); LAS float* fB = (LAS float*)(lds + EX_FB);
    if (!SBK) st += partner(st, hi);
    LDS_WAIT(); __builtin_amdgcn_s_barrier(); asm volatile("" ::: "memory");
    if (grp == 1) {
#pragma unroll
        for (int dp = 0; dp < D / 32; ++dp)
#pragma unroll
            for (int r = 0; r < 16; ++r) stg[(32 * w4 + crow(r, hi)) * PITCH + 32 * dp + r32] = o[dp][r];
        if (hi == 0) fB[32 * w4 + r32] = st;
    } else { if (hi == 0) fA[32 * w4 + r32] = st; }
    LDS_WAIT(); __builtin_amdgcn_s_barrier(); asm volatile("" ::: "memory");
    if (grp == 0) {
#pragma unroll
        for (int r = 0; r < 16; ++r) { const int row = 32 * w4 + crow(r, hi); const float f = SBK ? fA[row] : 1.0f;
#pragma unroll
            for (int dp = 0; dp < D / 32; ++dp) { LAS float* p = stg + row * PITCH + 32 * dp + r32; *p = o[dp][r] + f * (*p); } }
    }
    LDS_WAIT(); __builtin_amdgcn_s_barrier(); asm volatile("" ::: "memory");
    {
        constexpr int NC = D / 4;
        const int row = tid >> 2, qd = tid & 3, trow = t0 + row;
        float v[NC];
#pragma unroll
        for (int c = 0; c < NC / 4; ++c) { const f32x4 x = *(LAS const f32x4*)(stg + row * PITCH + qd * NC + 4 * c); v[4 * c] = x.x; v[4 * c + 1] = x.y; v[4 * c + 2] = x.z; v[4 * c + 3] = x.w; }
        if (!SBK) { const float den = fA[row] + fB[row]; const float inv = 1.0f / fmaxf(fabsf(den), ge[trow]);
#pragma unroll
            for (int c = 0; c < NC; ++c) v[c] *= inv; }
        float ss = 0.f;
#pragma unroll
        for (int c = 0; c < NC; ++c) ss += v[c] * v[c];
        ss += __shfl_xor(ss, 1); ss += __shfl_xor(ss, 2);
        const float rs = 1.0f / sqrtf(ss * (1.0f / D) + EPS);
        bf16* op = out + (size_t)trow * DM + qd * NC;
#pragma unroll
        for (int c8 = 0; c8 < NC / 8; ++c8) {
            float w[8];
#pragma unroll
            for (int c = 0; c < 8; ++c) w[c] = v[8 * c8 + c] * rs * gain[qd * NC + 8 * c8 + c];
            if (!SBK) { const v4u g = *(const GAS v4u*)(om + (size_t)trow * NPROJ + qd * NC + 8 * c8); float gg[8];
                gg[0] = bflo(g.x); gg[1] = bfhi(g.x); gg[2] = bflo(g.y); gg[3] = bfhi(g.y); gg[4] = bflo(g.z); gg[5] = bfhi(g.z); gg[6] = bflo(g.w); gg[7] = bfhi(g.w);
#pragma unroll
                for (int c = 0; c < 8; ++c) w[c] *= 1.0f / (1.0f + __expf(-gg[c])); }
            *(GAS v4u*)(op + 8 * c8) = (v4u){pk2(w[0], w[1]), pk2(w[2], w[3]), pk2(w[4], w[5]), pk2(w[6], w[7])};
        }
    }
    LDS_WAIT(); __builtin_amdgcn_s_barrier(); asm volatile("" ::: "memory");
}
#undef MX_MFMA
}

typedef unsigned cs_u32x2 __attribute__((ext_vector_type(2)));
constexpr int CS_PART = 4160, CS_IMG = 4 * CS_PART, CS_NV = 8 * CS_IMG;
static_assert(CS_NV + 16384 <= MISC_OFF, "chunk-state LDS map");
__device__ __forceinline__ void chunk_state_unit(Frame& F, const int bh, const int j, const bf16* proj, const float* cw, const float* cb, const float* GAw, const float* TG,
                                                 bf16* U, float* NV, float* CM, bf16* qkc) {
    using mix::f32x16; using mix::s16x4; using mix::vtr; using mix::lptr; using mix::cvtpk;
    const int b = bh >> 2, h = bh & 3, tid = F.tid, lane = F.lane, wid = F.wave;
    const size_t r0 = (size_t)b * SEQ;
    const int cg = tid & 15, kg = tid >> 4, c0 = 8 * cg, tl = kg >> 3;
    const int s0 = 256 * j + 8 * kg;
    LAS unsigned char* const img = F.lds + RING_OFF;
    const bf16* kp = proj + (r0 + s0) * NPROJ + 512 + h * 128 + c0;
    const bf16* vp = proj + (r0 + s0) * NPROJ + 1024 + h * 128 + c0;
    v4u kr[11], vr[8];
#pragma unroll
    for (int q = 0; q < 3; ++q) { kr[q] = (v4u){0u, 0u, 0u, 0u}; if (s0 > 0) kr[q] = *(const GAS v4u*)(kp + (ptrdiff_t)(q - 3) * NPROJ); }
#pragma unroll
    for (int q = 0; q < 8; ++q) { kr[3 + q] = *(const GAS v4u*)(kp + (size_t)q * NPROJ); vr[q] = *(const GAS v4u*)(vp + (size_t)q * NPROJ); }
    const f32x4 ga0 = *(const GAS f32x4*)(GAw + (size_t)bh * SEQ + s0), ga1 = *(const GAS f32x4*)(GAw + (size_t)bh * SEQ + s0 + 4);
    const float t0g = TG[bh * 32 + 4 * j], t1g = TG[bh * 32 + 4 * j + 1], t2g = TG[bh * 32 + 4 * j + 2], t3g = TG[bh * 32 + 4 * j + 3];
    const float cm = fmaxf(fmaxf(t0g, t1g), fmaxf(t2g, t3g));
    const float tf = __builtin_amdgcn_exp2f((tl == 0 ? t0g : (tl == 1 ? t1g : (tl == 2 ? t2g : t3g))) - cm);
    float w[4][8], bb[8];
#pragma unroll
    for (int tap = 0; tap < 4; ++tap) { const f32x4 x = *(const GAS f32x4*)(cw + tap * 1024 + 512 + h * 128 + c0), y = *(const GAS f32x4*)(cw + tap * 1024 + 512 + h * 128 + c0 + 4);
        w[tap][0] = x.x; w[tap][1] = x.y; w[tap][2] = x.z; w[tap][3] = x.w; w[tap][4] = y.x; w[tap][5] = y.y; w[tap][6] = y.z; w[tap][7] = y.w; }
    { const f32x4 x = *(const GAS f32x4*)(cb + 512 + h * 128 + c0), y = *(const GAS f32x4*)(cb + 512 + h * 128 + c0 + 4); bb[0] = x.x; bb[1] = x.y; bb[2] = x.z; bb[3] = x.w; bb[4] = y.x; bb[5] = y.y; bb[6] = y.z; bb[7] = y.w; }
    {
        float nvp[8];
#pragma unroll
        for (int c = 0; c < 8; ++c) nvp[c] = 0.f;
        float x0[8], x1[8], x2[8];
        unpack8(kr[0], x0); unpack8(kr[1], x1); unpack8(kr[2], x2);
        LAS unsigned char* const wp = img + tl * (2 * CS_IMG) + (cg >> 2) * CS_PART + (8 * (kg & 7)) * 64 + (cg & 3) * 16;
#pragma unroll
        for (int i = 0; i < 8; ++i) {
            float x3[8], o[8], xv[8]; unpack8(kr[3 + i], x3); unpack8(vr[i], xv);
            const float ws_ = (i < 4 ? ga0[i & 3] : ga1[i & 3]) * tf;
#pragma unroll
            for (int c = 0; c < 8; ++c) { const float yv = bb[c] + x0[c] * w[0][c] + x1[c] * w[1][c] + x2[c] * w[2][c] + x3[c] * w[3][c];
                o[c] = KM_SCALE * yv * __builtin_amdgcn_rcpf(1.0f + __builtin_amdgcn_exp2f(-yv * LOG2E)); nvp[c] += ws_ * o[c]; x0[c] = x1[c]; x1[c] = x2[c]; x2[c] = x3[c]; }
            const v4u kcv = (v4u){pk2(o[0], o[1]), pk2(o[2], o[3]), pk2(o[4], o[5]), pk2(o[6], o[7])};
            *(LAS v4u*)(wp + i * 64) = kcv;
            *(GAS v4u*)(qkc + (r0 + s0 + i) * DM + 512 + h * 128 + c0) = kcv;
            *(LAS v4u*)(wp + CS_IMG + i * 64) = (v4u){pk2(xv[0] * ws_, xv[1] * ws_), pk2(xv[2] * ws_, xv[3] * ws_), pk2(xv[4] * ws_, xv[5] * ws_), pk2(xv[6] * ws_, xv[7] * ws_)};
        }
        LAS float* np = (LAS float*)(img + CS_NV) + kg * 128 + c0;
        *(LAS f32x4*)np = (f32x4){nvp[0], nvp[1], nvp[2], nvp[3]}; *(LAS f32x4*)(np + 4) = (f32x4){nvp[4], nvp[5], nvp[6], nvp[7]};
    }
    LDS_WAIT(); __syncthreads();
    if (tid < 128) { const LAS float* np = (const LAS float*)(img + CS_NV) + tid; float nv = 0.f;
#pragma unroll
        for (int g = 0; g < 32; ++g) nv += np[g * 128];
        NV[((size_t)bh * 7 + j) * 128 + tid] = nv; }
    if (tid == 0) { CM[bh * 8 + j] = cm; if (j == 6) CM[bh * 8 + 7] = cm; }
    {
        const int hi = lane >> 5, r32 = lane & 31;
        const lptr fb = (lptr)img + ((lane >> 4) & 1) * 32 + (lane & 3) * 8 + (4 * hi + ((lane & 15) >> 2)) * 64;
        unsigned short* Uj = (unsigned short*)U + ((size_t)bh * 7 + j) * 16384;
#pragma unroll
        for (int q = 0; q < 2; ++q) { const int idx = 2 * wid + q, dpd = idx >> 2, dpe = idx & 3;
            f32x16 acc = {};
#pragma unroll
            for (int t = 0; t < 4; ++t)
#pragma unroll
                for (int ks = 0; ks < 4; ++ks) { const lptr tb = fb + t * (2 * CS_IMG) + ks * 1024;
                    const s16x4 a0 = vtr(tb + CS_IMG + dpe * CS_PART), a1 = vtr(tb + CS_IMG + dpe * CS_PART + 512), b0 = vtr(tb + dpd * CS_PART), b1 = vtr(tb + dpd * CS_PART + 512);
                    acc = __builtin_amdgcn_mfma_f32_32x32x16_bf16(((bf16x8){a0[0], a0[1], a0[2], a0[3], a1[0], a1[1], a1[2], a1[3]}), ((bf16x8){b0[0], b0[1], b0[2], b0[3], b1[0], b1[1], b1[2], b1[3]}), acc, 0, 0, 0); }
#pragma unroll
            for (int g = 0; g < 4; ++g) *(GAS cs_u32x2*)(Uj + (size_t)(32 * dpd + r32) * 128 + 32 * dpe + 8 * g + 4 * hi) = (cs_u32x2){pk2(acc[4 * g], acc[4 * g + 1]), pk2(acc[4 * g + 2], acc[4 * g + 3])};
        }
    }
    LDS_WAIT(); __syncthreads();
}

typedef const __attribute__((address_space(4))) Args* KArgs;
#define KA(field) ({ KArgs _p = kap; asm volatile("" : "+s"(_p)); _p->field; })
#define WSP(off) ((unsigned char*)KA(ws) + (off))
namespace mix2 {
using mix::f32x16; using mix::s16x4; using mix::u32x4; using mix::lptr; using mix::crow; using mix::cvtpk; using mix::vtr; using mix::partner; using mix::glds16; using mix::glds4;
#define MX_MFMA(a, b, c) __builtin_amdgcn_mfma_f32_32x32x16_bf16(a, b, c, 0, 0, 0)
constexpr int NKB = 3, NVB = 4;
constexpr int KBUF0 = 0, VBUF0 = NKB * 16384, BUFSZ = 16384, STAGE0 = (NKB + NVB) * 16384, STAGE_W = 4608;
constexpr int EX_GA = STAGE0 + 8 * STAGE_W;
constexpr int EX_DEAD = EX_GA + NVB * 256;
static_assert(EX_DEAD + 64 <= MISC_OFF, "mixer LDS map");
struct UnitP { int b, h, qb, layer; };
template <bool SBK> struct LoopPtrs { const bf16* Kp; const bf16* Vp; const float* ga; int pk, pv; };
template <bool SBK> __device__ __forceinline__ LoopPtrs<SBK> loop_ptrs(KArgs kap, const UnitP& u) {
    LoopPtrs<SBK> p; const size_t r0 = (size_t)u.b * SEQ; const bf16* proj = (const bf16*)WSP(WS_PROJ);
    if (SBK) { p.Kp = proj + r0 * NPROJ + 2560 + u.h * 64; p.Vp = proj + r0 * NPROJ + 3072 + u.h * 64; p.ga = nullptr; p.pk = NPROJ; p.pv = NPROJ; }
    else { const bf16* qkc = (const bf16*)WSP(WS_QKC); p.Kp = qkc + r0 * DM + 512 + u.h * 128; p.Vp = proj + r0 * NPROJ + 1024 + u.h * 128; p.ga = (const float*)WSP(WS_GA) + (size_t)(u.b * 4 + u.h) * SEQ; p.pk = DM; p.pv = NPROJ; }
    return p;
}

template <int D, bool ML, class LP>
__device__ __forceinline__ void issue_tile(unsigned kbuf, unsigned vbuf, unsigned gabuf, const LP& u, int s0, int wid, int lane) {
#pragma unroll
    for (int c = 0; c < D / 64; ++c) { const int ch = wid + 8 * c;
        glds16(u.Kp + (size_t)(s0 + lane) * u.pk + 8 * ch, (unsigned)__builtin_amdgcn_readfirstlane(kbuf + ch * 1024)); }
#pragma unroll
    for (int c = 0; c < D / 64; ++c) { const int idx = wid + 8 * c, dp = idx >> 2, rg = idx & 3;
        glds16(u.Vp + (size_t)(s0 + 16 * rg + (lane >> 2)) * u.pv + 32 * dp + 8 * (lane & 3), (unsigned)__builtin_amdgcn_readfirstlane(vbuf + dp * 4096 + rg * 1024)); }
    if (ML) glds4(u.ga + s0 + lane, (unsigned)__builtin_amdgcn_readfirstlane(gabuf));
}
template <int D>
__device__ __forceinline__ void qk(lptr kimg, const bf16x8 (&qr)[D / 16], f32x16& p0, f32x16& p1, const int lane) {
    const lptr kp = kimg + (lane >> 5) * 1024 + (lane & 31) * 16;
    p0 = f32x16{}; p1 = f32x16{};
#pragma unroll
    for (int hb = 0; hb < D / 64; ++hb) {
        bf16x8 kf[8];
#pragma unroll
        for (int d = 0; d < 4; ++d) { const int d0 = 4 * hb + d; kf[2 * d] = *(LAS const bf16x8*)(kp + d0 * 2048); kf[2 * d + 1] = *(LAS const bf16x8*)(kp + d0 * 2048 + 512); }
        __builtin_amdgcn_sched_barrier(0);
#pragma unroll
        for (int d = 0; d < 4; ++d) { const int d0 = 4 * hb + d; p0 = MX_MFMA(kf[2 * d], qr[d0], p0); p1 = MX_MFMA(kf[2 * d + 1], qr[d0], p1); }
        __builtin_amdgcn_sched_barrier(0);
    }
}
template <int D, bool SBK, bool MASK>
__device__ __forceinline__ void vp(lptr vimg, LAS const float* gat, const f32x16& p0, const f32x16& p1, f32x16 (&o)[D / 32], float& st, const float Mt, const int qrow, const int key0, const int lane) {
    const int hi = lane >> 5;
    const lptr vb = vimg + ((lane >> 4) & 1) * 32 + (lane & 3) * 8 + (4 * hi + ((lane & 15) >> 2)) * 64;
    constexpr int VPRE = (D == 128) ? 2 : D / 32;
    s16x4 vlo[VPRE * 4], vhi[VPRE * 4];
#pragma unroll
    for (int dp = 0; dp < VPRE; ++dp)
#pragma unroll
        for (int ks = 0; ks < 4; ++ks) { vlo[dp * 4 + ks] = vtr(vb + dp * 4096 + ks * 1024); vhi[dp * 4 + ks] = vtr(vb + dp * 4096 + ks * 1024 + 512); }
    __builtin_amdgcn_sched_barrier(0);
    u32x4 pw[4];
    if constexpr (SBK) {
        float R = st;
#pragma unroll
        for (int blk = 1; blk >= 0; --blk) {
            const f32x16& X = blk ? p1 : p0; const int kb = key0 + 32 * blk;
            float bt[16], sx[16], Pg[4], Qg[4];
#pragma unroll
            for (int g = 0; g < 4; ++g) { float run = 1.f;
#pragma unroll
                for (int i = 3; i >= 0; --i) { const int r = 4 * g + i; float z = X[r]; if (MASK) z = (kb + crow(r, hi) < qrow) ? z : -INFINITY;
                    const float e = __builtin_amdgcn_exp2f(-z); const float b = __builtin_amdgcn_rcpf(1.0f + e); bt[r] = b; sx[r] = run; run *= (1.0f - b); }
                Pg[g] = run; }
#pragma unroll
            for (int g = 0; g < 4; ++g) Qg[g] = partner(Pg[g], hi);
            float a[16];
#pragma unroll
            for (int g = 3; g >= 0; --g) { const float pre = R * (hi ? 1.0f : Qg[g]);
#pragma unroll
                for (int i = 0; i < 4; ++i) a[4 * g + i] = bt[4 * g + i] * sx[4 * g + i] * pre;
                R *= Pg[g] * Qg[g]; }
            pw[2 * blk] = (u32x4){cvtpk(a[0], a[1]), cvtpk(a[2], a[3]), cvtpk(a[4], a[5]), cvtpk(a[6], a[7])};
            pw[2 * blk + 1] = (u32x4){cvtpk(a[8], a[9]), cvtpk(a[10], a[11]), cvtpk(a[12], a[13]), cvtpk(a[14], a[15])};
        }
        st = R;
    } else {
        float den = st;
#pragma unroll
        for (int blk = 0; blk < 2; ++blk) {
            const f32x16& X = blk ? p1 : p0; const int kb = key0 + 32 * blk;
            float a[16];
#pragma unroll
            for (int g = 0; g < 4; ++g) { const f32x4 gv = *(LAS const f32x4*)(gat + 32 * blk + 8 * g + 4 * hi);
#pragma unroll
                for (int i = 0; i < 4; ++i) { const int r = 4 * g + i; float p = X[r] * (gv[i] * Mt); if (MASK) p = (kb + crow(r, hi) <= qrow) ? p : 0.f; den += p; a[r] = p; } }
            pw[2 * blk] = (u32x4){cvtpk(a[0], a[1]), cvtpk(a[2], a[3]), cvtpk(a[4], a[5]), cvtpk(a[6], a[7])};
            pw[2 * blk + 1] = (u32x4){cvtpk(a[8], a[9]), cvtpk(a[10], a[11]), cvtpk(a[12], a[13]), cvtpk(a[14], a[15])};
        }
        st = den;
    }
    __builtin_amdgcn_sched_barrier(0);
    if constexpr (VPRE < D / 32) {
#pragma unroll
        for (int dp = 0; dp < VPRE; ++dp)
#pragma unroll
            for (int ks = 0; ks < 4; ++ks) { const s16x4 a = vlo[dp * 4 + ks], b = vhi[dp * 4 + ks];
                o[dp] = MX_MFMA(__builtin_bit_cast(bf16x8, pw[ks]), ((bf16x8){a[0], a[1], a[2], a[3], b[0], b[1], b[2], b[3]}), o[dp]); }
        __builtin_amdgcn_sched_barrier(0);
        s16x4 wlo[(D / 32 - VPRE) * 4], whi[(D / 32 - VPRE) * 4];
#pragma unroll
        for (int dp = VPRE; dp < D / 32; ++dp)
#pragma unroll
            for (int ks = 0; ks < 4; ++ks) { wlo[(dp - VPRE) * 4 + ks] = vtr(vb + dp * 4096 + ks * 1024); whi[(dp - VPRE) * 4 + ks] = vtr(vb + dp * 4096 + ks * 1024 + 512); }
        __builtin_amdgcn_sched_barrier(0);
#pragma unroll
        for (int dp = VPRE; dp < D / 32; ++dp)
#pragma unroll
            for (int ks = 0; ks < 4; ++ks) { const s16x4 a = wlo[(dp - VPRE) * 4 + ks], b = whi[(dp - VPRE) * 4 + ks];
                o[dp] = MX_MFMA(__builtin_bit_cast(bf16x8, pw[ks]), ((bf16x8){a[0], a[1], a[2], a[3], b[0], b[1], b[2], b[3]}), o[dp]); }
    } else {
#pragma unroll
        for (int dp = 0; dp < D / 32; ++dp)
#pragma unroll
            for (int ks = 0; ks < 4; ++ks) { const s16x4 a = vlo[dp * 4 + ks], b = vhi[dp * 4 + ks];
                o[dp] = MX_MFMA(__builtin_bit_cast(bf16x8, pw[ks]), ((bf16x8){a[0], a[1], a[2], a[3], b[0], b[1], b[2], b[3]}), o[dp]); }
    }
}
template <int D, bool SBK, bool MASK>
__device__ __forceinline__ void valu(LAS const float* gat, const f32x16& p0, const f32x16& p1, u32x4 (&pw)[4], float& st, const float Mt, const int qrow, const int key0, const int lane) {
    const int hi = lane >> 5;
    if constexpr (SBK) {
        float R = st;
#pragma unroll
        for (int blk = 1; blk >= 0; --blk) {
            const f32x16& X = blk ? p1 : p0; const int kb = key0 + 32 * blk;
            float bt[16], sx[16], Pg[4], Qg[4];
#pragma unroll
            for (int g = 0; g < 4; ++g) { float run = 1.f;
#pragma unroll
                for (int i = 3; i >= 0; --i) { const int r = 4 * g + i; float z = X[r]; if (MASK) z = (kb + crow(r, hi) < qrow) ? z : -INFINITY;
                    const float e = __builtin_amdgcn_exp2f(-z); const float b = __builtin_amdgcn_rcpf(1.0f + e); bt[r] = b; sx[r] = run; run *= (1.0f - b); }
                Pg[g] = run; }
#pragma unroll
            for (int g = 0; g < 4; ++g) Qg[g] = partner(Pg[g], hi);
            float a[16];
#pragma unroll
            for (int g = 3; g >= 0; --g) { const float pre = R * (hi ? 1.0f : Qg[g]);
#pragma unroll
                for (int i = 0; i < 4; ++i) a[4 * g + i] = bt[4 * g + i] * sx[4 * g + i] * pre;
                R *= Pg[g] * Qg[g]; }
            pw[2 * blk] = (u32x4){cvtpk(a[0], a[1]), cvtpk(a[2], a[3]), cvtpk(a[4], a[5]), cvtpk(a[6], a[7])};
            pw[2 * blk + 1] = (u32x4){cvtpk(a[8], a[9]), cvtpk(a[10], a[11]), cvtpk(a[12], a[13]), cvtpk(a[14], a[15])};
        }
        st = R;
    } else {
        float den = st;
#pragma unroll
        for (int blk = 0; blk < 2; ++blk) {
            const f32x16& X = blk ? p1 : p0; const int kb = key0 + 32 * blk;
            float a[16];
#pragma unroll
            for (int g = 0; g < 4; ++g) { const f32x4 gv = *(LAS const f32x4*)(gat + 32 * blk + 8 * g + 4 * hi);
#pragma unroll
                for (int i = 0; i < 4; ++i) { const int r = 4 * g + i; float p = X[r] * (gv[i] * Mt); if (MASK) p = (kb + crow(r, hi) <= qrow) ? p : 0.f; den += p; a[r] = p; } }
            pw[2 * blk] = (u32x4){cvtpk(a[0], a[1]), cvtpk(a[2], a[3]), cvtpk(a[4], a[5]), cvtpk(a[6], a[7])};
            pw[2 * blk + 1] = (u32x4){cvtpk(a[8], a[9]), cvtpk(a[10], a[11]), cvtpk(a[12], a[13]), cvtpk(a[14], a[15])};
        }
        st = den;
    }
}
template <int D>
__device__ __forceinline__ void pv(lptr vimg, const u32x4 (&pw)[4], f32x16 (&o)[D / 32], const int lane) {
    const int hi = lane >> 5;
    const lptr vb = vimg + ((lane >> 4) & 1) * 32 + (lane & 3) * 8 + (4 * hi + ((lane & 15) >> 2)) * 64;
#pragma unroll
    for (int hb = 0; hb < D / 64; ++hb) {
        s16x4 vlo[8], vhi[8];
#pragma unroll
        for (int d = 0; d < 2; ++d)
#pragma unroll
            for (int ks = 0; ks < 4; ++ks) { const int dp = 2 * hb + d; vlo[d * 4 + ks] = vtr(vb + dp * 4096 + ks * 1024); vhi[d * 4 + ks] = vtr(vb + dp * 4096 + ks * 1024 + 512); }
        __builtin_amdgcn_sched_barrier(0);
#pragma unroll
        for (int d = 0; d < 2; ++d)
#pragma unroll
            for (int ks = 0; ks < 4; ++ks) { const int dp = 2 * hb + d; const s16x4 a = vlo[d * 4 + ks], b = vhi[d * 4 + ks];
                o[dp] = MX_MFMA(__builtin_bit_cast(bf16x8, pw[ks]), ((bf16x8){a[0], a[1], a[2], a[3], b[0], b[1], b[2], b[3]}), o[dp]); }
        __builtin_amdgcn_sched_barrier(0);
    }
}
__device__ __forceinline__ void ml_fused(LAS const float* gat, const f32x16& p0, const f32x16& p1, u32x4 (&pwN)[4], float& den, const float ft, const int lane,
                                         lptr vimgP, const u32x4 (&pwP)[4], f32x16 (&o)[4], const bool dopv) {
    const int hi = lane >> 5;
    const lptr vb = vimgP + ((lane >> 4) & 1) * 32 + (lane & 3) * 8 + (4 * hi + ((lane & 15) >> 2)) * 64;
    s16x4 f0a = vtr(vb), f0b = vtr(vb + 512), f1a = vtr(vb + 1024), f1b = vtr(vb + 1024 + 512);
    f32x4 gv = {};
    __builtin_amdgcn_sched_barrier(0);
#pragma unroll
    for (int k = 0; k < 16; ++k) {
        const int dp = k >> 2, ks = k & 3;
        s16x4 f2a = f0a, f2b = f0b;
        if (k + 2 < 16) { const int dn = (k + 2) >> 2, kn = (k + 2) & 3; f2a = vtr(vb + dn * 4096 + kn * 1024); f2b = vtr(vb + dn * 4096 + kn * 1024 + 512); }
        if (dopv) o[dp] = MX_MFMA(__builtin_bit_cast(bf16x8, pwP[ks]), ((bf16x8){f0a[0], f0a[1], f0a[2], f0a[3], f0b[0], f0b[1], f0b[2], f0b[3]}), o[dp]);
        const int blk = k >> 3, r = 2 * (k & 7);
        if ((k & 1) == 0) gv = *(LAS const f32x4*)(gat + 32 * blk + 8 * (r >> 2) + 4 * hi);
        const f32x16& X = blk ? p1 : p0;
        const float q0 = X[r] * (gv[r & 3] * ft), q1 = X[r + 1] * (gv[(r & 3) + 1] * ft);
        den += q0; den += q1;
        unsigned w = cvtpk(q0, q1);
        asm volatile("" : "+v"(w)); asm volatile("" : "+v"(den));
        pwN[2 * blk + ((k & 7) >> 2)][(k & 7) & 3] = w;
        f0a = f1a; f0b = f1b; f1a = f2a; f1b = f2b;
        __builtin_amdgcn_sched_barrier(0);
    }
}
__device__ __forceinline__ void ml_mask(f32x16& p0, f32x16& p1, const int qrow, const int key0, const int lane) {
    const int hi = lane >> 5;
#pragma unroll
    for (int r = 0; r < 16; ++r) { const int kk = key0 + crow(r, hi); p0[r] = (kk <= qrow) ? p0[r] : 0.f; p1[r] = (kk + 32 <= qrow) ? p1[r] : 0.f; }
}
template <int D, bool SBK>
__device__ __forceinline__ void prefetch_unit(KArgs kap, LAS unsigned char* lds, const int wave_s, const UnitP& u, bf16x8 (&qr)[D / 16], float& Mt, float& Ml, float& tgv) {
    int tid = wave_s * 64 + lane_id(); asm volatile("" : "+v"(tid));
    const int lane = tid & 63, wid = __builtin_amdgcn_readfirstlane(tid >> 6);
    const int qrow = 256 * u.qb + 32 * wid + (lane & 31), nt = 4 * (u.qb + 1);
    const unsigned l0 = (unsigned)(size_t)lds;
    const LoopPtrs<SBK> lp = loop_ptrs<SBK>(kap, u);
    issue_tile<D, !SBK>(l0 + KBUF0, l0 + VBUF0, l0 + EX_GA, lp, 64 * (nt - 1), wid, lane);
    issue_tile<D, !SBK>(l0 + KBUF0 + BUFSZ, l0 + VBUF0 + BUFSZ, l0 + EX_GA + 256, lp, 64 * (nt - 2), wid, lane);
    const size_t r0 = (size_t)u.b * SEQ;
    const bf16* Qp = SBK ? (const bf16*)WSP(WS_PROJ) + r0 * NPROJ + 2048 + u.h * 64 : (const bf16*)WSP(WS_QKC) + r0 * DM + u.h * 128; const int pq = SBK ? NPROJ : DM;
#pragma unroll
    for (int d0 = 0; d0 < D / 16; ++d0) qr[d0] = *(const GAS bf16x8*)(Qp + (size_t)qrow * pq + d0 * 16 + (lane >> 5) * 8);
    Mt = 0.f; Ml = 0.f; tgv = 0.f;
    if (!SBK) { const size_t bh = (size_t)(u.b * 4 + u.h); Mt = ((const float*)WSP(WS_GM))[bh * SEQ + qrow]; Ml = ((const float*)WSP(WS_GM))[bh * SEQ + 256 * u.qb + 255];
        tgv = ((const float*)WSP(WS_TG))[bh * 32 + (lane & 31)]; }
}
template <int D, bool SBK>
__device__ __forceinline__ void unit_run(KArgs kap, LAS unsigned char* lds, const int wave_s, const UnitP& u, const bool has_next, const UnitP& nx, bf16x8 (&qr)[D / 16], float& Mt, float& Ml, float& tgv) {
    int tid = wave_s * 64 + lane_id(); asm volatile("" : "+v"(tid));
    const LoopPtrs<SBK> lp = loop_ptrs<SBK>(kap, u);
    const int lane = tid & 63, wid = __builtin_amdgcn_readfirstlane(tid >> 6), late = MX_LATE ? (wid >> 2) : 0, r32 = lane & 31, hi = lane >> 5;
    const int t0 = 256 * u.qb, nt = 4 * (u.qb + 1), R0 = t0 + 32 * wid, qrow = R0 + r32;
    const unsigned l0 = (unsigned)(size_t)lds;
#pragma unroll
    for (int d0 = 0; d0 < D / 16; ++d0) asm volatile("" : "+v"(qr[d0]));
    asm volatile("" : "+v"(Mt)); asm volatile("" : "+v"(Ml)); asm volatile("" : "+v"(tgv));
    const float fv = SBK ? 0.f : __builtin_amdgcn_exp2f(tgv - Ml);
    const float Bt = SBK ? 1.f : __builtin_amdgcn_exp2f(Ml - Mt);
    f32x16 o[D / 32];
#pragma unroll
    for (int i = 0; i < D / 32; ++i) o[i] = f32x16{};
    float st = SBK ? 1.0f : 0.0f;
    const int nti = (!SBK && ML_CHUNK) ? 4 : nt;
    if constexpr (!SBK && ML_CHUNK) {
        __builtin_amdgcn_s_barrier();
        if (u.qb > 0) {
            const int bh = u.b * 4 + u.h;
            const float* CMp = (const float*)WSP(WS_CM) + bh * 8;
            {
                const int d = tid >> 2, dp = tid & 3;
                const unsigned short* Ub = (const unsigned short*)WSP(WS_U) + (size_t)bh * 7 * 16384 + d * 128 + dp * 32;
                v4u rr[7][4];
#pragma unroll
                for (int j = 0; j < 7; ++j) { const int jc = (j < u.qb) ? j : u.qb - 1;
#pragma unroll
                    for (int c = 0; c < 4; ++c) rr[j][c] = *(const GAS v4u*)(Ub + (size_t)jc * 16384 + 8 * c); }
                float scj[7];
                { const f32x4 c0 = *(const GAS f32x4*)CMp, c1 = *(const GAS f32x4*)(CMp + 4);
                  const float cmv[8] = {c0.x, c0.y, c0.z, c0.w, c1.x, c1.y, c1.z, c1.w};
#pragma unroll
                  for (int j = 0; j < 7; ++j) scj[j] = (j < u.qb) ? __builtin_amdgcn_exp2f(cmv[j] - Ml) : 0.f; }
                float ac[32];
#pragma unroll
                for (int c = 0; c < 32; ++c) ac[c] = 0.f;
#pragma unroll
                for (int j = 0; j < 7; ++j)
#pragma unroll
                    for (int c = 0; c < 4; ++c) { const v4u x = rr[j][c];
                        ac[8 * c + 0] += scj[j] * bflo(x.x); ac[8 * c + 1] += scj[j] * bfhi(x.x); ac[8 * c + 2] += scj[j] * bflo(x.y); ac[8 * c + 3] += scj[j] * bfhi(x.y);
                        ac[8 * c + 4] += scj[j] * bflo(x.z); ac[8 * c + 5] += scj[j] * bfhi(x.z); ac[8 * c + 6] += scj[j] * bflo(x.w); ac[8 * c + 7] += scj[j] * bfhi(x.w); }
                const int dl = d & 63, rho = (dl & 0x33) | ((dl & 4) << 1) | ((dl & 8) >> 1);
                LAS unsigned char* ip = lds + STAGE0 + (d >> 6) * 16384 + dp * 4096 + rho * 64;
#pragma unroll
                for (int c = 0; c < 4; ++c) *(LAS v4u*)(ip + 16 * c) = (v4u){cvtpk(ac[8 * c], ac[8 * c + 1]), cvtpk(ac[8 * c + 2], ac[8 * c + 3]), cvtpk(ac[8 * c + 4], ac[8 * c + 5]), cvtpk(ac[8 * c + 6], ac[8 * c + 7])};
                if (tid < 128) { const float* NVp = (const float*)WSP(WS_NV) + (size_t)bh * 7 * 128 + tid; float nn = 0.f, nvv[7];
#pragma unroll
                    for (int j = 0; j < 7; ++j) { const int jc = (j < u.qb) ? j : u.qb - 1; nvv[j] = NVp[jc * 128]; }
                    asm volatile("" : "+v"(nvv[0]), "+v"(nvv[1]), "+v"(nvv[2]), "+v"(nvv[3]), "+v"(nvv[4]), "+v"(nvv[5]), "+v"(nvv[6]));
#pragma unroll
                    for (int j = 0; j < 7; ++j) nn += scj[j] * nvv[j];
                    ((LAS float*)(lds + STAGE0 + 32768))[tid] = nn; }
            }
            LDS_WAIT(); __builtin_amdgcn_s_barrier(); asm volatile("" ::: "memory");
            {
                u32x4 qa[4], qb_[4];
#pragma unroll
                for (int c = 0; c < 4; ++c) { qa[c] = __builtin_bit_cast(u32x4, qr[c]); qb_[c] = __builtin_bit_cast(u32x4, qr[4 + c]); }
                pv<128>((lptr)(lds + STAGE0), qa, o, lane);
                pv<128>((lptr)(lds + STAGE0 + 16384), qb_, o, lane);
                LAS const float* nvl = (LAS const float*)(lds + STAGE0 + 32768);
                float dn = 0.f;
#pragma unroll
                for (int d0 = 0; d0 < 8; ++d0) { const f32x4 n0 = *(LAS const f32x4*)(nvl + 16 * d0 + 8 * hi), n1 = *(LAS const f32x4*)(nvl + 16 * d0 + 8 * hi + 4); const u32x4 qq = __builtin_bit_cast(u32x4, qr[d0]);
                    dn += bflo(qq.x) * n0.x + bfhi(qq.x) * n0.y + bflo(qq.y) * n0.z + bfhi(qq.y) * n0.w + bflo(qq.z) * n1.x + bfhi(qq.z) * n1.y + bflo(qq.w) * n1.z + bfhi(qq.w) * n1.w; }
                st = dn;
            }
        }
    }
    f32x16 p0 = {}, p1 = {};
    u32x4 pwP[4] = {}; bool havep = false;
    LAS unsigned* const dflag = (LAS unsigned*)(lds + EX_DEAD);
    if (SBK) { if (lane == 0) dflag[wid] = 0u; }
    int k3 = 0, v4 = 0;
    bool wdead = false;
    for (int i = 0; i < nti + MX_LATE; ++i) {
        if (i + 1 < nti) { if (D == 64) asm volatile("s_waitcnt vmcnt(2)" ::: "memory"); else asm volatile("s_waitcnt vmcnt(5)" ::: "memory"); }
        else asm volatile("s_waitcnt vmcnt(0)" ::: "memory");
        if (SBK) LDS_WAIT();
        __builtin_amdgcn_s_barrier();
        asm volatile("" ::: "memory");
        if (SBK && i > 0) { const u32x4 d0 = *(LAS const u32x4*)dflag, d1 = *(LAS const u32x4*)(dflag + 4);
            if (__builtin_amdgcn_readfirstlane((int)(d0.x & d0.y & d0.z & d0.w & d1.x & d1.y & d1.z & d1.w)) != 0) break; }
        if (i + 2 < nti) { const int k3n = (k3 == 0) ? 2 : k3 - 1, v4n = (v4 + 2) & 3;
            issue_tile<D, !SBK>(l0 + KBUF0 + k3n * BUFSZ, l0 + VBUF0 + v4n * BUFSZ, l0 + EX_GA + v4n * 256, lp, 64 * (nt - 3 - i), wid, lane); }
        const int v4p = (v4 + 3) & 3;
        const int tv = late ? nt - i : nt - 1 - i;
        const int vb = late ? v4p : v4;
        const bool dov = late ? (i >= 1) : (i < nti);
        const int tq = nt - 1 - i;
        const bool doq = (i < nti) && (SBK ? (64 * tq < R0 + 31) : (64 * tq <= R0 + 31));
        const lptr kimg = (lptr)(lds + KBUF0 + k3 * BUFSZ);
        if (!late && doq && !wdead) qk<D>(kimg, qr, p0, p1, lane);
        if constexpr (!SBK) {
            if (doq) {
                const float ft = __builtin_bit_cast(float, __builtin_amdgcn_readlane(__builtin_bit_cast(int, fv), tq));
                const bool unm = (64 * tq + 63 <= R0);
                LAS const float* gat = (LAS const float*)(lds + EX_GA + v4 * 256); const lptr vprev = (lptr)(lds + VBUF0 + v4p * BUFSZ);
                u32x4 pwN[4];
                if (!unm) ml_mask(p0, p1, qrow, 64 * tq, lane);
                ml_fused(gat, p0, p1, pwN, st, ft, lane, vprev, pwP, o, havep);
#pragma unroll
                for (int q_ = 0; q_ < 4; ++q_) pwP[q_] = pwN[q_];
                havep = true;
            }
        } else
        if (dov) {
            const bool live = SBK ? (64 * tv < R0 + 31) : (64 * tv <= R0 + 31);
            const bool unm = SBK ? (64 * tv + 63 < R0) : (64 * tv + 63 <= R0);
            const lptr vimg = (lptr)(lds + VBUF0 + vb * BUFSZ); LAS const float* gat = (LAS const float*)(lds + EX_GA + vb * 256);
            if (live && !wdead) { const float ft = SBK ? 0.f : __builtin_bit_cast(float, __builtin_amdgcn_readlane(__builtin_bit_cast(int, fv), tv));
                if (unm) vp<D, SBK, false>(vimg, gat, p0, p1, o, st, ft, qrow, 64 * tv, lane); else vp<D, SBK, true>(vimg, gat, p0, p1, o, st, ft, qrow, 64 * tv, lane);
                if (SBK) { const bool dead = (__ballot(st != 0.0f) == 0ull); if (lane == 0) dflag[wid] = dead ? 1u : 0u; wdead = dead; } }
        }
        if (late && doq) qk<D>(kimg, qr, p0, p1, lane);
        k3 = (k3 == 2) ? 0 : k3 + 1; v4 = (v4 + 1) & 3;
    }
    if constexpr (!SBK) { if (havep) pv<D>((lptr)(lds + VBUF0 + ((nt - 1) & 3) * BUFSZ), pwP, o, lane); }
    LDS_WAIT(); __builtin_amdgcn_s_barrier(); asm volatile("" ::: "memory");
    const float ge_q = SBK ? 0.f : ((const float*)WSP(WS_GE))[(size_t)(u.b * 4 + u.h) * SEQ + qrow];
    if (has_next) prefetch_unit<D, SBK>(kap, lds, wave_s, nx, qr, Mt, Ml, tgv);
    const size_t er0 = (size_t)u.b * SEQ;
    bf16* const e_out = (bf16*)WSP(WS_MIXED) + er0 * DM + (SBK ? 512 + u.h * 64 : u.h * 128);
    const float* const e_gain = SBK ? KA(g_sb) + u.layer * 512 + u.h * 64 : KA(g_mlstm) + u.layer * 512 + u.h * 128;
    const bf16* const e_om = (const bf16*)WSP(WS_PROJ) + er0 * NPROJ + 1536 + u.h * 128;
    LAS float* stg = (LAS float*)(lds + STAGE0 + wid * STAGE_W); LAS float* wsf = stg + 1088;
    if (!SBK) { const float den = (st + partner(st, hi)) * Bt; if (hi == 0) wsf[r32] = Bt / fmaxf(fabsf(den), ge_q); }
    constexpr int RP = (D == 64) ? 16 : 8, NPASS = 32 / RP, LPR = 64 / RP, PITCH = D + 4, RPP = 16 / NPASS;
    const int rl = lane / LPR, seg = lane % LPR;
    float gn[16];
#pragma unroll
    for (int c = 0; c < 4; ++c) { const f32x4 g = *(const GAS f32x4*)(e_gain + 16 * seg + 4 * c); gn[4 * c] = g.x; gn[4 * c + 1] = g.y; gn[4 * c + 2] = g.z; gn[4 * c + 3] = g.w; }
    v4u gpre[SBK ? 1 : NPASS][2];
    if constexpr (!SBK) {
#pragma unroll
        for (int ps = 0; ps < NPASS; ++ps) { const int gr_ = R0 + ps * RP + rl; gpre[ps][0] = *(const GAS v4u*)(e_om + (size_t)gr_ * NPROJ + 16 * seg); gpre[ps][1] = *(const GAS v4u*)(e_om + (size_t)gr_ * NPROJ + 16 * seg + 8); }
    }
#pragma unroll
    for (int ps = 0; ps < NPASS; ++ps) {
        LDS_WAIT(); asm volatile("" ::: "memory");
#pragma unroll
        for (int rr = 0; rr < RPP; ++rr) { const int r = ps * RPP + rr; const int srow = crow(r, hi) - ps * RP;
#pragma unroll
            for (int dp = 0; dp < D / 32; ++dp) stg[srow * PITCH + 32 * dp + r32] = o[dp][r]; }
        LDS_WAIT(); asm volatile("" ::: "memory");
        float x[16];
#pragma unroll
        for (int c = 0; c < 4; ++c) { const f32x4 v4 = *(LAS const f32x4*)(stg + rl * PITCH + 16 * seg + 4 * c); x[4 * c] = v4.x; x[4 * c + 1] = v4.y; x[4 * c + 2] = v4.z; x[4 * c + 3] = v4.w; }
        const int prow = ps * RP + rl, grow = R0 + prow;
        if (!SBK) { const float inv = wsf[prow];
#pragma unroll
            for (int c = 0; c < 16; ++c) x[c] *= inv; }
        float ss = 0.f;
#pragma unroll
        for (int c = 0; c < 16; ++c) ss += x[c] * x[c];
        ss = (LPR == 8) ? oct_sum(ss, lane) : quad_sum(ss);
        const float rs = 1.0f / sqrtf(ss * (1.0f / D) + EPS);
#pragma unroll
        for (int c = 0; c < 16; ++c) x[c] *= rs * gn[c];
        if (!SBK) { const v4u g0 = gpre[SBK ? 0 : ps][0], g1 = gpre[SBK ? 0 : ps][1];
            float gg[16]; gg[0] = bflo(g0.x); gg[1] = bfhi(g0.x); gg[2] = bflo(g0.y); gg[3] = bfhi(g0.y); gg[4] = bflo(g0.z); gg[5] = bfhi(g0.z); gg[6] = bflo(g0.w); gg[7] = bfhi(g0.w);
            gg[8] = bflo(g1.x); gg[9] = bfhi(g1.x); gg[10] = bflo(g1.y); gg[11] = bfhi(g1.y); gg[12] = bflo(g1.z); gg[13] = bfhi(g1.z); gg[14] = bflo(g1.w); gg[15] = bfhi(g1.w);
#pragma unroll
            for (int c = 0; c < 16; ++c) x[c] *= 1.0f / (1.0f + __expf(-gg[c])); }
        bf16* op = e_out + (size_t)grow * DM + 16 * seg;
        *(GAS v4u*)op = (v4u){pk2(x[0], x[1]), pk2(x[2], x[3]), pk2(x[4], x[5]), pk2(x[6], x[7])};
        *(GAS v4u*)(op + 8) = (v4u){pk2(x[8], x[9]), pk2(x[10], x[11]), pk2(x[12], x[13]), pk2(x[14], x[15])};
    }
    LDS_WAIT();
}
#undef MX_MFMA
}

__device__ __forceinline__ void mixer_phase(KArgs kap, LAS unsigned char* lds, const int wave_s, const int layer) {
    int G = gridDim.x; asm volatile("" : "+s"(G)); int bid = blockIdx.x; asm volatile("" : "+s"(bid));
    for (int jb = bid; jb < 256; jb += G) {
        {
            int jb2 = jb; asm volatile("" : "+s"(jb2));
            const int b = jb2 & 7, idx = jb2 >> 3, m = idx & 7, hl = idx >> 3;
#if ML_CHUNK
            int hA, qA, hB, qB;
            if (m < 6) { const int n0 = (m * 4 + hl) * 2, n1 = n0 + 1; hA = (n0 * 37) >> 8; qA = 1 + n0 - 7 * hA; hB = (n1 * 37) >> 8; qB = 1 + n1 - 7 * hB; }
            else { const int n0 = 48 + (m - 6) * 4 + hl; hA = (n0 * 37) >> 8; qA = 1 + n0 - 7 * hA; hB = hl + 4 * (m - 6); qB = 0; }
            bf16x8 qr[4]; float Mt, Ml, tgv;
            __builtin_amdgcn_s_barrier();
            {
                const mix2::UnitP uA{b, hA, qA, layer}, uB{b, hB, qB, layer};
                mix2::prefetch_unit<64, true>(kap, lds, wave_s, uA, qr, Mt, Ml, tgv);
                mix2::unit_run<64, true>(kap, lds, wave_s, uA, true, uB, qr, Mt, Ml, tgv);
                mix2::unit_run<64, true>(kap, lds, wave_s, uB, false, uB, qr, Mt, Ml, tgv);
            }
#else
            const int nsb = (0x01122334 >> (4 * m)) & 15, st0 = (int)((0xFECA740ull >> (4 * m)) & 15ull);
            bf16x8 qr[4]; float Mt, Ml, tgv;
            __builtin_amdgcn_s_barrier();
            if (nsb > 0) {
                const int u0 = hl * 16 + st0;
                mix2::UnitP uc{b, u0 >> 3, u0 & 7, layer};
                mix2::prefetch_unit<64, true>(kap, lds, wave_s, uc, qr, Mt, Ml, tgv);
#pragma unroll 1
                for (int k = 0; k < nsb; ++k) {
                    const int un = u0 + k + 1; const mix2::UnitP nx{b, un >> 3, un & 7, layer};
                    mix2::unit_run<64, true>(kap, lds, wave_s, uc, k + 1 < nsb, nx, qr, Mt, Ml, tgv);
                    uc = nx;
                }
            }
#endif
        }
#if CONV_NOBAR
        {
            int t0_ = wave_s * 64 + lane_id();
            if (t0_ == 0) { gu32* cc = (gu32*)WSP(WS_CTL) + CW_CONV + 8 * layer + (bid & 7); unsigned sp = 0u;
                while (__hip_atomic_load(cc, __ATOMIC_RELAXED, __HIP_MEMORY_SCOPE_AGENT) < (unsigned)(G >> 3)) { __builtin_amdgcn_s_sleep(1); if (++sp > (1u << 22)) break; }
                __builtin_amdgcn_fence(__ATOMIC_ACQUIRE, "agent"); }
            __builtin_amdgcn_s_barrier();
        }
#endif
        {
            const int b = jb & 7, idx = jb >> 3, m = idx & 7, hl = idx >> 3;
            const mix2::UnitP u{b, hl, m, layer};
            bf16x8 qr[8]; float Mt, Ml, tgv;
            mix2::prefetch_unit<128, false>(kap, lds, wave_s, u, qr, Mt, Ml, tgv);
            mix2::unit_run<128, false>(kap, lds, wave_s, u, false, u, qr, Mt, Ml, tgv);
        }
        __builtin_amdgcn_s_barrier();
    }
}

#define MKFRAME() Frame F; F.lds = (LAS unsigned char*)lds; F.MISC = (volatile LAS unsigned*)(F.lds + MISC_OFF); F.tid = wave_s * 64 + lane_id(); asm volatile("" : "+v"(F.tid)); F.lane = F.tid & 63; \
    F.wave = __builtin_amdgcn_readfirstlane(F.tid >> 6); F.G = gridDim.x; asm volatile("" : "+s"(F.G)); F.bid = blockIdx.x; asm volatile("" : "+s"(F.bid)); F.ctl = (gu32*)WSP(WS_CTL)
#define GRID_BAR() do { XcdBarrier bar_; bar_.bar = (unsigned*)WSP(WS_CTL) + CW_BAR; bar_.x = xb_xcc_id(); bar_.st = (volatile LAS unsigned*)((LAS unsigned char*)lds + MISC_OFF) + 8; xcd_barrier(bar_, wave_s); } while (0)
#define GROUP_BAR() group_barrier((gu32*)WSP(WS_CTL) + CW_GB + 4096 * ((int)blockIdx.x & 7), wave_s, (volatile LAS unsigned*)((LAS unsigned char*)lds + MISC_OFF) + 24, xb_xcc_id())
#define BUILD_TAB() do { __syncthreads(); \
            if (F.tid == 0) { int acc_ = 0; for (int e = 0; e < 8; ++e) { const int c_ = (int)__hip_atomic_load(F.ctl + CW_CNT + 64 * j + e, RLX_AGENT); tab[e] = acc_; tab[16 + e] = c_; acc_ += (c_ + 255) >> 8; } tab[8] = acc_; } \
            __syncthreads(); } while (0)

__global__ void __launch_bounds__(NTHREADS, 2) mk_fwd(Args args_unused) {
    extern __shared__ __attribute__((aligned(16))) unsigned char lds[];
    KArgs kap = (KArgs)__builtin_amdgcn_kernarg_segment_ptr();
    const int wave_s = __builtin_amdgcn_readfirstlane((int)threadIdx.x >> 6);
    for (int u = threadIdx.x; u < 256; u += NTHREADS) ((LAS unsigned*)((LAS unsigned char*)lds + MISC_OFF))[u] = 0u;
    __syncthreads();
    (void)xcd_barrier_post((unsigned*)WSP(WS_CTL) + CW_BAR, (volatile LAS unsigned*)((LAS unsigned char*)lds + MISC_OFF) + 8);
    { gu32* gbp = (gu32*)WSP(WS_CTL) + CW_GB + 4096 * ((int)blockIdx.x & 7) + GB_XCNT(xb_xcc_id());
      if (threadIdx.x == 0) (void)__hip_atomic_fetch_add(gbp, 1u, __ATOMIC_RELAXED, __HIP_MEMORY_SCOPE_AGENT); }

    { MKFRAME(); Args a; a.ws = KA(ws); a.w_in = KA(w_in); a.w_out = KA(w_out); a.ffn_w_gate = KA(ffn_w_gate); a.ffn_w_up = KA(ffn_w_up); a.ffn_w_down = KA(ffn_w_down);
      a.moe_w_gate = KA(moe_w_gate); a.moe_w_up = KA(moe_w_up); a.moe_w_down = KA(moe_w_down); a.norm_mix_g = KA(norm_mix_g); a.norm_ffn_g = KA(norm_ffn_g);
#pragma unroll 1
      for (int rep = 0; rep < REP_PRO; ++rep) prologue_phase(a, F); }
    __syncthreads();
    for (int layer = 0; layer < DEPTH; ++layer) {
        const int j = layer >> 1; const bool moe = layer & 1;
        { MKFRAME();
            NormIn p{}; p.src = KA(x); p.src16 = (const bf16*)WSP(WS_H16); p.o2 = (layer == 2) ? (bf16*)WSP(WS_O2) : nullptr; p.hout16 = (layer == 0 || layer == 2) ? (bf16*)WSP(WS_H16) : nullptr; p.rs = (float*)WSP(WS_RS);
            p.gain = KA(norm_mix_g) + layer * DM; p.w8 = KA(w_in) + (size_t)layer * DM * PIN + 2048; p.ld8 = PIN; p.G = (float*)WSP(WS_G);
            if (layer == 0) norm_phase<0, false>(F, p); else norm_phase<0, true>(F, p);
        }
        if (layer == 0) GRID_BAR(); else GROUP_BAR();
        { MKFRAME();
            if (F.bid >= 128 && F.bid < 160) gate_scan(F, (F.bid & 7) * HM + ((F.bid >> 3) - 16), (float*)WSP(WS_G), KA(b_igate) + layer * HM, KA(b_fgate) + layer * HM, (float*)WSP(WS_GA), (float*)WSP(WS_GM), (float*)WSP(WS_GE), (float*)WSP(WS_TG));
            __syncthreads();
            pg8::EpiProj E{(bf16*)WSP(WS_PROJ), (const float*)WSP(WS_RS)};
            const int ngw = F.G >> 3, lw = F.bid >> 3, ntl = pg8::WGM * (NPROJ / pg8::BM);
            const int maxu = (ntl + ngw - 1) / ngw, h0 = ntl - (maxu - 1) * ngw, nh = ngw - h0;
            { pg8::InprojOrder S; S.init(WSP(WS_H16), (bf16*)WSP(WS_WIN) + (size_t)layer * NPROJ * DM, T, NPROJ, DM, F.G, F.bid, 0, 2);
              pg8::gemm_phase<pg8::EpiProj, pg8::InprojOrder, true>(F.lds + RING_OFF, S, E, F.tid); }
            asm volatile("s_waitcnt vmcnt(0)" ::: "memory");
            __syncthreads();
            { const unsigned xcc = xb_xcc_id(); gu32* gbp = F.ctl + CW_GB + 4096 * (F.bid & 7);
              if (F.tid == 0) group_arrive(gbp, F.MISC + 24, xcc, (unsigned)layer + 1u); }
            { pg8::InprojOrder S; S.init(WSP(WS_H16), (bf16*)WSP(WS_WIN) + (size_t)layer * NPROJ * DM, T, NPROJ, DM, F.G, F.bid, 2, maxu - 2);
              pg8::gemm_phase<pg8::EpiProj, pg8::InprojOrder, true>(F.lds + RING_OFF, S, E, F.tid); }
            if (nh == 0 || lw >= h0) {
                const int hidx = nh == 0 ? lw : lw - h0, nhe = nh == 0 ? ngw : nh;
                __syncthreads();
                { const unsigned xcc = xb_xcc_id(); gu32* gbp = F.ctl + CW_GB + 4096 * (F.bid & 7);
                  if (F.tid == 0) group_wait(gbp, F.MISC + 24, xcc, (unsigned)layer + 1u); }
                __syncthreads();
                conv_phase(F, (bf16*)WSP(WS_PROJ), KA(conv_w) + (size_t)layer * 4 * 1024, KA(conv_b) + (size_t)layer * 1024, (bf16*)WSP(WS_QKC), hidx, nhe);
#pragma unroll 1
                for (int ub = nhe - 1 - hidx; ub < HM * 7; ub += nhe) chunk_state_unit(F, (F.bid & 7) * HM + ub / 7, ub % 7, (bf16*)WSP(WS_PROJ), KA(conv_w) + (size_t)layer * 4 * 1024, KA(conv_b) + (size_t)layer * 1024,
                                                                   (float*)WSP(WS_GA), (float*)WSP(WS_TG), (bf16*)WSP(WS_U), (float*)WSP(WS_NV), (float*)WSP(WS_CM), (bf16*)WSP(WS_QKC));
            }
        }
        GROUP_BAR();
        { MKFRAME();
#if NAIVE_MIX == 1
            naive_sb(F, (bf16*)WSP(WS_PROJ), KA(g_sb) + layer * 512, (bf16*)WSP(WS_MIXED));
            naive_mlstm(F, (bf16*)WSP(WS_PROJ), (bf16*)WSP(WS_QKC), (float*)WSP(WS_GA), (float*)WSP(WS_GM), (float*)WSP(WS_GE), KA(g_mlstm) + layer * 512, (bf16*)WSP(WS_MIXED));
#else
#pragma unroll 1
            for (int rep = 0; rep < REP_MIX; ++rep) mixer_phase(kap, F.lds, wave_s, layer);
#endif
            __syncthreads();
        }
        GROUP_BAR();
        { MKFRAME();
            pg8::DenseOrder S; S.init(WSP(WS_MIXED), (bf16*)WSP(WS_WOUT) + (size_t)layer * DM * DM, T, DM, DM, F.G, F.bid);
            { pg8::EpiResid16<false> E{nullptr, (bf16*)WSP(WS_H16)}; pg8::gemm_phase<pg8::EpiResid16<false>, pg8::DenseOrder, true>(F.lds + RING_OFF, S, E, F.tid); }
        }
        GROUP_BAR();
        { MKFRAME();
            NormIn p{}; p.src16 = (const bf16*)WSP(WS_H16); p.gain = KA(norm_ffn_g) + layer * DM; p.rs = (float*)WSP(WS_RS);
            if (moe) { p.w8 = KA(w_router) + (size_t)j * DM * 8; p.ld8 = 8; p.cnt = (unsigned*)(F.ctl + CW_CNT + 64 * j); p.rinfo = (uint2*)WSP(WS_RINFO); p.cntw = (int*)WSP(WS_CNTW); p.rrec = (int*)WSP(WS_RREC); p.h8 = (unsigned char*)WSP(WS_H8);
                norm_phase<2, true>(F, p); }
            else norm_phase<1, true>(F, p);
        }
        if (moe) { GRID_BAR(); MKFRAME(); route_finish(F, (const int*)WSP(WS_CNTW), (const int*)WSP(WS_RREC), (uint2*)WSP(WS_RINFO), (const float*)WSP(WS_RS), (float*)WSP(WS_RSI)); }
        if (moe) GRID_BAR(); else GROUP_BAR();
        { MKFRAME(); volatile LAS int* tab = (volatile LAS int*)(F.MISC + 32);
            if (!moe) {
                pg8::DenseOrder S; S.init(WSP(WS_H16), (bf16*)WSP(WS_WGU) + (size_t)j * 2 * FFDP * DM, T, 2 * FFDP, DM, F.G, F.bid);
                pg8::EpiSwiglu E{(bf16*)WSP(WS_HID), FFDP, (const float*)WSP(WS_RS), nullptr};
#pragma unroll 1
                for (int rep = 0; rep < REP_DUP; ++rep) pg8::gemm_phase<pg8::EpiSwiglu, pg8::DenseOrder, true>(F.lds + RING_OFF, S, E, F.tid);
            } else {
                BUILD_TAB();
#if MOE_FP8
                pg8::MoeOrder<true> S; S.init(WSP(WS_H8), (unsigned char*)WSP(WS_MGU) + (size_t)j * 8 * 2 * FFE * DM, (size_t)2 * FFE * DM, 2 * FFE, DM / 2, F.G, F.bid, tab, (const uint2*)WSP(WS_RINFO));
                pg8::EpiSwiglu8 E{(unsigned char*)WSP(WS_HIDM), FFE, 1.0f / F8_WGU};
#pragma unroll 1
                for (int rep = 0; rep < REP_MOEUP; ++rep) pg8::gemm_phase<pg8::EpiSwiglu8, pg8::MoeOrder<true>, true>(F.lds + RING_OFF, S, E, F.tid);
#else
                pg8::MoeOrder<true> S; S.init(WSP(WS_H16), (bf16*)WSP(WS_MGU) + (size_t)j * 8 * 2 * FFE * DM, (size_t)2 * FFE * DM * 2, 2 * FFE, DM, F.G, F.bid, tab, (const uint2*)WSP(WS_RINFO));
                pg8::EpiSwiglu E{(bf16*)WSP(WS_HIDM), FFE, nullptr, (const float*)WSP(WS_RSI)};
#pragma unroll 1
                for (int rep = 0; rep < REP_MOEUP; ++rep) pg8::gemm_phase<pg8::EpiSwiglu, pg8::MoeOrder<true>, true>(F.lds + RING_OFF, S, E, F.tid);
#endif
            }
        }
        if (moe) GRID_BAR(); else GROUP_BAR();
        { MKFRAME(); volatile LAS int* tab = (volatile LAS int*)(F.MISC + 32);
            if (!moe) {
                pg8::DenseOrder S; S.init(WSP(WS_HID), (bf16*)WSP(WS_WD) + (size_t)j * DM * FFDP, T, DM, FFDP, F.G, F.bid);
                pg8::EpiResid16<false> E{nullptr, (bf16*)WSP(WS_H16)};
                pg8::gemm_phase<pg8::EpiResid16<false>, pg8::DenseOrder, true>(F.lds + RING_OFF, S, E, F.tid);
            } else {
                BUILD_TAB();
#if MOE_FP8
                pg8::MoeOrder<false> S; S.init(WSP(WS_HIDM), (unsigned char*)WSP(WS_MD) + (size_t)j * 8 * DM * FFE, (size_t)DM * FFE, DM, FFE / 2, F.G, F.bid, tab, (const uint2*)WSP(WS_RINFO));
                pg8::EpiScatter E{(bf16*)WSP(WS_O2), (const uint2*)WSP(WS_RINFO), 1.0f / (F8_HID * F8_WD)};
#else
                pg8::MoeOrder<false> S; S.init(WSP(WS_HIDM), (bf16*)WSP(WS_MD) + (size_t)j * 8 * DM * FFE, (size_t)DM * FFE * 2, DM, FFE, F.G, F.bid, tab, (const uint2*)WSP(WS_RINFO));
                pg8::EpiScatter E{(bf16*)WSP(WS_O2), (const uint2*)WSP(WS_RINFO), 1.0f};
#endif
#if MOE_TAIL_KS > 1
                const int rem = S.nwg % F.G, nmain = S.nwg - rem;
                pg8::MoeOrder<false> S0 = S; S0.nwg = nmain;
                pg8::gemm_phase<pg8::EpiScatter, pg8::MoeOrder<false>, true>(F.lds + RING_OFF, S0, E, F.tid);
                if (rem > 0 && F.bid < rem * MOE_TAIL_KS) {
                    pg8::MoeTailOrder ST; ST.init(S, nmain, rem, MOE_TAIL_KS, F.bid);
                    const int tl = F.bid % rem;
                    float* Pt = (float*)WSP(WS_Y) + (size_t)tl * MOE_TAIL_KS * 65536;
                    pg8::EpiPartial EP{Pt + (size_t)ST.slice * 65536};
                    pg8::gemm_phase<pg8::EpiPartial, pg8::MoeTailOrder, true>(F.lds + RING_OFF, ST, EP, F.tid);
                    asm volatile("s_waitcnt vmcnt(0)" ::: "memory");
                    __syncthreads();
                    if (F.tid == 0) { __builtin_amdgcn_fence(__ATOMIC_RELEASE, "agent");
                        const unsigned old_ = __hip_atomic_fetch_add(F.ctl + CW_TAIL + 32 * j + tl, 1u, __ATOMIC_RELAXED, __HIP_MEMORY_SCOPE_AGENT);
                        if (old_ == MOE_TAIL_KS - 1) __builtin_amdgcn_fence(__ATOMIC_ACQUIRE, "agent");
                        F.MISC[16] = old_; }
                    __syncthreads();
                    if (F.MISC[16] == MOE_TAIL_KS - 1) {
                        f32x4 acc[2][2][4][2];
#pragma unroll
                        for (int g = 0; g < 4; ++g) {
                            const float* pg = Pt + ((size_t)(g * 8) * 512 + F.tid) * 4; asm volatile("" : "+v"(pg));
#pragma unroll
                            for (int kh = 0; kh < 2; ++kh) {
                                f32x4 t[4][MOE_TAIL_KS];
#pragma unroll
                                for (int k2 = 0; k2 < 4; ++k2)
#pragma unroll
                                    for (int sl = 0; sl < MOE_TAIL_KS; ++sl) t[k2][sl] = *(const GAS f32x4*)(pg + (size_t)sl * 65536 + (4 * kh + k2) * 2048);
#pragma unroll
                                for (int k2 = 0; k2 < 4; ++k2)
#pragma unroll
                                    for (int sl = 0; sl < MOE_TAIL_KS; ++sl) asm volatile("" : "+v"(t[k2][sl]));
#pragma unroll
                                for (int k2 = 0; k2 < 4; ++k2) { f32x4 v = t[k2][0];
#pragma unroll
                                    for (int sl = 1; sl < MOE_TAIL_KS; ++sl) v += t[k2][sl];
                                    const int k = 4 * kh + k2; acc[g >> 1][g & 1][k >> 1][k & 1] = v; }
                            }
                            asm volatile("" : "+v"(acc[g >> 1][g & 1][0][0]), "+v"(acc[g >> 1][g & 1][0][1]), "+v"(acc[g >> 1][g & 1][1][0]), "+v"(acc[g >> 1][g & 1][1][1]),
                                              "+v"(acc[g >> 1][g & 1][2][0]), "+v"(acc[g >> 1][g & 1][2][1]), "+v"(acc[g >> 1][g & 1][3][0]), "+v"(acc[g >> 1][g & 1][3][1]));
                        }
                        pg8::Unit ut; ST.base.decode(ST.wgid, ut);
                        const int wid_ = F.tid >> 6, ln_ = F.tid & 63;
                        E(acc, ut, wid_ >> 2, wid_ & 3, ln_ & 15, ln_ >> 4);
                    }
                    __syncthreads();
                }
#else
#pragma unroll 1
                for (int rep = 0; rep < REP_MOEDN; ++rep) pg8::gemm_phase<pg8::EpiScatter, pg8::MoeOrder<false>, true>(F.lds + RING_OFF, S, E, F.tid);
#endif
            }
        }
        if (moe) GRID_BAR(); else GROUP_BAR();
    }
    { MKFRAME(); NormIn p{}; p.src16 = (const bf16*)WSP(WS_H16); p.o2 = (bf16*)WSP(WS_O2); p.hout = KA(out); p.gain = KA(norm_final_g); norm_phase<3, true>(F, p); }
}

extern "C" void kernel_launch(void* const* d_in, const int* in_sizes, int n_in, void* d_out, int out_size, void* d_ws, size_t ws_size, hipStream_t stream) {
    static int grid = 0;
    if (grid == 0) {
        if (n_in != 19 || in_sizes[0] != T * DM || out_size != T * DM || ws_size < WS_END) { fprintf(stderr, "kernel_launch: unexpected shapes / workspace (%d inputs, in0 %d, out %d, ws %zu)\n", n_in, n_in > 0 ? in_sizes[0] : -1, out_size, ws_size); grid = -1; return; }
        int dev = 0, cus = 0, per_cu = 0;
        if (hipGetDevice(&dev) != hipSuccess || hipDeviceGetAttribute(&cus, hipDeviceAttributeMultiprocessorCount, dev) != hipSuccess) { grid = -1; return; }
        if (hipFuncSetAttribute((const void*)mk_fwd, hipFuncAttributeMaxDynamicSharedMemorySize, LDS_BYTES) != hipSuccess) { grid = -1; return; }
        if (hipOccupancyMaxActiveBlocksPerMultiprocessor(&per_cu, (const void*)mk_fwd, NTHREADS, LDS_BYTES) != hipSuccess || per_cu < 1) fprintf(stderr, "kernel_launch: occupancy query says %d\n", per_cu);
        (void)hipGetLastError();
        grid = cus - cus % 8;
        if (grid < 160) { fprintf(stderr, "kernel_launch: %d compute units: this kernel needs at least 160\n", cus); grid = -1; return; }
    }
    if (grid < 0) return;
    if (hipMemsetAsync((char*)d_ws + WS_CTL, 0, CTL_ZERO_BYTES, stream) != hipSuccess) return;
    Args a{};
    a.x = (const float*)d_in[0]; a.norm_mix_g = (const float*)d_in[1]; a.w_in = (const float*)d_in[2]; a.b_igate = (const float*)d_in[3]; a.b_fgate = (const float*)d_in[4];
    a.conv_w = (const float*)d_in[5]; a.conv_b = (const float*)d_in[6]; a.g_mlstm = (const float*)d_in[7]; a.g_sb = (const float*)d_in[8]; a.w_out = (const float*)d_in[9];
    a.norm_ffn_g = (const float*)d_in[10]; a.ffn_w_gate = (const float*)d_in[11]; a.ffn_w_up = (const float*)d_in[12]; a.ffn_w_down = (const float*)d_in[13];
    a.w_router = (const float*)d_in[14]; a.moe_w_gate = (const float*)d_in[15]; a.moe_w_up = (const float*)d_in[16]; a.moe_w_down = (const float*)d_in[17]; a.norm_final_g = (const float*)d_in[18];
    a.out = (float*)d_out; a.ws = (unsigned char*)d_ws; a.ph_lo = 0; a.ph_hi = 0;
    hipLaunchKernelGGL(mk_fwd, dim3(grid), dim3(NTHREADS), LDS_BYTES, stream, a);
}
```

```cpp
#include <hip/hip_runtime.h>
#include <cstdio>
#include <cstdint>

#ifndef REP_PRO
#define REP_PRO 1
#endif
#ifndef REP_MIX
#define REP_MIX 1
#endif
#ifndef REP_INPROJ
#define REP_INPROJ 1
#endif
#ifndef REP_DUP
#define REP_DUP 1
#endif
#ifndef REP_MOEUP
#define REP_MOEUP 1
#endif
#ifndef REP_MOEDN
#define REP_MOEDN 1
#endif
#ifndef REP_CONV
#define REP_CONV 1
#endif
#ifndef MX_LATE
#define MX_LATE 0
#endif
#ifndef ML_CHUNK
#define ML_CHUNK 1
#endif
#ifndef MOE_FP8
#define MOE_FP8 1
#endif
#ifndef DENSE_F8_MASK
#define DENSE_F8_MASK 2
#endif
#define DENSE_FP8 (DENSE_F8_MASK != 0)
#ifndef MOE_TAIL_KS
#define MOE_TAIL_KS (MOE_FP8 ? 2 : 4)
#endif
#ifndef CONV_NOBAR
#define CONV_NOBAR 0
#endif
#ifndef NAIVE_MIX
#define NAIVE_MIX 0
#endif

constexpr int T = 16384, DM = 1024, SEQ = 2048, NBATCH = 8, DEPTH = 4;
constexpr int PIN = 3592, NPROJ = 3584;
constexpr int FFD = 2752, FFDP = 2816, FFE = 3584, NEXP = 8;
constexpr int HM = 4, DHM = 128, HS = 8, DHS = 64;
constexpr float EPS = 1e-6f;
constexpr float LOG2E = 1.4426950408889634f;
constexpr float QS_SCALE = 0.125f * LOG2E;
constexpr float KM_SCALE = 0.08838834764831845f;
constexpr int NWAVES = 8, NTHREADS = 512;
constexpr float F8_WGU = 64.0f, F8_WD = 128.0f, F8_HID = 8.0f, F8_MAX = 448.0f;

constexpr size_t MiB = 1u << 20;
constexpr size_t WS_CTL = 0, CTL_ZERO_BYTES = 1 * MiB;
constexpr size_t WS_WIN = 1 * MiB;
constexpr size_t WS_WOUT = 29 * MiB;
constexpr size_t WS_WGU = 37 * MiB;
constexpr size_t WS_WD = 59 * MiB;
constexpr size_t WS_MGU = 70 * MiB;
constexpr size_t WS_H8 = WS_MGU + 112 * MiB;
constexpr size_t WS_MD = 294 * MiB;
constexpr size_t WS_Y = 406 * MiB;
constexpr size_t WS_MIXED = 438 * MiB;
constexpr size_t WS_G = 470 * MiB;
constexpr size_t WS_GA = WS_G + 512 * 1024, WS_GM = WS_GA + 256 * 1024, WS_GE = WS_GM + 256 * 1024, WS_TG = WS_GE + 256 * 1024;
constexpr size_t WS_RINFO = 472 * MiB;
constexpr size_t WS_O2 = 474 * MiB;
constexpr size_t WS_BIG = 538 * MiB;
constexpr size_t WS_PROJ = WS_BIG, WS_QKC = WS_BIG + 112 * MiB, WS_HIDM = WS_BIG;
constexpr size_t WS_U = WS_BIG + 238 * MiB;
constexpr size_t WS_NV = WS_U + 15 * MiB, WS_CM = WS_NV + 128 * 1024;
constexpr size_t WS_RREC = WS_CM + 128 * 1024, WS_CNTW = WS_RREC + 512 * 1024;
constexpr size_t WS_HID = WS_BIG + 144 * MiB;
constexpr size_t WS_H16 = WS_U + 16 * MiB;
constexpr size_t WS_RS = WS_H16 + 32 * MiB, WS_RSI = WS_RS + 64 * 1024;
constexpr size_t WS_END = WS_H16 + 33 * MiB;
constexpr int HIDM_ROWS = 2 * T + 2048;
static_assert((size_t)HIDM_ROWS * FFE * 2 <= 238 * MiB, "hidm");
constexpr int CW_TMO = 0;
constexpr int CW_CNT = 64;
constexpr int CW_BAR = 4096;
constexpr int CW_INP = 3264;
constexpr int CW_CONV = 3200;
constexpr int CW_GB = 8192;
constexpr int CW_TAIL = 2048;

constexpr int RING_OFF = 0, RING_BYTES = 131072;
constexpr int MISC_OFF = 155648;
constexpr int LDS_BYTES = 163840;

#define GAS __attribute__((address_space(1)))
#define LAS __attribute__((address_space(3)))
typedef unsigned short bf16;
typedef unsigned v4u __attribute__((ext_vector_type(4)));
typedef unsigned v2u __attribute__((ext_vector_type(2)));
typedef float f32x4 __attribute__((ext_vector_type(4)));
typedef int i32x4 __attribute__((ext_vector_type(4)));
typedef float f32x2 __attribute__((ext_vector_type(2)));
typedef short bf16x8 __attribute__((ext_vector_type(8)));
typedef int i32x8 __attribute__((ext_vector_type(8)));
typedef GAS unsigned gu32;
#define RLX_AGENT __ATOMIC_RELAXED, __HIP_MEMORY_SCOPE_AGENT
#define LDS_WAIT() asm volatile("s_waitcnt lgkmcnt(0)" ::: "memory")
#define VM_WAIT() asm volatile("s_waitcnt vmcnt(0)" ::: "memory")

__device__ __forceinline__ unsigned f2bf(float f) { unsigned u = __builtin_bit_cast(unsigned, f); return (u + 0x7fffu + ((u >> 16) & 1u)) >> 16; }
__device__ __forceinline__ unsigned pk2(float lo, float hi) { return f2bf(lo) | (f2bf(hi) << 16); }
__device__ __forceinline__ unsigned pk4_f8(float a, float b, float c, float d) { int w = __builtin_amdgcn_cvt_pk_fp8_f32(a, b, 0, false); w = __builtin_amdgcn_cvt_pk_fp8_f32(c, d, w, true); return (unsigned)w; }
__device__ __forceinline__ float bf2f(unsigned b) { return __builtin_bit_cast(float, b << 16); }
__device__ __forceinline__ float bflo(unsigned w) { return __builtin_bit_cast(float, w << 16); }
__device__ __forceinline__ float bfhi(unsigned w) { return __builtin_bit_cast(float, w & 0xffff0000u); }
__device__ __forceinline__ int lane_id() { return (int)__builtin_amdgcn_mbcnt_hi(~0u, __builtin_amdgcn_mbcnt_lo(~0u, 0u)); }
#define dpp_f(old, src, ctrl, rmask) __builtin_bit_cast(float, __builtin_amdgcn_update_dpp(__builtin_bit_cast(int, (float)(old)), __builtin_bit_cast(int, (float)(src)), ctrl, rmask, 0xf, false))
__device__ __forceinline__ float sxor32(float v, int hi) { auto rr = __builtin_amdgcn_permlane32_swap(__builtin_bit_cast(unsigned, v), __builtin_bit_cast(unsigned, v), false, false);
    return __builtin_bit_cast(float, hi ? rr[0] : rr[1]); }
__device__ __forceinline__ float quad_sum(float v) { v += dpp_f(0.f, v, 0xB1, 0xf); v += dpp_f(0.f, v, 0x4E, 0xf); return v; }
__device__ __forceinline__ float oct_sum(float v, int lane) { v = quad_sum(v); const float dn = dpp_f(0.f, v, 0x114, 0xf), up = dpp_f(0.f, v, 0x104, 0xf); return v + ((lane & 4) ? dn : up); }
#define DPP_SCAN(v, OP, ID) do { v = OP(v, __builtin_bit_cast(float, __builtin_amdgcn_update_dpp(__builtin_bit_cast(int, ID), __builtin_bit_cast(int, v), 0x111, 0xf, 0xf, false))); \
    v = OP(v, __builtin_bit_cast(float, __builtin_amdgcn_update_dpp(__builtin_bit_cast(int, ID), __builtin_bit_cast(int, v), 0x112, 0xf, 0xf, false))); \
    v = OP(v, __builtin_bit_cast(float, __builtin_amdgcn_update_dpp(__builtin_bit_cast(int, ID), __builtin_bit_cast(int, v), 0x114, 0xf, 0xf, false))); \
    v = OP(v, __builtin_bit_cast(float, __builtin_amdgcn_update_dpp(__builtin_bit_cast(int, ID), __builtin_bit_cast(int, v), 0x118, 0xf, 0xf, false))); \
    v = OP(v, __builtin_bit_cast(float, __builtin_amdgcn_update_dpp(__builtin_bit_cast(int, ID), __builtin_bit_cast(int, v), 0x142, 0xa, 0xf, false))); \
    v = OP(v, __builtin_bit_cast(float, __builtin_amdgcn_update_dpp(__builtin_bit_cast(int, ID), __builtin_bit_cast(int, v), 0x143, 0xc, 0xf, false))); } while (0)
#define OP_ADD(a, b) ((a) + (b))
#define OP_MAX(a, b) fmaxf((a), (b))
__device__ __forceinline__ float wave_sum(float v) { DPP_SCAN(v, OP_ADD, 0.0f); return __builtin_bit_cast(float, __builtin_amdgcn_readlane(__builtin_bit_cast(int, v), 63)); }

namespace pg8 {
#define PG8_LAS __attribute__((address_space(3)))
typedef unsigned short bf16_t;
typedef unsigned u32x4 __attribute__((ext_vector_type(4)));
constexpr int BM = 256, BK = 64, HALF = 128, HTB = HALF * BK * 2, STAGE_BYTES = 8 * HTB, NXCD = 8, WGM = 8;

__host__ __device__ __forceinline__ int lds_byte(int r, int c) { const int st = (r >> 4) * 2 + (c >> 5), rr = r & 15, cc = c & 31, ob = rr * 64 + cc * 2; return st * 1024 + (ob ^ (((ob >> 9) & 1) << 5)); }
__host__ __device__ __forceinline__ void stage_rc(int b, int& R, int& C) { const int st = b / 1024, sb = b % 1024, swz = sb ^ (((sb >> 9) & 1) << 5); R = (st >> 1) * 16 + swz / 64; C = (st & 1) * 32 + (swz % 64) / 2; }
__host__ __device__ __forceinline__ int perm32(int rho) { const int n = rho >> 4, i = rho & 15; return 8 * (i >> 2) + 4 * n + (i & 3); }

struct Unit { int pm, pn, e, pml, nvalid; };

__device__ __forceinline__ void tile_decode(int wgid, int nM, int nN, int& pm, int& pn) {
    const int nig = WGM * nN, gid = wgid / nig, fm = gid * WGM, gsz = (nM - fm) < WGM ? (nM - fm) : WGM;
    pm = fm + ((wgid % nig) % gsz); pn = (wgid % nig) / gsz;
}
__device__ __forceinline__ int xcd_remap(int L, int nwg) { const int q = nwg / NXCD, r = nwg % NXCD, xcd = L % NXCD, off = L / NXCD; return (xcd < r ? xcd * (q + 1) : r * (q + 1) + (xcd - r) * q) + off; }

template <bool F8> struct DenseOrderT {
    static constexpr bool GATHER = false, FP8 = F8;
    const char* A; const char* B; int K, KT; int nM, nN, nwg, G, c;
    __device__ void init(const void* A_, const void* B_, int M, int N, int K_, int G_, int c_) { A = (const char*)A_; B = (const char*)B_; K = K_; KT = K_ / BK; nM = M / BM; nN = N / BM; nwg = nM * nN; G = G_; c = c_; }
    __device__ __forceinline__ bool next(int i, Unit& u) const {
        const long L = (long)i * G + c; if (L >= nwg) return false;
        const int wgid = xcd_remap((int)L, nwg); tile_decode(wgid, nM, nN, u.pm, u.pn); u.e = 0; u.pml = u.pm; u.nvalid = BM; return true;
    }
    __device__ __forceinline__ const char* a_ptr(const Unit& u) const { return A + (size_t)u.pm * ((size_t)BM * K * 2); }
    __device__ __forceinline__ const char* b_ptr(const Unit& u) const { return B + (size_t)u.pn * ((size_t)BM * K * 2); }
    __device__ __forceinline__ unsigned grow(const Unit&, int) const { return 0u; }
    __device__ __forceinline__ const unsigned* rptr(const Unit&, int) const { return nullptr; }
};
typedef DenseOrderT<false> DenseOrder;
struct InprojOrder {
    static constexpr bool GATHER = false, FP8 = false;
    const char* A; const char* B; int K, KT, nM, nN, G, c, i0, ni;
    __device__ void init(const void* A_, const void* B_, int M, int N, int K_, int G_, int c_, int i0_, int ni_) { A = (const char*)A_; B = (const char*)B_; K = K_; KT = K_ / BK; nM = M / BM; nN = N / BM; G = G_; c = c_; i0 = i0_; ni = ni_; }
    __device__ __forceinline__ bool next(int i, Unit& u) const {
        if (i >= ni) return false;
        const int off = (i0 + i) * (G >> 3) + (c >> 3); if (off >= WGM * nN) return false;
        tile_decode((c & 7) * WGM * nN + off, nM, nN, u.pm, u.pn); u.e = 0; u.pml = u.pm; u.nvalid = BM; return true;
    }
    __device__ __forceinline__ const char* a_ptr(const Unit& u) const { return A + (size_t)u.pm * ((size_t)BM * K * 2); }
    __device__ __forceinline__ const char* b_ptr(const Unit& u) const { return B + (size_t)u.pn * ((size_t)BM * K * 2); }
    __device__ __forceinline__ unsigned grow(const Unit&, int) const { return 0u; }
    __device__ __forceinline__ const unsigned* rptr(const Unit&, int) const { return nullptr; }
};
template <bool GATH> struct MoeOrder {
    static constexpr bool GATHER = GATH, FP8 = MOE_FP8 != 0;

    const char* A; const char* B; int K, KT; size_t bstride; int nN, nwg, G, c; const volatile LAS int* tab; const uint2* rinfo;
    __device__ void init(const void* A_, const void* B_, size_t bstride_, int N, int K_, int G_, int c_, const volatile LAS int* tab_, const uint2* rinfo_) {
        A = (const char*)A_; B = (const char*)B_; K = K_; KT = K_ / BK; bstride = bstride_; nN = N / BM; G = G_; c = c_; tab = tab_; rinfo = rinfo_; nwg = tab_[8] * nN; }
    __device__ __forceinline__ bool next(int i, Unit& u) const {
        const long L = (long)i * G + c; if (L >= nwg) return false;
        decode(xcd_remap((int)L, nwg), u); return true;
    }
    __device__ __forceinline__ void decode(const int wgid, Unit& u) const {
        int e = 0;
#pragma unroll
        for (int j = 1; j < 8; ++j) if (wgid >= tab[j] * nN) e = j;
        const int t0 = tab[e], nMe = tab[e + 1] - t0, cnt = tab[16 + e];
        int pml, pn;
        if (GATH) {
            const int ng = (nMe + WGM - 1) / WGM, bs = nMe / ng, ex = nMe - bs * ng, big = (bs + 1) * 4;
            int w = wgid - t0 * nN, fm, gsz;
            const int cb = w / (4 * nMe); w -= cb * 4 * nMe;
            if (w < ex * big) { const int g = w / big; w -= g * big; gsz = bs + 1; fm = g * (bs + 1); }
            else { w -= ex * big; const int g = w / (bs * 4); w -= g * bs * 4; gsz = bs; fm = ex * (bs + 1) + g * bs; }
            pml = fm + w % gsz; pn = 4 * cb + w / gsz;
        } else tile_decode(wgid - t0 * nN, nMe, nN, pml, pn);
        u.e = __builtin_amdgcn_readfirstlane(e); u.pml = __builtin_amdgcn_readfirstlane(pml); u.pn = __builtin_amdgcn_readfirstlane(pn); u.pm = __builtin_amdgcn_readfirstlane(t0 + pml);
        const int nv = cnt - pml * BM; u.nvalid = __builtin_amdgcn_readfirstlane(nv < BM ? nv : BM);
    }
    __device__ __forceinline__ const char* a_ptr(const Unit& u) const { return GATH ? A : A + (size_t)u.pm * ((size_t)BM * K * 2); }
    __device__ __forceinline__ const char* b_ptr(const Unit& u) const { return B + (size_t)u.e * bstride + (size_t)u.pn * ((size_t)BM * K * 2); }
    __device__ __forceinline__ const unsigned* rptr(const Unit& u, int r) const { const int rr = r < u.nvalid ? r : u.nvalid - 1; return (const unsigned*)(rinfo + (size_t)u.e * T + (size_t)u.pml * BM + rr); }
    __device__ __forceinline__ unsigned grow(const Unit& u, int r) const {
        const int rr = r < u.nvalid ? r : u.nvalid - 1;
        const unsigned ts = rinfo[(size_t)u.e * T + (size_t)u.pml * BM + rr].x;
        return (ts >> 1) * (unsigned)(K * 2);
    }
};

__device__ __forceinline__ const char* uni_ptr(const char* p) { const unsigned long long v = (unsigned long long)p; const unsigned lo = __builtin_amdgcn_readfirstlane((unsigned)v), hi = __builtin_amdgcn_readfirstlane((unsigned)(v >> 32));
    return (const char*)(((unsigned long long)hi << 32) | lo); }
__device__ __forceinline__ unsigned cvt_pk_bf16(float lo, float hi) { unsigned r; asm volatile("v_cvt_pk_bf16_f32 %0, %1, %2" : "=v"(r) : "v"(lo), "v"(hi)); return r; }

struct EpiProj {
    static constexpr bool PERM = true, RSLDS = true;
    bf16_t* O; const float* RS;
    __device__ __forceinline__ const float* rs_base(const Unit& u) const { return RS + (size_t)u.pm * BM; }
    __device__ __forceinline__ void operator()(const f32x4 (&acc)[2][2][4][2], const Unit& u, int wr, int wc, int fr, int fq, const PG8_LAS float* rsl) const {
        const int row0 = u.pm * BM + wr * 64 + fr, col0 = u.pn * BM + wc * 64 + 8 * fq;
        const float sc0 = (u.pn == 8 || u.pn == 9) ? QS_SCALE : 1.0f;
        float rsv[2][4];
#pragma unroll
        for (int ai = 0; ai < 2; ++ai)
#pragma unroll
            for (int m = 0; m < 4; ++m) rsv[ai][m] = rsl[wr * 64 + fr + ai * HALF + m * 16];
#pragma unroll
        for (int ai = 0; ai < 2; ++ai)
#pragma unroll
            for (int m = 0; m < 4; ++m) { bf16_t* rowp = O + (size_t)(row0 + ai * HALF + m * 16) * NPROJ + col0; const float sc = sc0 * rsv[ai][m];
#pragma unroll
                for (int bj = 0; bj < 2; ++bj) { const f32x4 v0 = acc[ai][bj][m][0] * sc, v1 = acc[ai][bj][m][1] * sc;
                    u32x4 w; w.x = cvt_pk_bf16(v0[0], v0[1]); w.y = cvt_pk_bf16(v0[2], v0[3]); w.z = cvt_pk_bf16(v1[0], v1[1]); w.w = cvt_pk_bf16(v1[2], v1[3]);
                    *(u32x4*)(rowp + bj * 32) = w; } }
    }
};
struct EpiResid {
    static constexpr bool PERM = false, RSLDS = false;
    const float* Hin; float* Hout;
    __device__ __forceinline__ void operator()(const f32x4 (&acc)[2][2][4][2], const Unit& u, int wr, int wc, int fr, int fq) const {
        const int row0 = u.pm * BM + wr * 64 + fr, col0 = u.pn * BM + wc * 32 + 4 * fq;
#pragma unroll
        for (int ai = 0; ai < 2; ++ai)
#pragma unroll
            for (int mh = 0; mh < 2; ++mh) {
                f32x4 hv[2][2][2];
#pragma unroll
                for (int m2 = 0; m2 < 2; ++m2) { const size_t off = (size_t)(row0 + ai * HALF + (2 * mh + m2) * 16) * DM + col0;
#pragma unroll
                    for (int bj = 0; bj < 2; ++bj)
#pragma unroll
                        for (int n = 0; n < 2; ++n) hv[m2][bj][n] = *(const f32x4*)(Hin + off + bj * HALF + n * 16); }
                asm volatile("" : "+v"(hv[0][0][0]), "+v"(hv[0][0][1]), "+v"(hv[0][1][0]), "+v"(hv[0][1][1]), "+v"(hv[1][0][0]), "+v"(hv[1][0][1]), "+v"(hv[1][1][0]), "+v"(hv[1][1][1]));
#pragma unroll
                for (int m2 = 0; m2 < 2; ++m2) { const size_t off = (size_t)(row0 + ai * HALF + (2 * mh + m2) * 16) * DM + col0;
#pragma unroll
                    for (int bj = 0; bj < 2; ++bj)
#pragma unroll
                        for (int n = 0; n < 2; ++n) *(f32x4*)(Hout + off + bj * HALF + n * 16) = hv[m2][bj][n] + acc[ai][bj][2 * mh + m2][n]; }
            }
    }
};
template <bool XIN> struct EpiResid16 {
    static constexpr bool PERM = true, RSLDS = false;
    const float* X; bf16_t* H; float sc;
    __device__ __forceinline__ void operator()(const f32x4 (&acc)[2][2][4][2], const Unit& u, int wr, int wc, int fr, int fq) const {
        const int row0 = u.pm * BM + wr * 64 + fr, col0 = u.pn * BM + wc * 64 + 8 * fq;
#pragma unroll
        for (int ai = 0; ai < 2; ++ai) {
            u32x4 hb[4][2];
#pragma unroll
            for (int m = 0; m < 4; ++m)
#pragma unroll
                for (int bj = 0; bj < 2; ++bj) hb[m][bj] = *(const u32x4*)(H + (size_t)(row0 + ai * HALF + m * 16) * DM + col0 + bj * 32);
            asm volatile("" : "+v"(hb[0][0]), "+v"(hb[0][1]), "+v"(hb[1][0]), "+v"(hb[1][1]), "+v"(hb[2][0]), "+v"(hb[2][1]), "+v"(hb[3][0]), "+v"(hb[3][1]));
#pragma unroll
            for (int m = 0; m < 4; ++m)
#pragma unroll
                for (int bj = 0; bj < 2; ++bj) { const u32x4 b = hb[m][bj];
                    const f32x4 h0 = (f32x4){__builtin_bit_cast(float, b.x << 16), __builtin_bit_cast(float, b.x & 0xffff0000u), __builtin_bit_cast(float, b.y << 16), __builtin_bit_cast(float, b.y & 0xffff0000u)};
                    const f32x4 h1 = (f32x4){__builtin_bit_cast(float, b.z << 16), __builtin_bit_cast(float, b.z & 0xffff0000u), __builtin_bit_cast(float, b.w << 16), __builtin_bit_cast(float, b.w & 0xffff0000u)};
                    const f32x4 r0 = h0 + acc[ai][bj][m][0] * sc, r1 = h1 + acc[ai][bj][m][1] * sc;
                    u32x4 w; w.x = cvt_pk_bf16(r0[0], r0[1]); w.y = cvt_pk_bf16(r0[2], r0[3]); w.z = cvt_pk_bf16(r1[0], r1[1]); w.w = cvt_pk_bf16(r1[2], r1[3]);
                    *(u32x4*)(H + (size_t)(row0 + ai * HALF + m * 16) * DM + col0 + bj * 32) = w; }
        }
    }
};
__device__ __forceinline__ float silu_mul(float g, float u) { return g * u * __builtin_amdgcn_rcpf(1.0f + __builtin_amdgcn_exp2f(-g * LOG2E)); }
struct EpiSwiglu {
    static constexpr bool PERM = true, RSLDS = true;
    bf16_t* O; int ld; const float* RS; const float* RSI;
    __device__ __forceinline__ const float* rs_base(const Unit& u) const { return RSI ? RSI + (size_t)u.e * T + (size_t)u.pml * BM : RS + (size_t)u.pm * BM; }
    __device__ __forceinline__ void operator()(const f32x4 (&acc)[2][2][4][2], const Unit& u, int wr, int wc, int fr, int fq, const PG8_LAS float* rsl) const {
        const int row0 = u.pm * BM + wr * 64 + fr, col0 = u.pn * HALF + wc * 32 + 8 * fq;
        float rsv[2][4];
#pragma unroll
        for (int ai = 0; ai < 2; ++ai)
#pragma unroll
            for (int m = 0; m < 4; ++m) rsv[ai][m] = rsl[wr * 64 + fr + ai * HALF + m * 16];
#pragma unroll
        for (int ai = 0; ai < 2; ++ai)
#pragma unroll
            for (int m = 0; m < 4; ++m) { bf16_t* rowp = O + (size_t)(row0 + ai * HALF + m * 16) * ld + col0; const float rs = rsv[ai][m];
                const f32x4 g0 = acc[ai][0][m][0] * rs, g1 = acc[ai][0][m][1] * rs, u0 = acc[ai][1][m][0] * rs, u1 = acc[ai][1][m][1] * rs;
                u32x4 w; w.x = cvt_pk_bf16(silu_mul(g0[0], u0[0]), silu_mul(g0[1], u0[1])); w.y = cvt_pk_bf16(silu_mul(g0[2], u0[2]), silu_mul(g0[3], u0[3]));
                w.z = cvt_pk_bf16(silu_mul(g1[0], u1[0]), silu_mul(g1[1], u1[1])); w.w = cvt_pk_bf16(silu_mul(g1[2], u1[2]), silu_mul(g1[3], u1[3]));
                *(u32x4*)rowp = w; }
    }
};
struct EpiSwiglu8 {
    static constexpr bool PERM = true, RSLDS = false;
    unsigned char* O; int ld; float sc;
    __device__ __forceinline__ void operator()(const f32x4 (&acc)[2][2][4][2], const Unit& u, int wr, int wc, int fr, int fq) const {
        const int row0 = u.pm * BM + wr * 64 + fr, col0 = u.pn * HALF + wc * 32 + 8 * fq;
#pragma unroll
        for (int ai = 0; ai < 2; ++ai)
#pragma unroll
            for (int m = 0; m < 4; ++m) { unsigned char* rowp = O + (size_t)(row0 + ai * HALF + m * 16) * ld + col0;
                const f32x4 g0 = acc[ai][0][m][0] * sc, g1 = acc[ai][0][m][1] * sc, u0 = acc[ai][1][m][0] * (sc * F8_HID), u1 = acc[ai][1][m][1] * (sc * F8_HID);
                float h[8];
#pragma unroll
                for (int q = 0; q < 4; ++q) { h[q] = __builtin_fminf(__builtin_fmaxf(silu_mul(g0[q], u0[q]), -F8_MAX), F8_MAX); h[4 + q] = __builtin_fminf(__builtin_fmaxf(silu_mul(g1[q], u1[q]), -F8_MAX), F8_MAX); }
                typedef unsigned u32x2_ __attribute__((ext_vector_type(2)));
                *(u32x2_*)rowp = (u32x2_){pk4_f8(h[0], h[1], h[2], h[3]), pk4_f8(h[4], h[5], h[6], h[7])}; }
    }
};
struct EpiScatter {
    static constexpr bool PERM = true, RSLDS = false;
    bf16_t* O2; const uint2* rinfo; float sc;
    __device__ __forceinline__ void operator()(const f32x4 (&acc)[2][2][4][2], const Unit& u, int wr, int wc, int fr, int fq) const {
        const int col0 = u.pn * BM + wc * 64 + 8 * fq;
        uint2 inf[2][4];
#pragma unroll
        for (int ai = 0; ai < 2; ++ai)
#pragma unroll
            for (int m = 0; m < 4; ++m) { const int rl = ai * HALF + wr * 64 + m * 16 + fr; const int rc = rl < u.nvalid ? rl : u.nvalid - 1;
                inf[ai][m] = rinfo[(size_t)u.e * T + (size_t)u.pml * BM + rc]; }
#pragma unroll
        for (int ai = 0; ai < 2; ++ai)
#pragma unroll
            for (int m = 0; m < 4; ++m) asm volatile("" : "+v"(inf[ai][m].x), "+v"(inf[ai][m].y));
#pragma unroll
        for (int ai = 0; ai < 2; ++ai)
#pragma unroll
            for (int m = 0; m < 4; ++m) { const int rl = ai * HALF + wr * 64 + m * 16 + fr;
                if (rl < u.nvalid) { const float wgt = __builtin_bit_cast(float, inf[ai][m].y) * sc;
                    bf16_t* rowp = O2 + ((size_t)(inf[ai][m].x & 1u) * T + (size_t)(inf[ai][m].x >> 1)) * DM + col0;
#pragma unroll
                    for (int bj = 0; bj < 2; ++bj) { const f32x4 v0 = acc[ai][bj][m][0] * wgt, v1 = acc[ai][bj][m][1] * wgt;
                        u32x4 w; w.x = cvt_pk_bf16(v0[0], v0[1]); w.y = cvt_pk_bf16(v0[2], v0[3]); w.z = cvt_pk_bf16(v1[0], v1[1]); w.w = cvt_pk_bf16(v1[2], v1[3]);
                        *(u32x4*)(rowp + bj * 32) = w; } } }
    }
};

struct MoeTailOrder {
    static constexpr bool GATHER = false, FP8 = MOE_FP8 != 0;
    MoeOrder<false> base; const char* A; const char* B; int K, KT, slice, wgid; bool have;
    __device__ void init(const MoeOrder<false>& b, int nmain, int rem, int ks, int c) { base = b; A = b.A; B = b.B; K = b.K; KT = b.KT / ks; have = c < rem * ks; slice = c / (rem > 0 ? rem : 1); wgid = nmain + c % (rem > 0 ? rem : 1); }
    __device__ __forceinline__ bool next(int i, Unit& u) const { if (i != 0 || !have) return false; base.decode(wgid, u); return true; }
    __device__ __forceinline__ const char* a_ptr(const Unit& u) const { return base.a_ptr(u) + (size_t)slice * KT * (BK * 2); }
    __device__ __forceinline__ const char* b_ptr(const Unit& u) const { return base.b_ptr(u) + (size_t)slice * KT * (BK * 2); }
    __device__ __forceinline__ unsigned grow(const Unit&, int) const { return 0u; }
    __device__ __forceinline__ const unsigned* rptr(const Unit&, int) const { return nullptr; }
};
struct EpiPartial {
    static constexpr bool PERM = true, RSLDS = false;
    float* P;
    __device__ __forceinline__ void operator()(const f32x4 (&acc)[2][2][4][2], const Unit&, int wr, int wc, int fr, int fq) const {
        const int tid = (wr * 4 + wc) * 64 + fq * 16 + fr;
#pragma unroll
        for (int ai = 0; ai < 2; ++ai)
#pragma unroll
            for (int bj = 0; bj < 2; ++bj)
#pragma unroll
                for (int m = 0; m < 4; ++m)
#pragma unroll
                    for (int n = 0; n < 2; ++n) *(f32x4*)(P + ((size_t)((((ai * 2 + bj) * 4 + m) * 2 + n) * 512 + tid)) * 4) = acc[ai][bj][m][n];
    }
};

template <class Epi, class Sched, bool ALIGN_EPI>
__device__ __forceinline__ void gemm_phase(PG8_LAS unsigned char* lds, const Sched& S, const Epi& E, const int tid) {
    const int wid = __builtin_amdgcn_readfirstlane(tid >> 6), lane = tid & 63, wr = wid >> 2, wc = wid & 3, fr = lane & 15, fq = lane >> 4;
    const int K = S.K, nt = S.KT;
    constexpr bool GA = Sched::GATHER;
    unsigned voffA[2], voffB[2]; int RA[2], CA[2];
#pragma unroll
    for (int i = 0; i < 2; ++i) { int R, C; stage_rc(tid * 16 + i * 8192, R, C); const int Rb = Epi::PERM ? ((R >> 5) * 64 + perm32(R & 31)) : R;
        RA[i] = R; CA[i] = C; voffA[i] = GA ? (unsigned)(C * 2) : (unsigned)(R * K + C) * 2u; voffB[i] = (unsigned)(Rb * K + C) * 2u; }
    const size_t kstep = (size_t)(BK * 2);
    const size_t hstep = (size_t)HALF * K * 2;
    const size_t hstepB = Epi::PERM ? (size_t)32 * K * 2 : hstep;
    const unsigned ldsw = (unsigned)wid * 1024u;
    const int aoff = lds_byte(wr * 64 + fr, fq * 8), boff = lds_byte(wc * 32 + fr, fq * 8);
#define PG8_SA(b, h) (((b) * 2 + (h)) * HTB)
#define PG8_SB(b, h) ((4 + (b) * 2 + (h)) * HTB)
#define PG8_STAGE(bufoff, gbase, voff) do { const char* _g = (const char*)(gbase); asm volatile("" : "+s"(_g)); _Pragma("unroll") for (int _i = 0; _i < 2; ++_i) { unsigned _v = (voff)[_i]; asm volatile("" : "+v"(_v)); \
        __builtin_amdgcn_global_load_lds((const unsigned*)(_g + _v), (PG8_LAS unsigned*)(lds + (bufoff) + ldsw + _i * 8192), 16, 0, 0); } } while (0)
#define PG8_STAGE_A(bufoff, kb, h, NX) do { if constexpr (GA) { const char* _g = (const char*)(kb); asm volatile("" : "+s"(_g)); _Pragma("unroll") for (int _i = 0; _i < 2; ++_i) { unsigned _o = ((NX) ? gnx[h][_i] : gcu[h][_i]) + voffA[_i]; asm volatile("" : "+v"(_o)); \
        __builtin_amdgcn_global_load_lds((const unsigned*)(_g + _o), (PG8_LAS unsigned*)(lds + (bufoff) + ldsw + _i * 8192), 16, 0, 0); } } \
        else { PG8_STAGE(bufoff, (kb) + (h) * hstep, voffA); } } while (0)
#define PG8_LDA(dst, b, h) do { _Pragma("unroll") for (int m = 0; m < 4; ++m) _Pragma("unroll") for (int k = 0; k < 2; ++k) dst[m][k] = *(const PG8_LAS bf16x8*)(lds + PG8_SA(b, h) + aoff + m * 2048 + k * 1024); } while (0)
#define PG8_LDB(dst, b, h) do { _Pragma("unroll") for (int n = 0; n < 2; ++n) _Pragma("unroll") for (int k = 0; k < 2; ++k) dst[n][k] = *(const PG8_LAS bf16x8*)(lds + PG8_SB(b, h) + boff + n * 2048 + k * 1024); } while (0)
#define PG8_CAT(F) __builtin_shufflevector(__builtin_bit_cast(i32x4, F[0]), __builtin_bit_cast(i32x4, F[1]), 0, 1, 2, 3, 4, 5, 6, 7)
#define PG8_MMA(ai, bj, At, Bt) do { __builtin_amdgcn_s_setprio(1); if constexpr (Sched::FP8) { _Pragma("unroll") for (int m = 0; m < 4; ++m) _Pragma("unroll") for (int n = 0; n < 2; ++n) \
        { const i32x8 _b = PG8_CAT(Bt[n]), _a = PG8_CAT(At[m]); asm volatile("v_mfma_f32_16x16x128_f8f6f4 %0, %1, %2, %0" : "+v"(acc[ai][bj][m][n]) : "v"(_b), "v"(_a)); } } \
        else { _Pragma("unroll") for (int m = 0; m < 4; ++m) _Pragma("unroll") for (int n = 0; n < 2; ++n) _Pragma("unroll") for (int k = 0; k < 2; ++k) \
        acc[ai][bj][m][n] = __builtin_amdgcn_mfma_f32_16x16x32_bf16(Bt[n][k], At[m][k], acc[ai][bj][m][n], 0, 0, 0); } __builtin_amdgcn_s_setprio(0); } while (0)
#define PG8_WAIT_V(n) asm volatile("s_waitcnt vmcnt(" #n ")" ::: "memory")
#define PG8_WAIT_L(n) asm volatile("s_waitcnt lgkmcnt(" #n ")" ::: "memory")
#define PG8_BAR __builtin_amdgcn_s_barrier()
#define PG8_SCHED __builtin_amdgcn_sched_barrier(0)
    Unit cur, nxt; int ui = 0;
    if (!S.next(0, cur)) return;
#define PG8_RS_STAGE(u_, par_) do { if constexpr (Epi::RSLDS) { if (wid < 4) __builtin_amdgcn_global_load_lds((const unsigned*)(E.rs_base(u_) + wid * 64 + lane), (PG8_LAS unsigned*)(lds + STAGE_BYTES + (par_) * 1024 + wid * 256), 4, 0, 0); } } while (0)
    PG8_RS_STAGE(cur, 0);
    unsigned gcu[2][2] = {{0u, 0u}, {0u, 0u}}, gnx[2][2] = {{0u, 0u}, {0u, 0u}};
    if constexpr (GA) {
#pragma unroll
        for (int h = 0; h < 2; ++h)
#pragma unroll
            for (int i = 0; i < 2; ++i) gcu[h][i] = S.grow(cur, h * HALF + RA[i]);
    }
    f32x4 acc[2][2][4][2];
#pragma unroll
    for (int a = 0; a < 2; ++a)
#pragma unroll
        for (int b = 0; b < 2; ++b)
#pragma unroll
            for (int m = 0; m < 4; ++m)
#pragma unroll
                for (int n = 0; n < 2; ++n) acc[a][b][m][n] = (f32x4){0.f, 0.f, 0.f, 0.f};
    bf16x8 At[4][2], B0[2][2], B1[2][2];
    const char* cA = uni_ptr(S.a_ptr(cur)); const char* cB = uni_ptr(S.b_ptr(cur));
    PG8_STAGE(PG8_SB(0, 0), cB, voffB); PG8_STAGE(PG8_SB(0, 1), cB + hstepB, voffB); PG8_STAGE_A(PG8_SA(0, 0), cA, 0, false); PG8_STAGE_A(PG8_SA(0, 1), cA, 1, false);
    if (wr == 1) PG8_BAR;
    PG8_WAIT_V(2); PG8_BAR;
    PG8_STAGE(PG8_SB(1, 0), cB + kstep, voffB); PG8_STAGE_A(PG8_SA(1, 0), cA + kstep, 0, false); PG8_STAGE(PG8_SB(1, 1), cB + hstepB + kstep, voffB);
    PG8_WAIT_V(6); PG8_BAR;
    for (;;) {
        const bool has_next = S.next(ui + 1, nxt);
        const char* nA = uni_ptr(has_next ? S.a_ptr(nxt) : cA); const char* nB = uni_ptr(has_next ? S.b_ptr(nxt) : cB);
        unsigned raw[2][2] = {{0u, 0u}, {0u, 0u}};
        if constexpr (GA) {
            if (has_next) {
#pragma unroll
                for (int h = 0; h < 2; ++h)
#pragma unroll
                    for (int i = 0; i < 2; ++i) { const unsigned* rp = S.rptr(nxt, h * HALF + RA[i]); asm volatile("global_load_dword %0, %1, off" : "=v"(raw[h][i]) : "v"(rp) : "memory"); }
            }
        }
        for (int t = 0; t < nt; t += 2) {
            const bool last = (t == nt - 2);
            if constexpr (GA) { if (last) { asm volatile("" : "+v"(raw[0][0]), "+v"(raw[0][1]), "+v"(raw[1][0]), "+v"(raw[1][1]));
#pragma unroll
                for (int h = 0; h < 2; ++h)
#pragma unroll
                    for (int i = 0; i < 2; ++i) gnx[h][i] = has_next ? (raw[h][i] >> 1) * (unsigned)(K * 2) : gcu[h][i]; } }
            const char* a1 = cA + (size_t)(t + 1) * kstep;
            const char* a2 = last ? nA : cA + (size_t)(t + 2) * kstep; const char* b2 = last ? nB : cB + (size_t)(t + 2) * kstep;
            const char* a3 = a2 + kstep; const char* b3 = b2 + kstep;
            PG8_LDB(B0, 0, 0); PG8_LDB(B1, 0, 1); PG8_SCHED; PG8_LDA(At, 0, 0); PG8_STAGE_A(PG8_SA(1, 1), a1, 1, false);
            PG8_WAIT_V(8); PG8_WAIT_L(0); PG8_BAR; PG8_MMA(0, 0, At, B0); PG8_MMA(0, 1, At, B1); PG8_BAR; PG8_SCHED;
            PG8_LDA(At, 0, 1); PG8_STAGE(PG8_SB(0, 0), b2, voffB); PG8_STAGE(PG8_SB(0, 1), b2 + hstepB, voffB); PG8_STAGE_A(PG8_SA(0, 0), a2, 0, last);
            PG8_WAIT_V(8); PG8_WAIT_L(0); PG8_BAR; PG8_MMA(1, 0, At, B0); PG8_MMA(1, 1, At, B1); PG8_BAR; PG8_SCHED;
            PG8_LDB(B0, 1, 0); PG8_LDB(B1, 1, 1); PG8_SCHED; PG8_LDA(At, 1, 0); PG8_STAGE_A(PG8_SA(0, 1), a2, 1, last);
            PG8_WAIT_V(8); PG8_WAIT_L(0); PG8_BAR; PG8_MMA(0, 0, At, B0); PG8_MMA(0, 1, At, B1); PG8_BAR; PG8_SCHED;
            PG8_LDA(At, 1, 1); PG8_STAGE(PG8_SB(1, 0), b3, voffB); PG8_STAGE(PG8_SB(1, 1), b3 + hstepB, voffB); PG8_STAGE_A(PG8_SA(1, 0), a3, 0, last);
            PG8_WAIT_V(8); PG8_WAIT_L(0); PG8_BAR; PG8_MMA(1, 0, At, B0); PG8_MMA(1, 1, At, B1); PG8_BAR; PG8_SCHED;
        }
        if constexpr (Sched::FP8) asm volatile("s_nop 15\n\ts_nop 15" ::: "memory");
        if constexpr (ALIGN_EPI) { if (wr == 0) PG8_BAR; }
        if constexpr (Epi::RSLDS) E(acc, cur, wr, wc, fr, fq, (const PG8_LAS float*)(lds + STAGE_BYTES + (ui & 1) * 1024)); else E(acc, cur, wr, wc, fr, fq);
        if (!has_next) break;
#pragma unroll
        for (int a = 0; a < 2; ++a)
#pragma unroll
            for (int b = 0; b < 2; ++b)
#pragma unroll
                for (int m = 0; m < 4; ++m)
#pragma unroll
                    for (int n = 0; n < 2; ++n) acc[a][b][m][n] = (f32x4){0.f, 0.f, 0.f, 0.f};
        cur = nxt; cA = nA; cB = nB; ++ui;
        PG8_RS_STAGE(cur, ui & 1);
        if constexpr (GA) {
#pragma unroll
            for (int h = 0; h < 2; ++h)
#pragma unroll
                for (int i = 0; i < 2; ++i) gcu[h][i] = gnx[h][i];
        }
        if constexpr (ALIGN_EPI) { if (wr == 1) PG8_BAR; }
    }
    PG8_WAIT_V(0);
    if constexpr (!ALIGN_EPI) { if (wr == 0) PG8_BAR; }
    PG8_BAR;
#undef PG8_RS_STAGE
#undef PG8_SA
#undef PG8_SB
#undef PG8_STAGE
#undef PG8_STAGE_A
#undef PG8_LDA
#undef PG8_LDB
#undef PG8_MMA
#undef PG8_CAT
#undef PG8_WAIT_V
#undef PG8_WAIT_L
#undef PG8_BAR
#undef PG8_SCHED
}
}

#define XB_TMO      128
#define XB_XCNT(j)  (256  + 64 * (j))
#define XB_XSUB(j)  (1280 + 64 * (j))
#define XB_XGEN(j)  (2304 + 64 * (j))
#define XB_TOP      3328
#define XB_TOPGEN   3392
#define XCD_BAR_WORDS 3456
#define XB_SPIN_CAP (1u << 20)

__device__ __forceinline__ unsigned xb_ld(unsigned* p)              { return __hip_atomic_load(p, __ATOMIC_RELAXED, __HIP_MEMORY_SCOPE_AGENT); }
__device__ __forceinline__ unsigned xb_add(unsigned* p, unsigned v) { return __hip_atomic_fetch_add(p, v, __ATOMIC_RELAXED, __HIP_MEMORY_SCOPE_AGENT); }
__device__ __forceinline__ unsigned xb_xcc_id() { return (unsigned)__builtin_amdgcn_s_getreg((3 << 11) | 20) & 0xFu; }
#define XB_SPIN(cond, bar) do { unsigned _sp = 0; while (cond) { __builtin_amdgcn_s_sleep(1); \
    if ((++_sp & 255u) == 0u) { if (xb_ld(&(bar)[XB_TMO])) break; if (_sp > XB_SPIN_CAP) { atomicAdd(&(bar)[XB_TMO], 1u); break; } } } } while (0)

struct XcdBarrier { unsigned* bar; unsigned x; volatile LAS unsigned* st; };

__device__ __forceinline__ XcdBarrier xcd_barrier_post(unsigned* bar, volatile LAS unsigned* st) {
    XcdBarrier b; b.bar = bar; b.x = xb_xcc_id(); b.st = st;
    if (threadIdx.x == 0) (void)xb_add(&bar[XB_XCNT(b.x)], 1u);
    return b;
}
__device__ __forceinline__ void xcd_barrier_complete(unsigned* bar, unsigned x, unsigned& nloc, unsigned& nx) {
    const unsigned G = gridDim.x * gridDim.y * gridDim.z;
    unsigned sum, cnt, mine, sp = 0u;
    for (;;) {
        sum = 0u; cnt = 0u; mine = 0u;
#pragma unroll
        for (unsigned j = 0; j < 16; ++j) { const unsigned c = xb_ld(&bar[XB_XCNT(j)]); sum += c; cnt += (c > 0u) ? 1u : 0u; mine = (j == x) ? c : mine; }
        if (sum == G) break;
        __builtin_amdgcn_s_sleep(1);
        if ((++sp & 255u) == 0u) { if (xb_ld(&bar[XB_TMO])) break; if (sp > XB_SPIN_CAP) { atomicAdd(&bar[XB_TMO], 1u); break; } }
    }
    nloc = mine > 0u ? mine : 1u; nx = cnt > 0u ? cnt : 1u;
}
__device__ __forceinline__ void xcd_barrier(const XcdBarrier& b, const int wave_s) {
    asm volatile("s_waitcnt vmcnt(0)" ::: "memory");
    __syncthreads();
    if (wave_s == 0 && lane_id() == 0) {
        unsigned* bar = b.bar;
        __builtin_amdgcn_s_waitcnt(0);
        unsigned nloc = b.st[0], nx = b.st[1];
        if (nloc == 0u) { xcd_barrier_complete(bar, b.x, nloc, nx); b.st[0] = nloc; b.st[1] = nx; }
        const unsigned old = xb_add(&bar[XB_XSUB(b.x)], 1u);
        const unsigned gen = old / nloc;
        if (old + 1u == (gen + 1u) * nloc) {
            __builtin_amdgcn_fence(__ATOMIC_RELEASE, "agent");
            asm volatile("s_waitcnt vmcnt(0)" ::: "memory");
            const unsigned og = xb_add(&bar[XB_TOP], 1u);
            const unsigned tg = og / nx;
            if (og + 1u == (tg + 1u) * nx) xb_add(&bar[XB_TOPGEN], 1u);
            else XB_SPIN(xb_ld(&bar[XB_TOPGEN]) == tg, bar);
            __builtin_amdgcn_fence(__ATOMIC_ACQUIRE, "agent");
            xb_add(&bar[XB_XGEN(b.x)], 1u);
            asm volatile("s_waitcnt vmcnt(0)" ::: "memory");
        } else {
            XB_SPIN(xb_ld(&bar[XB_XGEN(b.x)]) == gen, bar);
            __builtin_amdgcn_fence(__ATOMIC_ACQUIRE, "agent");
            asm volatile("s_waitcnt vmcnt(0)" ::: "memory");
        }
    }
    __syncthreads();
}

#define GB_XCNT(x) (64 * (x))
#define GB_SUB(x)  (1024 + 64 * (x))
#define GB_GEN(x)  (2048 + 64 * (x))
#define GB_TOP     3072
#define GB_ASUB(x) (3136 + 32 * (x))
#define GB_ATOP    3712
__device__ __forceinline__ void group_members(gu32* gb, volatile LAS unsigned* st, const unsigned x, unsigned& nloc, unsigned& nx) {
    nloc = st[1]; nx = st[2];
    if (nloc == 0u) { nx = 0u;
        for (unsigned q = 0; q < 16; ++q) { const unsigned c = __hip_atomic_load(gb + GB_XCNT(q), __ATOMIC_RELAXED, __HIP_MEMORY_SCOPE_AGENT); nx += c > 0u ? 1u : 0u; nloc = q == x ? c : nloc; }
        nloc = nloc > 0u ? nloc : 1u; st[1] = nloc; st[2] = nx; }
}
__device__ __forceinline__ void group_arrive(gu32* gb, volatile LAS unsigned* st, const unsigned x, const unsigned r) {
    unsigned nloc, nx; group_members(gb, st, x, nloc, nx);
    const unsigned old = __hip_atomic_fetch_add(gb + GB_ASUB(x), 1u, __ATOMIC_RELAXED, __HIP_MEMORY_SCOPE_AGENT);
    if (old + 1u == r * nloc) { __builtin_amdgcn_fence(__ATOMIC_RELEASE, "agent"); asm volatile("s_waitcnt vmcnt(0)" ::: "memory");
        (void)__hip_atomic_fetch_add(gb + GB_ATOP, 1u, __ATOMIC_RELAXED, __HIP_MEMORY_SCOPE_AGENT); }
}
__device__ __forceinline__ void group_wait(gu32* gb, volatile LAS unsigned* st, const unsigned x, const unsigned r) {
    unsigned nloc, nx; group_members(gb, st, x, nloc, nx);
    unsigned sp = 0u;
    while (__hip_atomic_load(gb + GB_ATOP, __ATOMIC_RELAXED, __HIP_MEMORY_SCOPE_AGENT) < r * nx) { __builtin_amdgcn_s_sleep(1); if (++sp > (1u << 22)) break; }
    __builtin_amdgcn_fence(__ATOMIC_ACQUIRE, "agent");
}
__device__ __forceinline__ void group_barrier(gu32* gb, const int wave_s, volatile LAS unsigned* st, const unsigned x) {
    asm volatile("s_waitcnt vmcnt(0)" ::: "memory");
    __syncthreads();
    if (wave_s == 0 && lane_id() == 0) {
        unsigned nloc, nx; group_members(gb, st, x, nloc, nx);
        const unsigned r = st[0] + 1u; st[0] = r;
        const unsigned old = __hip_atomic_fetch_add(gb + GB_SUB(x), 1u, __ATOMIC_RELAXED, __HIP_MEMORY_SCOPE_AGENT);
        unsigned sp = 0u;
        if (old + 1u == r * nloc) {
            __builtin_amdgcn_fence(__ATOMIC_RELEASE, "agent");
            asm volatile("s_waitcnt vmcnt(0)" ::: "memory");
            (void)__hip_atomic_fetch_add(gb + GB_TOP, 1u, __ATOMIC_RELAXED, __HIP_MEMORY_SCOPE_AGENT);
            while (__hip_atomic_load(gb + GB_TOP, __ATOMIC_RELAXED, __HIP_MEMORY_SCOPE_AGENT) < r * nx) { __builtin_amdgcn_s_sleep(1); if (++sp > (1u << 22)) break; }
            __builtin_amdgcn_fence(__ATOMIC_ACQUIRE, "agent");
            (void)__hip_atomic_fetch_add(gb + GB_GEN(x), 1u, __ATOMIC_RELAXED, __HIP_MEMORY_SCOPE_AGENT);
        } else {
            while (__hip_atomic_load(gb + GB_GEN(x), __ATOMIC_RELAXED, __HIP_MEMORY_SCOPE_AGENT) < r) { __builtin_amdgcn_s_sleep(1); if (++sp > (1u << 22)) break; }
            __builtin_amdgcn_fence(__ATOMIC_ACQUIRE, "agent");
        }
    }
    __syncthreads();
}

struct Args {
    const float* x; const float* norm_mix_g; const float* w_in; const float* b_igate; const float* b_fgate; const float* conv_w; const float* conv_b;
    const float* g_mlstm; const float* g_sb; const float* w_out; const float* norm_ffn_g; const float* ffn_w_gate; const float* ffn_w_up; const float* ffn_w_down;
    const float* w_router; const float* moe_w_gate; const float* moe_w_up; const float* moe_w_down; const float* norm_final_g;
    float* out; unsigned char* ws; int ph_lo, ph_hi;
};
struct Frame {
    LAS unsigned char* lds; volatile LAS unsigned* MISC; gu32* ctl; int tid, lane, wave, G, bid;
};

template <bool F8>
__device__ __forceinline__ void tr_item(const float* src, int ldw, unsigned char* dst, int ldk, LAS float* scr, int lane, const float* gk, const float wsc) {
    const int c = lane & 7;
    f32x4 ga = {1.f, 1.f, 1.f, 1.f}, gb = ga;
    if (gk) { ga = *(const GAS f32x4*)(gk + 8 * c); gb = *(const GAS f32x4*)(gk + 8 * c + 4); }
    {
        const int r8 = lane >> 3, c4 = 4 * (lane & 7);
        f32x4 v[8];
#pragma unroll
        for (int i = 0; i < 8; ++i) v[i] = *(const GAS f32x4*)(src + (size_t)(8 * i + r8) * ldw + c4);
#pragma unroll
        for (int i = 0; i < 8; ++i) { LAS float* d = scr + (8 * i + r8) * 33 + c4; d[0] = v[i].x; d[1] = v[i].y; d[2] = v[i].z; d[3] = v[i].w; }
    }
    LDS_WAIT(); asm volatile("" ::: "memory");
    if constexpr (F8) { ga = ga * wsc; gb = gb * wsc;
#pragma unroll
        for (int j = 0; j < 4; ++j) { const int n = (lane >> 3) + 8 * j; const LAS float* s = scr + (8 * c) * 33 + n;
            v2u o; o.x = pk4_f8(s[0 * 33] * ga.x, s[1 * 33] * ga.y, s[2 * 33] * ga.z, s[3 * 33] * ga.w); o.y = pk4_f8(s[4 * 33] * gb.x, s[5 * 33] * gb.y, s[6 * 33] * gb.z, s[7 * 33] * gb.w);
            *(GAS v2u*)(dst + (size_t)n * ldk + 8 * c) = o; }
    } else {
#pragma unroll
    for (int j = 0; j < 4; ++j) { const int n = (lane >> 3) + 8 * j; const LAS float* s = scr + (8 * c) * 33 + n;
        v4u o; o.x = pk2(s[0 * 33] * ga.x, s[1 * 33] * ga.y); o.y = pk2(s[2 * 33] * ga.z, s[3 * 33] * ga.w); o.z = pk2(s[4 * 33] * gb.x, s[5 * 33] * gb.y); o.w = pk2(s[6 * 33] * gb.z, s[7 * 33] * gb.w);
        *(GAS v4u*)((GAS bf16*)dst + (size_t)n * ldk + 8 * c) = o; }
    }
    LDS_WAIT(); asm volatile("" ::: "memory");
}
template <int ROWMAP, bool F8 = false>
__device__ __forceinline__ bool tr_matrix(int& r, const float* W, int K, int N, int ldw, int c0, void* dstv, int ldk, int drow0, LAS float* scr, int lane, const float* g = nullptr, const float wsc = 1.0f) {
    unsigned char* dst = (unsigned char*)dstv;
    const int nblk = N / 32, items = (K / 64) * nblk;
    if (r >= items) { r -= items; return false; }
    const int kb = r / nblk, nb = r % nblk, k0 = 64 * kb, n0 = 32 * nb;
    const int drow = ROWMAP == 0 ? drow0 + n0 : drow0 + (n0 >> 7) * 256 + ((n0 & 127) >> 5) * 64;
    tr_item<F8>(W + (size_t)k0 * ldw + c0 + n0, ldw, dst + ((size_t)drow * ldk + k0) * (F8 ? 1 : 2), ldk, scr, lane, g ? g + k0 : nullptr, wsc);
    return true;
}
__device__ __forceinline__ void prologue_phase(const Args& a, Frame& F) {
    LAS float* scr = (LAS float*)(F.lds + RING_OFF + F.wave * 16384);
    unsigned char* ws = a.ws;
    const int gw = F.bid * NWAVES + F.wave, NGW = F.G * NWAVES;
    constexpr int I_IN = 16 * 112, I_OUT = 16 * 32, I_DG = 16 * 86, I_DD = 43 * 32, I_MG = 16 * 112, I_MD = 56 * 32;
    constexpr int PER_LAYER_A = I_IN + I_OUT;
    constexpr int PER_DENSE = 2 * I_DG + I_DD;
    constexpr int PER_EXP = 2 * I_MG + I_MD;
    constexpr int NITEMS = 4 * PER_LAYER_A + 2 * PER_DENSE + 16 * PER_EXP;
    for (int it = gw; it < NITEMS; it += NGW) {
        int r = it;
        if (r < 4 * PER_LAYER_A) {
            const int l = r / PER_LAYER_A; r -= l * PER_LAYER_A;
            const float* W = a.w_in + (size_t)l * DM * PIN; bf16* D = (bf16*)(ws + WS_WIN) + (size_t)l * NPROJ * DM;
            if (r < 16 * 64) { (void)tr_matrix<0>(r, W, DM, 2048, PIN, 0, D, DM, 0, scr, F.lane, a.norm_mix_g + l * DM); continue; } r -= 16 * 64;
            if (r < 16 * 48) { (void)tr_matrix<0>(r, W, DM, 1536, PIN, 2056, D, DM, 2048, scr, F.lane, a.norm_mix_g + l * DM); continue; } r -= 16 * 48;
            (void)tr_matrix<0>(r, a.w_out + (size_t)l * DM * DM, DM, DM, DM, 0, (bf16*)(ws + WS_WOUT) + (size_t)l * DM * DM, DM, 0, scr, F.lane); continue;
        }
        r -= 4 * PER_LAYER_A;
        if (r < 2 * PER_DENSE) {
            const int j = r / PER_DENSE; r -= j * PER_DENSE;
            unsigned char* GU = ws + WS_WGU + (size_t)j * 2 * FFDP * DM * 2; unsigned char* WDj = ws + WS_WD + (size_t)j * DM * FFDP * 2;
            if ((DENSE_F8_MASK >> j) & 1) {
                if (tr_matrix<1, true>(r, a.ffn_w_gate + (size_t)j * DM * FFD, DM, FFD, FFD, 0, GU, DM, 0, scr, F.lane, a.norm_ffn_g + (2 * j) * DM, F8_WGU)) continue;
                if (tr_matrix<1, true>(r, a.ffn_w_up + (size_t)j * DM * FFD, DM, FFD, FFD, 0, GU, DM, 32, scr, F.lane, a.norm_ffn_g + (2 * j) * DM, F8_WGU)) continue;
                (void)tr_matrix<0, true>(r, a.ffn_w_down + (size_t)j * FFD * DM, FFD, DM, DM, 0, WDj, FFDP, 0, scr, F.lane, nullptr, F8_WD); continue;
            }
            if (tr_matrix<1>(r, a.ffn_w_gate + (size_t)j * DM * FFD, DM, FFD, FFD, 0, GU, DM, 0, scr, F.lane, a.norm_ffn_g + (2 * j) * DM)) continue;
            if (tr_matrix<1>(r, a.ffn_w_up + (size_t)j * DM * FFD, DM, FFD, FFD, 0, GU, DM, 32, scr, F.lane, a.norm_ffn_g + (2 * j) * DM)) continue;
            (void)tr_matrix<0>(r, a.ffn_w_down + (size_t)j * FFD * DM, FFD, DM, DM, 0, WDj, FFDP, 0, scr, F.lane); continue;
        }
        r -= 2 * PER_DENSE;
        {
            const int je = r / PER_EXP; r -= je * PER_EXP;
            constexpr bool M8 = MOE_FP8 != 0; constexpr size_t MES = M8 ? 1 : 2;
            unsigned char* GU = ws + WS_MGU + (size_t)je * 2 * FFE * DM * MES;
            if (tr_matrix<1, M8>(r, a.moe_w_gate + (size_t)je * DM * FFE, DM, FFE, FFE, 0, GU, DM, 0, scr, F.lane, a.norm_ffn_g + (2 * (je >> 3) + 1) * DM, F8_WGU)) continue;
            if (tr_matrix<1, M8>(r, a.moe_w_up + (size_t)je * DM * FFE, DM, FFE, FFE, 0, GU, DM, 32, scr, F.lane, a.norm_ffn_g + (2 * (je >> 3) + 1) * DM, F8_WGU)) continue;
            (void)tr_matrix<0, M8>(r, a.moe_w_down + (size_t)je * FFE * DM, FFE, DM, DM, 0, ws + WS_MD + (size_t)je * DM * FFE * MES, FFE, 0, scr, F.lane, nullptr, F8_WD);
        }
    }
    const int gt = F.bid * NTHREADS + F.tid, NGT = F.G * NTHREADS;
    constexpr int RCH = DM * 2 / 16, PCH = 64 * 2 / 16;
    for (int i = gt; i < 2 * 128 * RCH; i += NGT) {
        const int j = i / (128 * RCH), rr = (i / RCH) % 128, ch = i % RCH; const int esz = ((DENSE_F8_MASK >> j) & 1) ? 1 : 2;
        const int row = 21 * 256 + 128 + rr;
        if (ch * 16 < DM * esz) *(GAS v4u*)(ws + WS_WGU + (size_t)j * 2 * FFDP * DM * 2 + ((size_t)row * DM) * esz + ch * 16) = (v4u){0u, 0u, 0u, 0u};
    }
    for (int i = gt; i < 2 * DM * PCH; i += NGT) {
        const int j = i / (DM * PCH), row = (i / PCH) % DM, ch = i % PCH; const int esz = ((DENSE_F8_MASK >> j) & 1) ? 1 : 2;
        if (ch * 16 < 64 * esz) *(GAS v4u*)(ws + WS_WD + (size_t)j * DM * FFDP * 2 + ((size_t)row * FFDP + FFD) * esz + ch * 16) = (v4u){0u, 0u, 0u, 0u};
    }
}

struct NormIn { const float* src; const bf16* o2; float* hout; const float* gain; bf16* y; const float* w8; int ld8; float* G; unsigned* cnt; uint2* rinfo; int* cntw; int* rrec; const bf16* src16; bf16* hout16; float* rs; unsigned char* h8; };
template <bool B> struct RowSel { typedef f32x4 T; };
template <> struct RowSel<true> { typedef v2u T; };
template <int MODE, bool S16 = false>
__device__ __forceinline__ void norm_phase(Frame& F, const NormIn& p) {
    typedef typename RowSel<S16>::T RowT;
    LAS float* W8 = (LAS float*)(F.lds + RING_OFF);
    LAS int* lcnt = (LAS int*)(F.lds + RING_OFF + 32768);
    LAS int* lbase = lcnt + 8;
    LAS int* rec = lcnt + 16;
    f32x4 wr[(MODE == 0 || MODE == 2) ? 32 : 1];
    if (MODE == 0 || MODE == 2) {
        for (int i = F.tid; i < DM * 2; i += NTHREADS) *(LAS f32x4*)(W8 + 4 * i) = *(const GAS f32x4*)(p.w8 + (size_t)(i >> 1) * p.ld8 + 4 * (i & 1));
        __syncthreads();
#pragma unroll
        for (int j = 0; j < 4; ++j)
#pragma unroll
            for (int c = 0; c < 4; ++c) { const int k = 4 * (F.lane + 64 * j) + c; wr[(j * 4 + c) * 2] = *(const LAS f32x4*)(W8 + k * 8); wr[(j * 4 + c) * 2 + 1] = *(const LAS f32x4*)(W8 + k * 8 + 4); }
        __syncthreads();
    }
    for (int rb0 = F.bid; rb0 < T / 64; rb0 += F.G) {
        const int rb = (rb0 & 7) * 32 + (rb0 >> 3);
        RowT vn[4], vm[4]; v2u na[4], nb[4], ma[4], mb[4];
        const GAS RowT* const srcr = (S16 ? (const GAS RowT*)p.src16 : (const GAS RowT*)p.src) + F.lane;
        { const int row = rb * 64 + F.wave * 8; const GAS RowT* xr = srcr + (size_t)row * (DM / 4);
#pragma unroll
          for (int j = 0; j < 4; ++j) { vn[j] = xr[64 * j]; vm[j] = xr[64 * j + DM / 4]; }
          if (p.o2) { const GAS v2u* oa = (const GAS v2u*)(p.o2 + (size_t)row * DM) + F.lane; const GAS v2u* ob = (const GAS v2u*)(p.o2 + ((size_t)T + row) * DM) + F.lane;
#pragma unroll
              for (int j = 0; j < 4; ++j) { na[j] = oa[64 * j]; nb[j] = ob[64 * j]; ma[j] = oa[64 * j + DM / 4]; mb[j] = ob[64 * j + DM / 4]; } } }
#pragma unroll 1
        for (int i = 0; i < 8; ++i) {
            const int row = rb * 64 + F.wave * 8 + i;
            f32x4 v[4]; float s = 0.f;
#pragma unroll
            for (int j = 0; j < 4; ++j) { if constexpr (S16) { const v2u a = vn[j]; v[j] = (f32x4){bflo(a.x), bfhi(a.x), bflo(a.y), bfhi(a.y)}; } else v[j] = vn[j]; }
            if (p.o2) {
#pragma unroll
                for (int j = 0; j < 4; ++j) { const v2u a = na[j], b = nb[j];
                    v[j].x += bflo(a.x) + bflo(b.x); v[j].y += bfhi(a.x) + bfhi(b.x); v[j].z += bflo(a.y) + bflo(b.y); v[j].w += bfhi(a.y) + bfhi(b.y); }
            }
#pragma unroll
            for (int j = 0; j < 4; ++j) { vn[j] = vm[j]; na[j] = ma[j]; nb[j] = mb[j]; }
            if (i + 2 < 8) { const int rn = row + 2; const GAS RowT* xr = srcr + (size_t)rn * (DM / 4);
#pragma unroll
                for (int j = 0; j < 4; ++j) vm[j] = xr[64 * j];
                if (p.o2) { const GAS v2u* oa = (const GAS v2u*)(p.o2 + (size_t)rn * DM) + F.lane; const GAS v2u* ob = (const GAS v2u*)(p.o2 + ((size_t)T + rn) * DM) + F.lane;
#pragma unroll
                    for (int j = 0; j < 4; ++j) { ma[j] = oa[64 * j]; mb[j] = ob[64 * j]; } } }
            if (MODE != 3 && p.hout) { GAS f32x4* ho = (GAS f32x4*)(p.hout + (size_t)row * DM) + F.lane;
#pragma unroll
                for (int j = 0; j < 4; ++j) ho[64 * j] = v[j]; }
            if (MODE != 3 && p.hout16) { GAS v2u* ho = (GAS v2u*)(p.hout16 + (size_t)row * DM) + F.lane;
#pragma unroll
                for (int j = 0; j < 4; ++j) { const v2u w = (v2u){pk2(v[j].x, v[j].y), pk2(v[j].z, v[j].w)}; ho[64 * j] = w; v[j] = (f32x4){bflo(w.x), bfhi(w.x), bflo(w.y), bfhi(w.y)}; } }
#pragma unroll
            for (int j = 0; j < 4; ++j) s += (v[j].x * v[j].x + v[j].y * v[j].y) + (v[j].z * v[j].z + v[j].w * v[j].w);
            const float rstd = 1.0f / sqrtf(wave_sum(s) * (1.0f / DM) + EPS);
            const GAS f32x4* gr = (const GAS f32x4*)p.gain + F.lane;
            if ((MODE == 2 && MOE_FP8) || (MODE == 1 && p.h8)) { GAS unsigned* h8r = (GAS unsigned*)(p.h8 + (size_t)row * DM) + F.lane;
#pragma unroll
                for (int j = 0; j < 4; ++j) { const f32x4 q = v[j] * rstd; h8r[64 * j] = pk4_f8(q.x, q.y, q.z, q.w); } }
#pragma unroll
            for (int j = 0; j < 4; ++j) { const f32x4 g = gr[64 * j]; v[j] = v[j] * rstd * g; }
            if (MODE == 3) { GAS f32x4* ho = (GAS f32x4*)(p.hout + (size_t)row * DM) + F.lane;
#pragma unroll
                for (int j = 0; j < 4; ++j) ho[64 * j] = v[j];
                continue; }
            if (F.lane == 0) ((GAS float*)p.rs)[row] = rstd;
            if (MODE == 0 || MODE == 2) {
                float d[8];
#pragma unroll
                for (int g = 0; g < 8; ++g) d[g] = 0.f;
#pragma unroll
                for (int j = 0; j < 4; ++j)
#pragma unroll
                    for (int c = 0; c < 4; ++c) { const f32x4 w0 = wr[(j * 4 + c) * 2], w1 = wr[(j * 4 + c) * 2 + 1];
                        const float yv = v[j][c];
                        d[0] += yv * w0.x; d[1] += yv * w0.y; d[2] += yv * w0.z; d[3] += yv * w0.w; d[4] += yv * w1.x; d[5] += yv * w1.y; d[6] += yv * w1.z; d[7] += yv * w1.w; }
#pragma unroll
                for (int g = 0; g < 8; ++g) d[g] = wave_sum(d[g]);
                if (MODE == 0) { if (F.lane == 0) { GAS f32x4* gp = (GAS f32x4*)(p.G + (size_t)row * 8); gp[0] = (f32x4){d[0], d[1], d[2], d[3]}; gp[1] = (f32x4){d[4], d[5], d[6], d[7]}; } }
                else {
                    int e0 = 0; float v0 = d[0];
#pragma unroll
                    for (int g = 1; g < 8; ++g) if (d[g] > v0) { v0 = d[g]; e0 = g; }
                    int e1 = -1; float v1 = -INFINITY;
#pragma unroll
                    for (int g = 0; g < 8; ++g) if (g != e0 && d[g] > v1) { v1 = d[g]; e1 = g; }
                    const float w0 = 1.0f / (1.0f + expf(v1 - v0)), w1 = 1.0f - w0;
                    if (F.lane == 0) { LAS int* rr = rec + (F.wave * 8 + i) * 6; rr[0] = e0; rr[1] = e1; rr[4] = __builtin_bit_cast(int, w0); rr[5] = __builtin_bit_cast(int, w1); }
                }
            }
        }
        if (MODE == 2) {
            __syncthreads();
            if (F.wave == 0) { const LAS int* rr = rec + F.lane * 6; const int e0 = rr[0], e1 = rr[1], row = rb * 64 + F.lane;
                const unsigned long long below = (1ull << F.lane) - 1ull;
                int lp0 = 0, lp1 = 0, mycnt = 0;
#pragma unroll
                for (int e = 0; e < 8; ++e) { const unsigned long long m0 = __ballot(e0 == e), m1 = __ballot(e1 == e);
                    const int lp = __popcll(m0 & below) + __popcll(m1 & below), ce = __popcll(m0) + __popcll(m1);
                    if (e0 == e) lp0 = lp; if (e1 == e) lp1 = lp; if (F.lane == e) mycnt = ce; }
                GAS int* ro = (GAS int*)p.rrec + (size_t)row * 6; ro[0] = e0; ro[1] = e1; ro[2] = lp0; ro[3] = lp1; ro[4] = rr[4]; ro[5] = rr[5];
                if (F.lane < 8) { ((GAS int*)p.cntw)[rb * 8 + F.lane] = mycnt; (void)__hip_atomic_fetch_add(p.cnt + F.lane, (unsigned)mycnt, __ATOMIC_RELAXED, __HIP_MEMORY_SCOPE_AGENT); } }
            __syncthreads();
        }
    }
}

__device__ __forceinline__ void route_finish(Frame& F, const int* cntw, const int* rrec, uint2* rinfo, const float* RS, float* RSI) {
    LAS float* lred = (LAS float*)(F.lds + RING_OFF);
    for (int rb0 = F.bid; rb0 < T / 64; rb0 += F.G) {
        const int rb = (rb0 & 7) * 32 + (rb0 >> 3);
        float c[8];
#pragma unroll
        for (int e = 0; e < 8; ++e) c[e] = 0.f;
        if (F.tid < rb) { const GAS i32x4* cp = (const GAS i32x4*)(cntw + F.tid * 8); const i32x4 a = cp[0], b = cp[1];
            c[0] = (float)a.x; c[1] = (float)a.y; c[2] = (float)a.z; c[3] = (float)a.w; c[4] = (float)b.x; c[5] = (float)b.y; c[6] = (float)b.z; c[7] = (float)b.w; }
#pragma unroll
        for (int e = 0; e < 8; ++e) c[e] = wave_sum(c[e]);
        if (F.lane == 0) {
#pragma unroll
            for (int e = 0; e < 8; ++e) lred[F.wave * 8 + e] = c[e]; }
        __syncthreads();
        if (F.tid < 64) { const int row = rb * 64 + F.tid; const GAS int* rr = (const GAS int*)rrec + (size_t)row * 6;
            const int e0 = rr[0], e1 = rr[1];
            float b0 = 0.f, b1 = 0.f;
#pragma unroll
            for (int w = 0; w < NWAVES; ++w) { b0 += lred[w * 8 + e0]; b1 += lred[w * 8 + e1]; }
            const int p0 = (int)b0 + rr[2], p1 = (int)b1 + rr[3];
            rinfo[(size_t)e0 * T + p0] = make_uint2((unsigned)row * 2u, (unsigned)rr[4]);
            rinfo[(size_t)e1 * T + p1] = make_uint2((unsigned)row * 2u + 1u, (unsigned)rr[5]);
            const float rsr = ((const GAS float*)RS)[row]; ((GAS float*)RSI)[(size_t)e0 * T + p0] = rsr; ((GAS float*)RSI)[(size_t)e1 * T + p1] = rsr; }
        __syncthreads();
    }
}

__device__ __forceinline__ float logsigmoid_f(float x) { return fminf(x, 0.f) - log1pf(expf(-fabsf(x))); }
__device__ __forceinline__ void gate_scan(Frame& F, int bh, const float* G, const float* b_i, const float* b_f, float* GA, float* GM, float* GE, float* TG) {
    LAS float* sc = (LAS float*)(F.lds + RING_OFF);
    const int b = bh >> 2, h = bh & 3, t0 = 4 * F.tid;
    const float bi = b_i[h], bf = b_f[h];
    float lf[4], ig[4];
#pragma unroll
    for (int j = 0; j < 4; ++j) { const float* g = G + ((size_t)b * SEQ + t0 + j) * 8; ig[j] = g[h] + bi; lf[j] = logsigmoid_f(g[4 + h] + bf); }
    float c[4]; c[0] = lf[0]; c[1] = c[0] + lf[1]; c[2] = c[1] + lf[2]; c[3] = c[2] + lf[3];
    float ws = c[3];
    DPP_SCAN(ws, OP_ADD, 0.0f);
    if (F.lane == 63) sc[F.wave] = ws;
    __syncthreads();
    float woff = 0.f;
    for (int w = 0; w < F.wave; ++w) woff += sc[w];
    const float excl = woff + ws - c[3];
    float Fc[4], av[4];
#pragma unroll
    for (int j = 0; j < 4; ++j) { Fc[j] = excl + c[j]; av[j] = ig[j] - Fc[j]; }
    float m[4]; m[0] = av[0]; m[1] = fmaxf(m[0], av[1]); m[2] = fmaxf(m[1], av[2]); m[3] = fmaxf(m[2], av[3]);
    float wm = m[3];
    DPP_SCAN(wm, OP_MAX, -INFINITY);
    if (F.lane == 63) sc[16 + F.wave] = wm;
    __syncthreads();
    float pm = -INFINITY;
    for (int w = 0; w < F.wave; ++w) pm = fmaxf(pm, sc[16 + w]);
    { float u = dpp_f(-INFINITY, wm, 0x111, 0xf);
      const float r15 = dpp_f(-INFINITY, wm, 0x142, 0xa), r31 = dpp_f(-INFINITY, wm, 0x143, 0xc);
      if ((F.lane & 15) == 0) u = (F.lane == 32) ? r31 : r15;
      pm = fmaxf(pm, u); }
    float tmx = m[3];
    tmx = fmaxf(tmx, dpp_f(-INFINITY, tmx, 0x111, 0xf)); tmx = fmaxf(tmx, dpp_f(-INFINITY, tmx, 0x112, 0xf)); tmx = fmaxf(tmx, dpp_f(-INFINITY, tmx, 0x114, 0xf)); tmx = fmaxf(tmx, dpp_f(-INFINITY, tmx, 0x118, 0xf));
    const int tbits = __builtin_bit_cast(int, tmx);
    const float t0m = __builtin_bit_cast(float, __builtin_amdgcn_readlane(tbits, 15)), t1m = __builtin_bit_cast(float, __builtin_amdgcn_readlane(tbits, 31)),
                t2m = __builtin_bit_cast(float, __builtin_amdgcn_readlane(tbits, 47)), t3m = __builtin_bit_cast(float, __builtin_amdgcn_readlane(tbits, 63));
    const int rw = F.lane >> 4; const float tm = rw == 0 ? t0m : (rw == 1 ? t1m : (rw == 2 ? t2m : t3m));
    if ((F.lane & 15) == 0) TG[bh * 32 + F.wave * 4 + rw] = tm * LOG2E;
#pragma unroll
    for (int j = 0; j < 4; ++j) { const float Mt = fmaxf(pm, m[j]); const size_t o = (size_t)bh * SEQ + t0 + j;
        GA[o] = expf(av[j] - tm); GM[o] = Mt * LOG2E; GE[o] = expf(-(Fc[j] + Mt)); }
    __syncthreads();
}

__device__ __forceinline__ void unpack8(const v4u r, float (&d)[8]) { d[0] = bflo(r.x); d[1] = bfhi(r.x); d[2] = bflo(r.y); d[3] = bfhi(r.y); d[4] = bflo(r.z); d[5] = bfhi(r.z); d[6] = bflo(r.w); d[7] = bfhi(r.w); }
__device__ __forceinline__ void conv_phase(Frame& F, const bf16* proj, const float* cw, const float* cb, bf16* qkc, const int hidx, const int nh) {
    const int cbat = F.bid & 7;
    for (int wi = F.wave * nh + hidx; wi < 144; wi += NWAVES * nh) {
        const int kpart = wi >= 128 ? 1 : 0;
        const int seg = cbat * 128 + (kpart ? 112 + (wi - 128) : wi);
        const int t0 = seg * 16, c0 = kpart * 512 + F.lane * 8;
        float w[4][8], bb[8];
#pragma unroll
        for (int tap = 0; tap < 4; ++tap) { const f32x4 a = *(const GAS f32x4*)(cw + tap * 1024 + c0), b = *(const GAS f32x4*)(cw + tap * 1024 + c0 + 4);
            w[tap][0] = a.x; w[tap][1] = a.y; w[tap][2] = a.z; w[tap][3] = a.w; w[tap][4] = b.x; w[tap][5] = b.y; w[tap][6] = b.z; w[tap][7] = b.w; }
        { const f32x4 a = *(const GAS f32x4*)(cb + c0), b = *(const GAS f32x4*)(cb + c0 + 4); bb[0] = a.x; bb[1] = a.y; bb[2] = a.z; bb[3] = a.w; bb[4] = b.x; bb[5] = b.y; bb[6] = b.z; bb[7] = b.w; }
        const float osc = kpart ? KM_SCALE : 1.0f;
        const bool first = (t0 % SEQ) == 0;
        v4u rw[19];
#pragma unroll
        for (int q = 0; q < 3; ++q) { rw[q] = (v4u){0u, 0u, 0u, 0u}; if (!first) rw[q] = *(const GAS v4u*)(proj + (size_t)(t0 - 3 + q) * NPROJ + c0); }
#pragma unroll
        for (int q = 0; q < 16; ++q) rw[3 + q] = *(const GAS v4u*)(proj + (size_t)(t0 + q) * NPROJ + c0);
        float x0[8], x1[8], x2[8];
        unpack8(rw[0], x0); unpack8(rw[1], x1); unpack8(rw[2], x2);
#pragma unroll
        for (int i = 0; i < 16; ++i) {
            float x3[8]; unpack8(rw[3 + i], x3);
            float o[8];
#pragma unroll
            for (int c = 0; c < 8; ++c) { const float yv = bb[c] + x0[c] * w[0][c] + x1[c] * w[1][c] + x2[c] * w[2][c] + x3[c] * w[3][c];
                o[c] = osc * yv * __builtin_amdgcn_rcpf(1.0f + __builtin_amdgcn_exp2f(-yv * LOG2E)); x0[c] = x1[c]; x1[c] = x2[c]; x2[c] = x3[c]; }
            *(GAS v4u*)(qkc + (size_t)(t0 + i) * DM + c0) = (v4u){pk2(o[0], o[1]), pk2(o[2], o[3]), pk2(o[4], o[5]), pk2(o[6], o[7])};
        }
    }
}

__device__ __forceinline__ void naive_sb(Frame& F, const bf16* proj, const float* g_sb, bf16* mixed) {
    LAS float* qs = (LAS float*)(F.lds + RING_OFF) + F.wave * 256;
    LAS float* ps = qs + 64;
    for (int it = F.bid * NWAVES + F.wave; it < T * HS; it += F.G * NWAVES) {
        const int h = it & 7, row = it >> 3, t = row % SEQ, rb = row - t;
        qs[F.lane] = bf2f(proj[(size_t)row * NPROJ + 2048 + h * 64 + F.lane]);
        LDS_WAIT();
        float R = 1.0f, o = 0.f;
        const int nch = (t + 63) / 64;
        for (int c = nch - 1; c >= 0; --c) {
            const int s = 64 * c + F.lane; const bool valid = s < t;
            const bf16* kr = proj + (size_t)(rb + s) * NPROJ + 2560 + h * 64;
            float z = 0.f;
#pragma unroll
            for (int d8 = 0; d8 < 8; ++d8) { const v4u kk = *(const GAS v4u*)(kr + d8 * 8); const f32x4 qa = *(const LAS f32x4*)(qs + d8 * 8), qb = *(const LAS f32x4*)(qs + d8 * 8 + 4);
                z += qa.x * bflo(kk.x) + qa.y * bfhi(kk.x) + qa.z * bflo(kk.y) + qa.w * bfhi(kk.y) + qb.x * bflo(kk.z) + qb.y * bfhi(kk.z) + qb.z * bflo(kk.w) + qb.w * bfhi(kk.w); }
            const float e = exp2f(-z); float beta = 1.0f / (1.0f + e); float omb = 1.0f - beta;
            if (!valid) { beta = 0.f; omb = 1.0f; }
            float pr = omb;
#pragma unroll
            for (int off = 1; off < 64; off <<= 1) { const float u = __shfl_down(pr, off); if (F.lane + off < 64) pr *= u; }
            float ex = __shfl_down(pr, 1); if (F.lane == 63) ex = 1.0f;
            const float a = beta * ex * R;
            R *= __shfl(pr, 0);
            ps[F.lane] = a; LDS_WAIT();
            const bf16* vr = proj + (size_t)(rb + 64 * c) * NPROJ + 3072 + h * 64 + F.lane;
#pragma unroll 8
            for (int j = 0; j < 64; ++j) o += ps[j] * bf2f(vr[(size_t)j * NPROJ]);
            LDS_WAIT();
        }
        const float ss = wave_sum(o * o) * (1.0f / 64.0f);
        const float val = o * (1.0f / sqrtf(ss + EPS)) * g_sb[h * 64 + F.lane];
        mixed[(size_t)row * DM + 512 + h * 64 + F.lane] = (bf16)f2bf(val);
    }
}
__device__ __forceinline__ void naive_mlstm(Frame& F, const bf16* proj, const bf16* qkc, const float* GA, const float* GM, const float* GE, const float* g_m, bf16* mixed) {
    LAS float* qs = (LAS float*)(F.lds + RING_OFF) + F.wave * 256;
    LAS float* ps = qs + 128;
    for (int it = F.bid * NWAVES + F.wave; it < T * HM; it += F.G * NWAVES) {
        const int h = it & 3, row = it >> 2, t = row % SEQ, rb = row - t, b = row / SEQ, bh = b * 4 + h;
        qs[F.lane] = bf2f(qkc[(size_t)row * DM + h * 128 + F.lane]); qs[64 + F.lane] = bf2f(qkc[(size_t)row * DM + h * 128 + 64 + F.lane]);
        LDS_WAIT();
        const float Mt = GM[(size_t)bh * SEQ + t];
        float den = 0.f, o0 = 0.f, o1 = 0.f;
        const int nch = t / 64 + 1;
        for (int c = 0; c < nch; ++c) {
            const int s = 64 * c + F.lane; const bool valid = s <= t;
            const bf16* kr = qkc + (size_t)(rb + s) * DM + 512 + h * 128;
            float z = 0.f;
#pragma unroll
            for (int d8 = 0; d8 < 16; ++d8) { const v4u kk = *(const GAS v4u*)(kr + d8 * 8); const f32x4 qa = *(const LAS f32x4*)(qs + d8 * 8), qb = *(const LAS f32x4*)(qs + d8 * 8 + 4);
                z += qa.x * bflo(kk.x) + qa.y * bfhi(kk.x) + qa.z * bflo(kk.y) + qa.w * bfhi(kk.y) + qb.x * bflo(kk.z) + qb.y * bfhi(kk.z) + qb.z * bflo(kk.w) + qb.w * bfhi(kk.w); }
            const float wgt = valid ? exp2f(GA[(size_t)bh * SEQ + s] - Mt) : 0.f;
            const float pv = z * wgt;
            den += pv;
            ps[F.lane] = pv; LDS_WAIT();
            const bf16* vr = proj + (size_t)(rb + 64 * c) * NPROJ + 1024 + h * 128 + F.lane;
#pragma unroll 8
            for (int j = 0; j < 64; ++j) { const float pj = ps[j]; o0 += pj * bf2f(vr[(size_t)j * NPROJ]); o1 += pj * bf2f(vr[(size_t)j * NPROJ + 64]); }
            LDS_WAIT();
        }
        den = wave_sum(den);
        const float dn = fmaxf(fabsf(den), GE[(size_t)bh * SEQ + t]);
        const float h0 = o0 / dn, h1 = o1 / dn;
        const float ss = wave_sum(h0 * h0 + h1 * h1) * (1.0f / 128.0f);
        const float rs = 1.0f / sqrtf(ss + EPS);
        const float om0 = bf2f(proj[(size_t)row * NPROJ + 1536 + h * 128 + F.lane]), om1 = bf2f(proj[(size_t)row * NPROJ + 1536 + h * 128 + 64 + F.lane]);
        const float r0 = h0 * rs * g_m[h * 128 + F.lane] / (1.0f + expf(-om0)), r1 = h1 * rs * g_m[h * 128 + 64 + F.lane] / (1.0f + expf(-om1));
        mixed[(size_t)row * DM + h * 128 + F.lane] = (bf16)f2bf(r0); mixed[(size_t)row * DM + h * 128 + 64 + F.lane] = (bf16)f2bf(r1);
    }
}

namespace mix {
typedef float f32x16 __attribute__((ext_vector_type(16)));
typedef short s16x4 __attribute__((ext_vector_type(4)));
typedef short v4i16_t __attribute__((ext_vector_type(4)));
typedef unsigned u32x4 __attribute__((ext_vector_type(4)));
typedef LAS const unsigned char* lptr;
#define MX_MFMA(a, b, c) __builtin_amdgcn_mfma_f32_32x32x16_bf16(a, b, c, 0, 0, 0)
__device__ __forceinline__ int crow(int r, int hi) { return (r & 3) + 8 * (r >> 2) + 4 * hi; }
__device__ __forceinline__ unsigned cvtpk(float lo, float hi) { unsigned r; asm("v_cvt_pk_bf16_f32 %0, %1, %2" : "=v"(r) : "v"(lo), "v"(hi)); return r; }
__device__ __forceinline__ s16x4 vtr(lptr p) { return __builtin_bit_cast(s16x4, __builtin_amdgcn_ds_read_tr16_b64_v4i16((LAS v4i16_t*)p)); }
__device__ __forceinline__ float partner(float x, int hi) { auto rr = __builtin_amdgcn_permlane32_swap(__builtin_bit_cast(unsigned, x), __builtin_bit_cast(unsigned, x), false, false);
    return __builtin_bit_cast(float, hi ? rr[0] : rr[1]); }

constexpr int STG_BYTES = 65536, GRP_BYTES = 32768, VIMG_OFF = 16384;
constexpr int EX_OFF = RING_BYTES + 1024;
constexpr int EX_GA = EX_OFF, EX_FA = EX_OFF + 1024, EX_FB = EX_OFF + 1536;

__device__ __forceinline__ void glds16(const void* g, unsigned lds_base) {
    unsigned sv; asm volatile("s_mov_b32 %0, m0\n\ts_mov_b32 m0, %2\n\ts_nop 0\n\tglobal_load_lds_dwordx4 %1, off\n\ts_mov_b32 m0, %0" : "=&s"(sv) : "v"(g), "s"(lds_base) : "memory"); }
__device__ __forceinline__ void glds4(const void* g, unsigned lds_base) {
    unsigned sv; asm volatile("s_mov_b32 %0, m0\n\ts_mov_b32 m0, %2\n\ts_nop 0\n\tglobal_load_lds_dword %1, off\n\ts_mov_b32 m0, %0" : "=&s"(sv) : "v"(g), "s"(lds_base) : "memory"); }
template <int D, bool ML>
__device__ __forceinline__ void issue_tile(unsigned gbase, unsigned gaimg, const bf16* Kp, int pk, const bf16* Vp, int pv, const float* ga, int s0, int w4, int lane) {
#pragma unroll
    for (int c = 0; c < D / 32; ++c) { const int ch = w4 + 4 * c;
        glds16(Kp + (size_t)(s0 + lane) * pk + 8 * ch, (unsigned)__builtin_amdgcn_readfirstlane(gbase + ch * 1024)); }
#pragma unroll
    for (int c = 0; c < D / 32; ++c) { const int idx = w4 + 4 * c, dp = idx >> 2, rg = idx & 3;
        glds16(Vp + (size_t)(s0 + 16 * rg + (lane >> 2)) * pv + 32 * dp + 8 * (lane & 3), (unsigned)__builtin_amdgcn_readfirstlane(gbase + VIMG_OFF + dp * 4096 + rg * 1024)); }
    if (ML) { if (w4 == 0) glds4(ga + s0 + lane, (unsigned)__builtin_amdgcn_readfirstlane(gaimg)); }
}

template <int D, bool SBK, bool MASK>
__device__ __forceinline__ void compute_tile(lptr kimg, lptr vimg, LAS const float* gat, const bf16x8 (&qr)[D / 16], f32x16 (&o)[D / 32], float& st, const float Mt, const int qrow, const int key0, const int lane) {
    const int r32 = lane & 31, hi = lane >> 5;
    f32x16 p0 = {}, p1 = {};
    const lptr kp = kimg + hi * 1024 + r32 * 16;
    {
        bf16x8 kf[D / 8];
#pragma unroll
        for (int d0 = 0; d0 < D / 16; ++d0) { kf[2 * d0] = *(LAS const bf16x8*)(kp + d0 * 2048); kf[2 * d0 + 1] = *(LAS const bf16x8*)(kp + d0 * 2048 + 512); }
        __builtin_amdgcn_sched_barrier(0);
#pragma unroll
        for (int d0 = 0; d0 < D / 16; ++d0) { p0 = MX_MFMA(kf[2 * d0], qr[d0], p0); p1 = MX_MFMA(kf[2 * d0 + 1], qr[d0], p1); }
    }
    const lptr vp = vimg + ((lane >> 4) & 1) * 32 + (lane & 3) * 8 + (4 * hi + ((lane & 15) >> 2)) * 64;
    s16x4 vlo[D / 8], vhi[D / 8];
#pragma unroll
    for (int dp = 0; dp < D / 32; ++dp)
#pragma unroll
        for (int ks = 0; ks < 4; ++ks) { vlo[dp * 4 + ks] = vtr(vp + dp * 4096 + ks * 1024); vhi[dp * 4 + ks] = vtr(vp + dp * 4096 + ks * 1024 + 512); }
    __builtin_amdgcn_sched_barrier(0);
    u32x4 pw[4];
    if constexpr (SBK) {
        float R = st;
#pragma unroll
        for (int blk = 1; blk >= 0; --blk) {
            const f32x16& X = blk ? p1 : p0; const int kb = key0 + 32 * blk;
            float bt[16], sx[16], Pg[4], Qg[4];
#pragma unroll
            for (int g = 0; g < 4; ++g) { float run = 1.f;
#pragma unroll
                for (int i = 3; i >= 0; --i) { const int r = 4 * g + i; float z = X[r]; if (MASK) z = (kb + crow(r, hi) < qrow) ? z : -INFINITY;
                    const float e = __builtin_amdgcn_exp2f(-z); const float b = __builtin_amdgcn_rcpf(1.0f + e); bt[r] = b; sx[r] = run; run *= (1.0f - b); }
                Pg[g] = run; }
#pragma unroll
            for (int g = 0; g < 4; ++g) Qg[g] = partner(Pg[g], hi);
            float a[16];
#pragma unroll
            for (int g = 3; g >= 0; --g) { const float pre = R * (hi ? 1.0f : Qg[g]);
#pragma unroll
                for (int i = 0; i < 4; ++i) a[4 * g + i] = bt[4 * g + i] * sx[4 * g + i] * pre;
                R *= Pg[g] * Qg[g]; }
            pw[2 * blk] = (u32x4){cvtpk(a[0], a[1]), cvtpk(a[2], a[3]), cvtpk(a[4], a[5]), cvtpk(a[6], a[7])};
            pw[2 * blk + 1] = (u32x4){cvtpk(a[8], a[9]), cvtpk(a[10], a[11]), cvtpk(a[12], a[13]), cvtpk(a[14], a[15])};
        }
        st = R;
    } else {
        float den = st;
#pragma unroll
        for (int blk = 0; blk < 2; ++blk) {
            const f32x16& X = blk ? p1 : p0; const int kb = key0 + 32 * blk;
            float a[16];
#pragma unroll
            for (int g = 0; g < 4; ++g) { const f32x4 gv = *(LAS const f32x4*)(gat + 32 * blk + 8 * g + 4 * hi);
#pragma unroll
                for (int i = 0; i < 4; ++i) { const int r = 4 * g + i; float p = X[r] * __builtin_amdgcn_exp2f(gv[i] - Mt); if (MASK) p = (kb + crow(r, hi) <= qrow) ? p : 0.f; den += p; a[r] = p; } }
            pw[2 * blk] = (u32x4){cvtpk(a[0], a[1]), cvtpk(a[2], a[3]), cvtpk(a[4], a[5]), cvtpk(a[6], a[7])};
            pw[2 * blk + 1] = (u32x4){cvtpk(a[8], a[9]), cvtpk(a[10], a[11]), cvtpk(a[12], a[13]), cvtpk(a[14], a[15])};
        }
        st = den;
    }
    __builtin_amdgcn_sched_barrier(0);
#pragma unroll
    for (int dp = 0; dp < D / 32; ++dp)
#pragma unroll
        for (int ks = 0; ks < 4; ++ks) { const s16x4 a = vlo[dp * 4 + ks], b = vhi[dp * 4 + ks];
            const bf16x8 vf = (bf16x8){a[0], a[1], a[2], a[3], b[0], b[1], b[2], b[3]};
            o[dp] = MX_MFMA(__builtin_bit_cast(bf16x8, pw[ks]), vf, o[dp]); }
}

template <int D, bool SBK>
__device__ __forceinline__ void attn_unit(LAS unsigned char* lds, const int tid_in, const bf16* Qp, int pq, const bf16* Kp, int pk, const bf16* Vp, int pv,
                                          const float* ga, const float* gm, const float* ge, const int qb, bf16* out, const float* gain, const bf16* om) {
    int tid = tid_in; asm volatile("" : "+v"(tid));
    const int lane = tid & 63, wid = __builtin_amdgcn_readfirstlane(tid >> 6), grp = wid >> 2, w4 = wid & 3, r32 = lane & 31, hi = lane >> 5;
    const int t0 = 128 * qb, ns = qb + 1, nt = 2 * ns;
    const int qrow = t0 + 32 * w4 + r32;
    bf16x8 qr[D / 16];
#pragma unroll
    for (int d0 = 0; d0 < D / 16; ++d0) qr[d0] = *(const GAS bf16x8*)(Qp + (size_t)qrow * pq + d0 * 16 + hi * 8);
    float Mt = 0.f; if (!SBK) Mt = gm[qrow];
    f32x16 o[D / 32];
#pragma unroll
    for (int i = 0; i < D / 32; ++i) o[i] = f32x16{};
    float st = SBK ? 1.0f : 0.0f;
    LAS unsigned char* const gb0 = lds + grp * GRP_BYTES; LAS unsigned char* const ga0 = lds + EX_GA + grp * 256;
    const unsigned gb0u = (unsigned)(size_t)gb0, ga0u = (unsigned)(size_t)ga0;
    const int tfirst = grp ? ns - 1 : nt - 1;
    issue_tile<D, !SBK>(gb0u, ga0u, Kp, pk, Vp, pv, ga, 64 * tfirst, w4, lane);
#pragma unroll
    for (int d0 = 0; d0 < D / 16; ++d0) asm volatile("" : "+v"(qr[d0]));
    asm volatile("" : "+v"(Mt));
    for (int i = 0; i < ns; ++i) {
        const int tl = tfirst - i, sb = (i & 1);
        asm volatile("s_waitcnt vmcnt(0)" ::: "memory");
        __builtin_amdgcn_s_barrier();
        asm volatile("" ::: "memory");
        if (i + 1 < ns) issue_tile<D, !SBK>(gb0u + (sb ^ 1) * STG_BYTES, ga0u + (sb ^ 1) * 512, Kp, pk, Vp, pv, ga, 64 * (tl - 1), w4, lane);
        const lptr kimg = (lptr)(gb0 + sb * STG_BYTES); LAS const float* gat = (LAS const float*)(ga0 + sb * 512);
        if (tl >= nt - 2) compute_tile<D, SBK, true>(kimg, kimg + VIMG_OFF, gat, qr, o, st, Mt, qrow, 64 * tl, lane);
        else compute_tile<D, SBK, false>(kimg, kimg + VIMG_OFF, gat, qr, o, st, Mt, qrow, 64 * tl, lane);
    }
    constexpr int PITCH = D + 4;
    LAS float* stg = (LAS float*)lds; LAS float* fA = (LAS float*)(lds + EX_FA); LAS float* fB = (LAS float*)(lds + EX_FB);
    if (!SBK) st += partner(st, hi);
    LDS_WAIT(); __builtin_amdgcn_s_barrier(); asm volatile("" ::: "memory");
    if (grp == 1) {
#pragma unroll
        for (int dp = 0; dp < D / 32; ++dp)
#pragma unroll
            for (int r = 0; r < 16; ++r) stg[(32 * w4 + crow(r, hi)) * PITCH + 32 * dp + r32] = o[dp][r];
        if (hi == 0) fB[32 * w4 + r32] = st;
    } else { if (hi == 0) fA[32 * w4 + r32] = st; }
    LDS_WAIT(); __builtin_amdgcn_s_barrier(); asm volatile("" ::: "memory");
    if (grp == 0) {
#pragma unroll
        for (int r = 0; r < 16; ++r) { const int row = 32 * w4 + crow(r, hi); const float f = SBK ? fA[row] : 1.0f;
#pragma unroll
            for (int dp = 0; dp < D / 32; ++dp) { LAS float* p = stg + row * PITCH + 32 * dp + r32; *p = o[dp][r] + f * (*p); } }
    }
    LDS_WAIT(); __builtin_amdgcn_s_barrier(); asm volatile("" ::: "memory");
    {
        constexpr int NC = D / 4;
        const int row = tid >> 2, qd = tid & 3, trow = t0 + row;
        float v[NC];
#pragma unroll
        for (int c = 0; c < NC / 4; ++c) { const f32x4 x = *(LAS const f32x4*)(stg + row * PITCH + qd * NC + 4 * c); v[4 * c] = x.x; v[4 * c + 1] = x.y; v[4 * c + 2] = x.z; v[4 * c + 3] = x.w; }
        if (!SBK) { const float den = fA[row] + fB[row]; const float inv = 1.0f / fmaxf(fabsf(den), ge[trow]);
#pragma unroll
            for (int c = 0; c < NC; ++c) v[c] *= inv; }
        float ss = 0.f;
#pragma unroll
        for (int c = 0; c < NC; ++c) ss += v[c] * v[c];
        ss += __shfl_xor(ss, 1); ss += __shfl_xor(ss, 2);
        const float rs = 1.0f / sqrtf(ss * (1.0f / D) + EPS);
        bf16* op = out + (size_t)trow * DM + qd * NC;
#pragma unroll
        for (int c8 = 0; c8 < NC / 8; ++c8) {
            float w[8];
#pragma unroll
            for (int c = 0; c < 8; ++c) w[c] = v[8 * c8 + c] * rs * gain[qd * NC + 8 * c8 + c];
            if (!SBK) { const v4u g = *(const GAS v4u*)(om + (size_t)trow * NPROJ + qd * NC + 8 * c8); float gg[8];
                gg[0] = bflo(g.x); gg[1] = bfhi(g.x); gg[2] = bflo(g.y); gg[3] = bfhi(g.y); gg[4] = bflo(g.z); gg[5] = bfhi(g.z); gg[6] = bflo(g.w); gg[7] = bfhi(g.w);
#pragma unroll
                for (int c = 0; c < 8; ++c) w[c] *= 1.0f / (1.0f + __expf(-gg[c])); }
            *(GAS v4u*)(op + 8 * c8) = (v4u){pk2(w[0], w[1]), pk2(w[2], w[3]), pk2(w[4], w[5]), pk2(w[6], w[7])};
        }
    }
    LDS_WAIT(); __builtin_amdgcn_s_barrier(); asm volatile("" ::: "memory");
}
#undef MX_MFMA
}

typedef unsigned cs_u32x2 __attribute__((ext_vector_type(2)));
constexpr int CS_PART = 4160, CS_IMG = 4 * CS_PART, CS_NV = 8 * CS_IMG;
static_assert(CS_NV + 16384 <= MISC_OFF, "chunk-state LDS map");
__device__ __forceinline__ void chunk_state_unit(Frame& F, const int bh, const int j, const bf16* proj, const float* cw, const float* cb, const float* GAw, const float* TG,
                                                 bf16* U, float* NV, float* CM, bf16* qkc) {
    using mix::f32x16; using mix::s16x4; using mix::vtr; using mix::lptr; using mix::cvtpk;
    const int b = bh >> 2, h = bh & 3, tid = F.tid, lane = F.lane, wid = F.wave;
    const size_t r0 = (size_t)b * SEQ;
    const int cg = tid & 15, kg = tid >> 4, c0 = 8 * cg, tl = kg >> 3;
    const int s0 = 256 * j + 8 * kg;
    LAS unsigned char* const img = F.lds + RING_OFF;
    const bf16* kp = proj + (r0 + s0) * NPROJ + 512 + h * 128 + c0;
    const bf16* vp = proj + (r0 + s0) * NPROJ + 1024 + h * 128 + c0;
    v4u kr[11], vr[8];
#pragma unroll
    for (int q = 0; q < 3; ++q) { kr[q] = (v4u){0u, 0u, 0u, 0u}; if (s0 > 0) kr[q] = *(const GAS v4u*)(kp + (ptrdiff_t)(q - 3) * NPROJ); }
#pragma unroll
    for (int q = 0; q < 8; ++q) { kr[3 + q] = *(const GAS v4u*)(kp + (size_t)q * NPROJ); vr[q] = *(const GAS v4u*)(vp + (size_t)q * NPROJ); }
    const f32x4 ga0 = *(const GAS f32x4*)(GAw + (size_t)bh * SEQ + s0), ga1 = *(const GAS f32x4*)(GAw + (size_t)bh * SEQ + s0 + 4);
    const float t0g = TG[bh * 32 + 4 * j], t1g = TG[bh * 32 + 4 * j + 1], t2g = TG[bh * 32 + 4 * j + 2], t3g = TG[bh * 32 + 4 * j + 3];
    const float cm = fmaxf(fmaxf(t0g, t1g), fmaxf(t2g, t3g));
    const float tf = __builtin_amdgcn_exp2f((tl == 0 ? t0g : (tl == 1 ? t1g : (tl == 2 ? t2g : t3g))) - cm);
    float w[4][8], bb[8];
#pragma unroll
    for (int tap = 0; tap < 4; ++tap) { const f32x4 x = *(const GAS f32x4*)(cw + tap * 1024 + 512 + h * 128 + c0), y = *(const GAS f32x4*)(cw + tap * 1024 + 512 + h * 128 + c0 + 4);
        w[tap][0] = x.x; w[tap][1] = x.y; w[tap][2] = x.z; w[tap][3] = x.w; w[tap][4] = y.x; w[tap][5] = y.y; w[tap][6] = y.z; w[tap][7] = y.w; }
    { const f32x4 x = *(const GAS f32x4*)(cb + 512 + h * 128 + c0), y = *(const GAS f32x4*)(cb + 512 + h * 128 + c0 + 4); bb[0] = x.x; bb[1] = x.y; bb[2] = x.z; bb[3] = x.w; bb[4] = y.x; bb[5] = y.y; bb[6] = y.z; bb[7] = y.w; }
    {
        float nvp[8];
#pragma unroll
        for (int c = 0; c < 8; ++c) nvp[c] = 0.f;
        float x0[8], x1[8], x2[8];
        unpack8(kr[0], x0); unpack8(kr[1], x1); unpack8(kr[2], x2);
        LAS unsigned char* const wp = img + tl * (2 * CS_IMG) + (cg >> 2) * CS_PART + (8 * (kg & 7)) * 64 + (cg & 3) * 16;
#pragma unroll
        for (int i = 0; i < 8; ++i) {
            float x3[8], o[8], xv[8]; unpack8(kr[3 + i], x3); unpack8(vr[i], xv);
            const float ws_ = (i < 4 ? ga0[i & 3] : ga1[i & 3]) * tf;
#pragma unroll
            for (int c = 0; c < 8; ++c) { const float yv = bb[c] + x0[c] * w[0][c] + x1[c] * w[1][c] + x2[c] * w[2][c] + x3[c] * w[3][c];
                o[c] = KM_SCALE * yv * __builtin_amdgcn_rcpf(1.0f + __builtin_amdgcn_exp2f(-yv * LOG2E)); nvp[c] += ws_ * o[c]; x0[c] = x1[c]; x1[c] = x2[c]; x2[c] = x3[c]; }
            const v4u kcv = (v4u){pk2(o[0], o[1]), pk2(o[2], o[3]), pk2(o[4], o[5]), pk2(o[6], o[7])};
            *(LAS v4u*)(wp + i * 64) = kcv;
            *(GAS v4u*)(qkc + (r0 + s0 + i) * DM + 512 + h * 128 + c0) = kcv;
            *(LAS v4u*)(wp + CS_IMG + i * 64) = (v4u){pk2(xv[0] * ws_, xv[1] * ws_), pk2(xv[2] * ws_, xv[3] * ws_), pk2(xv[4] * ws_, xv[5] * ws_), pk2(xv[6] * ws_, xv[7] * ws_)};
        }
        LAS float* np = (LAS float*)(img + CS_NV) + kg * 128 + c0;
        *(LAS f32x4*)np = (f32x4){nvp[0], nvp[1], nvp[2], nvp[3]}; *(LAS f32x4*)(np + 4) = (f32x4){nvp[4], nvp[5], nvp[6], nvp[7]};
    }
    LDS_WAIT(); __syncthreads();
    if (tid < 128) { const LAS float* np = (const LAS float*)(img + CS_NV) + tid; float nv = 0.f;
#pragma unroll
        for (int g = 0; g < 32; ++g) nv += np[g * 128];
        NV[((size_t)bh * 7 + j) * 128 + tid] = nv; }
    if (tid == 0) { CM[bh * 8 + j] = cm; if (j == 6) CM[bh * 8 + 7] = cm; }
    {
        const int hi = lane >> 5, r32 = lane & 31;
        const lptr fb = (lptr)img + ((lane >> 4) & 1) * 32 + (lane & 3) * 8 + (4 * hi + ((lane & 15) >> 2)) * 64;
        unsigned short* Uj = (unsigned short*)U + ((size_t)bh * 7 + j) * 16384;
#pragma unroll
        for (int q = 0; q < 2; ++q) { const int idx = 2 * wid + q, dpd = idx >> 2, dpe = idx & 3;
            f32x16 acc = {};
#pragma unroll
            for (int t = 0; t < 4; ++t)
#pragma unroll
                for (int ks = 0; ks < 4; ++ks) { const lptr tb = fb + t * (2 * CS_IMG) + ks * 1024;
                    const s16x4 a0 = vtr(tb + CS_IMG + dpe * CS_PART), a1 = vtr(tb + CS_IMG + dpe * CS_PART + 512), b0 = vtr(tb + dpd * CS_PART), b1 = vtr(tb + dpd * CS_PART + 512);
                    acc = __builtin_amdgcn_mfma_f32_32x32x16_bf16(((bf16x8){a0[0], a0[1], a0[2], a0[3], a1[0], a1[1], a1[2], a1[3]}), ((bf16x8){b0[0], b0[1], b0[2], b0[3], b1[0], b1[1], b1[2], b1[3]}), acc, 0, 0, 0); }
#pragma unroll
            for (int g = 0; g < 4; ++g) *(GAS cs_u32x2*)(Uj + (size_t)(32 * dpd + r32) * 128 + 32 * dpe + 8 * g + 4 * hi) = (cs_u32x2){pk2(acc[4 * g], acc[4 * g + 1]), pk2(acc[4 * g + 2], acc[4 * g + 3])};
        }
    }
    LDS_WAIT(); __syncthreads();
}

typedef const __attribute__((address_space(4))) Args* KArgs;
#define KA(field) ({ KArgs _p = kap; asm volatile("" : "+s"(_p)); _p->field; })
#define WSP(off) ((unsigned char*)KA(ws) + (off))
namespace mix2 {
using mix::f32x16; using mix::s16x4; using mix::u32x4; using mix::lptr; using mix::crow; using mix::cvtpk; using mix::vtr; using mix::partner; using mix::glds16; using mix::glds4;
#define MX_MFMA(a, b, c) __builtin_amdgcn_mfma_f32_32x32x16_bf16(a, b, c, 0, 0, 0)
constexpr int NKB = 3, NVB = 4;
constexpr int KBUF0 = 0, VBUF0 = NKB * 16384, BUFSZ = 16384, STAGE0 = (NKB + NVB) * 16384, STAGE_W = 4608;
constexpr int EX_GA = STAGE0 + 8 * STAGE_W;
constexpr int EX_DEAD = EX_GA + NVB * 256;
static_assert(EX_DEAD + 64 <= MISC_OFF, "mixer LDS map");
struct UnitP { int b, h, qb, layer; };
template <bool SBK> struct LoopPtrs { const bf16* Kp; const bf16* Vp; const float* ga; int pk, pv; };
template <bool SBK> __device__ __forceinline__ LoopPtrs<SBK> loop_ptrs(KArgs kap, const UnitP& u) {
    LoopPtrs<SBK> p; const size_t r0 = (size_t)u.b * SEQ; const bf16* proj = (const bf16*)WSP(WS_PROJ);
    if (SBK) { p.Kp = proj + r0 * NPROJ + 2560 + u.h * 64; p.Vp = proj + r0 * NPROJ + 3072 + u.h * 64; p.ga = nullptr; p.pk = NPROJ; p.pv = NPROJ; }
    else { const bf16* qkc = (const bf16*)WSP(WS_QKC); p.Kp = qkc + r0 * DM + 512 + u.h * 128; p.Vp = proj + r0 * NPROJ + 1024 + u.h * 128; p.ga = (const float*)WSP(WS_GA) + (size_t)(u.b * 4 + u.h) * SEQ; p.pk = DM; p.pv = NPROJ; }
    return p;
}

template <int D, bool ML, class LP>
__device__ __forceinline__ void issue_tile(unsigned kbuf, unsigned vbuf, unsigned gabuf, const LP& u, int s0, int wid, int lane) {
#pragma unroll
    for (int c = 0; c < D / 64; ++c) { const int ch = wid + 8 * c;
        glds16(u.Kp + (size_t)(s0 + lane) * u.pk + 8 * ch, (unsigned)__builtin_amdgcn_readfirstlane(kbuf + ch * 1024)); }
#pragma unroll
    for (int c = 0; c < D / 64; ++c) { const int idx = wid + 8 * c, dp = idx >> 2, rg = idx & 3;
        glds16(u.Vp + (size_t)(s0 + 16 * rg + (lane >> 2)) * u.pv + 32 * dp + 8 * (lane & 3), (unsigned)__builtin_amdgcn_readfirstlane(vbuf + dp * 4096 + rg * 1024)); }
    if (ML) glds4(u.ga + s0 + lane, (unsigned)__builtin_amdgcn_readfirstlane(gabuf));
}
template <int D>
__device__ __forceinline__ void qk(lptr kimg, const bf16x8 (&qr)[D / 16], f32x16& p0, f32x16& p1, const int lane) {
    const lptr kp = kimg + (lane >> 5) * 1024 + (lane & 31) * 16;
    p0 = f32x16{}; p1 = f32x16{};
#pragma unroll
    for (int hb = 0; hb < D / 64; ++hb) {
        bf16x8 kf[8];
#pragma unroll
        for (int d = 0; d < 4; ++d) { const int d0 = 4 * hb + d; kf[2 * d] = *(LAS const bf16x8*)(kp + d0 * 2048); kf[2 * d + 1] = *(LAS const bf16x8*)(kp + d0 * 2048 + 512); }
        __builtin_amdgcn_sched_barrier(0);
#pragma unroll
        for (int d = 0; d < 4; ++d) { const int d0 = 4 * hb + d; p0 = MX_MFMA(kf[2 * d], qr[d0], p0); p1 = MX_MFMA(kf[2 * d + 1], qr[d0], p1); }
        __builtin_amdgcn_sched_barrier(0);
    }
}
template <int D, bool SBK, bool MASK>
__device__ __forceinline__ void vp(lptr vimg, LAS const float* gat, const f32x16& p0, const f32x16& p1, f32x16 (&o)[D / 32], float& st, const float Mt, const int qrow, const int key0, const int lane) {
    const int hi = lane >> 5;
    const lptr vb = vimg + ((lane >> 4) & 1) * 32 + (lane & 3) * 8 + (4 * hi + ((lane & 15) >> 2)) * 64;
    constexpr int VPRE = (D == 128) ? 2 : D / 32;
    s16x4 vlo[VPRE * 4], vhi[VPRE * 4];
#pragma unroll
    for (int dp = 0; dp < VPRE; ++dp)
#pragma unroll
        for (int ks = 0; ks < 4; ++ks) { vlo[dp * 4 + ks] = vtr(vb + dp * 4096 + ks * 1024); vhi[dp * 4 + ks] = vtr(vb + dp * 4096 + ks * 1024 + 512); }
    __builtin_amdgcn_sched_barrier(0);
    u32x4 pw[4];
    if constexpr (SBK) {
        float R = st;
#pragma unroll
        for (int blk = 1; blk >= 0; --blk) {
            const f32x16& X = blk ? p1 : p0; const int kb = key0 + 32 * blk;
            float bt[16], sx[16], Pg[4], Qg[4];
#pragma unroll
            for (int g = 0; g < 4; ++g) { float run = 1.f;
#pragma unroll
                for (int i = 3; i >= 0; --i) { const int r = 4 * g + i; float z = X[r]; if (MASK) z = (kb + crow(r, hi) < qrow) ? z : -INFINITY;
                    const float e = __builtin_amdgcn_exp2f(-z); const float b = __builtin_amdgcn_rcpf(1.0f + e); bt[r] = b; sx[r] = run; run *= (1.0f - b); }
                Pg[g] = run; }
#pragma unroll
            for (int g = 0; g < 4; ++g) Qg[g] = partner(Pg[g], hi);
            float a[16];
#pragma unroll
            for (int g = 3; g >= 0; --g) { const float pre = R * (hi ? 1.0f : Qg[g]);
#pragma unroll
                for (int i = 0; i < 4; ++i) a[4 * g + i] = bt[4 * g + i] * sx[4 * g + i] * pre;
                R *= Pg[g] * Qg[g]; }
            pw[2 * blk] = (u32x4){cvtpk(a[0], a[1]), cvtpk(a[2], a[3]), cvtpk(a[4], a[5]), cvtpk(a[6], a[7])};
            pw[2 * blk + 1] = (u32x4){cvtpk(a[8], a[9]), cvtpk(a[10], a[11]), cvtpk(a[12], a[13]), cvtpk(a[14], a[15])};
        }
        st = R;
    } else {
        float den = st;
#pragma unroll
        for (int blk = 0; blk < 2; ++blk) {
            const f32x16& X = blk ? p1 : p0; const int kb = key0 + 32 * blk;
            float a[16];
#pragma unroll
            for (int g = 0; g < 4; ++g) { const f32x4 gv = *(LAS const f32x4*)(gat + 32 * blk + 8 * g + 4 * hi);
#pragma unroll
                for (int i = 0; i < 4; ++i) { const int r = 4 * g + i; float p = X[r] * (gv[i] * Mt); if (MASK) p = (kb + crow(r, hi) <= qrow) ? p : 0.f; den += p; a[r] = p; } }
            pw[2 * blk] = (u32x4){cvtpk(a[0], a[1]), cvtpk(a[2], a[3]), cvtpk(a[4], a[5]), cvtpk(a[6], a[7])};
            pw[2 * blk + 1] = (u32x4){cvtpk(a[8], a[9]), cvtpk(a[10], a[11]), cvtpk(a[12], a[13]), cvtpk(a[14], a[15])};
        }
        st = den;
    }
    __builtin_amdgcn_sched_barrier(0);
    if constexpr (VPRE < D / 32) {
#pragma unroll
        for (int dp = 0; dp < VPRE; ++dp)
#pragma unroll
            for (int ks = 0; ks < 4; ++ks) { const s16x4 a = vlo[dp * 4 + ks], b = vhi[dp * 4 + ks];
                o[dp] = MX_MFMA(__builtin_bit_cast(bf16x8, pw[ks]), ((bf16x8){a[0], a[1], a[2], a[3], b[0], b[1], b[2], b[3]}), o[dp]); }
        __builtin_amdgcn_sched_barrier(0);
        s16x4 wlo[(D / 32 - VPRE) * 4], whi[(D / 32 - VPRE) * 4];
#pragma unroll
        for (int dp = VPRE; dp < D / 32; ++dp)
#pragma unroll
            for (int ks = 0; ks < 4; ++ks) { wlo[(dp - VPRE) * 4 + ks] = vtr(vb + dp * 4096 + ks * 1024); whi[(dp - VPRE) * 4 + ks] = vtr(vb + dp * 4096 + ks * 1024 + 512); }
        __builtin_amdgcn_sched_barrier(0);
#pragma unroll
        for (int dp = VPRE; dp < D / 32; ++dp)
#pragma unroll
            for (int ks = 0; ks < 4; ++ks) { const s16x4 a = wlo[(dp - VPRE) * 4 + ks], b = whi[(dp - VPRE) * 4 + ks];
                o[dp] = MX_MFMA(__builtin_bit_cast(bf16x8, pw[ks]), ((bf16x8){a[0], a[1], a[2], a[3], b[0], b[1], b[2], b[3]}), o[dp]); }
    } else {
#pragma unroll
        for (int dp = 0; dp < D / 32; ++dp)
#pragma unroll
            for (int ks = 0; ks < 4; ++ks) { const s16x4 a = vlo[dp * 4 + ks], b = vhi[dp * 4 + ks];
                o[dp] = MX_MFMA(__builtin_bit_cast(bf16x8, pw[ks]), ((bf16x8){a[0], a[1], a[2], a[3], b[0], b[1], b[2], b[3]}), o[dp]); }
    }
}
template <int D, bool SBK, bool MASK>
__device__ __forceinline__ void valu(LAS const float* gat, const f32x16& p0, const f32x16& p1, u32x4 (&pw)[4], float& st, const float Mt, const int qrow, const int key0, const int lane) {
    const int hi = lane >> 5;
    if constexpr (SBK) {
        float R = st;
#pragma unroll
        for (int blk = 1; blk >= 0; --blk) {
            const f32x16& X = blk ? p1 : p0; const int kb = key0 + 32 * blk;
            float bt[16], sx[16], Pg[4], Qg[4];
#pragma unroll
            for (int g = 0; g < 4; ++g) { float run = 1.f;
#pragma unroll
                for (int i = 3; i >= 0; --i) { const int r = 4 * g + i; float z = X[r]; if (MASK) z = (kb + crow(r, hi) < qrow) ? z : -INFINITY;
                    const float e = __builtin_amdgcn_exp2f(-z); const float b = __builtin_amdgcn_rcpf(1.0f + e); bt[r] = b; sx[r] = run; run *= (1.0f - b); }
                Pg[g] = run; }
#pragma unroll
            for (int g = 0; g < 4; ++g) Qg[g] = partner(Pg[g], hi);
            float a[16];
#pragma unroll
            for (int g = 3; g >= 0; --g) { const float pre = R * (hi ? 1.0f : Qg[g]);
#pragma unroll
                for (int i = 0; i < 4; ++i) a[4 * g + i] = bt[4 * g + i] * sx[4 * g + i] * pre;
                R *= Pg[g] * Qg[g]; }
            pw[2 * blk] = (u32x4){cvtpk(a[0], a[1]), cvtpk(a[2], a[3]), cvtpk(a[4], a[5]), cvtpk(a[6], a[7])};
            pw[2 * blk + 1] = (u32x4){cvtpk(a[8], a[9]), cvtpk(a[10], a[11]), cvtpk(a[12], a[13]), cvtpk(a[14], a[15])};
        }
        st = R;
    } else {
        float den = st;
#pragma unroll
        for (int blk = 0; blk < 2; ++blk) {
            const f32x16& X = blk ? p1 : p0; const int kb = key0 + 32 * blk;
            float a[16];
#pragma unroll
            for (int g = 0; g < 4; ++g) { const f32x4 gv = *(LAS const f32x4*)(gat + 32 * blk + 8 * g + 4 * hi);
#pragma unroll
                for (int i = 0; i < 4; ++i) { const int r = 4 * g + i; float p = X[r] * (gv[i] * Mt); if (MASK) p = (kb + crow(r, hi) <= qrow) ? p : 0.f; den += p; a[r] = p; } }
            pw[2 * blk] = (u32x4){cvtpk(a[0], a[1]), cvtpk(a[2], a[3]), cvtpk(a[4], a[5]), cvtpk(a[6], a[7])};
            pw[2 * blk + 1] = (u32x4){cvtpk(a[8], a[9]), cvtpk(a[10], a[11]), cvtpk(a[12], a[13]), cvtpk(a[14], a[15])};
        }
        st = den;
    }
}
template <int D>
__device__ __forceinline__ void pv(lptr vimg, const u32x4 (&pw)[4], f32x16 (&o)[D / 32], const int lane) {
    const int hi = lane >> 5;
    const lptr vb = vimg + ((lane >> 4) & 1) * 32 + (lane & 3) * 8 + (4 * hi + ((lane & 15) >> 2)) * 64;
#pragma unroll
    for (int hb = 0; hb < D / 64; ++hb) {
        s16x4 vlo[8], vhi[8];
#pragma unroll
        for (int d = 0; d < 2; ++d)
#pragma unroll
            for (int ks = 0; ks < 4; ++ks) { const int dp = 2 * hb + d; vlo[d * 4 + ks] = vtr(vb + dp * 4096 + ks * 1024); vhi[d * 4 + ks] = vtr(vb + dp * 4096 + ks * 1024 + 512); }
        __builtin_amdgcn_sched_barrier(0);
#pragma unroll
        for (int d = 0; d < 2; ++d)
#pragma unroll
            for (int ks = 0; ks < 4; ++ks) { const int dp = 2 * hb + d; const s16x4 a = vlo[d * 4 + ks], b = vhi[d * 4 + ks];
                o[dp] = MX_MFMA(__builtin_bit_cast(bf16x8, pw[ks]), ((bf16x8){a[0], a[1], a[2], a[3], b[0], b[1], b[2], b[3]}), o[dp]); }
        __builtin_amdgcn_sched_barrier(0);
    }
}
__device__ __forceinline__ void ml_fused(LAS const float* gat, const f32x16& p0, const f32x16& p1, u32x4 (&pwN)[4], float& den, const float ft, const int lane,
                                         lptr vimgP, const u32x4 (&pwP)[4], f32x16 (&o)[4], const bool dopv) {
    const int hi = lane >> 5;
    const lptr vb = vimgP + ((lane >> 4) & 1) * 32 + (lane & 3) * 8 + (4 * hi + ((lane & 15) >> 2)) * 64;
    s16x4 f0a = vtr(vb), f0b = vtr(vb + 512), f1a = vtr(vb + 1024), f1b = vtr(vb + 1024 + 512);
    f32x4 gv = {};
    __builtin_amdgcn_sched_barrier(0);
#pragma unroll
    for (int k = 0; k < 16; ++k) {
        const int dp = k >> 2, ks = k & 3;
        s16x4 f2a = f0a, f2b = f0b;
        if (k + 2 < 16) { const int dn = (k + 2) >> 2, kn = (k + 2) & 3; f2a = vtr(vb + dn * 4096 + kn * 1024); f2b = vtr(vb + dn * 4096 + kn * 1024 + 512); }
        if (dopv) o[dp] = MX_MFMA(__builtin_bit_cast(bf16x8, pwP[ks]), ((bf16x8){f0a[0], f0a[1], f0a[2], f0a[3], f0b[0], f0b[1], f0b[2], f0b[3]}), o[dp]);
        const int blk = k >> 3, r = 2 * (k & 7);
        if ((k & 1) == 0) gv = *(LAS const f32x4*)(gat + 32 * blk + 8 * (r >> 2) + 4 * hi);
        const f32x16& X = blk ? p1 : p0;
        const float q0 = X[r] * (gv[r & 3] * ft), q1 = X[r + 1] * (gv[(r & 3) + 1] * ft);
        den += q0; den += q1;
        unsigned w = cvtpk(q0, q1);
        asm volatile("" : "+v"(w)); asm volatile("" : "+v"(den));
        pwN[2 * blk + ((k & 7) >> 2)][(k & 7) & 3] = w;
        f0a = f1a; f0b = f1b; f1a = f2a; f1b = f2b;
        __builtin_amdgcn_sched_barrier(0);
    }
}
__device__ __forceinline__ void ml_mask(f32x16& p0, f32x16& p1, const int qrow, const int key0, const int lane) {
    const int hi = lane >> 5;
#pragma unroll
    for (int r = 0; r < 16; ++r) { const int kk = key0 + crow(r, hi); p0[r] = (kk <= qrow) ? p0[r] : 0.f; p1[r] = (kk + 32 <= qrow) ? p1[r] : 0.f; }
}
template <int D, bool SBK>
__device__ __forceinline__ void prefetch_unit(KArgs kap, LAS unsigned char* lds, const int wave_s, const UnitP& u, bf16x8 (&qr)[D / 16], float& Mt, float& Ml, float& tgv) {
    int tid = wave_s * 64 + lane_id(); asm volatile("" : "+v"(tid));
    const int lane = tid & 63, wid = __builtin_amdgcn_readfirstlane(tid >> 6);
    const int qrow = 256 * u.qb + 32 * wid + (lane & 31), nt = 4 * (u.qb + 1);
    const unsigned l0 = (unsigned)(size_t)lds;
    const LoopPtrs<SBK> lp = loop_ptrs<SBK>(kap, u);
    issue_tile<D, !SBK>(l0 + KBUF0, l0 + VBUF0, l0 + EX_GA, lp, 64 * (nt - 1), wid, lane);
    issue_tile<D, !SBK>(l0 + KBUF0 + BUFSZ, l0 + VBUF0 + BUFSZ, l0 + EX_GA + 256, lp, 64 * (nt - 2), wid, lane);
    const size_t r0 = (size_t)u.b * SEQ;
    const bf16* Qp = SBK ? (const bf16*)WSP(WS_PROJ) + r0 * NPROJ + 2048 + u.h * 64 : (const bf16*)WSP(WS_QKC) + r0 * DM + u.h * 128; const int pq = SBK ? NPROJ : DM;
#pragma unroll
    for (int d0 = 0; d0 < D / 16; ++d0) qr[d0] = *(const GAS bf16x8*)(Qp + (size_t)qrow * pq + d0 * 16 + (lane >> 5) * 8);
    Mt = 0.f; Ml = 0.f; tgv = 0.f;
    if (!SBK) { const size_t bh = (size_t)(u.b * 4 + u.h); Mt = ((const float*)WSP(WS_GM))[bh * SEQ + qrow]; Ml = ((const float*)WSP(WS_GM))[bh * SEQ + 256 * u.qb + 255];
        tgv = ((const float*)WSP(WS_TG))[bh * 32 + (lane & 31)]; }
}
template <int D, bool SBK>
__device__ __forceinline__ void unit_run(KArgs kap, LAS unsigned char* lds, const int wave_s, const UnitP& u, const bool has_next, const UnitP& nx, bf16x8 (&qr)[D / 16], float& Mt, float& Ml, float& tgv) {
    int tid = wave_s * 64 + lane_id(); asm volatile("" : "+v"(tid));
    const LoopPtrs<SBK> lp = loop_ptrs<SBK>(kap, u);
    const int lane = tid & 63, wid = __builtin_amdgcn_readfirstlane(tid >> 6), late = MX_LATE ? (wid >> 2) : 0, r32 = lane & 31, hi = lane >> 5;
    const int t0 = 256 * u.qb, nt = 4 * (u.qb + 1), R0 = t0 + 32 * wid, qrow = R0 + r32;
    const unsigned l0 = (unsigned)(size_t)lds;
#pragma unroll
    for (int d0 = 0; d0 < D / 16; ++d0) asm volatile("" : "+v"(qr[d0]));
    asm volatile("" : "+v"(Mt)); asm volatile("" : "+v"(Ml)); asm volatile("" : "+v"(tgv));
    const float fv = SBK ? 0.f : __builtin_amdgcn_exp2f(tgv - Ml);
    const float Bt = SBK ? 1.f : __builtin_amdgcn_exp2f(Ml - Mt);
    f32x16 o[D / 32];
#pragma unroll
    for (int i = 0; i < D / 32; ++i) o[i] = f32x16{};
    float st = SBK ? 1.0f : 0.0f;
    const int nti = (!SBK && ML_CHUNK) ? 4 : nt;
    if constexpr (!SBK && ML_CHUNK) {
        __builtin_amdgcn_s_barrier();
        if (u.qb > 0) {
            const int bh = u.b * 4 + u.h;
            const float* CMp = (const float*)WSP(WS_CM) + bh * 8;
            {
                const int d = tid >> 2, dp = tid & 3;
                const unsigned short* Ub = (const unsigned short*)WSP(WS_U) + (size_t)bh * 7 * 16384 + d * 128 + dp * 32;
                v4u rr[7][4];
#pragma unroll
                for (int j = 0; j < 7; ++j) { const int jc = (j < u.qb) ? j : u.qb - 1;
#pragma unroll
                    for (int c = 0; c < 4; ++c) rr[j][c] = *(const GAS v4u*)(Ub + (size_t)jc * 16384 + 8 * c); }
                float scj[7];
                { const f32x4 c0 = *(const GAS f32x4*)CMp, c1 = *(const GAS f32x4*)(CMp + 4);
                  const float cmv[8] = {c0.x, c0.y, c0.z, c0.w, c1.x, c1.y, c1.z, c1.w};
#pragma unroll
                  for (int j = 0; j < 7; ++j) scj[j] = (j < u.qb) ? __builtin_amdgcn_exp2f(cmv[j] - Ml) : 0.f; }
                float ac[32];
#pragma unroll
                for (int c = 0; c < 32; ++c) ac[c] = 0.f;
#pragma unroll
                for (int j = 0; j < 7; ++j)
#pragma unroll
                    for (int c = 0; c < 4; ++c) { const v4u x = rr[j][c];
                        ac[8 * c + 0] += scj[j] * bflo(x.x); ac[8 * c + 1] += scj[j] * bfhi(x.x); ac[8 * c + 2] += scj[j] * bflo(x.y); ac[8 * c + 3] += scj[j] * bfhi(x.y);
                        ac[8 * c + 4] += scj[j] * bflo(x.z); ac[8 * c + 5] += scj[j] * bfhi(x.z); ac[8 * c + 6] += scj[j] * bflo(x.w); ac[8 * c + 7] += scj[j] * bfhi(x.w); }
                const int dl = d & 63, rho = (dl & 0x33) | ((dl & 4) << 1) | ((dl & 8) >> 1);
                LAS unsigned char* ip = lds + STAGE0 + (d >> 6) * 16384 + dp * 4096 + rho * 64;
#pragma unroll
                for (int c = 0; c < 4; ++c) *(LAS v4u*)(ip + 16 * c) = (v4u){cvtpk(ac[8 * c], ac[8 * c + 1]), cvtpk(ac[8 * c + 2], ac[8 * c + 3]), cvtpk(ac[8 * c + 4], ac[8 * c + 5]), cvtpk(ac[8 * c + 6], ac[8 * c + 7])};
                if (tid < 128) { const float* NVp = (const float*)WSP(WS_NV) + (size_t)bh * 7 * 128 + tid; float nn = 0.f, nvv[7];
#pragma unroll
                    for (int j = 0; j < 7; ++j) { const int jc = (j < u.qb) ? j : u.qb - 1; nvv[j] = NVp[jc * 128]; }
                    asm volatile("" : "+v"(nvv[0]), "+v"(nvv[1]), "+v"(nvv[2]), "+v"(nvv[3]), "+v"(nvv[4]), "+v"(nvv[5]), "+v"(nvv[6]));
#pragma unroll
                    for (int j = 0; j < 7; ++j) nn += scj[j] * nvv[j];
                    ((LAS float*)(lds + STAGE0 + 32768))[tid] = nn; }
            }
            LDS_WAIT(); __builtin_amdgcn_s_barrier(); asm volatile("" ::: "memory");
            {
                u32x4 qa[4], qb_[4];
#pragma unroll
                for (int c = 0; c < 4; ++c) { qa[c] = __builtin_bit_cast(u32x4, qr[c]); qb_[c] = __builtin_bit_cast(u32x4, qr[4 + c]); }
                pv<128>((lptr)(lds + STAGE0), qa, o, lane);
                pv<128>((lptr)(lds + STAGE0 + 16384), qb_, o, lane);
                LAS const float* nvl = (LAS const float*)(lds + STAGE0 + 32768);
                float dn = 0.f;
#pragma unroll
                for (int d0 = 0; d0 < 8; ++d0) { const f32x4 n0 = *(LAS const f32x4*)(nvl + 16 * d0 + 8 * hi), n1 = *(LAS const f32x4*)(nvl + 16 * d0 + 8 * hi + 4); const u32x4 qq = __builtin_bit_cast(u32x4, qr[d0]);
                    dn += bflo(qq.x) * n0.x + bfhi(qq.x) * n0.y + bflo(qq.y) * n0.z + bfhi(qq.y) * n0.w + bflo(qq.z) * n1.x + bfhi(qq.z) * n1.y + bflo(qq.w) * n1.z + bfhi(qq.w) * n1.w; }
                st = dn;
            }
        }
    }
    f32x16 p0 = {}, p1 = {};
    u32x4 pwP[4] = {}; bool havep = false;
    LAS unsigned* const dflag = (LAS unsigned*)(lds + EX_DEAD);
    if (SBK) { if (lane == 0) dflag[wid] = 0u; }
    int k3 = 0, v4 = 0;
    bool wdead = false;
    for (int i = 0; i < nti + MX_LATE; ++i) {
        if (i + 1 < nti) { if (D == 64) asm volatile("s_waitcnt vmcnt(2)" ::: "memory"); else asm volatile("s_waitcnt vmcnt(5)" ::: "memory"); }
        else asm volatile("s_waitcnt vmcnt(0)" ::: "memory");
        if (SBK) LDS_WAIT();
        __builtin_amdgcn_s_barrier();
        asm volatile("" ::: "memory");
        if (SBK && i > 0) { const u32x4 d0 = *(LAS const u32x4*)dflag, d1 = *(LAS const u32x4*)(dflag + 4);
            if (__builtin_amdgcn_readfirstlane((int)(d0.x & d0.y & d0.z & d0.w & d1.x & d1.y & d1.z & d1.w)) != 0) break; }
        if (i + 2 < nti) { const int k3n = (k3 == 0) ? 2 : k3 - 1, v4n = (v4 + 2) & 3;
            issue_tile<D, !SBK>(l0 + KBUF0 + k3n * BUFSZ, l0 + VBUF0 + v4n * BUFSZ, l0 + EX_GA + v4n * 256, lp, 64 * (nt - 3 - i), wid, lane); }
        const int v4p = (v4 + 3) & 3;
        const int tv = late ? nt - i : nt - 1 - i;
        const int vb = late ? v4p : v4;
        const bool dov = late ? (i >= 1) : (i < nti);
        const int tq = nt - 1 - i;
        const bool doq = (i < nti) && (SBK ? (64 * tq < R0 + 31) : (64 * tq <= R0 + 31));
        const lptr kimg = (lptr)(lds + KBUF0 + k3 * BUFSZ);
        if (!late && doq && !wdead) qk<D>(kimg, qr, p0, p1, lane);
        if constexpr (!SBK) {
            if (doq) {
                const float ft = __builtin_bit_cast(float, __builtin_amdgcn_readlane(__builtin_bit_cast(int, fv), tq));
                const bool unm = (64 * tq + 63 <= R0);
                LAS const float* gat = (LAS const float*)(lds + EX_GA + v4 * 256); const lptr vprev = (lptr)(lds + VBUF0 + v4p * BUFSZ);
                u32x4 pwN[4];
                if (!unm) ml_mask(p0, p1, qrow, 64 * tq, lane);
                ml_fused(gat, p0, p1, pwN, st, ft, lane, vprev, pwP, o, havep);
#pragma unroll
                for (int q_ = 0; q_ < 4; ++q_) pwP[q_] = pwN[q_];
                havep = true;
            }
        } else
        if (dov) {
            const bool live = SBK ? (64 * tv < R0 + 31) : (64 * tv <= R0 + 31);
            const bool unm = SBK ? (64 * tv + 63 < R0) : (64 * tv + 63 <= R0);
            const lptr vimg = (lptr)(lds + VBUF0 + vb * BUFSZ); LAS const float* gat = (LAS const float*)(lds + EX_GA + vb * 256);
            if (live && !wdead) { const float ft = SBK ? 0.f : __builtin_bit_cast(float, __builtin_amdgcn_readlane(__builtin_bit_cast(int, fv), tv));
                if (unm) vp<D, SBK, false>(vimg, gat, p0, p1, o, st, ft, qrow, 64 * tv, lane); else vp<D, SBK, true>(vimg, gat, p0, p1, o, st, ft, qrow, 64 * tv, lane);
                if (SBK) { const bool dead = (__ballot(st != 0.0f) == 0ull); if (lane == 0) dflag[wid] = dead ? 1u : 0u; wdead = dead; } }
        }
        if (late && doq) qk<D>(kimg, qr, p0, p1, lane);
        k3 = (k3 == 2) ? 0 : k3 + 1; v4 = (v4 + 1) & 3;
    }
    if constexpr (!SBK) { if (havep) pv<D>((lptr)(lds + VBUF0 + ((nt - 1) & 3) * BUFSZ), pwP, o, lane); }
    LDS_WAIT(); __builtin_amdgcn_s_barrier(); asm volatile("" ::: "memory");
    const float ge_q = SBK ? 0.f : ((const float*)WSP(WS_GE))[(size_t)(u.b * 4 + u.h) * SEQ + qrow];
    if (has_next) prefetch_unit<D, SBK>(kap, lds, wave_s, nx, qr, Mt, Ml, tgv);
    const size_t er0 = (size_t)u.b * SEQ;
    bf16* const e_out = (bf16*)WSP(WS_MIXED) + er0 * DM + (SBK ? 512 + u.h * 64 : u.h * 128);
    const float* const e_gain = SBK ? KA(g_sb) + u.layer * 512 + u.h * 64 : KA(g_mlstm) + u.layer * 512 + u.h * 128;
    const bf16* const e_om = (const bf16*)WSP(WS_PROJ) + er0 * NPROJ + 1536 + u.h * 128;
    LAS float* stg = (LAS float*)(lds + STAGE0 + wid * STAGE_W); LAS float* wsf = stg + 1088;
    if (!SBK) { const float den = (st + partner(st, hi)) * Bt; if (hi == 0) wsf[r32] = Bt / fmaxf(fabsf(den), ge_q); }
    constexpr int RP = (D == 64) ? 16 : 8, NPASS = 32 / RP, LPR = 64 / RP, PITCH = D + 4, RPP = 16 / NPASS;
    const int rl = lane / LPR, seg = lane % LPR;
    float gn[16];
#pragma unroll
    for (int c = 0; c < 4; ++c) { const f32x4 g = *(const GAS f32x4*)(e_gain + 16 * seg + 4 * c); gn[4 * c] = g.x; gn[4 * c + 1] = g.y; gn[4 * c + 2] = g.z; gn[4 * c + 3] = g.w; }
    v4u gpre[SBK ? 1 : NPASS][2];
    if constexpr (!SBK) {
#pragma unroll
        for (int ps = 0; ps < NPASS; ++ps) { const int gr_ = R0 + ps * RP + rl; gpre[ps][0] = *(const GAS v4u*)(e_om + (size_t)gr_ * NPROJ + 16 * seg); gpre[ps][1] = *(const GAS v4u*)(e_om + (size_t)gr_ * NPROJ + 16 * seg + 8); }
    }
#pragma unroll
    for (int ps = 0; ps < NPASS; ++ps) {
        LDS_WAIT(); asm volatile("" ::: "memory");
#pragma unroll
        for (int rr = 0; rr < RPP; ++rr) { const int r = ps * RPP + rr; const int srow = crow(r, hi) - ps * RP;
#pragma unroll
            for (int dp = 0; dp < D / 32; ++dp) stg[srow * PITCH + 32 * dp + r32] = o[dp][r]; }
        LDS_WAIT(); asm volatile("" ::: "memory");
        float x[16];
#pragma unroll
        for (int c = 0; c < 4; ++c) { const f32x4 v4 = *(LAS const f32x4*)(stg + rl * PITCH + 16 * seg + 4 * c); x[4 * c] = v4.x; x[4 * c + 1] = v4.y; x[4 * c + 2] = v4.z; x[4 * c + 3] = v4.w; }
        const int prow = ps * RP + rl, grow = R0 + prow;
        if (!SBK) { const float inv = wsf[prow];
#pragma unroll
            for (int c = 0; c < 16; ++c) x[c] *= inv; }
        float ss = 0.f;
#pragma unroll
        for (int c = 0; c < 16; ++c) ss += x[c] * x[c];
        ss = (LPR == 8) ? oct_sum(ss, lane) : quad_sum(ss);
        const float rs = 1.0f / sqrtf(ss * (1.0f / D) + EPS);
#pragma unroll
        for (int c = 0; c < 16; ++c) x[c] *= rs * gn[c];
        if (!SBK) { const v4u g0 = gpre[SBK ? 0 : ps][0], g1 = gpre[SBK ? 0 : ps][1];
            float gg[16]; gg[0] = bflo(g0.x); gg[1] = bfhi(g0.x); gg[2] = bflo(g0.y); gg[3] = bfhi(g0.y); gg[4] = bflo(g0.z); gg[5] = bfhi(g0.z); gg[6] = bflo(g0.w); gg[7] = bfhi(g0.w);
            gg[8] = bflo(g1.x); gg[9] = bfhi(g1.x); gg[10] = bflo(g1.y); gg[11] = bfhi(g1.y); gg[12] = bflo(g1.z); gg[13] = bfhi(g1.z); gg[14] = bflo(g1.w); gg[15] = bfhi(g1.w);
#pragma unroll
            for (int c = 0; c < 16; ++c) x[c] *= 1.0f / (1.0f + __expf(-gg[c])); }
        bf16* op = e_out + (size_t)grow * DM + 16 * seg;
        *(GAS v4u*)op = (v4u){pk2(x[0], x[1]), pk2(x[2], x[3]), pk2(x[4], x[5]), pk2(x[6], x[7])};
        *(GAS v4u*)(op + 8) = (v4u){pk2(x[8], x[9]), pk2(x[10], x[11]), pk2(x[12], x[13]), pk2(x[14], x[15])};
    }
    LDS_WAIT();
}
#undef MX_MFMA
}

__device__ __forceinline__ void mixer_phase(KArgs kap, LAS unsigned char* lds, const int wave_s, const int layer) {
    int G = gridDim.x; asm volatile("" : "+s"(G)); int bid = blockIdx.x; asm volatile("" : "+s"(bid));
    for (int jb = bid; jb < 256; jb += G) {
        {
            int jb2 = jb; asm volatile("" : "+s"(jb2));
            const int b = jb2 & 7, idx = jb2 >> 3, m = idx & 7, hl = idx >> 3;
#if ML_CHUNK
            int hA, qA, hB, qB;
            if (m < 6) { const int n0 = (m * 4 + hl) * 2, n1 = n0 + 1; hA = (n0 * 37) >> 8; qA = 1 + n0 - 7 * hA; hB = (n1 * 37) >> 8; qB = 1 + n1 - 7 * hB; }
            else { const int n0 = 48 + (m - 6) * 4 + hl; hA = (n0 * 37) >> 8; qA = 1 + n0 - 7 * hA; hB = hl + 4 * (m - 6); qB = 0; }
            bf16x8 qr[4]; float Mt, Ml, tgv;
            __builtin_amdgcn_s_barrier();
            {
                const mix2::UnitP uA{b, hA, qA, layer}, uB{b, hB, qB, layer};
                mix2::prefetch_unit<64, true>(kap, lds, wave_s, uA, qr, Mt, Ml, tgv);
                mix2::unit_run<64, true>(kap, lds, wave_s, uA, true, uB, qr, Mt, Ml, tgv);
                mix2::unit_run<64, true>(kap, lds, wave_s, uB, false, uB, qr, Mt, Ml, tgv);
            }
#else
            const int nsb = (0x01122334 >> (4 * m)) & 15, st0 = (int)((0xFECA740ull >> (4 * m)) & 15ull);
            bf16x8 qr[4]; float Mt, Ml, tgv;
            __builtin_amdgcn_s_barrier();
            if (nsb > 0) {
                const int u0 = hl * 16 + st0;
                mix2::UnitP uc{b, u0 >> 3, u0 & 7, layer};
                mix2::prefetch_unit<64, true>(kap, lds, wave_s, uc, qr, Mt, Ml, tgv);
#pragma unroll 1
                for (int k = 0; k < nsb; ++k) {
                    const int un = u0 + k + 1; const mix2::UnitP nx{b, un >> 3, un & 7, layer};
                    mix2::unit_run<64, true>(kap, lds, wave_s, uc, k + 1 < nsb, nx, qr, Mt, Ml, tgv);
                    uc = nx;
                }
            }
#endif
        }
#if CONV_NOBAR
        {
            int t0_ = wave_s * 64 + lane_id();
            if (t0_ == 0) { gu32* cc = (gu32*)WSP(WS_CTL) + CW_CONV + 8 * layer + (bid & 7); unsigned sp = 0u;
                while (__hip_atomic_load(cc, __ATOMIC_RELAXED, __HIP_MEMORY_SCOPE_AGENT) < (unsigned)(G >> 3)) { __builtin_amdgcn_s_sleep(1); if (++sp > (1u << 22)) break; }
                __builtin_amdgcn_fence(__ATOMIC_ACQUIRE, "agent"); }
            __builtin_amdgcn_s_barrier();
        }
#endif
        {
            const int b = jb & 7, idx = jb >> 3, m = idx & 7, hl = idx >> 3;
            const mix2::UnitP u{b, hl, m, layer};
            bf16x8 qr[8]; float Mt, Ml, tgv;
            mix2::prefetch_unit<128, false>(kap, lds, wave_s, u, qr, Mt, Ml, tgv);
            mix2::unit_run<128, false>(kap, lds, wave_s, u, false, u, qr, Mt, Ml, tgv);
        }
        __builtin_amdgcn_s_barrier();
    }
}

#define MKFRAME() Frame F; F.lds = (LAS unsigned char*)lds; F.MISC = (volatile LAS unsigned*)(F.lds + MISC_OFF); F.tid = wave_s * 64 + lane_id(); asm volatile("" : "+v"(F.tid)); F.lane = F.tid & 63; \
    F.wave = __builtin_amdgcn_readfirstlane(F.tid >> 6); F.G = gridDim.x; asm volatile("" : "+s"(F.G)); F.bid = blockIdx.x; asm volatile("" : "+s"(F.bid)); F.ctl = (gu32*)WSP(WS_CTL)
#define GRID_BAR() do { XcdBarrier bar_; bar_.bar = (unsigned*)WSP(WS_CTL) + CW_BAR; bar_.x = xb_xcc_id(); bar_.st = (volatile LAS unsigned*)((LAS unsigned char*)lds + MISC_OFF) + 8; xcd_barrier(bar_, wave_s); } while (0)
#define GROUP_BAR() group_barrier((gu32*)WSP(WS_CTL) + CW_GB + 4096 * ((int)blockIdx.x & 7), wave_s, (volatile LAS unsigned*)((LAS unsigned char*)lds + MISC_OFF) + 24, xb_xcc_id())
#define BUILD_TAB() do { __syncthreads(); \
            if (F.tid == 0) { int acc_ = 0; for (int e = 0; e < 8; ++e) { const int c_ = (int)__hip_atomic_load(F.ctl + CW_CNT + 64 * j + e, RLX_AGENT); tab[e] = acc_; tab[16 + e] = c_; acc_ += (c_ + 255) >> 8; } tab[8] = acc_; } \
            __syncthreads(); } while (0)

__global__ void __launch_bounds__(NTHREADS, 2) mk_fwd(Args args_unused) {
    extern __shared__ __attribute__((aligned(16))) unsigned char lds[];
    KArgs kap = (KArgs)__builtin_amdgcn_kernarg_segment_ptr();
    const int wave_s = __builtin_amdgcn_readfirstlane((int)threadIdx.x >> 6);
    for (int u = threadIdx.x; u < 256; u += NTHREADS) ((LAS unsigned*)((LAS unsigned char*)lds + MISC_OFF))[u] = 0u;
    __syncthreads();
    (void)xcd_barrier_post((unsigned*)WSP(WS_CTL) + CW_BAR, (volatile LAS unsigned*)((LAS unsigned char*)lds + MISC_OFF) + 8);
    { gu32* gbp = (gu32*)WSP(WS_CTL) + CW_GB + 4096 * ((int)blockIdx.x & 7) + GB_XCNT(xb_xcc_id());
      if (threadIdx.x == 0) (void)__hip_atomic_fetch_add(gbp, 1u, __ATOMIC_RELAXED, __HIP_MEMORY_SCOPE_AGENT); }

    { MKFRAME(); Args a; a.ws = KA(ws); a.w_in = KA(w_in); a.w_out = KA(w_out); a.ffn_w_gate = KA(ffn_w_gate); a.ffn_w_up = KA(ffn_w_up); a.ffn_w_down = KA(ffn_w_down);
      a.moe_w_gate = KA(moe_w_gate); a.moe_w_up = KA(moe_w_up); a.moe_w_down = KA(moe_w_down); a.norm_mix_g = KA(norm_mix_g); a.norm_ffn_g = KA(norm_ffn_g);
#pragma unroll 1
      for (int rep = 0; rep < REP_PRO; ++rep) prologue_phase(a, F); }
    __syncthreads();
    for (int layer = 0; layer < DEPTH; ++layer) {
        const int j = layer >> 1; const bool moe = layer & 1;
        { MKFRAME();
            NormIn p{}; p.src = KA(x); p.src16 = (const bf16*)WSP(WS_H16); p.o2 = (layer == 2) ? (bf16*)WSP(WS_O2) : nullptr; p.hout16 = (layer == 0 || layer == 2) ? (bf16*)WSP(WS_H16) : nullptr; p.rs = (float*)WSP(WS_RS);
            p.gain = KA(norm_mix_g) + layer * DM; p.w8 = KA(w_in) + (size_t)layer * DM * PIN + 2048; p.ld8 = PIN; p.G = (float*)WSP(WS_G);
            if (layer == 0) norm_phase<0, false>(F, p); else norm_phase<0, true>(F, p);
        }
        if (layer == 0) GRID_BAR(); else GROUP_BAR();
        { MKFRAME();
            if (F.bid >= 128 && F.bid < 160) gate_scan(F, (F.bid & 7) * HM + ((F.bid >> 3) - 16), (float*)WSP(WS_G), KA(b_igate) + layer * HM, KA(b_fgate) + layer * HM, (float*)WSP(WS_GA), (float*)WSP(WS_GM), (float*)WSP(WS_GE), (float*)WSP(WS_TG));
            __syncthreads();
            pg8::EpiProj E{(bf16*)WSP(WS_PROJ), (const float*)WSP(WS_RS)};
            const int ngw = F.G >> 3, lw = F.bid >> 3, ntl = pg8::WGM * (NPROJ / pg8::BM);
            const int maxu = (ntl + ngw - 1) / ngw, h0 = ntl - (maxu - 1) * ngw, nh = ngw - h0;
            { pg8::InprojOrder S; S.init(WSP(WS_H16), (bf16*)WSP(WS_WIN) + (size_t)layer * NPROJ * DM, T, NPROJ, DM, F.G, F.bid, 0, 2);
              pg8::gemm_phase<pg8::EpiProj, pg8::InprojOrder, true>(F.lds + RING_OFF, S, E, F.tid); }
            asm volatile("s_waitcnt vmcnt(0)" ::: "memory");
            __syncthreads();
            { const unsigned xcc = xb_xcc_id(); gu32* gbp = F.ctl + CW_GB + 4096 * (F.bid & 7);
              if (F.tid == 0) group_arrive(gbp, F.MISC + 24, xcc, (unsigned)layer + 1u); }
            { pg8::InprojOrder S; S.init(WSP(WS_H16), (bf16*)WSP(WS_WIN) + (size_t)layer * NPROJ * DM, T, NPROJ, DM, F.G, F.bid, 2, maxu - 2);
              pg8::gemm_phase<pg8::EpiProj, pg8::InprojOrder, true>(F.lds + RING_OFF, S, E, F.tid); }
            if (nh == 0 || lw >= h0) {
                const int hidx = nh == 0 ? lw : lw - h0, nhe = nh == 0 ? ngw : nh;
                __syncthreads();
                { const unsigned xcc = xb_xcc_id(); gu32* gbp = F.ctl + CW_GB + 4096 * (F.bid & 7);
                  if (F.tid == 0) group_wait(gbp, F.MISC + 24, xcc, (unsigned)layer + 1u); }
                __syncthreads();
                conv_phase(F, (bf16*)WSP(WS_PROJ), KA(conv_w) + (size_t)layer * 4 * 1024, KA(conv_b) + (size_t)layer * 1024, (bf16*)WSP(WS_QKC), hidx, nhe);
#pragma unroll 1
                for (int ub = nhe - 1 - hidx; ub < HM * 7; ub += nhe) chunk_state_unit(F, (F.bid & 7) * HM + ub / 7, ub % 7, (bf16*)WSP(WS_PROJ), KA(conv_w) + (size_t)layer * 4 * 1024, KA(conv_b) + (size_t)layer * 1024,
                                                                   (float*)WSP(WS_GA), (float*)WSP(WS_TG), (bf16*)WSP(WS_U), (float*)WSP(WS_NV), (float*)WSP(WS_CM), (bf16*)WSP(WS_QKC));
            }
        }
        GROUP_BAR();
        { MKFRAME();
#if NAIVE_MIX == 1
            naive_sb(F, (bf16*)WSP(WS_PROJ), KA(g_sb) + layer * 512, (bf16*)WSP(WS_MIXED));
            naive_mlstm(F, (bf16*)WSP(WS_PROJ), (bf16*)WSP(WS_QKC), (float*)WSP(WS_GA), (float*)WSP(WS_GM), (float*)WSP(WS_GE), KA(g_mlstm) + layer * 512, (bf16*)WSP(WS_MIXED));
#else
#pragma unroll 1
            for (int rep = 0; rep < REP_MIX; ++rep) mixer_phase(kap, F.lds, wave_s, layer);
#endif
            __syncthreads();
        }
        GROUP_BAR();
        { MKFRAME();
            pg8::DenseOrder S; S.init(WSP(WS_MIXED), (bf16*)WSP(WS_WOUT) + (size_t)layer * DM * DM, T, DM, DM, F.G, F.bid);
            { pg8::EpiResid16<false> E{nullptr, (bf16*)WSP(WS_H16), 1.0f}; pg8::gemm_phase<pg8::EpiResid16<false>, pg8::DenseOrder, true>(F.lds + RING_OFF, S, E, F.tid); }
        }
        GROUP_BAR();
        { MKFRAME();
            NormIn p{}; p.src16 = (const bf16*)WSP(WS_H16); p.gain = KA(norm_ffn_g) + layer * DM; p.rs = (float*)WSP(WS_RS);
            if (moe) { p.w8 = KA(w_router) + (size_t)j * DM * 8; p.ld8 = 8; p.cnt = (unsigned*)(F.ctl + CW_CNT + 64 * j); p.rinfo = (uint2*)WSP(WS_RINFO); p.cntw = (int*)WSP(WS_CNTW); p.rrec = (int*)WSP(WS_RREC); p.h8 = (unsigned char*)WSP(WS_H8);
                norm_phase<2, true>(F, p); }
            else { p.h8 = ((DENSE_F8_MASK >> j) & 1) ? (unsigned char*)WSP(WS_H8) : nullptr; norm_phase<1, true>(F, p); }
        }
        if (moe) { GRID_BAR(); MKFRAME(); route_finish(F, (const int*)WSP(WS_CNTW), (const int*)WSP(WS_RREC), (uint2*)WSP(WS_RINFO), (const float*)WSP(WS_RS), (float*)WSP(WS_RSI)); }
        if (moe) GRID_BAR(); else GROUP_BAR();
        { MKFRAME(); volatile LAS int* tab = (volatile LAS int*)(F.MISC + 32);
            if (!moe) {
              if ((DENSE_F8_MASK >> j) & 1) {
                pg8::DenseOrderT<true> S; S.init(WSP(WS_H8), (unsigned char*)WSP(WS_WGU) + (size_t)j * 2 * FFDP * DM * 2, T, 2 * FFDP, DM / 2, F.G, F.bid);
                pg8::EpiSwiglu8 E{(unsigned char*)WSP(WS_HID), FFDP, 1.0f / F8_WGU};
#pragma unroll 1
                for (int rep = 0; rep < REP_DUP; ++rep) pg8::gemm_phase<pg8::EpiSwiglu8, pg8::DenseOrderT<true>, true>(F.lds + RING_OFF, S, E, F.tid);
              } else {
                pg8::DenseOrder S; S.init(WSP(WS_H16), (bf16*)WSP(WS_WGU) + (size_t)j * 2 * FFDP * DM, T, 2 * FFDP, DM, F.G, F.bid);
                pg8::EpiSwiglu E{(bf16*)WSP(WS_HID), FFDP, (const float*)WSP(WS_RS), nullptr};
#pragma unroll 1
                for (int rep = 0; rep < REP_DUP; ++rep) pg8::gemm_phase<pg8::EpiSwiglu, pg8::DenseOrder, true>(F.lds + RING_OFF, S, E, F.tid);
              }
            } else {
                BUILD_TAB();
#if MOE_FP8
                pg8::MoeOrder<true> S; S.init(WSP(WS_H8), (unsigned char*)WSP(WS_MGU) + (size_t)j * 8 * 2 * FFE * DM, (size_t)2 * FFE * DM, 2 * FFE, DM / 2, F.G, F.bid, tab, (const uint2*)WSP(WS_RINFO));
                pg8::EpiSwiglu8 E{(unsigned char*)WSP(WS_HIDM), FFE, 1.0f / F8_WGU};
#pragma unroll 1
                for (int rep = 0; rep < REP_MOEUP; ++rep) pg8::gemm_phase<pg8::EpiSwiglu8, pg8::MoeOrder<true>, true>(F.lds + RING_OFF, S, E, F.tid);
#else
                pg8::MoeOrder<true> S; S.init(WSP(WS_H16), (bf16*)WSP(WS_MGU) + (size_t)j * 8 * 2 * FFE * DM, (size_t)2 * FFE * DM * 2, 2 * FFE, DM, F.G, F.bid, tab, (const uint2*)WSP(WS_RINFO));
                pg8::EpiSwiglu E{(bf16*)WSP(WS_HIDM), FFE, nullptr, (const float*)WSP(WS_RSI)};
#pragma unroll 1
                for (int rep = 0; rep < REP_MOEUP; ++rep) pg8::gemm_phase<pg8::EpiSwiglu, pg8::MoeOrder<true>, true>(F.lds + RING_OFF, S, E, F.tid);
#endif
            }
        }
        if (moe) GRID_BAR(); else GROUP_BAR();
        { MKFRAME(); volatile LAS int* tab = (volatile LAS int*)(F.MISC + 32);
            if (!moe) {
              if ((DENSE_F8_MASK >> j) & 1) {
                pg8::DenseOrderT<true> S; S.init(WSP(WS_HID), (unsigned char*)WSP(WS_WD) + (size_t)j * DM * FFDP * 2, T, DM, FFDP / 2, F.G, F.bid);
                pg8::EpiResid16<false> E{nullptr, (bf16*)WSP(WS_H16), 1.0f / (F8_HID * F8_WD)};
                pg8::gemm_phase<pg8::EpiResid16<false>, pg8::DenseOrderT<true>, true>(F.lds + RING_OFF, S, E, F.tid);
              } else {
                pg8::DenseOrder S; S.init(WSP(WS_HID), (bf16*)WSP(WS_WD) + (size_t)j * DM * FFDP, T, DM, FFDP, F.G, F.bid);
                pg8::EpiResid16<false> E{nullptr, (bf16*)WSP(WS_H16), 1.0f};
                pg8::gemm_phase<pg8::EpiResid16<false>, pg8::DenseOrder, true>(F.lds + RING_OFF, S, E, F.tid);
              }
            } else {
                BUILD_TAB();
#if MOE_FP8
                pg8::MoeOrder<false> S; S.init(WSP(WS_HIDM), (unsigned char*)WSP(WS_MD) + (size_t)j * 8 * DM * FFE, (size_t)DM * FFE, DM, FFE / 2, F.G, F.bid, tab, (const uint2*)WSP(WS_RINFO));
                pg8::EpiScatter E{(bf16*)WSP(WS_O2), (const uint2*)WSP(WS_RINFO), 1.0f / (F8_HID * F8_WD)};
#else
                pg8::MoeOrder<false> S; S.init(WSP(WS_HIDM), (bf16*)WSP(WS_MD) + (size_t)j * 8 * DM * FFE, (size_t)DM * FFE * 2, DM, FFE, F.G, F.bid, tab, (const uint2*)WSP(WS_RINFO));
                pg8::EpiScatter E{(bf16*)WSP(WS_O2), (const uint2*)WSP(WS_RINFO), 1.0f};
#endif
#if MOE_TAIL_KS > 1
                const int rem = S.nwg % F.G, nmain = S.nwg - rem;
                pg8::MoeOrder<false> S0 = S; S0.nwg = nmain;
                pg8::gemm_phase<pg8::EpiScatter, pg8::MoeOrder<false>, true>(F.lds + RING_OFF, S0, E, F.tid);
                if (rem > 0 && F.bid < rem * MOE_TAIL_KS) {
                    pg8::MoeTailOrder ST; ST.init(S, nmain, rem, MOE_TAIL_KS, F.bid);
                    const int tl = F.bid % rem;
                    float* Pt = (float*)WSP(WS_Y) + (size_t)tl * MOE_TAIL_KS * 65536;
                    pg8::EpiPartial EP{Pt + (size_t)ST.slice * 65536};
                    pg8::gemm_phase<pg8::EpiPartial, pg8::MoeTailOrder, true>(F.lds + RING_OFF, ST, EP, F.tid);
                    asm volatile("s_waitcnt vmcnt(0)" ::: "memory");
                    __syncthreads();
                    if (F.tid == 0) { __builtin_amdgcn_fence(__ATOMIC_RELEASE, "agent");
                        const unsigned old_ = __hip_atomic_fetch_add(F.ctl + CW_TAIL + 32 * j + tl, 1u, __ATOMIC_RELAXED, __HIP_MEMORY_SCOPE_AGENT);
                        if (old_ == MOE_TAIL_KS - 1) __builtin_amdgcn_fence(__ATOMIC_ACQUIRE, "agent");
                        F.MISC[16] = old_; }
                    __syncthreads();
                    if (F.MISC[16] == MOE_TAIL_KS - 1) {
                        f32x4 acc[2][2][4][2];
#pragma unroll
                        for (int g = 0; g < 4; ++g) {
                            const float* pg = Pt + ((size_t)(g * 8) * 512 + F.tid) * 4; asm volatile("" : "+v"(pg));
#pragma unroll
                            for (int kh = 0; kh < 2; ++kh) {
                                f32x4 t[4][MOE_TAIL_KS];
#pragma unroll
                                for (int k2 = 0; k2 < 4; ++k2)
#pragma unroll
                                    for (int sl = 0; sl < MOE_TAIL_KS; ++sl) t[k2][sl] = *(const GAS f32x4*)(pg + (size_t)sl * 65536 + (4 * kh + k2) * 2048);
#pragma unroll
                                for (int k2 = 0; k2 < 4; ++k2)
#pragma unroll
                                    for (int sl = 0; sl < MOE_TAIL_KS; ++sl) asm volatile("" : "+v"(t[k2][sl]));
#pragma unroll
                                for (int k2 = 0; k2 < 4; ++k2) { f32x4 v = t[k2][0];
#pragma unroll
                                    for (int sl = 1; sl < MOE_TAIL_KS; ++sl) v += t[k2][sl];
                                    const int k = 4 * kh + k2; acc[g >> 1][g & 1][k >> 1][k & 1] = v; }
                            }
                            asm volatile("" : "+v"(acc[g >> 1][g & 1][0][0]), "+v"(acc[g >> 1][g & 1][0][1]), "+v"(acc[g >> 1][g & 1][1][0]), "+v"(acc[g >> 1][g & 1][1][1]),
                                              "+v"(acc[g >> 1][g & 1][2][0]), "+v"(acc[g >> 1][g & 1][2][1]), "+v"(acc[g >> 1][g & 1][3][0]), "+v"(acc[g >> 1][g & 1][3][1]));
                        }
                        pg8::Unit ut; ST.base.decode(ST.wgid, ut);
                        const int wid_ = F.tid >> 6, ln_ = F.tid & 63;
                        E(acc, ut, wid_ >> 2, wid_ & 3, ln_ & 15, ln_ >> 4);
                    }
                    __syncthreads();
                }
#else
#pragma unroll 1
                for (int rep = 0; rep < REP_MOEDN; ++rep) pg8::gemm_phase<pg8::EpiScatter, pg8::MoeOrder<false>, true>(F.lds + RING_OFF, S, E, F.tid);
#endif
            }
        }
        if (moe) GRID_BAR(); else GROUP_BAR();
    }
    { MKFRAME(); NormIn p{}; p.src16 = (const bf16*)WSP(WS_H16); p.o2 = (bf16*)WSP(WS_O2); p.hout = KA(out); p.gain = KA(norm_final_g); norm_phase<3, true>(F, p); }
}

extern "C" void kernel_launch(void* const* d_in, const int* in_sizes, int n_in, void* d_out, int out_size, void* d_ws, size_t ws_size, hipStream_t stream) {
    static int grid = 0;
    if (grid == 0) {
        if (n_in != 19 || in_sizes[0] != T * DM || out_size != T * DM || ws_size < WS_END) { fprintf(stderr, "kernel_launch: unexpected shapes / workspace (%d inputs, in0 %d, out %d, ws %zu)\n", n_in, n_in > 0 ? in_sizes[0] : -1, out_size, ws_size); grid = -1; return; }
        int dev = 0, cus = 0, per_cu = 0;
        if (hipGetDevice(&dev) != hipSuccess || hipDeviceGetAttribute(&cus, hipDeviceAttributeMultiprocessorCount, dev) != hipSuccess) { grid = -1; return; }
        if (hipFuncSetAttribute((const void*)mk_fwd, hipFuncAttributeMaxDynamicSharedMemorySize, LDS_BYTES) != hipSuccess) { grid = -1; return; }
        if (hipOccupancyMaxActiveBlocksPerMultiprocessor(&per_cu, (const void*)mk_fwd, NTHREADS, LDS_BYTES) != hipSuccess || per_cu < 1) fprintf(stderr, "kernel_launch: occupancy query says %d\n", per_cu);
        (void)hipGetLastError();
        grid = cus - cus % 8;
        if (grid < 160) { fprintf(stderr, "kernel_launch: %d compute units: this kernel needs at least 160\n", cus); grid = -1; return; }
    }
    if (grid < 0) return;
    if (hipMemsetAsync((char*)d_ws + WS_CTL, 0, CTL_ZERO_BYTES, stream) != hipSuccess) return;
    Args a{};
    a.x = (const float*)d_in[0]; a.norm_mix_g = (const float*)d_in[1]; a.w_in = (const float*)d_in[2]; a.b_igate = (const float*)d_in[3]; a.b_fgate = (const float*)d_in[4];
    a.conv_w = (const float*)d_in[5]; a.conv_b = (const float*)d_in[6]; a.g_mlstm = (const float*)d_in[7]; a.g_sb = (const float*)d_in[8]; a.w_out = (const float*)d_in[9];
    a.norm_ffn_g = (const float*)d_in[10]; a.ffn_w_gate = (const float*)d_in[11]; a.ffn_w_up = (const float*)d_in[12]; a.ffn_w_down = (const float*)d_in[13];
    a.w_router = (const float*)d_in[14]; a.moe_w_gate = (const float*)d_in[15]; a.moe_w_up = (const float*)d_in[16]; a.moe_w_down = (const float*)d_in[17]; a.norm_final_g = (const float*)d_in[18];
    a.out = (float*)d_out; a.ws = (unsigned char*)d_ws; a.ph_lo = 0; a.ph_hi = 0;
    hipLaunchKernelGGL(mk_fwd, dim3(grid), dim3(NTHREADS), LDS_BYTES, stream, a);
}
```

```cpp
#include <hip/hip_runtime.h>
#include <cstdio>
#include <cstdint>

#ifndef REP_PRO
#define REP_PRO 1
#endif
#ifndef REP_MIX
#define REP_MIX 1
#endif
#ifndef REP_INPROJ
#define REP_INPROJ 1
#endif
#ifndef REP_DUP
#define REP_DUP 1
#endif
#ifndef REP_MOEUP
#define REP_MOEUP 1
#endif
#ifndef REP_MOEDN
#define REP_MOEDN 1
#endif
#ifndef REP_CONV
#define REP_CONV 1
#endif
#ifndef MX_LATE
#define MX_LATE 0
#endif
#ifndef ML_CHUNK
#define ML_CHUNK 1
#endif
#ifndef MOE_FP8
#define MOE_FP8 1
#endif
#ifndef DENSE_F8_UP
#define DENSE_F8_UP 2
#endif
#ifndef DENSE_F8_DN
#define DENSE_F8_DN 3
#endif
#ifndef MOE_TAIL_KS
#define MOE_TAIL_KS (MOE_FP8 ? 2 : 4)
#endif
#ifndef CONV_NOBAR
#define CONV_NOBAR 0
#endif
#ifndef NAIVE_MIX
#define NAIVE_MIX 0
#endif

constexpr int T = 16384, DM = 1024, SEQ = 2048, NBATCH = 8, DEPTH = 4;
constexpr int PIN = 3592, NPROJ = 3584;
constexpr int FFD = 2752, FFDP = 2816, FFE = 3584, NEXP = 8;
constexpr int HM = 4, DHM = 128, HS = 8, DHS = 64;
constexpr float EPS = 1e-6f;
constexpr float LOG2E = 1.4426950408889634f;
constexpr float QS_SCALE = 0.125f * LOG2E;
constexpr float KM_SCALE = 0.08838834764831845f;
constexpr int NWAVES = 8, NTHREADS = 512;
constexpr float F8_WGU = 64.0f, F8_WD = 128.0f, F8_HID = 8.0f, F8_MAX = 448.0f;

constexpr size_t MiB = 1u << 20;
constexpr size_t WS_CTL = 0, CTL_ZERO_BYTES = 1 * MiB;
constexpr size_t WS_WIN = 1 * MiB;
constexpr size_t WS_WOUT = 29 * MiB;
constexpr size_t WS_WGU = 37 * MiB;
constexpr size_t WS_WD = 59 * MiB;
constexpr size_t WS_MGU = 70 * MiB;
constexpr size_t WS_H8 = WS_MGU + 112 * MiB;
constexpr size_t WS_MD = 294 * MiB;
constexpr size_t WS_Y = 406 * MiB;
constexpr size_t WS_MIXED = 438 * MiB;
constexpr size_t WS_G = 470 * MiB;
constexpr size_t WS_GA = WS_G + 512 * 1024, WS_GM = WS_GA + 256 * 1024, WS_GE = WS_GM + 256 * 1024, WS_TG = WS_GE + 256 * 1024;
constexpr size_t WS_RINFO = 472 * MiB;
constexpr size_t WS_O2 = 474 * MiB;
constexpr size_t WS_BIG = 538 * MiB;
constexpr size_t WS_PROJ = WS_BIG, WS_QKC = WS_BIG + 112 * MiB, WS_HIDM = WS_BIG;
constexpr size_t WS_U = WS_BIG + 238 * MiB;
constexpr size_t WS_NV = WS_U + 15 * MiB, WS_CM = WS_NV + 128 * 1024;
constexpr size_t WS_RREC = WS_CM + 128 * 1024, WS_CNTW = WS_RREC + 512 * 1024;
constexpr size_t WS_HID = WS_BIG + 144 * MiB;
constexpr size_t WS_H16 = WS_U + 16 * MiB;
constexpr size_t WS_RS = WS_H16 + 32 * MiB, WS_RSI = WS_RS + 64 * 1024;
constexpr size_t WS_END = WS_H16 + 33 * MiB;
constexpr int HIDM_ROWS = 2 * T + 2048;
static_assert((size_t)HIDM_ROWS * FFE * 2 <= 238 * MiB, "hidm");
constexpr int CW_TMO = 0;
constexpr int CW_CNT = 64;
constexpr int CW_BAR = 4096;
constexpr int CW_INP = 3264;
constexpr int CW_CONV = 3200;
constexpr int CW_GB = 8192;
constexpr int CW_TAIL = 2048;

constexpr int RING_OFF = 0, RING_BYTES = 131072;
constexpr int MISC_OFF = 155648;
constexpr int LDS_BYTES = 163840;

#define GAS __attribute__((address_space(1)))
#define LAS __attribute__((address_space(3)))
typedef unsigned short bf16;
typedef unsigned v4u __attribute__((ext_vector_type(4)));
typedef unsigned v2u __attribute__((ext_vector_type(2)));
typedef float f32x4 __attribute__((ext_vector_type(4)));
typedef int i32x4 __attribute__((ext_vector_type(4)));
typedef float f32x2 __attribute__((ext_vector_type(2)));
typedef short bf16x8 __attribute__((ext_vector_type(8)));
typedef int i32x8 __attribute__((ext_vector_type(8)));
typedef GAS unsigned gu32;
#define RLX_AGENT __ATOMIC_RELAXED, __HIP_MEMORY_SCOPE_AGENT
#define LDS_WAIT() asm volatile("s_waitcnt lgkmcnt(0)" ::: "memory")
#define VM_WAIT() asm volatile("s_waitcnt vmcnt(0)" ::: "memory")

__device__ __forceinline__ unsigned f2bf(float f) { unsigned u = __builtin_bit_cast(unsigned, f); return (u + 0x7fffu + ((u >> 16) & 1u)) >> 16; }
__device__ __forceinline__ unsigned pk2(float lo, float hi) { return f2bf(lo) | (f2bf(hi) << 16); }
__device__ __forceinline__ unsigned pk4_f8(float a, float b, float c, float d) { int w = __builtin_amdgcn_cvt_pk_fp8_f32(a, b, 0, false); w = __builtin_amdgcn_cvt_pk_fp8_f32(c, d, w, true); return (unsigned)w; }
__device__ __forceinline__ float bf2f(unsigned b) { return __builtin_bit_cast(float, b << 16); }
__device__ __forceinline__ float bflo(unsigned w) { return __builtin_bit_cast(float, w << 16); }
__device__ __forceinline__ float bfhi(unsigned w) { return __builtin_bit_cast(float, w & 0xffff0000u); }
__device__ __forceinline__ int lane_id() { return (int)__builtin_amdgcn_mbcnt_hi(~0u, __builtin_amdgcn_mbcnt_lo(~0u, 0u)); }
#define dpp_f(old, src, ctrl, rmask) __builtin_bit_cast(float, __builtin_amdgcn_update_dpp(__builtin_bit_cast(int, (float)(old)), __builtin_bit_cast(int, (float)(src)), ctrl, rmask, 0xf, false))
__device__ __forceinline__ float sxor32(float v, int hi) { auto rr = __builtin_amdgcn_permlane32_swap(__builtin_bit_cast(unsigned, v), __builtin_bit_cast(unsigned, v), false, false);
    return __builtin_bit_cast(float, hi ? rr[0] : rr[1]); }
__device__ __forceinline__ float quad_sum(float v) { v += dpp_f(0.f, v, 0xB1, 0xf); v += dpp_f(0.f, v, 0x4E, 0xf); return v; }
__device__ __forceinline__ float oct_sum(float v, int lane) { v = quad_sum(v); const float dn = dpp_f(0.f, v, 0x114, 0xf), up = dpp_f(0.f, v, 0x104, 0xf); return v + ((lane & 4) ? dn : up); }
#define DPP_SCAN(v, OP, ID) do { v = OP(v, __builtin_bit_cast(float, __builtin_amdgcn_update_dpp(__builtin_bit_cast(int, ID), __builtin_bit_cast(int, v), 0x111, 0xf, 0xf, false))); \
    v = OP(v, __builtin_bit_cast(float, __builtin_amdgcn_update_dpp(__builtin_bit_cast(int, ID), __builtin_bit_cast(int, v), 0x112, 0xf, 0xf, false))); \
    v = OP(v, __builtin_bit_cast(float, __builtin_amdgcn_update_dpp(__builtin_bit_cast(int, ID), __builtin_bit_cast(int, v), 0x114, 0xf, 0xf, false))); \
    v = OP(v, __builtin_bit_cast(float, __builtin_amdgcn_update_dpp(__builtin_bit_cast(int, ID), __builtin_bit_cast(int, v), 0x118, 0xf, 0xf, false))); \
    v = OP(v, __builtin_bit_cast(float, __builtin_amdgcn_update_dpp(__builtin_bit_cast(int, ID), __builtin_bit_cast(int, v), 0x142, 0xa, 0xf, false))); \
    v = OP(v, __builtin_bit_cast(float, __builtin_amdgcn_update_dpp(__builtin_bit_cast(int, ID), __builtin_bit_cast(int, v), 0x143, 0xc, 0xf, false))); } while (0)
#define OP_ADD(a, b) ((a) + (b))
#define OP_MAX(a, b) fmaxf((a), (b))
__device__ __forceinline__ float wave_sum(float v) { DPP_SCAN(v, OP_ADD, 0.0f); return __builtin_bit_cast(float, __builtin_amdgcn_readlane(__builtin_bit_cast(int, v), 63)); }

namespace pg8 {
#define PG8_LAS __attribute__((address_space(3)))
typedef unsigned short bf16_t;
typedef unsigned u32x4 __attribute__((ext_vector_type(4)));
constexpr int BM = 256, BK = 64, HALF = 128, HTB = HALF * BK * 2, STAGE_BYTES = 8 * HTB, NXCD = 8, WGM = 8;

__host__ __device__ __forceinline__ int lds_byte(int r, int c) { const int st = (r >> 4) * 2 + (c >> 5), rr = r & 15, cc = c & 31, ob = rr * 64 + cc * 2; return st * 1024 + (ob ^ (((ob >> 9) & 1) << 5)); }
__host__ __device__ __forceinline__ void stage_rc(int b, int& R, int& C) { const int st = b / 1024, sb = b % 1024, swz = sb ^ (((sb >> 9) & 1) << 5); R = (st >> 1) * 16 + swz / 64; C = (st & 1) * 32 + (swz % 64) / 2; }
__host__ __device__ __forceinline__ int perm32(int rho) { const int n = rho >> 4, i = rho & 15; return 8 * (i >> 2) + 4 * n + (i & 3); }

struct Unit { int pm, pn, e, pml, nvalid; };

__device__ __forceinline__ void tile_decode(int wgid, int nM, int nN, int& pm, int& pn) {
    const int nig = WGM * nN, gid = wgid / nig, fm = gid * WGM, gsz = (nM - fm) < WGM ? (nM - fm) : WGM;
    pm = fm + ((wgid % nig) % gsz); pn = (wgid % nig) / gsz;
}
__device__ __forceinline__ int xcd_remap(int L, int nwg) { const int q = nwg / NXCD, r = nwg % NXCD, xcd = L % NXCD, off = L / NXCD; return (xcd < r ? xcd * (q + 1) : r * (q + 1) + (xcd - r) * q) + off; }

template <bool F8> struct DenseOrderT {
    static constexpr bool GATHER = false, FP8 = F8;
    const char* A; const char* B; int K, KT; int nM, nN, nwg, G, c;
    __device__ void init(const void* A_, const void* B_, int M, int N, int K_, int G_, int c_) { A = (const char*)A_; B = (const char*)B_; K = K_; KT = K_ / BK; nM = M / BM; nN = N / BM; nwg = nM * nN; G = G_; c = c_; }
    __device__ __forceinline__ bool next(int i, Unit& u) const {
        const long L = (long)i * G + c; if (L >= nwg) return false;
        const int wgid = xcd_remap((int)L, nwg); tile_decode(wgid, nM, nN, u.pm, u.pn); u.e = 0; u.pml = u.pm; u.nvalid = BM; return true;
    }
    __device__ __forceinline__ const char* a_ptr(const Unit& u) const { return A + (size_t)u.pm * ((size_t)BM * K * 2); }
    __device__ __forceinline__ const char* b_ptr(const Unit& u) const { return B + (size_t)u.pn * ((size_t)BM * K * 2); }
    __device__ __forceinline__ unsigned grow(const Unit&, int) const { return 0u; }
    __device__ __forceinline__ const unsigned* rptr(const Unit&, int) const { return nullptr; }
};
typedef DenseOrderT<false> DenseOrder;
struct InprojOrder {
    static constexpr bool GATHER = false, FP8 = false;
    const char* A; const char* B; int K, KT, nM, nN, G, c, i0, ni;
    __device__ void init(const void* A_, const void* B_, int M, int N, int K_, int G_, int c_, int i0_, int ni_) { A = (const char*)A_; B = (const char*)B_; K = K_; KT = K_ / BK; nM = M / BM; nN = N / BM; G = G_; c = c_; i0 = i0_; ni = ni_; }
    __device__ __forceinline__ bool next(int i, Unit& u) const {
        if (i >= ni) return false;
        const int off = (i0 + i) * (G >> 3) + (c >> 3); if (off >= WGM * nN) return false;
        tile_decode((c & 7) * WGM * nN + off, nM, nN, u.pm, u.pn); u.e = 0; u.pml = u.pm; u.nvalid = BM; return true;
    }
    __device__ __forceinline__ const char* a_ptr(const Unit& u) const { return A + (size_t)u.pm * ((size_t)BM * K * 2); }
    __device__ __forceinline__ const char* b_ptr(const Unit& u) const { return B + (size_t)u.pn * ((size_t)BM * K * 2); }
    __device__ __forceinline__ unsigned grow(const Unit&, int) const { return 0u; }
    __device__ __forceinline__ const unsigned* rptr(const Unit&, int) const { return nullptr; }
};
template <bool GATH> struct MoeOrder {
    static constexpr bool GATHER = GATH, FP8 = MOE_FP8 != 0;

    const char* A; const char* B; int K, KT; size_t bstride; int nN, nwg, G, c; const volatile LAS int* tab; const uint2* rinfo;
    __device__ void init(const void* A_, const void* B_, size_t bstride_, int N, int K_, int G_, int c_, const volatile LAS int* tab_, const uint2* rinfo_) {
        A = (const char*)A_; B = (const char*)B_; K = K_; KT = K_ / BK; bstride = bstride_; nN = N / BM; G = G_; c = c_; tab = tab_; rinfo = rinfo_; nwg = tab_[8] * nN; }
    __device__ __forceinline__ bool next(int i, Unit& u) const {
        const long L = (long)i * G + c; if (L >= nwg) return false;
        decode(xcd_remap((int)L, nwg), u); return true;
    }
    __device__ __forceinline__ void decode(const int wgid, Unit& u) const {
        int e = 0;
#pragma unroll
        for (int j = 1; j < 8; ++j) if (wgid >= tab[j] * nN) e = j;
        const int t0 = tab[e], nMe = tab[e + 1] - t0, cnt = tab[16 + e];
        int pml, pn;
        if (GATH) {
            const int ng = (nMe + WGM - 1) / WGM, bs = nMe / ng, ex = nMe - bs * ng, big = (bs + 1) * 4;
            int w = wgid - t0 * nN, fm, gsz;
            const int cb = w / (4 * nMe); w -= cb * 4 * nMe;
            if (w < ex * big) { const int g = w / big; w -= g * big; gsz = bs + 1; fm = g * (bs + 1); }
            else { w -= ex * big; const int g = w / (bs * 4); w -= g * bs * 4; gsz = bs; fm = ex * (bs + 1) + g * bs; }
            pml = fm + w % gsz; pn = 4 * cb + w / gsz;
        } else tile_decode(wgid - t0 * nN, nMe, nN, pml, pn);
        u.e = __builtin_amdgcn_readfirstlane(e); u.pml = __builtin_amdgcn_readfirstlane(pml); u.pn = __builtin_amdgcn_readfirstlane(pn); u.pm = __builtin_amdgcn_readfirstlane(t0 + pml);
        const int nv = cnt - pml * BM; u.nvalid = __builtin_amdgcn_readfirstlane(nv < BM ? nv : BM);
    }
    __device__ __forceinline__ const char* a_ptr(const Unit& u) const { return GATH ? A : A + (size_t)u.pm * ((size_t)BM * K * 2); }
    __device__ __forceinline__ const char* b_ptr(const Unit& u) const { return B + (size_t)u.e * bstride + (size_t)u.pn * ((size_t)BM * K * 2); }
    __device__ __forceinline__ const unsigned* rptr(const Unit& u, int r) const { const int rr = r < u.nvalid ? r : u.nvalid - 1; return (const unsigned*)(rinfo + (size_t)u.e * T + (size_t)u.pml * BM + rr); }
    __device__ __forceinline__ unsigned grow(const Unit& u, int r) const {
        const int rr = r < u.nvalid ? r : u.nvalid - 1;
        const unsigned ts = rinfo[(size_t)u.e * T + (size_t)u.pml * BM + rr].x;
        return (ts >> 1) * (unsigned)(K * 2);
    }
};

__device__ __forceinline__ const char* uni_ptr(const char* p) { const unsigned long long v = (unsigned long long)p; const unsigned lo = __builtin_amdgcn_readfirstlane((unsigned)v), hi = __builtin_amdgcn_readfirstlane((unsigned)(v >> 32));
    return (const char*)(((unsigned long long)hi << 32) | lo); }
__device__ __forceinline__ unsigned cvt_pk_bf16(float lo, float hi) { unsigned r; asm volatile("v_cvt_pk_bf16_f32 %0, %1, %2" : "=v"(r) : "v"(lo), "v"(hi)); return r; }

struct EpiProj {
    static constexpr bool PERM = true, RSLDS = true;
    bf16_t* O; const float* RS;
    __device__ __forceinline__ const float* rs_base(const Unit& u) const { return RS + (size_t)u.pm * BM; }
    __device__ __forceinline__ void operator()(const f32x4 (&acc)[2][2][4][2], const Unit& u, int wr, int wc, int fr, int fq, const PG8_LAS float* rsl) const {
        const int row0 = u.pm * BM + wr * 64 + fr, col0 = u.pn * BM + wc * 64 + 8 * fq;
        const float sc0 = (u.pn == 8 || u.pn == 9) ? QS_SCALE : 1.0f;
        float rsv[2][4];
#pragma unroll
        for (int ai = 0; ai < 2; ++ai)
#pragma unroll
            for (int m = 0; m < 4; ++m) rsv[ai][m] = rsl[wr * 64 + fr + ai * HALF + m * 16];
#pragma unroll
        for (int ai = 0; ai < 2; ++ai)
#pragma unroll
            for (int m = 0; m < 4; ++m) { bf16_t* rowp = O + (size_t)(row0 + ai * HALF + m * 16) * NPROJ + col0; const float sc = sc0 * rsv[ai][m];
#pragma unroll
                for (int bj = 0; bj < 2; ++bj) { const f32x4 v0 = acc[ai][bj][m][0] * sc, v1 = acc[ai][bj][m][1] * sc;
                    u32x4 w; w.x = cvt_pk_bf16(v0[0], v0[1]); w.y = cvt_pk_bf16(v0[2], v0[3]); w.z = cvt_pk_bf16(v1[0], v1[1]); w.w = cvt_pk_bf16(v1[2], v1[3]);
                    *(u32x4*)(rowp + bj * 32) = w; } }
    }
};
struct EpiResid {
    static constexpr bool PERM = false, RSLDS = false;
    const float* Hin; float* Hout;
    __device__ __forceinline__ void operator()(const f32x4 (&acc)[2][2][4][2], const Unit& u, int wr, int wc, int fr, int fq) const {
        const int row0 = u.pm * BM + wr * 64 + fr, col0 = u.pn * BM + wc * 32 + 4 * fq;
#pragma unroll
        for (int ai = 0; ai < 2; ++ai)
#pragma unroll
            for (int mh = 0; mh < 2; ++mh) {
                f32x4 hv[2][2][2];
#pragma unroll
                for (int m2 = 0; m2 < 2; ++m2) { const size_t off = (size_t)(row0 + ai * HALF + (2 * mh + m2) * 16) * DM + col0;
#pragma unroll
                    for (int bj = 0; bj < 2; ++bj)
#pragma unroll
                        for (int n = 0; n < 2; ++n) hv[m2][bj][n] = *(const f32x4*)(Hin + off + bj * HALF + n * 16); }
                asm volatile("" : "+v"(hv[0][0][0]), "+v"(hv[0][0][1]), "+v"(hv[0][1][0]), "+v"(hv[0][1][1]), "+v"(hv[1][0][0]), "+v"(hv[1][0][1]), "+v"(hv[1][1][0]), "+v"(hv[1][1][1]));
#pragma unroll
                for (int m2 = 0; m2 < 2; ++m2) { const size_t off = (size_t)(row0 + ai * HALF + (2 * mh + m2) * 16) * DM + col0;
#pragma unroll
                    for (int bj = 0; bj < 2; ++bj)
#pragma unroll
                        for (int n = 0; n < 2; ++n) *(f32x4*)(Hout + off + bj * HALF + n * 16) = hv[m2][bj][n] + acc[ai][bj][2 * mh + m2][n]; }
            }
    }
};
template <bool XIN> struct EpiResid16 {
    static constexpr bool PERM = true, RSLDS = false;
    const float* X; bf16_t* H; float sc;
    __device__ __forceinline__ void operator()(const f32x4 (&acc)[2][2][4][2], const Unit& u, int wr, int wc, int fr, int fq) const {
        const int row0 = u.pm * BM + wr * 64 + fr, col0 = u.pn * BM + wc * 64 + 8 * fq;
#pragma unroll
        for (int ai = 0; ai < 2; ++ai) {
            u32x4 hb[4][2];
#pragma unroll
            for (int m = 0; m < 4; ++m)
#pragma unroll
                for (int bj = 0; bj < 2; ++bj) hb[m][bj] = *(const u32x4*)(H + (size_t)(row0 + ai * HALF + m * 16) * DM + col0 + bj * 32);
            asm volatile("" : "+v"(hb[0][0]), "+v"(hb[0][1]), "+v"(hb[1][0]), "+v"(hb[1][1]), "+v"(hb[2][0]), "+v"(hb[2][1]), "+v"(hb[3][0]), "+v"(hb[3][1]));
#pragma unroll
            for (int m = 0; m < 4; ++m)
#pragma unroll
                for (int bj = 0; bj < 2; ++bj) { const u32x4 b = hb[m][bj];
                    const f32x4 h0 = (f32x4){__builtin_bit_cast(float, b.x << 16), __builtin_bit_cast(float, b.x & 0xffff0000u), __builtin_bit_cast(float, b.y << 16), __builtin_bit_cast(float, b.y & 0xffff0000u)};
                    const f32x4 h1 = (f32x4){__builtin_bit_cast(float, b.z << 16), __builtin_bit_cast(float, b.z & 0xffff0000u), __builtin_bit_cast(float, b.w << 16), __builtin_bit_cast(float, b.w & 0xffff0000u)};
                    const f32x4 r0 = h0 + acc[ai][bj][m][0] * sc, r1 = h1 + acc[ai][bj][m][1] * sc;
                    u32x4 w; w.x = cvt_pk_bf16(r0[0], r0[1]); w.y = cvt_pk_bf16(r0[2], r0[3]); w.z = cvt_pk_bf16(r1[0], r1[1]); w.w = cvt_pk_bf16(r1[2], r1[3]);
                    *(u32x4*)(H + (size_t)(row0 + ai * HALF + m * 16) * DM + col0 + bj * 32) = w; }
        }
    }
};
__device__ __forceinline__ float silu_mul(float g, float u) { return g * u * __builtin_amdgcn_rcpf(1.0f + __builtin_amdgcn_exp2f(-g * LOG2E)); }
struct EpiSwiglu {
    static constexpr bool PERM = true, RSLDS = true;
    bf16_t* O; int ld; const float* RS; const float* RSI;
    __device__ __forceinline__ const float* rs_base(const Unit& u) const { return RSI ? RSI + (size_t)u.e * T + (size_t)u.pml * BM : RS + (size_t)u.pm * BM; }
    __device__ __forceinline__ void operator()(const f32x4 (&acc)[2][2][4][2], const Unit& u, int wr, int wc, int fr, int fq, const PG8_LAS float* rsl) const {
        const int row0 = u.pm * BM + wr * 64 + fr, col0 = u.pn * HALF + wc * 32 + 8 * fq;
        float rsv[2][4];
#pragma unroll
        for (int ai = 0; ai < 2; ++ai)
#pragma unroll
            for (int m = 0; m < 4; ++m) rsv[ai][m] = rsl[wr * 64 + fr + ai * HALF + m * 16];
#pragma unroll
        for (int ai = 0; ai < 2; ++ai)
#pragma unroll
            for (int m = 0; m < 4; ++m) { bf16_t* rowp = O + (size_t)(row0 + ai * HALF + m * 16) * ld + col0; const float rs = rsv[ai][m];
                const f32x4 g0 = acc[ai][0][m][0] * rs, g1 = acc[ai][0][m][1] * rs, u0 = acc[ai][1][m][0] * rs, u1 = acc[ai][1][m][1] * rs;
                u32x4 w; w.x = cvt_pk_bf16(silu_mul(g0[0], u0[0]), silu_mul(g0[1], u0[1])); w.y = cvt_pk_bf16(silu_mul(g0[2], u0[2]), silu_mul(g0[3], u0[3]));
                w.z = cvt_pk_bf16(silu_mul(g1[0], u1[0]), silu_mul(g1[1], u1[1])); w.w = cvt_pk_bf16(silu_mul(g1[2], u1[2]), silu_mul(g1[3], u1[3]));
                *(u32x4*)rowp = w; }
    }
};
template <bool RSL> struct EpiSwiglu8T {
    static constexpr bool PERM = true, RSLDS = RSL;
    unsigned char* O; int ld; float sc; const float* RS;
    __device__ __forceinline__ const float* rs_base(const Unit& u) const { return RS + (size_t)u.pm * BM; }
    __device__ __forceinline__ void operator()(const f32x4 (&acc)[2][2][4][2], const Unit& u, int wr, int wc, int fr, int fq) const { body(acc, u, wr, wc, fr, fq, nullptr); }
    __device__ __forceinline__ void operator()(const f32x4 (&acc)[2][2][4][2], const Unit& u, int wr, int wc, int fr, int fq, const PG8_LAS float* rsl) const { body(acc, u, wr, wc, fr, fq, rsl); }
    __device__ __forceinline__ void body(const f32x4 (&acc)[2][2][4][2], const Unit& u, int wr, int wc, int fr, int fq, const PG8_LAS float* rsl) const {
        const int row0 = u.pm * BM + wr * 64 + fr, col0 = u.pn * HALF + wc * 32 + 8 * fq;
#pragma unroll
        for (int ai = 0; ai < 2; ++ai)
#pragma unroll
            for (int m = 0; m < 4; ++m) { unsigned char* rowp = O + (size_t)(row0 + ai * HALF + m * 16) * ld + col0;
                const float sr = RSL ? rsl[wr * 64 + fr + ai * HALF + m * 16] : sc;
                const float cg = -sr * LOG2E, cu = sr * sr * F8_HID;
                float h[8];
#pragma unroll
                for (int q = 0; q < 8; ++q) { const float ag = acc[ai][0][m][q >> 2][q & 3], au = acc[ai][1][m][q >> 2][q & 3];
                    h[q] = __builtin_amdgcn_fmed3f((ag * au) * (cu * __builtin_amdgcn_rcpf(1.0f + __builtin_amdgcn_exp2f(ag * cg))), -F8_MAX, F8_MAX); }
                typedef unsigned u32x2_ __attribute__((ext_vector_type(2)));
                *(u32x2_*)rowp = (u32x2_){pk4_f8(h[0], h[1], h[2], h[3]), pk4_f8(h[4], h[5], h[6], h[7])}; }
    }
};
typedef EpiSwiglu8T<false> EpiSwiglu8;
struct EpiScatter {
    static constexpr bool PERM = true, RSLDS = false;
    bf16_t* O2; const uint2* rinfo; float sc;
    __device__ __forceinline__ void operator()(const f32x4 (&acc)[2][2][4][2], const Unit& u, int wr, int wc, int fr, int fq) const {
        const int col0 = u.pn * BM + wc * 64 + 8 * fq;
        uint2 inf[2][4];
#pragma unroll
        for (int ai = 0; ai < 2; ++ai)
#pragma unroll
            for (int m = 0; m < 4; ++m) { const int rl = ai * HALF + wr * 64 + m * 16 + fr; const int rc = rl < u.nvalid ? rl : u.nvalid - 1;
                inf[ai][m] = rinfo[(size_t)u.e * T + (size_t)u.pml * BM + rc]; }
#pragma unroll
        for (int ai = 0; ai < 2; ++ai)
#pragma unroll
            for (int m = 0; m < 4; ++m) asm volatile("" : "+v"(inf[ai][m].x), "+v"(inf[ai][m].y));
#pragma unroll
        for (int ai = 0; ai < 2; ++ai)
#pragma unroll
            for (int m = 0; m < 4; ++m) { const int rl = ai * HALF + wr * 64 + m * 16 + fr;
                if (rl < u.nvalid) { const float wgt = __builtin_bit_cast(float, inf[ai][m].y) * sc;
                    bf16_t* rowp = O2 + ((size_t)(inf[ai][m].x & 1u) * T + (size_t)(inf[ai][m].x >> 1)) * DM + col0;
#pragma unroll
                    for (int bj = 0; bj < 2; ++bj) { const f32x4 v0 = acc[ai][bj][m][0] * wgt, v1 = acc[ai][bj][m][1] * wgt;
                        u32x4 w; w.x = cvt_pk_bf16(v0[0], v0[1]); w.y = cvt_pk_bf16(v0[2], v0[3]); w.z = cvt_pk_bf16(v1[0], v1[1]); w.w = cvt_pk_bf16(v1[2], v1[3]);
                        *(u32x4*)(rowp + bj * 32) = w; } } }
    }
};

struct MoeTailOrder {
    static constexpr bool GATHER = false, FP8 = MOE_FP8 != 0;
    MoeOrder<false> base; const char* A; const char* B; int K, KT, slice, wgid; bool have;
    __device__ void init(const MoeOrder<false>& b, int nmain, int rem, int ks, int c) { base = b; A = b.A; B = b.B; K = b.K; KT = b.KT / ks; have = c < rem * ks; slice = c / (rem > 0 ? rem : 1); wgid = nmain + c % (rem > 0 ? rem : 1); }
    __device__ __forceinline__ bool next(int i, Unit& u) const { if (i != 0 || !have) return false; base.decode(wgid, u); return true; }
    __device__ __forceinline__ const char* a_ptr(const Unit& u) const { return base.a_ptr(u) + (size_t)slice * KT * (BK * 2); }
    __device__ __forceinline__ const char* b_ptr(const Unit& u) const { return base.b_ptr(u) + (size_t)slice * KT * (BK * 2); }
    __device__ __forceinline__ unsigned grow(const Unit&, int) const { return 0u; }
    __device__ __forceinline__ const unsigned* rptr(const Unit&, int) const { return nullptr; }
};
struct EpiPartial {
    static constexpr bool PERM = true, RSLDS = false;
    float* P;
    __device__ __forceinline__ void operator()(const f32x4 (&acc)[2][2][4][2], const Unit&, int wr, int wc, int fr, int fq) const {
        const int tid = (wr * 4 + wc) * 64 + fq * 16 + fr;
#pragma unroll
        for (int ai = 0; ai < 2; ++ai)
#pragma unroll
            for (int bj = 0; bj < 2; ++bj)
#pragma unroll
                for (int m = 0; m < 4; ++m)
#pragma unroll
                    for (int n = 0; n < 2; ++n) *(f32x4*)(P + ((size_t)((((ai * 2 + bj) * 4 + m) * 2 + n) * 512 + tid)) * 4) = acc[ai][bj][m][n];
    }
};

template <class Epi, class Sched, bool ALIGN_EPI>
__device__ __forceinline__ void gemm_phase(PG8_LAS unsigned char* lds, const Sched& S, const Epi& E, const int tid) {
    const int wid = __builtin_amdgcn_readfirstlane(tid >> 6), lane = tid & 63, wr = wid >> 2, wc = wid & 3, fr = lane & 15, fq = lane >> 4;
    const int K = S.K, nt = S.KT;
    constexpr bool GA = Sched::GATHER;
    unsigned voffA[2], voffB[2]; int RA[2], CA[2];
#pragma unroll
    for (int i = 0; i < 2; ++i) { int R, C; stage_rc(tid * 16 + i * 8192, R, C); const int Rb = Epi::PERM ? ((R >> 5) * 64 + perm32(R & 31)) : R;
        RA[i] = R; CA[i] = C; voffA[i] = GA ? (unsigned)(C * 2) : (unsigned)(R * K + C) * 2u; voffB[i] = (unsigned)(Rb * K + C) * 2u; }
    const size_t kstep = (size_t)(BK * 2);
    const size_t hstep = (size_t)HALF * K * 2;
    const size_t hstepB = Epi::PERM ? (size_t)32 * K * 2 : hstep;
    const unsigned ldsw = (unsigned)wid * 1024u;
    const int aoff = lds_byte(wr * 64 + fr, fq * 8), boff = lds_byte(wc * 32 + fr, fq * 8);
#define PG8_SA(b, h) (((b) * 2 + (h)) * HTB)
#define PG8_SB(b, h) ((4 + (b) * 2 + (h)) * HTB)
#define PG8_STAGE(bufoff, gbase, voff) do { const char* _g = (const char*)(gbase); asm volatile("" : "+s"(_g)); _Pragma("unroll") for (int _i = 0; _i < 2; ++_i) { unsigned _v = (voff)[_i]; asm volatile("" : "+v"(_v)); \
        __builtin_amdgcn_global_load_lds((const unsigned*)(_g + _v), (PG8_LAS unsigned*)(lds + (bufoff) + ldsw + _i * 8192), 16, 0, 0); } } while (0)
#define PG8_STAGE_A(bufoff, kb, h, NX) do { if constexpr (GA) { const char* _g = (const char*)(kb); asm volatile("" : "+s"(_g)); _Pragma("unroll") for (int _i = 0; _i < 2; ++_i) { unsigned _o = ((NX) ? gnx[h][_i] : gcu[h][_i]) + voffA[_i]; asm volatile("" : "+v"(_o)); \
        __builtin_amdgcn_global_load_lds((const unsigned*)(_g + _o), (PG8_LAS unsigned*)(lds + (bufoff) + ldsw + _i * 8192), 16, 0, 0); } } \
        else { PG8_STAGE(bufoff, (kb) + (h) * hstep, voffA); } } while (0)
#define PG8_LDA(dst, b, h) do { _Pragma("unroll") for (int m = 0; m < 4; ++m) _Pragma("unroll") for (int k = 0; k < 2; ++k) dst[m][k] = *(const PG8_LAS bf16x8*)(lds + PG8_SA(b, h) + aoff + m * 2048 + k * 1024); } while (0)
#define PG8_LDB(dst, b, h) do { _Pragma("unroll") for (int n = 0; n < 2; ++n) _Pragma("unroll") for (int k = 0; k < 2; ++k) dst[n][k] = *(const PG8_LAS bf16x8*)(lds + PG8_SB(b, h) + boff + n * 2048 + k * 1024); } while (0)
#define PG8_CAT(F) __builtin_shufflevector(__builtin_bit_cast(i32x4, F[0]), __builtin_bit_cast(i32x4, F[1]), 0, 1, 2, 3, 4, 5, 6, 7)
#define PG8_MMA(ai, bj, At, Bt) do { __builtin_amdgcn_s_setprio(1); if constexpr (Sched::FP8) { _Pragma("unroll") for (int m = 0; m < 4; ++m) _Pragma("unroll") for (int n = 0; n < 2; ++n) \
        { const i32x8 _b = PG8_CAT(Bt[n]), _a = PG8_CAT(At[m]); asm volatile("v_mfma_f32_16x16x128_f8f6f4 %0, %1, %2, %0" : "+v"(acc[ai][bj][m][n]) : "v"(_b), "v"(_a)); } } \
        else { _Pragma("unroll") for (int m = 0; m < 4; ++m) _Pragma("unroll") for (int n = 0; n < 2; ++n) _Pragma("unroll") for (int k = 0; k < 2; ++k) \
        acc[ai][bj][m][n] = __builtin_amdgcn_mfma_f32_16x16x32_bf16(Bt[n][k], At[m][k], acc[ai][bj][m][n], 0, 0, 0); } __builtin_amdgcn_s_setprio(0); } while (0)
#define PG8_WAIT_V(n) asm volatile("s_waitcnt vmcnt(" #n ")" ::: "memory")
#define PG8_WAIT_L(n) asm volatile("s_waitcnt lgkmcnt(" #n ")" ::: "memory")
#define PG8_BAR __builtin_amdgcn_s_barrier()
#define PG8_SCHED __builtin_amdgcn_sched_barrier(0)
    Unit cur, nxt; int ui = 0;
    if (!S.next(0, cur)) return;
#define PG8_RS_STAGE(u_, par_) do { if constexpr (Epi::RSLDS) { if (wid < 4) __builtin_amdgcn_global_load_lds((const unsigned*)(E.rs_base(u_) + wid * 64 + lane), (PG8_LAS unsigned*)(lds + STAGE_BYTES + (par_) * 1024 + wid * 256), 4, 0, 0); } } while (0)
    PG8_RS_STAGE(cur, 0);
    unsigned gcu[2][2] = {{0u, 0u}, {0u, 0u}}, gnx[2][2] = {{0u, 0u}, {0u, 0u}};
    if constexpr (GA) {
#pragma unroll
        for (int h = 0; h < 2; ++h)
#pragma unroll
            for (int i = 0; i < 2; ++i) gcu[h][i] = S.grow(cur, h * HALF + RA[i]);
    }
    f32x4 acc[2][2][4][2];
#pragma unroll
    for (int a = 0; a < 2; ++a)
#pragma unroll
        for (int b = 0; b < 2; ++b)
#pragma unroll
            for (int m = 0; m < 4; ++m)
#pragma unroll
                for (int n = 0; n < 2; ++n) acc[a][b][m][n] = (f32x4){0.f, 0.f, 0.f, 0.f};
    bf16x8 At[4][2], B0[2][2], B1[2][2];
    const char* cA = uni_ptr(S.a_ptr(cur)); const char* cB = uni_ptr(S.b_ptr(cur));
    PG8_STAGE(PG8_SB(0, 0), cB, voffB); PG8_STAGE(PG8_SB(0, 1), cB + hstepB, voffB); PG8_STAGE_A(PG8_SA(0, 0), cA, 0, false); PG8_STAGE_A(PG8_SA(0, 1), cA, 1, false);
    if (wr == 1) PG8_BAR;
    PG8_WAIT_V(2); PG8_BAR;
    PG8_STAGE(PG8_SB(1, 0), cB + kstep, voffB); PG8_STAGE_A(PG8_SA(1, 0), cA + kstep, 0, false); PG8_STAGE(PG8_SB(1, 1), cB + hstepB + kstep, voffB);
    PG8_WAIT_V(6); PG8_BAR;
    for (;;) {
        const bool has_next = S.next(ui + 1, nxt);
        const char* nA = uni_ptr(has_next ? S.a_ptr(nxt) : cA); const char* nB = uni_ptr(has_next ? S.b_ptr(nxt) : cB);
        unsigned raw[2][2] = {{0u, 0u}, {0u, 0u}};
        if constexpr (GA) {
            if (has_next) {
#pragma unroll
                for (int h = 0; h < 2; ++h)
#pragma unroll
                    for (int i = 0; i < 2; ++i) { const unsigned* rp = S.rptr(nxt, h * HALF + RA[i]); asm volatile("global_load_dword %0, %1, off" : "=v"(raw[h][i]) : "v"(rp) : "memory"); }
            }
        }
        for (int t = 0; t < nt; t += 2) {
            const bool last = (t == nt - 2);
            if constexpr (GA) { if (last) { asm volatile("" : "+v"(raw[0][0]), "+v"(raw[0][1]), "+v"(raw[1][0]), "+v"(raw[1][1]));
#pragma unroll
                for (int h = 0; h < 2; ++h)
#pragma unroll
                    for (int i = 0; i < 2; ++i) gnx[h][i] = has_next ? (raw[h][i] >> 1) * (unsigned)(K * 2) : gcu[h][i]; } }
            const char* a1 = cA + (size_t)(t + 1) * kstep;
            const char* a2 = last ? nA : cA + (size_t)(t + 2) * kstep; const char* b2 = last ? nB : cB + (size_t)(t + 2) * kstep;
            const char* a3 = a2 + kstep; const char* b3 = b2 + kstep;
            PG8_LDB(B0, 0, 0); PG8_LDB(B1, 0, 1); PG8_SCHED; PG8_LDA(At, 0, 0); PG8_STAGE_A(PG8_SA(1, 1), a1, 1, false);
            PG8_WAIT_V(8); PG8_WAIT_L(0); PG8_BAR; PG8_MMA(0, 0, At, B0); PG8_MMA(0, 1, At, B1); PG8_BAR; PG8_SCHED;
            PG8_LDA(At, 0, 1); PG8_STAGE(PG8_SB(0, 0), b2, voffB); PG8_STAGE(PG8_SB(0, 1), b2 + hstepB, voffB); PG8_STAGE_A(PG8_SA(0, 0), a2, 0, last);
            PG8_WAIT_V(8); PG8_WAIT_L(0); PG8_BAR; PG8_MMA(1, 0, At, B0); PG8_MMA(1, 1, At, B1); PG8_BAR; PG8_SCHED;
            PG8_LDB(B0, 1, 0); PG8_LDB(B1, 1, 1); PG8_SCHED; PG8_LDA(At, 1, 0); PG8_STAGE_A(PG8_SA(0, 1), a2, 1, last);
            PG8_WAIT_V(8); PG8_WAIT_L(0); PG8_BAR; PG8_MMA(0, 0, At, B0); PG8_MMA(0, 1, At, B1); PG8_BAR; PG8_SCHED;
            PG8_LDA(At, 1, 1); PG8_STAGE(PG8_SB(1, 0), b3, voffB); PG8_STAGE(PG8_SB(1, 1), b3 + hstepB, voffB); PG8_STAGE_A(PG8_SA(1, 0), a3, 0, last);
            PG8_WAIT_V(8); PG8_WAIT_L(0); PG8_BAR; PG8_MMA(1, 0, At, B0); PG8_MMA(1, 1, At, B1); PG8_BAR; PG8_SCHED;
        }
        if constexpr (Sched::FP8) asm volatile("s_nop 15\n\ts_nop 15" ::: "memory");
        if constexpr (ALIGN_EPI) { if (wr == 0) PG8_BAR; }
        if constexpr (Epi::RSLDS) E(acc, cur, wr, wc, fr, fq, (const PG8_LAS float*)(lds + STAGE_BYTES + (ui & 1) * 1024)); else E(acc, cur, wr, wc, fr, fq);
        if (!has_next) break;
#pragma unroll
        for (int a = 0; a < 2; ++a)
#pragma unroll
            for (int b = 0; b < 2; ++b)
#pragma unroll
                for (int m = 0; m < 4; ++m)
#pragma unroll
                    for (int n = 0; n < 2; ++n) acc[a][b][m][n] = (f32x4){0.f, 0.f, 0.f, 0.f};
        cur = nxt; cA = nA; cB = nB; ++ui;
        PG8_RS_STAGE(cur, ui & 1);
        if constexpr (GA) {
#pragma unroll
            for (int h = 0; h < 2; ++h)
#pragma unroll
                for (int i = 0; i < 2; ++i) gcu[h][i] = gnx[h][i];
        }
        if constexpr (ALIGN_EPI) { if (wr == 1) PG8_BAR; }
    }
    PG8_WAIT_V(0);
    if constexpr (!ALIGN_EPI) { if (wr == 0) PG8_BAR; }
    PG8_BAR;
#undef PG8_RS_STAGE
#undef PG8_SA
#undef PG8_SB
#undef PG8_STAGE
#undef PG8_STAGE_A
#undef PG8_LDA
#undef PG8_LDB
#undef PG8_MMA
#undef PG8_CAT
#undef PG8_WAIT_V
#undef PG8_WAIT_L
#undef PG8_BAR
#undef PG8_SCHED
}
}

#define XB_TMO      128
#define XB_XCNT(j)  (256  + 64 * (j))
#define XB_XSUB(j)  (1280 + 64 * (j))
#define XB_XGEN(j)  (2304 + 64 * (j))
#define XB_TOP      3328
#define XB_TOPGEN   3392
#define XCD_BAR_WORDS 3456
#define XB_SPIN_CAP (1u << 20)

__device__ __forceinline__ unsigned xb_ld(unsigned* p)              { return __hip_atomic_load(p, __ATOMIC_RELAXED, __HIP_MEMORY_SCOPE_AGENT); }
__device__ __forceinline__ unsigned xb_add(unsigned* p, unsigned v) { return __hip_atomic_fetch_add(p, v, __ATOMIC_RELAXED, __HIP_MEMORY_SCOPE_AGENT); }
__device__ __forceinline__ unsigned xb_xcc_id() { return (unsigned)__builtin_amdgcn_s_getreg((3 << 11) | 20) & 0xFu; }
#define XB_SPIN(cond, bar) do { unsigned _sp = 0; while (cond) { __builtin_amdgcn_s_sleep(1); \
    if ((++_sp & 255u) == 0u) { if (xb_ld(&(bar)[XB_TMO])) break; if (_sp > XB_SPIN_CAP) { atomicAdd(&(bar)[XB_TMO], 1u); break; } } } } while (0)

struct XcdBarrier { unsigned* bar; unsigned x; volatile LAS unsigned* st; };

__device__ __forceinline__ XcdBarrier xcd_barrier_post(unsigned* bar, volatile LAS unsigned* st) {
    XcdBarrier b; b.bar = bar; b.x = xb_xcc_id(); b.st = st;
    if (threadIdx.x == 0) (void)xb_add(&bar[XB_XCNT(b.x)], 1u);
    return b;
}
__device__ __forceinline__ void xcd_barrier_complete(unsigned* bar, unsigned x, unsigned& nloc, unsigned& nx) {
    const unsigned G = gridDim.x * gridDim.y * gridDim.z;
    unsigned sum, cnt, mine, sp = 0u;
    for (;;) {
        sum = 0u; cnt = 0u; mine = 0u;
#pragma unroll
        for (unsigned j = 0; j < 16; ++j) { const unsigned c = xb_ld(&bar[XB_XCNT(j)]); sum += c; cnt += (c > 0u) ? 1u : 0u; mine = (j == x) ? c : mine; }
        if (sum == G) break;
        __builtin_amdgcn_s_sleep(1);
        if ((++sp & 255u) == 0u) { if (xb_ld(&bar[XB_TMO])) break; if (sp > XB_SPIN_CAP) { atomicAdd(&bar[XB_TMO], 1u); break; } }
    }
    nloc = mine > 0u ? mine : 1u; nx = cnt > 0u ? cnt : 1u;
}
__device__ __forceinline__ void xcd_barrier(const XcdBarrier& b, const int wave_s) {
    asm volatile("s_waitcnt vmcnt(0)" ::: "memory");
    __syncthreads();
    if (wave_s == 0 && lane_id() == 0) {
        unsigned* bar = b.bar;
        __builtin_amdgcn_s_waitcnt(0);
        unsigned nloc = b.st[0], nx = b.st[1];
        if (nloc == 0u) { xcd_barrier_complete(bar, b.x, nloc, nx); b.st[0] = nloc; b.st[1] = nx; }
        const unsigned old = xb_add(&bar[XB_XSUB(b.x)], 1u);
        const unsigned gen = old / nloc;
        if (old + 1u == (gen + 1u) * nloc) {
            __builtin_amdgcn_fence(__ATOMIC_RELEASE, "agent");
            asm volatile("s_waitcnt vmcnt(0)" ::: "memory");
            const unsigned og = xb_add(&bar[XB_TOP], 1u);
            const unsigned tg = og / nx;
            if (og + 1u == (tg + 1u) * nx) xb_add(&bar[XB_TOPGEN], 1u);
            else XB_SPIN(xb_ld(&bar[XB_TOPGEN]) == tg, bar);
            __builtin_amdgcn_fence(__ATOMIC_ACQUIRE, "agent");
            xb_add(&bar[XB_XGEN(b.x)], 1u);
            asm volatile("s_waitcnt vmcnt(0)" ::: "memory");
        } else {
            XB_SPIN(xb_ld(&bar[XB_XGEN(b.x)]) == gen, bar);
            __builtin_amdgcn_fence(__ATOMIC_ACQUIRE, "agent");
            asm volatile("s_waitcnt vmcnt(0)" ::: "memory");
        }
    }
    __syncthreads();
}

#define GB_XCNT(x) (64 * (x))
#define GB_SUB(x)  (1024 + 64 * (x))
#define GB_GEN(x)  (2048 + 64 * (x))
#define GB_TOP     3072
#define GB_ASUB(x) (3136 + 32 * (x))
#define GB_ATOP    3712
__device__ __forceinline__ void group_members(gu32* gb, volatile LAS unsigned* st, const unsigned x, unsigned& nloc, unsigned& nx) {
    nloc = st[1]; nx = st[2];
    if (nloc == 0u) { nx = 0u;
        for (unsigned q = 0; q < 16; ++q) { const unsigned c = __hip_atomic_load(gb + GB_XCNT(q), __ATOMIC_RELAXED, __HIP_MEMORY_SCOPE_AGENT); nx += c > 0u ? 1u : 0u; nloc = q == x ? c : nloc; }
        nloc = nloc > 0u ? nloc : 1u; st[1] = nloc; st[2] = nx; }
}
__device__ __forceinline__ void group_arrive(gu32* gb, volatile LAS unsigned* st, const unsigned x, const unsigned r) {
    unsigned nloc, nx; group_members(gb, st, x, nloc, nx);
    const unsigned old = __hip_atomic_fetch_add(gb + GB_ASUB(x), 1u, __ATOMIC_RELAXED, __HIP_MEMORY_SCOPE_AGENT);
    if (old + 1u == r * nloc) { __builtin_amdgcn_fence(__ATOMIC_RELEASE, "agent"); asm volatile("s_waitcnt vmcnt(0)" ::: "memory");
        (void)__hip_atomic_fetch_add(gb + GB_ATOP, 1u, __ATOMIC_RELAXED, __HIP_MEMORY_SCOPE_AGENT); }
}
__device__ __forceinline__ void group_wait(gu32* gb, volatile LAS unsigned* st, const unsigned x, const unsigned r) {
    unsigned nloc, nx; group_members(gb, st, x, nloc, nx);
    unsigned sp = 0u;
    while (__hip_atomic_load(gb + GB_ATOP, __ATOMIC_RELAXED, __HIP_MEMORY_SCOPE_AGENT) < r * nx) { __builtin_amdgcn_s_sleep(1); if (++sp > (1u << 22)) break; }
    __builtin_amdgcn_fence(__ATOMIC_ACQUIRE, "agent");
}
__device__ __forceinline__ void group_barrier(gu32* gb, const int wave_s, volatile LAS unsigned* st, const unsigned x) {
    asm volatile("s_waitcnt vmcnt(0)" ::: "memory");
    __syncthreads();
    if (wave_s == 0 && lane_id() == 0) {
        unsigned nloc, nx; group_members(gb, st, x, nloc, nx);
        const unsigned r = st[0] + 1u; st[0] = r;
        const unsigned old = __hip_atomic_fetch_add(gb + GB_SUB(x), 1u, __ATOMIC_RELAXED, __HIP_MEMORY_SCOPE_AGENT);
        unsigned sp = 0u;
        if (old + 1u == r * nloc) {
            __builtin_amdgcn_fence(__ATOMIC_RELEASE, "agent");
            asm volatile("s_waitcnt vmcnt(0)" ::: "memory");
            (void)__hip_atomic_fetch_add(gb + GB_TOP, 1u, __ATOMIC_RELAXED, __HIP_MEMORY_SCOPE_AGENT);
            while (__hip_atomic_load(gb + GB_TOP, __ATOMIC_RELAXED, __HIP_MEMORY_SCOPE_AGENT) < r * nx) { __builtin_amdgcn_s_sleep(1); if (++sp > (1u << 22)) break; }
            __builtin_amdgcn_fence(__ATOMIC_ACQUIRE, "agent");
            (void)__hip_atomic_fetch_add(gb + GB_GEN(x), 1u, __ATOMIC_RELAXED, __HIP_MEMORY_SCOPE_AGENT);
        } else {
            while (__hip_atomic_load(gb + GB_GEN(x), __ATOMIC_RELAXED, __HIP_MEMORY_SCOPE_AGENT) < r) { __builtin_amdgcn_s_sleep(1); if (++sp > (1u << 22)) break; }
            __builtin_amdgcn_fence(__ATOMIC_ACQUIRE, "agent");
        }
    }
    __syncthreads();
}

struct Args {
    const float* x; const float* norm_mix_g; const float* w_in; const float* b_igate; const float* b_fgate; const float* conv_w; const float* conv_b;
    const float* g_mlstm; const float* g_sb; const float* w_out; const float* norm_ffn_g; const float* ffn_w_gate; const float* ffn_w_up; const float* ffn_w_down;
    const float* w_router; const float* moe_w_gate; const float* moe_w_up; const float* moe_w_down; const float* norm_final_g;
    float* out; unsigned char* ws; int ph_lo, ph_hi;
};
struct Frame {
    LAS unsigned char* lds; volatile LAS unsigned* MISC; gu32* ctl; int tid, lane, wave, G, bid;
};

template <bool F8>
__device__ __forceinline__ void tr_item(const float* src, int ldw, unsigned char* dst, int ldk, LAS float* scr, int lane, const float* gk, const float wsc) {
    const int c = lane & 7;
    f32x4 ga = {1.f, 1.f, 1.f, 1.f}, gb = ga;
    if (gk) { ga = *(const GAS f32x4*)(gk + 8 * c); gb = *(const GAS f32x4*)(gk + 8 * c + 4); }
    {
        const int r8 = lane >> 3, c4 = 4 * (lane & 7);
        f32x4 v[8];
#pragma unroll
        for (int i = 0; i < 8; ++i) v[i] = *(const GAS f32x4*)(src + (size_t)(8 * i + r8) * ldw + c4);
#pragma unroll
        for (int i = 0; i < 8; ++i) { LAS float* d = scr + (8 * i + r8) * 33 + c4; d[0] = v[i].x; d[1] = v[i].y; d[2] = v[i].z; d[3] = v[i].w; }
    }
    LDS_WAIT(); asm volatile("" ::: "memory");
    if constexpr (F8) { ga = ga * wsc; gb = gb * wsc;
#pragma unroll
        for (int j = 0; j < 4; ++j) { const int n = (lane >> 3) + 8 * j; const LAS float* s = scr + (8 * c) * 33 + n;
            v2u o; o.x = pk4_f8(s[0 * 33] * ga.x, s[1 * 33] * ga.y, s[2 * 33] * ga.z, s[3 * 33] * ga.w); o.y = pk4_f8(s[4 * 33] * gb.x, s[5 * 33] * gb.y, s[6 * 33] * gb.z, s[7 * 33] * gb.w);
            *(GAS v2u*)(dst + (size_t)n * ldk + 8 * c) = o; }
    } else {
#pragma unroll
    for (int j = 0; j < 4; ++j) { const int n = (lane >> 3) + 8 * j; const LAS float* s = scr + (8 * c) * 33 + n;
        v4u o; o.x = pk2(s[0 * 33] * ga.x, s[1 * 33] * ga.y); o.y = pk2(s[2 * 33] * ga.z, s[3 * 33] * ga.w); o.z = pk2(s[4 * 33] * gb.x, s[5 * 33] * gb.y); o.w = pk2(s[6 * 33] * gb.z, s[7 * 33] * gb.w);
        *(GAS v4u*)((GAS bf16*)dst + (size_t)n * ldk + 8 * c) = o; }
    }
    LDS_WAIT(); asm volatile("" ::: "memory");
}
template <int ROWMAP, bool F8 = false>
__device__ __forceinline__ bool tr_matrix(int& r, const float* W, int K, int N, int ldw, int c0, void* dstv, int ldk, int drow0, LAS float* scr, int lane, const float* g = nullptr, const float wsc = 1.0f) {
    unsigned char* dst = (unsigned char*)dstv;
    const int nblk = N / 32, items = (K / 64) * nblk;
    if (r >= items) { r -= items; return false; }
    const int kb = r / nblk, nb = r % nblk, k0 = 64 * kb, n0 = 32 * nb;
    const int drow = ROWMAP == 0 ? drow0 + n0 : drow0 + (n0 >> 7) * 256 + ((n0 & 127) >> 5) * 64;
    tr_item<F8>(W + (size_t)k0 * ldw + c0 + n0, ldw, dst + ((size_t)drow * ldk + k0) * (F8 ? 1 : 2), ldk, scr, lane, g ? g + k0 : nullptr, wsc);
    return true;
}
__device__ __forceinline__ void prologue_phase(const Args& a, Frame& F) {
    LAS float* scr = (LAS float*)(F.lds + RING_OFF + F.wave * 16384);
    unsigned char* ws = a.ws;
    const int gw = F.bid * NWAVES + F.wave, NGW = F.G * NWAVES;
    constexpr int I_IN = 16 * 112, I_OUT = 16 * 32, I_DG = 16 * 86, I_DD = 43 * 32, I_MG = 16 * 112, I_MD = 56 * 32;
    constexpr int PER_LAYER_A = I_IN + I_OUT;
    constexpr int PER_DENSE = 2 * I_DG + I_DD;
    constexpr int PER_EXP = 2 * I_MG + I_MD;
    constexpr int NITEMS = 4 * PER_LAYER_A + 2 * PER_DENSE + 16 * PER_EXP;
    for (int it = gw; it < NITEMS; it += NGW) {
        int r = it;
        if (r < 4 * PER_LAYER_A) {
            const int l = r / PER_LAYER_A; r -= l * PER_LAYER_A;
            const float* W = a.w_in + (size_t)l * DM * PIN; bf16* D = (bf16*)(ws + WS_WIN) + (size_t)l * NPROJ * DM;
            if (r < 16 * 64) { (void)tr_matrix<0>(r, W, DM, 2048, PIN, 0, D, DM, 0, scr, F.lane, a.norm_mix_g + l * DM); continue; } r -= 16 * 64;
            if (r < 16 * 48) { (void)tr_matrix<0>(r, W, DM, 1536, PIN, 2056, D, DM, 2048, scr, F.lane, a.norm_mix_g + l * DM); continue; } r -= 16 * 48;
            (void)tr_matrix<0>(r, a.w_out + (size_t)l * DM * DM, DM, DM, DM, 0, (bf16*)(ws + WS_WOUT) + (size_t)l * DM * DM, DM, 0, scr, F.lane); continue;
        }
        r -= 4 * PER_LAYER_A;
        if (r < 2 * PER_DENSE) {
            const int j = r / PER_DENSE; r -= j * PER_DENSE;
            unsigned char* GU = ws + WS_WGU + (size_t)j * 2 * FFDP * DM * 2; unsigned char* WDj = ws + WS_WD + (size_t)j * DM * FFDP * 2;
            if ((DENSE_F8_UP >> j) & 1) {
                if (tr_matrix<1, true>(r, a.ffn_w_gate + (size_t)j * DM * FFD, DM, FFD, FFD, 0, GU, DM, 0, scr, F.lane, a.norm_ffn_g + (2 * j) * DM, F8_WGU)) continue;
                if (tr_matrix<1, true>(r, a.ffn_w_up + (size_t)j * DM * FFD, DM, FFD, FFD, 0, GU, DM, 32, scr, F.lane, a.norm_ffn_g + (2 * j) * DM, F8_WGU)) continue;
            } else {
                if (tr_matrix<1>(r, a.ffn_w_gate + (size_t)j * DM * FFD, DM, FFD, FFD, 0, GU, DM, 0, scr, F.lane, a.norm_ffn_g + (2 * j) * DM)) continue;
                if (tr_matrix<1>(r, a.ffn_w_up + (size_t)j * DM * FFD, DM, FFD, FFD, 0, GU, DM, 32, scr, F.lane, a.norm_ffn_g + (2 * j) * DM)) continue;
            }
            if ((DENSE_F8_DN >> j) & 1) (void)tr_matrix<0, true>(r, a.ffn_w_down + (size_t)j * FFD * DM, FFD, DM, DM, 0, WDj, FFDP, 0, scr, F.lane, nullptr, F8_WD);
            else (void)tr_matrix<0>(r, a.ffn_w_down + (size_t)j * FFD * DM, FFD, DM, DM, 0, WDj, FFDP, 0, scr, F.lane);
            continue;
        }
        r -= 2 * PER_DENSE;
        {
            const int je = r / PER_EXP; r -= je * PER_EXP;
            constexpr bool M8 = MOE_FP8 != 0; constexpr size_t MES = M8 ? 1 : 2;
            unsigned char* GU = ws + WS_MGU + (size_t)je * 2 * FFE * DM * MES;
            if (tr_matrix<1, M8>(r, a.moe_w_gate + (size_t)je * DM * FFE, DM, FFE, FFE, 0, GU, DM, 0, scr, F.lane, a.norm_ffn_g + (2 * (je >> 3) + 1) * DM, F8_WGU)) continue;
            if (tr_matrix<1, M8>(r, a.moe_w_up + (size_t)je * DM * FFE, DM, FFE, FFE, 0, GU, DM, 32, scr, F.lane, a.norm_ffn_g + (2 * (je >> 3) + 1) * DM, F8_WGU)) continue;
            (void)tr_matrix<0, M8>(r, a.moe_w_down + (size_t)je * FFE * DM, FFE, DM, DM, 0, ws + WS_MD + (size_t)je * DM * FFE * MES, FFE, 0, scr, F.lane, nullptr, F8_WD);
        }
    }
    const int gt = F.bid * NTHREADS + F.tid, NGT = F.G * NTHREADS;
    constexpr int RCH = DM * 2 / 16, PCH = 64 * 2 / 16;
    for (int i = gt; i < 2 * 128 * RCH; i += NGT) {
        const int j = i / (128 * RCH), rr = (i / RCH) % 128, ch = i % RCH; const int esz = ((DENSE_F8_UP >> j) & 1) ? 1 : 2;
        const int row = 21 * 256 + 128 + rr;
        if (ch * 16 < DM * esz) *(GAS v4u*)(ws + WS_WGU + (size_t)j * 2 * FFDP * DM * 2 + ((size_t)row * DM) * esz + ch * 16) = (v4u){0u, 0u, 0u, 0u};
    }
    for (int i = gt; i < 2 * DM * PCH; i += NGT) {
        const int j = i / (DM * PCH), row = (i / PCH) % DM, ch = i % PCH; const int esz = ((DENSE_F8_DN >> j) & 1) ? 1 : 2;
        if (ch * 16 < 64 * esz) *(GAS v4u*)(ws + WS_WD + (size_t)j * DM * FFDP * 2 + ((size_t)row * FFDP + FFD) * esz + ch * 16) = (v4u){0u, 0u, 0u, 0u};
    }
}

struct NormIn { const float* src; const bf16* o2; float* hout; const float* gain; bf16* y; const float* w8; int ld8; float* G; unsigned* cnt; uint2* rinfo; int* cntw; int* rrec; const bf16* src16; bf16* hout16; float* rs; unsigned char* h8; };
template <bool B> struct RowSel { typedef f32x4 T; };
template <> struct RowSel<true> { typedef v2u T; };
template <int MODE, bool S16 = false>
__device__ __forceinline__ void norm_phase(Frame& F, const NormIn& p) {
    typedef typename RowSel<S16>::T RowT;
    LAS float* W8 = (LAS float*)(F.lds + RING_OFF);
    LAS int* lcnt = (LAS int*)(F.lds + RING_OFF + 32768);
    LAS int* lbase = lcnt + 8;
    LAS int* rec = lcnt + 16;
    f32x4 wr[(MODE == 0 || MODE == 2) ? 32 : 1];
    if (MODE == 0 || MODE == 2) {
        for (int i = F.tid; i < DM * 2; i += NTHREADS) *(LAS f32x4*)(W8 + 4 * i) = *(const GAS f32x4*)(p.w8 + (size_t)(i >> 1) * p.ld8 + 4 * (i & 1));
        __syncthreads();
#pragma unroll
        for (int j = 0; j < 4; ++j)
#pragma unroll
            for (int c = 0; c < 4; ++c) { const int k = 4 * (F.lane + 64 * j) + c; wr[(j * 4 + c) * 2] = *(const LAS f32x4*)(W8 + k * 8); wr[(j * 4 + c) * 2 + 1] = *(const LAS f32x4*)(W8 + k * 8 + 4); }
        __syncthreads();
    }
    for (int rb0 = F.bid; rb0 < T / 64; rb0 += F.G) {
        const int rb = (rb0 & 7) * 32 + (rb0 >> 3);
        RowT vn[4], vm[4]; v2u na[4], nb[4], ma[4], mb[4];
        const GAS RowT* const srcr = (S16 ? (const GAS RowT*)p.src16 : (const GAS RowT*)p.src) + F.lane;
        { const int row = rb * 64 + F.wave * 8; const GAS RowT* xr = srcr + (size_t)row * (DM / 4);
#pragma unroll
          for (int j = 0; j < 4; ++j) { vn[j] = xr[64 * j]; vm[j] = xr[64 * j + DM / 4]; }
          if (p.o2) { const GAS v2u* oa = (const GAS v2u*)(p.o2 + (size_t)row * DM) + F.lane; const GAS v2u* ob = (const GAS v2u*)(p.o2 + ((size_t)T + row) * DM) + F.lane;
#pragma unroll
              for (int j = 0; j < 4; ++j) { na[j] = oa[64 * j]; nb[j] = ob[64 * j]; ma[j] = oa[64 * j + DM / 4]; mb[j] = ob[64 * j + DM / 4]; } } }
#pragma unroll 1
        for (int i = 0; i < 8; ++i) {
            const int row = rb * 64 + F.wave * 8 + i;
            f32x4 v[4]; float s = 0.f;
#pragma unroll
            for (int j = 0; j < 4; ++j) { if constexpr (S16) { const v2u a = vn[j]; v[j] = (f32x4){bflo(a.x), bfhi(a.x), bflo(a.y), bfhi(a.y)}; } else v[j] = vn[j]; }
            if (p.o2) {
#pragma unroll
                for (int j = 0; j < 4; ++j) { const v2u a = na[j], b = nb[j];
                    v[j].x += bflo(a.x) + bflo(b.x); v[j].y += bfhi(a.x) + bfhi(b.x); v[j].z += bflo(a.y) + bflo(b.y); v[j].w += bfhi(a.y) + bfhi(b.y); }
            }
#pragma unroll
            for (int j = 0; j < 4; ++j) { vn[j] = vm[j]; na[j] = ma[j]; nb[j] = mb[j]; }
            if (i + 2 < 8) { const int rn = row + 2; const GAS RowT* xr = srcr + (size_t)rn * (DM / 4);
#pragma unroll
                for (int j = 0; j < 4; ++j) vm[j] = xr[64 * j];
                if (p.o2) { const GAS v2u* oa = (const GAS v2u*)(p.o2 + (size_t)rn * DM) + F.lane; const GAS v2u* ob = (const GAS v2u*)(p.o2 + ((size_t)T + rn) * DM) + F.lane;
#pragma unroll
                    for (int j = 0; j < 4; ++j) { ma[j] = oa[64 * j]; mb[j] = ob[64 * j]; } } }
            if (MODE != 3 && p.hout) { GAS f32x4* ho = (GAS f32x4*)(p.hout + (size_t)row * DM) + F.lane;
#pragma unroll
                for (int j = 0; j < 4; ++j) ho[64 * j] = v[j]; }
            if (MODE != 3 && p.hout16) { GAS v2u* ho = (GAS v2u*)(p.hout16 + (size_t)row * DM) + F.lane;
#pragma unroll
                for (int j = 0; j < 4; ++j) { const v2u w = (v2u){pk2(v[j].x, v[j].y), pk2(v[j].z, v[j].w)}; ho[64 * j] = w; v[j] = (f32x4){bflo(w.x), bfhi(w.x), bflo(w.y), bfhi(w.y)}; } }
#pragma unroll
            for (int j = 0; j < 4; ++j) s += (v[j].x * v[j].x + v[j].y * v[j].y) + (v[j].z * v[j].z + v[j].w * v[j].w);
            const float rstd = 1.0f / sqrtf(wave_sum(s) * (1.0f / DM) + EPS);
            const GAS f32x4* gr = (const GAS f32x4*)p.gain + F.lane;
            if ((MODE == 2 && MOE_FP8) || (MODE == 1 && p.h8)) { GAS unsigned* h8r = (GAS unsigned*)(p.h8 + (size_t)row * DM) + F.lane;
#pragma unroll
                for (int j = 0; j < 4; ++j) { const f32x4 q = v[j] * rstd; h8r[64 * j] = pk4_f8(q.x, q.y, q.z, q.w); } }
#pragma unroll
            for (int j = 0; j < 4; ++j) { const f32x4 g = gr[64 * j]; v[j] = v[j] * rstd * g; }
            if (MODE == 3) { GAS f32x4* ho = (GAS f32x4*)(p.hout + (size_t)row * DM) + F.lane;
#pragma unroll
                for (int j = 0; j < 4; ++j) ho[64 * j] = v[j];
                continue; }
            if (F.lane == 0) ((GAS float*)p.rs)[row] = rstd;
            if (MODE == 0 || MODE == 2) {
                float d[8];
#pragma unroll
                for (int g = 0; g < 8; ++g) d[g] = 0.f;
#pragma unroll
                for (int j = 0; j < 4; ++j)
#pragma unroll
                    for (int c = 0; c < 4; ++c) { const f32x4 w0 = wr[(j * 4 + c) * 2], w1 = wr[(j * 4 + c) * 2 + 1];
                        const float yv = v[j][c];
                        d[0] += yv * w0.x; d[1] += yv * w0.y; d[2] += yv * w0.z; d[3] += yv * w0.w; d[4] += yv * w1.x; d[5] += yv * w1.y; d[6] += yv * w1.z; d[7] += yv * w1.w; }
#pragma unroll
                for (int g = 0; g < 8; ++g) d[g] = wave_sum(d[g]);
                if (MODE == 0) { if (F.lane == 0) { GAS f32x4* gp = (GAS f32x4*)(p.G + (size_t)row * 8); gp[0] = (f32x4){d[0], d[1], d[2], d[3]}; gp[1] = (f32x4){d[4], d[5], d[6], d[7]}; } }
                else {
                    int e0 = 0; float v0 = d[0];
#pragma unroll
                    for (int g = 1; g < 8; ++g) if (d[g] > v0) { v0 = d[g]; e0 = g; }
                    int e1 = -1; float v1 = -INFINITY;
#pragma unroll
                    for (int g = 0; g < 8; ++g) if (g != e0 && d[g] > v1) { v1 = d[g]; e1 = g; }
                    const float w0 = 1.0f / (1.0f + expf(v1 - v0)), w1 = 1.0f - w0;
                    if (F.lane == 0) { LAS int* rr = rec + (F.wave * 8 + i) * 6; rr[0] = e0; rr[1] = e1; rr[4] = __builtin_bit_cast(int, w0); rr[5] = __builtin_bit_cast(int, w1); }
                }
            }
        }
        if (MODE == 2) {
            __syncthreads();
            if (F.wave == 0) { const LAS int* rr = rec + F.lane * 6; const int e0 = rr[0], e1 = rr[1], row = rb * 64 + F.lane;
                const unsigned long long below = (1ull << F.lane) - 1ull;
                int lp0 = 0, lp1 = 0, mycnt = 0;
#pragma unroll
                for (int e = 0; e < 8; ++e) { const unsigned long long m0 = __ballot(e0 == e), m1 = __ballot(e1 == e);
                    const int lp = __popcll(m0 & below) + __popcll(m1 & below), ce = __popcll(m0) + __popcll(m1);
                    if (e0 == e) lp0 = lp; if (e1 == e) lp1 = lp; if (F.lane == e) mycnt = ce; }
                GAS int* ro = (GAS int*)p.rrec + (size_t)row * 6; ro[0] = e0; ro[1] = e1; ro[2] = lp0; ro[3] = lp1; ro[4] = rr[4]; ro[5] = rr[5];
                if (F.lane < 8) { ((GAS int*)p.cntw)[rb * 8 + F.lane] = mycnt; (void)__hip_atomic_fetch_add(p.cnt + F.lane, (unsigned)mycnt, __ATOMIC_RELAXED, __HIP_MEMORY_SCOPE_AGENT); } }
            __syncthreads();
        }
    }
}

__device__ __forceinline__ void route_finish(Frame& F, const int* cntw, const int* rrec, uint2* rinfo, const float* RS, float* RSI) {
    LAS float* lred = (LAS float*)(F.lds + RING_OFF);
    for (int rb0 = F.bid; rb0 < T / 64; rb0 += F.G) {
        const int rb = (rb0 & 7) * 32 + (rb0 >> 3);
        float c[8];
#pragma unroll
        for (int e = 0; e < 8; ++e) c[e] = 0.f;
        if (F.tid < rb) { const GAS i32x4* cp = (const GAS i32x4*)(cntw + F.tid * 8); const i32x4 a = cp[0], b = cp[1];
            c[0] = (float)a.x; c[1] = (float)a.y; c[2] = (float)a.z; c[3] = (float)a.w; c[4] = (float)b.x; c[5] = (float)b.y; c[6] = (float)b.z; c[7] = (float)b.w; }
#pragma unroll
        for (int e = 0; e < 8; ++e) c[e] = wave_sum(c[e]);
        if (F.lane == 0) {
#pragma unroll
            for (int e = 0; e < 8; ++e) lred[F.wave * 8 + e] = c[e]; }
        __syncthreads();
        if (F.tid < 64) { const int row = rb * 64 + F.tid; const GAS int* rr = (const GAS int*)rrec + (size_t)row * 6;
            const int e0 = rr[0], e1 = rr[1];
            float b0 = 0.f, b1 = 0.f;
#pragma unroll
            for (int w = 0; w < NWAVES; ++w) { b0 += lred[w * 8 + e0]; b1 += lred[w * 8 + e1]; }
            const int p0 = (int)b0 + rr[2], p1 = (int)b1 + rr[3];
            rinfo[(size_t)e0 * T + p0] = make_uint2((unsigned)row * 2u, (unsigned)rr[4]);
            rinfo[(size_t)e1 * T + p1] = make_uint2((unsigned)row * 2u + 1u, (unsigned)rr[5]);
            const float rsr = ((const GAS float*)RS)[row]; ((GAS float*)RSI)[(size_t)e0 * T + p0] = rsr; ((GAS float*)RSI)[(size_t)e1 * T + p1] = rsr; }
        __syncthreads();
    }
}

__device__ __forceinline__ float logsigmoid_f(float x) { return fminf(x, 0.f) - log1pf(expf(-fabsf(x))); }
__device__ __forceinline__ void gate_scan(Frame& F, int bh, const float* G, const float* b_i, const float* b_f, float* GA, float* GM, float* GE, float* TG) {
    LAS float* sc = (LAS float*)(F.lds + RING_OFF);
    const int b = bh >> 2, h = bh & 3, t0 = 4 * F.tid;
    const float bi = b_i[h], bf = b_f[h];
    float lf[4], ig[4];
#pragma unroll
    for (int j = 0; j < 4; ++j) { const float* g = G + ((size_t)b * SEQ + t0 + j) * 8; ig[j] = g[h] + bi; lf[j] = logsigmoid_f(g[4 + h] + bf); }
    float c[4]; c[0] = lf[0]; c[1] = c[0] + lf[1]; c[2] = c[1] + lf[2]; c[3] = c[2] + lf[3];
    float ws = c[3];
    DPP_SCAN(ws, OP_ADD, 0.0f);
    if (F.lane == 63) sc[F.wave] = ws;
    __syncthreads();
    float woff = 0.f;
    for (int w = 0; w < F.wave; ++w) woff += sc[w];
    const float excl = woff + ws - c[3];
    float Fc[4], av[4];
#pragma unroll
    for (int j = 0; j < 4; ++j) { Fc[j] = excl + c[j]; av[j] = ig[j] - Fc[j]; }
    float m[4]; m[0] = av[0]; m[1] = fmaxf(m[0], av[1]); m[2] = fmaxf(m[1], av[2]); m[3] = fmaxf(m[2], av[3]);
    float wm = m[3];
    DPP_SCAN(wm, OP_MAX, -INFINITY);
    if (F.lane == 63) sc[16 + F.wave] = wm;
    __syncthreads();
    float pm = -INFINITY;
    for (int w = 0; w < F.wave; ++w) pm = fmaxf(pm, sc[16 + w]);
    { float u = dpp_f(-INFINITY, wm, 0x111, 0xf);
      const float r15 = dpp_f(-INFINITY, wm, 0x142, 0xa), r31 = dpp_f(-INFINITY, wm, 0x143, 0xc);
      if ((F.lane & 15) == 0) u = (F.lane == 32) ? r31 : r15;
      pm = fmaxf(pm, u); }
    float tmx = m[3];
    tmx = fmaxf(tmx, dpp_f(-INFINITY, tmx, 0x111, 0xf)); tmx = fmaxf(tmx, dpp_f(-INFINITY, tmx, 0x112, 0xf)); tmx = fmaxf(tmx, dpp_f(-INFINITY, tmx, 0x114, 0xf)); tmx = fmaxf(tmx, dpp_f(-INFINITY, tmx, 0x118, 0xf));
    const int tbits = __builtin_bit_cast(int, tmx);
    const float t0m = __builtin_bit_cast(float, __builtin_amdgcn_readlane(tbits, 15)), t1m = __builtin_bit_cast(float, __builtin_amdgcn_readlane(tbits, 31)),
                t2m = __builtin_bit_cast(float, __builtin_amdgcn_readlane(tbits, 47)), t3m = __builtin_bit_cast(float, __builtin_amdgcn_readlane(tbits, 63));
    const int rw = F.lane >> 4; const float tm = rw == 0 ? t0m : (rw == 1 ? t1m : (rw == 2 ? t2m : t3m));
    if ((F.lane & 15) == 0) TG[bh * 32 + F.wave * 4 + rw] = tm * LOG2E;
#pragma unroll
    for (int j = 0; j < 4; ++j) { const float Mt = fmaxf(pm, m[j]); const size_t o = (size_t)bh * SEQ + t0 + j;
        GA[o] = expf(av[j] - tm); GM[o] = Mt * LOG2E; GE[o] = expf(-(Fc[j] + Mt)); }
    __syncthreads();
}

__device__ __forceinline__ void unpack8(const v4u r, float (&d)[8]) { d[0] = bflo(r.x); d[1] = bfhi(r.x); d[2] = bflo(r.y); d[3] = bfhi(r.y); d[4] = bflo(r.z); d[5] = bfhi(r.z); d[6] = bflo(r.w); d[7] = bfhi(r.w); }
__device__ __forceinline__ void conv_phase(Frame& F, const bf16* proj, const float* cw, const float* cb, bf16* qkc, const int hidx, const int nh) {
    const int cbat = F.bid & 7;
    for (int wi = F.wave * nh + hidx; wi < 144; wi += NWAVES * nh) {
        const int kpart = wi >= 128 ? 1 : 0;
        const int seg = cbat * 128 + (kpart ? 112 + (wi - 128) : wi);
        const int t0 = seg * 16, c0 = kpart * 512 + F.lane * 8;
        float w[4][8], bb[8];
#pragma unroll
        for (int tap = 0; tap < 4; ++tap) { const f32x4 a = *(const GAS f32x4*)(cw + tap * 1024 + c0), b = *(const GAS f32x4*)(cw + tap * 1024 + c0 + 4);
            w[tap][0] = a.x; w[tap][1] = a.y; w[tap][2] = a.z; w[tap][3] = a.w; w[tap][4] = b.x; w[tap][5] = b.y; w[tap][6] = b.z; w[tap][7] = b.w; }
        { const f32x4 a = *(const GAS f32x4*)(cb + c0), b = *(const GAS f32x4*)(cb + c0 + 4); bb[0] = a.x; bb[1] = a.y; bb[2] = a.z; bb[3] = a.w; bb[4] = b.x; bb[5] = b.y; bb[6] = b.z; bb[7] = b.w; }
        const float osc = kpart ? KM_SCALE : 1.0f;
        const bool first = (t0 % SEQ) == 0;
        v4u rw[19];
#pragma unroll
        for (int q = 0; q < 3; ++q) { rw[q] = (v4u){0u, 0u, 0u, 0u}; if (!first) rw[q] = *(const GAS v4u*)(proj + (size_t)(t0 - 3 + q) * NPROJ + c0); }
#pragma unroll
        for (int q = 0; q < 16; ++q) rw[3 + q] = *(const GAS v4u*)(proj + (size_t)(t0 + q) * NPROJ + c0);
        float x0[8], x1[8], x2[8];
        unpack8(rw[0], x0); unpack8(rw[1], x1); unpack8(rw[2], x2);
#pragma unroll
        for (int i = 0; i < 16; ++i) {
            float x3[8]; unpack8(rw[3 + i], x3);
            float o[8];
#pragma unroll
            for (int c = 0; c < 8; ++c) { const float yv = bb[c] + x0[c] * w[0][c] + x1[c] * w[1][c] + x2[c] * w[2][c] + x3[c] * w[3][c];
                o[c] = osc * yv * __builtin_amdgcn_rcpf(1.0f + __builtin_amdgcn_exp2f(-yv * LOG2E)); x0[c] = x1[c]; x1[c] = x2[c]; x2[c] = x3[c]; }
            *(GAS v4u*)(qkc + (size_t)(t0 + i) * DM + c0) = (v4u){pk2(o[0], o[1]), pk2(o[2], o[3]), pk2(o[4], o[5]), pk2(o[6], o[7])};
        }
    }
}

__device__ __forceinline__ void naive_sb(Frame& F, const bf16* proj, const float* g_sb, bf16* mixed) {
    LAS float* qs = (LAS float*)(F.lds + RING_OFF) + F.wave * 256;
    LAS float* ps = qs + 64;
    for (int it = F.bid * NWAVES + F.wave; it < T * HS; it += F.G * NWAVES) {
        const int h = it & 7, row = it >> 3, t = row % SEQ, rb = row - t;
        qs[F.lane] = bf2f(proj[(size_t)row * NPROJ + 2048 + h * 64 + F.lane]);
        LDS_WAIT();
        float R = 1.0f, o = 0.f;
        const int nch = (t + 63) / 64;
        for (int c = nch - 1; c >= 0; --c) {
            const int s = 64 * c + F.lane; const bool valid = s < t;
            const bf16* kr = proj + (size_t)(rb + s) * NPROJ + 2560 + h * 64;
            float z = 0.f;
#pragma unroll
            for (int d8 = 0; d8 < 8; ++d8) { const v4u kk = *(const GAS v4u*)(kr + d8 * 8); const f32x4 qa = *(const LAS f32x4*)(qs + d8 * 8), qb = *(const LAS f32x4*)(qs + d8 * 8 + 4);
                z += qa.x * bflo(kk.x) + qa.y * bfhi(kk.x) + qa.z * bflo(kk.y) + qa.w * bfhi(kk.y) + qb.x * bflo(kk.z) + qb.y * bfhi(kk.z) + qb.z * bflo(kk.w) + qb.w * bfhi(kk.w); }
            const float e = exp2f(-z); float beta = 1.0f / (1.0f + e); float omb = 1.0f - beta;
            if (!valid) { beta = 0.f; omb = 1.0f; }
            float pr = omb;
#pragma unroll
            for (int off = 1; off < 64; off <<= 1) { const float u = __shfl_down(pr, off); if (F.lane + off < 64) pr *= u; }
            float ex = __shfl_down(pr, 1); if (F.lane == 63) ex = 1.0f;
            const float a = beta * ex * R;
            R *= __shfl(pr, 0);
            ps[F.lane] = a; LDS_WAIT();
            const bf16* vr = proj + (size_t)(rb + 64 * c) * NPROJ + 3072 + h * 64 + F.lane;
#pragma unroll 8
            for (int j = 0; j < 64; ++j) o += ps[j] * bf2f(vr[(size_t)j * NPROJ]);
            LDS_WAIT();
        }
        const float ss = wave_sum(o * o) * (1.0f / 64.0f);
        const float val = o * (1.0f / sqrtf(ss + EPS)) * g_sb[h * 64 + F.lane];
        mixed[(size_t)row * DM + 512 + h * 64 + F.lane] = (bf16)f2bf(val);
    }
}
__device__ __forceinline__ void naive_mlstm(Frame& F, const bf16* proj, const bf16* qkc, const float* GA, const float* GM, const float* GE, const float* g_m, bf16* mixed) {
    LAS float* qs = (LAS float*)(F.lds + RING_OFF) + F.wave * 256;
    LAS float* ps = qs + 128;
    for (int it = F.bid * NWAVES + F.wave; it < T * HM; it += F.G * NWAVES) {
        const int h = it & 3, row = it >> 2, t = row % SEQ, rb = row - t, b = row / SEQ, bh = b * 4 + h;
        qs[F.lane] = bf2f(qkc[(size_t)row * DM + h * 128 + F.lane]); qs[64 + F.lane] = bf2f(qkc[(size_t)row * DM + h * 128 + 64 + F.lane]);
        LDS_WAIT();
        const float Mt = GM[(size_t)bh * SEQ + t];
        float den = 0.f, o0 = 0.f, o1 = 0.f;
        const int nch = t / 64 + 1;
        for (int c = 0; c < nch; ++c) {
            const int s = 64 * c + F.lane; const bool valid = s <= t;
            const bf16* kr = qkc + (size_t)(rb + s) * DM + 512 + h * 128;
            float z = 0.f;
#pragma unroll
            for (int d8 = 0; d8 < 16; ++d8) { const v4u kk = *(const GAS v4u*)(kr + d8 * 8); const f32x4 qa = *(const LAS f32x4*)(qs + d8 * 8), qb = *(const LAS f32x4*)(qs + d8 * 8 + 4);
                z += qa.x * bflo(kk.x) + qa.y * bfhi(kk.x) + qa.z * bflo(kk.y) + qa.w * bfhi(kk.y) + qb.x * bflo(kk.z) + qb.y * bfhi(kk.z) + qb.z * bflo(kk.w) + qb.w * bfhi(kk.w); }
            const float wgt = valid ? exp2f(GA[(size_t)bh * SEQ + s] - Mt) : 0.f;
            const float pv = z * wgt;
            den += pv;
            ps[F.lane] = pv; LDS_WAIT();
            const bf16* vr = proj + (size_t)(rb + 64 * c) * NPROJ + 1024 + h * 128 + F.lane;
#pragma unroll 8
            for (int j = 0; j < 64; ++j) { const float pj = ps[j]; o0 += pj * bf2f(vr[(size_t)j * NPROJ]); o1 += pj * bf2f(vr[(size_t)j * NPROJ + 64]); }
            LDS_WAIT();
        }
        den = wave_sum(den);
        const float dn = fmaxf(fabsf(den), GE[(size_t)bh * SEQ + t]);
        const float h0 = o0 / dn, h1 = o1 / dn;
        const float ss = wave_sum(h0 * h0 + h1 * h1) * (1.0f / 128.0f);
        const float rs = 1.0f / sqrtf(ss + EPS);
        const float om0 = bf2f(proj[(size_t)row * NPROJ + 1536 + h * 128 + F.lane]), om1 = bf2f(proj[(size_t)row * NPROJ + 1536 + h * 128 + 64 + F.lane]);
        const float r0 = h0 * rs * g_m[h * 128 + F.lane] / (1.0f + expf(-om0)), r1 = h1 * rs * g_m[h * 128 + 64 + F.lane] / (1.0f + expf(-om1));
        mixed[(size_t)row * DM + h * 128 + F.lane] = (bf16)f2bf(r0); mixed[(size_t)row * DM + h * 128 + 64 + F.lane] = (bf16)f2bf(r1);
    }
}

namespace mix {
typedef float f32x16 __attribute__((ext_vector_type(16)));
typedef short s16x4 __attribute__((ext_vector_type(4)));
typedef short v4i16_t __attribute__((ext_vector_type(4)));
typedef unsigned u32x4 __attribute__((ext_vector_type(4)));
typedef LAS const unsigned char* lptr;
#define MX_MFMA(a, b, c) __builtin_amdgcn_mfma_f32_32x32x16_bf16(a, b, c, 0, 0, 0)
__device__ __forceinline__ int crow(int r, int hi) { return (r & 3) + 8 * (r >> 2) + 4 * hi; }
__device__ __forceinline__ unsigned cvtpk(float lo, float hi) { unsigned r; asm("v_cvt_pk_bf16_f32 %0, %1, %2" : "=v"(r) : "v"(lo), "v"(hi)); return r; }
__device__ __forceinline__ s16x4 vtr(lptr p) { return __builtin_bit_cast(s16x4, __builtin_amdgcn_ds_read_tr16_b64_v4i16((LAS v4i16_t*)p)); }
__device__ __forceinline__ float partner(float x, int hi) { auto rr = __builtin_amdgcn_permlane32_swap(__builtin_bit_cast(unsigned, x), __builtin_bit_cast(unsigned, x), false, false);
    return __builtin_bit_cast(float, hi ? rr[0] : rr[1]); }

constexpr int STG_BYTES = 65536, GRP_BYTES = 32768, VIMG_OFF = 16384;
constexpr int EX_OFF = RING_BYTES + 1024;
constexpr int EX_GA = EX_OFF, EX_FA = EX_OFF + 1024, EX_FB = EX_OFF + 1536;

__device__ __forceinline__ void glds16(const void* g, unsigned lds_base) {
    unsigned sv; asm volatile("s_mov_b32 %0, m0\n\ts_mov_b32 m0, %2\n\ts_nop 0\n\tglobal_load_lds_dwordx4 %1, off\n\ts_mov_b32 m0, %0" : "=&s"(sv) : "v"(g), "s"(lds_base) : "memory"); }
__device__ __forceinline__ void glds4(const void* g, unsigned lds_base) {
    unsigned sv; asm volatile("s_mov_b32 %0, m0\n\ts_mov_b32 m0, %2\n\ts_nop 0\n\tglobal_load_lds_dword %1, off\n\ts_mov_b32 m0, %0" : "=&s"(sv) : "v"(g), "s"(lds_base) : "memory"); }
template <int D, bool ML>
__device__ __forceinline__ void issue_tile(unsigned gbase, unsigned gaimg, const bf16* Kp, int pk, const bf16* Vp, int pv, const float* ga, int s0, int w4, int lane) {
#pragma unroll
    for (int c = 0; c < D / 32; ++c) { const int ch = w4 + 4 * c;
        glds16(Kp + (size_t)(s0 + lane) * pk + 8 * ch, (unsigned)__builtin_amdgcn_readfirstlane(gbase + ch * 1024)); }
#pragma unroll
    for (int c = 0; c < D / 32; ++c) { const int idx = w4 + 4 * c, dp = idx >> 2, rg = idx & 3;
        glds16(Vp + (size_t)(s0 + 16 * rg + (lane >> 2)) * pv + 32 * dp + 8 * (lane & 3), (unsigned)__builtin_amdgcn_readfirstlane(gbase + VIMG_OFF + dp * 4096 + rg * 1024)); }
    if (ML) { if (w4 == 0) glds4(ga + s0 + lane, (unsigned)__builtin_amdgcn_readfirstlane(gaimg)); }
}

template <int D, bool SBK, bool MASK>
__device__ __forceinline__ void compute_tile(lptr kimg, lptr vimg, LAS const float* gat, const bf16x8 (&qr)[D / 16], f32x16 (&o)[D / 32], float& st, const float Mt, const int qrow, const int key0, const int lane) {
    const int r32 = lane & 31, hi = lane >> 5;
    f32x16 p0 = {}, p1 = {};
    const lptr kp = kimg + hi * 1024 + r32 * 16;
    {
        bf16x8 kf[D / 8];
#pragma unroll
        for (int d0 = 0; d0 < D / 16; ++d0) { kf[2 * d0] = *(LAS const bf16x8*)(kp + d0 * 2048); kf[2 * d0 + 1] = *(LAS const bf16x8*)(kp + d0 * 2048 + 512); }
        __builtin_amdgcn_sched_barrier(0);
#pragma unroll
        for (int d0 = 0; d0 < D / 16; ++d0) { p0 = MX_MFMA(kf[2 * d0], qr[d0], p0); p1 = MX_MFMA(kf[2 * d0 + 1], qr[d0], p1); }
    }
    const lptr vp = vimg + ((lane >> 4) & 1) * 32 + (lane & 3) * 8 + (4 * hi + ((lane & 15) >> 2)) * 64;
    s16x4 vlo[D / 8], vhi[D / 8];
#pragma unroll
    for (int dp = 0; dp < D / 32; ++dp)
#pragma unroll
        for (int ks = 0; ks < 4; ++ks) { vlo[dp * 4 + ks] = vtr(vp + dp * 4096 + ks * 1024); vhi[dp * 4 + ks] = vtr(vp + dp * 4096 + ks * 1024 + 512); }
    __builtin_amdgcn_sched_barrier(0);
    u32x4 pw[4];
    if constexpr (SBK) {
        float R = st;
#pragma unroll
        for (int blk = 1; blk >= 0; --blk) {
            const f32x16& X = blk ? p1 : p0; const int kb = key0 + 32 * blk;
            float bt[16], sx[16], Pg[4], Qg[4];
#pragma unroll
            for (int g = 0; g < 4; ++g) { float run = 1.f;
#pragma unroll
                for (int i = 3; i >= 0; --i) { const int r = 4 * g + i; float z = X[r]; if (MASK) z = (kb + crow(r, hi) < qrow) ? z : -INFINITY;
                    const float e = __builtin_amdgcn_exp2f(-z); const float b = __builtin_amdgcn_rcpf(1.0f + e); bt[r] = b; sx[r] = run; run *= (1.0f - b); }
                Pg[g] = run; }
#pragma unroll
            for (int g = 0; g < 4; ++g) Qg[g] = partner(Pg[g], hi);
            float a[16];
#pragma unroll
            for (int g = 3; g >= 0; --g) { const float pre = R * (hi ? 1.0f : Qg[g]);
#pragma unroll
                for (int i = 0; i < 4; ++i) a[4 * g + i] = bt[4 * g + i] * sx[4 * g + i] * pre;
                R *= Pg[g] * Qg[g]; }
            pw[2 * blk] = (u32x4){cvtpk(a[0], a[1]), cvtpk(a[2], a[3]), cvtpk(a[4], a[5]), cvtpk(a[6], a[7])};
            pw[2 * blk + 1] = (u32x4){cvtpk(a[8], a[9]), cvtpk(a[10], a[11]), cvtpk(a[12], a[13]), cvtpk(a[14], a[15])};
        }
        st = R;
    } else {
        float den = st;
#pragma unroll
        for (int blk = 0; blk < 2; ++blk) {
            const f32x16& X = blk ? p1 : p0; const int kb = key0 + 32 * blk;
            float a[16];
#pragma unroll
            for (int g = 0; g < 4; ++g) { const f32x4 gv = *(LAS const f32x4*)(gat + 32 * blk + 8 * g + 4 * hi);
#pragma unroll
                for (int i = 0; i < 4; ++i) { const int r = 4 * g + i; float p = X[r] * __builtin_amdgcn_exp2f(gv[i] - Mt); if (MASK) p = (kb + crow(r, hi) <= qrow) ? p : 0.f; den += p; a[r] = p; } }
            pw[2 * blk] = (u32x4){cvtpk(a[0], a[1]), cvtpk(a[2], a[3]), cvtpk(a[4], a[5]), cvtpk(a[6], a[7])};
            pw[2 * blk + 1] = (u32x4){cvtpk(a[8], a[9]), cvtpk(a[10], a[11]), cvtpk(a[12], a[13]), cvtpk(a[14], a[15])};
        }
        st = den;
    }
    __builtin_amdgcn_sched_barrier(0);
#pragma unroll
    for (int dp = 0; dp < D / 32; ++dp)
#pragma unroll
        for (int ks = 0; ks < 4; ++ks) { const s16x4 a = vlo[dp * 4 + ks], b = vhi[dp * 4 + ks];
            const bf16x8 vf = (bf16x8){a[0], a[1], a[2], a[3], b[0], b[1], b[2], b[3]};
            o[dp] = MX_MFMA(__builtin_bit_cast(bf16x8, pw[ks]), vf, o[dp]); }
}

template <int D, bool SBK>
__device__ __forceinline__ void attn_unit(LAS unsigned char* lds, const int tid_in, const bf16* Qp, int pq, const bf16* Kp, int pk, const bf16* Vp, int pv,
                                          const float* ga, const float* gm, const float* ge, const int qb, bf16* out, const float* gain, const bf16* om) {
    int tid = tid_in; asm volatile("" : "+v"(tid));
    const int lane = tid & 63, wid = __builtin_amdgcn_readfirstlane(tid >> 6), grp = wid >> 2, w4 = wid & 3, r32 = lane & 31, hi = lane >> 5;
    const int t0 = 128 * qb, ns = qb + 1, nt = 2 * ns;
    const int qrow = t0 + 32 * w4 + r32;
    bf16x8 qr[D / 16];
#pragma unroll
    for (int d0 = 0; d0 < D / 16; ++d0) qr[d0] = *(const GAS bf16x8*)(Qp + (size_t)qrow * pq + d0 * 16 + hi * 8);
    float Mt = 0.f; if (!SBK) Mt = gm[qrow];
    f32x16 o[D / 32];
#pragma unroll
    for (int i = 0; i < D / 32; ++i) o[i] = f32x16{};
    float st = SBK ? 1.0f : 0.0f;
    LAS unsigned char* const gb0 = lds + grp * GRP_BYTES; LAS unsigned char* const ga0 = lds + EX_GA + grp * 256;
    const unsigned gb0u = (unsigned)(size_t)gb0, ga0u = (unsigned)(size_t)ga0;
    const int tfirst = grp ? ns - 1 : nt - 1;
    issue_tile<D, !SBK>(gb0u, ga0u, Kp, pk, Vp, pv, ga, 64 * tfirst, w4, lane);
#pragma unroll
    for (int d0 = 0; d0 < D / 16; ++d0) asm volatile("" : "+v"(qr[d0]));
    asm volatile("" : "+v"(Mt));
    for (int i = 0; i < ns; ++i) {
        const int tl = tfirst - i, sb = (i & 1);
        asm volatile("s_waitcnt vmcnt(0)" ::: "memory");
        __builtin_amdgcn_s_barrier();
        asm volatile("" ::: "memory");
        if (i + 1 < ns) issue_tile<D, !SBK>(gb0u + (sb ^ 1) * STG_BYTES, ga0u + (sb ^ 1) * 512, Kp, pk, Vp, pv, ga, 64 * (tl - 1), w4, lane);
        const lptr kimg = (lptr)(gb0 + sb * STG_BYTES); LAS const float* gat = (LAS const float*)(ga0 + sb * 512);
        if (tl >= nt - 2) compute_tile<D, SBK, true>(kimg, kimg + VIMG_OFF, gat, qr, o, st, Mt, qrow, 64 * tl, lane);
        else compute_tile<D, SBK, false>(kimg, kimg + VIMG_OFF, gat, qr, o, st, Mt, qrow, 64 * tl, lane);
    }
    constexpr int PITCH = D + 4;
    LAS float* stg = (LAS float*)lds; LAS float* fA = (LAS float*)(lds + EX_FA); LAS float* fB = (LAS float*)(lds + EX_FB);
    if (!SBK) st += partner(st, hi);
    LDS_WAIT(); __builtin_amdgcn_s_barrier(); asm volatile("" ::: "memory");
    if (grp == 1) {
#pragma unroll
        for (int dp = 0; dp < D / 32; ++dp)
#pragma unroll
            for (int r = 0; r < 16; ++r) stg[(32 * w4 + crow(r, hi)) * PITCH + 32 * dp + r32] = o[dp][r];
        if (hi == 0) fB[32 * w4 + r32] = st;
    } else { if (hi == 0) fA[32 * w4 + r32] = st; }
    LDS_WAIT(); __builtin_amdgcn_s_barrier(); asm volatile("" ::: "memory");
    if (grp == 0) {
#pragma unroll
        for (int r = 0; r < 16; ++r) { const int row = 32 * w4 + crow(r, hi); const float f = SBK ? fA[row] : 1.0f;
#pragma unroll
            for (int dp = 0; dp < D / 32; ++dp) { LAS float* p = stg + row * PITCH + 32 * dp + r32; *p = o[dp][r] + f * (*p); } }
    }
    LDS_WAIT(); __builtin_amdgcn_s_barrier(); asm volatile("" ::: "memory");
    {
        constexpr int NC = D / 4;
        const int row = tid >> 2, qd = tid & 3, trow = t0 + row;
        float v[NC];
#pragma unroll
        for (int c = 0; c < NC / 4; ++c) { const f32x4 x = *(LAS const f32x4*)(stg + row * PITCH + qd * NC + 4 * c); v[4 * c] = x.x; v[4 * c + 1] = x.y; v[4 * c + 2] = x.z; v[4 * c + 3] = x.w; }
        if (!SBK) { const float den = fA[row] + fB[row]; const float inv = 1.0f / fmaxf(fabsf(den), ge[trow]);
#pragma unroll
            for (int c = 0; c < NC; ++c) v[c] *= inv; }
        float ss = 0.f;
#pragma unroll
        for (int c = 0; c < NC; ++c) ss += v[c] * v[c];
        ss += __shfl_xor(ss, 1); ss += __shfl_xor(ss, 2);
        const float rs = 1.0f / sqrtf(ss * (1.0f / D) + EPS);
        bf16* op = out + (size_t)trow * DM + qd * NC;
#pragma unroll
        for (int c8 = 0; c8 < NC / 8; ++c8) {
            float w[8];
#pragma unroll
            for (int c = 0; c < 8; ++c) w[c] = v[8 * c8 + c] * rs * gain[qd * NC + 8 * c8 + c];
            if (!SBK) { const v4u g = *(const GAS v4u*)(om + (size_t)trow * NPROJ + qd * NC + 8 * c8); float gg[8];
                gg[0] = bflo(g.x); gg[1] = bfhi(g.x); gg[2] = bflo(g.y); gg[3] = bfhi(g.y); gg[4] = bflo(g.z); gg[5] = bfhi(g.z); gg[6] = bflo(g.w); gg[7] = bfhi(g.w);
#pragma unroll
                for (int c = 0; c < 8; ++c) w[c] *= 1.0f / (1.0f + __expf(-gg[c])); }
            *(GAS v4u*)(op + 8 * c8) = (v4u){pk2(w[0], w[1]), pk2(w[2], w[3]), pk2(w[4], w[5]), pk2(w[6], w[7])};
        }
    }
    LDS_WAIT(); __builtin_amdgcn_s_barrier(); asm volatile("" ::: "memory");
}
#undef MX_MFMA
}

typedef unsigned cs_u32x2 __attribute__((ext_vector_type(2)));
constexpr int CS_PART = 4160, CS_IMG = 4 * CS_PART, CS_NV = 8 * CS_IMG;
static_assert(CS_NV + 16384 <= MISC_OFF, "chunk-state LDS map");
__device__ __forceinline__ void chunk_state_unit(Frame& F, const int bh, const int j, const bf16* proj, const float* cw, const float* cb, const float* GAw, const float* TG,
                                                 bf16* U, float* NV, float* CM, bf16* qkc) {
    using mix::f32x16; using mix::s16x4; using mix::vtr; using mix::lptr; using mix::cvtpk;
    const int b = bh >> 2, h = bh & 3, tid = F.tid, lane = F.lane, wid = F.wave;
    const size_t r0 = (size_t)b * SEQ;
    const int cg = tid & 15, kg = tid >> 4, c0 = 8 * cg, tl = kg >> 3;
    const int s0 = 256 * j + 8 * kg;
    LAS unsigned char* const img = F.lds + RING_OFF;
    const bf16* kp = proj + (r0 + s0) * NPROJ + 512 + h * 128 + c0;
    const bf16* vp = proj + (r0 + s0) * NPROJ + 1024 + h * 128 + c0;
    v4u kr[11], vr[8];
#pragma unroll
    for (int q = 0; q < 3; ++q) { kr[q] = (v4u){0u, 0u, 0u, 0u}; if (s0 > 0) kr[q] = *(const GAS v4u*)(kp + (ptrdiff_t)(q - 3) * NPROJ); }
#pragma unroll
    for (int q = 0; q < 8; ++q) { kr[3 + q] = *(const GAS v4u*)(kp + (size_t)q * NPROJ); vr[q] = *(const GAS v4u*)(vp + (size_t)q * NPROJ); }
    const f32x4 ga0 = *(const GAS f32x4*)(GAw + (size_t)bh * SEQ + s0), ga1 = *(const GAS f32x4*)(GAw + (size_t)bh * SEQ + s0 + 4);
    const float t0g = TG[bh * 32 + 4 * j], t1g = TG[bh * 32 + 4 * j + 1], t2g = TG[bh * 32 + 4 * j + 2], t3g = TG[bh * 32 + 4 * j + 3];
    const float cm = fmaxf(fmaxf(t0g, t1g), fmaxf(t2g, t3g));
    const float tf = __builtin_amdgcn_exp2f((tl == 0 ? t0g : (tl == 1 ? t1g : (tl == 2 ? t2g : t3g))) - cm);
    float w[4][8], bb[8];
#pragma unroll
    for (int tap = 0; tap < 4; ++tap) { const f32x4 x = *(const GAS f32x4*)(cw + tap * 1024 + 512 + h * 128 + c0), y = *(const GAS f32x4*)(cw + tap * 1024 + 512 + h * 128 + c0 + 4);
        w[tap][0] = x.x; w[tap][1] = x.y; w[tap][2] = x.z; w[tap][3] = x.w; w[tap][4] = y.x; w[tap][5] = y.y; w[tap][6] = y.z; w[tap][7] = y.w; }
    { const f32x4 x = *(const GAS f32x4*)(cb + 512 + h * 128 + c0), y = *(const GAS f32x4*)(cb + 512 + h * 128 + c0 + 4); bb[0] = x.x; bb[1] = x.y; bb[2] = x.z; bb[3] = x.w; bb[4] = y.x; bb[5] = y.y; bb[6] = y.z; bb[7] = y.w; }
    {
        float nvp[8];
#pragma unroll
        for (int c = 0; c < 8; ++c) nvp[c] = 0.f;
        float x0[8], x1[8], x2[8];
        unpack8(kr[0], x0); unpack8(kr[1], x1); unpack8(kr[2], x2);
        LAS unsigned char* const wp = img + tl * (2 * CS_IMG) + (cg >> 2) * CS_PART + (8 * (kg & 7)) * 64 + (cg & 3) * 16;
#pragma unroll
        for (int i = 0; i < 8; ++i) {
            float x3[8], o[8], xv[8]; unpack8(kr[3 + i], x3); unpack8(vr[i], xv);
            const float ws_ = (i < 4 ? ga0[i & 3] : ga1[i & 3]) * tf;
#pragma unroll
            for (int c = 0; c < 8; ++c) { const float yv = bb[c] + x0[c] * w[0][c] + x1[c] * w[1][c] + x2[c] * w[2][c] + x3[c] * w[3][c];
                o[c] = KM_SCALE * yv * __builtin_amdgcn_rcpf(1.0f + __builtin_amdgcn_exp2f(-yv * LOG2E)); nvp[c] += ws_ * o[c]; x0[c] = x1[c]; x1[c] = x2[c]; x2[c] = x3[c]; }
            const v4u kcv = (v4u){pk2(o[0], o[1]), pk2(o[2], o[3]), pk2(o[4], o[5]), pk2(o[6], o[7])};
            *(LAS v4u*)(wp + i * 64) = kcv;
            *(GAS v4u*)(qkc + (r0 + s0 + i) * DM + 512 + h * 128 + c0) = kcv;
            *(LAS v4u*)(wp + CS_IMG + i * 64) = (v4u){pk2(xv[0] * ws_, xv[1] * ws_), pk2(xv[2] * ws_, xv[3] * ws_), pk2(xv[4] * ws_, xv[5] * ws_), pk2(xv[6] * ws_, xv[7] * ws_)};
        }
        LAS float* np = (LAS float*)(img + CS_NV) + kg * 128 + c0;
        *(LAS f32x4*)np = (f32x4){nvp[0], nvp[1], nvp[2], nvp[3]}; *(LAS f32x4*)(np + 4) = (f32x4){nvp[4], nvp[5], nvp[6], nvp[7]};
    }
    LDS_WAIT(); __syncthreads();
    if (tid < 128) { const LAS float* np = (const LAS float*)(img + CS_NV) + tid; float nv = 0.f;
#pragma unroll
        for (int g = 0; g < 32; ++g) nv += np[g * 128];
        NV[((size_t)bh * 7 + j) * 128 + tid] = nv; }
    if (tid == 0) { CM[bh * 8 + j] = cm; if (j == 6) CM[bh * 8 + 7] = cm; }
    {
        const int hi = lane >> 5, r32 = lane & 31;
        const lptr fb = (lptr)img + ((lane >> 4) & 1) * 32 + (lane & 3) * 8 + (4 * hi + ((lane & 15) >> 2)) * 64;
        unsigned short* Uj = (unsigned short*)U + ((size_t)bh * 7 + j) * 16384;
#pragma unroll
        for (int q = 0; q < 2; ++q) { const int idx = 2 * wid + q, dpd = idx >> 2, dpe = idx & 3;
            f32x16 acc = {};
#pragma unroll
            for (int t = 0; t < 4; ++t)
#pragma unroll
                for (int ks = 0; ks < 4; ++ks) { const lptr tb = fb + t * (2 * CS_IMG) + ks * 1024;
                    const s16x4 a0 = vtr(tb + CS_IMG + dpe * CS_PART), a1 = vtr(tb + CS_IMG + dpe * CS_PART + 512), b0 = vtr(tb + dpd * CS_PART), b1 = vtr(tb + dpd * CS_PART + 512);
                    acc = __builtin_amdgcn_mfma_f32_32x32x16_bf16(((bf16x8){a0[0], a0[1], a0[2], a0[3], a1[0], a1[1], a1[2], a1[3]}), ((bf16x8){b0[0], b0[1], b0[2], b0[3], b1[0], b1[1], b1[2], b1[3]}), acc, 0, 0, 0); }
#pragma unroll
            for (int g = 0; g < 4; ++g) *(GAS cs_u32x2*)(Uj + (size_t)(32 * dpd + r32) * 128 + 32 * dpe + 8 * g + 4 * hi) = (cs_u32x2){pk2(acc[4 * g], acc[4 * g + 1]), pk2(acc[4 * g + 2], acc[4 * g + 3])};
        }
    }
    LDS_WAIT(); __syncthreads();
}

typedef const __attribute__((address_space(4))) Args* KArgs;
#define KA(field) ({ KArgs _p = kap; asm volatile("" : "+s"(_p)); _p->field; })
#define WSP(off) ((unsigned char*)KA(ws) + (off))
namespace mix2 {
using mix::f32x16; using mix::s16x4; using mix::u32x4; using mix::lptr; using mix::crow; using mix::cvtpk; using mix::vtr; using mix::partner; using mix::glds16; using mix::glds4;
#define MX_MFMA(a, b, c) __builtin_amdgcn_mfma_f32_32x32x16_bf16(a, b, c, 0, 0, 0)
constexpr int NKB = 3, NVB = 4;
constexpr int KBUF0 = 0, VBUF0 = NKB * 16384, BUFSZ = 16384, STAGE0 = (NKB + NVB) * 16384, STAGE_W = 4608;
constexpr int EX_GA = STAGE0 + 8 * STAGE_W;
constexpr int EX_DEAD = EX_GA + NVB * 256;
static_assert(EX_DEAD + 64 <= MISC_OFF, "mixer LDS map");
struct UnitP { int b, h, qb, layer; };
template <bool SBK> struct LoopPtrs { const bf16* Kp; const bf16* Vp; const float* ga; int pk, pv; };
template <bool SBK> __device__ __forceinline__ LoopPtrs<SBK> loop_ptrs(KArgs kap, const UnitP& u) {
    LoopPtrs<SBK> p; const size_t r0 = (size_t)u.b * SEQ; const bf16* proj = (const bf16*)WSP(WS_PROJ);
    if (SBK) { p.Kp = proj + r0 * NPROJ + 2560 + u.h * 64; p.Vp = proj + r0 * NPROJ + 3072 + u.h * 64; p.ga = nullptr; p.pk = NPROJ; p.pv = NPROJ; }
    else { const bf16* qkc = (const bf16*)WSP(WS_QKC); p.Kp = qkc + r0 * DM + 512 + u.h * 128; p.Vp = proj + r0 * NPROJ + 1024 + u.h * 128; p.ga = (const float*)WSP(WS_GA) + (size_t)(u.b * 4 + u.h) * SEQ; p.pk = DM; p.pv = NPROJ; }
    return p;
}

template <int D, bool ML, class LP>
__device__ __forceinline__ void issue_tile(unsigned kbuf, unsigned vbuf, unsigned gabuf, const LP& u, int s0, int wid, int lane) {
#pragma unroll
    for (int c = 0; c < D / 64; ++c) { const int ch = wid + 8 * c;
        glds16(u.Kp + (size_t)(s0 + lane) * u.pk + 8 * ch, (unsigned)__builtin_amdgcn_readfirstlane(kbuf + ch * 1024)); }
#pragma unroll
    for (int c = 0; c < D / 64; ++c) { const int idx = wid + 8 * c, dp = idx >> 2, rg = idx & 3;
        glds16(u.Vp + (size_t)(s0 + 16 * rg + (lane >> 2)) * u.pv + 32 * dp + 8 * (lane & 3), (unsigned)__builtin_amdgcn_readfirstlane(vbuf + dp * 4096 + rg * 1024)); }
    if (ML) glds4(u.ga + s0 + lane, (unsigned)__builtin_amdgcn_readfirstlane(gabuf));
}
template <int D>
__device__ __forceinline__ void qk(lptr kimg, const bf16x8 (&qr)[D / 16], f32x16& p0, f32x16& p1, const int lane) {
    const lptr kp = kimg + (lane >> 5) * 1024 + (lane & 31) * 16;
    p0 = f32x16{}; p1 = f32x16{};
#pragma unroll
    for (int hb = 0; hb < D / 64; ++hb) {
        bf16x8 kf[8];
#pragma unroll
        for (int d = 0; d < 4; ++d) { const int d0 = 4 * hb + d; kf[2 * d] = *(LAS const bf16x8*)(kp + d0 * 2048); kf[2 * d + 1] = *(LAS const bf16x8*)(kp + d0 * 2048 + 512); }
        __builtin_amdgcn_sched_barrier(0);
#pragma unroll
        for (int d = 0; d < 4; ++d) { const int d0 = 4 * hb + d; p0 = MX_MFMA(kf[2 * d], qr[d0], p0); p1 = MX_MFMA(kf[2 * d + 1], qr[d0], p1); }
        __builtin_amdgcn_sched_barrier(0);
    }
}
template <int D, bool SBK, bool MASK>
__device__ __forceinline__ void vp(lptr vimg, LAS const float* gat, const f32x16& p0, const f32x16& p1, f32x16 (&o)[D / 32], float& st, const float Mt, const int qrow, const int key0, const int lane) {
    const int hi = lane >> 5;
    const lptr vb = vimg + ((lane >> 4) & 1) * 32 + (lane & 3) * 8 + (4 * hi + ((lane & 15) >> 2)) * 64;
    constexpr int VPRE = (D == 128) ? 2 : D / 32;
    s16x4 vlo[VPRE * 4], vhi[VPRE * 4];
#pragma unroll
    for (int dp = 0; dp < VPRE; ++dp)
#pragma unroll
        for (int ks = 0; ks < 4; ++ks) { vlo[dp * 4 + ks] = vtr(vb + dp * 4096 + ks * 1024); vhi[dp * 4 + ks] = vtr(vb + dp * 4096 + ks * 1024 + 512); }
    __builtin_amdgcn_sched_barrier(0);
    u32x4 pw[4];
    if constexpr (SBK) {
        float R = st;
#pragma unroll
        for (int blk = 1; blk >= 0; --blk) {
            const f32x16& X = blk ? p1 : p0; const int kb = key0 + 32 * blk;
            float bt[16], sx[16], Pg[4], Qg[4];
#pragma unroll
            for (int g = 0; g < 4; ++g) { float run = 1.f;
#pragma unroll
                for (int i = 3; i >= 0; --i) { const int r = 4 * g + i; float z = X[r]; if (MASK) z = (kb + crow(r, hi) < qrow) ? z : -INFINITY;
                    const float e = __builtin_amdgcn_exp2f(-z); const float b = __builtin_amdgcn_rcpf(1.0f + e); bt[r] = b; sx[r] = run; run *= (1.0f - b); }
                Pg[g] = run; }
#pragma unroll
            for (int g = 0; g < 4; ++g) Qg[g] = partner(Pg[g], hi);
            float a[16];
#pragma unroll
            for (int g = 3; g >= 0; --g) { const float pre = R * (hi ? 1.0f : Qg[g]);
#pragma unroll
                for (int i = 0; i < 4; ++i) a[4 * g + i] = bt[4 * g + i] * sx[4 * g + i] * pre;
                R *= Pg[g] * Qg[g]; }
            pw[2 * blk] = (u32x4){cvtpk(a[0], a[1]), cvtpk(a[2], a[3]), cvtpk(a[4], a[5]), cvtpk(a[6], a[7])};
            pw[2 * blk + 1] = (u32x4){cvtpk(a[8], a[9]), cvtpk(a[10], a[11]), cvtpk(a[12], a[13]), cvtpk(a[14], a[15])};
        }
        st = R;
    } else {
        float den = st;
#pragma unroll
        for (int blk = 0; blk < 2; ++blk) {
            const f32x16& X = blk ? p1 : p0; const int kb = key0 + 32 * blk;
            float a[16];
#pragma unroll
            for (int g = 0; g < 4; ++g) { const f32x4 gv = *(LAS const f32x4*)(gat + 32 * blk + 8 * g + 4 * hi);
#pragma unroll
                for (int i = 0; i < 4; ++i) { const int r = 4 * g + i; float p = X[r] * (gv[i] * Mt); if (MASK) p = (kb + crow(r, hi) <= qrow) ? p : 0.f; den += p; a[r] = p; } }
            pw[2 * blk] = (u32x4){cvtpk(a[0], a[1]), cvtpk(a[2], a[3]), cvtpk(a[4], a[5]), cvtpk(a[6], a[7])};
            pw[2 * blk + 1] = (u32x4){cvtpk(a[8], a[9]), cvtpk(a[10], a[11]), cvtpk(a[12], a[13]), cvtpk(a[14], a[15])};
        }
        st = den;
    }
    __builtin_amdgcn_sched_barrier(0);
    if constexpr (VPRE < D / 32) {
#pragma unroll
        for (int dp = 0; dp < VPRE; ++dp)
#pragma unroll
            for (int ks = 0; ks < 4; ++ks) { const s16x4 a = vlo[dp * 4 + ks], b = vhi[dp * 4 + ks];
                o[dp] = MX_MFMA(__builtin_bit_cast(bf16x8, pw[ks]), ((bf16x8){a[0], a[1], a[2], a[3], b[0], b[1], b[2], b[3]}), o[dp]); }
        __builtin_amdgcn_sched_barrier(0);
        s16x4 wlo[(D / 32 - VPRE) * 4], whi[(D / 32 - VPRE) * 4];
#pragma unroll
        for (int dp = VPRE; dp < D / 32; ++dp)
#pragma unroll
            for (int ks = 0; ks < 4; ++ks) { wlo[(dp - VPRE) * 4 + ks] = vtr(vb + dp * 4096 + ks * 1024); whi[(dp - VPRE) * 4 + ks] = vtr(vb + dp * 4096 + ks * 1024 + 512); }
        __builtin_amdgcn_sched_barrier(0);
#pragma unroll
        for (int dp = VPRE; dp < D / 32; ++dp)
#pragma unroll
            for (int ks = 0; ks < 4; ++ks) { const s16x4 a = wlo[(dp - VPRE) * 4 + ks], b = whi[(dp - VPRE) * 4 + ks];
                o[dp] = MX_MFMA(__builtin_bit_cast(bf16x8, pw[ks]), ((bf16x8){a[0], a[1], a[2], a[3], b[0], b[1], b[2], b[3]}), o[dp]); }
    } else {
#pragma unroll
        for (int dp = 0; dp < D / 32; ++dp)
#pragma unroll
            for (int ks = 0; ks < 4; ++ks) { const s16x4 a = vlo[dp * 4 + ks], b = vhi[dp * 4 + ks];
                o[dp] = MX_MFMA(__builtin_bit_cast(bf16x8, pw[ks]), ((bf16x8){a[0], a[1], a[2], a[3], b[0], b[1], b[2], b[3]}), o[dp]); }
    }
}
template <int D, bool SBK, bool MASK>
__device__ __forceinline__ void valu(LAS const float* gat, const f32x16& p0, const f32x16& p1, u32x4 (&pw)[4], float& st, const float Mt, const int qrow, const int key0, const int lane) {
    const int hi = lane >> 5;
    if constexpr (SBK) {
        float R = st;
#pragma unroll
        for (int blk = 1; blk >= 0; --blk) {
            const f32x16& X = blk ? p1 : p0; const int kb = key0 + 32 * blk;
            float bt[16], sx[16], Pg[4], Qg[4];
#pragma unroll
            for (int g = 0; g < 4; ++g) { float run = 1.f;
#pragma unroll
                for (int i = 3; i >= 0; --i) { const int r = 4 * g + i; float z = X[r]; if (MASK) z = (kb + crow(r, hi) < qrow) ? z : -INFINITY;
                    const float e = __builtin_amdgcn_exp2f(-z); const float b = __builtin_amdgcn_rcpf(1.0f + e); bt[r] = b; sx[r] = run; run *= (1.0f - b); }
                Pg[g] = run; }
#pragma unroll
            for (int g = 0; g < 4; ++g) Qg[g] = partner(Pg[g], hi);
            float a[16];
#pragma unroll
            for (int g = 3; g >= 0; --g) { const float pre = R * (hi ? 1.0f : Qg[g]);
#pragma unroll
                for (int i = 0; i < 4; ++i) a[4 * g + i] = bt[4 * g + i] * sx[4 * g + i] * pre;
                R *= Pg[g] * Qg[g]; }
            pw[2 * blk] = (u32x4){cvtpk(a[0], a[1]), cvtpk(a[2], a[3]), cvtpk(a[4], a[5]), cvtpk(a[6], a[7])};
            pw[2 * blk + 1] = (u32x4){cvtpk(a[8], a[9]), cvtpk(a[10], a[11]), cvtpk(a[12], a[13]), cvtpk(a[14], a[15])};
        }
        st = R;
    } else {
        float den = st;
#pragma unroll
        for (int blk = 0; blk < 2; ++blk) {
            const f32x16& X = blk ? p1 : p0; const int kb = key0 + 32 * blk;
            float a[16];
#pragma unroll
            for (int g = 0; g < 4; ++g) { const f32x4 gv = *(LAS const f32x4*)(gat + 32 * blk + 8 * g + 4 * hi);
#pragma unroll
                for (int i = 0; i < 4; ++i) { const int r = 4 * g + i; float p = X[r] * (gv[i] * Mt); if (MASK) p = (kb + crow(r, hi) <= qrow) ? p : 0.f; den += p; a[r] = p; } }
            pw[2 * blk] = (u32x4){cvtpk(a[0], a[1]), cvtpk(a[2], a[3]), cvtpk(a[4], a[5]), cvtpk(a[6], a[7])};
            pw[2 * blk + 1] = (u32x4){cvtpk(a[8], a[9]), cvtpk(a[10], a[11]), cvtpk(a[12], a[13]), cvtpk(a[14], a[15])};
        }
        st = den;
    }
}
template <int D>
__device__ __forceinline__ void pv(lptr vimg, const u32x4 (&pw)[4], f32x16 (&o)[D / 32], const int lane) {
    const int hi = lane >> 5;
    const lptr vb = vimg + ((lane >> 4) & 1) * 32 + (lane & 3) * 8 + (4 * hi + ((lane & 15) >> 2)) * 64;
#pragma unroll
    for (int hb = 0; hb < D / 64; ++hb) {
        s16x4 vlo[8], vhi[8];
#pragma unroll
        for (int d = 0; d < 2; ++d)
#pragma unroll
            for (int ks = 0; ks < 4; ++ks) { const int dp = 2 * hb + d; vlo[d * 4 + ks] = vtr(vb + dp * 4096 + ks * 1024); vhi[d * 4 + ks] = vtr(vb + dp * 4096 + ks * 1024 + 512); }
        __builtin_amdgcn_sched_barrier(0);
#pragma unroll
        for (int d = 0; d < 2; ++d)
#pragma unroll
            for (int ks = 0; ks < 4; ++ks) { const int dp = 2 * hb + d; const s16x4 a = vlo[d * 4 + ks], b = vhi[d * 4 + ks];
                o[dp] = MX_MFMA(__builtin_bit_cast(bf16x8, pw[ks]), ((bf16x8){a[0], a[1], a[2], a[3], b[0], b[1], b[2], b[3]}), o[dp]); }
        __builtin_amdgcn_sched_barrier(0);
    }
}
__device__ __forceinline__ void ml_fused(LAS const float* gat, const f32x16& p0, const f32x16& p1, u32x4 (&pwN)[4], float& den, const float ft, const int lane,
                                         lptr vimgP, const u32x4 (&pwP)[4], f32x16 (&o)[4], const bool dopv) {
    const int hi = lane >> 5;
    const lptr vb = vimgP + ((lane >> 4) & 1) * 32 + (lane & 3) * 8 + (4 * hi + ((lane & 15) >> 2)) * 64;
    s16x4 f0a = vtr(vb), f0b = vtr(vb + 512), f1a = vtr(vb + 1024), f1b = vtr(vb + 1024 + 512);
    f32x4 gv = {};
    __builtin_amdgcn_sched_barrier(0);
#pragma unroll
    for (int k = 0; k < 16; ++k) {
        const int dp = k >> 2, ks = k & 3;
        s16x4 f2a = f0a, f2b = f0b;
        if (k + 2 < 16) { const int dn = (k + 2) >> 2, kn = (k + 2) & 3; f2a = vtr(vb + dn * 4096 + kn * 1024); f2b = vtr(vb + dn * 4096 + kn * 1024 + 512); }
        if (dopv) o[dp] = MX_MFMA(__builtin_bit_cast(bf16x8, pwP[ks]), ((bf16x8){f0a[0], f0a[1], f0a[2], f0a[3], f0b[0], f0b[1], f0b[2], f0b[3]}), o[dp]);
        const int blk = k >> 3, r = 2 * (k & 7);
        if ((k & 1) == 0) gv = *(LAS const f32x4*)(gat + 32 * blk + 8 * (r >> 2) + 4 * hi);
        const f32x16& X = blk ? p1 : p0;
        const float q0 = X[r] * (gv[r & 3] * ft), q1 = X[r + 1] * (gv[(r & 3) + 1] * ft);
        den += q0; den += q1;
        unsigned w = cvtpk(q0, q1);
        asm volatile("" : "+v"(w)); asm volatile("" : "+v"(den));
        pwN[2 * blk + ((k & 7) >> 2)][(k & 7) & 3] = w;
        f0a = f1a; f0b = f1b; f1a = f2a; f1b = f2b;
        __builtin_amdgcn_sched_barrier(0);
    }
}
__device__ __forceinline__ void ml_mask(f32x16& p0, f32x16& p1, const int qrow, const int key0, const int lane) {
    const int hi = lane >> 5;
#pragma unroll
    for (int r = 0; r < 16; ++r) { const int kk = key0 + crow(r, hi); p0[r] = (kk <= qrow) ? p0[r] : 0.f; p1[r] = (kk + 32 <= qrow) ? p1[r] : 0.f; }
}
template <int D, bool SBK>
__device__ __forceinline__ void prefetch_unit(KArgs kap, LAS unsigned char* lds, const int wave_s, const UnitP& u, bf16x8 (&qr)[D / 16], float& Mt, float& Ml, float& tgv) {
    int tid = wave_s * 64 + lane_id(); asm volatile("" : "+v"(tid));
    const int lane = tid & 63, wid = __builtin_amdgcn_readfirstlane(tid >> 6);
    const int qrow = 256 * u.qb + 32 * wid + (lane & 31), nt = 4 * (u.qb + 1);
    const unsigned l0 = (unsigned)(size_t)lds;
    const LoopPtrs<SBK> lp = loop_ptrs<SBK>(kap, u);
    issue_tile<D, !SBK>(l0 + KBUF0, l0 + VBUF0, l0 + EX_GA, lp, 64 * (nt - 1), wid, lane);
    issue_tile<D, !SBK>(l0 + KBUF0 + BUFSZ, l0 + VBUF0 + BUFSZ, l0 + EX_GA + 256, lp, 64 * (nt - 2), wid, lane);
    const size_t r0 = (size_t)u.b * SEQ;
    const bf16* Qp = SBK ? (const bf16*)WSP(WS_PROJ) + r0 * NPROJ + 2048 + u.h * 64 : (const bf16*)WSP(WS_QKC) + r0 * DM + u.h * 128; const int pq = SBK ? NPROJ : DM;
#pragma unroll
    for (int d0 = 0; d0 < D / 16; ++d0) qr[d0] = *(const GAS bf16x8*)(Qp + (size_t)qrow * pq + d0 * 16 + (lane >> 5) * 8);
    Mt = 0.f; Ml = 0.f; tgv = 0.f;
    if (!SBK) { const size_t bh = (size_t)(u.b * 4 + u.h); Mt = ((const float*)WSP(WS_GM))[bh * SEQ + qrow]; Ml = ((const float*)WSP(WS_GM))[bh * SEQ + 256 * u.qb + 255];
        tgv = ((const float*)WSP(WS_TG))[bh * 32 + (lane & 31)]; }
}
template <int D, bool SBK>
__device__ __forceinline__ void unit_run(KArgs kap, LAS unsigned char* lds, const int wave_s, const UnitP& u, const bool has_next, const UnitP& nx, bf16x8 (&qr)[D / 16], float& Mt, float& Ml, float& tgv) {
    int tid = wave_s * 64 + lane_id(); asm volatile("" : "+v"(tid));
    const LoopPtrs<SBK> lp = loop_ptrs<SBK>(kap, u);
    const int lane = tid & 63, wid = __builtin_amdgcn_readfirstlane(tid >> 6), late = MX_LATE ? (wid >> 2) : 0, r32 = lane & 31, hi = lane >> 5;
    const int t0 = 256 * u.qb, nt = 4 * (u.qb + 1), R0 = t0 + 32 * wid, qrow = R0 + r32;
    const unsigned l0 = (unsigned)(size_t)lds;
#pragma unroll
    for (int d0 = 0; d0 < D / 16; ++d0) asm volatile("" : "+v"(qr[d0]));
    asm volatile("" : "+v"(Mt)); asm volatile("" : "+v"(Ml)); asm volatile("" : "+v"(tgv));
    const float fv = SBK ? 0.f : __builtin_amdgcn_exp2f(tgv - Ml);
    const float Bt = SBK ? 1.f : __builtin_amdgcn_exp2f(Ml - Mt);
    f32x16 o[D / 32];
#pragma unroll
    for (int i = 0; i < D / 32; ++i) o[i] = f32x16{};
    float st = SBK ? 1.0f : 0.0f;
    const int nti = (!SBK && ML_CHUNK) ? 4 : nt;
    if constexpr (!SBK && ML_CHUNK) {
        __builtin_amdgcn_s_barrier();
        if (u.qb > 0) {
            const int bh = u.b * 4 + u.h;
            const float* CMp = (const float*)WSP(WS_CM) + bh * 8;
            {
                const int d = tid >> 2, dp = tid & 3;
                const unsigned short* Ub = (const unsigned short*)WSP(WS_U) + (size_t)bh * 7 * 16384 + d * 128 + dp * 32;
                v4u rr[7][4];
#pragma unroll
                for (int j = 0; j < 7; ++j) { const int jc = (j < u.qb) ? j : u.qb - 1;
#pragma unroll
                    for (int c = 0; c < 4; ++c) rr[j][c] = *(const GAS v4u*)(Ub + (size_t)jc * 16384 + 8 * c); }
                float scj[7];
                { const f32x4 c0 = *(const GAS f32x4*)CMp, c1 = *(const GAS f32x4*)(CMp + 4);
                  const float cmv[8] = {c0.x, c0.y, c0.z, c0.w, c1.x, c1.y, c1.z, c1.w};
#pragma unroll
                  for (int j = 0; j < 7; ++j) scj[j] = (j < u.qb) ? __builtin_amdgcn_exp2f(cmv[j] - Ml) : 0.f; }
                float ac[32];
#pragma unroll
                for (int c = 0; c < 32; ++c) ac[c] = 0.f;
#pragma unroll
                for (int j = 0; j < 7; ++j)
#pragma unroll
                    for (int c = 0; c < 4; ++c) { const v4u x = rr[j][c];
                        ac[8 * c + 0] += scj[j] * bflo(x.x); ac[8 * c + 1] += scj[j] * bfhi(x.x); ac[8 * c + 2] += scj[j] * bflo(x.y); ac[8 * c + 3] += scj[j] * bfhi(x.y);
                        ac[8 * c + 4] += scj[j] * bflo(x.z); ac[8 * c + 5] += scj[j] * bfhi(x.z); ac[8 * c + 6] += scj[j] * bflo(x.w); ac[8 * c + 7] += scj[j] * bfhi(x.w); }
                const int dl = d & 63, rho = (dl & 0x33) | ((dl & 4) << 1) | ((dl & 8) >> 1);
                LAS unsigned char* ip = lds + STAGE0 + (d >> 6) * 16384 + dp * 4096 + rho * 64;
#pragma unroll
                for (int c = 0; c < 4; ++c) *(LAS v4u*)(ip + 16 * c) = (v4u){cvtpk(ac[8 * c], ac[8 * c + 1]), cvtpk(ac[8 * c + 2], ac[8 * c + 3]), cvtpk(ac[8 * c + 4], ac[8 * c + 5]), cvtpk(ac[8 * c + 6], ac[8 * c + 7])};
                if (tid < 128) { const float* NVp = (const float*)WSP(WS_NV) + (size_t)bh * 7 * 128 + tid; float nn = 0.f, nvv[7];
#pragma unroll
                    for (int j = 0; j < 7; ++j) { const int jc = (j < u.qb) ? j : u.qb - 1; nvv[j] = NVp[jc * 128]; }
                    asm volatile("" : "+v"(nvv[0]), "+v"(nvv[1]), "+v"(nvv[2]), "+v"(nvv[3]), "+v"(nvv[4]), "+v"(nvv[5]), "+v"(nvv[6]));
#pragma unroll
                    for (int j = 0; j < 7; ++j) nn += scj[j] * nvv[j];
                    ((LAS float*)(lds + STAGE0 + 32768))[tid] = nn; }
            }
            LDS_WAIT(); __builtin_amdgcn_s_barrier(); asm volatile("" ::: "memory");
            {
                u32x4 qa[4], qb_[4];
#pragma unroll
                for (int c = 0; c < 4; ++c) { qa[c] = __builtin_bit_cast(u32x4, qr[c]); qb_[c] = __builtin_bit_cast(u32x4, qr[4 + c]); }
                pv<128>((lptr)(lds + STAGE0), qa, o, lane);
                pv<128>((lptr)(lds + STAGE0 + 16384), qb_, o, lane);
                LAS const float* nvl = (LAS const float*)(lds + STAGE0 + 32768);
                float dn = 0.f;
#pragma unroll
                for (int d0 = 0; d0 < 8; ++d0) { const f32x4 n0 = *(LAS const f32x4*)(nvl + 16 * d0 + 8 * hi), n1 = *(LAS const f32x4*)(nvl + 16 * d0 + 8 * hi + 4); const u32x4 qq = __builtin_bit_cast(u32x4, qr[d0]);
                    dn += bflo(qq.x) * n0.x + bfhi(qq.x) * n0.y + bflo(qq.y) * n0.z + bfhi(qq.y) * n0.w + bflo(qq.z) * n1.x + bfhi(qq.z) * n1.y + bflo(qq.w) * n1.z + bfhi(qq.w) * n1.w; }
                st = dn;
            }
        }
    }
    f32x16 p0 = {}, p1 = {};
    u32x4 pwP[4] = {}; bool havep = false;
    LAS unsigned* const dflag = (LAS unsigned*)(lds + EX_DEAD);
    if (SBK) { if (lane == 0) dflag[wid] = 0u; }
    int k3 = 0, v4 = 0;
    bool wdead = false;
    for (int i = 0; i < nti + MX_LATE; ++i) {
        if (i + 1 < nti) { if (D == 64) asm volatile("s_waitcnt vmcnt(2)" ::: "memory"); else asm volatile("s_waitcnt vmcnt(5)" ::: "memory"); }
        else asm volatile("s_waitcnt vmcnt(0)" ::: "memory");
        if (SBK) LDS_WAIT();
        __builtin_amdgcn_s_barrier();
        asm volatile("" ::: "memory");
        if (SBK && i > 0) { const u32x4 d0 = *(LAS const u32x4*)dflag, d1 = *(LAS const u32x4*)(dflag + 4);
            if (__builtin_amdgcn_readfirstlane((int)(d0.x & d0.y & d0.z & d0.w & d1.x & d1.y & d1.z & d1.w)) != 0) break; }
        if (i + 2 < nti) { const int k3n = (k3 == 0) ? 2 : k3 - 1, v4n = (v4 + 2) & 3;
            issue_tile<D, !SBK>(l0 + KBUF0 + k3n * BUFSZ, l0 + VBUF0 + v4n * BUFSZ, l0 + EX_GA + v4n * 256, lp, 64 * (nt - 3 - i), wid, lane); }
        const int v4p = (v4 + 3) & 3;
        const int tv = late ? nt - i : nt - 1 - i;
        const int vb = late ? v4p : v4;
        const bool dov = late ? (i >= 1) : (i < nti);
        const int tq = nt - 1 - i;
        const bool doq = (i < nti) && (SBK ? (64 * tq < R0 + 31) : (64 * tq <= R0 + 31));
        const lptr kimg = (lptr)(lds + KBUF0 + k3 * BUFSZ);
        if (!late && doq && !wdead) qk<D>(kimg, qr, p0, p1, lane);
        if constexpr (!SBK) {
            if (doq) {
                const float ft = __builtin_bit_cast(float, __builtin_amdgcn_readlane(__builtin_bit_cast(int, fv), tq));
                const bool unm = (64 * tq + 63 <= R0);
                LAS const float* gat = (LAS const float*)(lds + EX_GA + v4 * 256); const lptr vprev = (lptr)(lds + VBUF0 + v4p * BUFSZ);
                u32x4 pwN[4];
                if (!unm) ml_mask(p0, p1, qrow, 64 * tq, lane);
                ml_fused(gat, p0, p1, pwN, st, ft, lane, vprev, pwP, o, havep);
#pragma unroll
                for (int q_ = 0; q_ < 4; ++q_) pwP[q_] = pwN[q_];
                havep = true;
            }
        } else
        if (dov) {
            const bool live = SBK ? (64 * tv < R0 + 31) : (64 * tv <= R0 + 31);
            const bool unm = SBK ? (64 * tv + 63 < R0) : (64 * tv + 63 <= R0);
            const lptr vimg = (lptr)(lds + VBUF0 + vb * BUFSZ); LAS const float* gat = (LAS const float*)(lds + EX_GA + vb * 256);
            if (live && !wdead) { const float ft = SBK ? 0.f : __builtin_bit_cast(float, __builtin_amdgcn_readlane(__builtin_bit_cast(int, fv), tv));
                if (unm) vp<D, SBK, false>(vimg, gat, p0, p1, o, st, ft, qrow, 64 * tv, lane); else vp<D, SBK, true>(vimg, gat, p0, p1, o, st, ft, qrow, 64 * tv, lane);
                if (SBK) { const bool dead = (__ballot(st != 0.0f) == 0ull); if (lane == 0) dflag[wid] = dead ? 1u : 0u; wdead = dead; } }
        }
        if (late && doq) qk<D>(kimg, qr, p0, p1, lane);
        k3 = (k3 == 2) ? 0 : k3 + 1; v4 = (v4 + 1) & 3;
    }
    if constexpr (!SBK) { if (havep) pv<D>((lptr)(lds + VBUF0 + ((nt - 1) & 3) * BUFSZ), pwP, o, lane); }
    LDS_WAIT(); __builtin_amdgcn_s_barrier(); asm volatile("" ::: "memory");
    const float ge_q = SBK ? 0.f : ((const float*)WSP(WS_GE))[(size_t)(u.b * 4 + u.h) * SEQ + qrow];
    if (has_next) prefetch_unit<D, SBK>(kap, lds, wave_s, nx, qr, Mt, Ml, tgv);
    const size_t er0 = (size_t)u.b * SEQ;
    bf16* const e_out = (bf16*)WSP(WS_MIXED) + er0 * DM + (SBK ? 512 + u.h * 64 : u.h * 128);
    const float* const e_gain = SBK ? KA(g_sb) + u.layer * 512 + u.h * 64 : KA(g_mlstm) + u.layer * 512 + u.h * 128;
    const bf16* const e_om = (const bf16*)WSP(WS_PROJ) + er0 * NPROJ + 1536 + u.h * 128;
    LAS float* stg = (LAS float*)(lds + STAGE0 + wid * STAGE_W); LAS float* wsf = stg + 1088;
    if (!SBK) { const float den = (st + partner(st, hi)) * Bt; if (hi == 0) wsf[r32] = Bt / fmaxf(fabsf(den), ge_q); }
    constexpr int RP = (D == 64) ? 16 : 8, NPASS = 32 / RP, LPR = 64 / RP, PITCH = D + 4, RPP = 16 / NPASS;
    const int rl = lane / LPR, seg = lane % LPR;
    float gn[16];
#pragma unroll
    for (int c = 0; c < 4; ++c) { const f32x4 g = *(const GAS f32x4*)(e_gain + 16 * seg + 4 * c); gn[4 * c] = g.x; gn[4 * c + 1] = g.y; gn[4 * c + 2] = g.z; gn[4 * c + 3] = g.w; }
    v4u gpre[SBK ? 1 : NPASS][2];
    if constexpr (!SBK) {
#pragma unroll
        for (int ps = 0; ps < NPASS; ++ps) { const int gr_ = R0 + ps * RP + rl; gpre[ps][0] = *(const GAS v4u*)(e_om + (size_t)gr_ * NPROJ + 16 * seg); gpre[ps][1] = *(const GAS v4u*)(e_om + (size_t)gr_ * NPROJ + 16 * seg + 8); }
    }
#pragma unroll
    for (int ps = 0; ps < NPASS; ++ps) {
        LDS_WAIT(); asm volatile("" ::: "memory");
#pragma unroll
        for (int rr = 0; rr < RPP; ++rr) { const int r = ps * RPP + rr; const int srow = crow(r, hi) - ps * RP;
#pragma unroll
            for (int dp = 0; dp < D / 32; ++dp) stg[srow * PITCH + 32 * dp + r32] = o[dp][r]; }
        LDS_WAIT(); asm volatile("" ::: "memory");
        float x[16];
#pragma unroll
        for (int c = 0; c < 4; ++c) { const f32x4 v4 = *(LAS const f32x4*)(stg + rl * PITCH + 16 * seg + 4 * c); x[4 * c] = v4.x; x[4 * c + 1] = v4.y; x[4 * c + 2] = v4.z; x[4 * c + 3] = v4.w; }
        const int prow = ps * RP + rl, grow = R0 + prow;
        if (!SBK) { const float inv = wsf[prow];
#pragma unroll
            for (int c = 0; c < 16; ++c) x[c] *= inv; }
        float ss = 0.f;
#pragma unroll
        for (int c = 0; c < 16; ++c) ss += x[c] * x[c];
        ss = (LPR == 8) ? oct_sum(ss, lane) : quad_sum(ss);
        const float rs = 1.0f / sqrtf(ss * (1.0f / D) + EPS);
#pragma unroll
        for (int c = 0; c < 16; ++c) x[c] *= rs * gn[c];
        if (!SBK) { const v4u g0 = gpre[SBK ? 0 : ps][0], g1 = gpre[SBK ? 0 : ps][1];
            float gg[16]; gg[0] = bflo(g0.x); gg[1] = bfhi(g0.x); gg[2] = bflo(g0.y); gg[3] = bfhi(g0.y); gg[4] = bflo(g0.z); gg[5] = bfhi(g0.z); gg[6] = bflo(g0.w); gg[7] = bfhi(g0.w);
            gg[8] = bflo(g1.x); gg[9] = bfhi(g1.x); gg[10] = bflo(g1.y); gg[11] = bfhi(g1.y); gg[12] = bflo(g1.z); gg[13] = bfhi(g1.z); gg[14] = bflo(g1.w); gg[15] = bfhi(g1.w);
#pragma unroll
            for (int c = 0; c < 16; ++c) x[c] *= 1.0f / (1.0f + __expf(-gg[c])); }
        bf16* op = e_out + (size_t)grow * DM + 16 * seg;
        *(GAS v4u*)op = (v4u){pk2(x[0], x[1]), pk2(x[2], x[3]), pk2(x[4], x[5]), pk2(x[6], x[7])};
        *(GAS v4u*)(op + 8) = (v4u){pk2(x[8], x[9]), pk2(x[10], x[11]), pk2(x[12], x[13]), pk2(x[14], x[15])};
    }
    LDS_WAIT();
}
#undef MX_MFMA
}

__device__ __forceinline__ void mixer_phase(KArgs kap, LAS unsigned char* lds, const int wave_s, const int layer) {
    int G = gridDim.x; asm volatile("" : "+s"(G)); int bid = blockIdx.x; asm volatile("" : "+s"(bid));
    for (int jb = bid; jb < 256; jb += G) {
        {
            int jb2 = jb; asm volatile("" : "+s"(jb2));
            const int b = jb2 & 7, idx = jb2 >> 3, m = idx & 7, hl = idx >> 3;
#if ML_CHUNK
            int hA, qA, hB, qB;
            if (m < 6) { const int n0 = (m * 4 + hl) * 2, n1 = n0 + 1; hA = (n0 * 37) >> 8; qA = 1 + n0 - 7 * hA; hB = (n1 * 37) >> 8; qB = 1 + n1 - 7 * hB; }
            else { const int n0 = 48 + (m - 6) * 4 + hl; hA = (n0 * 37) >> 8; qA = 1 + n0 - 7 * hA; hB = hl + 4 * (m - 6); qB = 0; }
            bf16x8 qr[4]; float Mt, Ml, tgv;
            __builtin_amdgcn_s_barrier();
            {
                const mix2::UnitP uA{b, hA, qA, layer}, uB{b, hB, qB, layer};
                mix2::prefetch_unit<64, true>(kap, lds, wave_s, uA, qr, Mt, Ml, tgv);
                mix2::unit_run<64, true>(kap, lds, wave_s, uA, true, uB, qr, Mt, Ml, tgv);
                mix2::unit_run<64, true>(kap, lds, wave_s, uB, false, uB, qr, Mt, Ml, tgv);
            }
#else
            const int nsb = (0x01122334 >> (4 * m)) & 15, st0 = (int)((0xFECA740ull >> (4 * m)) & 15ull);
            bf16x8 qr[4]; float Mt, Ml, tgv;
            __builtin_amdgcn_s_barrier();
            if (nsb > 0) {
                const int u0 = hl * 16 + st0;
                mix2::UnitP uc{b, u0 >> 3, u0 & 7, layer};
                mix2::prefetch_unit<64, true>(kap, lds, wave_s, uc, qr, Mt, Ml, tgv);
#pragma unroll 1
                for (int k = 0; k < nsb; ++k) {
                    const int un = u0 + k + 1; const mix2::UnitP nx{b, un >> 3, un & 7, layer};
                    mix2::unit_run<64, true>(kap, lds, wave_s, uc, k + 1 < nsb, nx, qr, Mt, Ml, tgv);
                    uc = nx;
                }
            }
#endif
        }
#if CONV_NOBAR
        {
            int t0_ = wave_s * 64 + lane_id();
            if (t0_ == 0) { gu32* cc = (gu32*)WSP(WS_CTL) + CW_CONV + 8 * layer + (bid & 7); unsigned sp = 0u;
                while (__hip_atomic_load(cc, __ATOMIC_RELAXED, __HIP_MEMORY_SCOPE_AGENT) < (unsigned)(G >> 3)) { __builtin_amdgcn_s_sleep(1); if (++sp > (1u << 22)) break; }
                __builtin_amdgcn_fence(__ATOMIC_ACQUIRE, "agent"); }
            __builtin_amdgcn_s_barrier();
        }
#endif
        {
            const int b = jb & 7, idx = jb >> 3, m = idx & 7, hl = idx >> 3;
            const mix2::UnitP u{b, hl, m, layer};
            bf16x8 qr[8]; float Mt, Ml, tgv;
            mix2::prefetch_unit<128, false>(kap, lds, wave_s, u, qr, Mt, Ml, tgv);
            mix2::unit_run<128, false>(kap, lds, wave_s, u, false, u, qr, Mt, Ml, tgv);
        }
        __builtin_amdgcn_s_barrier();
    }
}

#define MKFRAME() Frame F; F.lds = (LAS unsigned char*)lds; F.MISC = (volatile LAS unsigned*)(F.lds + MISC_OFF); F.tid = wave_s * 64 + lane_id(); asm volatile("" : "+v"(F.tid)); F.lane = F.tid & 63; \
    F.wave = __builtin_amdgcn_readfirstlane(F.tid >> 6); F.G = gridDim.x; asm volatile("" : "+s"(F.G)); F.bid = blockIdx.x; asm volatile("" : "+s"(F.bid)); F.ctl = (gu32*)WSP(WS_CTL)
#define GRID_BAR() do { XcdBarrier bar_; bar_.bar = (unsigned*)WSP(WS_CTL) + CW_BAR; bar_.x = xb_xcc_id(); bar_.st = (volatile LAS unsigned*)((LAS unsigned char*)lds + MISC_OFF) + 8; xcd_barrier(bar_, wave_s); } while (0)
#define GROUP_BAR() group_barrier((gu32*)WSP(WS_CTL) + CW_GB + 4096 * ((int)blockIdx.x & 7), wave_s, (volatile LAS unsigned*)((LAS unsigned char*)lds + MISC_OFF) + 24, xb_xcc_id())
#define BUILD_TAB() do { __syncthreads(); \
            if (F.tid == 0) { int acc_ = 0; for (int e = 0; e < 8; ++e) { const int c_ = (int)__hip_atomic_load(F.ctl + CW_CNT + 64 * j + e, RLX_AGENT); tab[e] = acc_; tab[16 + e] = c_; acc_ += (c_ + 255) >> 8; } tab[8] = acc_; } \
            __syncthreads(); } while (0)

__global__ void __launch_bounds__(NTHREADS, 2) mk_fwd(Args args_unused) {
    extern __shared__ __attribute__((aligned(16))) unsigned char lds[];
    KArgs kap = (KArgs)__builtin_amdgcn_kernarg_segment_ptr();
    const int wave_s = __builtin_amdgcn_readfirstlane((int)threadIdx.x >> 6);
    for (int u = threadIdx.x; u < 256; u += NTHREADS) ((LAS unsigned*)((LAS unsigned char*)lds + MISC_OFF))[u] = 0u;
    __syncthreads();
    (void)xcd_barrier_post((unsigned*)WSP(WS_CTL) + CW_BAR, (volatile LAS unsigned*)((LAS unsigned char*)lds + MISC_OFF) + 8);
    { gu32* gbp = (gu32*)WSP(WS_CTL) + CW_GB + 4096 * ((int)blockIdx.x & 7) + GB_XCNT(xb_xcc_id());
      if (threadIdx.x == 0) (void)__hip_atomic_fetch_add(gbp, 1u, __ATOMIC_RELAXED, __HIP_MEMORY_SCOPE_AGENT); }

    { MKFRAME(); Args a; a.ws = KA(ws); a.w_in = KA(w_in); a.w_out = KA(w_out); a.ffn_w_gate = KA(ffn_w_gate); a.ffn_w_up = KA(ffn_w_up); a.ffn_w_down = KA(ffn_w_down);
      a.moe_w_gate = KA(moe_w_gate); a.moe_w_up = KA(moe_w_up); a.moe_w_down = KA(moe_w_down); a.norm_mix_g = KA(norm_mix_g); a.norm_ffn_g = KA(norm_ffn_g);
#pragma unroll 1
      for (int rep = 0; rep < REP_PRO; ++rep) prologue_phase(a, F); }
    __syncthreads();
    for (int layer = 0; layer < DEPTH; ++layer) {
        const int j = layer >> 1; const bool moe = layer & 1;
        { MKFRAME();
            NormIn p{}; p.src = KA(x); p.src16 = (const bf16*)WSP(WS_H16); p.o2 = (layer == 2) ? (bf16*)WSP(WS_O2) : nullptr; p.hout16 = (layer == 0 || layer == 2) ? (bf16*)WSP(WS_H16) : nullptr; p.rs = (float*)WSP(WS_RS);
            p.gain = KA(norm_mix_g) + layer * DM; p.w8 = KA(w_in) + (size_t)layer * DM * PIN + 2048; p.ld8 = PIN; p.G = (float*)WSP(WS_G);
            if (layer == 0) norm_phase<0, false>(F, p); else norm_phase<0, true>(F, p);
        }
        if (layer == 0) GRID_BAR(); else GROUP_BAR();
        { MKFRAME();
            if (F.bid >= 128 && F.bid < 160) gate_scan(F, (F.bid & 7) * HM + ((F.bid >> 3) - 16), (float*)WSP(WS_G), KA(b_igate) + layer * HM, KA(b_fgate) + layer * HM, (float*)WSP(WS_GA), (float*)WSP(WS_GM), (float*)WSP(WS_GE), (float*)WSP(WS_TG));
            __syncthreads();
            pg8::EpiProj E{(bf16*)WSP(WS_PROJ), (const float*)WSP(WS_RS)};
            const int ngw = F.G >> 3, lw = F.bid >> 3, ntl = pg8::WGM * (NPROJ / pg8::BM);
            const int maxu = (ntl + ngw - 1) / ngw, h0 = ntl - (maxu - 1) * ngw, nh = ngw - h0;
            { pg8::InprojOrder S; S.init(WSP(WS_H16), (bf16*)WSP(WS_WIN) + (size_t)layer * NPROJ * DM, T, NPROJ, DM, F.G, F.bid, 0, 2);
              pg8::gemm_phase<pg8::EpiProj, pg8::InprojOrder, true>(F.lds + RING_OFF, S, E, F.tid); }
            asm volatile("s_waitcnt vmcnt(0)" ::: "memory");
            __syncthreads();
            { const unsigned xcc = xb_xcc_id(); gu32* gbp = F.ctl + CW_GB + 4096 * (F.bid & 7);
              if (F.tid == 0) group_arrive(gbp, F.MISC + 24, xcc, (unsigned)layer + 1u); }
            { pg8::InprojOrder S; S.init(WSP(WS_H16), (bf16*)WSP(WS_WIN) + (size_t)layer * NPROJ * DM, T, NPROJ, DM, F.G, F.bid, 2, maxu - 2);
              pg8::gemm_phase<pg8::EpiProj, pg8::InprojOrder, true>(F.lds + RING_OFF, S, E, F.tid); }
            if (nh == 0 || lw >= h0) {
                const int hidx = nh == 0 ? lw : lw - h0, nhe = nh == 0 ? ngw : nh;
                __syncthreads();
                { const unsigned xcc = xb_xcc_id(); gu32* gbp = F.ctl + CW_GB + 4096 * (F.bid & 7);
                  if (F.tid == 0) group_wait(gbp, F.MISC + 24, xcc, (unsigned)layer + 1u); }
                __syncthreads();
                conv_phase(F, (bf16*)WSP(WS_PROJ), KA(conv_w) + (size_t)layer * 4 * 1024, KA(conv_b) + (size_t)layer * 1024, (bf16*)WSP(WS_QKC), hidx, nhe);
#pragma unroll 1
                for (int ub = nhe - 1 - hidx; ub < HM * 7; ub += nhe) chunk_state_unit(F, (F.bid & 7) * HM + ub / 7, ub % 7, (bf16*)WSP(WS_PROJ), KA(conv_w) + (size_t)layer * 4 * 1024, KA(conv_b) + (size_t)layer * 1024,
                                                                   (float*)WSP(WS_GA), (float*)WSP(WS_TG), (bf16*)WSP(WS_U), (float*)WSP(WS_NV), (float*)WSP(WS_CM), (bf16*)WSP(WS_QKC));
            }
        }
        GROUP_BAR();
        { MKFRAME();
#if NAIVE_MIX == 1
            naive_sb(F, (bf16*)WSP(WS_PROJ), KA(g_sb) + layer * 512, (bf16*)WSP(WS_MIXED));
            naive_mlstm(F, (bf16*)WSP(WS_PROJ), (bf16*)WSP(WS_QKC), (float*)WSP(WS_GA), (float*)WSP(WS_GM), (float*)WSP(WS_GE), KA(g_mlstm) + layer * 512, (bf16*)WSP(WS_MIXED));
#else
#pragma unroll 1
            for (int rep = 0; rep < REP_MIX; ++rep) mixer_phase(kap, F.lds, wave_s, layer);
#endif
            __syncthreads();
        }
        GROUP_BAR();
        { MKFRAME();
            pg8::DenseOrder S; S.init(WSP(WS_MIXED), (bf16*)WSP(WS_WOUT) + (size_t)layer * DM * DM, T, DM, DM, F.G, F.bid);
            { pg8::EpiResid16<false> E{nullptr, (bf16*)WSP(WS_H16), 1.0f}; pg8::gemm_phase<pg8::EpiResid16<false>, pg8::DenseOrder, true>(F.lds + RING_OFF, S, E, F.tid); }
        }
        GROUP_BAR();
        { MKFRAME();
            NormIn p{}; p.src16 = (const bf16*)WSP(WS_H16); p.gain = KA(norm_ffn_g) + layer * DM; p.rs = (float*)WSP(WS_RS);
            if (moe) { p.w8 = KA(w_router) + (size_t)j * DM * 8; p.ld8 = 8; p.cnt = (unsigned*)(F.ctl + CW_CNT + 64 * j); p.rinfo = (uint2*)WSP(WS_RINFO); p.cntw = (int*)WSP(WS_CNTW); p.rrec = (int*)WSP(WS_RREC); p.h8 = (unsigned char*)WSP(WS_H8);
                norm_phase<2, true>(F, p); }
            else { p.h8 = ((DENSE_F8_UP >> j) & 1) ? (unsigned char*)WSP(WS_H8) : nullptr; norm_phase<1, true>(F, p); }
        }
        if (moe) { GRID_BAR(); MKFRAME(); route_finish(F, (const int*)WSP(WS_CNTW), (const int*)WSP(WS_RREC), (uint2*)WSP(WS_RINFO), (const float*)WSP(WS_RS), (float*)WSP(WS_RSI)); }
        if (moe) GRID_BAR(); else GROUP_BAR();
        { MKFRAME(); volatile LAS int* tab = (volatile LAS int*)(F.MISC + 32);
            if (!moe) {
              if ((DENSE_F8_UP >> j) & 1) {
                pg8::DenseOrderT<true> S; S.init(WSP(WS_H8), (unsigned char*)WSP(WS_WGU) + (size_t)j * 2 * FFDP * DM * 2, T, 2 * FFDP, DM / 2, F.G, F.bid);
                pg8::EpiSwiglu8 E{(unsigned char*)WSP(WS_HID), FFDP, 1.0f / F8_WGU, nullptr};
#pragma unroll 1
                for (int rep = 0; rep < REP_DUP; ++rep) pg8::gemm_phase<pg8::EpiSwiglu8, pg8::DenseOrderT<true>, true>(F.lds + RING_OFF, S, E, F.tid);
              } else if ((DENSE_F8_DN >> j) & 1) {
                pg8::DenseOrder S; S.init(WSP(WS_H16), (bf16*)WSP(WS_WGU) + (size_t)j * 2 * FFDP * DM, T, 2 * FFDP, DM, F.G, F.bid);
                pg8::EpiSwiglu8T<true> E{(unsigned char*)WSP(WS_HID), FFDP, 1.0f, (const float*)WSP(WS_RS)};
                pg8::gemm_phase<pg8::EpiSwiglu8T<true>, pg8::DenseOrder, true>(F.lds + RING_OFF, S, E, F.tid);
              } else {
                pg8::DenseOrder S; S.init(WSP(WS_H16), (bf16*)WSP(WS_WGU) + (size_t)j * 2 * FFDP * DM, T, 2 * FFDP, DM, F.G, F.bid);
                pg8::EpiSwiglu E{(bf16*)WSP(WS_HID), FFDP, (const float*)WSP(WS_RS), nullptr};
#pragma unroll 1
                for (int rep = 0; rep < REP_DUP; ++rep) pg8::gemm_phase<pg8::EpiSwiglu, pg8::DenseOrder, true>(F.lds + RING_OFF, S, E, F.tid);
              }
            } else {
                BUILD_TAB();
#if MOE_FP8
                pg8::MoeOrder<true> S; S.init(WSP(WS_H8), (unsigned char*)WSP(WS_MGU) + (size_t)j * 8 * 2 * FFE * DM, (size_t)2 * FFE * DM, 2 * FFE, DM / 2, F.G, F.bid, tab, (const uint2*)WSP(WS_RINFO));
                pg8::EpiSwiglu8 E{(unsigned char*)WSP(WS_HIDM), FFE, 1.0f / F8_WGU, nullptr};
#pragma unroll 1
                for (int rep = 0; rep < REP_MOEUP; ++rep) pg8::gemm_phase<pg8::EpiSwiglu8, pg8::MoeOrder<true>, true>(F.lds + RING_OFF, S, E, F.tid);
#else
                pg8::MoeOrder<true> S; S.init(WSP(WS_H16), (bf16*)WSP(WS_MGU) + (size_t)j * 8 * 2 * FFE * DM, (size_t)2 * FFE * DM * 2, 2 * FFE, DM, F.G, F.bid, tab, (const uint2*)WSP(WS_RINFO));
                pg8::EpiSwiglu E{(bf16*)WSP(WS_HIDM), FFE, nullptr, (const float*)WSP(WS_RSI)};
#pragma unroll 1
                for (int rep = 0; rep < REP_MOEUP; ++rep) pg8::gemm_phase<pg8::EpiSwiglu, pg8::MoeOrder<true>, true>(F.lds + RING_OFF, S, E, F.tid);
#endif
            }
        }
        if (moe) GRID_BAR(); else GROUP_BAR();
        { MKFRAME(); volatile LAS int* tab = (volatile LAS int*)(F.MISC + 32);
            if (!moe) {
              if ((DENSE_F8_DN >> j) & 1) {
                pg8::DenseOrderT<true> S; S.init(WSP(WS_HID), (unsigned char*)WSP(WS_WD) + (size_t)j * DM * FFDP * 2, T, DM, FFDP / 2, F.G, F.bid);
                pg8::EpiResid16<false> E{nullptr, (bf16*)WSP(WS_H16), 1.0f / (F8_HID * F8_WD)};
                pg8::gemm_phase<pg8::EpiResid16<false>, pg8::DenseOrderT<true>, true>(F.lds + RING_OFF, S, E, F.tid);
              } else {
                pg8::DenseOrder S; S.init(WSP(WS_HID), (bf16*)WSP(WS_WD) + (size_t)j * DM * FFDP, T, DM, FFDP, F.G, F.bid);
                pg8::EpiResid16<false> E{nullptr, (bf16*)WSP(WS_H16), 1.0f};
                pg8::gemm_phase<pg8::EpiResid16<false>, pg8::DenseOrder, true>(F.lds + RING_OFF, S, E, F.tid);
              }
            } else {
                BUILD_TAB();
#if MOE_FP8
                pg8::MoeOrder<false> S; S.init(WSP(WS_HIDM), (unsigned char*)WSP(WS_MD) + (size_t)j * 8 * DM * FFE, (size_t)DM * FFE, DM, FFE / 2, F.G, F.bid, tab, (const uint2*)WSP(WS_RINFO));
                pg8::EpiScatter E{(bf16*)WSP(WS_O2), (const uint2*)WSP(WS_RINFO), 1.0f / (F8_HID * F8_WD)};
#else
                pg8::MoeOrder<false> S; S.init(WSP(WS_HIDM), (bf16*)WSP(WS_MD) + (size_t)j * 8 * DM * FFE, (size_t)DM * FFE * 2, DM, FFE, F.G, F.bid, tab, (const uint2*)WSP(WS_RINFO));
                pg8::EpiScatter E{(bf16*)WSP(WS_O2), (const uint2*)WSP(WS_RINFO), 1.0f};
#endif
#if MOE_TAIL_KS > 1
                const int rem = S.nwg % F.G, nmain = S.nwg - rem;
                pg8::MoeOrder<false> S0 = S; S0.nwg = nmain;
                pg8::gemm_phase<pg8::EpiScatter, pg8::MoeOrder<false>, true>(F.lds + RING_OFF, S0, E, F.tid);
                if (rem > 0 && F.bid < rem * MOE_TAIL_KS) {
                    pg8::MoeTailOrder ST; ST.init(S, nmain, rem, MOE_TAIL_KS, F.bid);
                    const int tl = F.bid % rem;
                    float* Pt = (float*)WSP(WS_Y) + (size_t)tl * MOE_TAIL_KS * 65536;
                    pg8::EpiPartial EP{Pt + (size_t)ST.slice * 65536};
                    pg8::gemm_phase<pg8::EpiPartial, pg8::MoeTailOrder, true>(F.lds + RING_OFF, ST, EP, F.tid);
                    asm volatile("s_waitcnt vmcnt(0)" ::: "memory");
                    __syncthreads();
                    if (F.tid == 0) { __builtin_amdgcn_fence(__ATOMIC_RELEASE, "agent");
                        const unsigned old_ = __hip_atomic_fetch_add(F.ctl + CW_TAIL + 32 * j + tl, 1u, __ATOMIC_RELAXED, __HIP_MEMORY_SCOPE_AGENT);
                        if (old_ == MOE_TAIL_KS - 1) __builtin_amdgcn_fence(__ATOMIC_ACQUIRE, "agent");
                        F.MISC[16] = old_; }
                    __syncthreads();
                    if (F.MISC[16] == MOE_TAIL_KS - 1) {
                        f32x4 acc[2][2][4][2];
#pragma unroll
                        for (int g = 0; g < 4; ++g) {
                            const float* pg = Pt + ((size_t)(g * 8) * 512 + F.tid) * 4; asm volatile("" : "+v"(pg));
#pragma unroll
                            for (int kh = 0; kh < 2; ++kh) {
                                f32x4 t[4][MOE_TAIL_KS];
#pragma unroll
                                for (int k2 = 0; k2 < 4; ++k2)
#pragma unroll
                                    for (int sl = 0; sl < MOE_TAIL_KS; ++sl) t[k2][sl] = *(const GAS f32x4*)(pg + (size_t)sl * 65536 + (4 * kh + k2) * 2048);
#pragma unroll
                                for (int k2 = 0; k2 < 4; ++k2)
#pragma unroll
                                    for (int sl = 0; sl < MOE_TAIL_KS; ++sl) asm volatile("" : "+v"(t[k2][sl]));
#pragma unroll
                                for (int k2 = 0; k2 < 4; ++k2) { f32x4 v = t[k2][0];
#pragma unroll
                                    for (int sl = 1; sl < MOE_TAIL_KS; ++sl) v += t[k2][sl];
                                    const int k = 4 * kh + k2; acc[g >> 1][g & 1][k >> 1][k & 1] = v; }
                            }
                            asm volatile("" : "+v"(acc[g >> 1][g & 1][0][0]), "+v"(acc[g >> 1][g & 1][0][1]), "+v"(acc[g >> 1][g & 1][1][0]), "+v"(acc[g >> 1][g & 1][1][1]),
                                              "+v"(acc[g >> 1][g & 1][2][0]), "+v"(acc[g >> 1][g & 1][2][1]), "+v"(acc[g >> 1][g & 1][3][0]), "+v"(acc[g >> 1][g & 1][3][1]));
                        }
                        pg8::Unit ut; ST.base.decode(ST.wgid, ut);
                        const int wid_ = F.tid >> 6, ln_ = F.tid & 63;
                        E(acc, ut, wid_ >> 2, wid_ & 3, ln_ & 15, ln_ >> 4);
                    }
                    __syncthreads();
                }
#else
#pragma unroll 1
                for (int rep = 0; rep < REP_MOEDN; ++rep) pg8::gemm_phase<pg8::EpiScatter, pg8::MoeOrder<false>, true>(F.lds + RING_OFF, S, E, F.tid);
#endif
            }
        }
        if (moe) GRID_BAR(); else GROUP_BAR();
    }
    { MKFRAME(); NormIn p{}; p.src16 = (const bf16*)WSP(WS_H16); p.o2 = (bf16*)WSP(WS_O2); p.hout = KA(out); p.gain = KA(norm_final_g); norm_phase<3, true>(F, p); }
}

extern "C" void kernel_launch(void* const* d_in, const int* in_sizes, int n_in, void* d_out, int out_size, void* d_ws, size_t ws_size, hipStream_t stream) {
    static int grid = 0;
    if (grid == 0) {
        if (n_in != 19 || in_sizes[0] != T * DM || out_size != T * DM || ws_size < WS_END) { fprintf(stderr, "kernel_launch: unexpected shapes / workspace (%d inputs, in0 %d, out %d, ws %zu)\n", n_in, n_in > 0 ? in_sizes[0] : -1, out_size, ws_size); grid = -1; return; }
        int dev = 0, cus = 0, per_cu = 0;
        if (hipGetDevice(&dev) != hipSuccess || hipDeviceGetAttribute(&cus, hipDeviceAttributeMultiprocessorCount, dev) != hipSuccess) { grid = -1; return; }
        if (hipFuncSetAttribute((const void*)mk_fwd, hipFuncAttributeMaxDynamicSharedMemorySize, LDS_BYTES) != hipSuccess) { grid = -1; return; }
        if (hipOccupancyMaxActiveBlocksPerMultiprocessor(&per_cu, (const void*)mk_fwd, NTHREADS, LDS_BYTES) != hipSuccess || per_cu < 1) fprintf(stderr, "kernel_launch: occupancy query says %d\n", per_cu);
        (void)hipGetLastError();
        grid = cus - cus % 8;
        if (grid < 160) { fprintf(stderr, "kernel_launch: %d compute units: this kernel needs at least 160\n", cus); grid = -1; return; }
    }
    if (grid < 0) return;
    if (hipMemsetAsync((char*)d_ws + WS_CTL, 0, CTL_ZERO_BYTES, stream) != hipSuccess) return;
    Args a{};
    a.x = (const float*)d_in[0]; a.norm_mix_g = (const float*)d_in[1]; a.w_in = (const float*)d_in[2]; a.b_igate = (const float*)d_in[3]; a.b_fgate = (const float*)d_in[4];
    a.conv_w = (const float*)d_in[5]; a.conv_b = (const float*)d_in[6]; a.g_mlstm = (const float*)d_in[7]; a.g_sb = (const float*)d_in[8]; a.w_out = (const float*)d_in[9];
    a.norm_ffn_g = (const float*)d_in[10]; a.ffn_w_gate = (const float*)d_in[11]; a.ffn_w_up = (const float*)d_in[12]; a.ffn_w_down = (const float*)d_in[13];
    a.w_router = (const float*)d_in[14]; a.moe_w_gate = (const float*)d_in[15]; a.moe_w_up = (const float*)d_in[16]; a.moe_w_down = (const float*)d_in[17]; a.norm_final_g = (const float*)d_in[18];
    a.out = (float*)d_out; a.ws = (unsigned char*)d_ws; a.ph_lo = 0; a.ph_hi = 0;
    hipLaunchKernelGGL(mk_fwd, dim3(grid), dim3(NTHREADS), LDS_BYTES, stream, a);
}
```

```cpp
#include <hip/hip_runtime.h>
#include <cstdio>
#include <cstdint>

#ifndef REP_PRO
#define REP_PRO 1
#endif
#ifndef REP_MIX
#define REP_MIX 1
#endif
#ifndef REP_INPROJ
#define REP_INPROJ 1
#endif
#ifndef REP_DUP
#define REP_DUP 1
#endif
#ifndef REP_MOEUP
#define REP_MOEUP 1
#endif
#ifndef REP_MOEDN
#define REP_MOEDN 1
#endif
#ifndef REP_CONV
#define REP_CONV 1
#endif
#ifndef MX_LATE
#define MX_LATE 0
#endif
#ifndef ML_CHUNK
#define ML_CHUNK 1
#endif
#ifndef MOE_FP8
#define MOE_FP8 1
#endif
#ifndef DENSE_F8_UP
#define DENSE_F8_UP 2
#endif
#ifndef DENSE_F8_DN
#define DENSE_F8_DN 3
#endif
#ifndef MOE_TAIL_KS
#define MOE_TAIL_KS (MOE_FP8 ? 2 : 4)
#endif
#ifndef CONV_NOBAR
#define CONV_NOBAR 0
#endif
#ifndef NAIVE_MIX
#define NAIVE_MIX 0
#endif

constexpr int T = 16384, DM = 1024, SEQ = 2048, NBATCH = 8, DEPTH = 4;
constexpr int PIN = 3592, NPROJ = 3584;
constexpr int FFD = 2752, FFDP = 2816, FFE = 3584, NEXP = 8;
constexpr int HM = 4, DHM = 128, HS = 8, DHS = 64;
constexpr float EPS = 1e-6f;
constexpr float LOG2E = 1.4426950408889634f;
constexpr float QS_SCALE = 0.125f * LOG2E;
constexpr float KM_SCALE = 0.08838834764831845f;
constexpr int NWAVES = 8, NTHREADS = 512;
constexpr float F8_WGU = 64.0f, F8_WD = 128.0f, F8_HID = 8.0f, F8_MAX = 448.0f;

constexpr size_t MiB = 1u << 20;
constexpr size_t WS_CTL = 0, CTL_ZERO_BYTES = 1 * MiB;
constexpr size_t WS_WIN = 1 * MiB;
constexpr size_t WS_WOUT = 29 * MiB;
constexpr size_t WS_WGU = 37 * MiB;
constexpr size_t WS_WD = 59 * MiB;
constexpr size_t WS_MGU = 70 * MiB;
constexpr size_t WS_H8 = WS_MGU + 112 * MiB;
constexpr size_t WS_MD = 294 * MiB;
constexpr size_t WS_Y = 406 * MiB;
constexpr size_t WS_MIXED = 438 * MiB;
constexpr size_t WS_G = 470 * MiB;
constexpr size_t WS_GA = WS_G + 512 * 1024, WS_GM = WS_GA + 256 * 1024, WS_GE = WS_GM + 256 * 1024, WS_TG = WS_GE + 256 * 1024;
constexpr size_t WS_RINFO = 472 * MiB;
constexpr size_t WS_O2 = 474 * MiB;
constexpr size_t WS_BIG = 538 * MiB;
constexpr size_t WS_PROJ = WS_BIG, WS_QKC = WS_BIG + 112 * MiB, WS_HIDM = WS_BIG;
constexpr size_t WS_U = WS_BIG + 238 * MiB;
constexpr size_t WS_NV = WS_U + 15 * MiB, WS_CM = WS_NV + 128 * 1024;
constexpr size_t WS_RREC = WS_CM + 128 * 1024, WS_CNTW = WS_RREC + 512 * 1024;
constexpr size_t WS_HID = WS_BIG + 144 * MiB;
constexpr size_t WS_H16 = WS_U + 16 * MiB;
constexpr size_t WS_RS = WS_H16 + 32 * MiB, WS_RSI = WS_RS + 64 * 1024;
constexpr size_t WS_END = WS_H16 + 33 * MiB;
constexpr int HIDM_ROWS = 2 * T + 2048;
static_assert((size_t)HIDM_ROWS * FFE * 2 <= 238 * MiB, "hidm");
constexpr int CW_TMO = 0;
constexpr int CW_CNT = 64;
constexpr int CW_BAR = 4096;
constexpr int CW_INP = 3264;
constexpr int CW_CONV = 3200;
constexpr int CW_GB = 8192;
constexpr int CW_TAIL = 2048;

constexpr int RING_OFF = 0, RING_BYTES = 131072;
constexpr int MISC_OFF = 155648;
constexpr int LDS_BYTES = 163840;

#define GAS __attribute__((address_space(1)))
#define LAS __attribute__((address_space(3)))
typedef unsigned short bf16;
typedef unsigned v4u __attribute__((ext_vector_type(4)));
typedef unsigned v2u __attribute__((ext_vector_type(2)));
typedef float f32x4 __attribute__((ext_vector_type(4)));
typedef int i32x4 __attribute__((ext_vector_type(4)));
typedef float f32x2 __attribute__((ext_vector_type(2)));
typedef short bf16x8 __attribute__((ext_vector_type(8)));
typedef int i32x8 __attribute__((ext_vector_type(8)));
typedef GAS unsigned gu32;
#define RLX_AGENT __ATOMIC_RELAXED, __HIP_MEMORY_SCOPE_AGENT
#define LDS_WAIT() asm volatile("s_waitcnt lgkmcnt(0)" ::: "memory")
#define VM_WAIT() asm volatile("s_waitcnt vmcnt(0)" ::: "memory")

__device__ __forceinline__ unsigned f2bf(float f) { unsigned u = __builtin_bit_cast(unsigned, f); return (u + 0x7fffu + ((u >> 16) & 1u)) >> 16; }
__device__ __forceinline__ unsigned pk2(float lo, float hi) { return f2bf(lo) | (f2bf(hi) << 16); }
__device__ __forceinline__ unsigned pk4_f8(float a, float b, float c, float d) { int w = __builtin_amdgcn_cvt_pk_fp8_f32(a, b, 0, false); w = __builtin_amdgcn_cvt_pk_fp8_f32(c, d, w, true); return (unsigned)w; }
__device__ __forceinline__ float bf2f(unsigned b) { return __builtin_bit_cast(float, b << 16); }
__device__ __forceinline__ float bflo(unsigned w) { return __builtin_bit_cast(float, w << 16); }
__device__ __forceinline__ float bfhi(unsigned w) { return __builtin_bit_cast(float, w & 0xffff0000u); }
__device__ __forceinline__ int lane_id() { return (int)__builtin_amdgcn_mbcnt_hi(~0u, __builtin_amdgcn_mbcnt_lo(~0u, 0u)); }
#define dpp_f(old, src, ctrl, rmask) __builtin_bit_cast(float, __builtin_amdgcn_update_dpp(__builtin_bit_cast(int, (float)(old)), __builtin_bit_cast(int, (float)(src)), ctrl, rmask, 0xf, false))
__device__ __forceinline__ float sxor32(float v, int hi) { auto rr = __builtin_amdgcn_permlane32_swap(__builtin_bit_cast(unsigned, v), __builtin_bit_cast(unsigned, v), false, false);
    return __builtin_bit_cast(float, hi ? rr[0] : rr[1]); }
__device__ __forceinline__ float quad_sum(float v) { v += dpp_f(0.f, v, 0xB1, 0xf); v += dpp_f(0.f, v, 0x4E, 0xf); return v; }
__device__ __forceinline__ float oct_sum(float v, int lane) { v = quad_sum(v); const float dn = dpp_f(0.f, v, 0x114, 0xf), up = dpp_f(0.f, v, 0x104, 0xf); return v + ((lane & 4) ? dn : up); }
#define DPP_SCAN(v, OP, ID) do { v = OP(v, __builtin_bit_cast(float, __builtin_amdgcn_update_dpp(__builtin_bit_cast(int, ID), __builtin_bit_cast(int, v), 0x111, 0xf, 0xf, false))); \
    v = OP(v, __builtin_bit_cast(float, __builtin_amdgcn_update_dpp(__builtin_bit_cast(int, ID), __builtin_bit_cast(int, v), 0x112, 0xf, 0xf, false))); \
    v = OP(v, __builtin_bit_cast(float, __builtin_amdgcn_update_dpp(__builtin_bit_cast(int, ID), __builtin_bit_cast(int, v), 0x114, 0xf, 0xf, false))); \
    v = OP(v, __builtin_bit_cast(float, __builtin_amdgcn_update_dpp(__builtin_bit_cast(int, ID), __builtin_bit_cast(int, v), 0x118, 0xf, 0xf, false))); \
    v = OP(v, __builtin_bit_cast(float, __builtin_amdgcn_update_dpp(__builtin_bit_cast(int, ID), __builtin_bit_cast(int, v), 0x142, 0xa, 0xf, false))); \
    v = OP(v, __builtin_bit_cast(float, __builtin_amdgcn_update_dpp(__builtin_bit_cast(int, ID), __builtin_bit_cast(int, v), 0x143, 0xc, 0xf, false))); } while (0)
#define OP_ADD(a, b) ((a) + (b))
#define OP_MAX(a, b) fmaxf((a), (b))
__device__ __forceinline__ float wave_sum(float v) { DPP_SCAN(v, OP_ADD, 0.0f); return __builtin_bit_cast(float, __builtin_amdgcn_readlane(__builtin_bit_cast(int, v), 63)); }

namespace pg8 {
#define PG8_LAS __attribute__((address_space(3)))
typedef unsigned short bf16_t;
typedef unsigned u32x4 __attribute__((ext_vector_type(4)));
constexpr int BM = 256, BK = 64, HALF = 128, HTB = HALF * BK * 2, STAGE_BYTES = 8 * HTB, NXCD = 8, WGM = 8;

__host__ __device__ __forceinline__ int lds_byte(int r, int c) { const int st = (r >> 4) * 2 + (c >> 5), rr = r & 15, cc = c & 31, ob = rr * 64 + cc * 2; return st * 1024 + (ob ^ (((ob >> 9) & 1) << 5)); }
__host__ __device__ __forceinline__ void stage_rc(int b, int& R, int& C) { const int st = b / 1024, sb = b % 1024, swz = sb ^ (((sb >> 9) & 1) << 5); R = (st >> 1) * 16 + swz / 64; C = (st & 1) * 32 + (swz % 64) / 2; }
__host__ __device__ __forceinline__ int perm32(int rho) { const int n = rho >> 4, i = rho & 15; return 8 * (i >> 2) + 4 * n + (i & 3); }

struct Unit { int pm, pn, e, pml, nvalid; };

__device__ __forceinline__ void tile_decode(int wgid, int nM, int nN, int& pm, int& pn) {
    const int nig = WGM * nN, gid = wgid / nig, fm = gid * WGM, gsz = (nM - fm) < WGM ? (nM - fm) : WGM;
    pm = fm + ((wgid % nig) % gsz); pn = (wgid % nig) / gsz;
}
__device__ __forceinline__ int xcd_remap(int L, int nwg) { const int q = nwg / NXCD, r = nwg % NXCD, xcd = L % NXCD, off = L / NXCD; return (xcd < r ? xcd * (q + 1) : r * (q + 1) + (xcd - r) * q) + off; }

template <bool F8> struct DenseOrderT {
    static constexpr bool GATHER = false, FP8 = F8;
    const char* A; const char* B; int K, KT; int nM, nN, nwg, G, c;
    __device__ void init(const void* A_, const void* B_, int M, int N, int K_, int G_, int c_) { A = (const char*)A_; B = (const char*)B_; K = K_; KT = K_ / BK; nM = M / BM; nN = N / BM; nwg = nM * nN; G = G_; c = c_; }
    __device__ __forceinline__ bool next(int i, Unit& u) const {
        const long L = (long)i * G + c; if (L >= nwg) return false;
        const int wgid = xcd_remap((int)L, nwg); tile_decode(wgid, nM, nN, u.pm, u.pn); u.e = 0; u.pml = u.pm; u.nvalid = BM; return true;
    }
    __device__ __forceinline__ const char* a_ptr(const Unit& u) const { return A + (size_t)u.pm * ((size_t)BM * K * 2); }
    __device__ __forceinline__ const char* b_ptr(const Unit& u) const { return B + (size_t)u.pn * ((size_t)BM * K * 2); }
    __device__ __forceinline__ unsigned grow(const Unit&, int) const { return 0u; }
    __device__ __forceinline__ const unsigned* rptr(const Unit&, int) const { return nullptr; }
};
typedef DenseOrderT<false> DenseOrder;
struct InprojOrder {
    static constexpr bool GATHER = false, FP8 = false;
    const char* A; const char* B; int K, KT, nM, nN, G, c, i0, ni;
    __device__ void init(const void* A_, const void* B_, int M, int N, int K_, int G_, int c_, int i0_, int ni_) { A = (const char*)A_; B = (const char*)B_; K = K_; KT = K_ / BK; nM = M / BM; nN = N / BM; G = G_; c = c_; i0 = i0_; ni = ni_; }
    __device__ __forceinline__ bool next(int i, Unit& u) const {
        if (i >= ni) return false;
        const int off = (i0 + i) * (G >> 3) + (c >> 3); if (off >= WGM * nN) return false;
        tile_decode((c & 7) * WGM * nN + off, nM, nN, u.pm, u.pn); u.e = 0; u.pml = u.pm; u.nvalid = BM; return true;
    }
    __device__ __forceinline__ const char* a_ptr(const Unit& u) const { return A + (size_t)u.pm * ((size_t)BM * K * 2); }
    __device__ __forceinline__ const char* b_ptr(const Unit& u) const { return B + (size_t)u.pn * ((size_t)BM * K * 2); }
    __device__ __forceinline__ unsigned grow(const Unit&, int) const { return 0u; }
    __device__ __forceinline__ const unsigned* rptr(const Unit&, int) const { return nullptr; }
};
template <bool GATH> struct MoeOrder {
    static constexpr bool GATHER = GATH, FP8 = MOE_FP8 != 0;

    const char* A; const char* B; int K, KT; size_t bstride; int nN, nwg, G, c; const volatile LAS int* tab; const uint2* rinfo;
    __device__ void init(const void* A_, const void* B_, size_t bstride_, int N, int K_, int G_, int c_, const volatile LAS int* tab_, const uint2* rinfo_) {
        A = (const char*)A_; B = (const char*)B_; K = K_; KT = K_ / BK; bstride = bstride_; nN = N / BM; G = G_; c = c_; tab = tab_; rinfo = rinfo_; nwg = tab_[8] * nN; }
    __device__ __forceinline__ bool next(int i, Unit& u) const {
        const long L = (long)i * G + c; if (L >= nwg) return false;
        decode(xcd_remap((int)L, nwg), u); return true;
    }
    __device__ __forceinline__ void decode(const int wgid, Unit& u) const {
        int e = 0;
#pragma unroll
        for (int j = 1; j < 8; ++j) if (wgid >= tab[j] * nN) e = j;
        const int t0 = tab[e], nMe = tab[e + 1] - t0, cnt = tab[16 + e];
        int pml, pn;
        if (GATH) {
            const int ng = (nMe + WGM - 1) / WGM, bs = nMe / ng, ex = nMe - bs * ng, big = (bs + 1) * 4;
            int w = wgid - t0 * nN, fm, gsz;
            const int cb = w / (4 * nMe); w -= cb * 4 * nMe;
            if (w < ex * big) { const int g = w / big; w -= g * big; gsz = bs + 1; fm = g * (bs + 1); }
            else { w -= ex * big; const int g = w / (bs * 4); w -= g * bs * 4; gsz = bs; fm = ex * (bs + 1) + g * bs; }
            pml = fm + w % gsz; pn = 4 * cb + w / gsz;
        } else tile_decode(wgid - t0 * nN, nMe, nN, pml, pn);
        u.e = __builtin_amdgcn_readfirstlane(e); u.pml = __builtin_amdgcn_readfirstlane(pml); u.pn = __builtin_amdgcn_readfirstlane(pn); u.pm = __builtin_amdgcn_readfirstlane(t0 + pml);
        const int nv = cnt - pml * BM; u.nvalid = __builtin_amdgcn_readfirstlane(nv < BM ? nv : BM);
    }
    __device__ __forceinline__ const char* a_ptr(const Unit& u) const { return GATH ? A : A + (size_t)u.pm * ((size_t)BM * K * 2); }
    __device__ __forceinline__ const char* b_ptr(const Unit& u) const { return B + (size_t)u.e * bstride + (size_t)u.pn * ((size_t)BM * K * 2); }
    __device__ __forceinline__ const unsigned* rptr(const Unit& u, int r) const { const int rr = r < u.nvalid ? r : u.nvalid - 1; return (const unsigned*)(rinfo + (size_t)u.e * T + (size_t)u.pml * BM + rr); }
    __device__ __forceinline__ unsigned grow(const Unit& u, int r) const {
        const int rr = r < u.nvalid ? r : u.nvalid - 1;
        const unsigned ts = rinfo[(size_t)u.e * T + (size_t)u.pml * BM + rr].x;
        return (ts >> 1) * (unsigned)(K * 2);
    }
};

__device__ __forceinline__ const char* uni_ptr(const char* p) { const unsigned long long v = (unsigned long long)p; const unsigned lo = __builtin_amdgcn_readfirstlane((unsigned)v), hi = __builtin_amdgcn_readfirstlane((unsigned)(v >> 32));
    return (const char*)(((unsigned long long)hi << 32) | lo); }
__device__ __forceinline__ unsigned cvt_pk_bf16(float lo, float hi) { unsigned r; asm volatile("v_cvt_pk_bf16_f32 %0, %1, %2" : "=v"(r) : "v"(lo), "v"(hi)); return r; }

struct EpiProj {
    static constexpr bool PERM = true, RSLDS = true;
    bf16_t* O; const float* RS;
    __device__ __forceinline__ const float* rs_base(const Unit& u) const { return RS + (size_t)u.pm * BM; }
    __device__ __forceinline__ void operator()(const f32x4 (&acc)[2][2][4][2], const Unit& u, int wr, int wc, int fr, int fq, const PG8_LAS float* rsl) const {
        const int row0 = u.pm * BM + wr * 64 + fr, col0 = u.pn * BM + wc * 64 + 8 * fq;
        const float sc0 = (u.pn == 8 || u.pn == 9) ? QS_SCALE : 1.0f;
        float rsv[2][4];
#pragma unroll
        for (int ai = 0; ai < 2; ++ai)
#pragma unroll
            for (int m = 0; m < 4; ++m) rsv[ai][m] = rsl[wr * 64 + fr + ai * HALF + m * 16];
#pragma unroll
        for (int ai = 0; ai < 2; ++ai)
#pragma unroll
            for (int m = 0; m < 4; ++m) { bf16_t* rowp = O + (size_t)(row0 + ai * HALF + m * 16) * NPROJ + col0; const float sc = sc0 * rsv[ai][m];
#pragma unroll
                for (int bj = 0; bj < 2; ++bj) { const f32x4 v0 = acc[ai][bj][m][0] * sc, v1 = acc[ai][bj][m][1] * sc;
                    u32x4 w; w.x = cvt_pk_bf16(v0[0], v0[1]); w.y = cvt_pk_bf16(v0[2], v0[3]); w.z = cvt_pk_bf16(v1[0], v1[1]); w.w = cvt_pk_bf16(v1[2], v1[3]);
                    *(u32x4*)(rowp + bj * 32) = w; } }
    }
};
struct EpiResid {
    static constexpr bool PERM = false, RSLDS = false;
    const float* Hin; float* Hout;
    __device__ __forceinline__ void operator()(const f32x4 (&acc)[2][2][4][2], const Unit& u, int wr, int wc, int fr, int fq) const {
        const int row0 = u.pm * BM + wr * 64 + fr, col0 = u.pn * BM + wc * 32 + 4 * fq;
#pragma unroll
        for (int ai = 0; ai < 2; ++ai)
#pragma unroll
            for (int mh = 0; mh < 2; ++mh) {
                f32x4 hv[2][2][2];
#pragma unroll
                for (int m2 = 0; m2 < 2; ++m2) { const size_t off = (size_t)(row0 + ai * HALF + (2 * mh + m2) * 16) * DM + col0;
#pragma unroll
                    for (int bj = 0; bj < 2; ++bj)
#pragma unroll
                        for (int n = 0; n < 2; ++n) hv[m2][bj][n] = *(const f32x4*)(Hin + off + bj * HALF + n * 16); }
                asm volatile("" : "+v"(hv[0][0][0]), "+v"(hv[0][0][1]), "+v"(hv[0][1][0]), "+v"(hv[0][1][1]), "+v"(hv[1][0][0]), "+v"(hv[1][0][1]), "+v"(hv[1][1][0]), "+v"(hv[1][1][1]));
#pragma unroll
                for (int m2 = 0; m2 < 2; ++m2) { const size_t off = (size_t)(row0 + ai * HALF + (2 * mh + m2) * 16) * DM + col0;
#pragma unroll
                    for (int bj = 0; bj < 2; ++bj)
#pragma unroll
                        for (int n = 0; n < 2; ++n) *(f32x4*)(Hout + off + bj * HALF + n * 16) = hv[m2][bj][n] + acc[ai][bj][2 * mh + m2][n]; }
            }
    }
};
template <bool XIN> struct EpiResid16 {
    static constexpr bool PERM = true, RSLDS = false;
    const float* X; bf16_t* H; float sc;
    __device__ __forceinline__ void operator()(const f32x4 (&acc)[2][2][4][2], const Unit& u, int wr, int wc, int fr, int fq) const {
        const int row0 = u.pm * BM + wr * 64 + fr, col0 = u.pn * BM + wc * 64 + 8 * fq;
#pragma unroll
        for (int ai = 0; ai < 2; ++ai) {
            u32x4 hb[4][2];
#pragma unroll
            for (int m = 0; m < 4; ++m)
#pragma unroll
                for (int bj = 0; bj < 2; ++bj) hb[m][bj] = *(const u32x4*)(H + (size_t)(row0 + ai * HALF + m * 16) * DM + col0 + bj * 32);
            asm volatile("" : "+v"(hb[0][0]), "+v"(hb[0][1]), "+v"(hb[1][0]), "+v"(hb[1][1]), "+v"(hb[2][0]), "+v"(hb[2][1]), "+v"(hb[3][0]), "+v"(hb[3][1]));
#pragma unroll
            for (int m = 0; m < 4; ++m)
#pragma unroll
                for (int bj = 0; bj < 2; ++bj) { const u32x4 b = hb[m][bj];
                    const f32x4 h0 = (f32x4){__builtin_bit_cast(float, b.x << 16), __builtin_bit_cast(float, b.x & 0xffff0000u), __builtin_bit_cast(float, b.y << 16), __builtin_bit_cast(float, b.y & 0xffff0000u)};
                    const f32x4 h1 = (f32x4){__builtin_bit_cast(float, b.z << 16), __builtin_bit_cast(float, b.z & 0xffff0000u), __builtin_bit_cast(float, b.w << 16), __builtin_bit_cast(float, b.w & 0xffff0000u)};
                    const f32x4 r0 = h0 + acc[ai][bj][m][0] * sc, r1 = h1 + acc[ai][bj][m][1] * sc;
                    u32x4 w; w.x = cvt_pk_bf16(r0[0], r0[1]); w.y = cvt_pk_bf16(r0[2], r0[3]); w.z = cvt_pk_bf16(r1[0], r1[1]); w.w = cvt_pk_bf16(r1[2], r1[3]);
                    *(u32x4*)(H + (size_t)(row0 + ai * HALF + m * 16) * DM + col0 + bj * 32) = w; }
        }
    }
};
__device__ __forceinline__ float silu_mul(float g, float u) { return g * u * __builtin_amdgcn_rcpf(1.0f + __builtin_amdgcn_exp2f(-g * LOG2E)); }
struct EpiSwiglu {
    static constexpr bool PERM = true, RSLDS = true;
    bf16_t* O; int ld; const float* RS; const float* RSI;
    __device__ __forceinline__ const float* rs_base(const Unit& u) const { return RSI ? RSI + (size_t)u.e * T + (size_t)u.pml * BM : RS + (size_t)u.pm * BM; }
    __device__ __forceinline__ void operator()(const f32x4 (&acc)[2][2][4][2], const Unit& u, int wr, int wc, int fr, int fq, const PG8_LAS float* rsl) const {
        const int row0 = u.pm * BM + wr * 64 + fr, col0 = u.pn * HALF + wc * 32 + 8 * fq;
        float rsv[2][4];
#pragma unroll
        for (int ai = 0; ai < 2; ++ai)
#pragma unroll
            for (int m = 0; m < 4; ++m) rsv[ai][m] = rsl[wr * 64 + fr + ai * HALF + m * 16];
#pragma unroll
        for (int ai = 0; ai < 2; ++ai)
#pragma unroll
            for (int m = 0; m < 4; ++m) { bf16_t* rowp = O + (size_t)(row0 + ai * HALF + m * 16) * ld + col0; const float rs = rsv[ai][m];
                const f32x4 g0 = acc[ai][0][m][0] * rs, g1 = acc[ai][0][m][1] * rs, u0 = acc[ai][1][m][0] * rs, u1 = acc[ai][1][m][1] * rs;
                u32x4 w; w.x = cvt_pk_bf16(silu_mul(g0[0], u0[0]), silu_mul(g0[1], u0[1])); w.y = cvt_pk_bf16(silu_mul(g0[2], u0[2]), silu_mul(g0[3], u0[3]));
                w.z = cvt_pk_bf16(silu_mul(g1[0], u1[0]), silu_mul(g1[1], u1[1])); w.w = cvt_pk_bf16(silu_mul(g1[2], u1[2]), silu_mul(g1[3], u1[3]));
                *(u32x4*)rowp = w; }
    }
};
template <bool RSL> struct EpiSwiglu8T {
    static constexpr bool PERM = true, RSLDS = RSL;
    unsigned char* O; int ld; float sc; const float* RS;
    __device__ __forceinline__ const float* rs_base(const Unit& u) const { return RS + (size_t)u.pm * BM; }
    __device__ __forceinline__ void operator()(const f32x4 (&acc)[2][2][4][2], const Unit& u, int wr, int wc, int fr, int fq) const { body(acc, u, wr, wc, fr, fq, nullptr); }
    __device__ __forceinline__ void operator()(const f32x4 (&acc)[2][2][4][2], const Unit& u, int wr, int wc, int fr, int fq, const PG8_LAS float* rsl) const { body(acc, u, wr, wc, fr, fq, rsl); }
    __device__ __forceinline__ void body(const f32x4 (&acc)[2][2][4][2], const Unit& u, int wr, int wc, int fr, int fq, const PG8_LAS float* rsl) const {
        const int row0 = u.pm * BM + wr * 64 + fr, col0 = u.pn * HALF + wc * 32 + 8 * fq;
#pragma unroll
        for (int ai = 0; ai < 2; ++ai)
#pragma unroll
            for (int m = 0; m < 4; ++m) { unsigned char* rowp = O + (size_t)(row0 + ai * HALF + m * 16) * ld + col0;
                const float sr = RSL ? rsl[wr * 64 + fr + ai * HALF + m * 16] : sc;
                const float cg = -sr * LOG2E, cu = sr * sr * F8_HID;
                float h[8];
                const f32x2 cg2 = {cg, cg}, cu2 = {cu, cu}, one2 = {1.0f, 1.0f};
                const float icu = 1.0f / cu, lcu = __builtin_log2f(icu); const f32x2 icu2 = {icu, icu}, lcu2 = {lcu, lcu};
#pragma unroll
                for (int q = 0; q < 4; ++q) {
                    const f32x4 G = acc[ai][0][m][q >> 1], U = acc[ai][1][m][q >> 1];
                    const f32x2 ag = (q & 1) ? (f32x2){G[2], G[3]} : (f32x2){G[0], G[1]}, au = (q & 1) ? (f32x2){U[2], U[3]} : (f32x2){U[0], U[1]};
                    f32x2 pr;
                    if constexpr (!RSL) {
                        const f32x2 t = ag * cg2 + lcu2;
                        const f32x2 d = (f32x2){__builtin_amdgcn_exp2f(t.x), __builtin_amdgcn_exp2f(t.y)} + icu2;
                        const f32x2 r = (f32x2){__builtin_amdgcn_rcpf(d.x), __builtin_amdgcn_rcpf(d.y)};
                        pr = (ag * au) * r;
                    } else {
                    const f32x2 t = ag * cg2;
                    const f32x2 d = (f32x2){__builtin_amdgcn_exp2f(t.x), __builtin_amdgcn_exp2f(t.y)} + one2;
                    const f32x2 r = (f32x2){__builtin_amdgcn_rcpf(d.x), __builtin_amdgcn_rcpf(d.y)};
                    pr = (ag * au) * (r * cu2); }
                    h[2 * q] = __builtin_amdgcn_fmed3f(pr.x, -F8_MAX, F8_MAX); h[2 * q + 1] = __builtin_amdgcn_fmed3f(pr.y, -F8_MAX, F8_MAX); }
                typedef unsigned u32x2_ __attribute__((ext_vector_type(2)));
                *(u32x2_*)rowp = (u32x2_){pk4_f8(h[0], h[1], h[2], h[3]), pk4_f8(h[4], h[5], h[6], h[7])}; }
    }
};
typedef EpiSwiglu8T<false> EpiSwiglu8;
struct EpiScatter {
    static constexpr bool PERM = true, RSLDS = false;
    bf16_t* O2; const uint2* rinfo; float sc;
    __device__ __forceinline__ void operator()(const f32x4 (&acc)[2][2][4][2], const Unit& u, int wr, int wc, int fr, int fq) const {
        const int col0 = u.pn * BM + wc * 64 + 8 * fq;
        uint2 inf[2][4];
#pragma unroll
        for (int ai = 0; ai < 2; ++ai)
#pragma unroll
            for (int m = 0; m < 4; ++m) { const int rl = ai * HALF + wr * 64 + m * 16 + fr; const int rc = rl < u.nvalid ? rl : u.nvalid - 1;
                inf[ai][m] = rinfo[(size_t)u.e * T + (size_t)u.pml * BM + rc]; }
#pragma unroll
        for (int ai = 0; ai < 2; ++ai)
#pragma unroll
            for (int m = 0; m < 4; ++m) asm volatile("" : "+v"(inf[ai][m].x), "+v"(inf[ai][m].y));
#pragma unroll
        for (int ai = 0; ai < 2; ++ai)
#pragma unroll
            for (int m = 0; m < 4; ++m) { const int rl = ai * HALF + wr * 64 + m * 16 + fr;
                if (rl < u.nvalid) { const float wgt = __builtin_bit_cast(float, inf[ai][m].y) * sc;
                    bf16_t* rowp = O2 + ((size_t)(inf[ai][m].x & 1u) * T + (size_t)(inf[ai][m].x >> 1)) * DM + col0;
#pragma unroll
                    for (int bj = 0; bj < 2; ++bj) { const f32x4 v0 = acc[ai][bj][m][0] * wgt, v1 = acc[ai][bj][m][1] * wgt;
                        u32x4 w; w.x = cvt_pk_bf16(v0[0], v0[1]); w.y = cvt_pk_bf16(v0[2], v0[3]); w.z = cvt_pk_bf16(v1[0], v1[1]); w.w = cvt_pk_bf16(v1[2], v1[3]);
                        *(u32x4*)(rowp + bj * 32) = w; } } }
    }
};

struct MoeTailOrder {
    static constexpr bool GATHER = false, FP8 = MOE_FP8 != 0;
    MoeOrder<false> base; const char* A; const char* B; int K, KT, slice, wgid; bool have;
    __device__ void init(const MoeOrder<false>& b, int nmain, int rem, int ks, int c) { base = b; A = b.A; B = b.B; K = b.K; KT = b.KT / ks; have = c < rem * ks; slice = c / (rem > 0 ? rem : 1); wgid = nmain + c % (rem > 0 ? rem : 1); }
    __device__ __forceinline__ bool next(int i, Unit& u) const { if (i != 0 || !have) return false; base.decode(wgid, u); return true; }
    __device__ __forceinline__ const char* a_ptr(const Unit& u) const { return base.a_ptr(u) + (size_t)slice * KT * (BK * 2); }
    __device__ __forceinline__ const char* b_ptr(const Unit& u) const { return base.b_ptr(u) + (size_t)slice * KT * (BK * 2); }
    __device__ __forceinline__ unsigned grow(const Unit&, int) const { return 0u; }
    __device__ __forceinline__ const unsigned* rptr(const Unit&, int) const { return nullptr; }
};
struct EpiPartial {
    static constexpr bool PERM = true, RSLDS = false;
    float* P;
    __device__ __forceinline__ void operator()(const f32x4 (&acc)[2][2][4][2], const Unit&, int wr, int wc, int fr, int fq) const {
        const int tid = (wr * 4 + wc) * 64 + fq * 16 + fr;
#pragma unroll
        for (int ai = 0; ai < 2; ++ai)
#pragma unroll
            for (int bj = 0; bj < 2; ++bj)
#pragma unroll
                for (int m = 0; m < 4; ++m)
#pragma unroll
                    for (int n = 0; n < 2; ++n) *(f32x4*)(P + ((size_t)((((ai * 2 + bj) * 4 + m) * 2 + n) * 512 + tid)) * 4) = acc[ai][bj][m][n];
    }
};

template <class Epi, class Sched, bool ALIGN_EPI>
__device__ __forceinline__ void gemm_phase(PG8_LAS unsigned char* lds, const Sched& S, const Epi& E, const int tid) {
    const int wid = __builtin_amdgcn_readfirstlane(tid >> 6), lane = tid & 63, wr = wid >> 2, wc = wid & 3, fr = lane & 15, fq = lane >> 4;
    const int K = S.K, nt = S.KT;
    constexpr bool GA = Sched::GATHER;
    unsigned voffA[2], voffB[2]; int RA[2], CA[2];
#pragma unroll
    for (int i = 0; i < 2; ++i) { int R, C; stage_rc(tid * 16 + i * 8192, R, C); const int Rb = Epi::PERM ? ((R >> 5) * 64 + perm32(R & 31)) : R;
        RA[i] = R; CA[i] = C; voffA[i] = GA ? (unsigned)(C * 2) : (unsigned)(R * K + C) * 2u; voffB[i] = (unsigned)(Rb * K + C) * 2u; }
    const size_t kstep = (size_t)(BK * 2);
    const size_t hstep = (size_t)HALF * K * 2;
    const size_t hstepB = Epi::PERM ? (size_t)32 * K * 2 : hstep;
    const unsigned ldsw = (unsigned)wid * 1024u;
    const int aoff = lds_byte(wr * 64 + fr, fq * 8), boff = lds_byte(wc * 32 + fr, fq * 8);
#define PG8_SA(b, h) (((b) * 2 + (h)) * HTB)
#define PG8_SB(b, h) ((4 + (b) * 2 + (h)) * HTB)
#define PG8_STAGE(bufoff, gbase, voff) do { const char* _g = (const char*)(gbase); asm volatile("" : "+s"(_g)); _Pragma("unroll") for (int _i = 0; _i < 2; ++_i) { unsigned _v = (voff)[_i]; asm volatile("" : "+v"(_v)); \
        __builtin_amdgcn_global_load_lds((const unsigned*)(_g + _v), (PG8_LAS unsigned*)(lds + (bufoff) + ldsw + _i * 8192), 16, 0, 0); } } while (0)
#define PG8_STAGE_A(bufoff, kb, h, NX) do { if constexpr (GA) { const char* _g = (const char*)(kb); asm volatile("" : "+s"(_g)); _Pragma("unroll") for (int _i = 0; _i < 2; ++_i) { unsigned _o = ((NX) ? gnx[h][_i] : gcu[h][_i]) + voffA[_i]; asm volatile("" : "+v"(_o)); \
        __builtin_amdgcn_global_load_lds((const unsigned*)(_g + _o), (PG8_LAS unsigned*)(lds + (bufoff) + ldsw + _i * 8192), 16, 0, 0); } } \
        else { PG8_STAGE(bufoff, (kb) + (h) * hstep, voffA); } } while (0)
#define PG8_LDA(dst, b, h) do { _Pragma("unroll") for (int m = 0; m < 4; ++m) _Pragma("unroll") for (int k = 0; k < 2; ++k) dst[m][k] = *(const PG8_LAS bf16x8*)(lds + PG8_SA(b, h) + aoff + m * 2048 + k * 1024); } while (0)
#define PG8_LDB(dst, b, h) do { _Pragma("unroll") for (int n = 0; n < 2; ++n) _Pragma("unroll") for (int k = 0; k < 2; ++k) dst[n][k] = *(const PG8_LAS bf16x8*)(lds + PG8_SB(b, h) + boff + n * 2048 + k * 1024); } while (0)
#define PG8_CAT(F) __builtin_shufflevector(__builtin_bit_cast(i32x4, F[0]), __builtin_bit_cast(i32x4, F[1]), 0, 1, 2, 3, 4, 5, 6, 7)
#define PG8_MMAZ(ai, bj, At, Bt, Z) do { if (Sched::FP8 && (Z)) { __builtin_amdgcn_s_setprio(1); _Pragma("unroll") for (int m = 0; m < 4; ++m) _Pragma("unroll") for (int n = 0; n < 2; ++n) \
        { const i32x8 _b = PG8_CAT(Bt[n]), _a = PG8_CAT(At[m]); asm volatile("v_mfma_f32_16x16x128_f8f6f4 %0, %1, %2, 0" : "+v"(acc[ai][bj][m][n]) : "v"(_b), "v"(_a)); } __builtin_amdgcn_s_setprio(0); } else PG8_MMA(ai, bj, At, Bt); } while (0)
#define PG8_MMA(ai, bj, At, Bt) do { __builtin_amdgcn_s_setprio(1); if constexpr (Sched::FP8) { _Pragma("unroll") for (int m = 0; m < 4; ++m) _Pragma("unroll") for (int n = 0; n < 2; ++n) \
        { const i32x8 _b = PG8_CAT(Bt[n]), _a = PG8_CAT(At[m]); asm volatile("v_mfma_f32_16x16x128_f8f6f4 %0, %1, %2, %0" : "+v"(acc[ai][bj][m][n]) : "v"(_b), "v"(_a)); } } \
        else { _Pragma("unroll") for (int m = 0; m < 4; ++m) _Pragma("unroll") for (int n = 0; n < 2; ++n) _Pragma("unroll") for (int k = 0; k < 2; ++k) \
        acc[ai][bj][m][n] = __builtin_amdgcn_mfma_f32_16x16x32_bf16(Bt[n][k], At[m][k], acc[ai][bj][m][n], 0, 0, 0); } __builtin_amdgcn_s_setprio(0); } while (0)
#define PG8_WAIT_V(n) asm volatile("s_waitcnt vmcnt(" #n ")" ::: "memory")
#define PG8_WAIT_L(n) asm volatile("s_waitcnt lgkmcnt(" #n ")" ::: "memory")
#define PG8_BAR __builtin_amdgcn_s_barrier()
#define PG8_SCHED __builtin_amdgcn_sched_barrier(0)
    Unit cur, nxt; int ui = 0;
    if (!S.next(0, cur)) return;
#define PG8_RS_STAGE(u_, par_) do { if constexpr (Epi::RSLDS) { if (wid < 4) __builtin_amdgcn_global_load_lds((const unsigned*)(E.rs_base(u_) + wid * 64 + lane), (PG8_LAS unsigned*)(lds + STAGE_BYTES + (par_) * 1024 + wid * 256), 4, 0, 0); } } while (0)
    PG8_RS_STAGE(cur, 0);
    unsigned gcu[2][2] = {{0u, 0u}, {0u, 0u}}, gnx[2][2] = {{0u, 0u}, {0u, 0u}};
    if constexpr (GA) {
#pragma unroll
        for (int h = 0; h < 2; ++h)
#pragma unroll
            for (int i = 0; i < 2; ++i) gcu[h][i] = S.grow(cur, h * HALF + RA[i]);
    }
    f32x4 acc[2][2][4][2];
#pragma unroll
    for (int a = 0; a < 2; ++a)
#pragma unroll
        for (int b = 0; b < 2; ++b)
#pragma unroll
            for (int m = 0; m < 4; ++m)
#pragma unroll
                for (int n = 0; n < 2; ++n) acc[a][b][m][n] = (f32x4){0.f, 0.f, 0.f, 0.f};
    bf16x8 At[4][2], B0[2][2], B1[2][2];
    const char* cA = uni_ptr(S.a_ptr(cur)); const char* cB = uni_ptr(S.b_ptr(cur));
    PG8_STAGE(PG8_SB(0, 0), cB, voffB); PG8_STAGE(PG8_SB(0, 1), cB + hstepB, voffB); PG8_STAGE_A(PG8_SA(0, 0), cA, 0, false); PG8_STAGE_A(PG8_SA(0, 1), cA, 1, false);
    if (wr == 1) PG8_BAR;
    PG8_WAIT_V(2); PG8_BAR;
    PG8_STAGE(PG8_SB(1, 0), cB + kstep, voffB); PG8_STAGE_A(PG8_SA(1, 0), cA + kstep, 0, false); PG8_STAGE(PG8_SB(1, 1), cB + hstepB + kstep, voffB);
    PG8_WAIT_V(6); PG8_BAR;
    for (;;) {
        const bool has_next = S.next(ui + 1, nxt);
        const char* nA = uni_ptr(has_next ? S.a_ptr(nxt) : cA); const char* nB = uni_ptr(has_next ? S.b_ptr(nxt) : cB);
        unsigned raw[2][2] = {{0u, 0u}, {0u, 0u}};
        if constexpr (GA) {
            if (has_next) {
#pragma unroll
                for (int h = 0; h < 2; ++h)
#pragma unroll
                    for (int i = 0; i < 2; ++i) { const unsigned* rp = S.rptr(nxt, h * HALF + RA[i]); asm volatile("global_load_dword %0, %1, off" : "=v"(raw[h][i]) : "v"(rp) : "memory"); }
            }
        }
        for (int t = 0; t < nt; t += 2) {
            const bool last = (t == nt - 2);
            if constexpr (GA) { if (last) { asm volatile("" : "+v"(raw[0][0]), "+v"(raw[0][1]), "+v"(raw[1][0]), "+v"(raw[1][1]));
#pragma unroll
                for (int h = 0; h < 2; ++h)
#pragma unroll
                    for (int i = 0; i < 2; ++i) gnx[h][i] = has_next ? (raw[h][i] >> 1) * (unsigned)(K * 2) : gcu[h][i]; } }
            const char* a1 = cA + (size_t)(t + 1) * kstep;
            const char* a2 = last ? nA : cA + (size_t)(t + 2) * kstep; const char* b2 = last ? nB : cB + (size_t)(t + 2) * kstep;
            const char* a3 = a2 + kstep; const char* b3 = b2 + kstep;
            PG8_LDB(B0, 0, 0); PG8_LDB(B1, 0, 1); PG8_SCHED; PG8_LDA(At, 0, 0); PG8_STAGE_A(PG8_SA(1, 1), a1, 1, false);
            PG8_WAIT_V(8); PG8_WAIT_L(0); PG8_BAR; PG8_MMAZ(0, 0, At, B0, t == 0); PG8_MMAZ(0, 1, At, B1, t == 0); PG8_BAR; PG8_SCHED;
            PG8_LDA(At, 0, 1); PG8_STAGE(PG8_SB(0, 0), b2, voffB); PG8_STAGE(PG8_SB(0, 1), b2 + hstepB, voffB); PG8_STAGE_A(PG8_SA(0, 0), a2, 0, last);
            PG8_WAIT_V(8); PG8_WAIT_L(0); PG8_BAR; PG8_MMAZ(1, 0, At, B0, t == 0); PG8_MMAZ(1, 1, At, B1, t == 0); PG8_BAR; PG8_SCHED;
            PG8_LDB(B0, 1, 0); PG8_LDB(B1, 1, 1); PG8_SCHED; PG8_LDA(At, 1, 0); PG8_STAGE_A(PG8_SA(0, 1), a2, 1, last);
            PG8_WAIT_V(8); PG8_WAIT_L(0); PG8_BAR; PG8_MMA(0, 0, At, B0); PG8_MMA(0, 1, At, B1); PG8_BAR; PG8_SCHED;
            PG8_LDA(At, 1, 1); PG8_STAGE(PG8_SB(1, 0), b3, voffB); PG8_STAGE(PG8_SB(1, 1), b3 + hstepB, voffB); PG8_STAGE_A(PG8_SA(1, 0), a3, 0, last);
            PG8_WAIT_V(8); PG8_WAIT_L(0); PG8_BAR; PG8_MMA(1, 0, At, B0); PG8_MMA(1, 1, At, B1); PG8_BAR; PG8_SCHED;
        }
        if constexpr (Sched::FP8) asm volatile("s_nop 15\n\ts_nop 15" ::: "memory");
        if constexpr (ALIGN_EPI) { if (wr == 0) PG8_BAR; }
        if constexpr (Epi::RSLDS) E(acc, cur, wr, wc, fr, fq, (const PG8_LAS float*)(lds + STAGE_BYTES + (ui & 1) * 1024)); else E(acc, cur, wr, wc, fr, fq);
        if (!has_next) break;
        if constexpr (!Sched::FP8) {
#pragma unroll
        for (int a = 0; a < 2; ++a)
#pragma unroll
            for (int b = 0; b < 2; ++b)
#pragma unroll
                for (int m = 0; m < 4; ++m)
#pragma unroll
                    for (int n = 0; n < 2; ++n) acc[a][b][m][n] = (f32x4){0.f, 0.f, 0.f, 0.f};
        }
        cur = nxt; cA = nA; cB = nB; ++ui;
        PG8_RS_STAGE(cur, ui & 1);
        if constexpr (GA) {
#pragma unroll
            for (int h = 0; h < 2; ++h)
#pragma unroll
                for (int i = 0; i < 2; ++i) gcu[h][i] = gnx[h][i];
        }
        if constexpr (ALIGN_EPI) { if (wr == 1) PG8_BAR; }
    }
    PG8_WAIT_V(0);
    if constexpr (!ALIGN_EPI) { if (wr == 0) PG8_BAR; }
    PG8_BAR;
#undef PG8_RS_STAGE
#undef PG8_SA
#undef PG8_SB
#undef PG8_STAGE
#undef PG8_STAGE_A
#undef PG8_LDA
#undef PG8_LDB
#undef PG8_MMA
#undef PG8_MMAZ
#undef PG8_CAT
#undef PG8_WAIT_V
#undef PG8_WAIT_L
#undef PG8_BAR
#undef PG8_SCHED
}
}

#define XB_TMO      128
#define XB_XCNT(j)  (256  + 64 * (j))
#define XB_XSUB(j)  (1280 + 64 * (j))
#define XB_XGEN(j)  (2304 + 64 * (j))
#define XB_TOP      3328
#define XB_TOPGEN   3392
#define XCD_BAR_WORDS 3456
#define XB_SPIN_CAP (1u << 20)

__device__ __forceinline__ unsigned xb_ld(unsigned* p)              { return __hip_atomic_load(p, __ATOMIC_RELAXED, __HIP_MEMORY_SCOPE_AGENT); }
__device__ __forceinline__ unsigned xb_add(unsigned* p, unsigned v) { return __hip_atomic_fetch_add(p, v, __ATOMIC_RELAXED, __HIP_MEMORY_SCOPE_AGENT); }
__device__ __forceinline__ unsigned xb_xcc_id() { return (unsigned)__builtin_amdgcn_s_getreg((3 << 11) | 20) & 0xFu; }
#define XB_SPIN(cond, bar) do { unsigned _sp = 0; while (cond) { __builtin_amdgcn_s_sleep(1); \
    if ((++_sp & 255u) == 0u) { if (xb_ld(&(bar)[XB_TMO])) break; if (_sp > XB_SPIN_CAP) { atomicAdd(&(bar)[XB_TMO], 1u); break; } } } } while (0)

struct XcdBarrier { unsigned* bar; unsigned x; volatile LAS unsigned* st; };

__device__ __forceinline__ XcdBarrier xcd_barrier_post(unsigned* bar, volatile LAS unsigned* st) {
    XcdBarrier b; b.bar = bar; b.x = xb_xcc_id(); b.st = st;
    if (threadIdx.x == 0) (void)xb_add(&bar[XB_XCNT(b.x)], 1u);
    return b;
}
__device__ __forceinline__ void xcd_barrier_complete(unsigned* bar, unsigned x, unsigned& nloc, unsigned& nx) {
    const unsigned G = gridDim.x * gridDim.y * gridDim.z;
    unsigned sum, cnt, mine, sp = 0u;
    for (;;) {
        sum = 0u; cnt = 0u; mine = 0u;
#pragma unroll
        for (unsigned j = 0; j < 16; ++j) { const unsigned c = xb_ld(&bar[XB_XCNT(j)]); sum += c; cnt += (c > 0u) ? 1u : 0u; mine = (j == x) ? c : mine; }
        if (sum == G) break;
        __builtin_amdgcn_s_sleep(1);
        if ((++sp & 255u) == 0u) { if (xb_ld(&bar[XB_TMO])) break; if (sp > XB_SPIN_CAP) { atomicAdd(&bar[XB_TMO], 1u); break; } }
    }
    nloc = mine > 0u ? mine : 1u; nx = cnt > 0u ? cnt : 1u;
}
__device__ __forceinline__ void xcd_barrier(const XcdBarrier& b, const int wave_s) {
    asm volatile("s_waitcnt vmcnt(0)" ::: "memory");
    __syncthreads();
    if (wave_s == 0 && lane_id() == 0) {
        unsigned* bar = b.bar;
        __builtin_amdgcn_s_waitcnt(0);
        unsigned nloc = b.st[0], nx = b.st[1];
        if (nloc == 0u) { xcd_barrier_complete(bar, b.x, nloc, nx); b.st[0] = nloc; b.st[1] = nx; }
        const unsigned old = xb_add(&bar[XB_XSUB(b.x)], 1u);
        const unsigned gen = old / nloc;
        if (old + 1u == (gen + 1u) * nloc) {
            __builtin_amdgcn_fence(__ATOMIC_RELEASE, "agent");
            asm volatile("s_waitcnt vmcnt(0)" ::: "memory");
            const unsigned og = xb_add(&bar[XB_TOP], 1u);
            const unsigned tg = og / nx;
            if (og + 1u == (tg + 1u) * nx) xb_add(&bar[XB_TOPGEN], 1u);
            else XB_SPIN(xb_ld(&bar[XB_TOPGEN]) == tg, bar);
            __builtin_amdgcn_fence(__ATOMIC_ACQUIRE, "agent");
            xb_add(&bar[XB_XGEN(b.x)], 1u);
            asm volatile("s_waitcnt vmcnt(0)" ::: "memory");
        } else {
            XB_SPIN(xb_ld(&bar[XB_XGEN(b.x)]) == gen, bar);
            __builtin_amdgcn_fence(__ATOMIC_ACQUIRE, "agent");
            asm volatile("s_waitcnt vmcnt(0)" ::: "memory");
        }
    }
    __syncthreads();
}

#define GB_XCNT(x) (64 * (x))
#define GB_SUB(x)  (1024 + 64 * (x))
#define GB_GEN(x)  (2048 + 64 * (x))
#define GB_TOP     3072
#define GB_ASUB(x) (3136 + 32 * (x))
#define GB_ATOP    3712
__device__ __forceinline__ void group_members(gu32* gb, volatile LAS unsigned* st, const unsigned x, unsigned& nloc, unsigned& nx) {
    nloc = st[1]; nx = st[2];
    if (nloc == 0u) { nx = 0u;
        for (unsigned q = 0; q < 16; ++q) { const unsigned c = __hip_atomic_load(gb + GB_XCNT(q), __ATOMIC_RELAXED, __HIP_MEMORY_SCOPE_AGENT); nx += c > 0u ? 1u : 0u; nloc = q == x ? c : nloc; }
        nloc = nloc > 0u ? nloc : 1u; st[1] = nloc; st[2] = nx; }
}
__device__ __forceinline__ void group_arrive(gu32* gb, volatile LAS unsigned* st, const unsigned x, const unsigned r) {
    unsigned nloc, nx; group_members(gb, st, x, nloc, nx);
    const unsigned old = __hip_atomic_fetch_add(gb + GB_ASUB(x), 1u, __ATOMIC_RELAXED, __HIP_MEMORY_SCOPE_AGENT);
    if (old + 1u == r * nloc) { __builtin_amdgcn_fence(__ATOMIC_RELEASE, "agent"); asm volatile("s_waitcnt vmcnt(0)" ::: "memory");
        (void)__hip_atomic_fetch_add(gb + GB_ATOP, 1u, __ATOMIC_RELAXED, __HIP_MEMORY_SCOPE_AGENT); }
}
__device__ __forceinline__ void group_wait(gu32* gb, volatile LAS unsigned* st, const unsigned x, const unsigned r) {
    unsigned nloc, nx; group_members(gb, st, x, nloc, nx);
    unsigned sp = 0u;
    while (__hip_atomic_load(gb + GB_ATOP, __ATOMIC_RELAXED, __HIP_MEMORY_SCOPE_AGENT) < r * nx) { __builtin_amdgcn_s_sleep(1); if (++sp > (1u << 22)) break; }
    __builtin_amdgcn_fence(__ATOMIC_ACQUIRE, "agent");
}
__device__ __forceinline__ void group_barrier(gu32* gb, const int wave_s, volatile LAS unsigned* st, const unsigned x) {
    asm volatile("s_waitcnt vmcnt(0)" ::: "memory");
    __syncthreads();
    if (wave_s == 0 && lane_id() == 0) {
        unsigned nloc, nx; group_members(gb, st, x, nloc, nx);
        const unsigned r = st[0] + 1u; st[0] = r;
        const unsigned old = __hip_atomic_fetch_add(gb + GB_SUB(x), 1u, __ATOMIC_RELAXED, __HIP_MEMORY_SCOPE_AGENT);
        unsigned sp = 0u;
        if (old + 1u == r * nloc) {
            __builtin_amdgcn_fence(__ATOMIC_RELEASE, "agent");
            asm volatile("s_waitcnt vmcnt(0)" ::: "memory");
            (void)__hip_atomic_fetch_add(gb + GB_TOP, 1u, __ATOMIC_RELAXED, __HIP_MEMORY_SCOPE_AGENT);
            while (__hip_atomic_load(gb + GB_TOP, __ATOMIC_RELAXED, __HIP_MEMORY_SCOPE_AGENT) < r * nx) { __builtin_amdgcn_s_sleep(1); if (++sp > (1u << 22)) break; }
            __builtin_amdgcn_fence(__ATOMIC_ACQUIRE, "agent");
            (void)__hip_atomic_fetch_add(gb + GB_GEN(x), 1u, __ATOMIC_RELAXED, __HIP_MEMORY_SCOPE_AGENT);
        } else {
            while (__hip_atomic_load(gb + GB_GEN(x), __ATOMIC_RELAXED, __HIP_MEMORY_SCOPE_AGENT) < r) { __builtin_amdgcn_s_sleep(1); if (++sp > (1u << 22)) break; }
            __builtin_amdgcn_fence(__ATOMIC_ACQUIRE, "agent");
        }
    }
    __syncthreads();
}

struct Args {
    const float* x; const float* norm_mix_g; const float* w_in; const float* b_igate; const float* b_fgate; const float* conv_w; const float* conv_b;
    const float* g_mlstm; const float* g_sb; const float* w_out; const float* norm_ffn_g; const float* ffn_w_gate; const float* ffn_w_up; const float* ffn_w_down;
    const float* w_router; const float* moe_w_gate; const float* moe_w_up; const float* moe_w_down; const float* norm_final_g;
    float* out; unsigned char* ws; int ph_lo, ph_hi;
};
struct Frame {
    LAS unsigned char* lds; volatile LAS unsigned* MISC; gu32* ctl; int tid, lane, wave, G, bid;
};

template <bool F8>
__device__ __forceinline__ void tr_item(const float* src, int ldw, unsigned char* dst, int ldk, LAS float* scr, int lane, const float* gk, const float wsc) {
    const int c = lane & 7;
    f32x4 ga = {1.f, 1.f, 1.f, 1.f}, gb = ga;
    if (gk) { ga = *(const GAS f32x4*)(gk + 8 * c); gb = *(const GAS f32x4*)(gk + 8 * c + 4); }
    {
        const int r8 = lane >> 3, c4 = 4 * (lane & 7);
        f32x4 v[8];
#pragma unroll
        for (int i = 0; i < 8; ++i) v[i] = *(const GAS f32x4*)(src + (size_t)(8 * i + r8) * ldw + c4);
#pragma unroll
        for (int i = 0; i < 8; ++i) { LAS float* d = scr + (8 * i + r8) * 33 + c4; d[0] = v[i].x; d[1] = v[i].y; d[2] = v[i].z; d[3] = v[i].w; }
    }
    LDS_WAIT(); asm volatile("" ::: "memory");
    if constexpr (F8) { ga = ga * wsc; gb = gb * wsc;
#pragma unroll
        for (int j = 0; j < 4; ++j) { const int n = (lane >> 3) + 8 * j; const LAS float* s = scr + (8 * c) * 33 + n;
            v2u o; o.x = pk4_f8(s[0 * 33] * ga.x, s[1 * 33] * ga.y, s[2 * 33] * ga.z, s[3 * 33] * ga.w); o.y = pk4_f8(s[4 * 33] * gb.x, s[5 * 33] * gb.y, s[6 * 33] * gb.z, s[7 * 33] * gb.w);
            *(GAS v2u*)(dst + (size_t)n * ldk + 8 * c) = o; }
    } else {
#pragma unroll
    for (int j = 0; j < 4; ++j) { const int n = (lane >> 3) + 8 * j; const LAS float* s = scr + (8 * c) * 33 + n;
        v4u o; o.x = pk2(s[0 * 33] * ga.x, s[1 * 33] * ga.y); o.y = pk2(s[2 * 33] * ga.z, s[3 * 33] * ga.w); o.z = pk2(s[4 * 33] * gb.x, s[5 * 33] * gb.y); o.w = pk2(s[6 * 33] * gb.z, s[7 * 33] * gb.w);
        *(GAS v4u*)((GAS bf16*)dst + (size_t)n * ldk + 8 * c) = o; }
    }
    LDS_WAIT(); asm volatile("" ::: "memory");
}
__device__ __forceinline__ void tr_item_f8w(const float* src, int ldw, unsigned char* dst, int ldk, LAS float* scr, int lane, const float* gk, const float wsc) {
    const int kg = lane & 7;
    f32x4 g[4];
#pragma unroll
    for (int q = 0; q < 4; ++q) g[q] = (f32x4){1.f, 1.f, 1.f, 1.f};
    if (gk) {
#pragma unroll
        for (int q = 0; q < 4; ++q) g[q] = *(const GAS f32x4*)(gk + 16 * kg + 4 * q); }
    {   const int r16 = lane >> 2, c4 = 4 * (lane & 3);
        f32x4 v[8];
#pragma unroll
        for (int i = 0; i < 8; ++i) v[i] = *(const GAS f32x4*)(src + (size_t)(16 * i + r16) * ldw + c4);
#pragma unroll
        for (int i = 0; i < 8; ++i) { LAS float* d = scr + (16 * i + r16) * 17 + c4; d[0] = v[i].x; d[1] = v[i].y; d[2] = v[i].z; d[3] = v[i].w; }
    }
    LDS_WAIT(); asm volatile("" ::: "memory");
#pragma unroll
    for (int q = 0; q < 4; ++q) g[q] = g[q] * wsc;
#pragma unroll
    for (int j = 0; j < 2; ++j) { const int n = (lane >> 3) + 8 * j; const LAS float* s = scr + (16 * kg) * 17 + n;
        v4u o;
        o.x = pk4_f8(s[0 * 17] * g[0].x, s[1 * 17] * g[0].y, s[2 * 17] * g[0].z, s[3 * 17] * g[0].w); o.y = pk4_f8(s[4 * 17] * g[1].x, s[5 * 17] * g[1].y, s[6 * 17] * g[1].z, s[7 * 17] * g[1].w);
        o.z = pk4_f8(s[8 * 17] * g[2].x, s[9 * 17] * g[2].y, s[10 * 17] * g[2].z, s[11 * 17] * g[2].w); o.w = pk4_f8(s[12 * 17] * g[3].x, s[13 * 17] * g[3].y, s[14 * 17] * g[3].z, s[15 * 17] * g[3].w);
        *(GAS v4u*)(dst + (size_t)n * ldk + 16 * kg) = o; }
    LDS_WAIT(); asm volatile("" ::: "memory");
}
template <int ROWMAP, int F8 = 0>
__device__ __forceinline__ bool tr_matrix(int& r, const float* W, int K, int N, int ldw, int c0, void* dstv, int ldk, int drow0, LAS float* scr, int lane, const float* g = nullptr, const float wsc = 1.0f) {
    unsigned char* dst = (unsigned char*)dstv;
    if constexpr (F8 == 2) {
        const int nblk = N / 16, items = (K / 128) * nblk;
        if (r >= items) { r -= items; return false; }
        const int kb = r / nblk, nb = r % nblk, k0 = 128 * kb, n0 = 16 * nb;
        const int drow = ROWMAP == 0 ? drow0 + n0 : drow0 + (n0 >> 7) * 256 + ((n0 & 127) >> 5) * 64 + (n0 & 31);
        tr_item_f8w(W + (size_t)k0 * ldw + c0 + n0, ldw, dst + (size_t)drow * ldk + k0, ldk, scr, lane, g ? g + k0 : nullptr, wsc);
        return true;
    }
    const int nblk = N / 32, items = (K / 64) * nblk;
    if (r >= items) { r -= items; return false; }
    const int kb = r / nblk, nb = r % nblk, k0 = 64 * kb, n0 = 32 * nb;
    const int drow = ROWMAP == 0 ? drow0 + n0 : drow0 + (n0 >> 7) * 256 + ((n0 & 127) >> 5) * 64;
    tr_item<F8 != 0>(W + (size_t)k0 * ldw + c0 + n0, ldw, dst + ((size_t)drow * ldk + k0) * (F8 ? 1 : 2), ldk, scr, lane, g ? g + k0 : nullptr, wsc);
    return true;
}
__device__ __forceinline__ void prologue_phase(const Args& a, Frame& F) {
    LAS float* scr = (LAS float*)(F.lds + RING_OFF + F.wave * 16384);
    unsigned char* ws = a.ws;
    const int gw = F.bid * NWAVES + F.wave, NGW = F.G * NWAVES;
    constexpr int I_IN = 16 * 112, I_OUT = 16 * 32, I_DG = 16 * 86, I_DD = 43 * 32, I_MG = 16 * 112, I_MD = 56 * 32;
    constexpr int PER_LAYER_A = I_IN + I_OUT;
    constexpr int PER_DENSE = 2 * I_DG + I_DD;
    constexpr int PER_EXP = 2 * I_MG + I_MD;
    constexpr int NITEMS = 4 * PER_LAYER_A + 2 * PER_DENSE + 16 * PER_EXP;
    for (int it = gw; it < NITEMS; it += NGW) {
        int r = it;
        if (r < 4 * PER_LAYER_A) {
            const int l = r / PER_LAYER_A; r -= l * PER_LAYER_A;
            const float* W = a.w_in + (size_t)l * DM * PIN; bf16* D = (bf16*)(ws + WS_WIN) + (size_t)l * NPROJ * DM;
            if (r < 16 * 64) { (void)tr_matrix<0>(r, W, DM, 2048, PIN, 0, D, DM, 0, scr, F.lane, a.norm_mix_g + l * DM); continue; } r -= 16 * 64;
            if (r < 16 * 48) { (void)tr_matrix<0>(r, W, DM, 1536, PIN, 2056, D, DM, 2048, scr, F.lane, a.norm_mix_g + l * DM); continue; } r -= 16 * 48;
            (void)tr_matrix<0>(r, a.w_out + (size_t)l * DM * DM, DM, DM, DM, 0, (bf16*)(ws + WS_WOUT) + (size_t)l * DM * DM, DM, 0, scr, F.lane); continue;
        }
        r -= 4 * PER_LAYER_A;
        if (r < 2 * PER_DENSE) {
            const int j = r / PER_DENSE; r -= j * PER_DENSE;
            unsigned char* GU = ws + WS_WGU + (size_t)j * 2 * FFDP * DM * 2; unsigned char* WDj = ws + WS_WD + (size_t)j * DM * FFDP * 2;
            if ((DENSE_F8_UP >> j) & 1) {
                if (tr_matrix<1, 2>(r, a.ffn_w_gate + (size_t)j * DM * FFD, DM, FFD, FFD, 0, GU, DM, 0, scr, F.lane, a.norm_ffn_g + (2 * j) * DM, F8_WGU)) continue;
                if (tr_matrix<1, 2>(r, a.ffn_w_up + (size_t)j * DM * FFD, DM, FFD, FFD, 0, GU, DM, 32, scr, F.lane, a.norm_ffn_g + (2 * j) * DM, F8_WGU)) continue;
            } else {
                if (tr_matrix<1>(r, a.ffn_w_gate + (size_t)j * DM * FFD, DM, FFD, FFD, 0, GU, DM, 0, scr, F.lane, a.norm_ffn_g + (2 * j) * DM)) continue;
                if (tr_matrix<1>(r, a.ffn_w_up + (size_t)j * DM * FFD, DM, FFD, FFD, 0, GU, DM, 32, scr, F.lane, a.norm_ffn_g + (2 * j) * DM)) continue;
            }
            if ((DENSE_F8_DN >> j) & 1) (void)tr_matrix<0, 1>(r, a.ffn_w_down + (size_t)j * FFD * DM, FFD, DM, DM, 0, WDj, FFDP, 0, scr, F.lane, nullptr, F8_WD);
            else (void)tr_matrix<0>(r, a.ffn_w_down + (size_t)j * FFD * DM, FFD, DM, DM, 0, WDj, FFDP, 0, scr, F.lane);
            continue;
        }
        r -= 2 * PER_DENSE;
        {
            const int je = r / PER_EXP; r -= je * PER_EXP;
            constexpr int M8 = MOE_FP8 ? 2 : 0; constexpr size_t MES = M8 ? 1 : 2;
            unsigned char* GU = ws + WS_MGU + (size_t)je * 2 * FFE * DM * MES;
            if (tr_matrix<1, M8>(r, a.moe_w_gate + (size_t)je * DM * FFE, DM, FFE, FFE, 0, GU, DM, 0, scr, F.lane, a.norm_ffn_g + (2 * (je >> 3) + 1) * DM, F8_WGU)) continue;
            if (tr_matrix<1, M8>(r, a.moe_w_up + (size_t)je * DM * FFE, DM, FFE, FFE, 0, GU, DM, 32, scr, F.lane, a.norm_ffn_g + (2 * (je >> 3) + 1) * DM, F8_WGU)) continue;
            (void)tr_matrix<0, M8>(r, a.moe_w_down + (size_t)je * FFE * DM, FFE, DM, DM, 0, ws + WS_MD + (size_t)je * DM * FFE * MES, FFE, 0, scr, F.lane, nullptr, F8_WD);
        }
    }
    const int gt = F.bid * NTHREADS + F.tid, NGT = F.G * NTHREADS;
    constexpr int RCH = DM * 2 / 16, PCH = 64 * 2 / 16;
    for (int i = gt; i < 2 * 128 * RCH; i += NGT) {
        const int j = i / (128 * RCH), rr = (i / RCH) % 128, ch = i % RCH; const int esz = ((DENSE_F8_UP >> j) & 1) ? 1 : 2;
        const int row = 21 * 256 + 128 + rr;
        if (ch * 16 < DM * esz) *(GAS v4u*)(ws + WS_WGU + (size_t)j * 2 * FFDP * DM * 2 + ((size_t)row * DM) * esz + ch * 16) = (v4u){0u, 0u, 0u, 0u};
    }
    for (int i = gt; i < 2 * DM * PCH; i += NGT) {
        const int j = i / (DM * PCH), row = (i / PCH) % DM, ch = i % PCH; const int esz = ((DENSE_F8_DN >> j) & 1) ? 1 : 2;
        if (ch * 16 < 64 * esz) *(GAS v4u*)(ws + WS_WD + (size_t)j * DM * FFDP * 2 + ((size_t)row * FFDP + FFD) * esz + ch * 16) = (v4u){0u, 0u, 0u, 0u};
    }
}

struct NormIn { const float* src; const bf16* o2; float* hout; const float* gain; bf16* y; const float* w8; int ld8; float* G; unsigned* cnt; uint2* rinfo; int* cntw; int* rrec; const bf16* src16; bf16* hout16; float* rs; unsigned char* h8; };
template <bool B> struct RowSel { typedef f32x4 T; };
template <> struct RowSel<true> { typedef v2u T; };
template <int MODE, bool S16 = false>
__device__ __forceinline__ void norm_phase(Frame& F, const NormIn& p) {
    typedef typename RowSel<S16>::T RowT;
    LAS float* W8 = (LAS float*)(F.lds + RING_OFF);
    LAS int* lcnt = (LAS int*)(F.lds + RING_OFF + 32768);
    LAS int* lbase = lcnt + 8;
    LAS int* rec = lcnt + 16;
    f32x4 wr[(MODE == 0 || MODE == 2) ? 32 : 1];
    if (MODE == 0 || MODE == 2) {
        for (int i = F.tid; i < DM * 2; i += NTHREADS) *(LAS f32x4*)(W8 + 4 * i) = *(const GAS f32x4*)(p.w8 + (size_t)(i >> 1) * p.ld8 + 4 * (i & 1));
        __syncthreads();
#pragma unroll
        for (int j = 0; j < 4; ++j)
#pragma unroll
            for (int c = 0; c < 4; ++c) { const int k = 4 * (F.lane + 64 * j) + c; wr[(j * 4 + c) * 2] = *(const LAS f32x4*)(W8 + k * 8); wr[(j * 4 + c) * 2 + 1] = *(const LAS f32x4*)(W8 + k * 8 + 4); }
        __syncthreads();
    }
    for (int rb0 = F.bid; rb0 < T / 64; rb0 += F.G) {
        const int rb = (rb0 & 7) * 32 + (rb0 >> 3);
        RowT vn[4], vm[4]; v2u na[4], nb[4], ma[4], mb[4];
        const GAS RowT* const srcr = (S16 ? (const GAS RowT*)p.src16 : (const GAS RowT*)p.src) + F.lane;
        { const int row = rb * 64 + F.wave * 8; const GAS RowT* xr = srcr + (size_t)row * (DM / 4);
#pragma unroll
          for (int j = 0; j < 4; ++j) { vn[j] = xr[64 * j]; vm[j] = xr[64 * j + DM / 4]; }
          if (p.o2) { const GAS v2u* oa = (const GAS v2u*)(p.o2 + (size_t)row * DM) + F.lane; const GAS v2u* ob = (const GAS v2u*)(p.o2 + ((size_t)T + row) * DM) + F.lane;
#pragma unroll
              for (int j = 0; j < 4; ++j) { na[j] = oa[64 * j]; nb[j] = ob[64 * j]; ma[j] = oa[64 * j + DM / 4]; mb[j] = ob[64 * j + DM / 4]; } } }
#pragma unroll 1
        for (int i = 0; i < 8; ++i) {
            const int row = rb * 64 + F.wave * 8 + i;
            f32x4 v[4]; float s = 0.f;
#pragma unroll
            for (int j = 0; j < 4; ++j) { if constexpr (S16) { const v2u a = vn[j]; v[j] = (f32x4){bflo(a.x), bfhi(a.x), bflo(a.y), bfhi(a.y)}; } else v[j] = vn[j]; }
            if (p.o2) {
#pragma unroll
                for (int j = 0; j < 4; ++j) { const v2u a = na[j], b = nb[j];
                    v[j].x += bflo(a.x) + bflo(b.x); v[j].y += bfhi(a.x) + bfhi(b.x); v[j].z += bflo(a.y) + bflo(b.y); v[j].w += bfhi(a.y) + bfhi(b.y); }
            }
#pragma unroll
            for (int j = 0; j < 4; ++j) { vn[j] = vm[j]; na[j] = ma[j]; nb[j] = mb[j]; }
            if (i + 2 < 8) { const int rn = row + 2; const GAS RowT* xr = srcr + (size_t)rn * (DM / 4);
#pragma unroll
                for (int j = 0; j < 4; ++j) vm[j] = xr[64 * j];
                if (p.o2) { const GAS v2u* oa = (const GAS v2u*)(p.o2 + (size_t)rn * DM) + F.lane; const GAS v2u* ob = (const GAS v2u*)(p.o2 + ((size_t)T + rn) * DM) + F.lane;
#pragma unroll
                    for (int j = 0; j < 4; ++j) { ma[j] = oa[64 * j]; mb[j] = ob[64 * j]; } } }
            if (MODE != 3 && p.hout) { GAS f32x4* ho = (GAS f32x4*)(p.hout + (size_t)row * DM) + F.lane;
#pragma unroll
                for (int j = 0; j < 4; ++j) ho[64 * j] = v[j]; }
            if (MODE != 3 && p.hout16) { GAS v2u* ho = (GAS v2u*)(p.hout16 + (size_t)row * DM) + F.lane;
#pragma unroll
                for (int j = 0; j < 4; ++j) { const v2u w = (v2u){pk2(v[j].x, v[j].y), pk2(v[j].z, v[j].w)}; ho[64 * j] = w; v[j] = (f32x4){bflo(w.x), bfhi(w.x), bflo(w.y), bfhi(w.y)}; } }
#pragma unroll
            for (int j = 0; j < 4; ++j) s += (v[j].x * v[j].x + v[j].y * v[j].y) + (v[j].z * v[j].z + v[j].w * v[j].w);
            const float rstd = 1.0f / sqrtf(wave_sum(s) * (1.0f / DM) + EPS);
            const GAS f32x4* gr = (const GAS f32x4*)p.gain + F.lane;
            if ((MODE == 2 && MOE_FP8) || (MODE == 1 && p.h8)) { GAS unsigned* h8r = (GAS unsigned*)(p.h8 + (size_t)row * DM) + F.lane;
#pragma unroll
                for (int j = 0; j < 4; ++j) { const f32x4 q = v[j] * rstd; h8r[64 * j] = pk4_f8(q.x, q.y, q.z, q.w); } }
#pragma unroll
            for (int j = 0; j < 4; ++j) { const f32x4 g = gr[64 * j]; v[j] = v[j] * rstd * g; }
            if (MODE == 3) { GAS f32x4* ho = (GAS f32x4*)(p.hout + (size_t)row * DM) + F.lane;
#pragma unroll
                for (int j = 0; j < 4; ++j) ho[64 * j] = v[j];
                continue; }
            if (F.lane == 0) ((GAS float*)p.rs)[row] = rstd;
            if (MODE == 0 || MODE == 2) {
                float d[8];
#pragma unroll
                for (int g = 0; g < 8; ++g) d[g] = 0.f;
#pragma unroll
                for (int j = 0; j < 4; ++j)
#pragma unroll
                    for (int c = 0; c < 4; ++c) { const f32x4 w0 = wr[(j * 4 + c) * 2], w1 = wr[(j * 4 + c) * 2 + 1];
                        const float yv = v[j][c];
                        d[0] += yv * w0.x; d[1] += yv * w0.y; d[2] += yv * w0.z; d[3] += yv * w0.w; d[4] += yv * w1.x; d[5] += yv * w1.y; d[6] += yv * w1.z; d[7] += yv * w1.w; }
#pragma unroll
                for (int g = 0; g < 8; ++g) d[g] = wave_sum(d[g]);
                if (MODE == 0) { if (F.lane == 0) { GAS f32x4* gp = (GAS f32x4*)(p.G + (size_t)row * 8); gp[0] = (f32x4){d[0], d[1], d[2], d[3]}; gp[1] = (f32x4){d[4], d[5], d[6], d[7]}; } }
                else {
                    int e0 = 0; float v0 = d[0];
#pragma unroll
                    for (int g = 1; g < 8; ++g) if (d[g] > v0) { v0 = d[g]; e0 = g; }
                    int e1 = -1; float v1 = -INFINITY;
#pragma unroll
                    for (int g = 0; g < 8; ++g) if (g != e0 && d[g] > v1) { v1 = d[g]; e1 = g; }
                    const float w0 = 1.0f / (1.0f + expf(v1 - v0)), w1 = 1.0f - w0;
                    if (F.lane == 0) { LAS int* rr = rec + (F.wave * 8 + i) * 6; rr[0] = e0; rr[1] = e1; rr[4] = __builtin_bit_cast(int, w0); rr[5] = __builtin_bit_cast(int, w1); }
                }
            }
        }
        if (MODE == 2) {
            __syncthreads();
            if (F.wave == 0) { const LAS int* rr = rec + F.lane * 6; const int e0 = rr[0], e1 = rr[1], row = rb * 64 + F.lane;
                const unsigned long long below = (1ull << F.lane) - 1ull;
                int lp0 = 0, lp1 = 0, mycnt = 0;
#pragma unroll
                for (int e = 0; e < 8; ++e) { const unsigned long long m0 = __ballot(e0 == e), m1 = __ballot(e1 == e);
                    const int lp = __popcll(m0 & below) + __popcll(m1 & below), ce = __popcll(m0) + __popcll(m1);
                    if (e0 == e) lp0 = lp; if (e1 == e) lp1 = lp; if (F.lane == e) mycnt = ce; }
                GAS int* ro = (GAS int*)p.rrec + (size_t)row * 6; ro[0] = e0; ro[1] = e1; ro[2] = lp0; ro[3] = lp1; ro[4] = rr[4]; ro[5] = rr[5];
                if (F.lane < 8) { ((GAS int*)p.cntw)[rb * 8 + F.lane] = mycnt; (void)__hip_atomic_fetch_add(p.cnt + F.lane, (unsigned)mycnt, __ATOMIC_RELAXED, __HIP_MEMORY_SCOPE_AGENT); } }
            __syncthreads();
        }
    }
}

__device__ __forceinline__ void route_finish(Frame& F, const int* cntw, const int* rrec, uint2* rinfo, const float* RS, float* RSI) {
    LAS float* lred = (LAS float*)(F.lds + RING_OFF);
    for (int rb0 = F.bid; rb0 < T / 64; rb0 += F.G) {
        const int rb = (rb0 & 7) * 32 + (rb0 >> 3);
        float c[8];
#pragma unroll
        for (int e = 0; e < 8; ++e) c[e] = 0.f;
        if (F.tid < rb) { const GAS i32x4* cp = (const GAS i32x4*)(cntw + F.tid * 8); const i32x4 a = cp[0], b = cp[1];
            c[0] = (float)a.x; c[1] = (float)a.y; c[2] = (float)a.z; c[3] = (float)a.w; c[4] = (float)b.x; c[5] = (float)b.y; c[6] = (float)b.z; c[7] = (float)b.w; }
#pragma unroll
        for (int e = 0; e < 8; ++e) c[e] = wave_sum(c[e]);
        if (F.lane == 0) {
#pragma unroll
            for (int e = 0; e < 8; ++e) lred[F.wave * 8 + e] = c[e]; }
        __syncthreads();
        if (F.tid < 64) { const int row = rb * 64 + F.tid; const GAS int* rr = (const GAS int*)rrec + (size_t)row * 6;
            const int e0 = rr[0], e1 = rr[1];
            float b0 = 0.f, b1 = 0.f;
#pragma unroll
            for (int w = 0; w < NWAVES; ++w) { b0 += lred[w * 8 + e0]; b1 += lred[w * 8 + e1]; }
            const int p0 = (int)b0 + rr[2], p1 = (int)b1 + rr[3];
            rinfo[(size_t)e0 * T + p0] = make_uint2((unsigned)row * 2u, (unsigned)rr[4]);
            rinfo[(size_t)e1 * T + p1] = make_uint2((unsigned)row * 2u + 1u, (unsigned)rr[5]);
            const float rsr = ((const GAS float*)RS)[row]; ((GAS float*)RSI)[(size_t)e0 * T + p0] = rsr; ((GAS float*)RSI)[(size_t)e1 * T + p1] = rsr; }
        __syncthreads();
    }
}

__device__ __forceinline__ float logsigmoid_f(float x) { return fminf(x, 0.f) - log1pf(expf(-fabsf(x))); }
__device__ __forceinline__ void gate_scan(Frame& F, int bh, const float* G, const float* b_i, const float* b_f, float* GA, float* GM, float* GE, float* TG) {
    LAS float* sc = (LAS float*)(F.lds + RING_OFF);
    const int b = bh >> 2, h = bh & 3, t0 = 4 * F.tid;
    const float bi = b_i[h], bf = b_f[h];
    float lf[4], ig[4];
#pragma unroll
    for (int j = 0; j < 4; ++j) { const float* g = G + ((size_t)b * SEQ + t0 + j) * 8; ig[j] = g[h] + bi; lf[j] = logsigmoid_f(g[4 + h] + bf); }
    float c[4]; c[0] = lf[0]; c[1] = c[0] + lf[1]; c[2] = c[1] + lf[2]; c[3] = c[2] + lf[3];
    float ws = c[3];
    DPP_SCAN(ws, OP_ADD, 0.0f);
    if (F.lane == 63) sc[F.wave] = ws;
    __syncthreads();
    float woff = 0.f;
    for (int w = 0; w < F.wave; ++w) woff += sc[w];
    const float excl = woff + ws - c[3];
    float Fc[4], av[4];
#pragma unroll
    for (int j = 0; j < 4; ++j) { Fc[j] = excl + c[j]; av[j] = ig[j] - Fc[j]; }
    float m[4]; m[0] = av[0]; m[1] = fmaxf(m[0], av[1]); m[2] = fmaxf(m[1], av[2]); m[3] = fmaxf(m[2], av[3]);
    float wm = m[3];
    DPP_SCAN(wm, OP_MAX, -INFINITY);
    if (F.lane == 63) sc[16 + F.wave] = wm;
    __syncthreads();
    float pm = -INFINITY;
    for (int w = 0; w < F.wave; ++w) pm = fmaxf(pm, sc[16 + w]);
    { float u = dpp_f(-INFINITY, wm, 0x111, 0xf);
      const float r15 = dpp_f(-INFINITY, wm, 0x142, 0xa), r31 = dpp_f(-INFINITY, wm, 0x143, 0xc);
      if ((F.lane & 15) == 0) u = (F.lane == 32) ? r31 : r15;
      pm = fmaxf(pm, u); }
    float tmx = m[3];
    tmx = fmaxf(tmx, dpp_f(-INFINITY, tmx, 0x111, 0xf)); tmx = fmaxf(tmx, dpp_f(-INFINITY, tmx, 0x112, 0xf)); tmx = fmaxf(tmx, dpp_f(-INFINITY, tmx, 0x114, 0xf)); tmx = fmaxf(tmx, dpp_f(-INFINITY, tmx, 0x118, 0xf));
    const int tbits = __builtin_bit_cast(int, tmx);
    const float t0m = __builtin_bit_cast(float, __builtin_amdgcn_readlane(tbits, 15)), t1m = __builtin_bit_cast(float, __builtin_amdgcn_readlane(tbits, 31)),
                t2m = __builtin_bit_cast(float, __builtin_amdgcn_readlane(tbits, 47)), t3m = __builtin_bit_cast(float, __builtin_amdgcn_readlane(tbits, 63));
    const int rw = F.lane >> 4; const float tm = rw == 0 ? t0m : (rw == 1 ? t1m : (rw == 2 ? t2m : t3m));
    if ((F.lane & 15) == 0) TG[bh * 32 + F.wave * 4 + rw] = tm * LOG2E;
#pragma unroll
    for (int j = 0; j < 4; ++j) { const float Mt = fmaxf(pm, m[j]); const size_t o = (size_t)bh * SEQ + t0 + j;
        GA[o] = expf(av[j] - tm); GM[o] = Mt * LOG2E; GE[o] = expf(-(Fc[j] + Mt)); }
    __syncthreads();
}

__device__ __forceinline__ void unpack8(const v4u r, float (&d)[8]) { d[0] = bflo(r.x); d[1] = bfhi(r.x); d[2] = bflo(r.y); d[3] = bfhi(r.y); d[4] = bflo(r.z); d[5] = bfhi(r.z); d[6] = bflo(r.w); d[7] = bfhi(r.w); }
__device__ __forceinline__ void conv_phase(Frame& F, const bf16* proj, const float* cw, const float* cb, bf16* qkc, const int hidx, const int nh) {
    const int cbat = F.bid & 7;
    for (int wi = F.wave * nh + hidx; wi < 144; wi += NWAVES * nh) {
        const int kpart = wi >= 128 ? 1 : 0;
        const int seg = cbat * 128 + (kpart ? 112 + (wi - 128) : wi);
        const int t0 = seg * 16, c0 = kpart * 512 + F.lane * 8;
        float w[4][8], bb[8];
#pragma unroll
        for (int tap = 0; tap < 4; ++tap) { const f32x4 a = *(const GAS f32x4*)(cw + tap * 1024 + c0), b = *(const GAS f32x4*)(cw + tap * 1024 + c0 + 4);
            w[tap][0] = a.x; w[tap][1] = a.y; w[tap][2] = a.z; w[tap][3] = a.w; w[tap][4] = b.x; w[tap][5] = b.y; w[tap][6] = b.z; w[tap][7] = b.w; }
        { const f32x4 a = *(const GAS f32x4*)(cb + c0), b = *(const GAS f32x4*)(cb + c0 + 4); bb[0] = a.x; bb[1] = a.y; bb[2] = a.z; bb[3] = a.w; bb[4] = b.x; bb[5] = b.y; bb[6] = b.z; bb[7] = b.w; }
        const float osc = kpart ? KM_SCALE : 1.0f;
        const bool first = (t0 % SEQ) == 0;
        v4u rw[19];
#pragma unroll
        for (int q = 0; q < 3; ++q) { rw[q] = (v4u){0u, 0u, 0u, 0u}; if (!first) rw[q] = *(const GAS v4u*)(proj + (size_t)(t0 - 3 + q) * NPROJ + c0); }
#pragma unroll
        for (int q = 0; q < 16; ++q) rw[3 + q] = *(const GAS v4u*)(proj + (size_t)(t0 + q) * NPROJ + c0);
        float x0[8], x1[8], x2[8];
        unpack8(rw[0], x0); unpack8(rw[1], x1); unpack8(rw[2], x2);
#pragma unroll
        for (int i = 0; i < 16; ++i) {
            float x3[8]; unpack8(rw[3 + i], x3);
            float o[8];
#pragma unroll
            for (int c = 0; c < 8; ++c) { const float yv = bb[c] + x0[c] * w[0][c] + x1[c] * w[1][c] + x2[c] * w[2][c] + x3[c] * w[3][c];
                o[c] = osc * yv * __builtin_amdgcn_rcpf(1.0f + __builtin_amdgcn_exp2f(-yv * LOG2E)); x0[c] = x1[c]; x1[c] = x2[c]; x2[c] = x3[c]; }
            *(GAS v4u*)(qkc + (size_t)(t0 + i) * DM + c0) = (v4u){pk2(o[0], o[1]), pk2(o[2], o[3]), pk2(o[4], o[5]), pk2(o[6], o[7])};
        }
    }
}

__device__ __forceinline__ void naive_sb(Frame& F, const bf16* proj, const float* g_sb, bf16* mixed) {
    LAS float* qs = (LAS float*)(F.lds + RING_OFF) + F.wave * 256;
    LAS float* ps = qs + 64;
    for (int it = F.bid * NWAVES + F.wave; it < T * HS; it += F.G * NWAVES) {
        const int h = it & 7, row = it >> 3, t = row % SEQ, rb = row - t;
        qs[F.lane] = bf2f(proj[(size_t)row * NPROJ + 2048 + h * 64 + F.lane]);
        LDS_WAIT();
        float R = 1.0f, o = 0.f;
        const int nch = (t + 63) / 64;
        for (int c = nch - 1; c >= 0; --c) {
            const int s = 64 * c + F.lane; const bool valid = s < t;
            const bf16* kr = proj + (size_t)(rb + s) * NPROJ + 2560 + h * 64;
            float z = 0.f;
#pragma unroll
            for (int d8 = 0; d8 < 8; ++d8) { const v4u kk = *(const GAS v4u*)(kr + d8 * 8); const f32x4 qa = *(const LAS f32x4*)(qs + d8 * 8), qb = *(const LAS f32x4*)(qs + d8 * 8 + 4);
                z += qa.x * bflo(kk.x) + qa.y * bfhi(kk.x) + qa.z * bflo(kk.y) + qa.w * bfhi(kk.y) + qb.x * bflo(kk.z) + qb.y * bfhi(kk.z) + qb.z * bflo(kk.w) + qb.w * bfhi(kk.w); }
            const float e = exp2f(-z); float beta = 1.0f / (1.0f + e); float omb = 1.0f - beta;
            if (!valid) { beta = 0.f; omb = 1.0f; }
            float pr = omb;
#pragma unroll
            for (int off = 1; off < 64; off <<= 1) { const float u = __shfl_down(pr, off); if (F.lane + off < 64) pr *= u; }
            float ex = __shfl_down(pr, 1); if (F.lane == 63) ex = 1.0f;
            const float a = beta * ex * R;
            R *= __shfl(pr, 0);
            ps[F.lane] = a; LDS_WAIT();
            const bf16* vr = proj + (size_t)(rb + 64 * c) * NPROJ + 3072 + h * 64 + F.lane;
#pragma unroll 8
            for (int j = 0; j < 64; ++j) o += ps[j] * bf2f(vr[(size_t)j * NPROJ]);
            LDS_WAIT();
        }
        const float ss = wave_sum(o * o) * (1.0f / 64.0f);
        const float val = o * (1.0f / sqrtf(ss + EPS)) * g_sb[h * 64 + F.lane];
        mixed[(size_t)row * DM + 512 + h * 64 + F.lane] = (bf16)f2bf(val);
    }
}
__device__ __forceinline__ void naive_mlstm(Frame& F, const bf16* proj, const bf16* qkc, const float* GA, const float* GM, const float* GE, const float* g_m, bf16* mixed) {
    LAS float* qs = (LAS float*)(F.lds + RING_OFF) + F.wave * 256;
    LAS float* ps = qs + 128;
    for (int it = F.bid * NWAVES + F.wave; it < T * HM; it += F.G * NWAVES) {
        const int h = it & 3, row = it >> 2, t = row % SEQ, rb = row - t, b = row / SEQ, bh = b * 4 + h;
        qs[F.lane] = bf2f(qkc[(size_t)row * DM + h * 128 + F.lane]); qs[64 + F.lane] = bf2f(qkc[(size_t)row * DM + h * 128 + 64 + F.lane]);
        LDS_WAIT();
        const float Mt = GM[(size_t)bh * SEQ + t];
        float den = 0.f, o0 = 0.f, o1 = 0.f;
        const int nch = t / 64 + 1;
        for (int c = 0; c < nch; ++c) {
            const int s = 64 * c + F.lane; const bool valid = s <= t;
            const bf16* kr = qkc + (size_t)(rb + s) * DM + 512 + h * 128;
            float z = 0.f;
#pragma unroll
            for (int d8 = 0; d8 < 16; ++d8) { const v4u kk = *(const GAS v4u*)(kr + d8 * 8); const f32x4 qa = *(const LAS f32x4*)(qs + d8 * 8), qb = *(const LAS f32x4*)(qs + d8 * 8 + 4);
                z += qa.x * bflo(kk.x) + qa.y * bfhi(kk.x) + qa.z * bflo(kk.y) + qa.w * bfhi(kk.y) + qb.x * bflo(kk.z) + qb.y * bfhi(kk.z) + qb.z * bflo(kk.w) + qb.w * bfhi(kk.w); }
            const float wgt = valid ? exp2f(GA[(size_t)bh * SEQ + s] - Mt) : 0.f;
            const float pv = z * wgt;
            den += pv;
            ps[F.lane] = pv; LDS_WAIT();
            const bf16* vr = proj + (size_t)(rb + 64 * c) * NPROJ + 1024 + h * 128 + F.lane;
#pragma unroll 8
            for (int j = 0; j < 64; ++j) { const float pj = ps[j]; o0 += pj * bf2f(vr[(size_t)j * NPROJ]); o1 += pj * bf2f(vr[(size_t)j * NPROJ + 64]); }
            LDS_WAIT();
        }
        den = wave_sum(den);
        const float dn = fmaxf(fabsf(den), GE[(size_t)bh * SEQ + t]);
        const float h0 = o0 / dn, h1 = o1 / dn;
        const float ss = wave_sum(h0 * h0 + h1 * h1) * (1.0f / 128.0f);
        const float rs = 1.0f / sqrtf(ss + EPS);
        const float om0 = bf2f(proj[(size_t)row * NPROJ + 1536 + h * 128 + F.lane]), om1 = bf2f(proj[(size_t)row * NPROJ + 1536 + h * 128 + 64 + F.lane]);
        const float r0 = h0 * rs * g_m[h * 128 + F.lane] / (1.0f + expf(-om0)), r1 = h1 * rs * g_m[h * 128 + 64 + F.lane] / (1.0f + expf(-om1));
        mixed[(size_t)row * DM + h * 128 + F.lane] = (bf16)f2bf(r0); mixed[(size_t)row * DM + h * 128 + 64 + F.lane] = (bf16)f2bf(r1);
    }
}

namespace mix {
typedef float f32x16 __attribute__((ext_vector_type(16)));
typedef short s16x4 __attribute__((ext_vector_type(4)));
typedef short v4i16_t __attribute__((ext_vector_type(4)));
typedef unsigned u32x4 __attribute__((ext_vector_type(4)));
typedef LAS const unsigned char* lptr;
#define MX_MFMA(a, b, c) __builtin_amdgcn_mfma_f32_32x32x16_bf16(a, b, c, 0, 0, 0)
__device__ __forceinline__ int crow(int r, int hi) { return (r & 3) + 8 * (r >> 2) + 4 * hi; }
__device__ __forceinline__ unsigned cvtpk(float lo, float hi) { unsigned r; asm("v_cvt_pk_bf16_f32 %0, %1, %2" : "=v"(r) : "v"(lo), "v"(hi)); return r; }
__device__ __forceinline__ s16x4 vtr(lptr p) { return __builtin_bit_cast(s16x4, __builtin_amdgcn_ds_read_tr16_b64_v4i16((LAS v4i16_t*)p)); }
__device__ __forceinline__ float partner(float x, int hi) { auto rr = __builtin_amdgcn_permlane32_swap(__builtin_bit_cast(unsigned, x), __builtin_bit_cast(unsigned, x), false, false);
    return __builtin_bit_cast(float, hi ? rr[0] : rr[1]); }

constexpr int STG_BYTES = 65536, GRP_BYTES = 32768, VIMG_OFF = 16384;
constexpr int EX_OFF = RING_BYTES + 1024;
constexpr int EX_GA = EX_OFF, EX_FA = EX_OFF + 1024, EX_FB = EX_OFF + 1536;

__device__ __forceinline__ void glds16(const void* g, unsigned lds_base) {
    unsigned sv; asm volatile("s_mov_b32 %0, m0\n\ts_mov_b32 m0, %2\n\ts_nop 0\n\tglobal_load_lds_dwordx4 %1, off\n\ts_mov_b32 m0, %0" : "=&s"(sv) : "v"(g), "s"(lds_base) : "memory"); }
__device__ __forceinline__ void glds4(const void* g, unsigned lds_base) {
    unsigned sv; asm volatile("s_mov_b32 %0, m0\n\ts_mov_b32 m0, %2\n\ts_nop 0\n\tglobal_load_lds_dword %1, off\n\ts_mov_b32 m0, %0" : "=&s"(sv) : "v"(g), "s"(lds_base) : "memory"); }
template <int D, bool ML>
__device__ __forceinline__ void issue_tile(unsigned gbase, unsigned gaimg, const bf16* Kp, int pk, const bf16* Vp, int pv, const float* ga, int s0, int w4, int lane) {
#pragma unroll
    for (int c = 0; c < D / 32; ++c) { const int ch = w4 + 4 * c;
        glds16(Kp + (size_t)(s0 + lane) * pk + 8 * ch, (unsigned)__builtin_amdgcn_readfirstlane(gbase + ch * 1024)); }
#pragma unroll
    for (int c = 0; c < D / 32; ++c) { const int idx = w4 + 4 * c, dp = idx >> 2, rg = idx & 3;
        glds16(Vp + (size_t)(s0 + 16 * rg + (lane >> 2)) * pv + 32 * dp + 8 * (lane & 3), (unsigned)__builtin_amdgcn_readfirstlane(gbase + VIMG_OFF + dp * 4096 + rg * 1024)); }
    if (ML) { if (w4 == 0) glds4(ga + s0 + lane, (unsigned)__builtin_amdgcn_readfirstlane(gaimg)); }
}

template <int D, bool SBK, bool MASK>
__device__ __forceinline__ void compute_tile(lptr kimg, lptr vimg, LAS const float* gat, const bf16x8 (&qr)[D / 16], f32x16 (&o)[D / 32], float& st, const float Mt, const int qrow, const int key0, const int lane) {
    const int r32 = lane & 31, hi = lane >> 5;
    f32x16 p0 = {}, p1 = {};
    const lptr kp = kimg + hi * 1024 + r32 * 16;
    {
        bf16x8 kf[D / 8];
#pragma unroll
        for (int d0 = 0; d0 < D / 16; ++d0) { kf[2 * d0] = *(LAS const bf16x8*)(kp + d0 * 2048); kf[2 * d0 + 1] = *(LAS const bf16x8*)(kp + d0 * 2048 + 512); }
        __builtin_amdgcn_sched_barrier(0);
#pragma unroll
        for (int d0 = 0; d0 < D / 16; ++d0) { p0 = MX_MFMA(kf[2 * d0], qr[d0], p0); p1 = MX_MFMA(kf[2 * d0 + 1], qr[d0], p1); }
    }
    const lptr vp = vimg + ((lane >> 4) & 1) * 32 + (lane & 3) * 8 + (4 * hi + ((lane & 15) >> 2)) * 64;
    s16x4 vlo[D / 8], vhi[D / 8];
#pragma unroll
    for (int dp = 0; dp < D / 32; ++dp)
#pragma unroll
        for (int ks = 0; ks < 4; ++ks) { vlo[dp * 4 + ks] = vtr(vp + dp * 4096 + ks * 1024); vhi[dp * 4 + ks] = vtr(vp + dp * 4096 + ks * 1024 + 512); }
    __builtin_amdgcn_sched_barrier(0);
    u32x4 pw[4];
    if constexpr (SBK) {
        float R = st;
#pragma unroll
        for (int blk = 1; blk >= 0; --blk) {
            const f32x16& X = blk ? p1 : p0; const int kb = key0 + 32 * blk;
            float bt[16], sx[16], Pg[4], Qg[4];
#pragma unroll
            for (int g = 0; g < 4; ++g) { float run = 1.f;
#pragma unroll
                for (int i = 3; i >= 0; --i) { const int r = 4 * g + i; float z = X[r]; if (MASK) z = (kb + crow(r, hi) < qrow) ? z : -INFINITY;
                    const float e = __builtin_amdgcn_exp2f(-z); const float b = __builtin_amdgcn_rcpf(1.0f + e); bt[r] = b; sx[r] = run; run *= (1.0f - b); }
                Pg[g] = run; }
#pragma unroll
            for (int g = 0; g < 4; ++g) Qg[g] = partner(Pg[g], hi);
            float a[16];
#pragma unroll
            for (int g = 3; g >= 0; --g) { const float pre = R * (hi ? 1.0f : Qg[g]);
#pragma unroll
                for (int i = 0; i < 4; ++i) a[4 * g + i] = bt[4 * g + i] * sx[4 * g + i] * pre;
                R *= Pg[g] * Qg[g]; }
            pw[2 * blk] = (u32x4){cvtpk(a[0], a[1]), cvtpk(a[2], a[3]), cvtpk(a[4], a[5]), cvtpk(a[6], a[7])};
            pw[2 * blk + 1] = (u32x4){cvtpk(a[8], a[9]), cvtpk(a[10], a[11]), cvtpk(a[12], a[13]), cvtpk(a[14], a[15])};
        }
        st = R;
    } else {
        float den = st;
#pragma unroll
        for (int blk = 0; blk < 2; ++blk) {
            const f32x16& X = blk ? p1 : p0; const int kb = key0 + 32 * blk;
            float a[16];
#pragma unroll
            for (int g = 0; g < 4; ++g) { const f32x4 gv = *(LAS const f32x4*)(gat + 32 * blk + 8 * g + 4 * hi);
#pragma unroll
                for (int i = 0; i < 4; ++i) { const int r = 4 * g + i; float p = X[r] * __builtin_amdgcn_exp2f(gv[i] - Mt); if (MASK) p = (kb + crow(r, hi) <= qrow) ? p : 0.f; den += p; a[r] = p; } }
            pw[2 * blk] = (u32x4){cvtpk(a[0], a[1]), cvtpk(a[2], a[3]), cvtpk(a[4], a[5]), cvtpk(a[6], a[7])};
            pw[2 * blk + 1] = (u32x4){cvtpk(a[8], a[9]), cvtpk(a[10], a[11]), cvtpk(a[12], a[13]), cvtpk(a[14], a[15])};
        }
        st = den;
    }
    __builtin_amdgcn_sched_barrier(0);
#pragma unroll
    for (int dp = 0; dp < D / 32; ++dp)
#pragma unroll
        for (int ks = 0; ks < 4; ++ks) { const s16x4 a = vlo[dp * 4 + ks], b = vhi[dp * 4 + ks];
            const bf16x8 vf = (bf16x8){a[0], a[1], a[2], a[3], b[0], b[1], b[2], b[3]};
            o[dp] = MX_MFMA(__builtin_bit_cast(bf16x8, pw[ks]), vf, o[dp]); }
}

template <int D, bool SBK>
__device__ __forceinline__ void attn_unit(LAS unsigned char* lds, const int tid_in, const bf16* Qp, int pq, const bf16* Kp, int pk, const bf16* Vp, int pv,
                                          const float* ga, const float* gm, const float* ge, const int qb, bf16* out, const float* gain, const bf16* om) {
    int tid = tid_in; asm volatile("" : "+v"(tid));
    const int lane = tid & 63, wid = __builtin_amdgcn_readfirstlane(tid >> 6), grp = wid >> 2, w4 = wid & 3, r32 = lane & 31, hi = lane >> 5;
    const int t0 = 128 * qb, ns = qb + 1, nt = 2 * ns;
    const int qrow = t0 + 32 * w4 + r32;
    bf16x8 qr[D / 16];
#pragma unroll
    for (int d0 = 0; d0 < D / 16; ++d0) qr[d0] = *(const GAS bf16x8*)(Qp + (size_t)qrow * pq + d0 * 16 + hi * 8);
    float Mt = 0.f; if (!SBK) Mt = gm[qrow];
    f32x16 o[D / 32];
#pragma unroll
    for (int i = 0; i < D / 32; ++i) o[i] = f32x16{};
    float st = SBK ? 1.0f : 0.0f;
    LAS unsigned char* const gb0 = lds + grp * GRP_BYTES; LAS unsigned char* const ga0 = lds + EX_GA + grp * 256;
    const unsigned gb0u = (unsigned)(size_t)gb0, ga0u = (unsigned)(size_t)ga0;
    const int tfirst = grp ? ns - 1 : nt - 1;
    issue_tile<D, !SBK>(gb0u, ga0u, Kp, pk, Vp, pv, ga, 64 * tfirst, w4, lane);
#pragma unroll
    for (int d0 = 0; d0 < D / 16; ++d0) asm volatile("" : "+v"(qr[d0]));
    asm volatile("" : "+v"(Mt));
    for (int i = 0; i < ns; ++i) {
        const int tl = tfirst - i, sb = (i & 1);
        asm volatile("s_waitcnt vmcnt(0)" ::: "memory");
        __builtin_amdgcn_s_barrier();
        asm volatile("" ::: "memory");
        if (i + 1 < ns) issue_tile<D, !SBK>(gb0u + (sb ^ 1) * STG_BYTES, ga0u + (sb ^ 1) * 512, Kp, pk, Vp, pv, ga, 64 * (tl - 1), w4, lane);
        const lptr kimg = (lptr)(gb0 + sb * STG_BYTES); LAS const float* gat = (LAS const float*)(ga0 + sb * 512);
        if (tl >= nt - 2) compute_tile<D, SBK, true>(kimg, kimg + VIMG_OFF, gat, qr, o, st, Mt, qrow, 64 * tl, lane);
        else compute_tile<D, SBK, false>(kimg, kimg + VIMG_OFF, gat, qr, o, st, Mt, qrow, 64 * tl, lane);
    }
    constexpr int PITCH = D + 4;
    LAS float* stg = (LAS float*)lds; LAS float* fA = (LAS float*)(lds + EX_FA); LAS float* fB = (LAS float*)(lds + EX_FB);
    if (!SBK) st += partner(st, hi);
    LDS_WAIT(); __builtin_amdgcn_s_barrier(); asm volatile("" ::: "memory");
    if (grp == 1) {
#pragma unroll
        for (int dp = 0; dp < D / 32; ++dp)
#pragma unroll
            for (int r = 0; r < 16; ++r) stg[(32 * w4 + crow(r, hi)) * PITCH + 32 * dp + r32] = o[dp][r];
        if (hi == 0) fB[32 * w4 + r32] = st;
    } else { if (hi == 0) fA[32 * w4 + r32] = st; }
    LDS_WAIT(); __builtin_amdgcn_s_barrier(); asm volatile("" ::: "memory");
    if (grp == 0) {
#pragma unroll
        for (int r = 0; r < 16; ++r) { const int row = 32 * w4 + crow(r, hi); const float f = SBK ? fA[row] : 1.0f;
#pragma unroll
            for (int dp = 0; dp < D / 32; ++dp) { LAS float* p = stg + row * PITCH + 32 * dp + r32; *p = o[dp][r] + f * (*p); } }
    }
    LDS_WAIT(); __builtin_amdgcn_s_barrier(); asm volatile("" ::: "memory");
    {
        constexpr int NC = D / 4;
        const int row = tid >> 2, qd = tid & 3, trow = t0 + row;
        float v[NC];
#pragma unroll
        for (int c = 0; c < NC / 4; ++c) { const f32x4 x = *(LAS const f32x4*)(stg + row * PITCH + qd * NC + 4 * c); v[4 * c] = x.x; v[4 * c + 1] = x.y; v[4 * c + 2] = x.z; v[4 * c + 3] = x.w; }
        if (!SBK) { const float den = fA[row] + fB[row]; const float inv = 1.0f / fmaxf(fabsf(den), ge[trow]);
#pragma unroll
            for (int c = 0; c < NC; ++c) v[c] *= inv; }
        float ss = 0.f;
#pragma unroll
        for (int c = 0; c < NC; ++c) ss += v[c] * v[c];
        ss += __shfl_xor(ss, 1); ss += __shfl_xor(ss, 2);
        const float rs = 1.0f / sqrtf(ss * (1.0f / D) + EPS);
        bf16* op = out + (size_t)trow * DM + qd * NC;
#pragma unroll
        for (int c8 = 0; c8 < NC / 8; ++c8) {
            float w[8];
#pragma unroll
            for (int c = 0; c < 8; ++c) w[c] = v[8 * c8 + c] * rs * gain[qd * NC + 8 * c8 + c];
            if (!SBK) { const v4u g = *(const GAS v4u*)(om + (size_t)trow * NPROJ + qd * NC + 8 * c8); float gg[8];
                gg[0] = bflo(g.x); gg[1] = bfhi(g.x); gg[2] = bflo(g.y); gg[3] = bfhi(g.y); gg[4] = bflo(g.z); gg[5] = bfhi(g.z); gg[6] = bflo(g.w); gg[7] = bfhi(g.w);
#pragma unroll
                for (int c = 0; c < 8; ++c) w[c] *= 1.0f / (1.0f + __expf(-gg[c])); }
            *(GAS v4u*)(op + 8 * c8) = (v4u){pk2(w[0], w[1]), pk2(w[2], w[3]), pk2(w[4], w[5]), pk2(w[6], w[7])};
        }
    }
    LDS_WAIT(); __builtin_amdgcn_s_barrier(); asm volatile("" ::: "memory");
}
#undef MX_MFMA
}

typedef unsigned cs_u32x2 __attribute__((ext_vector_type(2)));
constexpr int CS_PART = 4160, CS_IMG = 4 * CS_PART, CS_NV = 8 * CS_IMG;
static_assert(CS_NV + 16384 <= MISC_OFF, "chunk-state LDS map");
__device__ __forceinline__ void chunk_state_unit(Frame& F, const int bh, const int j, const bf16* proj, const float* cw, const float* cb, const float* GAw, const float* TG,
                                                 bf16* U, float* NV, float* CM, bf16* qkc) {
    using mix::f32x16; using mix::s16x4; using mix::vtr; using mix::lptr; using mix::cvtpk;
    const int b = bh >> 2, h = bh & 3, tid = F.tid, lane = F.lane, wid = F.wave;
    const size_t r0 = (size_t)b * SEQ;
    const int cg = tid & 15, kg = tid >> 4, c0 = 8 * cg, tl = kg >> 3;
    const int s0 = 256 * j + 8 * kg;
    LAS unsigned char* const img = F.lds + RING_OFF;
    const bf16* kp = proj + (r0 + s0) * NPROJ + 512 + h * 128 + c0;
    const bf16* vp = proj + (r0 + s0) * NPROJ + 1024 + h * 128 + c0;
    v4u kr[11], vr[8];
#pragma unroll
    for (int q = 0; q < 3; ++q) { kr[q] = (v4u){0u, 0u, 0u, 0u}; if (s0 > 0) kr[q] = *(const GAS v4u*)(kp + (ptrdiff_t)(q - 3) * NPROJ); }
#pragma unroll
    for (int q = 0; q < 8; ++q) { kr[3 + q] = *(const GAS v4u*)(kp + (size_t)q * NPROJ); vr[q] = *(const GAS v4u*)(vp + (size_t)q * NPROJ); }
    const f32x4 ga0 = *(const GAS f32x4*)(GAw + (size_t)bh * SEQ + s0), ga1 = *(const GAS f32x4*)(GAw + (size_t)bh * SEQ + s0 + 4);
    const float t0g = TG[bh * 32 + 4 * j], t1g = TG[bh * 32 + 4 * j + 1], t2g = TG[bh * 32 + 4 * j + 2], t3g = TG[bh * 32 + 4 * j + 3];
    const float cm = fmaxf(fmaxf(t0g, t1g), fmaxf(t2g, t3g));
    const float tf = __builtin_amdgcn_exp2f((tl == 0 ? t0g : (tl == 1 ? t1g : (tl == 2 ? t2g : t3g))) - cm);
    float w[4][8], bb[8];
#pragma unroll
    for (int tap = 0; tap < 4; ++tap) { const f32x4 x = *(const GAS f32x4*)(cw + tap * 1024 + 512 + h * 128 + c0), y = *(const GAS f32x4*)(cw + tap * 1024 + 512 + h * 128 + c0 + 4);
        w[tap][0] = x.x; w[tap][1] = x.y; w[tap][2] = x.z; w[tap][3] = x.w; w[tap][4] = y.x; w[tap][5] = y.y; w[tap][6] = y.z; w[tap][7] = y.w; }
    { const f32x4 x = *(const GAS f32x4*)(cb + 512 + h * 128 + c0), y = *(const GAS f32x4*)(cb + 512 + h * 128 + c0 + 4); bb[0] = x.x; bb[1] = x.y; bb[2] = x.z; bb[3] = x.w; bb[4] = y.x; bb[5] = y.y; bb[6] = y.z; bb[7] = y.w; }
    {
        float nvp[8];
#pragma unroll
        for (int c = 0; c < 8; ++c) nvp[c] = 0.f;
        float x0[8], x1[8], x2[8];
        unpack8(kr[0], x0); unpack8(kr[1], x1); unpack8(kr[2], x2);
        LAS unsigned char* const wp = img + tl * (2 * CS_IMG) + (cg >> 2) * CS_PART + (8 * (kg & 7)) * 64 + (cg & 3) * 16;
#pragma unroll
        for (int i = 0; i < 8; ++i) {
            float x3[8], o[8], xv[8]; unpack8(kr[3 + i], x3); unpack8(vr[i], xv);
            const float ws_ = (i < 4 ? ga0[i & 3] : ga1[i & 3]) * tf;
#pragma unroll
            for (int c = 0; c < 8; ++c) { const float yv = bb[c] + x0[c] * w[0][c] + x1[c] * w[1][c] + x2[c] * w[2][c] + x3[c] * w[3][c];
                o[c] = KM_SCALE * yv * __builtin_amdgcn_rcpf(1.0f + __builtin_amdgcn_exp2f(-yv * LOG2E)); nvp[c] += ws_ * o[c]; x0[c] = x1[c]; x1[c] = x2[c]; x2[c] = x3[c]; }
            const v4u kcv = (v4u){pk2(o[0], o[1]), pk2(o[2], o[3]), pk2(o[4], o[5]), pk2(o[6], o[7])};
            *(LAS v4u*)(wp + i * 64) = kcv;
            *(GAS v4u*)(qkc + (r0 + s0 + i) * DM + 512 + h * 128 + c0) = kcv;
            *(LAS v4u*)(wp + CS_IMG + i * 64) = (v4u){pk2(xv[0] * ws_, xv[1] * ws_), pk2(xv[2] * ws_, xv[3] * ws_), pk2(xv[4] * ws_, xv[5] * ws_), pk2(xv[6] * ws_, xv[7] * ws_)};
        }
        LAS float* np = (LAS float*)(img + CS_NV) + kg * 128 + c0;
        *(LAS f32x4*)np = (f32x4){nvp[0], nvp[1], nvp[2], nvp[3]}; *(LAS f32x4*)(np + 4) = (f32x4){nvp[4], nvp[5], nvp[6], nvp[7]};
    }
    LDS_WAIT(); __syncthreads();
    if (tid < 128) { const LAS float* np = (const LAS float*)(img + CS_NV) + tid; float nv = 0.f;
#pragma unroll
        for (int g = 0; g < 32; ++g) nv += np[g * 128];
        NV[((size_t)bh * 7 + j) * 128 + tid] = nv; }
    if (tid == 0) { CM[bh * 8 + j] = cm; if (j == 6) CM[bh * 8 + 7] = cm; }
    {
        const int hi = lane >> 5, r32 = lane & 31;
        const lptr fb = (lptr)img + ((lane >> 4) & 1) * 32 + (lane & 3) * 8 + (4 * hi + ((lane & 15) >> 2)) * 64;
        unsigned short* Uj = (unsigned short*)U + ((size_t)bh * 7 + j) * 16384;
#pragma unroll
        for (int q = 0; q < 2; ++q) { const int idx = 2 * wid + q, dpd = idx >> 2, dpe = idx & 3;
            f32x16 acc = {};
#pragma unroll
            for (int t = 0; t < 4; ++t)
#pragma unroll
                for (int ks = 0; ks < 4; ++ks) { const lptr tb = fb + t * (2 * CS_IMG) + ks * 1024;
                    const s16x4 a0 = vtr(tb + CS_IMG + dpe * CS_PART), a1 = vtr(tb + CS_IMG + dpe * CS_PART + 512), b0 = vtr(tb + dpd * CS_PART), b1 = vtr(tb + dpd * CS_PART + 512);
                    acc = __builtin_amdgcn_mfma_f32_32x32x16_bf16(((bf16x8){a0[0], a0[1], a0[2], a0[3], a1[0], a1[1], a1[2], a1[3]}), ((bf16x8){b0[0], b0[1], b0[2], b0[3], b1[0], b1[1], b1[2], b1[3]}), acc, 0, 0, 0); }
#pragma unroll
            for (int g = 0; g < 4; ++g) *(GAS cs_u32x2*)(Uj + (size_t)(32 * dpd + r32) * 128 + 32 * dpe + 8 * g + 4 * hi) = (cs_u32x2){pk2(acc[4 * g], acc[4 * g + 1]), pk2(acc[4 * g + 2], acc[4 * g + 3])};
        }
    }
    LDS_WAIT(); __syncthreads();
}

typedef const __attribute__((address_space(4))) Args* KArgs;
#define KA(field) ({ KArgs _p = kap; asm volatile("" : "+s"(_p)); _p->field; })
#define WSP(off) ((unsigned char*)KA(ws) + (off))
namespace mix2 {
using mix::f32x16; using mix::s16x4; using mix::u32x4; using mix::lptr; using mix::crow; using mix::cvtpk; using mix::vtr; using mix::partner; using mix::glds16; using mix::glds4;
#define MX_MFMA(a, b, c) __builtin_amdgcn_mfma_f32_32x32x16_bf16(a, b, c, 0, 0, 0)
constexpr int NKB = 3, NVB = 4;
constexpr int KBUF0 = 0, VBUF0 = NKB * 16384, BUFSZ = 16384, STAGE0 = (NKB + NVB) * 16384, STAGE_W = 4608;
constexpr int EX_GA = STAGE0 + 8 * STAGE_W;
constexpr int EX_DEAD = EX_GA + NVB * 256;
static_assert(EX_DEAD + 64 <= MISC_OFF, "mixer LDS map");
struct UnitP { int b, h, qb, layer; };
template <bool SBK> struct LoopPtrs { const bf16* Kp; const bf16* Vp; const float* ga; int pk, pv; };
template <bool SBK> __device__ __forceinline__ LoopPtrs<SBK> loop_ptrs(KArgs kap, const UnitP& u) {
    LoopPtrs<SBK> p; const size_t r0 = (size_t)u.b * SEQ; const bf16* proj = (const bf16*)WSP(WS_PROJ);
    if (SBK) { p.Kp = proj + r0 * NPROJ + 2560 + u.h * 64; p.Vp = proj + r0 * NPROJ + 3072 + u.h * 64; p.ga = nullptr; p.pk = NPROJ; p.pv = NPROJ; }
    else { const bf16* qkc = (const bf16*)WSP(WS_QKC); p.Kp = qkc + r0 * DM + 512 + u.h * 128; p.Vp = proj + r0 * NPROJ + 1024 + u.h * 128; p.ga = (const float*)WSP(WS_GA) + (size_t)(u.b * 4 + u.h) * SEQ; p.pk = DM; p.pv = NPROJ; }
    return p;
}

template <int D, bool ML, class LP>
__device__ __forceinline__ void issue_tile(unsigned kbuf, unsigned vbuf, unsigned gabuf, const LP& u, int s0, int wid, int lane) {
#pragma unroll
    for (int c = 0; c < D / 64; ++c) { const int ch = wid + 8 * c;
        glds16(u.Kp + (size_t)(s0 + lane) * u.pk + 8 * ch, (unsigned)__builtin_amdgcn_readfirstlane(kbuf + ch * 1024)); }
#pragma unroll
    for (int c = 0; c < D / 64; ++c) { const int idx = wid + 8 * c, dp = idx >> 2, rg = idx & 3;
        glds16(u.Vp + (size_t)(s0 + 16 * rg + (lane >> 2)) * u.pv + 32 * dp + 8 * (lane & 3), (unsigned)__builtin_amdgcn_readfirstlane(vbuf + dp * 4096 + rg * 1024)); }
    if (ML) glds4(u.ga + s0 + lane, (unsigned)__builtin_amdgcn_readfirstlane(gabuf));
}
template <int D>
__device__ __forceinline__ void qk(lptr kimg, const bf16x8 (&qr)[D / 16], f32x16& p0, f32x16& p1, const int lane) {
    const lptr kp = kimg + (lane >> 5) * 1024 + (lane & 31) * 16;
    p0 = f32x16{}; p1 = f32x16{};
#pragma unroll
    for (int hb = 0; hb < D / 64; ++hb) {
        bf16x8 kf[8];
#pragma unroll
        for (int d = 0; d < 4; ++d) { const int d0 = 4 * hb + d; kf[2 * d] = *(LAS const bf16x8*)(kp + d0 * 2048); kf[2 * d + 1] = *(LAS const bf16x8*)(kp + d0 * 2048 + 512); }
        __builtin_amdgcn_sched_barrier(0);
#pragma unroll
        for (int d = 0; d < 4; ++d) { const int d0 = 4 * hb + d; p0 = MX_MFMA(kf[2 * d], qr[d0], p0); p1 = MX_MFMA(kf[2 * d + 1], qr[d0], p1); }
        __builtin_amdgcn_sched_barrier(0);
    }
}
template <int D, bool SBK, bool MASK>
__device__ __forceinline__ void vp(lptr vimg, LAS const float* gat, const f32x16& p0, const f32x16& p1, f32x16 (&o)[D / 32], float& st, const float Mt, const int qrow, const int key0, const int lane) {
    const int hi = lane >> 5;
    const lptr vb = vimg + ((lane >> 4) & 1) * 32 + (lane & 3) * 8 + (4 * hi + ((lane & 15) >> 2)) * 64;
    constexpr int VPRE = (D == 128) ? 2 : D / 32;
    s16x4 vlo[VPRE * 4], vhi[VPRE * 4];
#pragma unroll
    for (int dp = 0; dp < VPRE; ++dp)
#pragma unroll
        for (int ks = 0; ks < 4; ++ks) { vlo[dp * 4 + ks] = vtr(vb + dp * 4096 + ks * 1024); vhi[dp * 4 + ks] = vtr(vb + dp * 4096 + ks * 1024 + 512); }
    __builtin_amdgcn_sched_barrier(0);
    u32x4 pw[4];
    if constexpr (SBK) {
        float R = st;
#pragma unroll
        for (int blk = 1; blk >= 0; --blk) {
            const f32x16& X = blk ? p1 : p0; const int kb = key0 + 32 * blk;
            float bt[16], sx[16], Pg[4], Qg[4];
#pragma unroll
            for (int g = 0; g < 4; ++g) { float run = 1.f;
#pragma unroll
                for (int i = 3; i >= 0; --i) { const int r = 4 * g + i; float z = X[r]; if (MASK) z = (kb + crow(r, hi) < qrow) ? z : -INFINITY;
                    const float e = __builtin_amdgcn_exp2f(-z); const float b = __builtin_amdgcn_rcpf(1.0f + e); bt[r] = b; sx[r] = run; run *= (1.0f - b); }
                Pg[g] = run; }
#pragma unroll
            for (int g = 0; g < 4; ++g) Qg[g] = partner(Pg[g], hi);
            float a[16];
#pragma unroll
            for (int g = 3; g >= 0; --g) { const float pre = R * (hi ? 1.0f : Qg[g]);
#pragma unroll
                for (int i = 0; i < 4; ++i) a[4 * g + i] = bt[4 * g + i] * sx[4 * g + i] * pre;
                R *= Pg[g] * Qg[g]; }
            pw[2 * blk] = (u32x4){cvtpk(a[0], a[1]), cvtpk(a[2], a[3]), cvtpk(a[4], a[5]), cvtpk(a[6], a[7])};
            pw[2 * blk + 1] = (u32x4){cvtpk(a[8], a[9]), cvtpk(a[10], a[11]), cvtpk(a[12], a[13]), cvtpk(a[14], a[15])};
        }
        st = R;
    } else {
        float den = st;
#pragma unroll
        for (int blk = 0; blk < 2; ++blk) {
            const f32x16& X = blk ? p1 : p0; const int kb = key0 + 32 * blk;
            float a[16];
#pragma unroll
            for (int g = 0; g < 4; ++g) { const f32x4 gv = *(LAS const f32x4*)(gat + 32 * blk + 8 * g + 4 * hi);
#pragma unroll
                for (int i = 0; i < 4; ++i) { const int r = 4 * g + i; float p = X[r] * (gv[i] * Mt); if (MASK) p = (kb + crow(r, hi) <= qrow) ? p : 0.f; den += p; a[r] = p; } }
            pw[2 * blk] = (u32x4){cvtpk(a[0], a[1]), cvtpk(a[2], a[3]), cvtpk(a[4], a[5]), cvtpk(a[6], a[7])};
            pw[2 * blk + 1] = (u32x4){cvtpk(a[8], a[9]), cvtpk(a[10], a[11]), cvtpk(a[12], a[13]), cvtpk(a[14], a[15])};
        }
        st = den;
    }
    __builtin_amdgcn_sched_barrier(0);
    if constexpr (VPRE < D / 32) {
#pragma unroll
        for (int dp = 0; dp < VPRE; ++dp)
#pragma unroll
            for (int ks = 0; ks < 4; ++ks) { const s16x4 a = vlo[dp * 4 + ks], b = vhi[dp * 4 + ks];
                o[dp] = MX_MFMA(__builtin_bit_cast(bf16x8, pw[ks]), ((bf16x8){a[0], a[1], a[2], a[3], b[0], b[1], b[2], b[3]}), o[dp]); }
        __builtin_amdgcn_sched_barrier(0);
        s16x4 wlo[(D / 32 - VPRE) * 4], whi[(D / 32 - VPRE) * 4];
#pragma unroll
        for (int dp = VPRE; dp < D / 32; ++dp)
#pragma unroll
            for (int ks = 0; ks < 4; ++ks) { wlo[(dp - VPRE) * 4 + ks] = vtr(vb + dp * 4096 + ks * 1024); whi[(dp - VPRE) * 4 + ks] = vtr(vb + dp * 4096 + ks * 1024 + 512); }
        __builtin_amdgcn_sched_barrier(0);
#pragma unroll
        for (int dp = VPRE; dp < D / 32; ++dp)
#pragma unroll
            for (int ks = 0; ks < 4; ++ks) { const s16x4 a = wlo[(dp - VPRE) * 4 + ks], b = whi[(dp - VPRE) * 4 + ks];
                o[dp] = MX_MFMA(__builtin_bit_cast(bf16x8, pw[ks]), ((bf16x8){a[0], a[1], a[2], a[3], b[0], b[1], b[2], b[3]}), o[dp]); }
    } else {
#pragma unroll
        for (int dp = 0; dp < D / 32; ++dp)
#pragma unroll
            for (int ks = 0; ks < 4; ++ks) { const s16x4 a = vlo[dp * 4 + ks], b = vhi[dp * 4 + ks];
                o[dp] = MX_MFMA(__builtin_bit_cast(bf16x8, pw[ks]), ((bf16x8){a[0], a[1], a[2], a[3], b[0], b[1], b[2], b[3]}), o[dp]); }
    }
}
template <int D, bool SBK, bool MASK>
__device__ __forceinline__ void valu(LAS const float* gat, const f32x16& p0, const f32x16& p1, u32x4 (&pw)[4], float& st, const float Mt, const int qrow, const int key0, const int lane) {
    const int hi = lane >> 5;
    if constexpr (SBK) {
        float R = st;
#pragma unroll
        for (int blk = 1; blk >= 0; --blk) {
            const f32x16& X = blk ? p1 : p0; const int kb = key0 + 32 * blk;
            float bt[16], sx[16], Pg[4], Qg[4];
#pragma unroll
            for (int g = 0; g < 4; ++g) { float run = 1.f;
#pragma unroll
                for (int i = 3; i >= 0; --i) { const int r = 4 * g + i; float z = X[r]; if (MASK) z = (kb + crow(r, hi) < qrow) ? z : -INFINITY;
                    const float e = __builtin_amdgcn_exp2f(-z); const float b = __builtin_amdgcn_rcpf(1.0f + e); bt[r] = b; sx[r] = run; run *= (1.0f - b); }
                Pg[g] = run; }
#pragma unroll
            for (int g = 0; g < 4; ++g) Qg[g] = partner(Pg[g], hi);
            float a[16];
#pragma unroll
            for (int g = 3; g >= 0; --g) { const float pre = R * (hi ? 1.0f : Qg[g]);
#pragma unroll
                for (int i = 0; i < 4; ++i) a[4 * g + i] = bt[4 * g + i] * sx[4 * g + i] * pre;
                R *= Pg[g] * Qg[g]; }
            pw[2 * blk] = (u32x4){cvtpk(a[0], a[1]), cvtpk(a[2], a[3]), cvtpk(a[4], a[5]), cvtpk(a[6], a[7])};
            pw[2 * blk + 1] = (u32x4){cvtpk(a[8], a[9]), cvtpk(a[10], a[11]), cvtpk(a[12], a[13]), cvtpk(a[14], a[15])};
        }
        st = R;
    } else {
        float den = st;
#pragma unroll
        for (int blk = 0; blk < 2; ++blk) {
            const f32x16& X = blk ? p1 : p0; const int kb = key0 + 32 * blk;
            float a[16];
#pragma unroll
            for (int g = 0; g < 4; ++g) { const f32x4 gv = *(LAS const f32x4*)(gat + 32 * blk + 8 * g + 4 * hi);
#pragma unroll
                for (int i = 0; i < 4; ++i) { const int r = 4 * g + i; float p = X[r] * (gv[i] * Mt); if (MASK) p = (kb + crow(r, hi) <= qrow) ? p : 0.f; den += p; a[r] = p; } }
            pw[2 * blk] = (u32x4){cvtpk(a[0], a[1]), cvtpk(a[2], a[3]), cvtpk(a[4], a[5]), cvtpk(a[6], a[7])};
            pw[2 * blk + 1] = (u32x4){cvtpk(a[8], a[9]), cvtpk(a[10], a[11]), cvtpk(a[12], a[13]), cvtpk(a[14], a[15])};
        }
        st = den;
    }
}
template <int D>
__device__ __forceinline__ void pv(lptr vimg, const u32x4 (&pw)[4], f32x16 (&o)[D / 32], const int lane) {
    const int hi = lane >> 5;
    const lptr vb = vimg + ((lane >> 4) & 1) * 32 + (lane & 3) * 8 + (4 * hi + ((lane & 15) >> 2)) * 64;
#pragma unroll
    for (int hb = 0; hb < D / 64; ++hb) {
        s16x4 vlo[8], vhi[8];
#pragma unroll
        for (int d = 0; d < 2; ++d)
#pragma unroll
            for (int ks = 0; ks < 4; ++ks) { const int dp = 2 * hb + d; vlo[d * 4 + ks] = vtr(vb + dp * 4096 + ks * 1024); vhi[d * 4 + ks] = vtr(vb + dp * 4096 + ks * 1024 + 512); }
        __builtin_amdgcn_sched_barrier(0);
#pragma unroll
        for (int d = 0; d < 2; ++d)
#pragma unroll
            for (int ks = 0; ks < 4; ++ks) { const int dp = 2 * hb + d; const s16x4 a = vlo[d * 4 + ks], b = vhi[d * 4 + ks];
                o[dp] = MX_MFMA(__builtin_bit_cast(bf16x8, pw[ks]), ((bf16x8){a[0], a[1], a[2], a[3], b[0], b[1], b[2], b[3]}), o[dp]); }
        __builtin_amdgcn_sched_barrier(0);
    }
}
__device__ __forceinline__ void ml_fused(LAS const float* gat, const f32x16& p0, const f32x16& p1, u32x4 (&pwN)[4], float& den, const float ft, const int lane,
                                         lptr vimgP, const u32x4 (&pwP)[4], f32x16 (&o)[4], const bool dopv) {
    const int hi = lane >> 5;
    const lptr vb = vimgP + ((lane >> 4) & 1) * 32 + (lane & 3) * 8 + (4 * hi + ((lane & 15) >> 2)) * 64;
    s16x4 f0a = vtr(vb), f0b = vtr(vb + 512), f1a = vtr(vb + 1024), f1b = vtr(vb + 1024 + 512);
    f32x4 gv = {};
    __builtin_amdgcn_sched_barrier(0);
#pragma unroll
    for (int k = 0; k < 16; ++k) {
        const int dp = k >> 2, ks = k & 3;
        s16x4 f2a = f0a, f2b = f0b;
        if (k + 2 < 16) { const int dn = (k + 2) >> 2, kn = (k + 2) & 3; f2a = vtr(vb + dn * 4096 + kn * 1024); f2b = vtr(vb + dn * 4096 + kn * 1024 + 512); }
        if (dopv) o[dp] = MX_MFMA(__builtin_bit_cast(bf16x8, pwP[ks]), ((bf16x8){f0a[0], f0a[1], f0a[2], f0a[3], f0b[0], f0b[1], f0b[2], f0b[3]}), o[dp]);
        const int blk = k >> 3, r = 2 * (k & 7);
        if ((k & 1) == 0) gv = *(LAS const f32x4*)(gat + 32 * blk + 8 * (r >> 2) + 4 * hi);
        const f32x16& X = blk ? p1 : p0;
        const float q0 = X[r] * (gv[r & 3] * ft), q1 = X[r + 1] * (gv[(r & 3) + 1] * ft);
        den += q0; den += q1;
        unsigned w = cvtpk(q0, q1);
        asm volatile("" : "+v"(w)); asm volatile("" : "+v"(den));
        pwN[2 * blk + ((k & 7) >> 2)][(k & 7) & 3] = w;
        f0a = f1a; f0b = f1b; f1a = f2a; f1b = f2b;
        __builtin_amdgcn_sched_barrier(0);
    }
}
__device__ __forceinline__ void ml_mask(f32x16& p0, f32x16& p1, const int qrow, const int key0, const int lane) {
    const int hi = lane >> 5;
#pragma unroll
    for (int r = 0; r < 16; ++r) { const int kk = key0 + crow(r, hi); p0[r] = (kk <= qrow) ? p0[r] : 0.f; p1[r] = (kk + 32 <= qrow) ? p1[r] : 0.f; }
}
template <int D, bool SBK>
__device__ __forceinline__ void prefetch_unit(KArgs kap, LAS unsigned char* lds, const int wave_s, const UnitP& u, bf16x8 (&qr)[D / 16], float& Mt, float& Ml, float& tgv) {
    int tid = wave_s * 64 + lane_id(); asm volatile("" : "+v"(tid));
    const int lane = tid & 63, wid = __builtin_amdgcn_readfirstlane(tid >> 6);
    const int qrow = 256 * u.qb + 32 * wid + (lane & 31), nt = 4 * (u.qb + 1);
    const unsigned l0 = (unsigned)(size_t)lds;
    const LoopPtrs<SBK> lp = loop_ptrs<SBK>(kap, u);
    issue_tile<D, !SBK>(l0 + KBUF0, l0 + VBUF0, l0 + EX_GA, lp, 64 * (nt - 1), wid, lane);
    issue_tile<D, !SBK>(l0 + KBUF0 + BUFSZ, l0 + VBUF0 + BUFSZ, l0 + EX_GA + 256, lp, 64 * (nt - 2), wid, lane);
    const size_t r0 = (size_t)u.b * SEQ;
    const bf16* Qp = SBK ? (const bf16*)WSP(WS_PROJ) + r0 * NPROJ + 2048 + u.h * 64 : (const bf16*)WSP(WS_QKC) + r0 * DM + u.h * 128; const int pq = SBK ? NPROJ : DM;
#pragma unroll
    for (int d0 = 0; d0 < D / 16; ++d0) qr[d0] = *(const GAS bf16x8*)(Qp + (size_t)qrow * pq + d0 * 16 + (lane >> 5) * 8);
    Mt = 0.f; Ml = 0.f; tgv = 0.f;
    if (!SBK) { const size_t bh = (size_t)(u.b * 4 + u.h); Mt = ((const float*)WSP(WS_GM))[bh * SEQ + qrow]; Ml = ((const float*)WSP(WS_GM))[bh * SEQ + 256 * u.qb + 255];
        tgv = ((const float*)WSP(WS_TG))[bh * 32 + (lane & 31)]; }
}
template <int D, bool SBK>
__device__ __forceinline__ void unit_run(KArgs kap, LAS unsigned char* lds, const int wave_s, const UnitP& u, const bool has_next, const UnitP& nx, bf16x8 (&qr)[D / 16], float& Mt, float& Ml, float& tgv) {
    int tid = wave_s * 64 + lane_id(); asm volatile("" : "+v"(tid));
    const LoopPtrs<SBK> lp = loop_ptrs<SBK>(kap, u);
    const int lane = tid & 63, wid = __builtin_amdgcn_readfirstlane(tid >> 6), late = MX_LATE ? (wid >> 2) : 0, r32 = lane & 31, hi = lane >> 5;
    const int t0 = 256 * u.qb, nt = 4 * (u.qb + 1), R0 = t0 + 32 * wid, qrow = R0 + r32;
    const unsigned l0 = (unsigned)(size_t)lds;
#pragma unroll
    for (int d0 = 0; d0 < D / 16; ++d0) asm volatile("" : "+v"(qr[d0]));
    asm volatile("" : "+v"(Mt)); asm volatile("" : "+v"(Ml)); asm volatile("" : "+v"(tgv));
    const float fv = SBK ? 0.f : __builtin_amdgcn_exp2f(tgv - Ml);
    const float Bt = SBK ? 1.f : __builtin_amdgcn_exp2f(Ml - Mt);
    f32x16 o[D / 32];
#pragma unroll
    for (int i = 0; i < D / 32; ++i) o[i] = f32x16{};
    float st = SBK ? 1.0f : 0.0f;
    const int nti = (!SBK && ML_CHUNK) ? 4 : nt;
    if constexpr (!SBK && ML_CHUNK) {
        __builtin_amdgcn_s_barrier();
        if (u.qb > 0) {
            const int bh = u.b * 4 + u.h;
            const float* CMp = (const float*)WSP(WS_CM) + bh * 8;
            {
                const int d = tid >> 2, dp = tid & 3;
                const unsigned short* Ub = (const unsigned short*)WSP(WS_U) + (size_t)bh * 7 * 16384 + d * 128 + dp * 32;
                v4u rr[7][4];
#pragma unroll
                for (int j = 0; j < 7; ++j) { const int jc = (j < u.qb) ? j : u.qb - 1;
#pragma unroll
                    for (int c = 0; c < 4; ++c) rr[j][c] = *(const GAS v4u*)(Ub + (size_t)jc * 16384 + 8 * c); }
                float scj[7];
                { const f32x4 c0 = *(const GAS f32x4*)CMp, c1 = *(const GAS f32x4*)(CMp + 4);
                  const float cmv[8] = {c0.x, c0.y, c0.z, c0.w, c1.x, c1.y, c1.z, c1.w};
#pragma unroll
                  for (int j = 0; j < 7; ++j) scj[j] = (j < u.qb) ? __builtin_amdgcn_exp2f(cmv[j] - Ml) : 0.f; }
                float ac[32];
#pragma unroll
                for (int c = 0; c < 32; ++c) ac[c] = 0.f;
#pragma unroll
                for (int j = 0; j < 7; ++j)
#pragma unroll
                    for (int c = 0; c < 4; ++c) { const v4u x = rr[j][c];
                        ac[8 * c + 0] += scj[j] * bflo(x.x); ac[8 * c + 1] += scj[j] * bfhi(x.x); ac[8 * c + 2] += scj[j] * bflo(x.y); ac[8 * c + 3] += scj[j] * bfhi(x.y);
                        ac[8 * c + 4] += scj[j] * bflo(x.z); ac[8 * c + 5] += scj[j] * bfhi(x.z); ac[8 * c + 6] += scj[j] * bflo(x.w); ac[8 * c + 7] += scj[j] * bfhi(x.w); }
                const int dl = d & 63, rho = (dl & 0x33) | ((dl & 4) << 1) | ((dl & 8) >> 1);
                LAS unsigned char* ip = lds + STAGE0 + (d >> 6) * 16384 + dp * 4096 + rho * 64;
#pragma unroll
                for (int c = 0; c < 4; ++c) *(LAS v4u*)(ip + 16 * c) = (v4u){cvtpk(ac[8 * c], ac[8 * c + 1]), cvtpk(ac[8 * c + 2], ac[8 * c + 3]), cvtpk(ac[8 * c + 4], ac[8 * c + 5]), cvtpk(ac[8 * c + 6], ac[8 * c + 7])};
                if (tid < 128) { const float* NVp = (const float*)WSP(WS_NV) + (size_t)bh * 7 * 128 + tid; float nn = 0.f, nvv[7];
#pragma unroll
                    for (int j = 0; j < 7; ++j) { const int jc = (j < u.qb) ? j : u.qb - 1; nvv[j] = NVp[jc * 128]; }
                    asm volatile("" : "+v"(nvv[0]), "+v"(nvv[1]), "+v"(nvv[2]), "+v"(nvv[3]), "+v"(nvv[4]), "+v"(nvv[5]), "+v"(nvv[6]));
#pragma unroll
                    for (int j = 0; j < 7; ++j) nn += scj[j] * nvv[j];
                    ((LAS float*)(lds + STAGE0 + 32768))[tid] = nn; }
            }
            LDS_WAIT(); __builtin_amdgcn_s_barrier(); asm volatile("" ::: "memory");
            {
                u32x4 qa[4], qb_[4];
#pragma unroll
                for (int c = 0; c < 4; ++c) { qa[c] = __builtin_bit_cast(u32x4, qr[c]); qb_[c] = __builtin_bit_cast(u32x4, qr[4 + c]); }
                pv<128>((lptr)(lds + STAGE0), qa, o, lane);
                pv<128>((lptr)(lds + STAGE0 + 16384), qb_, o, lane);
                LAS const float* nvl = (LAS const float*)(lds + STAGE0 + 32768);
                float dn = 0.f;
#pragma unroll
                for (int d0 = 0; d0 < 8; ++d0) { const f32x4 n0 = *(LAS const f32x4*)(nvl + 16 * d0 + 8 * hi), n1 = *(LAS const f32x4*)(nvl + 16 * d0 + 8 * hi + 4); const u32x4 qq = __builtin_bit_cast(u32x4, qr[d0]);
                    dn += bflo(qq.x) * n0.x + bfhi(qq.x) * n0.y + bflo(qq.y) * n0.z + bfhi(qq.y) * n0.w + bflo(qq.z) * n1.x + bfhi(qq.z) * n1.y + bflo(qq.w) * n1.z + bfhi(qq.w) * n1.w; }
                st = dn;
            }
        }
    }
    f32x16 p0 = {}, p1 = {};
    u32x4 pwP[4] = {}; bool havep = false;
    LAS unsigned* const dflag = (LAS unsigned*)(lds + EX_DEAD);
    if (SBK) { if (lane == 0) dflag[wid] = 0u; }
    int k3 = 0, v4 = 0;
    bool wdead = false;
    for (int i = 0; i < nti + MX_LATE; ++i) {
        if (i + 1 < nti) { if (D == 64) asm volatile("s_waitcnt vmcnt(2)" ::: "memory"); else asm volatile("s_waitcnt vmcnt(5)" ::: "memory"); }
        else asm volatile("s_waitcnt vmcnt(0)" ::: "memory");
        if (SBK) LDS_WAIT();
        __builtin_amdgcn_s_barrier();
        asm volatile("" ::: "memory");
        if (SBK && i > 0) { const u32x4 d0 = *(LAS const u32x4*)dflag, d1 = *(LAS const u32x4*)(dflag + 4);
            if (__builtin_amdgcn_readfirstlane((int)(d0.x & d0.y & d0.z & d0.w & d1.x & d1.y & d1.z & d1.w)) != 0) break; }
        if (i + 2 < nti) { const int k3n = (k3 == 0) ? 2 : k3 - 1, v4n = (v4 + 2) & 3;
            issue_tile<D, !SBK>(l0 + KBUF0 + k3n * BUFSZ, l0 + VBUF0 + v4n * BUFSZ, l0 + EX_GA + v4n * 256, lp, 64 * (nt - 3 - i), wid, lane); }
        const int v4p = (v4 + 3) & 3;
        const int tv = late ? nt - i : nt - 1 - i;
        const int vb = late ? v4p : v4;
        const bool dov = late ? (i >= 1) : (i < nti);
        const int tq = nt - 1 - i;
        const bool doq = (i < nti) && (SBK ? (64 * tq < R0 + 31) : (64 * tq <= R0 + 31));
        const lptr kimg = (lptr)(lds + KBUF0 + k3 * BUFSZ);
        if (!late && doq && !wdead) qk<D>(kimg, qr, p0, p1, lane);
        if constexpr (!SBK) {
            if (doq) {
                const float ft = __builtin_bit_cast(float, __builtin_amdgcn_readlane(__builtin_bit_cast(int, fv), tq));
                const bool unm = (64 * tq + 63 <= R0);
                LAS const float* gat = (LAS const float*)(lds + EX_GA + v4 * 256); const lptr vprev = (lptr)(lds + VBUF0 + v4p * BUFSZ);
                u32x4 pwN[4];
                if (!unm) ml_mask(p0, p1, qrow, 64 * tq, lane);
                ml_fused(gat, p0, p1, pwN, st, ft, lane, vprev, pwP, o, havep);
#pragma unroll
                for (int q_ = 0; q_ < 4; ++q_) pwP[q_] = pwN[q_];
                havep = true;
            }
        } else
        if (dov) {
            const bool live = SBK ? (64 * tv < R0 + 31) : (64 * tv <= R0 + 31);
            const bool unm = SBK ? (64 * tv + 63 < R0) : (64 * tv + 63 <= R0);
            const lptr vimg = (lptr)(lds + VBUF0 + vb * BUFSZ); LAS const float* gat = (LAS const float*)(lds + EX_GA + vb * 256);
            if (live && !wdead) { const float ft = SBK ? 0.f : __builtin_bit_cast(float, __builtin_amdgcn_readlane(__builtin_bit_cast(int, fv), tv));
                if (unm) vp<D, SBK, false>(vimg, gat, p0, p1, o, st, ft, qrow, 64 * tv, lane); else vp<D, SBK, true>(vimg, gat, p0, p1, o, st, ft, qrow, 64 * tv, lane);
                if (SBK) { const bool dead = (__ballot(st != 0.0f) == 0ull); if (lane == 0) dflag[wid] = dead ? 1u : 0u; wdead = dead; } }
        }
        if (late && doq) qk<D>(kimg, qr, p0, p1, lane);
        k3 = (k3 == 2) ? 0 : k3 + 1; v4 = (v4 + 1) & 3;
    }
    if constexpr (!SBK) { if (havep) pv<D>((lptr)(lds + VBUF0 + ((nt - 1) & 3) * BUFSZ), pwP, o, lane); }
    LDS_WAIT(); __builtin_amdgcn_s_barrier(); asm volatile("" ::: "memory");
    const float ge_q = SBK ? 0.f : ((const float*)WSP(WS_GE))[(size_t)(u.b * 4 + u.h) * SEQ + qrow];
    if (has_next) prefetch_unit<D, SBK>(kap, lds, wave_s, nx, qr, Mt, Ml, tgv);
    const size_t er0 = (size_t)u.b * SEQ;
    bf16* const e_out = (bf16*)WSP(WS_MIXED) + er0 * DM + (SBK ? 512 + u.h * 64 : u.h * 128);
    const float* const e_gain = SBK ? KA(g_sb) + u.layer * 512 + u.h * 64 : KA(g_mlstm) + u.layer * 512 + u.h * 128;
    const bf16* const e_om = (const bf16*)WSP(WS_PROJ) + er0 * NPROJ + 1536 + u.h * 128;
    LAS float* stg = (LAS float*)(lds + STAGE0 + wid * STAGE_W); LAS float* wsf = stg + 1088;
    if (!SBK) { const float den = (st + partner(st, hi)) * Bt; if (hi == 0) wsf[r32] = Bt / fmaxf(fabsf(den), ge_q); }
    constexpr int RP = (D == 64) ? 16 : 8, NPASS = 32 / RP, LPR = 64 / RP, PITCH = D + 4, RPP = 16 / NPASS;
    const int rl = lane / LPR, seg = lane % LPR;
    float gn[16];
#pragma unroll
    for (int c = 0; c < 4; ++c) { const f32x4 g = *(const GAS f32x4*)(e_gain + 16 * seg + 4 * c); gn[4 * c] = g.x; gn[4 * c + 1] = g.y; gn[4 * c + 2] = g.z; gn[4 * c + 3] = g.w; }
    v4u gpre[SBK ? 1 : NPASS][2];
    if constexpr (!SBK) {
#pragma unroll
        for (int ps = 0; ps < NPASS; ++ps) { const int gr_ = R0 + ps * RP + rl; gpre[ps][0] = *(const GAS v4u*)(e_om + (size_t)gr_ * NPROJ + 16 * seg); gpre[ps][1] = *(const GAS v4u*)(e_om + (size_t)gr_ * NPROJ + 16 * seg + 8); }
    }
#pragma unroll
    for (int ps = 0; ps < NPASS; ++ps) {
        LDS_WAIT(); asm volatile("" ::: "memory");
#pragma unroll
        for (int rr = 0; rr < RPP; ++rr) { const int r = ps * RPP + rr; const int srow = crow(r, hi) - ps * RP;
#pragma unroll
            for (int dp = 0; dp < D / 32; ++dp) stg[srow * PITCH + 32 * dp + r32] = o[dp][r]; }
        LDS_WAIT(); asm volatile("" ::: "memory");
        float x[16];
#pragma unroll
        for (int c = 0; c < 4; ++c) { const f32x4 v4 = *(LAS const f32x4*)(stg + rl * PITCH + 16 * seg + 4 * c); x[4 * c] = v4.x; x[4 * c + 1] = v4.y; x[4 * c + 2] = v4.z; x[4 * c + 3] = v4.w; }
        const int prow = ps * RP + rl, grow = R0 + prow;
        if (!SBK) { const float inv = wsf[prow];
#pragma unroll
            for (int c = 0; c < 16; ++c) x[c] *= inv; }
        float ss = 0.f;
#pragma unroll
        for (int c = 0; c < 16; ++c) ss += x[c] * x[c];
        ss = (LPR == 8) ? oct_sum(ss, lane) : quad_sum(ss);
        const float rs = 1.0f / sqrtf(ss * (1.0f / D) + EPS);
#pragma unroll
        for (int c = 0; c < 16; ++c) x[c] *= rs * gn[c];
        if (!SBK) { const v4u g0 = gpre[SBK ? 0 : ps][0], g1 = gpre[SBK ? 0 : ps][1];
            float gg[16]; gg[0] = bflo(g0.x); gg[1] = bfhi(g0.x); gg[2] = bflo(g0.y); gg[3] = bfhi(g0.y); gg[4] = bflo(g0.z); gg[5] = bfhi(g0.z); gg[6] = bflo(g0.w); gg[7] = bfhi(g0.w);
            gg[8] = bflo(g1.x); gg[9] = bfhi(g1.x); gg[10] = bflo(g1.y); gg[11] = bfhi(g1.y); gg[12] = bflo(g1.z); gg[13] = bfhi(g1.z); gg[14] = bflo(g1.w); gg[15] = bfhi(g1.w);
#pragma unroll
            for (int c = 0; c < 16; ++c) x[c] *= 1.0f / (1.0f + __expf(-gg[c])); }
        bf16* op = e_out + (size_t)grow * DM + 16 * seg;
        *(GAS v4u*)op = (v4u){pk2(x[0], x[1]), pk2(x[2], x[3]), pk2(x[4], x[5]), pk2(x[6], x[7])};
        *(GAS v4u*)(op + 8) = (v4u){pk2(x[8], x[9]), pk2(x[10], x[11]), pk2(x[12], x[13]), pk2(x[14], x[15])};
    }
    LDS_WAIT();
}
#undef MX_MFMA
}

__device__ __forceinline__ void mixer_phase(KArgs kap, LAS unsigned char* lds, const int wave_s, const int layer) {
    int G = gridDim.x; asm volatile("" : "+s"(G)); int bid = blockIdx.x; asm volatile("" : "+s"(bid));
    for (int jb = bid; jb < 256; jb += G) {
        {
            int jb2 = jb; asm volatile("" : "+s"(jb2));
            const int b = jb2 & 7, idx = jb2 >> 3, m = idx & 7, hl = idx >> 3;
#if ML_CHUNK
            int hA, qA, hB, qB;
            if (m < 6) { const int n0 = (m * 4 + hl) * 2, n1 = n0 + 1; hA = (n0 * 37) >> 8; qA = 1 + n0 - 7 * hA; hB = (n1 * 37) >> 8; qB = 1 + n1 - 7 * hB; }
            else { const int n0 = 48 + (m - 6) * 4 + hl; hA = (n0 * 37) >> 8; qA = 1 + n0 - 7 * hA; hB = hl + 4 * (m - 6); qB = 0; }
            bf16x8 qr[4]; float Mt, Ml, tgv;
            __builtin_amdgcn_s_barrier();
            {
                const mix2::UnitP uA{b, hA, qA, layer}, uB{b, hB, qB, layer};
                mix2::prefetch_unit<64, true>(kap, lds, wave_s, uA, qr, Mt, Ml, tgv);
                mix2::unit_run<64, true>(kap, lds, wave_s, uA, true, uB, qr, Mt, Ml, tgv);
                mix2::unit_run<64, true>(kap, lds, wave_s, uB, false, uB, qr, Mt, Ml, tgv);
            }
#else
            const int nsb = (0x01122334 >> (4 * m)) & 15, st0 = (int)((0xFECA740ull >> (4 * m)) & 15ull);
            bf16x8 qr[4]; float Mt, Ml, tgv;
            __builtin_amdgcn_s_barrier();
            if (nsb > 0) {
                const int u0 = hl * 16 + st0;
                mix2::UnitP uc{b, u0 >> 3, u0 & 7, layer};
                mix2::prefetch_unit<64, true>(kap, lds, wave_s, uc, qr, Mt, Ml, tgv);
#pragma unroll 1
                for (int k = 0; k < nsb; ++k) {
                    const int un = u0 + k + 1; const mix2::UnitP nx{b, un >> 3, un & 7, layer};
                    mix2::unit_run<64, true>(kap, lds, wave_s, uc, k + 1 < nsb, nx, qr, Mt, Ml, tgv);
                    uc = nx;
                }
            }
#endif
        }
#if CONV_NOBAR
        {
            int t0_ = wave_s * 64 + lane_id();
            if (t0_ == 0) { gu32* cc = (gu32*)WSP(WS_CTL) + CW_CONV + 8 * layer + (bid & 7); unsigned sp = 0u;
                while (__hip_atomic_load(cc, __ATOMIC_RELAXED, __HIP_MEMORY_SCOPE_AGENT) < (unsigned)(G >> 3)) { __builtin_amdgcn_s_sleep(1); if (++sp > (1u << 22)) break; }
                __builtin_amdgcn_fence(__ATOMIC_ACQUIRE, "agent"); }
            __builtin_amdgcn_s_barrier();
        }
#endif
        {
            const int b = jb & 7, idx = jb >> 3, m = idx & 7, hl = idx >> 3;
            const mix2::UnitP u{b, hl, m, layer};
            bf16x8 qr[8]; float Mt, Ml, tgv;
            mix2::prefetch_unit<128, false>(kap, lds, wave_s, u, qr, Mt, Ml, tgv);
            mix2::unit_run<128, false>(kap, lds, wave_s, u, false, u, qr, Mt, Ml, tgv);
        }
        __builtin_amdgcn_s_barrier();
    }
}

#define MKFRAME() Frame F; F.lds = (LAS unsigned char*)lds; F.MISC = (volatile LAS unsigned*)(F.lds + MISC_OFF); F.tid = wave_s * 64 + lane_id(); asm volatile("" : "+v"(F.tid)); F.lane = F.tid & 63; \
    F.wave = __builtin_amdgcn_readfirstlane(F.tid >> 6); F.G = gridDim.x; asm volatile("" : "+s"(F.G)); F.bid = blockIdx.x; asm volatile("" : "+s"(F.bid)); F.ctl = (gu32*)WSP(WS_CTL)
#define GRID_BAR() do { XcdBarrier bar_; bar_.bar = (unsigned*)WSP(WS_CTL) + CW_BAR; bar_.x = xb_xcc_id(); bar_.st = (volatile LAS unsigned*)((LAS unsigned char*)lds + MISC_OFF) + 8; xcd_barrier(bar_, wave_s); } while (0)
#define GROUP_BAR() group_barrier((gu32*)WSP(WS_CTL) + CW_GB + 4096 * ((int)blockIdx.x & 7), wave_s, (volatile LAS unsigned*)((LAS unsigned char*)lds + MISC_OFF) + 24, xb_xcc_id())
#define BUILD_TAB() do { __syncthreads(); \
            if (F.tid == 0) { int acc_ = 0; for (int e = 0; e < 8; ++e) { const int c_ = (int)__hip_atomic_load(F.ctl + CW_CNT + 64 * j + e, RLX_AGENT); tab[e] = acc_; tab[16 + e] = c_; acc_ += (c_ + 255) >> 8; } tab[8] = acc_; } \
            __syncthreads(); } while (0)

__global__ void __launch_bounds__(NTHREADS, 2) mk_fwd(Args args_unused) {
    extern __shared__ __attribute__((aligned(16))) unsigned char lds[];
    KArgs kap = (KArgs)__builtin_amdgcn_kernarg_segment_ptr();
    const int wave_s = __builtin_amdgcn_readfirstlane((int)threadIdx.x >> 6);
    for (int u = threadIdx.x; u < 256; u += NTHREADS) ((LAS unsigned*)((LAS unsigned char*)lds + MISC_OFF))[u] = 0u;
    __syncthreads();
    (void)xcd_barrier_post((unsigned*)WSP(WS_CTL) + CW_BAR, (volatile LAS unsigned*)((LAS unsigned char*)lds + MISC_OFF) + 8);
    { gu32* gbp = (gu32*)WSP(WS_CTL) + CW_GB + 4096 * ((int)blockIdx.x & 7) + GB_XCNT(xb_xcc_id());
      if (threadIdx.x == 0) (void)__hip_atomic_fetch_add(gbp, 1u, __ATOMIC_RELAXED, __HIP_MEMORY_SCOPE_AGENT); }

    { MKFRAME(); Args a; a.ws = KA(ws); a.w_in = KA(w_in); a.w_out = KA(w_out); a.ffn_w_gate = KA(ffn_w_gate); a.ffn_w_up = KA(ffn_w_up); a.ffn_w_down = KA(ffn_w_down);
      a.moe_w_gate = KA(moe_w_gate); a.moe_w_up = KA(moe_w_up); a.moe_w_down = KA(moe_w_down); a.norm_mix_g = KA(norm_mix_g); a.norm_ffn_g = KA(norm_ffn_g);
#pragma unroll 1
      for (int rep = 0; rep < REP_PRO; ++rep) prologue_phase(a, F); }
    __syncthreads();
    for (int layer = 0; layer < DEPTH; ++layer) {
        const int j = layer >> 1; const bool moe = layer & 1;
        { MKFRAME();
            NormIn p{}; p.src = KA(x); p.src16 = (const bf16*)WSP(WS_H16); p.o2 = (layer == 2) ? (bf16*)WSP(WS_O2) : nullptr; p.hout16 = (layer == 0 || layer == 2) ? (bf16*)WSP(WS_H16) : nullptr; p.rs = (float*)WSP(WS_RS);
            p.gain = KA(norm_mix_g) + layer * DM; p.w8 = KA(w_in) + (size_t)layer * DM * PIN + 2048; p.ld8 = PIN; p.G = (float*)WSP(WS_G);
            if (layer == 0) norm_phase<0, false>(F, p); else norm_phase<0, true>(F, p);
        }
        if (layer == 0) GRID_BAR(); else GROUP_BAR();
        { MKFRAME();
            if (F.bid >= 128 && F.bid < 160) gate_scan(F, (F.bid & 7) * HM + ((F.bid >> 3) - 16), (float*)WSP(WS_G), KA(b_igate) + layer * HM, KA(b_fgate) + layer * HM, (float*)WSP(WS_GA), (float*)WSP(WS_GM), (float*)WSP(WS_GE), (float*)WSP(WS_TG));
            __syncthreads();
            pg8::EpiProj E{(bf16*)WSP(WS_PROJ), (const float*)WSP(WS_RS)};
            const int ngw = F.G >> 3, lw = F.bid >> 3, ntl = pg8::WGM * (NPROJ / pg8::BM);
            const int maxu = (ntl + ngw - 1) / ngw, h0 = ntl - (maxu - 1) * ngw, nh = ngw - h0;
            { pg8::InprojOrder S; S.init(WSP(WS_H16), (bf16*)WSP(WS_WIN) + (size_t)layer * NPROJ * DM, T, NPROJ, DM, F.G, F.bid, 0, 2);
              pg8::gemm_phase<pg8::EpiProj, pg8::InprojOrder, true>(F.lds + RING_OFF, S, E, F.tid); }
            asm volatile("s_waitcnt vmcnt(0)" ::: "memory");
            __syncthreads();
            { const unsigned xcc = xb_xcc_id(); gu32* gbp = F.ctl + CW_GB + 4096 * (F.bid & 7);
              if (F.tid == 0) group_arrive(gbp, F.MISC + 24, xcc, (unsigned)layer + 1u); }
            { pg8::InprojOrder S; S.init(WSP(WS_H16), (bf16*)WSP(WS_WIN) + (size_t)layer * NPROJ * DM, T, NPROJ, DM, F.G, F.bid, 2, maxu - 2);
              pg8::gemm_phase<pg8::EpiProj, pg8::InprojOrder, true>(F.lds + RING_OFF, S, E, F.tid); }
            if (nh == 0 || lw >= h0) {
                const int hidx = nh == 0 ? lw : lw - h0, nhe = nh == 0 ? ngw : nh;
                __syncthreads();
                { const unsigned xcc = xb_xcc_id(); gu32* gbp = F.ctl + CW_GB + 4096 * (F.bid & 7);
                  if (F.tid == 0) group_wait(gbp, F.MISC + 24, xcc, (unsigned)layer + 1u); }
                __syncthreads();
                conv_phase(F, (bf16*)WSP(WS_PROJ), KA(conv_w) + (size_t)layer * 4 * 1024, KA(conv_b) + (size_t)layer * 1024, (bf16*)WSP(WS_QKC), hidx, nhe);
#pragma unroll 1
                for (int ub = nhe - 1 - hidx; ub < HM * 7; ub += nhe) chunk_state_unit(F, (F.bid & 7) * HM + ub / 7, ub % 7, (bf16*)WSP(WS_PROJ), KA(conv_w) + (size_t)layer * 4 * 1024, KA(conv_b) + (size_t)layer * 1024,
                                                                   (float*)WSP(WS_GA), (float*)WSP(WS_TG), (bf16*)WSP(WS_U), (float*)WSP(WS_NV), (float*)WSP(WS_CM), (bf16*)WSP(WS_QKC));
            }
        }
        GROUP_BAR();
        { MKFRAME();
#if NAIVE_MIX == 1
            naive_sb(F, (bf16*)WSP(WS_PROJ), KA(g_sb) + layer * 512, (bf16*)WSP(WS_MIXED));
            naive_mlstm(F, (bf16*)WSP(WS_PROJ), (bf16*)WSP(WS_QKC), (float*)WSP(WS_GA), (float*)WSP(WS_GM), (float*)WSP(WS_GE), KA(g_mlstm) + layer * 512, (bf16*)WSP(WS_MIXED));
#else
#pragma unroll 1
            for (int rep = 0; rep < REP_MIX; ++rep) mixer_phase(kap, F.lds, wave_s, layer);
#endif
            __syncthreads();
        }
        GROUP_BAR();
        { MKFRAME();
            pg8::DenseOrder S; S.init(WSP(WS_MIXED), (bf16*)WSP(WS_WOUT) + (size_t)layer * DM * DM, T, DM, DM, F.G, F.bid);
            { pg8::EpiResid16<false> E{nullptr, (bf16*)WSP(WS_H16), 1.0f}; pg8::gemm_phase<pg8::EpiResid16<false>, pg8::DenseOrder, true>(F.lds + RING_OFF, S, E, F.tid); }
        }
        GROUP_BAR();
        { MKFRAME();
            NormIn p{}; p.src16 = (const bf16*)WSP(WS_H16); p.gain = KA(norm_ffn_g) + layer * DM; p.rs = (float*)WSP(WS_RS);
            if (moe) { p.w8 = KA(w_router) + (size_t)j * DM * 8; p.ld8 = 8; p.cnt = (unsigned*)(F.ctl + CW_CNT + 64 * j); p.rinfo = (uint2*)WSP(WS_RINFO); p.cntw = (int*)WSP(WS_CNTW); p.rrec = (int*)WSP(WS_RREC); p.h8 = (unsigned char*)WSP(WS_H8);
                norm_phase<2, true>(F, p); }
            else { p.h8 = ((DENSE_F8_UP >> j) & 1) ? (unsigned char*)WSP(WS_H8) : nullptr; norm_phase<1, true>(F, p); }
        }
        if (moe) { GRID_BAR(); MKFRAME(); route_finish(F, (const int*)WSP(WS_CNTW), (const int*)WSP(WS_RREC), (uint2*)WSP(WS_RINFO), (const float*)WSP(WS_RS), (float*)WSP(WS_RSI)); }
        if (moe) GRID_BAR(); else GROUP_BAR();
        { MKFRAME(); volatile LAS int* tab = (volatile LAS int*)(F.MISC + 32);
            if (!moe) {
              if ((DENSE_F8_UP >> j) & 1) {
                pg8::DenseOrderT<true> S; S.init(WSP(WS_H8), (unsigned char*)WSP(WS_WGU) + (size_t)j * 2 * FFDP * DM * 2, T, 2 * FFDP, DM / 2, F.G, F.bid);
                pg8::EpiSwiglu8 E{(unsigned char*)WSP(WS_HID), FFDP, 1.0f / F8_WGU, nullptr};
#pragma unroll 1
                for (int rep = 0; rep < REP_DUP; ++rep) pg8::gemm_phase<pg8::EpiSwiglu8, pg8::DenseOrderT<true>, true>(F.lds + RING_OFF, S, E, F.tid);
              } else if ((DENSE_F8_DN >> j) & 1) {
                pg8::DenseOrder S; S.init(WSP(WS_H16), (bf16*)WSP(WS_WGU) + (size_t)j * 2 * FFDP * DM, T, 2 * FFDP, DM, F.G, F.bid);
                pg8::EpiSwiglu8T<true> E{(unsigned char*)WSP(WS_HID), FFDP, 1.0f, (const float*)WSP(WS_RS)};
                pg8::gemm_phase<pg8::EpiSwiglu8T<true>, pg8::DenseOrder, true>(F.lds + RING_OFF, S, E, F.tid);
              } else {
                pg8::DenseOrder S; S.init(WSP(WS_H16), (bf16*)WSP(WS_WGU) + (size_t)j * 2 * FFDP * DM, T, 2 * FFDP, DM, F.G, F.bid);
                pg8::EpiSwiglu E{(bf16*)WSP(WS_HID), FFDP, (const float*)WSP(WS_RS), nullptr};
#pragma unroll 1
                for (int rep = 0; rep < REP_DUP; ++rep) pg8::gemm_phase<pg8::EpiSwiglu, pg8::DenseOrder, true>(F.lds + RING_OFF, S, E, F.tid);
              }
            } else {
                BUILD_TAB();
#if MOE_FP8
                pg8::MoeOrder<true> S; S.init(WSP(WS_H8), (unsigned char*)WSP(WS_MGU) + (size_t)j * 8 * 2 * FFE * DM, (size_t)2 * FFE * DM, 2 * FFE, DM / 2, F.G, F.bid, tab, (const uint2*)WSP(WS_RINFO));
                pg8::EpiSwiglu8 E{(unsigned char*)WSP(WS_HIDM), FFE, 1.0f / F8_WGU, nullptr};
#pragma unroll 1
                for (int rep = 0; rep < REP_MOEUP; ++rep) pg8::gemm_phase<pg8::EpiSwiglu8, pg8::MoeOrder<true>, true>(F.lds + RING_OFF, S, E, F.tid);
#else
                pg8::MoeOrder<true> S; S.init(WSP(WS_H16), (bf16*)WSP(WS_MGU) + (size_t)j * 8 * 2 * FFE * DM, (size_t)2 * FFE * DM * 2, 2 * FFE, DM, F.G, F.bid, tab, (const uint2*)WSP(WS_RINFO));
                pg8::EpiSwiglu E{(bf16*)WSP(WS_HIDM), FFE, nullptr, (const float*)WSP(WS_RSI)};
#pragma unroll 1
                for (int rep = 0; rep < REP_MOEUP; ++rep) pg8::gemm_phase<pg8::EpiSwiglu, pg8::MoeOrder<true>, true>(F.lds + RING_OFF, S, E, F.tid);
#endif
            }
        }
        if (moe) GRID_BAR(); else GROUP_BAR();
        { MKFRAME(); volatile LAS int* tab = (volatile LAS int*)(F.MISC + 32);
            if (!moe) {
              if ((DENSE_F8_DN >> j) & 1) {
                pg8::DenseOrderT<true> S; S.init(WSP(WS_HID), (unsigned char*)WSP(WS_WD) + (size_t)j * DM * FFDP * 2, T, DM, FFDP / 2, F.G, F.bid);
                pg8::EpiResid16<false> E{nullptr, (bf16*)WSP(WS_H16), 1.0f / (F8_HID * F8_WD)};
                pg8::gemm_phase<pg8::EpiResid16<false>, pg8::DenseOrderT<true>, true>(F.lds + RING_OFF, S, E, F.tid);
              } else {
                pg8::DenseOrder S; S.init(WSP(WS_HID), (bf16*)WSP(WS_WD) + (size_t)j * DM * FFDP, T, DM, FFDP, F.G, F.bid);
                pg8::EpiResid16<false> E{nullptr, (bf16*)WSP(WS_H16), 1.0f};
                pg8::gemm_phase<pg8::EpiResid16<false>, pg8::DenseOrder, true>(F.lds + RING_OFF, S, E, F.tid);
              }
            } else {
                BUILD_TAB();
#if MOE_FP8
                pg8::MoeOrder<false> S; S.init(WSP(WS_HIDM), (unsigned char*)WSP(WS_MD) + (size_t)j * 8 * DM * FFE, (size_t)DM * FFE, DM, FFE / 2, F.G, F.bid, tab, (const uint2*)WSP(WS_RINFO));
                pg8::EpiScatter E{(bf16*)WSP(WS_O2), (const uint2*)WSP(WS_RINFO), 1.0f / (F8_HID * F8_WD)};
#else
                pg8::MoeOrder<false> S; S.init(WSP(WS_HIDM), (bf16*)WSP(WS_MD) + (size_t)j * 8 * DM * FFE, (size_t)DM * FFE * 2, DM, FFE, F.G, F.bid, tab, (const uint2*)WSP(WS_RINFO));
                pg8::EpiScatter E{(bf16*)WSP(WS_O2), (const uint2*)WSP(WS_RINFO), 1.0f};
#endif
#if MOE_TAIL_KS > 1
                const int rem = S.nwg % F.G, nmain = S.nwg - rem;
                pg8::MoeOrder<false> S0 = S; S0.nwg = nmain;
                pg8::gemm_phase<pg8::EpiScatter, pg8::MoeOrder<false>, true>(F.lds + RING_OFF, S0, E, F.tid);
                if (rem > 0 && F.bid < rem * MOE_TAIL_KS) {
                    pg8::MoeTailOrder ST; ST.init(S, nmain, rem, MOE_TAIL_KS, F.bid);
                    const int tl = F.bid % rem;
                    float* Pt = (float*)WSP(WS_Y) + (size_t)tl * MOE_TAIL_KS * 65536;
                    pg8::EpiPartial EP{Pt + (size_t)ST.slice * 65536};
                    pg8::gemm_phase<pg8::EpiPartial, pg8::MoeTailOrder, true>(F.lds + RING_OFF, ST, EP, F.tid);
                    asm volatile("s_waitcnt vmcnt(0)" ::: "memory");
                    __syncthreads();
                    if (F.tid == 0) { __builtin_amdgcn_fence(__ATOMIC_RELEASE, "agent");
                        const unsigned old_ = __hip_atomic_fetch_add(F.ctl + CW_TAIL + 32 * j + tl, 1u, __ATOMIC_RELAXED, __HIP_MEMORY_SCOPE_AGENT);
                        if (old_ == MOE_TAIL_KS - 1) __builtin_amdgcn_fence(__ATOMIC_ACQUIRE, "agent");
                        F.MISC[16] = old_; }
                    __syncthreads();
                    if (F.MISC[16] == MOE_TAIL_KS - 1) {
                        f32x4 acc[2][2][4][2];
#pragma unroll
                        for (int g = 0; g < 4; ++g) {
                            const float* pg = Pt + ((size_t)(g * 8) * 512 + F.tid) * 4; asm volatile("" : "+v"(pg));
#pragma unroll
                            for (int kh = 0; kh < 2; ++kh) {
                                f32x4 t[4][MOE_TAIL_KS];
#pragma unroll
                                for (int k2 = 0; k2 < 4; ++k2)
#pragma unroll
                                    for (int sl = 0; sl < MOE_TAIL_KS; ++sl) t[k2][sl] = *(const GAS f32x4*)(pg + (size_t)sl * 65536 + (4 * kh + k2) * 2048);
#pragma unroll
                                for (int k2 = 0; k2 < 4; ++k2)
#pragma unroll
                                    for (int sl = 0; sl < MOE_TAIL_KS; ++sl) asm volatile("" : "+v"(t[k2][sl]));
#pragma unroll
                                for (int k2 = 0; k2 < 4; ++k2) { f32x4 v = t[k2][0];
#pragma unroll
                                    for (int sl = 1; sl < MOE_TAIL_KS; ++sl) v += t[k2][sl];
                                    const int k = 4 * kh + k2; acc[g >> 1][g & 1][k >> 1][k & 1] = v; }
                            }
                            asm volatile("" : "+v"(acc[g >> 1][g & 1][0][0]), "+v"(acc[g >> 1][g & 1][0][1]), "+v"(acc[g >> 1][g & 1][1][0]), "+v"(acc[g >> 1][g & 1][1][1]),
                                              "+v"(acc[g >> 1][g & 1][2][0]), "+v"(acc[g >> 1][g & 1][2][1]), "+v"(acc[g >> 1][g & 1][3][0]), "+v"(acc[g >> 1][g & 1][3][1]));
                        }
                        pg8::Unit ut; ST.base.decode(ST.wgid, ut);
                        const int wid_ = F.tid >> 6, ln_ = F.tid & 63;
                        E(acc, ut, wid_ >> 2, wid_ & 3, ln_ & 15, ln_ >> 4);
                    }
                    __syncthreads();
                }
#else
#pragma unroll 1
                for (int rep = 0; rep < REP_MOEDN; ++rep) pg8::gemm_phase<pg8::EpiScatter, pg8::MoeOrder<false>, true>(F.lds + RING_OFF, S, E, F.tid);
#endif
            }
        }
        if (moe) GRID_BAR(); else GROUP_BAR();
    }
    { MKFRAME(); NormIn p{}; p.src16 = (const bf16*)WSP(WS_H16); p.o2 = (bf16*)WSP(WS_O2); p.hout = KA(out); p.gain = KA(norm_final_g); norm_phase<3, true>(F, p); }
}

extern "C" void kernel_launch(void* const* d_in, const int* in_sizes, int n_in, void* d_out, int out_size, void* d_ws, size_t ws_size, hipStream_t stream) {
    static int grid = 0;
    if (grid == 0) {
        if (n_in != 19 || in_sizes[0] != T * DM || out_size != T * DM || ws_size < WS_END) { fprintf(stderr, "kernel_launch: unexpected shapes / workspace (%d inputs, in0 %d, out %d, ws %zu)\n", n_in, n_in > 0 ? in_sizes[0] : -1, out_size, ws_size); grid = -1; return; }
        int dev = 0, cus = 0, per_cu = 0;
        if (hipGetDevice(&dev) != hipSuccess || hipDeviceGetAttribute(&cus, hipDeviceAttributeMultiprocessorCount, dev) != hipSuccess) { grid = -1; return; }
        if (hipFuncSetAttribute((const void*)mk_fwd, hipFuncAttributeMaxDynamicSharedMemorySize, LDS_BYTES) != hipSuccess) { grid = -1; return; }
        if (hipOccupancyMaxActiveBlocksPerMultiprocessor(&per_cu, (const void*)mk_fwd, NTHREADS, LDS_BYTES) != hipSuccess || per_cu < 1) fprintf(stderr, "kernel_launch: occupancy query says %d\n", per_cu);
        (void)hipGetLastError();
        grid = cus - cus % 8;
        if (grid < 160) { fprintf(stderr, "kernel_launch: %d compute units: this kernel needs at least 160\n", cus); grid = -1; return; }
    }
    if (grid < 0) return;
    if (hipMemsetAsync((char*)d_ws + WS_CTL, 0, CTL_ZERO_BYTES, stream) != hipSuccess) return;
    Args a{};
    a.x = (const float*)d_in[0]; a.norm_mix_g = (const float*)d_in[1]; a.w_in = (const float*)d_in[2]; a.b_igate = (const float*)d_in[3]; a.b_fgate = (const float*)d_in[4];
    a.conv_w = (const float*)d_in[5]; a.conv_b = (const float*)d_in[6]; a.g_mlstm = (const float*)d_in[7]; a.g_sb = (const float*)d_in[8]; a.w_out = (const float*)d_in[9];
    a.norm_ffn_g = (const float*)d_in[10]; a.ffn_w_gate = (const float*)d_in[11]; a.ffn_w_up = (const float*)d_in[12]; a.ffn_w_down = (const float*)d_in[13];
    a.w_router = (const float*)d_in[14]; a.moe_w_gate = (const float*)d_in[15]; a.moe_w_up = (const float*)d_in[16]; a.moe_w_down = (const float*)d_in[17]; a.norm_final_g = (const float*)d_in[18];
    a.out = (float*)d_out; a.ws = (unsigned char*)d_ws; a.ph_lo = 0; a.ph_hi = 0;
    hipLaunchKernelGGL(mk_fwd, dim3(grid), dim3(NTHREADS), LDS_BYTES, stream, a);
}
```
